# Optimizing an MI355X kernel written in HIP

```python
import jax
import jax.numpy as jnp
from jax import lax
import numpy as np

D_MODEL = 1024
BATCH = 2
SEQ = 16384
DEPTH = 1

MIX_W = D_MODEL
M_HEADS = 4
M_HEAD_DIM = MIX_W // (2 * M_HEADS)
M_W = M_HEADS * M_HEAD_DIM
M_CHUNK = 128
CONV_K = 5
N_GATE = 4 * M_HEADS
A_HEADS = 4
A_V_DIM = (MIX_W - M_W) // A_HEADS
A_NOPE = A_V_DIM
A_ROPE = A_NOPE // 2
A_W = A_HEADS * A_V_DIM
Q_LORA = 3 * D_MODEL // 8
KV_LORA = D_MODEL // 4
ROPE_BASE = 10000.0
Q_BLOCK = 128
N_GROUPS = 4
EXP_PER_GROUP = 8
N_EXPERTS = N_GROUPS * EXP_PER_GROUP
TOP_K = 2
D_EXPERT = D_MODEL // 2
MOE_BLOCK = 128
POS_OFFSET_MAX = 1024
LN_EPS = 1e-5
RMS_EPS = 1e-6
IN_SIZES = (M_W, M_W, M_W, M_W, N_GATE, Q_LORA, KV_LORA, A_ROPE)
N_IN = 4 * M_W + N_GATE + Q_LORA + KV_LORA + A_ROPE

kernel_name = 'hymba_mlstm_mla_hmoe_deepnorm_encoder'


def _split_points(sizes):
    pts, acc = [], 0
    for s in sizes[:-1]:
        acc += s
        pts.append(acc)
    return pts


def _layernorm(x):
    xf = x.astype(jnp.float32)
    mu = jnp.mean(xf, -1, keepdims=True)
    var = jnp.mean(jnp.square(xf - mu), -1, keepdims=True)
    return (xf - mu) * lax.rsqrt(var + LN_EPS)


def _post_ln(z, g, b):
    return (_layernorm(z) * g.astype(jnp.float32) + b.astype(jnp.float32)).astype(z.dtype)


def _rmsnorm(x, g):
    xf = x.astype(jnp.float32)
    y = xf * lax.rsqrt(jnp.mean(jnp.square(xf), -1, keepdims=True) + RMS_EPS)
    return (y * g.astype(jnp.float32)).astype(x.dtype)


def _rope_tables(positions):
    half = A_ROPE // 2
    inv = ROPE_BASE ** (-jnp.arange(half, dtype=jnp.float32) / half)
    ang = positions.astype(jnp.float32)[..., None] * inv
    return jnp.cos(ang), jnp.sin(ang)


def _rope(x, cos, sin):
    xf = x.astype(jnp.float32)
    x1, x2 = jnp.split(xf, 2, axis=-1)
    return jnp.concatenate([x1 * cos - x2 * sin, x2 * cos + x1 * sin], -1).astype(x.dtype)


def _mlstm_scan(q, k, v, i_pre, f_pre):
    B, H, S, dk = q.shape
    dv = v.shape[-1]
    L = M_CHUNK
    nc = S // L
    f32 = jnp.float32

    def chunks(t):
        return jnp.moveaxis(t.reshape((B, H, nc, L) + t.shape[3:]), 2, 0)

    qc, kc, vc = chunks(q.astype(f32)), chunks(k.astype(f32)), chunks(v.astype(f32))
    ic = chunks(i_pre.astype(f32))
    lfc = chunks(jax.nn.log_sigmoid(f_pre.astype(f32)))
    past_mask = jnp.tril(jnp.ones((L, L), dtype=bool))

    def step(carry, inp):
        c_mat, n_vec, m_prev = carry
        qb, kb, vb, ib, lfb = inp
        b = jnp.cumsum(lfb, axis=-1)
        d_log = b[..., :, None] - b[..., None, :] + ib[..., None, :]
        d_log = jnp.where(past_mask, d_log, -jnp.inf)
        inter = b + m_prev[..., None]
        m_t = jnp.maximum(inter, jnp.max(d_log, -1))
        w = jnp.exp(d_log - m_t[..., None])
        s = jnp.einsum('bhtd,bhsd->bhts', qb, kb) * w
        a = jnp.exp(inter - m_t)
        num = a[..., None] * jnp.einsum('bhtd,bhde->bhte', qb, c_mat) + jnp.einsum('bhts,bhse->bhte', s, vb)
        den = a * jnp.einsum('bhtd,bhd->bht', qb, n_vec) + jnp.sum(s, -1)
        h = num / jnp.maximum(jnp.abs(den), jnp.exp(-m_t))[..., None]
        b_end = b[..., -1]
        g = b_end[..., None] - b + ib
        m_new = jnp.maximum(b_end + m_prev, jnp.max(g, -1))
        wg = jnp.exp(g - m_new[..., None])
        decay = jnp.exp(b_end + m_prev - m_new)
        kw = kb * wg[..., None]
        c_new = decay[..., None, None] * c_mat + jnp.einsum('bhsd,bhse->bhde', kw, vb)
        n_new = decay[..., None] * n_vec + jnp.sum(kw, axis=2)
        return (c_new, n_new, m_new), h

    init = (jnp.zeros((B, H, dk, dv), f32), jnp.zeros((B, H, dk), f32), jnp.zeros((B, H), f32))
    _, h = lax.scan(step, init, (qc, kc, vc, ic, lfc))
    return jnp.moveaxis(h, 0, 2).reshape(B, H, S, dv)


def _block_attention(q_nope, q_rope, k_nope, k_rope, v):
    B, S, H, _ = q_nope.shape
    dv = v.shape[-1]
    nb = S // Q_BLOCK
    scale = (A_NOPE + A_ROPE) ** -0.5

    def to_blocks(t):
        return jnp.swapaxes(t.reshape((B, nb, Q_BLOCK) + t.shape[2:]), 0, 1)

    def attend(blk):
        qn, qr = blk
        s = jnp.einsum('bqhd,bkhd->bhqk', qn, k_nope) + jnp.einsum('bqhr,bkr->bhqk', qr, k_rope)
        p = jax.nn.softmax(s.astype(jnp.float32) * scale, axis=-1)
        return jnp.einsum('bhqk,bkhd->bqhd', p.astype(v.dtype), v)

    out = lax.map(attend, (to_blocks(q_nope), to_blocks(q_rope)))
    return jnp.swapaxes(out, 0, 1).reshape(B, S, H * dv)


def _mixer(u, cos, sin, w_in, conv_w, conv_b, gate_b, mh_norm_g, q_norm_g, kv_norm_g,
           w_uq, w_ukv, attn_norm_g, w_out):
    B, S, _ = u.shape
    dt = u.dtype
    proj = u @ w_in
    qm, km, vm, om, gates, cq, ckv, kr = jnp.split(proj, _split_points(IN_SIZES), axis=-1)

    qk = jnp.concatenate([qm, km], -1)
    qk = lax.conv_general_dilated(qk, conv_w[:, None, :], window_strides=(1,),
                                  padding=[(CONV_K // 2, CONV_K // 2)],
                                  dimension_numbers=('NWC', 'WIO', 'NWC'),
                                  feature_group_count=2 * M_W) + conv_b
    qm, km = jnp.split(jax.nn.silu(qk), 2, axis=-1)

    def heads(t):
        return t.reshape(B, S, M_HEADS, M_HEAD_DIM).transpose(0, 2, 1, 3)

    q = heads(qm) * (M_HEAD_DIM ** -0.5)
    k = heads(km)
    v = heads(vm)
    g = gates.astype(jnp.float32).reshape(B, S, 4, M_HEADS) + gate_b.astype(jnp.float32)
    i_fw, f_fw, i_bw, f_bw = g.transpose(2, 0, 3, 1)
    h_fw = _mlstm_scan(q, k, v, i_fw, f_fw)
    flip = lambda t: jnp.flip(t, axis=2)
    h_bw = flip(_mlstm_scan(flip(q), flip(k), flip(v), flip(i_bw), flip(f_bw)))
    h = (h_fw + h_bw).transpose(0, 2, 1, 3)
    mu = jnp.mean(h, -1, keepdims=True)
    var = jnp.mean(jnp.square(h - mu), -1, keepdims=True)
    h = (h - mu) * lax.rsqrt(var + LN_EPS) * mh_norm_g.astype(jnp.float32).reshape(M_HEADS, M_HEAD_DIM)
    h_m = (jax.nn.sigmoid(om.astype(jnp.float32)) * h.reshape(B, S, M_W)).astype(dt)

    cq = _rmsnorm(cq, q_norm_g)
    qa = (cq @ w_uq).reshape(B, S, A_HEADS, A_NOPE + A_ROPE)
    q_nope, q_rope = qa[..., :A_NOPE], qa[..., A_NOPE:]
    q_rope = _rope(q_rope, cos[:, :, None, :], sin[:, :, None, :])
    ckv = _rmsnorm(ckv, kv_norm_g)
    kv = (ckv @ w_ukv).reshape(B, S, A_HEADS, A_NOPE + A_V_DIM)
    k_nope, v_a = kv[..., :A_NOPE], kv[..., A_NOPE:]
    k_rope = _rope(kr, cos, sin)
    o_a = _block_attention(q_nope, q_rope, k_nope, k_rope, v_a)
    h_a = _rmsnorm(o_a, attn_norm_g)

    return jnp.concatenate([h_m, h_a], -1) @ w_out


def _hier_moe(u, w_rg, b_rg, w_re, b_re, w_gate, w_up, w_down):
    B, S, D = u.shape
    dt = u.dtype
    T = B * S
    A = T * TOP_K
    f32 = jnp.float32
    xt = u.reshape(T, D)
    g_logits = (xt @ w_rg).astype(f32) + b_rg.astype(f32)
    g_prob = jax.nn.softmax(g_logits, -1)
    _, g_idx = lax.top_k(g_logits, 1)
    g_w = jnp.take_along_axis(g_prob, g_idx, axis=1)
    e_logits = ((xt @ w_re).astype(f32) + b_re.astype(f32)).reshape(T, N_GROUPS, EXP_PER_GROUP)
    e_in = jnp.take_along_axis(e_logits, g_idx[:, :, None], axis=1)[:, 0]
    top_v, top_i = lax.top_k(e_in, TOP_K)
    w_pair = jax.nn.softmax(top_v, -1) * g_w
    eid = (g_idx * EXP_PER_GROUP + top_i).reshape(A)
    tok = jnp.repeat(jnp.arange(T, dtype=jnp.int32), TOP_K)
    wts = w_pair.reshape(A)
    order = jnp.argsort(eid)
    se, stok, sw = eid[order], tok[order], wts[order]
    counts = jnp.bincount(eid, length=N_EXPERTS)
    starts = jnp.cumsum(counts) - counts
    pcounts = (counts + MOE_BLOCK - 1) // MOE_BLOCK * MOE_BLOCK
    pends = jnp.cumsum(pcounts)
    pstarts = pends - pcounts
    dest = pstarts[se] + (jnp.arange(A) - starts[se])
    n_slots = A + N_EXPERTS * MOE_BLOCK
    n_blocks = n_slots // MOE_BLOCK
    slot_tok = jnp.full((n_slots,), T, jnp.int32).at[dest].set(stok)
    slot_w = jnp.zeros((n_slots,), f32).at[dest].set(sw)
    x_pad = jnp.concatenate([xt, jnp.zeros((1, D), dt)], 0)
    xbuf = x_pad[slot_tok].reshape(n_blocks, MOE_BLOCK, D)
    block_e = jnp.minimum(jnp.searchsorted(pends, jnp.arange(n_blocks) * MOE_BLOCK, side='right'),
                          N_EXPERTS - 1)

    def run_block(args):
        xb, e = args
        hdn = jax.nn.silu(xb @ w_gate[e]) * (xb @ w_up[e])
        return hdn @ w_down[e]

    out = lax.map(run_block, (xbuf, block_e)).reshape(n_slots, D)
    y = jnp.zeros((T + 1, D), dt).at[slot_tok].add(out * slot_w[:, None].astype(dt))[:T]
    return y.reshape(B, S, D)


def setup_inputs(seed: int = 0) -> dict:
    key = jax.random.key(seed)
    ks = iter(jax.random.split(key, 48))
    f32 = jnp.float32
    L, D = DEPTH, D_MODEL
    beta = (8.0 * DEPTH) ** -0.25

    def nrm(shape, scale):
        return scale * jax.random.normal(next(ks), shape, f32)

    x = nrm((BATCH, SEQ, D), 1.0)
    c = nrm((BATCH, D), 1.0)
    positions = (jnp.arange(SEQ, dtype=jnp.int32)[None, :]
                 + jax.random.randint(next(ks), (BATCH, 1), 0, POS_OFFSET_MAX, dtype=jnp.int32))
    fb = jnp.linspace(3.0, 6.0, M_HEADS, dtype=f32)
    zb = jnp.zeros((M_HEADS,), f32)
    gate_base = jnp.stack([zb, fb, zb, fb])
    return {
        'x': x,
        'c': c,
        'positions': positions,
        'w_ada': nrm((L, D, 6 * D), 0.5 * D ** -0.5),
        'b_ada': nrm((L, 6 * D), 0.02),
        'w_in': nrm((L, D, N_IN), D ** -0.5),
        'conv_w': nrm((L, CONV_K, 2 * M_W), CONV_K ** -0.5),
        'conv_b': nrm((L, 2 * M_W), 0.02),
        'gate_b': gate_base[None] + nrm((L, 4, M_HEADS), 0.1),
        'mh_norm_g': 1.0 + nrm((L, M_W), 0.02),
        'q_norm_g': 1.0 + nrm((L, Q_LORA), 0.02),
        'kv_norm_g': 1.0 + nrm((L, KV_LORA), 0.02),
        'w_uq': nrm((L, Q_LORA, A_HEADS * (A_NOPE + A_ROPE)), Q_LORA ** -0.5),
        'w_ukv': nrm((L, KV_LORA, A_HEADS * (A_NOPE + A_V_DIM)), KV_LORA ** -0.5),
        'attn_norm_g': 1.0 + nrm((L, A_W), 0.02),
        'w_out': nrm((L, MIX_W, D), beta * MIX_W ** -0.5),
        'ln1_g': 1.0 + nrm((L, D), 0.02),
        'ln1_b': nrm((L, D), 0.02),
        'w_rg': nrm((L, D, N_GROUPS), D ** -0.5),
        'b_rg': nrm((L, N_GROUPS), 0.01),
        'w_re': nrm((L, D, N_EXPERTS), D ** -0.5),
        'b_re': nrm((L, N_EXPERTS), 0.01),
        'w_gate': nrm((L, N_EXPERTS, D, D_EXPERT), D ** -0.5),
        'w_up': nrm((L, N_EXPERTS, D, D_EXPERT), D ** -0.5),
        'w_down': nrm((L, N_EXPERTS, D_EXPERT, D), beta * D_EXPERT ** -0.5),
        'ln2_g': 1.0 + nrm((L, D), 0.02),
        'ln2_b': nrm((L, D), 0.02),
    }


def reference(x, c, positions, w_ada, b_ada, w_in, conv_w, conv_b, gate_b, mh_norm_g,
              q_norm_g, kv_norm_g, w_uq, w_ukv, attn_norm_g, w_out, ln1_g, ln1_b,
              w_rg, b_rg, w_re, b_re, w_gate, w_up, w_down, ln2_g, ln2_b):
    dt = x.dtype
    alpha = (2.0 * DEPTH) ** 0.25
    cos, sin = _rope_tables(positions)
    c_act = jax.nn.silu(c)
    for l in range(DEPTH):
        mod = c_act @ w_ada[l] + b_ada[l]
        sh1, sc1, g1, sh2, sc2, g2 = jnp.split(mod, 6, axis=-1)
        u = (_layernorm(x) * (1.0 + sc1[:, None, :]) + sh1[:, None, :]).astype(dt)
        y = _mixer(u, cos, sin, w_in[l], conv_w[l], conv_b[l], gate_b[l], mh_norm_g[l],
                   q_norm_g[l], kv_norm_g[l], w_uq[l], w_ukv[l], attn_norm_g[l], w_out[l])
        x = _post_ln(alpha * x + (1.0 + g1[:, None, :]) * y, ln1_g[l], ln1_b[l])
        u = (_layernorm(x) * (1.0 + sc2[:, None, :]) + sh2[:, None, :]).astype(dt)
        y = _hier_moe(u, w_rg[l], b_rg[l], w_re[l], b_re[l], w_gate[l], w_up[l], w_down[l])
        x = _post_ln(alpha * x + (1.0 + g2[:, None, :]) * y, ln2_g[l], ln2_b[l])
    return x
```

```cpp
#define NKERN 99
#ifndef MEGA_STOP
#define MEGA_STOP 0
#endif
#ifndef DBL_PHASE
#define DBL_PHASE -1
#endif
#include <hip/hip_runtime.h>
#include <cstdio>
#include <cstdint>
#include <cmath>

#define DI __device__ __forceinline__
#define LAS __attribute__((address_space(3)))
typedef unsigned short bf16_t;
typedef short bf16x8 __attribute__((ext_vector_type(8)));
typedef short s16x4 __attribute__((ext_vector_type(4)));
typedef float f32x4 __attribute__((ext_vector_type(4)));
typedef float f32x2 __attribute__((ext_vector_type(2)));
typedef float f32x16 __attribute__((ext_vector_type(16)));
typedef unsigned u32x4 __attribute__((ext_vector_type(4)));
typedef unsigned u32x2 __attribute__((ext_vector_type(2)));

constexpr int BATCH = 2, SEQ = 16384, T = BATCH * SEQ, D = 1024;
constexpr int NCH = SEQ / 128;
constexpr int N_IN = 2768, N_INP = 2816;
constexpr int NEXP = 32;
constexpr float LN_EPS = 1e-5f, RMS_EPS = 1e-6f;
constexpr float ALPHA = 1.189207115002721f;
constexpr float LOG2E = 1.4426950408889634f;
constexpr float QSCALE = 0.07216878364870323f * LOG2E * 16.f;
constexpr int NTHREADS = 512;
constexpr int LDS_BYTES = 148 * 1024;

constexpr size_t MiB = 1u << 20;
constexpr size_t WS_WIN = 0, WS_WUQ = 6 * MiB, WS_WUKV = 7 * MiB, WS_WOUT = 8 * MiB, WS_WGU = 10 * MiB, WS_WDN = 74 * MiB;
constexpr size_t WS_MOD = 106 * MiB, WS_CNT = 106 * MiB + 65536, WS_ROPE = 107 * MiB, WS_GATES = 115 * MiB, WS_GVEC = 117 * MiB;
constexpr size_t WS_SSQQ = 120 * MiB, WS_SSQKV = 122 * MiB, WS_NVEC = 123 * MiB, WS_SCAL = 124 * MiB, WS_TOKE = 125 * MiB, WS_TOKP = 125 * MiB + 512 * 1024;
constexpr size_t WS_U = 128 * MiB, WS_H = 192 * MiB, WS_QKPRE = 256 * MiB, WS_VM = 320 * MiB, WS_CQ = 352 * MiB, WS_CKV = 376 * MiB;
constexpr size_t WS_KROPE = 392 * MiB, WS_QATT = 396 * MiB, WS_KN = 444 * MiB, WS_VA = 476 * MiB, WS_END = 512 * MiB;
constexpr size_t WS_BAR = 106 * MiB + 131072, CTL_ZERO_OFF = WS_CNT, CTL_ZERO_BYTES = 131072;
constexpr int LDS_BARST = LDS_BYTES - 256;
constexpr size_t WS_LTOK = 256 * MiB, WS_LW = 260 * MiB, WS_HDN = 264 * MiB, WS_YBUF = 336 * MiB;
constexpr int MAXTILES = 288;
constexpr int CNT_STRIDE = 64;
constexpr size_t WS_WRT = 126 * MiB;

struct Params {
  const float* x; const float* c; const int* pos; const float* w_ada; const float* b_ada; const float* w_in; const float* conv_w; const float* conv_b;
  const float* gate_b; const float* mh_g; const float* qn_g; const float* kvn_g; const float* w_uq; const float* w_ukv; const float* an_g; const float* w_out;
  const float* ln1_g; const float* ln1_b; const float* w_rg; const float* b_rg; const float* w_re; const float* b_re; const float* w_gate; const float* w_up;
  const float* w_down; const float* ln2_g; const float* ln2_b;
  float* out; unsigned char* ws;
};

enum { A_X = 0, A_C, A_POS, A_WADA, A_BADA, A_WIN, A_CONVW, A_CONVB, A_GATEB, A_MHG, A_QNG, A_KVNG, A_WUQ, A_WUKV, A_ANG, A_WOUT, A_LN1G, A_LN1B, A_WRG, A_BRG, A_WRE, A_BRE,
       A_WGATE, A_WUP, A_WDOWN, A_LN2G, A_LN2B, A_OUT, A_WS };
template <int IDX, class Tp = const float> __device__ __forceinline__ Tp* karg() {
  const unsigned long long k = (unsigned long long)__builtin_amdgcn_kernarg_segment_ptr();
  unsigned long long v;
  asm volatile("s_load_dwordx2 %0, %1, %2\n\ts_waitcnt lgkmcnt(0)" : "=s"(v) : "s"(k), "i"(IDX * 8) : "memory");
  return (Tp*)v;
}
struct Ctx { unsigned char* ws; float* out; };
DI unsigned cvtpk(float lo, float hi) { unsigned r; asm volatile("v_cvt_pk_bf16_f32 %0, %1, %2" : "=v"(r) : "v"(lo), "v"(hi)); return r; }
DI unsigned short f2bf(float f) { unsigned u = __float_as_uint(f); return (unsigned short)((u + 0x7fffu + ((u >> 16) & 1u)) >> 16); }
typedef int v8i __attribute__((ext_vector_type(8)));
DI u32x2 cvt8(f32x4 a, f32x4 b) {
  int w0 = __builtin_amdgcn_cvt_pk_fp8_f32(a[0], a[1], 0, false); w0 = __builtin_amdgcn_cvt_pk_fp8_f32(a[2], a[3], w0, true);
  int w1 = __builtin_amdgcn_cvt_pk_fp8_f32(b[0], b[1], 0, false); w1 = __builtin_amdgcn_cvt_pk_fp8_f32(b[2], b[3], w1, true);
  return (u32x2){(unsigned)w0, (unsigned)w1};
}
DI float bf2f(unsigned short v) { return __uint_as_float(((unsigned)v) << 16); }
DI float bflo(unsigned w) { return __uint_as_float(w << 16); }
DI float bfhi(unsigned w) { return __uint_as_float(w & 0xffff0000u); }
DI int tid_fresh() { int t = threadIdx.x; asm volatile("" : "+v"(t)); return t; }
DI float wave_sum(float v) {
#pragma unroll
  for (int o = 1; o < 64; o <<= 1) v += __shfl_xor(v, o);
  return v;
}
DI float sigmoidf_(float x) { return 1.f / (1.f + __expf(-x)); }
DI float siluf_(float x) { return x / (1.f + __expf(-x)); }
DI float logsigmoidf_(float x) { return fminf(x, 0.f) - log1pf(__expf(-fabsf(x))); }
DI int crow(int r, int hi) { return (r & 3) + 8 * (r >> 2) + 4 * hi; }
#define SBAR() __builtin_amdgcn_sched_barrier(0)
#define KSWZ(row, colB) ((row) * 256 + ((colB) ^ (((row) & 15) << 4)))
#define KRSWZ(row, colB) ((row) * 128 + ((colB) ^ ((((row) >> 1) & 7) << 4)))
#define MFMA32(a, b, c) __builtin_amdgcn_mfma_f32_32x32x16_bf16((a), (b), (c), 0, 0, 0)

DI int v_st(int k, int c) { const int kk = (k & ~0xC) | ((k & 4) << 1) | ((k & 8) >> 1); return ((kk >> 3) * 4 + (c >> 5)) * 512 + ((kk & 7) * 32 + (c & 31)) * 2; }
DI int v_rd_base(int lane) { return ((lane & 3) << 3) | (((lane >> 2) & 3) << 6) | (((lane >> 4) & 1) << 5) | (((lane >> 5) & 1) << 8); }
constexpr int v_rd_off(int d0, int ks, int half) { return d0 * 512 + ks * 4096 + half * 2048; }
template <int OFF> DI s16x4 tr_read(int vb) {
  s16x4 r; asm volatile("ds_read_b64_tr_b16 %0, %1 offset:%2" : "=&v"(r) : "v"(vb), "i"(OFF) : "memory"); return r;
}
#define PKLH(L, H) (bf16x8){L[0], L[1], L[2], L[3], H[0], H[1], H[2], H[3]}
template <int KS> DI bf16x8 tr_frag_nowait(int vb, s16x4& l, s16x4& h) { l = tr_read<v_rd_off(0, KS, 0)>(vb); h = tr_read<v_rd_off(0, KS, 1)>(vb); return PKLH(l, h); }
template <int D0> DI void pv_one(f32x16& od, int vb, bf16x8 pa0, bf16x8 pa1, bf16x8 pa2, bf16x8 pa3) {
  const s16x4 l0 = tr_read<v_rd_off(D0, 0, 0)>(vb), h0 = tr_read<v_rd_off(D0, 0, 1)>(vb), l1 = tr_read<v_rd_off(D0, 1, 0)>(vb), h1 = tr_read<v_rd_off(D0, 1, 1)>(vb);
  const s16x4 l2 = tr_read<v_rd_off(D0, 2, 0)>(vb), h2 = tr_read<v_rd_off(D0, 2, 1)>(vb), l3 = tr_read<v_rd_off(D0, 3, 0)>(vb), h3 = tr_read<v_rd_off(D0, 3, 1)>(vb);
  asm volatile("s_waitcnt lgkmcnt(0)" ::: "memory"); SBAR();
  od = MFMA32(pa0, PKLH(l0, h0), od); od = MFMA32(pa1, PKLH(l1, h1), od); od = MFMA32(pa2, PKLH(l2, h2), od); od = MFMA32(pa3, PKLH(l3, h3), od);
}
DI void pv_d0(f32x16* o, int vb, bf16x8 pa0, bf16x8 pa1, bf16x8 pa2, bf16x8 pa3) {
  pv_one<0>(o[0], vb, pa0, pa1, pa2, pa3); pv_one<1>(o[1], vb, pa0, pa1, pa2, pa3); pv_one<2>(o[2], vb, pa0, pa1, pa2, pa3); pv_one<3>(o[3], vb, pa0, pa1, pa2, pa3);
}
DI void pack_p(const f32x16& p0, const f32x16& p1, bf16x8& pa0, bf16x8& pa1, bf16x8& pa2, bf16x8& pa3) {
#define PK4(P, BASE, OUT) do { unsigned a0 = cvtpk(P[BASE + 0], P[BASE + 1]), a1 = cvtpk(P[BASE + 2], P[BASE + 3]);   \
    unsigned b0 = cvtpk(P[BASE + 4], P[BASE + 5]), b1 = cvtpk(P[BASE + 6], P[BASE + 7]);                              \
    auto r0 = __builtin_amdgcn_permlane32_swap(a0, b0, false, false); auto r1 = __builtin_amdgcn_permlane32_swap(a1, b1, false, false); \
    u32x4 w = {r0[0], r1[0], r0[1], r1[1]}; OUT = *reinterpret_cast<bf16x8*>(&w); } while (0)
  PK4(p0, 0, pa0); PK4(p0, 8, pa1); PK4(p1, 0, pa2); PK4(p1, 8, pa3);
#undef PK4
}
DI float half_swap_sum(float v) { auto rr = __builtin_amdgcn_permlane32_swap(__float_as_uint(v), __float_as_uint(v), false, false); return __uint_as_float(rr[0]) + __uint_as_float(rr[1]); }
DI float half_swap_max(float v) { auto rr = __builtin_amdgcn_permlane32_swap(__float_as_uint(v), __float_as_uint(v), false, false); return fmaxf(__uint_as_float(rr[0]), __uint_as_float(rr[1])); }

namespace g8 {
constexpr int BM = 256, BK = 64, HALF = 128, HTB = HALF * BK * 2, STAGE_BYTES = 8 * HTB;
DI int lds_byte(int r, int c) { const int st = (r >> 4) * 2 + (c >> 5), rr = r & 15, cc = c & 31, ob = rr * 64 + cc * 2; return st * 1024 + (ob ^ (((ob >> 9) & 1) << 5)); }
DI void stage_rc(int b, int& R, int& C) { const int st = b / 1024, sb = b % 1024, swz = sb ^ (((sb >> 9) & 1) << 5); R = (st >> 1) * 16 + swz / 64; C = (st & 1) * 32 + (swz % 64) / 2; }
DI int perm32(int rho) { const int n = rho >> 4, i = rho & 15; return 8 * (i >> 2) + 4 * n + (i & 3); }
struct Unit { int pm, pn, e, j; };

template <class Epi, class Sched>
DI void gemm_phase(LAS unsigned char* lds, const char* Abase, const int Kc, const Sched& S, const Epi& E) {
  constexpr bool GATHER = Sched::GATHER;
  int K = Kc; asm volatile("" : "+s"(K));
  const int tid = tid_fresh(), wid = __builtin_amdgcn_readfirstlane(tid >> 6), lane = tid & 63, wr = wid >> 2, wc = wid & 3, fr = lane & 15, fq = lane >> 4;
  const int nt = K / BK;
  unsigned voffA[2], voffB[2];
#pragma unroll
  for (int i = 0; i < 2; ++i) { int R, C; stage_rc(tid * 16 + i * 8192, R, C); const int Rb = Epi::PERM ? ((R & ~31) + perm32(R & 31)) : R; voffA[i] = (unsigned)(R * K + C) * 2u; voffB[i] = (unsigned)(Rb * K + C) * 2u; }
  const size_t kstep = (size_t)(BK * 2);
  const size_t hstepB = (size_t)HALF * K * 2;
  const unsigned ldsw = (unsigned)wid * 1024u;
  const int aoff = lds_byte(wr * 64 + fr, fq * 8), boff = lds_byte(wc * 32 + fr, fq * 8);
#define G8_SA(b, h) (((b) * 2 + (h)) * HTB)
#define G8_SB(b, h) ((4 + (b) * 2 + (h)) * HTB)
#define G8_STAGEB(bufoff, gptr) do { _Pragma("unroll") for (int _i = 0; _i < 2; ++_i) \
    __builtin_amdgcn_global_load_lds((const unsigned*)((const char*)(gptr) + voffB[_i]), (LAS unsigned*)(lds + (bufoff) + ldsw + _i * 8192), 16, 0, 0); } while (0)
#define G8_STAGEA(bufoff, kb, NXT, h) do { _Pragma("unroll") for (int _i = 0; _i < 2; ++_i) { const char* _src; \
    if constexpr (GATHER) _src = Abase + (size_t)(kb) + (size_t)((NXT) ? o2[h][_i] : cuA[h][_i]); else _src = ((NXT) ? a2b : cA) + (size_t)(kb) + (size_t)(h) * hstepB + voffA[_i]; \
    __builtin_amdgcn_global_load_lds((const unsigned*)_src, (LAS unsigned*)(lds + (bufoff) + ldsw + _i * 8192), 16, 0, 0); } } while (0)
#define G8_LDA(dst, b, h) do { _Pragma("unroll") for (int m = 0; m < 4; ++m) _Pragma("unroll") for (int k = 0; k < 2; ++k) dst[m][k] = *(const LAS bf16x8*)(lds + G8_SA(b, h) + aoff + m * 2048 + k * 1024); } while (0)
#define G8_LDB(dst, b, h) do { _Pragma("unroll") for (int n = 0; n < 2; ++n) _Pragma("unroll") for (int k = 0; k < 2; ++k) dst[n][k] = *(const LAS bf16x8*)(lds + G8_SB(b, h) + boff + n * 2048 + k * 1024); } while (0)
#define G8_MMA(ai, bj, At, Bt) do { __builtin_amdgcn_s_setprio(1); _Pragma("unroll") for (int m = 0; m < 4; ++m) _Pragma("unroll") for (int n = 0; n < 2; ++n) _Pragma("unroll") for (int k = 0; k < 2; ++k) \
    acc[ai][bj][m][n] = __builtin_amdgcn_mfma_f32_16x16x32_bf16(Bt[n][k], At[m][k], acc[ai][bj][m][n], 0, 0, 0); __builtin_amdgcn_s_setprio(0); } while (0)
#define G8_WAIT_V(n) asm volatile("s_waitcnt vmcnt(" #n ")" ::: "memory")
#define G8_WAIT_L(n) asm volatile("s_waitcnt lgkmcnt(" #n ")" ::: "memory")
#define G8_BAR __builtin_amdgcn_s_barrier()
#define G8_SCHED __builtin_amdgcn_sched_barrier(0)
#define G8_GOFF(dst, u) do { _Pragma("unroll") for (int _i = 0; _i < 2; ++_i) { int _R, _C; stage_rc(tid * 16 + _i * 8192, _R, _C); \
    _Pragma("unroll") for (int _h = 0; _h < 2; ++_h) dst[_h][_i] = S.a_off(u, _R + 128 * _h) + (unsigned)_C * 2u; } } while (0)
  Unit cur, nxt; int ui = 0;
  if (!S.next(0, cur)) return;
  f32x4 acc[2][2][4][2];
#pragma unroll
  for (int a = 0; a < 2; ++a)
#pragma unroll
    for (int b = 0; b < 2; ++b)
#pragma unroll
      for (int m = 0; m < 4; ++m)
#pragma unroll
        for (int n = 0; n < 2; ++n) acc[a][b][m][n] = (f32x4){0.f, 0.f, 0.f, 0.f};
  bf16x8 At[4][2], B0[2][2], B1[2][2];
  unsigned cuA[2][2], nxA[2][2], o2[2][2];
  const char* cA = Abase; const char* nA = Abase; const char* a2b = Abase;
  if constexpr (GATHER) { G8_GOFF(cuA, cur); } else { cA = Abase + S.a_off(cur, 0); }
  const char* cB = S.b_base(cur);
  (void)voffA; (void)nxA; (void)o2; (void)nA; (void)a2b;
  G8_STAGEB(G8_SB(0, 0), cB); G8_STAGEB(G8_SB(0, 1), cB + hstepB); G8_STAGEA(G8_SA(0, 0), 0, false, 0); G8_STAGEA(G8_SA(0, 1), 0, false, 1);
  if (wr == 1) G8_BAR;
  G8_WAIT_V(2); G8_BAR;
  G8_STAGEB(G8_SB(1, 0), cB + kstep); G8_STAGEA(G8_SA(1, 0), kstep, false, 0); G8_STAGEB(G8_SB(1, 1), cB + hstepB + kstep);
  G8_WAIT_V(6); G8_BAR;
  for (;;) {
    const bool has_next = S.next(ui + 1, nxt);
    const char* nB = cB;
    if (has_next) {
      nB = S.b_base(nxt);
      if constexpr (GATHER) { G8_GOFF(nxA, nxt); } else { nA = Abase + S.a_off(nxt, 0); }
    } else {
      if constexpr (GATHER) {
#pragma unroll
        for (int h = 0; h < 2; ++h)
#pragma unroll
          for (int i = 0; i < 2; ++i) nxA[h][i] = cuA[h][i];
      } else nA = cA;
    }
    for (int t = 0; t < nt; t += 2) {
      const bool last = (t == nt - 2);
      const size_t k1 = (size_t)(t + 1) * kstep;
      const size_t k2 = last ? 0 : (size_t)(t + 2) * kstep, k3 = k2 + kstep;
      if constexpr (GATHER) {
#pragma unroll
        for (int h = 0; h < 2; ++h)
#pragma unroll
          for (int i = 0; i < 2; ++i) o2[h][i] = last ? nxA[h][i] : cuA[h][i];
      } else a2b = last ? nA : cA;
      const char* b2 = last ? nB : cB + (size_t)(t + 2) * kstep; const char* b3 = b2 + kstep;
      G8_LDB(B0, 0, 0); G8_LDB(B1, 0, 1); G8_SCHED; G8_LDA(At, 0, 0); G8_STAGEA(G8_SA(1, 1), k1, false, 1);
      G8_WAIT_V(8); G8_WAIT_L(0); G8_BAR; G8_MMA(0, 0, At, B0); G8_MMA(0, 1, At, B1); G8_BAR; G8_SCHED;
      G8_LDA(At, 0, 1); G8_STAGEB(G8_SB(0, 0), b2); G8_STAGEB(G8_SB(0, 1), b2 + hstepB); G8_STAGEA(G8_SA(0, 0), k2, true, 0);
      G8_WAIT_V(8); G8_WAIT_L(0); G8_BAR; G8_MMA(1, 0, At, B0); G8_MMA(1, 1, At, B1); G8_BAR; G8_SCHED;
      G8_LDB(B0, 1, 0); G8_LDB(B1, 1, 1); G8_SCHED; G8_LDA(At, 1, 0); G8_STAGEA(G8_SA(0, 1), k2, true, 1);
      G8_WAIT_V(8); G8_WAIT_L(0); G8_BAR; G8_MMA(0, 0, At, B0); G8_MMA(0, 1, At, B1); G8_BAR; G8_SCHED;
      G8_LDA(At, 1, 1); G8_STAGEB(G8_SB(1, 0), b3); G8_STAGEB(G8_SB(1, 1), b3 + hstepB); G8_STAGEA(G8_SA(1, 0), k3, true, 0);
      G8_WAIT_V(8); G8_WAIT_L(0); G8_BAR; G8_MMA(1, 0, At, B0); G8_MMA(1, 1, At, B1); G8_BAR; G8_SCHED;
    }
    if (wr == 0) G8_BAR;
    G8_SCHED; asm volatile("s_nop 15\n\ts_nop 7" ::: "memory"); G8_SCHED;
    E(acc, cur, wr, wc, fr, fq);
    if (!has_next) break;
#pragma unroll
    for (int a = 0; a < 2; ++a)
#pragma unroll
      for (int b = 0; b < 2; ++b)
#pragma unroll
        for (int m = 0; m < 4; ++m)
#pragma unroll
          for (int n = 0; n < 2; ++n) acc[a][b][m][n] = (f32x4){0.f, 0.f, 0.f, 0.f};
    cur = nxt; cB = nB; ++ui;
    if constexpr (GATHER) {
#pragma unroll
      for (int h = 0; h < 2; ++h)
#pragma unroll
        for (int i = 0; i < 2; ++i) cuA[h][i] = nxA[h][i];
    } else cA = nA;
    if (wr == 1) G8_BAR;
  }
  G8_WAIT_V(0);
  G8_BAR;
#undef G8_SA
#undef G8_SB
#undef G8_STAGEA
#undef G8_STAGEB
#undef G8_LDA
#undef G8_LDB
#undef G8_MMA
#undef G8_WAIT_V
#undef G8_WAIT_L
#undef G8_BAR
#undef G8_SCHED
#undef G8_GOFF
}

struct DenseOrder {
  static constexpr bool GATHER = false;
  int nM, nN, nwg, G, c, K; const char* Bt;
  DI void init(int M, int N, int K_, const void* Bt_, int G_, int c_) { nM = M / BM; nN = N / BM; nwg = nM * nN; G = G_; c = c_; K = K_; Bt = (const char*)Bt_; }
  DI bool next(int i, Unit& u) const {
    const long L = (long)i * G + c; if (L >= nwg) return false;
    int wgid = (int)L; { const int q = nwg / 8, r = nwg % 8, xcd = wgid % 8, off = wgid / 8; wgid = (xcd < r ? xcd * (q + 1) : r * (q + 1) + (xcd - r) * q) + off; }
    const int nig = 8 * nN, gid = wgid / nig, fm = gid * 8, gsz = (nM - fm) < 8 ? (nM - fm) : 8;
    u.pm = fm + ((wgid % nig) % gsz); u.pn = (wgid % nig) / gsz; u.e = 0; u.j = 0; return true;
  }
  DI unsigned a_off(const Unit& u, int R) const { return (unsigned)(u.pm * BM + R) * (unsigned)(K * 2); }
  DI const char* b_base(const Unit& u) const { return Bt + (size_t)u.pn * BM * K * 2; }
};
}
using g8::Unit;

struct EpiIn {
  static constexpr bool PERM = true;
  bf16_t* qkpre; bf16_t* vm; bf16_t* hcat; bf16_t* cq; bf16_t* ckv; unsigned char* krope  ; float* gates; float* ssq_q; float* ssq_kv; const float* rope; const float* gate_b;
  DI void operator()(const f32x4 (&acc)[2][2][4][2], const Unit& u, int wr, int wc, int fr, int fq) const {
#pragma unroll
    for (int bj = 0; bj < 2; ++bj) {
      const int cw = u.pn * 256 + bj * 128 + wc * 32, c0 = cw + 8 * fq;
#pragma unroll
      for (int ai = 0; ai < 2; ++ai)
#pragma unroll
        for (int m = 0; m < 4; ++m) {
          const int row = u.pm * 256 + ai * 128 + wr * 64 + m * 16 + fr;
          const f32x4 v0 = acc[ai][bj][m][0], v1 = acc[ai][bj][m][1];
          if (cw < 1024) { u32x4 w = {cvtpk(v0[0], v0[1]), cvtpk(v0[2], v0[3]), cvtpk(v1[0], v1[1]), cvtpk(v1[2], v1[3])}; *(u32x4*)(qkpre + (size_t)row * 1024 + c0) = w; }
          else if (cw < 1536) { u32x4 w = {cvtpk(v0[0], v0[1]), cvtpk(v0[2], v0[3]), cvtpk(v1[0], v1[1]), cvtpk(v1[2], v1[3])}; *(u32x4*)(vm + (size_t)row * 512 + (c0 - 1024)) = w; }
          else if (cw < 2048) { u32x4 w = {cvtpk(sigmoidf_(v0[0]), sigmoidf_(v0[1])), cvtpk(sigmoidf_(v0[2]), sigmoidf_(v0[3])), cvtpk(sigmoidf_(v1[0]), sigmoidf_(v1[1])), cvtpk(sigmoidf_(v1[2]), sigmoidf_(v1[3]))};
                                *(u32x4*)(hcat + (size_t)row * 1024 + (c0 - 1536)) = w; }
          else if (cw < 2688) {
            u32x4 w = {cvtpk(v0[0], v0[1]), cvtpk(v0[2], v0[3]), cvtpk(v1[0], v1[1]), cvtpk(v1[2], v1[3])};
            float s = v0[0] * v0[0] + v0[1] * v0[1] + v0[2] * v0[2] + v0[3] * v0[3] + v1[0] * v1[0] + v1[1] * v1[1] + v1[2] * v1[2] + v1[3] * v1[3];
            s += __shfl_xor(s, 16); s += __shfl_xor(s, 32);
            if (cw < 2432) { *(u32x4*)(cq + (size_t)row * 384 + (c0 - 2048)) = w; if (fq == 0) ssq_q[(size_t)row * 12 + ((cw - 2048) >> 5)] = s; }
            else { *(u32x4*)(ckv + (size_t)row * 256 + (c0 - 2432)) = w; if (fq == 0) ssq_kv[(size_t)row * 8 + ((cw - 2432) >> 5)] = s; }
          }
          else if (cw < 2752) {
            const int i0 = (c0 - 2688) >> 1;
            const f32x4 cs0 = *(const f32x4*)(rope + (size_t)row * 64 + 2 * i0), cs1 = *(const f32x4*)(rope + (size_t)row * 64 + 2 * i0 + 4);
            const float a0 = v0[0] * cs0[0] - v0[1] * cs0[1], b0 = v0[1] * cs0[0] + v0[0] * cs0[1];
            const float a1 = v0[2] * cs0[2] - v0[3] * cs0[3], b1 = v0[3] * cs0[2] + v0[2] * cs0[3];
            const float a2 = v1[0] * cs1[0] - v1[1] * cs1[1], b2 = v1[1] * cs1[0] + v1[0] * cs1[1];
            const float a3 = v1[2] * cs1[2] - v1[3] * cs1[3], b3 = v1[3] * cs1[2] + v1[2] * cs1[3];
            const u32x2 w = cvt8((f32x4){a0, b0, a1, b1}, (f32x4){a2, b2, a3, b3});
            const int b_ = row >> 14, s_ = row & (SEQ - 1);
#pragma unroll
            for (int hh = 0; hh < 4; ++hh) *(u32x2*)(krope + ((size_t)(b_ * 4 + hh) * SEQ + s_) * 192 + 128 + (c0 - 2688)) = w;
          }
          else if (cw == 2752) {
            if (fq < 2) { const f32x4 g0 = *(const f32x4*)(gate_b + 8 * fq), g1 = *(const f32x4*)(gate_b + 8 * fq + 4);
              *(f32x4*)(gates + (size_t)row * 16 + 8 * fq) = v0 + g0; *(f32x4*)(gates + (size_t)row * 16 + 8 * fq + 4) = v1 + g1; }
          }
        }
    }
  }
};
struct EpiUQ {
  static constexpr bool PERM = true;
  unsigned char* qatt; const float* ssq_q; const float* rope;
  DI void operator()(const f32x4 (&acc)[2][2][4][2], const Unit& u, int wr, int wc, int fr, int fq) const {
    float rs[2][4];
#pragma unroll
    for (int ai = 0; ai < 2; ++ai)
#pragma unroll
      for (int m = 0; m < 4; ++m) {
        const int row = u.pm * 256 + ai * 128 + wr * 64 + m * 16 + fr;
        const f32x4 q0 = *(const f32x4*)(ssq_q + (size_t)row * 12), q1 = *(const f32x4*)(ssq_q + (size_t)row * 12 + 4), q2 = *(const f32x4*)(ssq_q + (size_t)row * 12 + 8);
        const float ss = (q0[0] + q0[1] + q0[2] + q0[3]) + (q1[0] + q1[1] + q1[2] + q1[3]) + (q2[0] + q2[1] + q2[2] + q2[3]);
        rs[ai][m] = rsqrtf(ss * (1.f / 384.f) + RMS_EPS) * QSCALE;
        asm volatile("" ::: "memory");
      }
#pragma unroll
    for (int bj = 0; bj < 2; ++bj) {
      const int cw = u.pn * 256 + bj * 128 + wc * 32, h = cw / 192, dw = cw - h * 192, d = dw + 8 * fq;
#pragma unroll
      for (int ai = 0; ai < 2; ++ai)
#pragma unroll
        for (int m = 0; m < 4; ++m) {
          const int row = u.pm * 256 + ai * 128 + wr * 64 + m * 16 + fr, b = row >> 14, s = row & (SEQ - 1);
          const f32x4 v0 = acc[ai][bj][m][0] * rs[ai][m], v1 = acc[ai][bj][m][1] * rs[ai][m];
          u32x2 w;
          if (dw < 128) { w = cvt8(v0, v1); }
          else {
            const int i0 = (d - 128) >> 1;
            const f32x4 cs0 = *(const f32x4*)(rope + (size_t)row * 64 + 2 * i0), cs1 = *(const f32x4*)(rope + (size_t)row * 64 + 2 * i0 + 4);
            const float a0 = v0[0] * cs0[0] - v0[1] * cs0[1], b0 = v0[1] * cs0[0] + v0[0] * cs0[1];
            const float a1 = v0[2] * cs0[2] - v0[3] * cs0[3], b1 = v0[3] * cs0[2] + v0[2] * cs0[3];
            const float a2 = v1[0] * cs1[0] - v1[1] * cs1[1], b2 = v1[1] * cs1[0] + v1[0] * cs1[1];
            const float a3 = v1[2] * cs1[2] - v1[3] * cs1[3], b3 = v1[3] * cs1[2] + v1[2] * cs1[3];
            w = cvt8((f32x4){a0, b0, a1, b1}, (f32x4){a2, b2, a3, b3});
          }
          *(u32x2*)(qatt + ((size_t)(b * 4 + h) * SEQ + s) * 192 + d) = w;
          asm volatile("" ::: "memory");
        }
    }
  }
};
struct EpiUKV {
  static constexpr bool PERM = true;
  unsigned char* kn; unsigned char* vt8; const float* ssq_kv;
  DI void operator()(const f32x4 (&acc)[2][2][4][2], const Unit& u, int wr, int wc, int fr, int fq) const {
#pragma unroll
    for (int ai = 0; ai < 2; ++ai)
#pragma unroll
      for (int m = 0; m < 4; ++m) {
        const int row = u.pm * 256 + ai * 128 + wr * 64 + m * 16 + fr, b = row >> 14, s = row & (SEQ - 1);
        const f32x4 q0 = *(const f32x4*)(ssq_kv + (size_t)row * 8), q1 = *(const f32x4*)(ssq_kv + (size_t)row * 8 + 4);
        const float ss = (q0[0] + q0[1] + q0[2] + q0[3]) + (q1[0] + q1[1] + q1[2] + q1[3]);
        const float rs = rsqrtf(ss * (1.f / 256.f) + RMS_EPS);
        { const f32x4 v0 = acc[ai][0][m][0] * rs, v1 = acc[ai][0][m][1] * rs;
          *(u32x2*)(kn + ((size_t)(b * 4 + u.pn) * SEQ + s) * 192 + wc * 32 + 8 * fq) = cvt8(v0, v1); }
        { const f32x4 v0 = acc[ai][1][m][0] * rs, v1 = acc[ai][1][m][1] * rs;
          const u32x2 w = cvt8(v0, v1);
          const int k = s & 63, kq = k & 31, pos = 32 * ((kq >> 2) & 1) + (kq & 3) + 4 * (kq >> 3) + 16 * (k >> 5);
          unsigned char* dst = vt8 + ((size_t)((b * 4 + u.pn) * 256 + (s >> 6)) * 128 + wc * 32 + 8 * fq) * 64 + pos;
          dst[0] = (unsigned char)w[0]; dst[64] = (unsigned char)(w[0] >> 8); dst[128] = (unsigned char)(w[0] >> 16); dst[192] = (unsigned char)(w[0] >> 24);
          dst[256] = (unsigned char)w[1]; dst[320] = (unsigned char)(w[1] >> 8); dst[384] = (unsigned char)(w[1] >> 16); dst[448] = (unsigned char)(w[1] >> 24); }
        asm volatile("" ::: "memory");
      }
  }
};
struct EpiOut {
  static constexpr bool PERM = true;
  const float* x; const float* mod; bf16_t* z;
  DI void operator()(const f32x4 (&acc)[2][2][4][2], const Unit& u, int wr, int wc, int fr, int fq) const {
#pragma unroll
    for (int ai = 0; ai < 2; ++ai)
#pragma unroll
      for (int m = 0; m < 4; ++m) {
        const int row = u.pm * 256 + ai * 128 + wr * 64 + m * 16 + fr, b = row >> 14;
#pragma unroll
        for (int bj = 0; bj < 2; ++bj) {
          const int c = u.pn * 256 + bj * 128 + wc * 32 + 8 * fq;
          const unsigned off = (unsigned)row * 1024u + (unsigned)c;
          const f32x4 x0 = *(const f32x4*)(x + off), x1 = *(const f32x4*)(x + off + 4), g0 = *(const f32x4*)(mod + b * 6144 + 2048 + c), g1 = *(const f32x4*)(mod + b * 6144 + 2048 + c + 4);
          const f32x4 z0 = x0 * ALPHA + (g0 + 1.f) * acc[ai][bj][m][0], z1 = x1 * ALPHA + (g1 + 1.f) * acc[ai][bj][m][1];
          *(u32x4*)(z + off) = (u32x4){cvtpk(z0[0], z0[1]), cvtpk(z0[2], z0[3]), cvtpk(z1[0], z1[1]), cvtpk(z1[2], z1[3])};
        }
        asm volatile("" ::: "memory");
      }
  }
};
struct EpiGU {
  static constexpr bool PERM = true;
  bf16_t* hdn;
  DI void operator()(const f32x4 (&acc)[2][2][4][2], const Unit& u, int wr, int wc, int fr, int fq) const {
    const unsigned base = ((unsigned)u.pm * 256u + wr * 64 + fr) * 1024u + (unsigned)(u.pn * 256 + wc * 32 + 8 * fq);
#pragma unroll
    for (int ai = 0; ai < 2; ++ai)
#pragma unroll
      for (int m = 0; m < 4; ++m) {
#pragma unroll
        for (int bj = 0; bj < 2; ++bj) {
          const f32x4 g = acc[ai][bj][m][0], up = acc[ai][bj][m][1];
          const u32x2 w = {cvtpk(siluf_(g[0]) * up[0], siluf_(g[1]) * up[1]), cvtpk(siluf_(g[2]) * up[2], siluf_(g[3]) * up[3])};
          *(u32x2*)((char*)hdn + (base + (unsigned)((ai * 128 + m * 16) * 1024 + bj * 128))) = w;
        }
      }
  }
};
struct EpiDN {
  static constexpr bool PERM = true;
  bf16_t* ybuf; const float* lw;
  DI void operator()(const f32x4 (&acc)[2][2][4][2], const Unit& u, int wr, int wc, int fr, int fq) const {
    const unsigned base = ((unsigned)u.pm * 256u + wr * 64 + fr) * 2048u + (unsigned)(u.pn * 256 + wc * 32 + 8 * fq) * 2u;
    const unsigned wbase = ((unsigned)u.e * (unsigned)T + (unsigned)(u.j * 256 + wr * 64 + fr)) * 4u;
#pragma unroll
    for (int ai = 0; ai < 2; ++ai)
#pragma unroll
      for (int m = 0; m < 4; ++m) {
        const float wgt = *(const float*)((const char*)lw + (wbase + (unsigned)((ai * 128 + m * 16) * 4)));
#pragma unroll
        for (int bj = 0; bj < 2; ++bj) {
          const f32x4 v0 = acc[ai][bj][m][0] * wgt, v1 = acc[ai][bj][m][1] * wgt;
          const u32x4 w = {cvtpk(v0[0], v0[1]), cvtpk(v0[2], v0[3]), cvtpk(v1[0], v1[1]), cvtpk(v1[2], v1[3])};
          *(u32x4*)((char*)ybuf + (base + (unsigned)((ai * 128 + m * 16) * 2048 + bj * 256))) = w;
        }
        asm volatile("" ::: "memory");
      }
  }
};
struct MoeOrderBase {
  const LAS int* tstart; const int* cnt; int G, c;
  DI bool next(int i, Unit& u) const {
    const int L = i * G + c, NT = tstart[32]; if (L >= NT * 4) return false;
    const int tile = L >> 2; int e = 0;
    for (int k = 1; k < 32; ++k) e = (tstart[k] <= tile) ? k : e;
    u.pm = tile; u.pn = L & 3; u.e = e; u.j = tile - tstart[e]; return true;
  }
};
struct MoeOrderGU : MoeOrderBase {
  static constexpr bool GATHER = true;
  const int* ltok; const char* Bt;
  DI unsigned a_off(const Unit& u, int R) const { const int n = cnt[u.e * CNT_STRIDE]; int idx = u.j * 256 + R; idx = idx < n ? idx : n - 1; return (unsigned)ltok[(size_t)u.e * T + idx] * 2048u; }
  DI const char* b_base(const Unit& u) const { return Bt + ((size_t)u.e * 1024 + u.pn * 256) * 2048; }
};
struct MoeOrderDN : MoeOrderBase {
  static constexpr bool GATHER = false;
  const char* Bt;
  DI unsigned a_off(const Unit& u, int R) const { return (unsigned)(u.pm * 256 + R) * 1024u; }
  DI const char* b_base(const Unit& u) const { return Bt + ((size_t)u.e * 1024 + u.pn * 256) * 1024; }
};

struct TDesc { const float* src; const float* kscale; bf16_t* dst; int ld, K, k0, n0, ok; };
DI TDesc tdesc(int r, int lane, unsigned char* ws) {
  constexpr int I_IN = 16 * 88, I_UQ = 6 * 24, I_UKV = 4 * 32, I_OUT = 16 * 32, I_GU = 32 * 16 * 32;
  TDesc d; d.kscale = nullptr; int sc, kb, nb; const float* W;
  if (r < I_IN) { kb = r / 88; nb = r % 88; const int n = nb * 32 + (lane & 31);
    sc = n < 2048 ? n : n < 2432 ? 2064 + (n - 2048) : n < 2688 ? 2448 + (n - 2432) : n < 2752 ? 2704 + ((n - 2688) & 1) * 32 + ((n - 2688) >> 1) : n < 2768 ? 2048 + (n - 2752) : -1;
    W = karg<A_WIN>(); d.ld = N_IN; d.K = 1024; d.dst = (bf16_t*)(ws + WS_WIN); }
  else if ((r -= I_IN) < I_UQ) { kb = r / 24; nb = r % 24; const int n = nb * 32 + (lane & 31), h = n / 192, dd = n - h * 192;
    sc = dd < 128 ? n : h * 192 + 128 + ((dd - 128) & 1) * 32 + ((dd - 128) >> 1);
    W = karg<A_WUQ>(); d.ld = 768; d.K = 384; d.dst = (bf16_t*)(ws + WS_WUQ); d.kscale = karg<A_QNG>(); }
  else if ((r -= I_UQ) < I_UKV) { kb = r / 32; nb = r % 32; sc = nb * 32 + (lane & 31); W = karg<A_WUKV>(); d.ld = 1024; d.K = 256; d.dst = (bf16_t*)(ws + WS_WUKV); d.kscale = karg<A_KVNG>(); }
  else if ((r -= I_UKV) < I_OUT) { kb = r / 32; nb = r % 32; sc = nb * 32 + (lane & 31); W = karg<A_WOUT>(); d.ld = 1024; d.K = 1024; d.dst = (bf16_t*)(ws + WS_WOUT); }
  else if ((r -= I_OUT) < I_GU) { const int e = r / 512, q = r % 512; kb = q / 32; nb = q % 32;
    const int lr = nb * 32 + (lane & 31), up = (lr >> 2) & 1; sc = (lr >> 3) * 4 + (lr & 3);
    W = (up ? karg<A_WUP>() : karg<A_WGATE>()) + (size_t)e * 1024 * 512; d.ld = 512; d.K = 1024; d.dst = (bf16_t*)(ws + WS_WGU) + (size_t)e * 1024 * 1024; }
  else { r -= I_GU; const int e = r / 256, q = r % 256; kb = q / 32; nb = q % 32; sc = nb * 32 + (lane & 31);
    W = karg<A_WDOWN>() + (size_t)e * 512 * 1024; d.ld = 1024; d.K = 512; d.dst = (bf16_t*)(ws + WS_WDN) + (size_t)e * 1024 * 512; }
  d.k0 = 64 * kb; d.n0 = 32 * nb; d.ok = sc >= 0;
  d.src = W + (size_t)(d.k0 + (lane >> 5)) * d.ld + (sc >= 0 ? sc : 0);
  return d;
}
DI void tload(const TDesc& d, float (&v)[32]) {
#pragma unroll
  for (int i = 0; i < 32; ++i) v[i] = d.src[(size_t)(2 * i) * d.ld];
}
DI void tstore(const TDesc& d, float (&v)[32], LAS float* scr, int lane) {
  if (d.kscale) {
#pragma unroll
    for (int i = 0; i < 32; ++i) v[i] *= d.kscale[d.k0 + 2 * i + (lane >> 5)];
  }
#pragma unroll
  for (int i = 0; i < 32; ++i) scr[(2 * i + (lane >> 5)) * 33 + (lane & 31)] = d.ok ? v[i] : 0.f;
  asm volatile("s_waitcnt lgkmcnt(0)" ::: "memory");
  const int c = lane & 7;
#pragma unroll
  for (int j = 0; j < 4; ++j) { const int n = (lane >> 3) + 8 * j; const LAS float* s = scr + (8 * c) * 33 + n;
    u32x4 o; o.x = cvtpk(s[0 * 33], s[1 * 33]); o.y = cvtpk(s[2 * 33], s[3 * 33]); o.z = cvtpk(s[4 * 33], s[5 * 33]); o.w = cvtpk(s[6 * 33], s[7 * 33]);
    *(u32x4*)(d.dst + (size_t)(d.n0 + n) * d.K + d.k0 + 8 * c) = o; }
  asm volatile("s_waitcnt lgkmcnt(0)" ::: "memory");
}
constexpr int PREP_ITEMS = 16 * 88 + 6 * 24 + 4 * 32 + 16 * 32 + 32 * 16 * 32 + 32 * 8 * 32;
constexpr int PREP_DEFER = 8192;
constexpr int PREP_DEFER_B = 4096;
DI void prep_items(int it, const int end, const int stride, const int lane, unsigned char* ws, LAS float* scr) {
  TDesc dA, dB; float vA[32], vB[32];
  if (it < end) { dA = tdesc(it, lane, ws); tload(dA, vA); }
  while (it < end) {
    if (it + stride < end) { dB = tdesc(it + stride, lane, ws); tload(dB, vB); }
    tstore(dA, vA, scr, lane);
    it += stride; if (it >= end) break;
    if (it + stride < end) { dA = tdesc(it + stride, lane, ws); tload(dA, vA); }
    tstore(dB, vB, scr, lane);
    it += stride;
  }
}
DI void phase_prep(const Ctx& p, int bid, int G, LAS unsigned char* lds) {
  const int tid = tid_fresh(), lane = tid & 63, wave = __builtin_amdgcn_readfirstlane(tid >> 6);
  unsigned char* ws = p.ws;
  LAS float* scr = (LAS float*)(lds + wave * 16384);
  LAS float* cact = (LAS float*)(lds + 131072);
  for (int i = tid; i < 2048; i += NTHREADS) cact[i] = siluf_(karg<A_C>()[i]);
  __syncthreads();
  const int gw = bid * 8 + wave, NGW = G * 8;
  constexpr int I_MOD = 192;
  if (bid < I_MOD) {
    const int kg = lane >> 3, cc = lane & 7, col = bid * 32 + 4 * cc; const float* w_ada = karg<A_WADA>() + col;
    f32x4 a0 = {0.f, 0.f, 0.f, 0.f}, a1 = {0.f, 0.f, 0.f, 0.f};
#pragma unroll
    for (int j = 0; j < 16; ++j) { const int k = wave * 128 + kg + 8 * j; const f32x4 w = *(const f32x4*)(w_ada + (size_t)k * 6144); a0 += w * cact[k]; a1 += w * cact[1024 + k]; }
#pragma unroll
    for (int e = 0; e < 4; ++e) {
#pragma unroll
      for (int o = 8; o < 64; o <<= 1) { a0[e] += __shfl_xor(a0[e], o); a1[e] += __shfl_xor(a1[e], o); } }
    LAS f32x4* part = (LAS f32x4*)(lds + 131072 + 8192);
    if (kg == 0) { part[(wave * 8 + cc) * 2] = a0; part[(wave * 8 + cc) * 2 + 1] = a1; }
    __syncthreads();
    if (wave == 0 && kg == 0) { float* mod = (float*)(ws + WS_MOD); const f32x4 bb = *(const f32x4*)(karg<A_BADA>() + col);
      f32x4 s0 = part[cc * 2], s1 = part[cc * 2 + 1];
#pragma unroll
      for (int w = 1; w < 8; ++w) { s0 += part[(w * 8 + cc) * 2]; s1 += part[(w * 8 + cc) * 2 + 1]; }
      *(f32x4*)(mod + col) = s0 + bb; *(f32x4*)(mod + 6144 + col) = s1 + bb; }
  }
#ifndef DBL_PREP
#define DBL_PREP 0
#endif
  for (int rp_ = 0; rp_ < (DBL_PREP == 1 ? 2 : 1); ++rp_) prep_items(gw, PREP_ITEMS - PREP_DEFER - PREP_DEFER_B, NGW, lane, ws, scr);
  {
    const float INV[32] = {1.000000000e+00f, 7.498942018e-01f, 5.623413324e-01f, 4.216965139e-01f, 3.162277639e-01f, 2.371373773e-01f, 1.778279394e-01f, 1.333521456e-01f,
                           1.000000015e-01f, 7.498942316e-02f, 5.623413250e-02f, 4.216964915e-02f, 3.162277490e-02f, 2.371373773e-02f, 1.778279431e-02f, 1.333521400e-02f,
                           9.999999776e-03f, 7.498942316e-03f, 5.623413250e-03f, 4.216964822e-03f, 3.162277630e-03f, 2.371373819e-03f, 1.778279431e-03f, 1.333521446e-03f,
                           1.000000047e-03f, 7.498941850e-04f, 5.623413017e-04f, 4.216965172e-04f, 3.162277571e-04f, 2.371373703e-04f, 1.778279402e-04f, 1.333521504e-04f};
    f32x2* rope = (f32x2*)(ws + WS_ROPE); const int* pos = karg<A_POS, const int>();
    for (int rp_ = 0; rp_ < (DBL_PREP == 2 ? 2 : 1); ++rp_)
    for (int i = bid * NTHREADS + tid; i < T * 32; i += G * NTHREADS) {
      const int t = i >> 5, fi = i & 31;
      const float ang = (float)pos[t] * INV[fi];
      float sn, cs; sincosf(ang, &sn, &cs); rope[i] = (f32x2){cs, sn};
    }
  }
  if (bid == 0) for (int i = tid; i < 64 * CNT_STRIDE; i += NTHREADS) ((int*)(ws + WS_CNT))[i] = 0;
  { const float* w_re = karg<A_WRE>(); const float* w_rg = karg<A_WRG>(); float* wrt = (float*)(ws + WS_WRT);
    for (int i = bid * NTHREADS + tid; i < 36 * 1024; i += G * NTHREADS) { const int e = i >> 10, k = i & 1023; wrt[i] = e < 32 ? w_re[k * 32 + e] : w_rg[k * 4 + (e - 32)]; } }
}

DI void phase_lnmod(const Ctx& p, int bid, int G) {
  const int tid = tid_fresh(), lane = tid & 63, wave = tid >> 6;
  const float* mod = (const float*)(p.ws + WS_MOD); bf16_t* U = (bf16_t*)(p.ws + WS_U); const float* xin = karg<A_X>();
  f32x4 vn[4];
  { const int row = bid * 8 + wave; if (row < T) { const f32x4* xr = (const f32x4*)(xin + (size_t)row * 1024) + lane;
#pragma unroll
      for (int j = 0; j < 4; ++j) vn[j] = xr[64 * j]; } }
  for (int row = bid * 8 + wave; row < T; row += G * 8) {
    const int b = row >> 14;
    f32x4 v[4]; float s = 0.f;
#pragma unroll
    for (int j = 0; j < 4; ++j) { v[j] = vn[j]; s += (v[j][0] + v[j][1]) + (v[j][2] + v[j][3]); }
    if (row + G * 8 < T) { const f32x4* xr = (const f32x4*)(xin + (size_t)(row + G * 8) * 1024) + lane;
#pragma unroll
      for (int j = 0; j < 4; ++j) vn[j] = xr[64 * j]; }
    const float mean = wave_sum(s) * (1.f / 1024.f); float s2 = 0.f;
#pragma unroll
    for (int j = 0; j < 4; ++j) { v[j] = v[j] - mean; s2 += (v[j][0] * v[j][0] + v[j][1] * v[j][1]) + (v[j][2] * v[j][2] + v[j][3] * v[j][3]); }
    const float rstd = rsqrtf(wave_sum(s2) * (1.f / 1024.f) + LN_EPS);
    u32x2* o8 = (u32x2*)(U + (size_t)row * 1024) + lane;
#pragma unroll
    for (int j = 0; j < 4; ++j) {
      const int col = 4 * lane + 256 * j;
      const f32x4 sh = *(const f32x4*)(mod + b * 6144 + col), sc = *(const f32x4*)(mod + b * 6144 + 1024 + col);
      const f32x4 y = v[j] * rstd * (sc + 1.f) + sh;
      o8[64 * j] = (u32x2){cvtpk(y[0], y[1]), cvtpk(y[2], y[3])};
    }
  }
}

constexpr int PA_V = 0, PA_KF = 32768, PA_KB = 65536, PA_RAWK = 100352, PA_VEC = 135168;
DI void mlstmA_unit(const Ctx& p, int b, int h, int c, LAS unsigned char* lds) {
  const int tid = tid_fresh(), lane = tid & 63, wid = __builtin_amdgcn_readfirstlane(tid >> 6), r32 = lane & 31, hi = lane >> 5;
  unsigned char* ws = p.ws;
  const bf16_t* qkpre = (const bf16_t*)(ws + WS_QKPRE); const bf16_t* vmp = (const bf16_t*)(ws + WS_VM); bf16_t* qkpost = (bf16_t*)(ws + WS_U);
  const float* gates = (const float*)(ws + WS_GATES); float* gvec = (float*)(ws + WS_GVEC); float* nvec = (float*)(ws + WS_NVEC); float* scal = (float*)(ws + WS_SCAL);
  bf16_t* Cbuf = (bf16_t*)p.out;
  LAS float* vec = (LAS float*)(lds + PA_VEC);
  const int bh = b * 4 + h, row0 = b * SEQ + c * 128;
  const int r0 = tid >> 4, c8 = (tid & 15) * 8;
  u32x4 rk[5], rq[5], rv[4];
#pragma unroll
  for (int j = 0; j < 5; ++j) {
    const int rr = r0 + 32 * j, sj = c * 128 + rr - 2; const bool ok = rr < 132 && sj >= 0 && sj < SEQ;
    const bf16_t* src = qkpre + (size_t)(b * SEQ + (ok ? sj : 0)) * 1024 + h * 128 + c8;
    rk[j] = ok ? *(const u32x4*)(src + 512) : (u32x4){0u, 0u, 0u, 0u}; rq[j] = ok ? *(const u32x4*)src : (u32x4){0u, 0u, 0u, 0u};
  }
#pragma unroll
  for (int j = 0; j < 4; ++j) rv[j] = *(const u32x4*)(vmp + (size_t)(row0 + r0 + 32 * j) * 512 + h * 128 + c8);
  float gb = 0.f, gcol = 0.f, gcm = 0.f;
  if (tid < 256) {
    const int dir = tid >> 7, t = tid & 127, wv = (tid >> 6) & 1;
    const float ig = gates[(size_t)(row0 + t) * 16 + (dir * 2) * 4 + h], fg = gates[(size_t)(row0 + t) * 16 + (dir * 2 + 1) * 4 + h];
    float x = logsigmoidf_(fg);
    if (dir == 0) {
#pragma unroll
      for (int o = 1; o < 64; o <<= 1) { const float y = __shfl_up(x, o); if (lane >= o) x += y; }
      if (lane == 63) vec[256 + wv] = x;
    } else {
#pragma unroll
      for (int o = 1; o < 64; o <<= 1) { const float y = __shfl_down(x, o); if (lane + o < 64) x += y; }
      if (lane == 0) vec[258 + wv] = x;
    }
    gb = x; gcol = ig;
  }
  __syncthreads();
  if (tid < 256) {
    const int dir = tid >> 7, wv = (tid >> 6) & 1;
    if (dir == 0) { if (wv == 1) gb += vec[256]; } else { if (wv == 0) gb += vec[259]; }
    gcol = gcol - gb;
    float x = gcol;
    if (dir == 0) {
#pragma unroll
      for (int o = 1; o < 64; o <<= 1) { const float y = __shfl_up(x, o); if (lane >= o) x = fmaxf(x, y); }
      if (lane == 63) vec[260 + wv] = x;
    } else {
#pragma unroll
      for (int o = 1; o < 64; o <<= 1) { const float y = __shfl_down(x, o); if (lane + o < 64) x = fmaxf(x, y); }
      if (lane == 0) vec[262 + wv] = x;
    }
    gcm = x;
  }
  __syncthreads();
  if (tid < 256) {
    const int dir = tid >> 7, t = tid & 127, wv = (tid >> 6) & 1;
    if (dir == 0) { if (wv == 1) gcm = fmaxf(gcm, vec[260]); } else { if (wv == 0) gcm = fmaxf(gcm, vec[263]); }
    const float mx = fmaxf(vec[260 + 2 * dir], vec[261 + 2 * dir]);
    const float tot = vec[256 + 2 * dir] + vec[257 + 2 * dir];
    float* gv = gvec + ((size_t)(dir * 8 + bh) * SEQ + c * 128 + t) * 3;
    gv[0] = gb; gv[1] = gcol; gv[2] = gcm;
    vec[dir * 128 + t] = __expf(gcol - mx);
    if (t == 0) { scal[(dir * 8 + bh) * 128 + c] = tot; scal[2048 + (dir * 8 + bh) * 128 + c] = tot + mx; }
  }
  __syncthreads();
#pragma unroll
  for (int j = 0; j < 5; ++j) { const int rr = r0 + 32 * j;
    if (rr < 132) { *(LAS u32x4*)(lds + PA_RAWK + rr * 256 + c8 * 2) = rk[j]; *(LAS u32x4*)(lds + PA_KB + rr * 256 + c8 * 2) = rq[j]; } }
#pragma unroll
  for (int j = 0; j < 4; ++j) { const int r = r0 + 32 * j; *(LAS u32x4*)(lds + PA_V + (r >> 6) * 16384 + v_st(r & 63, c8)) = rv[j]; }
  __syncthreads();
  const float* conv_w = karg<A_CONVW>(); const float* conv_b = karg<A_CONVB>();
  {
    const int ch = h * 128 + c8;
    float w[5][8], bias[8];
#pragma unroll
    for (int j = 0; j < 5; ++j) { const f32x4 a = *(const f32x4*)(conv_w + j * 1024 + ch), bq = *(const f32x4*)(conv_w + j * 1024 + ch + 4);
      w[j][0] = a[0]; w[j][1] = a[1]; w[j][2] = a[2]; w[j][3] = a[3]; w[j][4] = bq[0]; w[j][5] = bq[1]; w[j][6] = bq[2]; w[j][7] = bq[3]; }
    { const f32x4 a = *(const f32x4*)(conv_b + ch), bq = *(const f32x4*)(conv_b + ch + 4); bias[0] = a[0]; bias[1] = a[1]; bias[2] = a[2]; bias[3] = a[3]; bias[4] = bq[0]; bias[5] = bq[1]; bias[6] = bq[2]; bias[7] = bq[3]; }
#pragma unroll
    for (int ps = 0; ps < 4; ++ps) {
      const int r = r0 + 32 * ps;
      float a[8];
#pragma unroll
      for (int e = 0; e < 8; ++e) a[e] = bias[e];
#pragma unroll
      for (int j = 0; j < 5; ++j) { const u32x4 xv = *(const LAS u32x4*)(lds + PA_KB + (r + j) * 256 + c8 * 2);
        a[0] += w[j][0] * bflo(xv[0]); a[1] += w[j][1] * bfhi(xv[0]); a[2] += w[j][2] * bflo(xv[1]); a[3] += w[j][3] * bfhi(xv[1]);
        a[4] += w[j][4] * bflo(xv[2]); a[5] += w[j][5] * bfhi(xv[2]); a[6] += w[j][6] * bflo(xv[3]); a[7] += w[j][7] * bfhi(xv[3]); }
      const float qs = 0.08838834764831845f;
#pragma unroll
      for (int e = 0; e < 8; ++e) a[e] = siluf_(a[e]) * qs;
      *(u32x4*)(qkpost + (size_t)(row0 + r) * 1024 + ch) = (u32x4){cvtpk(a[0], a[1]), cvtpk(a[2], a[3]), cvtpk(a[4], a[5]), cvtpk(a[6], a[7])};
    }
  }
  __syncthreads();
  {
    const int ch = 512 + h * 128 + c8;
    float w[5][8], bias[8];
#pragma unroll
    for (int j = 0; j < 5; ++j) { const f32x4 a = *(const f32x4*)(conv_w + j * 1024 + ch), bq = *(const f32x4*)(conv_w + j * 1024 + ch + 4);
      w[j][0] = a[0]; w[j][1] = a[1]; w[j][2] = a[2]; w[j][3] = a[3]; w[j][4] = bq[0]; w[j][5] = bq[1]; w[j][6] = bq[2]; w[j][7] = bq[3]; }
    { const f32x4 a = *(const f32x4*)(conv_b + ch), bq = *(const f32x4*)(conv_b + ch + 4); bias[0] = a[0]; bias[1] = a[1]; bias[2] = a[2]; bias[3] = a[3]; bias[4] = bq[0]; bias[5] = bq[1]; bias[6] = bq[2]; bias[7] = bq[3]; }
#pragma unroll
    for (int ps = 0; ps < 4; ++ps) {
      const int r = r0 + 32 * ps;
      float a[8];
#pragma unroll
      for (int e = 0; e < 8; ++e) a[e] = bias[e];
#pragma unroll
      for (int j = 0; j < 5; ++j) { const u32x4 xv = *(const LAS u32x4*)(lds + PA_RAWK + (r + j) * 256 + c8 * 2);
        a[0] += w[j][0] * bflo(xv[0]); a[1] += w[j][1] * bfhi(xv[0]); a[2] += w[j][2] * bflo(xv[1]); a[3] += w[j][3] * bfhi(xv[1]);
        a[4] += w[j][4] * bflo(xv[2]); a[5] += w[j][5] * bfhi(xv[2]); a[6] += w[j][6] * bflo(xv[3]); a[7] += w[j][7] * bfhi(xv[3]); }
#pragma unroll
      for (int e = 0; e < 8; ++e) a[e] = siluf_(a[e]);
      *(u32x4*)(qkpost + (size_t)(row0 + r) * 1024 + ch) = (u32x4){cvtpk(a[0], a[1]), cvtpk(a[2], a[3]), cvtpk(a[4], a[5]), cvtpk(a[6], a[7])};
      const float wf = vec[r], wb = vec[128 + r];
      const u32x4 kf = {cvtpk(a[0] * wf, a[1] * wf), cvtpk(a[2] * wf, a[3] * wf), cvtpk(a[4] * wf, a[5] * wf), cvtpk(a[6] * wf, a[7] * wf)};
      const u32x4 kb = {cvtpk(a[0] * wb, a[1] * wb), cvtpk(a[2] * wb, a[3] * wb), cvtpk(a[4] * wb, a[5] * wb), cvtpk(a[6] * wb, a[7] * wb)};
      const int io = (r >> 6) * 16384 + v_st(r & 63, c8);
      *(LAS u32x4*)(lds + PA_KF + io) = kf; *(LAS u32x4*)(lds + PA_KB + io) = kb;
    }
  }
  __syncthreads();
  {
    const int dir = wid >> 2, dkb = wid & 3;
    const int ka = (int)(uintptr_t)(lds + (dir ? PA_KB : PA_KF)) + v_rd_base(lane) + dkb * 512;
    const int va = (int)(uintptr_t)(lds + PA_V) + v_rd_base(lane);
    f32x16 o[4] = {};
#define PA_STEP(TILE, KS) do { s16x4 al, ah, l0, h0, l1, h1, l2, h2, l3, h3;                                                   \
      al = tr_read<v_rd_off(0, KS, 0)>(ka + TILE * 16384); ah = tr_read<v_rd_off(0, KS, 1)>(ka + TILE * 16384);                 \
      l0 = tr_read<v_rd_off(0, KS, 0)>(va + TILE * 16384); h0 = tr_read<v_rd_off(0, KS, 1)>(va + TILE * 16384);                 \
      l1 = tr_read<v_rd_off(1, KS, 0)>(va + TILE * 16384); h1 = tr_read<v_rd_off(1, KS, 1)>(va + TILE * 16384);                 \
      l2 = tr_read<v_rd_off(2, KS, 0)>(va + TILE * 16384); h2 = tr_read<v_rd_off(2, KS, 1)>(va + TILE * 16384);                 \
      l3 = tr_read<v_rd_off(3, KS, 0)>(va + TILE * 16384); h3 = tr_read<v_rd_off(3, KS, 1)>(va + TILE * 16384);                 \
      asm volatile("s_waitcnt lgkmcnt(0)" ::: "memory"); SBAR();                                                                \
      const bf16x8 A = PKLH(al, ah);                                                                                            \
      o[0] = MFMA32(A, PKLH(l0, h0), o[0]); o[1] = MFMA32(A, PKLH(l1, h1), o[1]); o[2] = MFMA32(A, PKLH(l2, h2), o[2]); o[3] = MFMA32(A, PKLH(l3, h3), o[3]); } while (0)
    PA_STEP(0, 0); PA_STEP(0, 1); PA_STEP(0, 2); PA_STEP(0, 3); PA_STEP(1, 0); PA_STEP(1, 1); PA_STEP(1, 2); PA_STEP(1, 3);
#undef PA_STEP
    bf16_t* Cd = Cbuf + ((size_t)(dir * 8 + bh) * 128 + c) * 16384;
#pragma unroll
    for (int r = 0; r < 16; ++r) { const int dk = dkb * 32 + crow(r, hi);
#pragma unroll
      for (int d0 = 0; d0 < 4; ++d0) Cd[dk * 128 + d0 * 32 + r32] = f2bf(o[d0][r]); }
  }
  if (tid < 256) {
    const int dir = tid >> 7, dk = tid & 127; const LAS unsigned char* img = lds + (dir ? PA_KB : PA_KF);
    float n = 0.f;
#pragma unroll 8
    for (int s = 0; s < 128; ++s) n += bf2f(*(const LAS unsigned short*)(img + (s >> 6) * 16384 + v_st(s & 63, dk)));
    nvec[((size_t)(dir * 8 + bh) * 128 + c) * 128 + dk] = n;
  }
  __syncthreads();
}

DI void phase_scan(const Ctx& p, int bid, int G) {
  const int tid = tid_fresh(); unsigned char* ws = p.ws;
  const float* scal = (const float*)(ws + WS_SCAL); float* mprev = (float*)(ws + WS_SCAL) + 4096; float* nvec = (float*)(ws + WS_NVEC); bf16_t* Cbuf = (bf16_t*)p.out;
  for (int gid = bid * NTHREADS + tid, it = 0; gid < 131072; gid += G * NTHREADS, ++it) {
    const int seq = gid >> 13, e2c = gid & 8191, dir = seq >> 3;
    const bool ex = (it == 0) && (gid < 1024);
    const int seqn = (gid & 1023) >> 6, e2 = gid & 63, dirn = seqn >> 3;
    float m = 0.f, a0 = 0.f, a1 = 0.f, mN = 0.f, n0 = 0.f, n1 = 0.f;
    for (int sb = 0; sb < 128; sb += 8) {
      unsigned raw[8]; f32x2 rawn[8];
#pragma unroll
      for (int q = 0; q < 8; ++q) { const int c = dir ? 127 - (sb + q) : sb + q; raw[q] = *(const unsigned*)(Cbuf + ((size_t)seq * 128 + c) * 16384 + e2c * 2); }
      if (ex) {
#pragma unroll
        for (int q = 0; q < 8; ++q) { const int c = dirn ? 127 - (sb + q) : sb + q; rawn[q] = *(const f32x2*)(nvec + ((size_t)seqn * 128 + c) * 128 + e2 * 2); }
      }
#pragma unroll
      for (int q = 0; q < 8; ++q) {
        const int c = dir ? 127 - (sb + q) : sb + q;
        const float be = scal[seq * 128 + c], ml = scal[2048 + seq * 128 + c];
        *(unsigned*)(Cbuf + ((size_t)seq * 128 + c) * 16384 + e2c * 2) = cvtpk(a0, a1);
        if (e2c == 0) mprev[seq * 128 + c] = m;
        const float mn = fmaxf(be + m, ml), al = __expf(be + m - mn), bt = __expf(ml - mn);
        a0 = al * a0 + bt * bflo(raw[q]); a1 = al * a1 + bt * bfhi(raw[q]);
        m = mn;
      }
      if (ex) {
#pragma unroll
        for (int q = 0; q < 8; ++q) {
          const int c = dirn ? 127 - (sb + q) : sb + q;
          const float be = scal[seqn * 128 + c], ml = scal[2048 + seqn * 128 + c];
          *(f32x2*)(nvec + ((size_t)seqn * 128 + c) * 128 + e2 * 2) = (f32x2){n0, n1};
          const float mn = fmaxf(be + mN, ml), al = __expf(be + mN - mn), bt = __expf(ml - mn);
          n0 = al * n0 + bt * rawn[q][0]; n1 = al * n1 + bt * rawn[q][1];
          mN = mn;
        }
      }
    }
  }
}

DI void qkt8(f32x16& p0, f32x16& p1, const LAS unsigned char* Ks, const bf16x8* qr, int r32, int hi) {
  p0 = f32x16{}; p1 = f32x16{};
#pragma unroll
  for (int d0 = 0; d0 < 8; ++d0) { const int cb = (d0 * 16 + hi * 8) * 2;
    const bf16x8 b0 = *(const LAS bf16x8*)(Ks + KSWZ(r32, cb)), b1 = *(const LAS bf16x8*)(Ks + KSWZ(32 + r32, cb));
    p0 = MFMA32(b0, qr[d0], p0); p1 = MFMA32(b1, qr[d0], p1); }
}
DI v8i kfrag8(const LAS unsigned char* K8, int row, int s, int hi) {
  const int c = 4 * s + 2 * hi;
  const u32x4 lo = *(const LAS u32x4*)(K8 + row * 256 + ((c ^ (row & 15)) << 4)), hi4 = *(const LAS u32x4*)(K8 + row * 256 + (((c + 1) ^ (row & 15)) << 4));
  return (v8i){(int)lo[0], (int)lo[1], (int)lo[2], (int)lo[3], (int)hi4[0], (int)hi4[1], (int)hi4[2], (int)hi4[3]};
}
#define MFMA8(a, b, c) __builtin_amdgcn_mfma_scale_f32_32x32x64_f8f6f4((a), (b), (c), 0, 0, 0, 127, 0, 123)
DI void qkt12(f32x16& p0, f32x16& p1, const LAS unsigned char* K8, const v8i* qr, int r32, int hi) {
  p0 = f32x16{}; p1 = f32x16{};
#pragma unroll
  for (int s = 0; s < 3; ++s) {
    const v8i a0 = kfrag8(K8, r32, s, hi), a1 = kfrag8(K8, 32 + r32, s, hi);
    p0 = MFMA8(a0, qr[s], p0); p1 = MFMA8(a1, qr[s], p1);
  }
}

DI void glds16(const void* gsrc, unsigned lds_dst) {
  unsigned keep;
  asm volatile("s_mov_b32 %0, m0\n\ts_mov_b32 m0, %2\n\ts_nop 0\n\tglobal_load_lds_dwordx4 %1, off\n\ts_mov_b32 m0, %0" : "=&s"(keep) : "v"(gsrc), "s"(lds_dst) : "memory");
}
constexpr int AT_KN = 0, AT_V = 49152, AT_WS = 73728;
constexpr float ATT_THR = 3.f;
DI void partialSM(f32x16& p0, f32x16& p1, float& m_reg, float& mn, float& alpha) {
  float pmax = p0[0];
#pragma unroll
  for (int r = 1; r < 16; ++r) pmax = fmaxf(pmax, p0[r]);
#pragma unroll
  for (int r = 0; r < 16; ++r) pmax = fmaxf(pmax, p1[r]);
  pmax = half_swap_max(pmax);
  if (__builtin_expect(__all(pmax - m_reg <= ATT_THR), 1)) { mn = m_reg; alpha = 1.f; }
  else { mn = fmaxf(m_reg, pmax); alpha = __builtin_amdgcn_exp2f(m_reg - mn); m_reg = mn; }
  const float mo = mn - 5.f;
#pragma unroll
  for (int r = 0; r < 16; ++r) { p0[r] = p0[r] - mo; p1[r] = p1[r] - mo; }
#pragma unroll
  for (int r = 0; r < 16; ++r) p0[r] = __builtin_amdgcn_exp2f(p0[r]);
}
DI void finishSM(f32x16& p0, f32x16& p1, v8i& pa) {
#pragma unroll
  for (int r = 0; r < 16; ++r) p1[r] = __builtin_amdgcn_exp2f(p1[r]);
#pragma unroll
  for (int q = 0; q < 4; ++q) {
    int w = __builtin_amdgcn_cvt_pk_fp8_f32(p0[4 * q], p0[4 * q + 1], 0, false); pa[q] = __builtin_amdgcn_cvt_pk_fp8_f32(p0[4 * q + 2], p0[4 * q + 3], w, true);
    w = __builtin_amdgcn_cvt_pk_fp8_f32(p1[4 * q], p1[4 * q + 1], 0, false); pa[4 + q] = __builtin_amdgcn_cvt_pk_fp8_f32(p1[4 * q + 2], p1[4 * q + 3], w, true);
  }
}
DI void pv8(f32x16* o, f32x16& lsum, const LAS unsigned char* Vt, v8i pa, int r32, int hi) {
  { const v8i ones = {0x38383838, 0x38383838, 0x38383838, 0x38383838, 0x38383838, 0x38383838, 0x38383838, 0x38383838};
    lsum = __builtin_amdgcn_mfma_scale_f32_32x32x64_f8f6f4(pa, ones, lsum, 0, 0, 0, 122, 0, 127); }
#pragma unroll
  for (int d0 = 0; d0 < 4; ++d0) {
    const int n = 32 * d0 + r32, x = (n >> 2) & 3;
    const u32x4 lo = *(const LAS u32x4*)(Vt + n * 64 + (((2 * hi) ^ x) << 4)), h4 = *(const LAS u32x4*)(Vt + n * 64 + (((2 * hi + 1) ^ x) << 4));
    const v8i bv = {(int)lo[0], (int)lo[1], (int)lo[2], (int)lo[3], (int)h4[0], (int)h4[1], (int)h4[2], (int)h4[3]};
    o[d0] = __builtin_amdgcn_mfma_scale_f32_32x32x64_f8f6f4(pa, bv, o[d0], 0, 0, 0, 122, 0, 127);
  }
}
DI void attn_unit(const unsigned char* Qb, const unsigned char* Knh, const unsigned char* Vh, bf16_t* Ob, LAS unsigned char* lds) {
  const int tid = tid_fresh(), wid = __builtin_amdgcn_readfirstlane(tid >> 6), lane = tid & 63, r32 = lane & 31, hi = lane >> 5;
  LAS float* wsf = (LAS float*)(lds + AT_WS) + wid * 64; LAS float* al_l = wsf + 32;
  constexpr int NT = SEQ / 64;
  unsigned offKn, offV;
  { const int row = wid * 4 + (lane >> 4); int lg = (lane & 15) ^ (row & 15); lg = lg < 12 ? lg : 0; offKn = (unsigned)(row * 192 + lg * 16); }
  { const int n = wid * 16 + (lane >> 2), c = (lane & 3) ^ ((n >> 2) & 3); offV = (unsigned)(n * 64 + c * 16); }
  const unsigned ldsw = (unsigned)wid * 1024u, lds0 = (unsigned)(uintptr_t)lds;
#define DMA16(gptr, ldsoff) glds16((gptr), (unsigned)__builtin_amdgcn_readfirstlane((int)(lds0 + (unsigned)(ldsoff))))
#define ISSUE_K(t, ks) do { const int t_ = (t) < NT ? (t) : NT - 1; const char* kn_ = (const char*)Knh + (size_t)t_ * (64 * 192) + offKn; \
    DMA16(kn_, AT_KN + (ks) * 16384 + ldsw); DMA16(kn_ + 32 * 192, AT_KN + (ks) * 16384 + 8192 + ldsw); } while (0)
#define ISSUE_V(t, vs) do { const int t_ = (t) < NT ? (t) : NT - 1; DMA16((const char*)Vh + (size_t)t_ * 8192 + offV, AT_V + (vs) * 8192 + ldsw); } while (0)
#define WAIT_BAR(N) asm volatile("s_waitcnt vmcnt(" #N ") lgkmcnt(0)\n\ts_barrier" ::: "memory")
#define RESC(a) do { if (__any((a) < 1.f)) { if (hi == 0) al_l[r32] = (a); asm volatile("s_waitcnt lgkmcnt(0)" ::: "memory"); \
    _Pragma("unroll") for (int r = 0; r < 16; ++r) { const float a_ = al_l[crow(r, hi)]; lsum[r] *= a_; _Pragma("unroll") for (int d = 0; d < 4; ++d) o[d][r] *= a_; } } } while (0)
  const bool trail = wid >= 4;
  ISSUE_K(0, 0); ISSUE_K(1, 1); ISSUE_V(0, 0);
  float m_reg = -1e30f; f32x16 lsum = {}; f32x16 o[4] = {}; v8i qr[3];
  { const unsigned char* Qw = Qb + (size_t)(wid * 32 + r32) * 192 + hi * 32;
#pragma unroll
    for (int s_ = 0; s_ < 3; ++s_) { const u32x4 lo = *(const u32x4*)(Qw + s_ * 64), h4 = *(const u32x4*)(Qw + s_ * 64 + 16);
      qr[s_] = (v8i){(int)lo[0], (int)lo[1], (int)lo[2], (int)lo[3], (int)h4[0], (int)h4[1], (int)h4[2], (int)h4[3]}; } }
  f32x16 pA0, pA1, pB0, pB1; float mnA, mnB, alA, alB; v8i pa;
  asm volatile("s_waitcnt vmcnt(0)" ::: "memory");
  __builtin_amdgcn_s_barrier();
  if (trail) __builtin_amdgcn_s_barrier();
  ISSUE_K(2, 2);
  qkt12(pA0, pA1, lds + AT_KN, qr, r32, hi);
  WAIT_BAR(3);
  ISSUE_V(1, 1);
  partialSM(pA0, pA1, m_reg, mnA, alA);
  WAIT_BAR(3);
  int s1 = 1;
  for (int j = 1; j + 1 < NT; j += 2) {
    const int s0 = s1 == 0 ? 2 : s1 - 1, s2 = s1 == 2 ? 0 : s1 + 1;
    ISSUE_K(j + 2, s0);
    SBAR(); qkt12(pB0, pB1, lds + AT_KN + s1 * 16384, qr, r32, hi);
    finishSM(pA0, pA1, pa); SBAR();
    WAIT_BAR(3);
    ISSUE_V(j + 1, s2);
    pv8(o, lsum, lds + AT_V + s0 * 8192, pa, r32, hi); partialSM(pB0, pB1, m_reg, mnB, alB);
    RESC(alB);
    WAIT_BAR(3);
    ISSUE_K(j + 3, s1);
    SBAR(); qkt12(pA0, pA1, lds + AT_KN + s2 * 16384, qr, r32, hi);
    finishSM(pB0, pB1, pa); SBAR();
    WAIT_BAR(3);
    ISSUE_V(j + 2, s0);
    pv8(o, lsum, lds + AT_V + s1 * 8192, pa, r32, hi); partialSM(pA0, pA1, m_reg, mnA, alA);
    RESC(alA);
    WAIT_BAR(3);
    s1 = s0;
  }
  {
    const int s0 = s1 == 0 ? 2 : s1 - 1, s2 = s1 == 2 ? 0 : s1 + 1;
    ISSUE_K(NT + 1, s0);
    SBAR(); qkt12(pB0, pB1, lds + AT_KN + s1 * 16384, qr, r32, hi);
    finishSM(pA0, pA1, pa); SBAR();
    WAIT_BAR(3);
    ISSUE_V(NT, s2);
    pv8(o, lsum, lds + AT_V + s0 * 8192, pa, r32, hi); partialSM(pB0, pB1, m_reg, mnB, alB);
    RESC(alB);
    WAIT_BAR(3);
    if (!trail) __builtin_amdgcn_s_barrier();
    finishSM(pB0, pB1, pa); SBAR();
    pv8(o, lsum, lds + AT_V + s1 * 8192, pa, r32, hi);
  }
  float rli[16];
#pragma unroll
  for (int r = 0; r < 16; ++r) rli[r] = __builtin_amdgcn_rcpf(lsum[r]);
  bf16_t* Ow = Ob + (size_t)(wid * 32) * 1024;
#pragma unroll
  for (int r = 0; r < 16; ++r) { const int orow = crow(r, hi);
#pragma unroll
    for (int d0 = 0; d0 < 4; ++d0) Ow[(size_t)orow * 1024 + d0 * 32 + r32] = f2bf(o[d0][r] * rli[r]); }
  asm volatile("s_waitcnt vmcnt(0) lgkmcnt(0)\n\ts_barrier" ::: "memory");
#undef DMA16
#undef ISSUE_K
#undef ISSUE_V
#undef WAIT_BAR
#undef RESC
}
DI void phase_attn(const Ctx& p, int bid, int G, LAS unsigned char* lds) {
  unsigned char* ws = p.ws;
  const unsigned char* qatt = ws + WS_QATT; const unsigned char* k8 = ws + WS_KN; const unsigned char* va = ws + WS_VA;
  bf16_t* hcat = (bf16_t*)(ws + WS_H);
  for (int u = bid; u < 512; u += G) {
    const int bh = u & 7, qb = u >> 3, b = bh >> 2, h = bh & 3;
    attn_unit(qatt + ((size_t)bh * SEQ + qb * 256) * 192, k8 + (size_t)bh * SEQ * 192, va + (size_t)bh * SEQ * 128,
              hcat + (size_t)(b * SEQ + qb * 256) * 1024 + 512 + h * 128, lds);
  }
}

constexpr int PC_K = 0, PC_V = 32768, PC_CF = 65536, PC_CB = 98304, PC_VEC = 131072;
template <bool DRY = false> DI void mlstmC_unit(const Ctx& p, int b, int h, int c, LAS unsigned char* lds) {
  const int tid = tid_fresh(), lane = tid & 63, wid = __builtin_amdgcn_readfirstlane(tid >> 6), r32 = lane & 31, hi = lane >> 5;
  unsigned char* ws = p.ws;
  const bf16_t* qkpost = (const bf16_t*)(ws + WS_U); const bf16_t* vmp = (const bf16_t*)(ws + WS_VM); bf16_t* hcat = (bf16_t*)(ws + WS_H);
  const float* gvec = (const float*)(ws + WS_GVEC); const float* nvec = (const float*)(ws + WS_NVEC); const float* mprev = (const float*)(ws + WS_SCAL) + 4096;
  const bf16_t* Cbuf = (const bf16_t*)p.out;
  LAS float* vec = (LAS float*)(lds + PC_VEC);
  const int bh = b * 4 + h, row0 = b * SEQ + c * 128;
  if (tid < 256) {
    const int dir = tid >> 7, t = tid & 127;
    const float* gv = gvec + ((size_t)(dir * 8 + bh) * SEQ + c * 128 + t) * 3;
    const float gb = gv[0], gcol = gv[1], gcm = gv[2], mp = mprev[(dir * 8 + bh) * 128 + c];
    const float M = fmaxf(mp, gcm);
    vec[dir * 128 + t] = gcol * LOG2E; vec[256 + dir * 128 + t] = M * LOG2E; vec[512 + dir * 128 + t] = __expf(mp - M); vec[768 + dir * 128 + t] = __expf(-(gb + M));
    vec[1024 + dir * 128 + t] = nvec[((size_t)(dir * 8 + bh) * 128 + c) * 128 + t];
  }
  {
    const int r0 = tid >> 4, c8 = (tid & 15) * 8;
    const bf16_t* Cf = Cbuf + ((size_t)(0 * 8 + bh) * 128 + c) * 16384; const bf16_t* Cb = Cbuf + ((size_t)(1 * 8 + bh) * 128 + c) * 16384;
#pragma unroll
    for (int ps = 0; ps < 4; ++ps) {
      const int r = r0 + 32 * ps, tile = r >> 6, rr = r & 63;
      *(LAS u32x4*)(lds + PC_K + tile * 16384 + KSWZ(rr, c8 * 2)) = *(const u32x4*)(qkpost + (size_t)(row0 + r) * 1024 + 512 + h * 128 + c8);
      *(LAS u32x4*)(lds + PC_V + tile * 16384 + v_st(rr, c8)) = *(const u32x4*)(vmp + (size_t)(row0 + r) * 512 + h * 128 + c8);
      *(LAS u32x4*)(lds + PC_CF + tile * 16384 + v_st(rr, c8)) = *(const u32x4*)(Cf + r * 128 + c8);
      *(LAS u32x4*)(lds + PC_CB + tile * 16384 + v_st(rr, c8)) = *(const u32x4*)(Cb + r * 128 + c8);
    }
  }
  const int dir = wid >> 2, tb = wid & 3, t = tb * 32 + r32;
  bf16x8 qr[8];
  { const bf16_t* Qw = qkpost + (size_t)(row0 + t) * 1024 + h * 128 + hi * 8;
#pragma unroll
    for (int d0 = 0; d0 < 8; ++d0) qr[d0] = *(const bf16x8*)(Qw + d0 * 16); }
  __syncthreads();
  const LAS float* vcol = vec + dir * 128; const LAS float* va_ = vec + 512 + dir * 128; const LAS float* vn = vec + 1024 + dir * 128;
  float qn = 0.f;
#pragma unroll
  for (int d0 = 0; d0 < 8; ++d0)
#pragma unroll
    for (int j = 0; j < 8; ++j) qn += bf2f((unsigned short)qr[d0][j]) * vn[d0 * 16 + hi * 8 + j];
  qn = half_swap_sum(qn);
  asm volatile("" : "+v"(qn));
  SBAR();
  f32x16 o[4] = {};
  {
    const int vbc = (int)(uintptr_t)(lds + (dir ? PC_CB : PC_CF)) + v_rd_base(lane);
    pv_d0(o, vbc, qr[0], qr[1], qr[2], qr[3]);
    pv_d0(o, vbc + 16384, qr[4], qr[5], qr[6], qr[7]);
  }
#pragma unroll
  for (int d = 0; d < 4; ++d)
#pragma unroll
    for (int r = 0; r < 16; ++r) o[d][r] *= va_[tb * 32 + crow(r, hi)];
  SBAR();
  const float Mt = vec[256 + dir * 128 + t], at = va_[t], flt = vec[768 + dir * 128 + t];
  float rsum = 0.f;
  const int vbv = (int)(uintptr_t)(lds + PC_V) + v_rd_base(lane);
#pragma unroll
  for (int kt = 0; kt < 2; ++kt) {
    const bool need = dir == 0 ? (kt * 64 <= tb * 32 + 31) : (kt * 64 + 63 >= tb * 32);
    if (need) {
      f32x16 p0, p1; qkt8(p0, p1, lds + PC_K + kt * 16384, qr, r32, hi);
#pragma unroll
      for (int r = 0; r < 16; ++r) {
        const int s0 = kt * 64 + crow(r, hi), s1 = s0 + 32;
        const bool ok0 = dir == 0 ? (s0 <= t) : (s0 >= t), ok1 = dir == 0 ? (s1 <= t) : (s1 >= t);
        const float w0 = __builtin_amdgcn_exp2f(vcol[s0] - Mt), w1 = __builtin_amdgcn_exp2f(vcol[s1] - Mt);
        p0[r] = ok0 ? p0[r] * w0 : 0.f; p1[r] = ok1 ? p1[r] * w1 : 0.f;
        rsum += p0[r] + p1[r];
      }
      bf16x8 pa0, pa1, pa2, pa3; pack_p(p0, p1, pa0, pa1, pa2, pa3);
      pv_d0(o, vbv + kt * 16384, pa0, pa1, pa2, pa3);
    }
  }
  rsum = half_swap_sum(rsum);
  {
    const float den = at * qn + rsum, dn = fmaxf(fabsf(den), flt);
    LAS float* rd = vec + 1280 + dir * 128;
    if (hi == 0) rd[t] = 1.f / dn;
    asm volatile("s_waitcnt lgkmcnt(0)" ::: "memory");
#pragma unroll
    for (int d = 0; d < 4; ++d)
#pragma unroll
      for (int r = 0; r < 16; ++r) o[d][r] *= rd[tb * 32 + crow(r, hi)];
  }
  __syncthreads();
  {
    LAS float* hst = (LAS float*)(lds + dir * 65536);
#pragma unroll
    for (int r = 0; r < 16; ++r) { const int tr = tb * 32 + crow(r, hi);
#pragma unroll
      for (int d = 0; d < 4; ++d) hst[tr * 128 + d * 32 + r32] = o[d][r]; }
  }
  __syncthreads();
  {
    const int rg = tid >> 5, cl = tid & 31;
    const f32x4 g = *(const f32x4*)(karg<A_MHG>() + h * 128 + 4 * cl);
    u32x2 sgv[8];
#pragma unroll
    for (int ps = 0; ps < 8; ++ps) sgv[ps] = *(const u32x2*)(hcat + (size_t)(row0 + ps * 16 + rg) * 1024 + h * 128 + 4 * cl);
#pragma unroll
    for (int ps = 0; ps < 8; ++ps) {
      const int tr = ps * 16 + rg;
      const f32x4 xf = *(const LAS f32x4*)(lds + (tr * 128 + 4 * cl) * 4), xb = *(const LAS f32x4*)(lds + 65536 + (tr * 128 + 4 * cl) * 4);
      f32x4 x = xf + xb;
      float s = (x[0] + x[1]) + (x[2] + x[3]);
#pragma unroll
      for (int o_ = 1; o_ < 32; o_ <<= 1) s += __shfl_xor(s, o_);
      const float mu = s * (1.f / 128.f); x = x - mu;
      float q = (x[0] * x[0] + x[1] * x[1]) + (x[2] * x[2] + x[3] * x[3]);
#pragma unroll
      for (int o_ = 1; o_ < 32; o_ <<= 1) q += __shfl_xor(q, o_);
      const float rstd = rsqrtf(q * (1.f / 128.f) + LN_EPS);
      u32x2* dst = (u32x2*)(hcat + (size_t)(row0 + tr) * 1024 + h * 128 + 4 * cl);
      const u32x2 sg = sgv[ps];
      const f32x4 y = x * rstd * g;
      if (DRY) dst = (u32x2*)((bf16_t*)(ws + WS_QKPRE) + (size_t)(row0 + tr) * 1024 + h * 128 + 4 * cl);
      *dst = (u32x2){cvtpk(y[0] * bflo(sg[0]), y[1] * bfhi(sg[0])), cvtpk(y[2] * bflo(sg[1]), y[3] * bfhi(sg[1]))};
    }
  }
  __syncthreads();
}

template <bool DRY = false> DI void phase_hanorm(const Ctx& p, int bid, int G) {
  const int tid = tid_fresh(), lane = tid & 63, wave = tid >> 6; bf16_t* hcat = (bf16_t*)(p.ws + WS_H);
  const f32x4 g0 = *(const f32x4*)(karg<A_ANG>() + 8 * lane), g1 = *(const f32x4*)(karg<A_ANG>() + 8 * lane + 4);
  u32x4 wn = {0u, 0u, 0u, 0u};
  { const int row = bid * 8 + wave; if (row < T) wn = *(const u32x4*)(hcat + (size_t)row * 1024 + 512 + 8 * lane); }
  for (int row = bid * 8 + wave; row < T; row += G * 8) {
    u32x4* ptr = (u32x4*)(hcat + (size_t)row * 1024 + 512 + 8 * lane);
    const u32x4 w = wn;
    if (row + G * 8 < T) wn = *(const u32x4*)(hcat + (size_t)(row + G * 8) * 1024 + 512 + 8 * lane);
    float v[8] = {bflo(w[0]), bfhi(w[0]), bflo(w[1]), bfhi(w[1]), bflo(w[2]), bfhi(w[2]), bflo(w[3]), bfhi(w[3])};
    float s = 0.f;
#pragma unroll
    for (int e = 0; e < 8; ++e) s += v[e] * v[e];
    const float rs = rsqrtf(wave_sum(s) * (1.f / 512.f) + RMS_EPS);
    if (DRY) ptr = (u32x4*)((bf16_t*)(p.ws + WS_QKPRE) + (size_t)row * 1024 + 512 + 8 * lane);
    *ptr = (u32x4){cvtpk(v[0] * rs * g0[0], v[1] * rs * g0[1]), cvtpk(v[2] * rs * g0[2], v[3] * rs * g0[3]), cvtpk(v[4] * rs * g1[0], v[5] * rs * g1[1]), cvtpk(v[6] * rs * g1[2], v[7] * rs * g1[3])};
  }
}

template <bool DRY = false> DI void phase_route(const Ctx& p, int bid, int G, LAS unsigned char* lds) {
  const int tid = tid_fresh(), lane = tid & 63, wave = tid >> 6; unsigned char* ws = p.ws;
  LAS float* wreT = (LAS float*)lds;
  LAS float* wrgT = (LAS float*)(lds + 131072);
  LAS int* rec = (LAS int*)(lds + 147456);
  LAS int* lcnt = (LAS int*)(lds + 147456 + 2048);
  { const f32x4* wrt = (const f32x4*)(ws + WS_WRT);
    for (int i = tid; i < 36 * 256; i += NTHREADS) ((LAS f32x4*)lds)[i] = wrt[i]; }
  const float* ln1_g = karg<A_LN1G>(); const float* ln1_b = karg<A_LN1B>(); const float* b_rg = karg<A_BRG>(); const float* b_re = karg<A_BRE>();
  const float* mod = (const float*)(ws + WS_MOD); bf16_t* U = (bf16_t*)(ws + WS_U);
  int* cnt = (int*)(ws + WS_CNT) + (DRY ? 32 * CNT_STRIDE : 0);
  int* ltok = (int*)(ws + (DRY ? WS_HDN : WS_LTOK)); float* lw = (float*)(ws + (DRY ? WS_HDN + 8 * MiB : WS_LW));
  int* toke = (int*)(ws + WS_TOKE) + (DRY ? 2 * T : 0); int* tokp = (int*)(ws + WS_TOKP) + (DRY ? 2 * T : 0);
  const int nk = T / (G * 8);
  for (int k0 = 0; k0 < nk; k0 += 16) {
    if (tid < 32) lcnt[tid] = 0;
    __syncthreads();
    u32x2 zn[4];
    { const u32x2* zr = (const u32x2*)((const bf16_t*)p.out + (size_t)(bid * 8 + wave + k0 * G * 8) * 1024) + lane;
#pragma unroll
      for (int j = 0; j < 4; ++j) zn[j] = zr[64 * j]; }
    for (int kk = 0; kk < 16 && k0 + kk < nk; ++kk) {
      const int row = bid * 8 + wave + (k0 + kk) * G * 8, b = row >> 14;
      u32x2* x1r = (u32x2*)((bf16_t*)(ws + (DRY ? 384 * MiB : WS_H)) + (size_t)row * 1024) + lane;
      f32x4 v[4]; float s = 0.f;
#pragma unroll
      for (int j = 0; j < 4; ++j) { const u32x2 raw = zn[j]; v[j] = (f32x4){bflo(raw[0]), bfhi(raw[0]), bflo(raw[1]), bfhi(raw[1])}; s += (v[j][0] + v[j][1]) + (v[j][2] + v[j][3]); }
      if (kk + 1 < 16 && k0 + kk + 1 < nk) { const u32x2* zr = (const u32x2*)((const bf16_t*)p.out + (size_t)(row + G * 8) * 1024) + lane;
#pragma unroll
        for (int j = 0; j < 4; ++j) zn[j] = zr[64 * j]; }
      float mean = wave_sum(s) * (1.f / 1024.f), s2 = 0.f;
#pragma unroll
      for (int j = 0; j < 4; ++j) { v[j] = v[j] - mean; s2 += (v[j][0] * v[j][0] + v[j][1] * v[j][1]) + (v[j][2] * v[j][2] + v[j][3] * v[j][3]); }
      float rstd = rsqrtf(wave_sum(s2) * (1.f / 1024.f) + LN_EPS);
      s = 0.f;
#pragma unroll
      for (int j = 0; j < 4; ++j) { const int col = 4 * lane + 256 * j;
        v[j] = v[j] * rstd * *(const f32x4*)(ln1_g + col) + *(const f32x4*)(ln1_b + col);
        x1r[64 * j] = (u32x2){cvtpk(v[j][0], v[j][1]), cvtpk(v[j][2], v[j][3])};
        s += (v[j][0] + v[j][1]) + (v[j][2] + v[j][3]); }
      mean = wave_sum(s) * (1.f / 1024.f); s2 = 0.f;
#pragma unroll
      for (int j = 0; j < 4; ++j) { v[j] = v[j] - mean; s2 += (v[j][0] * v[j][0] + v[j][1] * v[j][1]) + (v[j][2] * v[j][2] + v[j][3] * v[j][3]); }
      rstd = rsqrtf(wave_sum(s2) * (1.f / 1024.f) + LN_EPS);
      u32x2* o8 = (u32x2*)(U + (size_t)row * 1024) + lane;
      float gl[4] = {0.f, 0.f, 0.f, 0.f};
#pragma unroll
      for (int j = 0; j < 4; ++j) { const int col = 4 * lane + 256 * j;
        v[j] = v[j] * rstd * (*(const f32x4*)(mod + b * 6144 + 4096 + col) + 1.f) + *(const f32x4*)(mod + b * 6144 + 3072 + col);
        o8[64 * j] = (u32x2){cvtpk(v[j][0], v[j][1]), cvtpk(v[j][2], v[j][3])};
#pragma unroll
        for (int e = 0; e < 4; ++e) { const f32x4 w = *(const LAS f32x4*)(wrgT + e * 1024 + col); gl[e] += v[j][0] * w[0] + v[j][1] * w[1] + v[j][2] * w[2] + v[j][3] * w[3]; } }
#pragma unroll
      for (int e = 0; e < 4; ++e) gl[e] = wave_sum(gl[e]) + b_rg[e];
      int gi = 0; float gm = gl[0];
#pragma unroll
      for (int e = 1; e < 4; ++e) if (gl[e] > gm) { gm = gl[e]; gi = e; }
      float gs = 0.f;
#pragma unroll
      for (int e = 0; e < 4; ++e) gs += __expf(gl[e] - gm);
      const float gw = 1.f / gs;
      float el[8] = {0.f, 0.f, 0.f, 0.f, 0.f, 0.f, 0.f, 0.f};
#pragma unroll
      for (int j = 0; j < 4; ++j) { const int col = 4 * lane + 256 * j;
#pragma unroll
        for (int e = 0; e < 8; ++e) { const f32x4 w = *(const LAS f32x4*)(wreT + (gi * 8 + e) * 1024 + col); el[e] += v[j][0] * w[0] + v[j][1] * w[1] + v[j][2] * w[2] + v[j][3] * w[3]; } }
#pragma unroll
      for (int e = 0; e < 8; ++e) el[e] = wave_sum(el[e]) + b_re[gi * 8 + e];
      int i1 = 0; float v1 = el[0];
#pragma unroll
      for (int e = 1; e < 8; ++e) if (el[e] > v1) { v1 = el[e]; i1 = e; }
      int i2 = (i1 == 0) ? 1 : 0; float v2 = (i1 == 0) ? el[1] : el[0];
#pragma unroll
      for (int e = 0; e < 8; ++e) if (e != i1 && el[e] > v2) { v2 = el[e]; i2 = e; }
      const float p1 = 1.f / (1.f + __expf(v2 - v1)), p2 = 1.f - p1;
      if (lane == 0) {
        const int e1 = gi * 8 + i1, e2 = gi * 8 + i2, li = kk * 8 + wave;
        const int q1 = __hip_atomic_fetch_add(&lcnt[e1], 1, __ATOMIC_RELAXED, __HIP_MEMORY_SCOPE_WORKGROUP), q2 = __hip_atomic_fetch_add(&lcnt[e2], 1, __ATOMIC_RELAXED, __HIP_MEMORY_SCOPE_WORKGROUP);
        rec[li * 4 + 0] = e1 | (e2 << 8); rec[li * 4 + 1] = q1 | (q2 << 16); rec[li * 4 + 2] = __float_as_int(p1 * gw); rec[li * 4 + 3] = __float_as_int(p2 * gw);
      }
    }
    __syncthreads();
    if (tid < 32) { const int n = lcnt[tid]; lcnt[32 + tid] = n ? atomicAdd(&cnt[tid * CNT_STRIDE], n) : 0; }
    __syncthreads();
    if (tid < 128 && k0 + (tid >> 3) < nk) {
      const int li = tid, row = bid * 8 + (li & 7) + (k0 + (li >> 3)) * G * 8;
      const int ee = rec[li * 4], qq = rec[li * 4 + 1], e1 = ee & 255, e2 = ee >> 8, q1 = lcnt[32 + e1] + (qq & 0xffff), q2 = lcnt[32 + e2] + (qq >> 16);
      ltok[(size_t)e1 * T + q1] = row; lw[(size_t)e1 * T + q1] = __int_as_float(rec[li * 4 + 2]);
      ltok[(size_t)e2 * T + q2] = row; lw[(size_t)e2 * T + q2] = __int_as_float(rec[li * 4 + 3]);
      toke[row * 2] = e1; toke[row * 2 + 1] = e2; tokp[row * 2] = q1; tokp[row * 2 + 1] = q2;
    }
    __syncthreads();
  }
}

constexpr int MOE_TS = 131072;
DI void moe_table(const Ctx& p, LAS unsigned char* lds) {
  LAS int* ts = (LAS int*)(lds + MOE_TS); const int* cnt = (const int*)(p.ws + WS_CNT);
  if (threadIdx.x < 64) {
    const int lane = threadIdx.x; const int n = lane < 32 ? (cnt[lane * CNT_STRIDE] + 255) >> 8 : 0; int a = n;
#pragma unroll
    for (int o = 1; o < 32; o <<= 1) { const int t = __shfl_up(a, o); a += lane >= o ? t : 0; }
    if (lane < 32) ts[lane] = a - n;
    if (lane == 31) ts[32] = a;
  }
  __syncthreads();
}

template <bool DRY = false> DI void phase_final(const Ctx& p, int bid, int G, LAS unsigned char* lds) {
  const int tid = tid_fresh(), lane = tid & 63, wave = tid >> 6; unsigned char* ws = p.ws;
  const LAS int* ts = (const LAS int*)(lds + MOE_TS); const float* ln2_g = karg<A_LN2G>(); const float* ln2_b = karg<A_LN2B>();
  const float* mod = (const float*)(ws + WS_MOD); const bf16_t* ybuf = (const bf16_t*)(ws + WS_YBUF); const int* toke = (const int*)(ws + WS_TOKE); const int* tokp = (const int*)(ws + WS_TOKP);
  const int stride = G * 8; int row = bid * 8 + wave;
  size_t s0n = 0, s1n = 0;
  u32x2 an[4], cn[4], xn[4];
  auto slots = [&](int r, size_t& a, size_t& c) { a = (size_t)ts[toke[r * 2]] * 256 + tokp[r * 2]; c = (size_t)ts[toke[r * 2 + 1]] * 256 + tokp[r * 2 + 1]; };
  auto loadrow = [&](int r, size_t a, size_t c) {
    const u32x2* x1r = (const u32x2*)((const bf16_t*)(ws + WS_H) + (size_t)r * 1024) + lane;
    const u32x2* y0 = (const u32x2*)(ybuf + a * 1024) + lane; const u32x2* y1 = (const u32x2*)(ybuf + c * 1024) + lane;
#pragma unroll
    for (int j = 0; j < 4; ++j) { an[j] = y0[64 * j]; cn[j] = y1[64 * j]; xn[j] = x1r[64 * j]; } };
  if (row < T) { size_t a, c; slots(row, a, c); loadrow(row, a, c); if (row + stride < T) slots(row + stride, s0n, s1n); }
  for (; row < T; row += stride) {
    const int b = row >> 14;
    f32x4 v[4]; float s = 0.f;
#pragma unroll
    for (int j = 0; j < 4; ++j) { const int col = 4 * lane + 256 * j;
      const u32x2 a = an[j], c = cn[j], xw = xn[j];
      const f32x4 y = {bflo(a[0]) + bflo(c[0]), bfhi(a[0]) + bfhi(c[0]), bflo(a[1]) + bflo(c[1]), bfhi(a[1]) + bfhi(c[1])};
      const f32x4 x1v = {bflo(xw[0]), bfhi(xw[0]), bflo(xw[1]), bfhi(xw[1])};
      v[j] = x1v * ALPHA + (*(const f32x4*)(mod + b * 6144 + 5120 + col) + 1.f) * y;
      s += (v[j][0] + v[j][1]) + (v[j][2] + v[j][3]); }
    if (row + stride < T) { loadrow(row + stride, s0n, s1n); if (row + 2 * stride < T) slots(row + 2 * stride, s0n, s1n); }
    const float mean = wave_sum(s) * (1.f / 1024.f); float s2 = 0.f;
#pragma unroll
    for (int j = 0; j < 4; ++j) { v[j] = v[j] - mean; s2 += (v[j][0] * v[j][0] + v[j][1] * v[j][1]) + (v[j][2] * v[j][2] + v[j][3] * v[j][3]); }
    const float rstd = rsqrtf(wave_sum(s2) * (1.f / 1024.f) + LN_EPS);
    f32x4* xr = (f32x4*)(p.out + (size_t)row * 1024) + lane;
#pragma unroll
    for (int j = 0; j < 4; ++j) { const int col = 4 * lane + 256 * j; xr[64 * j] = v[j] * rstd * *(const f32x4*)(ln2_g + col) + *(const f32x4*)(ln2_b + col); }
  }
}


#define XB_TMO      128
#define XB_XCNT(j)  (256  + 64 * (j))
#define XB_XSUB(j)  (1280 + 64 * (j))
#define XB_XGEN(j)  (2304 + 64 * (j))
#define XB_TOP      3328
#define XB_TOPGEN   3392
#define XCD_BAR_WORDS 3456
#define XB_SPIN_CAP (1u << 18)
DI unsigned xb_ld(unsigned* p)              { return __hip_atomic_load(p, __ATOMIC_RELAXED, __HIP_MEMORY_SCOPE_AGENT); }
DI unsigned xb_add(unsigned* p, unsigned v) { return __hip_atomic_fetch_add(p, v, __ATOMIC_RELAXED, __HIP_MEMORY_SCOPE_AGENT); }
DI unsigned xb_xcc_id() { return (unsigned)__builtin_amdgcn_s_getreg((3 << 11) | 20) & 0xFu; }
#define XB_SPIN(cond, bar) do { unsigned _sp = 0; while (cond) { __builtin_amdgcn_s_sleep(1); \
    if ((++_sp & 255u) == 0u) { if (xb_ld(&(bar)[XB_TMO])) break; if (_sp > XB_SPIN_CAP) { atomicAdd(&(bar)[XB_TMO], 1u); break; } } } } while (0)
struct XcdBarrier { unsigned* bar; unsigned x; volatile LAS unsigned* st; };
DI XcdBarrier xcd_barrier_post(unsigned* bar, volatile LAS unsigned* st) {
  XcdBarrier b; b.bar = bar; b.x = xb_xcc_id(); b.st = st;
  if (threadIdx.x == 0) (void)xb_add(&bar[XB_XCNT(b.x)], 1u);
  return b;
}
DI void xcd_barrier_complete(unsigned* bar, unsigned x, unsigned& nloc, unsigned& nx) {
  const unsigned G = gridDim.x * gridDim.y * gridDim.z;
  unsigned sum, cnt, mine, sp = 0u;
  for (;;) {
    sum = 0u; cnt = 0u; mine = 0u;
#pragma unroll
    for (unsigned j = 0; j < 16; ++j) { const unsigned c = xb_ld(&bar[XB_XCNT(j)]); sum += c; cnt += (c > 0u) ? 1u : 0u; mine = (j == x) ? c : mine; }
    if (sum == G) break;
    __builtin_amdgcn_s_sleep(1);
    if ((++sp & 255u) == 0u) { if (xb_ld(&bar[XB_TMO])) break; if (sp > XB_SPIN_CAP) { atomicAdd(&bar[XB_TMO], 1u); break; } }
  }
  nloc = mine > 0u ? mine : 1u; nx = cnt > 0u ? cnt : 1u;
}
DI void xcd_barrier(const XcdBarrier& b) {
  asm volatile("s_waitcnt vmcnt(0)" ::: "memory");
  __syncthreads();
  if (threadIdx.x == 0) {
    unsigned* bar = b.bar;
    __builtin_amdgcn_s_waitcnt(0);
    unsigned nloc = b.st[0], nx = b.st[1];
    if (nloc == 0u) { xcd_barrier_complete(bar, b.x, nloc, nx); b.st[0] = nloc; b.st[1] = nx; }
    const unsigned old = xb_add(&bar[XB_XSUB(b.x)], 1u);
    const unsigned gen = old / nloc;
    if (old + 1u == (gen + 1u) * nloc) {
      __builtin_amdgcn_fence(__ATOMIC_RELEASE, "agent");
      asm volatile("s_waitcnt vmcnt(0)" ::: "memory");
      const unsigned og = xb_add(&bar[XB_TOP], 1u);
      const unsigned tg = og / nx;
      if (og + 1u == (tg + 1u) * nx) xb_add(&bar[XB_TOPGEN], 1u);
      else XB_SPIN(xb_ld(&bar[XB_TOPGEN]) == tg, bar);
      __builtin_amdgcn_fence(__ATOMIC_ACQUIRE, "agent");
      xb_add(&bar[XB_XGEN(b.x)], 1u);
      asm volatile("s_waitcnt vmcnt(0)" ::: "memory");
    } else {
      XB_SPIN(xb_ld(&bar[XB_XGEN(b.x)]) == gen, bar);
      __builtin_amdgcn_fence(__ATOMIC_ACQUIRE, "agent");
      asm volatile("s_waitcnt vmcnt(0)" ::: "memory");
    }
  }
  __syncthreads();
}

__device__ unsigned g_bar_counter = 0;
DI void grid_barrier(const unsigned G) {
  asm volatile("s_waitcnt vmcnt(0)" ::: "memory");
  __syncthreads();
  if (threadIdx.x == 0) {
    __builtin_amdgcn_fence(__ATOMIC_RELEASE, "agent");
    asm volatile("s_waitcnt vmcnt(0)" ::: "memory");
    const unsigned old = __hip_atomic_fetch_add(&g_bar_counter, 1u, __ATOMIC_RELAXED, __HIP_MEMORY_SCOPE_AGENT);
    const unsigned target = (old / G + 1u) * G;
    unsigned sp = 0;
    while ((int)(__hip_atomic_load(&g_bar_counter, __ATOMIC_RELAXED, __HIP_MEMORY_SCOPE_AGENT) - target) < 0) { __builtin_amdgcn_s_sleep(1); if (++sp > (1u << 24)) break; }
    __builtin_amdgcn_fence(__ATOMIC_ACQUIRE, "agent");
    asm volatile("s_waitcnt vmcnt(0)" ::: "memory");
  }
  __syncthreads();
}

#define KERNEL_HEAD extern __shared__ __attribute__((aligned(16))) unsigned char lds_raw[]; LAS unsigned char* lds = (LAS unsigned char*)lds_raw; const int bid = blockIdx.x, G = gridDim.x; \
  Ctx p; p.ws = karg<A_WS, unsigned char>(); p.out = karg<A_OUT, float>();
#ifdef MULTI_LAUNCH
__global__ void __launch_bounds__(NTHREADS, 2) k_prep(Params) { KERNEL_HEAD phase_prep(p, bid, G, lds); }
__global__ void __launch_bounds__(NTHREADS, 2) k_lnmod(Params) { KERNEL_HEAD (void)lds; phase_lnmod(p, bid, G); }
__global__ void __launch_bounds__(NTHREADS, 2) k_inproj(Params) { KERNEL_HEAD
  unsigned char* ws = p.ws;
  g8::DenseOrder S; S.init(T, N_INP, 1024, ws + WS_WIN, G, bid);
  EpiIn E{(bf16_t*)(ws + WS_QKPRE), (bf16_t*)(ws + WS_VM), (bf16_t*)(ws + WS_H), (bf16_t*)(ws + WS_CQ), (bf16_t*)(ws + WS_CKV), (unsigned char*)(ws + WS_KN), (float*)(ws + WS_GATES),
          (float*)(ws + WS_SSQQ), (float*)(ws + WS_SSQKV), (const float*)(ws + WS_ROPE), karg<A_GATEB>()};
  g8::gemm_phase(lds, (const char*)(ws + WS_U), 1024, S, E);
}
__global__ void __launch_bounds__(NTHREADS, 2) k_mid1(Params) { KERNEL_HEAD
  unsigned char* ws = p.ws;
  { g8::DenseOrder S; S.init(T, 768, 384, ws + WS_WUQ, G, bid); EpiUQ E{(unsigned char*)(ws + WS_QATT), (const float*)(ws + WS_SSQQ), (const float*)(ws + WS_ROPE)};
    g8::gemm_phase(lds, (const char*)(ws + WS_CQ), 384, S, E); }
}
__global__ void __launch_bounds__(NTHREADS, 2) k_mid2(Params) { KERNEL_HEAD
  unsigned char* ws = p.ws;
  { g8::DenseOrder S; S.init(T, 1024, 256, ws + WS_WUKV, G, bid); EpiUKV E{(unsigned char*)(ws + WS_KN), (unsigned char*)(ws + WS_VA), (const float*)(ws + WS_SSQKV)};
    g8::gemm_phase(lds, (const char*)(ws + WS_CKV), 256, S, E); }
}
__global__ void __launch_bounds__(NTHREADS, 2) k_mid3(Params) { KERNEL_HEAD
  for (int u = bid; u < 1024; u += G) { const int c = u & 127, bh = u >> 7; mlstmA_unit(p, bh >> 2, bh & 3, c, lds); }
}
__global__ void __launch_bounds__(NTHREADS, 2) k_scan_attn(Params) { KERNEL_HEAD phase_scan(p, bid, G); phase_attn(p, bid, G, lds); }
__global__ void __launch_bounds__(NTHREADS, 2) k_mlstm_out(Params) { KERNEL_HEAD
  for (int u = bid; u < 1024; u += G) { const int c = u & 127, bh = u >> 7; mlstmC_unit(p, bh >> 2, bh & 3, c, lds); }
  phase_hanorm(p, bid, G);
}
__global__ void __launch_bounds__(NTHREADS, 2) k_outproj(Params) { KERNEL_HEAD
  unsigned char* ws = p.ws;
  g8::DenseOrder S; S.init(T, 1024, 1024, ws + WS_WOUT, G, bid); EpiOut E{karg<A_X>(), (const float*)(ws + WS_MOD), (bf16_t*)p.out};
  g8::gemm_phase(lds, (const char*)(ws + WS_H), 1024, S, E);
}
__global__ void __launch_bounds__(NTHREADS, 2) k_route(Params) { KERNEL_HEAD phase_route(p, bid, G, lds); }
__global__ void __launch_bounds__(NTHREADS, 2) k_moe_gu(Params) { KERNEL_HEAD
  unsigned char* ws = p.ws; moe_table(p, lds);
  MoeOrderGU S; S.tstart = (const LAS int*)(lds + MOE_TS); S.cnt = (const int*)(ws + WS_CNT); S.G = G; S.c = bid; S.ltok = (const int*)(ws + WS_LTOK); S.Bt = (const char*)(ws + WS_WGU);
  EpiGU E{(bf16_t*)(ws + WS_HDN)};
  g8::gemm_phase(lds, (const char*)(ws + WS_U), 1024, S, E);
}
__global__ void __launch_bounds__(NTHREADS, 2) k_moe_dn(Params) { KERNEL_HEAD
  unsigned char* ws = p.ws; moe_table(p, lds);
  MoeOrderDN S; S.tstart = (const LAS int*)(lds + MOE_TS); S.cnt = (const int*)(ws + WS_CNT); S.G = G; S.c = bid; S.Bt = (const char*)(ws + WS_WDN);
  EpiDN E{(bf16_t*)(ws + WS_YBUF), (const float*)(ws + WS_LW)};
  g8::gemm_phase(lds, (const char*)(ws + WS_HDN), 512, S, E);
}
__global__ void __launch_bounds__(NTHREADS, 2) k_final(Params) { KERNEL_HEAD moe_table(p, lds); phase_final(p, bid, G, lds); }

#endif

__global__ void __launch_bounds__(NTHREADS, 2) k_mega(Params) { KERNEL_HEAD
  unsigned char* ws = p.ws;
  if (bid == 0) for (int i = threadIdx.x; i < XCD_BAR_WORDS; i += NTHREADS) ((unsigned*)(ws + WS_BAR))[i] = 0u;
  if (threadIdx.x < 64) ((LAS unsigned*)(lds + LDS_BARST))[threadIdx.x] = 0u;
  XcdBarrier xbar; xbar.bar = (unsigned*)(ws + WS_BAR); xbar.x = 0; xbar.st = (volatile LAS unsigned*)(lds + LDS_BARST);
  bool xb_ready = false;
#define PHASE_SEP() do { asm volatile("" ::: "memory"); if (!xb_ready) { grid_barrier((unsigned)G); xbar = xcd_barrier_post((unsigned*)(ws + WS_BAR), (volatile LAS unsigned*)(lds + LDS_BARST)); xb_ready = true; } \
    else xcd_barrier(xbar); asm volatile("" ::: "memory"); } while (0)
#define REP(n) for (int rep_ = 0; rep_ < ((n) == DBL_PHASE ? 2 : 1); ++rep_)
  REP(0) phase_prep(p, bid, G, lds);
  PHASE_SEP();
#if MEGA_STOP == 1
  return;
#endif
  REP(1) phase_lnmod(p, bid, G);
  PHASE_SEP();
#if MEGA_STOP == 2
  return;
#endif
  REP(2) { g8::DenseOrder S; S.init(T, N_INP, 1024, ws + WS_WIN, G, bid);
    EpiIn E{(bf16_t*)(ws + WS_QKPRE), (bf16_t*)(ws + WS_VM), (bf16_t*)(ws + WS_H), (bf16_t*)(ws + WS_CQ), (bf16_t*)(ws + WS_CKV), (unsigned char*)(ws + WS_KN), (float*)(ws + WS_GATES),
            (float*)(ws + WS_SSQQ), (float*)(ws + WS_SSQKV), (const float*)(ws + WS_ROPE), karg<A_GATEB>()};
    g8::gemm_phase(lds, (const char*)(ws + WS_U), 1024, S, E);
    { const int first = S.nwg % G, nb = G - first;
      if (bid >= first) { const int tid = tid_fresh(), lane = tid & 63, wave = __builtin_amdgcn_readfirstlane(tid >> 6);
        prep_items(PREP_ITEMS - PREP_DEFER + (bid - first) * 8 + wave, PREP_ITEMS, nb * 8, lane, ws, (LAS float*)(lds + wave * 16384)); } } }
  PHASE_SEP();
#if MEGA_STOP == 3
  return;
#endif
  REP(3) { REP(31) { g8::DenseOrder S; S.init(T, 768, 384, ws + WS_WUQ, G, bid); EpiUQ E{(unsigned char*)(ws + WS_QATT), (const float*)(ws + WS_SSQQ), (const float*)(ws + WS_ROPE)};
    g8::gemm_phase(lds, (const char*)(ws + WS_CQ), 384, S, E); }
  __syncthreads();
  REP(32) { g8::DenseOrder S; S.init(T, 1024, 256, ws + WS_WUKV, G, bid); EpiUKV E{(unsigned char*)(ws + WS_KN), (unsigned char*)(ws + WS_VA), (const float*)(ws + WS_SSQKV)};
    g8::gemm_phase(lds, (const char*)(ws + WS_CKV), 256, S, E); }
  __syncthreads();
  REP(33) for (int u = bid; u < 1024; u += G) { const int c = u & 127, bh = u >> 7; mlstmA_unit(p, bh >> 2, bh & 3, c, lds); } }
  { const int first = 384 % G, nb = G - first;
    if (bid >= first) { const int tid = tid_fresh(), lane = tid & 63, wave = __builtin_amdgcn_readfirstlane(tid >> 6);
      __syncthreads();
      prep_items(PREP_ITEMS - PREP_DEFER - PREP_DEFER_B + (bid - first) * 8 + wave, PREP_ITEMS - PREP_DEFER, nb * 8, lane, ws, (LAS float*)(lds + wave * 16384)); } }
  PHASE_SEP();
#if MEGA_STOP == 4
  return;
#endif
  phase_scan(p, bid, G);
  REP(4) phase_attn(p, bid, G, lds);
  PHASE_SEP();
#if MEGA_STOP == 5
  return;
#endif
#if DBL_PHASE == 5
  for (int u = bid; u < 1024; u += G) { const int c = u & 127, bh = u >> 7; mlstmC_unit<true>(p, bh >> 2, bh & 3, c, lds); }
#endif
#if DBL_PHASE == 55
  phase_hanorm<true>(p, bid, G);
#endif
  for (int u = bid; u < 1024; u += G) { const int c = u & 127, bh = u >> 7; mlstmC_unit(p, bh >> 2, bh & 3, c, lds); }
  phase_hanorm(p, bid, G);
  PHASE_SEP();
#if MEGA_STOP == 6
  return;
#endif
  REP(6) { g8::DenseOrder S; S.init(T, 1024, 1024, ws + WS_WOUT, G, bid); EpiOut E{karg<A_X>(), (const float*)(ws + WS_MOD), (bf16_t*)p.out};
    g8::gemm_phase(lds, (const char*)(ws + WS_H), 1024, S, E); }
  PHASE_SEP();
#if MEGA_STOP == 7
  return;
#endif
#if DBL_PHASE == 7
  phase_route<true>(p, bid, G, lds);
#endif
  phase_route(p, bid, G, lds);
  PHASE_SEP();
#if MEGA_STOP == 8
  return;
#endif
  moe_table(p, lds);
  REP(8) { MoeOrderGU S; S.tstart = (const LAS int*)(lds + MOE_TS); S.cnt = (const int*)(ws + WS_CNT); S.G = G; S.c = bid; S.ltok = (const int*)(ws + WS_LTOK); S.Bt = (const char*)(ws + WS_WGU);
    EpiGU E{(bf16_t*)(ws + WS_HDN)};
    g8::gemm_phase(lds, (const char*)(ws + WS_U), 1024, S, E); }
  PHASE_SEP();
#if MEGA_STOP == 9
  return;
#endif
  REP(9) { MoeOrderDN S; S.tstart = (const LAS int*)(lds + MOE_TS); S.cnt = (const int*)(ws + WS_CNT); S.G = G; S.c = bid; S.Bt = (const char*)(ws + WS_WDN);
    EpiDN E{(bf16_t*)(ws + WS_YBUF), (const float*)(ws + WS_LW)};
    g8::gemm_phase(lds, (const char*)(ws + WS_HDN), 512, S, E); }
  PHASE_SEP();
#if MEGA_STOP == 10
  return;
#endif
#if DBL_PHASE == 10
  phase_final<true>(p, bid, G, lds);
#endif
  phase_final(p, bid, G, lds);
#undef REP
#undef PHASE_SEP
}

#ifdef PROBE_OFF
__global__ void __launch_bounds__(NTHREADS, 2) k_probe(Params p, size_t off, size_t n, int is_f32, int from_out) {
  const unsigned char* base = from_out ? (const unsigned char*)p.out : p.ws + off;
  for (size_t i = (size_t)blockIdx.x * NTHREADS + threadIdx.x; i < (size_t)T * D; i += (size_t)gridDim.x * NTHREADS) {
    const size_t j = i % n; float v = is_f32 ? ((const float*)base)[j] : bf2f(((const unsigned short*)base)[j]);
    if (!(fabsf(v) < 1e30f)) v = 777.f;
    if (from_out) { if (j != i) break; ((float*)p.out)[i] = v; } else p.out[i] = v;
  }
}
#endif
extern "C" void kernel_launch(void* const* d_in, const int* in_sizes, int n_in, void* d_out, int out_size, void* d_ws, size_t ws_size, hipStream_t stream) {
  static int ok = 0, grid = 256;
  typedef void (*kfn)(Params);
#ifndef MULTI_LAUNCH
  const kfn kernels[] = {k_mega};
#else
  const kfn kernels[] = {k_prep, k_lnmod, k_inproj, k_mid1, k_mid2, k_mid3, k_scan_attn, k_mlstm_out, k_outproj, k_route, k_moe_gu, k_moe_dn, k_final};
#endif
  if (ok == 0) {
    if (n_in != 27 || in_sizes[0] != T * D || out_size != T * D || ws_size < WS_END) { fprintf(stderr, "kernel_launch: unexpected shapes (n_in %d, in0 %d, out %d, ws %zu)\n", n_in, n_in > 0 ? in_sizes[0] : -1, out_size, ws_size); ok = -1; return; }
    for (kfn k : kernels) if (hipFuncSetAttribute((const void*)k, hipFuncAttributeMaxDynamicSharedMemorySize, LDS_BYTES) != hipSuccess) { fprintf(stderr, "kernel_launch: hipFuncSetAttribute failed\n"); ok = -1; return; }
    int dev = 0, cus = 0, per_cu = 0;
    if (hipGetDevice(&dev) != hipSuccess || hipDeviceGetAttribute(&cus, hipDeviceAttributeMultiprocessorCount, dev) != hipSuccess) { fprintf(stderr, "kernel_launch: device query failed\n"); ok = -1; return; }
    if (hipOccupancyMaxActiveBlocksPerMultiprocessor(&per_cu, (const void*)kernels[0], NTHREADS, LDS_BYTES) != hipSuccess || per_cu < 1) { fprintf(stderr, "kernel_launch: occupancy query says %d blocks/CU\n", per_cu); (void)hipGetLastError(); per_cu = 1; }
    grid = cus < 256 ? cus : 256;
    fprintf(stderr, "kernel_launch: %d CUs, %d blocks/CU by the occupancy query, grid %d\n", cus, per_cu, grid);
    ok = 1;
  }
  if (ok < 0) return;
  Params p{};
  p.x = (const float*)d_in[0]; p.c = (const float*)d_in[1]; p.pos = (const int*)d_in[2]; p.w_ada = (const float*)d_in[3]; p.b_ada = (const float*)d_in[4]; p.w_in = (const float*)d_in[5];
  p.conv_w = (const float*)d_in[6]; p.conv_b = (const float*)d_in[7]; p.gate_b = (const float*)d_in[8]; p.mh_g = (const float*)d_in[9]; p.qn_g = (const float*)d_in[10]; p.kvn_g = (const float*)d_in[11];
  p.w_uq = (const float*)d_in[12]; p.w_ukv = (const float*)d_in[13]; p.an_g = (const float*)d_in[14]; p.w_out = (const float*)d_in[15]; p.ln1_g = (const float*)d_in[16]; p.ln1_b = (const float*)d_in[17];
  p.w_rg = (const float*)d_in[18]; p.b_rg = (const float*)d_in[19]; p.w_re = (const float*)d_in[20]; p.b_re = (const float*)d_in[21]; p.w_gate = (const float*)d_in[22]; p.w_up = (const float*)d_in[23];
  p.w_down = (const float*)d_in[24]; p.ln2_g = (const float*)d_in[25]; p.ln2_b = (const float*)d_in[26];
  p.out = (float*)d_out; p.ws = (unsigned char*)d_ws;
#ifndef NKERN
#define NKERN 6
#endif
  { int ik = 0; for (kfn k : kernels) { if (ik++ >= NKERN) break; hipLaunchKernelGGL(k, dim3(grid), dim3(NTHREADS), LDS_BYTES, stream, p); } }
#ifdef PROBE_OFF
  hipLaunchKernelGGL(k_probe, dim3(1024), dim3(NTHREADS), 0, stream, p, (size_t)(PROBE_OFF), (size_t)(PROBE_N), PROBE_F32, 0);
#endif
  const hipError_t le = hipPeekAtLastError();
  if (le != hipSuccess) fprintf(stderr, "kernel_launch: launch failed: %s\n", hipGetErrorName(le));
}
```

```cpp
#define NKERN 99
#ifndef MEGA_STOP
#define MEGA_STOP 0
#endif
#ifndef DBL_PHASE
#define DBL_PHASE -1
#endif
#include <hip/hip_runtime.h>
#include <cstdio>
#include <cstdint>
#include <cmath>

#define DI __device__ __forceinline__
#define LAS __attribute__((address_space(3)))
typedef unsigned short bf16_t;
typedef short bf16x8 __attribute__((ext_vector_type(8)));
typedef short s16x4 __attribute__((ext_vector_type(4)));
typedef float f32x4 __attribute__((ext_vector_type(4)));
typedef float f32x2 __attribute__((ext_vector_type(2)));
typedef float f32x16 __attribute__((ext_vector_type(16)));
typedef unsigned u32x4 __attribute__((ext_vector_type(4)));
typedef unsigned u32x2 __attribute__((ext_vector_type(2)));

constexpr int BATCH = 2, SEQ = 16384, T = BATCH * SEQ, D = 1024;
constexpr int NCH = SEQ / 128;
constexpr int N_IN = 2768, N_INP = 2816;
constexpr int NEXP = 32;
constexpr float LN_EPS = 1e-5f, RMS_EPS = 1e-6f;
constexpr float ALPHA = 1.189207115002721f;
constexpr float LOG2E = 1.4426950408889634f;
constexpr float QSCALE = 0.07216878364870323f * LOG2E * 16.f;
constexpr int NTHREADS = 512;
constexpr int LDS_BYTES = 148 * 1024;

constexpr size_t MiB = 1u << 20;
constexpr size_t WS_WIN = 0, WS_WUQ = 6 * MiB, WS_WUKV = 7 * MiB, WS_WOUT = 8 * MiB, WS_WGU = 10 * MiB, WS_WDN = 74 * MiB;
constexpr size_t WS_MOD = 106 * MiB, WS_CNT = 106 * MiB + 65536, WS_ROPE = 107 * MiB, WS_GATES = 115 * MiB, WS_GVEC = 117 * MiB;
constexpr size_t WS_SSQQ = 120 * MiB, WS_SSQKV = 122 * MiB, WS_NVEC = 123 * MiB, WS_SCAL = 124 * MiB, WS_TOKE = 125 * MiB, WS_TOKP = 125 * MiB + 512 * 1024;
constexpr size_t WS_U = 128 * MiB, WS_H = 192 * MiB, WS_QKPRE = 256 * MiB, WS_VM = 320 * MiB, WS_CQ = 352 * MiB, WS_CKV = 376 * MiB;
constexpr size_t WS_KROPE = 392 * MiB, WS_QATT = 396 * MiB, WS_KN = 444 * MiB, WS_VA = 476 * MiB, WS_END = 512 * MiB;
constexpr size_t WS_BAR = 106 * MiB + 131072, CTL_ZERO_OFF = WS_CNT, CTL_ZERO_BYTES = 131072;
constexpr int LDS_BARST = LDS_BYTES - 256;
constexpr size_t WS_LTOK = 256 * MiB, WS_LW = 260 * MiB, WS_HDN = 264 * MiB, WS_YBUF = 336 * MiB;
constexpr int MAXTILES = 288;
constexpr int CNT_STRIDE = 64;
constexpr size_t WS_WRT = 126 * MiB;

struct Params {
  const float* x; const float* c; const int* pos; const float* w_ada; const float* b_ada; const float* w_in; const float* conv_w; const float* conv_b;
  const float* gate_b; const float* mh_g; const float* qn_g; const float* kvn_g; const float* w_uq; const float* w_ukv; const float* an_g; const float* w_out;
  const float* ln1_g; const float* ln1_b; const float* w_rg; const float* b_rg; const float* w_re; const float* b_re; const float* w_gate; const float* w_up;
  const float* w_down; const float* ln2_g; const float* ln2_b;
  float* out; unsigned char* ws;
};

enum { A_X = 0, A_C, A_POS, A_WADA, A_BADA, A_WIN, A_CONVW, A_CONVB, A_GATEB, A_MHG, A_QNG, A_KVNG, A_WUQ, A_WUKV, A_ANG, A_WOUT, A_LN1G, A_LN1B, A_WRG, A_BRG, A_WRE, A_BRE,
       A_WGATE, A_WUP, A_WDOWN, A_LN2G, A_LN2B, A_OUT, A_WS };
template <int IDX, class Tp = const float> __device__ __forceinline__ Tp* karg() {
  const unsigned long long k = (unsigned long long)__builtin_amdgcn_kernarg_segment_ptr();
  unsigned long long v;
  asm volatile("s_load_dwordx2 %0, %1, %2\n\ts_waitcnt lgkmcnt(0)" : "=s"(v) : "s"(k), "i"(IDX * 8) : "memory");
  return (Tp*)v;
}
struct Ctx { unsigned char* ws; float* out; };
DI unsigned cvtpk(float lo, float hi) { unsigned r; asm volatile("v_cvt_pk_bf16_f32 %0, %1, %2" : "=v"(r) : "v"(lo), "v"(hi)); return r; }
DI unsigned short f2bf(float f) { unsigned u = __float_as_uint(f); return (unsigned short)((u + 0x7fffu + ((u >> 16) & 1u)) >> 16); }
typedef int v8i __attribute__((ext_vector_type(8)));
DI u32x2 cvt8(f32x4 a, f32x4 b) {
  int w0 = __builtin_amdgcn_cvt_pk_fp8_f32(a[0], a[1], 0, false); w0 = __builtin_amdgcn_cvt_pk_fp8_f32(a[2], a[3], w0, true);
  int w1 = __builtin_amdgcn_cvt_pk_fp8_f32(b[0], b[1], 0, false); w1 = __builtin_amdgcn_cvt_pk_fp8_f32(b[2], b[3], w1, true);
  return (u32x2){(unsigned)w0, (unsigned)w1};
}
DI float bf2f(unsigned short v) { return __uint_as_float(((unsigned)v) << 16); }
DI float bflo(unsigned w) { return __uint_as_float(w << 16); }
DI float bfhi(unsigned w) { return __uint_as_float(w & 0xffff0000u); }
DI int tid_fresh() { int t = threadIdx.x; asm volatile("" : "+v"(t)); return t; }
DI float wave_sum(float v) {
#pragma unroll
  for (int o = 1; o < 64; o <<= 1) v += __shfl_xor(v, o);
  return v;
}
DI float sigmoidf_(float x) { return 1.f / (1.f + __expf(-x)); }
DI float siluf_(float x) { return x / (1.f + __expf(-x)); }
DI float logsigmoidf_(float x) { return fminf(x, 0.f) - log1pf(__expf(-fabsf(x))); }
DI int crow(int r, int hi) { return (r & 3) + 8 * (r >> 2) + 4 * hi; }
#define SBAR() __builtin_amdgcn_sched_barrier(0)
#define KSWZ(row, colB) ((row) * 256 + ((colB) ^ (((row) & 15) << 4)))
#define KRSWZ(row, colB) ((row) * 128 + ((colB) ^ ((((row) >> 1) & 7) << 4)))
#define MFMA32(a, b, c) __builtin_amdgcn_mfma_f32_32x32x16_bf16((a), (b), (c), 0, 0, 0)

DI int v_st(int k, int c) { const int kk = (k & ~0xC) | ((k & 4) << 1) | ((k & 8) >> 1); return ((kk >> 3) * 4 + (c >> 5)) * 512 + ((kk & 7) * 32 + (c & 31)) * 2; }
DI int v_rd_base(int lane) { return ((lane & 3) << 3) | (((lane >> 2) & 3) << 6) | (((lane >> 4) & 1) << 5) | (((lane >> 5) & 1) << 8); }
constexpr int v_rd_off(int d0, int ks, int half) { return d0 * 512 + ks * 4096 + half * 2048; }
template <int OFF> DI s16x4 tr_read(int vb) {
  s16x4 r; asm volatile("ds_read_b64_tr_b16 %0, %1 offset:%2" : "=&v"(r) : "v"(vb), "i"(OFF) : "memory"); return r;
}
#define PKLH(L, H) (bf16x8){L[0], L[1], L[2], L[3], H[0], H[1], H[2], H[3]}
template <int KS> DI bf16x8 tr_frag_nowait(int vb, s16x4& l, s16x4& h) { l = tr_read<v_rd_off(0, KS, 0)>(vb); h = tr_read<v_rd_off(0, KS, 1)>(vb); return PKLH(l, h); }
template <int D0> DI void pv_one(f32x16& od, int vb, bf16x8 pa0, bf16x8 pa1, bf16x8 pa2, bf16x8 pa3) {
  const s16x4 l0 = tr_read<v_rd_off(D0, 0, 0)>(vb), h0 = tr_read<v_rd_off(D0, 0, 1)>(vb), l1 = tr_read<v_rd_off(D0, 1, 0)>(vb), h1 = tr_read<v_rd_off(D0, 1, 1)>(vb);
  const s16x4 l2 = tr_read<v_rd_off(D0, 2, 0)>(vb), h2 = tr_read<v_rd_off(D0, 2, 1)>(vb), l3 = tr_read<v_rd_off(D0, 3, 0)>(vb), h3 = tr_read<v_rd_off(D0, 3, 1)>(vb);
  asm volatile("s_waitcnt lgkmcnt(0)" ::: "memory"); SBAR();
  od = MFMA32(pa0, PKLH(l0, h0), od); od = MFMA32(pa1, PKLH(l1, h1), od); od = MFMA32(pa2, PKLH(l2, h2), od); od = MFMA32(pa3, PKLH(l3, h3), od);
}
DI void pv_d0(f32x16* o, int vb, bf16x8 pa0, bf16x8 pa1, bf16x8 pa2, bf16x8 pa3) {
  pv_one<0>(o[0], vb, pa0, pa1, pa2, pa3); pv_one<1>(o[1], vb, pa0, pa1, pa2, pa3); pv_one<2>(o[2], vb, pa0, pa1, pa2, pa3); pv_one<3>(o[3], vb, pa0, pa1, pa2, pa3);
}
DI void pack_p(const f32x16& p0, const f32x16& p1, bf16x8& pa0, bf16x8& pa1, bf16x8& pa2, bf16x8& pa3) {
#define PK4(P, BASE, OUT) do { unsigned a0 = cvtpk(P[BASE + 0], P[BASE + 1]), a1 = cvtpk(P[BASE + 2], P[BASE + 3]);   \
    unsigned b0 = cvtpk(P[BASE + 4], P[BASE + 5]), b1 = cvtpk(P[BASE + 6], P[BASE + 7]);                              \
    auto r0 = __builtin_amdgcn_permlane32_swap(a0, b0, false, false); auto r1 = __builtin_amdgcn_permlane32_swap(a1, b1, false, false); \
    u32x4 w = {r0[0], r1[0], r0[1], r1[1]}; OUT = *reinterpret_cast<bf16x8*>(&w); } while (0)
  PK4(p0, 0, pa0); PK4(p0, 8, pa1); PK4(p1, 0, pa2); PK4(p1, 8, pa3);
#undef PK4
}
DI float half_swap_sum(float v) { auto rr = __builtin_amdgcn_permlane32_swap(__float_as_uint(v), __float_as_uint(v), false, false); return __uint_as_float(rr[0]) + __uint_as_float(rr[1]); }
DI float half_swap_max(float v) { auto rr = __builtin_amdgcn_permlane32_swap(__float_as_uint(v), __float_as_uint(v), false, false); return fmaxf(__uint_as_float(rr[0]), __uint_as_float(rr[1])); }

namespace g8 {
constexpr int BM = 256, BK = 64, HALF = 128, HTB = HALF * BK * 2, STAGE_BYTES = 8 * HTB;
DI int lds_byte(int r, int c) { const int st = (r >> 4) * 2 + (c >> 5), rr = r & 15, cc = c & 31, ob = rr * 64 + cc * 2; return st * 1024 + (ob ^ (((ob >> 9) & 1) << 5)); }
DI void stage_rc(int b, int& R, int& C) { const int st = b / 1024, sb = b % 1024, swz = sb ^ (((sb >> 9) & 1) << 5); R = (st >> 1) * 16 + swz / 64; C = (st & 1) * 32 + (swz % 64) / 2; }
DI int perm32(int rho) { const int n = rho >> 4, i = rho & 15; return 8 * (i >> 2) + 4 * n + (i & 3); }
struct Unit { int pm, pn, e, j; };

template <class Epi, class Sched>
DI void gemm_phase(LAS unsigned char* lds, const char* Abase, const int Kc, const Sched& S, const Epi& E) {
  constexpr bool GATHER = Sched::GATHER;
  int K = Kc; asm volatile("" : "+s"(K));
  const int tid = tid_fresh(), wid = __builtin_amdgcn_readfirstlane(tid >> 6), lane = tid & 63, wr = wid >> 2, wc = wid & 3, fr = lane & 15, fq = lane >> 4;
  const int nt = K / BK;
  unsigned voffA[2], voffB[2];
#pragma unroll
  for (int i = 0; i < 2; ++i) { int R, C; stage_rc(tid * 16 + i * 8192, R, C); const int Rb = Epi::PERM ? ((R & ~31) + perm32(R & 31)) : R; voffA[i] = (unsigned)(R * K + C) * 2u; voffB[i] = (unsigned)(Rb * K + C) * 2u; }
  const size_t kstep = (size_t)(BK * 2);
  const size_t hstepB = (size_t)HALF * K * 2;
  const unsigned ldsw = (unsigned)wid * 1024u;
  const int aoff = lds_byte(wr * 64 + fr, fq * 8), boff = lds_byte(wc * 32 + fr, fq * 8);
#define G8_SA(b, h) (((b) * 2 + (h)) * HTB)
#define G8_SB(b, h) ((4 + (b) * 2 + (h)) * HTB)
#define G8_STAGEB(bufoff, gptr) do { _Pragma("unroll") for (int _i = 0; _i < 2; ++_i) \
    __builtin_amdgcn_global_load_lds((const unsigned*)((const char*)(gptr) + voffB[_i]), (LAS unsigned*)(lds + (bufoff) + ldsw + _i * 8192), 16, 0, 0); } while (0)
#define G8_STAGEA(bufoff, kb, NXT, h) do { _Pragma("unroll") for (int _i = 0; _i < 2; ++_i) { const char* _src; \
    if constexpr (GATHER) _src = Abase + (size_t)(kb) + (size_t)((NXT) ? o2[h][_i] : cuA[h][_i]); else _src = ((NXT) ? a2b : cA) + (size_t)(kb) + (size_t)(h) * hstepB + voffA[_i]; \
    __builtin_amdgcn_global_load_lds((const unsigned*)_src, (LAS unsigned*)(lds + (bufoff) + ldsw + _i * 8192), 16, 0, 0); } } while (0)
#define G8_LDA(dst, b, h) do { _Pragma("unroll") for (int m = 0; m < 4; ++m) _Pragma("unroll") for (int k = 0; k < 2; ++k) dst[m][k] = *(const LAS bf16x8*)(lds + G8_SA(b, h) + aoff + m * 2048 + k * 1024); } while (0)
#define G8_LDB(dst, b, h) do { _Pragma("unroll") for (int n = 0; n < 2; ++n) _Pragma("unroll") for (int k = 0; k < 2; ++k) dst[n][k] = *(const LAS bf16x8*)(lds + G8_SB(b, h) + boff + n * 2048 + k * 1024); } while (0)
#define G8_MMA(ai, bj, At, Bt) do { __builtin_amdgcn_s_setprio(1); _Pragma("unroll") for (int m = 0; m < 4; ++m) _Pragma("unroll") for (int n = 0; n < 2; ++n) _Pragma("unroll") for (int k = 0; k < 2; ++k) \
    acc[ai][bj][m][n] = __builtin_amdgcn_mfma_f32_16x16x32_bf16(Bt[n][k], At[m][k], acc[ai][bj][m][n], 0, 0, 0); __builtin_amdgcn_s_setprio(0); } while (0)
#define G8_WAIT_V(n) asm volatile("s_waitcnt vmcnt(" #n ")" ::: "memory")
#define G8_WAIT_L(n) asm volatile("s_waitcnt lgkmcnt(" #n ")" ::: "memory")
#define G8_BAR __builtin_amdgcn_s_barrier()
#define G8_SCHED __builtin_amdgcn_sched_barrier(0)
#define G8_GOFF(dst, u) do { _Pragma("unroll") for (int _i = 0; _i < 2; ++_i) { int _R, _C; stage_rc(tid * 16 + _i * 8192, _R, _C); \
    _Pragma("unroll") for (int _h = 0; _h < 2; ++_h) dst[_h][_i] = S.a_off(u, _R + 128 * _h) + (unsigned)_C * 2u; } } while (0)
  Unit cur, nxt; int ui = 0;
  if (!S.next(0, cur)) return;
  f32x4 acc[2][2][4][2];
#pragma unroll
  for (int a = 0; a < 2; ++a)
#pragma unroll
    for (int b = 0; b < 2; ++b)
#pragma unroll
      for (int m = 0; m < 4; ++m)
#pragma unroll
        for (int n = 0; n < 2; ++n) acc[a][b][m][n] = (f32x4){0.f, 0.f, 0.f, 0.f};
  bf16x8 At[4][2], B0[2][2], B1[2][2];
  unsigned cuA[2][2], nxA[2][2], o2[2][2];
  const char* cA = Abase; const char* nA = Abase; const char* a2b = Abase;
  if constexpr (GATHER) { G8_GOFF(cuA, cur); } else { cA = Abase + S.a_off(cur, 0); }
  const char* cB = S.b_base(cur);
  (void)voffA; (void)nxA; (void)o2; (void)nA; (void)a2b;
  G8_STAGEB(G8_SB(0, 0), cB); G8_STAGEB(G8_SB(0, 1), cB + hstepB); G8_STAGEA(G8_SA(0, 0), 0, false, 0); G8_STAGEA(G8_SA(0, 1), 0, false, 1);
  if (wr == 1) G8_BAR;
  G8_WAIT_V(2); G8_BAR;
  G8_STAGEB(G8_SB(1, 0), cB + kstep); G8_STAGEA(G8_SA(1, 0), kstep, false, 0); G8_STAGEB(G8_SB(1, 1), cB + hstepB + kstep);
  G8_WAIT_V(6); G8_BAR;
  for (;;) {
    const bool has_next = S.next(ui + 1, nxt);
    const char* nB = cB;
    if (has_next) {
      nB = S.b_base(nxt);
      if constexpr (GATHER) { G8_GOFF(nxA, nxt); } else { nA = Abase + S.a_off(nxt, 0); }
    } else {
      if constexpr (GATHER) {
#pragma unroll
        for (int h = 0; h < 2; ++h)
#pragma unroll
          for (int i = 0; i < 2; ++i) nxA[h][i] = cuA[h][i];
      } else nA = cA;
    }
    for (int t = 0; t < nt; t += 2) {
      const bool last = (t == nt - 2);
      const size_t k1 = (size_t)(t + 1) * kstep;
      const size_t k2 = last ? 0 : (size_t)(t + 2) * kstep, k3 = k2 + kstep;
      if constexpr (GATHER) {
#pragma unroll
        for (int h = 0; h < 2; ++h)
#pragma unroll
          for (int i = 0; i < 2; ++i) o2[h][i] = last ? nxA[h][i] : cuA[h][i];
      } else a2b = last ? nA : cA;
      const char* b2 = last ? nB : cB + (size_t)(t + 2) * kstep; const char* b3 = b2 + kstep;
      G8_LDB(B0, 0, 0); G8_LDB(B1, 0, 1); G8_SCHED; G8_LDA(At, 0, 0); G8_STAGEA(G8_SA(1, 1), k1, false, 1);
      G8_WAIT_V(8); G8_WAIT_L(0); G8_BAR; G8_MMA(0, 0, At, B0); G8_MMA(0, 1, At, B1); G8_BAR; G8_SCHED;
      G8_LDA(At, 0, 1); G8_STAGEB(G8_SB(0, 0), b2); G8_STAGEB(G8_SB(0, 1), b2 + hstepB); G8_STAGEA(G8_SA(0, 0), k2, true, 0);
      G8_WAIT_V(8); G8_WAIT_L(0); G8_BAR; G8_MMA(1, 0, At, B0); G8_MMA(1, 1, At, B1); G8_BAR; G8_SCHED;
      G8_LDB(B0, 1, 0); G8_LDB(B1, 1, 1); G8_SCHED; G8_LDA(At, 1, 0); G8_STAGEA(G8_SA(0, 1), k2, true, 1);
      G8_WAIT_V(8); G8_WAIT_L(0); G8_BAR; G8_MMA(0, 0, At, B0); G8_MMA(0, 1, At, B1); G8_BAR; G8_SCHED;
      G8_LDA(At, 1, 1); G8_STAGEB(G8_SB(1, 0), b3); G8_STAGEB(G8_SB(1, 1), b3 + hstepB); G8_STAGEA(G8_SA(1, 0), k3, true, 0);
      G8_WAIT_V(8); G8_WAIT_L(0); G8_BAR; G8_MMA(1, 0, At, B0); G8_MMA(1, 1, At, B1); G8_BAR; G8_SCHED;
    }
    if (wr == 0) G8_BAR;
    G8_SCHED; asm volatile("s_nop 15\n\ts_nop 7" ::: "memory"); G8_SCHED;
    E(acc, cur, wr, wc, fr, fq);
    if (!has_next) break;
#pragma unroll
    for (int a = 0; a < 2; ++a)
#pragma unroll
      for (int b = 0; b < 2; ++b)
#pragma unroll
        for (int m = 0; m < 4; ++m)
#pragma unroll
          for (int n = 0; n < 2; ++n) acc[a][b][m][n] = (f32x4){0.f, 0.f, 0.f, 0.f};
    cur = nxt; cB = nB; ++ui;
    if constexpr (GATHER) {
#pragma unroll
      for (int h = 0; h < 2; ++h)
#pragma unroll
        for (int i = 0; i < 2; ++i) cuA[h][i] = nxA[h][i];
    } else cA = nA;
    if (wr == 1) G8_BAR;
  }
  G8_WAIT_V(0);
  G8_BAR;
#undef G8_SA
#undef G8_SB
#undef G8_STAGEA
#undef G8_STAGEB
#undef G8_LDA
#undef G8_LDB
#undef G8_MMA
#undef G8_WAIT_V
#undef G8_WAIT_L
#undef G8_BAR
#undef G8_SCHED
#undef G8_GOFF
}

struct DenseOrder {
  static constexpr bool GATHER = false;
  int nM, nN, nwg, G, c, K; const char* Bt;
  DI void init(int M, int N, int K_, const void* Bt_, int G_, int c_) { nM = M / BM; nN = N / BM; nwg = nM * nN; G = G_; c = c_; K = K_; Bt = (const char*)Bt_; }
  DI bool next(int i, Unit& u) const {
    const long L = (long)i * G + c; if (L >= nwg) return false;
    int wgid = (int)L; { const int q = nwg / 8, r = nwg % 8, xcd = wgid % 8, off = wgid / 8; wgid = (xcd < r ? xcd * (q + 1) : r * (q + 1) + (xcd - r) * q) + off; }
    const int nig = 8 * nN, gid = wgid / nig, fm = gid * 8, gsz = (nM - fm) < 8 ? (nM - fm) : 8;
    u.pm = fm + ((wgid % nig) % gsz); u.pn = (wgid % nig) / gsz; u.e = 0; u.j = 0; return true;
  }
  DI unsigned a_off(const Unit& u, int R) const { return (unsigned)(u.pm * BM + R) * (unsigned)(K * 2); }
  DI const char* b_base(const Unit& u) const { return Bt + (size_t)u.pn * BM * K * 2; }
};
}
using g8::Unit;

struct EpiIn {
  static constexpr bool PERM = true;
  bf16_t* qkpre; bf16_t* vm; bf16_t* hcat; bf16_t* cq; bf16_t* ckv; unsigned char* krope  ; float* gates; float* ssq_q; float* ssq_kv; const float* rope; const float* gate_b;
  DI void operator()(const f32x4 (&acc)[2][2][4][2], const Unit& u, int wr, int wc, int fr, int fq) const {
#pragma unroll
    for (int bj = 0; bj < 2; ++bj) {
      const int cw = u.pn * 256 + bj * 128 + wc * 32, c0 = cw + 8 * fq;
#pragma unroll
      for (int ai = 0; ai < 2; ++ai)
#pragma unroll
        for (int m = 0; m < 4; ++m) {
          const int row = u.pm * 256 + ai * 128 + wr * 64 + m * 16 + fr;
          const f32x4 v0 = acc[ai][bj][m][0], v1 = acc[ai][bj][m][1];
          if (cw < 1024) { u32x4 w = {cvtpk(v0[0], v0[1]), cvtpk(v0[2], v0[3]), cvtpk(v1[0], v1[1]), cvtpk(v1[2], v1[3])}; *(u32x4*)(qkpre + (size_t)row * 1024 + c0) = w; }
          else if (cw < 1536) { u32x4 w = {cvtpk(v0[0], v0[1]), cvtpk(v0[2], v0[3]), cvtpk(v1[0], v1[1]), cvtpk(v1[2], v1[3])}; *(u32x4*)(vm + (size_t)row * 512 + (c0 - 1024)) = w; }
          else if (cw < 2048) { u32x4 w = {cvtpk(sigmoidf_(v0[0]), sigmoidf_(v0[1])), cvtpk(sigmoidf_(v0[2]), sigmoidf_(v0[3])), cvtpk(sigmoidf_(v1[0]), sigmoidf_(v1[1])), cvtpk(sigmoidf_(v1[2]), sigmoidf_(v1[3]))};
                                *(u32x4*)(hcat + (size_t)row * 1024 + (c0 - 1536)) = w; }
          else if (cw < 2688) {
            u32x4 w = {cvtpk(v0[0], v0[1]), cvtpk(v0[2], v0[3]), cvtpk(v1[0], v1[1]), cvtpk(v1[2], v1[3])};
            float s = v0[0] * v0[0] + v0[1] * v0[1] + v0[2] * v0[2] + v0[3] * v0[3] + v1[0] * v1[0] + v1[1] * v1[1] + v1[2] * v1[2] + v1[3] * v1[3];
            s += __shfl_xor(s, 16); s += __shfl_xor(s, 32);
            if (cw < 2432) { *(u32x4*)(cq + (size_t)row * 384 + (c0 - 2048)) = w; if (fq == 0) ssq_q[(size_t)row * 12 + ((cw - 2048) >> 5)] = s; }
            else { *(u32x4*)(ckv + (size_t)row * 256 + (c0 - 2432)) = w; if (fq == 0) ssq_kv[(size_t)row * 8 + ((cw - 2432) >> 5)] = s; }
          }
          else if (cw < 2752) {
            const int i0 = (c0 - 2688) >> 1;
            const f32x4 cs0 = *(const f32x4*)(rope + (size_t)row * 64 + 2 * i0), cs1 = *(const f32x4*)(rope + (size_t)row * 64 + 2 * i0 + 4);
            const float a0 = v0[0] * cs0[0] - v0[1] * cs0[1], b0 = v0[1] * cs0[0] + v0[0] * cs0[1];
            const float a1 = v0[2] * cs0[2] - v0[3] * cs0[3], b1 = v0[3] * cs0[2] + v0[2] * cs0[3];
            const float a2 = v1[0] * cs1[0] - v1[1] * cs1[1], b2 = v1[1] * cs1[0] + v1[0] * cs1[1];
            const float a3 = v1[2] * cs1[2] - v1[3] * cs1[3], b3 = v1[3] * cs1[2] + v1[2] * cs1[3];
            const u32x2 w = cvt8((f32x4){a0, b0, a1, b1}, (f32x4){a2, b2, a3, b3});
            const int b_ = row >> 14, s_ = row & (SEQ - 1);
#pragma unroll
            for (int hh = 0; hh < 4; ++hh) *(u32x2*)(krope + ((size_t)(b_ * 4 + hh) * SEQ + s_) * 192 + 128 + (c0 - 2688)) = w;
          }
          else if (cw == 2752) {
            if (fq < 2) { const f32x4 g0 = *(const f32x4*)(gate_b + 8 * fq), g1 = *(const f32x4*)(gate_b + 8 * fq + 4);
              *(f32x4*)(gates + (size_t)row * 16 + 8 * fq) = v0 + g0; *(f32x4*)(gates + (size_t)row * 16 + 8 * fq + 4) = v1 + g1; }
          }
        }
    }
  }
};
struct EpiUQ {
  static constexpr bool PERM = true;
  unsigned char* qatt; const float* ssq_q; const float* rope;
  DI void operator()(const f32x4 (&acc)[2][2][4][2], const Unit& u, int wr, int wc, int fr, int fq) const {
    float rs[2][4];
#pragma unroll
    for (int ai = 0; ai < 2; ++ai)
#pragma unroll
      for (int m = 0; m < 4; ++m) {
        const int row = u.pm * 256 + ai * 128 + wr * 64 + m * 16 + fr;
        const f32x4 q0 = *(const f32x4*)(ssq_q + (size_t)row * 12), q1 = *(const f32x4*)(ssq_q + (size_t)row * 12 + 4), q2 = *(const f32x4*)(ssq_q + (size_t)row * 12 + 8);
        const float ss = (q0[0] + q0[1] + q0[2] + q0[3]) + (q1[0] + q1[1] + q1[2] + q1[3]) + (q2[0] + q2[1] + q2[2] + q2[3]);
        rs[ai][m] = rsqrtf(ss * (1.f / 384.f) + RMS_EPS) * QSCALE;
        asm volatile("" ::: "memory");
      }
#pragma unroll
    for (int bj = 0; bj < 2; ++bj) {
      const int cw = u.pn * 256 + bj * 128 + wc * 32, h = cw / 192, dw = cw - h * 192, d = dw + 8 * fq;
#pragma unroll
      for (int ai = 0; ai < 2; ++ai)
#pragma unroll
        for (int m = 0; m < 4; ++m) {
          const int row = u.pm * 256 + ai * 128 + wr * 64 + m * 16 + fr, b = row >> 14, s = row & (SEQ - 1);
          const f32x4 v0 = acc[ai][bj][m][0] * rs[ai][m], v1 = acc[ai][bj][m][1] * rs[ai][m];
          u32x2 w;
          if (dw < 128) { w = cvt8(v0, v1); }
          else {
            const int i0 = (d - 128) >> 1;
            const f32x4 cs0 = *(const f32x4*)(rope + (size_t)row * 64 + 2 * i0), cs1 = *(const f32x4*)(rope + (size_t)row * 64 + 2 * i0 + 4);
            const float a0 = v0[0] * cs0[0] - v0[1] * cs0[1], b0 = v0[1] * cs0[0] + v0[0] * cs0[1];
            const float a1 = v0[2] * cs0[2] - v0[3] * cs0[3], b1 = v0[3] * cs0[2] + v0[2] * cs0[3];
            const float a2 = v1[0] * cs1[0] - v1[1] * cs1[1], b2 = v1[1] * cs1[0] + v1[0] * cs1[1];
            const float a3 = v1[2] * cs1[2] - v1[3] * cs1[3], b3 = v1[3] * cs1[2] + v1[2] * cs1[3];
            w = cvt8((f32x4){a0, b0, a1, b1}, (f32x4){a2, b2, a3, b3});
          }
          *(u32x2*)(qatt + ((size_t)(b * 4 + h) * SEQ + s) * 192 + d) = w;
          asm volatile("" ::: "memory");
        }
    }
  }
};
struct EpiUKV {
  static constexpr bool PERM = true;
  unsigned char* kn; unsigned char* vt8; const float* ssq_kv;
  DI void operator()(const f32x4 (&acc)[2][2][4][2], const Unit& u, int wr, int wc, int fr, int fq) const {
#pragma unroll
    for (int ai = 0; ai < 2; ++ai)
#pragma unroll
      for (int m = 0; m < 4; ++m) {
        const int row = u.pm * 256 + ai * 128 + wr * 64 + m * 16 + fr, b = row >> 14, s = row & (SEQ - 1);
        const f32x4 q0 = *(const f32x4*)(ssq_kv + (size_t)row * 8), q1 = *(const f32x4*)(ssq_kv + (size_t)row * 8 + 4);
        const float ss = (q0[0] + q0[1] + q0[2] + q0[3]) + (q1[0] + q1[1] + q1[2] + q1[3]);
        const float rs = rsqrtf(ss * (1.f / 256.f) + RMS_EPS);
        { const f32x4 v0 = acc[ai][0][m][0] * rs, v1 = acc[ai][0][m][1] * rs;
          *(u32x2*)(kn + ((size_t)(b * 4 + u.pn) * SEQ + s) * 192 + wc * 32 + 8 * fq) = cvt8(v0, v1); }
        { const f32x4 v0 = acc[ai][1][m][0] * rs, v1 = acc[ai][1][m][1] * rs;
          const u32x2 w = cvt8(v0, v1);
          const int k = s & 63, kq = k & 31, pos = 32 * ((kq >> 2) & 1) + (kq & 3) + 4 * (kq >> 3) + 16 * (k >> 5);
          unsigned char* dst = vt8 + ((size_t)((b * 4 + u.pn) * 256 + (s >> 6)) * 128 + wc * 32 + 8 * fq) * 64 + pos;
          dst[0] = (unsigned char)w[0]; dst[64] = (unsigned char)(w[0] >> 8); dst[128] = (unsigned char)(w[0] >> 16); dst[192] = (unsigned char)(w[0] >> 24);
          dst[256] = (unsigned char)w[1]; dst[320] = (unsigned char)(w[1] >> 8); dst[384] = (unsigned char)(w[1] >> 16); dst[448] = (unsigned char)(w[1] >> 24); }
        asm volatile("" ::: "memory");
      }
  }
};
struct EpiOut {
  static constexpr bool PERM = true;
  const float* x; const float* mod; bf16_t* z;
  DI void operator()(const f32x4 (&acc)[2][2][4][2], const Unit& u, int wr, int wc, int fr, int fq) const {
#pragma unroll
    for (int ai = 0; ai < 2; ++ai)
#pragma unroll
      for (int m = 0; m < 4; ++m) {
        const int row = u.pm * 256 + ai * 128 + wr * 64 + m * 16 + fr, b = row >> 14;
#pragma unroll
        for (int bj = 0; bj < 2; ++bj) {
          const int c = u.pn * 256 + bj * 128 + wc * 32 + 8 * fq;
          const unsigned off = (unsigned)row * 1024u + (unsigned)c;
          const f32x4 x0 = *(const f32x4*)(x + off), x1 = *(const f32x4*)(x + off + 4), g0 = *(const f32x4*)(mod + b * 6144 + 2048 + c), g1 = *(const f32x4*)(mod + b * 6144 + 2048 + c + 4);
          const f32x4 z0 = x0 * ALPHA + (g0 + 1.f) * acc[ai][bj][m][0], z1 = x1 * ALPHA + (g1 + 1.f) * acc[ai][bj][m][1];
          *(u32x4*)(z + off) = (u32x4){cvtpk(z0[0], z0[1]), cvtpk(z0[2], z0[3]), cvtpk(z1[0], z1[1]), cvtpk(z1[2], z1[3])};
        }
        asm volatile("" ::: "memory");
      }
  }
};
struct EpiGU {
  static constexpr bool PERM = true;
  bf16_t* hdn;
  DI void operator()(const f32x4 (&acc)[2][2][4][2], const Unit& u, int wr, int wc, int fr, int fq) const {
    const unsigned base = ((unsigned)u.pm * 256u + wr * 64 + fr) * 1024u + (unsigned)(u.pn * 256 + wc * 32 + 8 * fq);
#pragma unroll
    for (int ai = 0; ai < 2; ++ai)
#pragma unroll
      for (int m = 0; m < 4; ++m) {
#pragma unroll
        for (int bj = 0; bj < 2; ++bj) {
          const f32x4 g = acc[ai][bj][m][0], up = acc[ai][bj][m][1];
          const u32x2 w = {cvtpk(siluf_(g[0]) * up[0], siluf_(g[1]) * up[1]), cvtpk(siluf_(g[2]) * up[2], siluf_(g[3]) * up[3])};
          *(u32x2*)((char*)hdn + (base + (unsigned)((ai * 128 + m * 16) * 1024 + bj * 128))) = w;
        }
      }
  }
};
struct EpiDN {
  static constexpr bool PERM = true;
  bf16_t* ybuf; const float* lw;
  DI void operator()(const f32x4 (&acc)[2][2][4][2], const Unit& u, int wr, int wc, int fr, int fq) const {
    const unsigned base = ((unsigned)u.pm * 256u + wr * 64 + fr) * 2048u + (unsigned)(u.pn * 256 + wc * 32 + 8 * fq) * 2u;
    const unsigned wbase = ((unsigned)u.e * (unsigned)T + (unsigned)(u.j * 256 + wr * 64 + fr)) * 4u;
#pragma unroll
    for (int ai = 0; ai < 2; ++ai)
#pragma unroll
      for (int m = 0; m < 4; ++m) {
        const float wgt = *(const float*)((const char*)lw + (wbase + (unsigned)((ai * 128 + m * 16) * 4)));
#pragma unroll
        for (int bj = 0; bj < 2; ++bj) {
          const f32x4 v0 = acc[ai][bj][m][0] * wgt, v1 = acc[ai][bj][m][1] * wgt;
          const u32x4 w = {cvtpk(v0[0], v0[1]), cvtpk(v0[2], v0[3]), cvtpk(v1[0], v1[1]), cvtpk(v1[2], v1[3])};
          *(u32x4*)((char*)ybuf + (base + (unsigned)((ai * 128 + m * 16) * 2048 + bj * 256))) = w;
        }
        asm volatile("" ::: "memory");
      }
  }
};
struct MoeOrderBase {
  const LAS int* tstart; const int* cnt; int G, c;
  DI bool next(int i, Unit& u) const {
    const int L = i * G + c, NT = tstart[32]; if (L >= NT * 4) return false;
    const int tile = L >> 2; int e = 0;
    for (int k = 1; k < 32; ++k) e = (tstart[k] <= tile) ? k : e;
    u.pm = tile; u.pn = L & 3; u.e = e; u.j = tile - tstart[e]; return true;
  }
};
struct MoeOrderGU : MoeOrderBase {
  static constexpr bool GATHER = true;
  const int* ltok; const char* Bt;
  DI unsigned a_off(const Unit& u, int R) const { const int n = cnt[u.e * CNT_STRIDE]; int idx = u.j * 256 + R; idx = idx < n ? idx : n - 1; return (unsigned)ltok[(size_t)u.e * T + idx] * 2048u; }
  DI const char* b_base(const Unit& u) const { return Bt + ((size_t)u.e * 1024 + u.pn * 256) * 2048; }
};
struct MoeOrderDN : MoeOrderBase {
  static constexpr bool GATHER = false;
  const char* Bt;
  DI unsigned a_off(const Unit& u, int R) const { return (unsigned)(u.pm * 256 + R) * 1024u; }
  DI const char* b_base(const Unit& u) const { return Bt + ((size_t)u.e * 1024 + u.pn * 256) * 1024; }
};

struct TDesc { const float* src; const float* kscale; bf16_t* dst; int ld, K, k0, n0, ok; };
DI TDesc tdesc(int r, int lane, unsigned char* ws) {
  constexpr int I_IN = 16 * 88, I_UQ = 6 * 24, I_UKV = 4 * 32, I_OUT = 16 * 32, I_GU = 32 * 16 * 32;
  TDesc d; d.kscale = nullptr; int sc, kb, nb; const float* W;
  if (r < I_IN) { kb = r / 88; nb = r % 88; const int n = nb * 32 + (lane & 31);
    sc = n < 2048 ? n : n < 2432 ? 2064 + (n - 2048) : n < 2688 ? 2448 + (n - 2432) : n < 2752 ? 2704 + ((n - 2688) & 1) * 32 + ((n - 2688) >> 1) : n < 2768 ? 2048 + (n - 2752) : -1;
    W = karg<A_WIN>(); d.ld = N_IN; d.K = 1024; d.dst = (bf16_t*)(ws + WS_WIN); }
  else if ((r -= I_IN) < I_UQ) { kb = r / 24; nb = r % 24; const int n = nb * 32 + (lane & 31), h = n / 192, dd = n - h * 192;
    sc = dd < 128 ? n : h * 192 + 128 + ((dd - 128) & 1) * 32 + ((dd - 128) >> 1);
    W = karg<A_WUQ>(); d.ld = 768; d.K = 384; d.dst = (bf16_t*)(ws + WS_WUQ); d.kscale = karg<A_QNG>(); }
  else if ((r -= I_UQ) < I_UKV) { kb = r / 32; nb = r % 32; sc = nb * 32 + (lane & 31); W = karg<A_WUKV>(); d.ld = 1024; d.K = 256; d.dst = (bf16_t*)(ws + WS_WUKV); d.kscale = karg<A_KVNG>(); }
  else if ((r -= I_UKV) < I_OUT) { kb = r / 32; nb = r % 32; sc = nb * 32 + (lane & 31); W = karg<A_WOUT>(); d.ld = 1024; d.K = 1024; d.dst = (bf16_t*)(ws + WS_WOUT); }
  else if ((r -= I_OUT) < I_GU) { const int e = r / 512, q = r % 512; kb = q / 32; nb = q % 32;
    const int lr = nb * 32 + (lane & 31), up = (lr >> 2) & 1; sc = (lr >> 3) * 4 + (lr & 3);
    W = (up ? karg<A_WUP>() : karg<A_WGATE>()) + (size_t)e * 1024 * 512; d.ld = 512; d.K = 1024; d.dst = (bf16_t*)(ws + WS_WGU) + (size_t)e * 1024 * 1024; }
  else { r -= I_GU; const int e = r / 256, q = r % 256; kb = q / 32; nb = q % 32; sc = nb * 32 + (lane & 31);
    W = karg<A_WDOWN>() + (size_t)e * 512 * 1024; d.ld = 1024; d.K = 512; d.dst = (bf16_t*)(ws + WS_WDN) + (size_t)e * 1024 * 512; }
  d.k0 = 64 * kb; d.n0 = 32 * nb; d.ok = sc >= 0;
  d.src = W + (size_t)(d.k0 + (lane >> 5)) * d.ld + (sc >= 0 ? sc : 0);
  return d;
}
DI void tload(const TDesc& d, float (&v)[32]) {
#pragma unroll
  for (int i = 0; i < 32; ++i) v[i] = d.src[(size_t)(2 * i) * d.ld];
}
DI void tstore(const TDesc& d, float (&v)[32], LAS float* scr, int lane) {
  if (d.kscale) {
#pragma unroll
    for (int i = 0; i < 32; ++i) v[i] *= d.kscale[d.k0 + 2 * i + (lane >> 5)];
  }
#pragma unroll
  for (int i = 0; i < 32; ++i) scr[(2 * i + (lane >> 5)) * 33 + (lane & 31)] = d.ok ? v[i] : 0.f;
  asm volatile("s_waitcnt lgkmcnt(0)" ::: "memory");
  const int c = lane & 7;
#pragma unroll
  for (int j = 0; j < 4; ++j) { const int n = (lane >> 3) + 8 * j; const LAS float* s = scr + (8 * c) * 33 + n;
    u32x4 o; o.x = cvtpk(s[0 * 33], s[1 * 33]); o.y = cvtpk(s[2 * 33], s[3 * 33]); o.z = cvtpk(s[4 * 33], s[5 * 33]); o.w = cvtpk(s[6 * 33], s[7 * 33]);
    *(u32x4*)(d.dst + (size_t)(d.n0 + n) * d.K + d.k0 + 8 * c) = o; }
  asm volatile("s_waitcnt lgkmcnt(0)" ::: "memory");
}
constexpr int PREP_ITEMS = 16 * 88 + 6 * 24 + 4 * 32 + 16 * 32 + 32 * 16 * 32 + 32 * 8 * 32;
constexpr int PREP_DEFER = 8192;
DI void prep_items(int it, const int end, const int stride, const int lane, unsigned char* ws, LAS float* scr) {
  TDesc dA, dB; float vA[32], vB[32];
  if (it < end) { dA = tdesc(it, lane, ws); tload(dA, vA); }
  while (it < end) {
    if (it + stride < end) { dB = tdesc(it + stride, lane, ws); tload(dB, vB); }
    tstore(dA, vA, scr, lane);
    it += stride; if (it >= end) break;
    if (it + stride < end) { dA = tdesc(it + stride, lane, ws); tload(dA, vA); }
    tstore(dB, vB, scr, lane);
    it += stride;
  }
}
DI void phase_prep(const Ctx& p, int bid, int G, LAS unsigned char* lds) {
  const int tid = tid_fresh(), lane = tid & 63, wave = __builtin_amdgcn_readfirstlane(tid >> 6);
  unsigned char* ws = p.ws;
  LAS float* scr = (LAS float*)(lds + wave * 16384);
  LAS float* cact = (LAS float*)(lds + 131072);
  for (int i = tid; i < 2048; i += NTHREADS) cact[i] = siluf_(karg<A_C>()[i]);
  __syncthreads();
  const int gw = bid * 8 + wave, NGW = G * 8;
  constexpr int I_MOD = 192;
  if (bid < I_MOD) {
    const int kg = lane >> 3, cc = lane & 7, col = bid * 32 + 4 * cc; const float* w_ada = karg<A_WADA>() + col;
    f32x4 a0 = {0.f, 0.f, 0.f, 0.f}, a1 = {0.f, 0.f, 0.f, 0.f};
#pragma unroll
    for (int j = 0; j < 16; ++j) { const int k = wave * 128 + kg + 8 * j; const f32x4 w = *(const f32x4*)(w_ada + (size_t)k * 6144); a0 += w * cact[k]; a1 += w * cact[1024 + k]; }
#pragma unroll
    for (int e = 0; e < 4; ++e) {
#pragma unroll
      for (int o = 8; o < 64; o <<= 1) { a0[e] += __shfl_xor(a0[e], o); a1[e] += __shfl_xor(a1[e], o); } }
    LAS f32x4* part = (LAS f32x4*)(lds + 131072 + 8192);
    if (kg == 0) { part[(wave * 8 + cc) * 2] = a0; part[(wave * 8 + cc) * 2 + 1] = a1; }
    __syncthreads();
    if (wave == 0 && kg == 0) { float* mod = (float*)(ws + WS_MOD); const f32x4 bb = *(const f32x4*)(karg<A_BADA>() + col);
      f32x4 s0 = part[cc * 2], s1 = part[cc * 2 + 1];
#pragma unroll
      for (int w = 1; w < 8; ++w) { s0 += part[(w * 8 + cc) * 2]; s1 += part[(w * 8 + cc) * 2 + 1]; }
      *(f32x4*)(mod + col) = s0 + bb; *(f32x4*)(mod + 6144 + col) = s1 + bb; }
  }
#ifndef DBL_PREP
#define DBL_PREP 0
#endif
  for (int rp_ = 0; rp_ < (DBL_PREP == 1 ? 2 : 1); ++rp_) prep_items(gw, PREP_ITEMS - PREP_DEFER, NGW, lane, ws, scr);
  {
    const float INV[32] = {1.000000000e+00f, 7.498942018e-01f, 5.623413324e-01f, 4.216965139e-01f, 3.162277639e-01f, 2.371373773e-01f, 1.778279394e-01f, 1.333521456e-01f,
                           1.000000015e-01f, 7.498942316e-02f, 5.623413250e-02f, 4.216964915e-02f, 3.162277490e-02f, 2.371373773e-02f, 1.778279431e-02f, 1.333521400e-02f,
                           9.999999776e-03f, 7.498942316e-03f, 5.623413250e-03f, 4.216964822e-03f, 3.162277630e-03f, 2.371373819e-03f, 1.778279431e-03f, 1.333521446e-03f,
                           1.000000047e-03f, 7.498941850e-04f, 5.623413017e-04f, 4.216965172e-04f, 3.162277571e-04f, 2.371373703e-04f, 1.778279402e-04f, 1.333521504e-04f};
    f32x2* rope = (f32x2*)(ws + WS_ROPE); const int* pos = karg<A_POS, const int>();
    for (int rp_ = 0; rp_ < (DBL_PREP == 2 ? 2 : 1); ++rp_)
    for (int i = bid * NTHREADS + tid; i < T * 32; i += G * NTHREADS) {
      const int t = i >> 5, fi = i & 31;
      const float ang = (float)pos[t] * INV[fi];
      float sn, cs; sincosf(ang, &sn, &cs); rope[i] = (f32x2){cs, sn};
    }
  }
  if (bid == 0) for (int i = tid; i < 64 * CNT_STRIDE; i += NTHREADS) ((int*)(ws + WS_CNT))[i] = 0;
  { const float* w_re = karg<A_WRE>(); const float* w_rg = karg<A_WRG>(); float* wrt = (float*)(ws + WS_WRT);
    for (int i = bid * NTHREADS + tid; i < 36 * 1024; i += G * NTHREADS) { const int e = i >> 10, k = i & 1023; wrt[i] = e < 32 ? w_re[k * 32 + e] : w_rg[k * 4 + (e - 32)]; } }
}

DI void phase_lnmod(const Ctx& p, int bid, int G) {
  const int tid = tid_fresh(), lane = tid & 63, wave = tid >> 6;
  const float* mod = (const float*)(p.ws + WS_MOD); bf16_t* U = (bf16_t*)(p.ws + WS_U); const float* xin = karg<A_X>();
  f32x4 vn[4];
  { const int row = bid * 8 + wave; if (row < T) { const f32x4* xr = (const f32x4*)(xin + (size_t)row * 1024) + lane;
#pragma unroll
      for (int j = 0; j < 4; ++j) vn[j] = xr[64 * j]; } }
  for (int row = bid * 8 + wave; row < T; row += G * 8) {
    const int b = row >> 14;
    f32x4 v[4]; float s = 0.f;
#pragma unroll
    for (int j = 0; j < 4; ++j) { v[j] = vn[j]; s += (v[j][0] + v[j][1]) + (v[j][2] + v[j][3]); }
    if (row + G * 8 < T) { const f32x4* xr = (const f32x4*)(xin + (size_t)(row + G * 8) * 1024) + lane;
#pragma unroll
      for (int j = 0; j < 4; ++j) vn[j] = xr[64 * j]; }
    const float mean = wave_sum(s) * (1.f / 1024.f); float s2 = 0.f;
#pragma unroll
    for (int j = 0; j < 4; ++j) { v[j] = v[j] - mean; s2 += (v[j][0] * v[j][0] + v[j][1] * v[j][1]) + (v[j][2] * v[j][2] + v[j][3] * v[j][3]); }
    const float rstd = rsqrtf(wave_sum(s2) * (1.f / 1024.f) + LN_EPS);
    u32x2* o8 = (u32x2*)(U + (size_t)row * 1024) + lane;
#pragma unroll
    for (int j = 0; j < 4; ++j) {
      const int col = 4 * lane + 256 * j;
      const f32x4 sh = *(const f32x4*)(mod + b * 6144 + col), sc = *(const f32x4*)(mod + b * 6144 + 1024 + col);
      const f32x4 y = v[j] * rstd * (sc + 1.f) + sh;
      o8[64 * j] = (u32x2){cvtpk(y[0], y[1]), cvtpk(y[2], y[3])};
    }
  }
}

constexpr int PA_V = 0, PA_KF = 32768, PA_KB = 65536, PA_RAWK = 100352, PA_VEC = 135168;
DI void mlstmA_unit(const Ctx& p, int b, int h, int c, LAS unsigned char* lds) {
  const int tid = tid_fresh(), lane = tid & 63, wid = __builtin_amdgcn_readfirstlane(tid >> 6), r32 = lane & 31, hi = lane >> 5;
  unsigned char* ws = p.ws;
  const bf16_t* qkpre = (const bf16_t*)(ws + WS_QKPRE); const bf16_t* vmp = (const bf16_t*)(ws + WS_VM); bf16_t* qkpost = (bf16_t*)(ws + WS_U);
  const float* gates = (const float*)(ws + WS_GATES); float* gvec = (float*)(ws + WS_GVEC); float* nvec = (float*)(ws + WS_NVEC); float* scal = (float*)(ws + WS_SCAL);
  bf16_t* Cbuf = (bf16_t*)p.out;
  LAS float* vec = (LAS float*)(lds + PA_VEC);
  const int bh = b * 4 + h, row0 = b * SEQ + c * 128;
  const int r0 = tid >> 4, c8 = (tid & 15) * 8;
  u32x4 rk[5], rq[5], rv[4];
#pragma unroll
  for (int j = 0; j < 5; ++j) {
    const int rr = r0 + 32 * j, sj = c * 128 + rr - 2; const bool ok = rr < 132 && sj >= 0 && sj < SEQ;
    const bf16_t* src = qkpre + (size_t)(b * SEQ + (ok ? sj : 0)) * 1024 + h * 128 + c8;
    rk[j] = ok ? *(const u32x4*)(src + 512) : (u32x4){0u, 0u, 0u, 0u}; rq[j] = ok ? *(const u32x4*)src : (u32x4){0u, 0u, 0u, 0u};
  }
#pragma unroll
  for (int j = 0; j < 4; ++j) rv[j] = *(const u32x4*)(vmp + (size_t)(row0 + r0 + 32 * j) * 512 + h * 128 + c8);
  float gb = 0.f, gcol = 0.f, gcm = 0.f;
  if (tid < 256) {
    const int dir = tid >> 7, t = tid & 127, wv = (tid >> 6) & 1;
    const float ig = gates[(size_t)(row0 + t) * 16 + (dir * 2) * 4 + h], fg = gates[(size_t)(row0 + t) * 16 + (dir * 2 + 1) * 4 + h];
    float x = logsigmoidf_(fg);
    if (dir == 0) {
#pragma unroll
      for (int o = 1; o < 64; o <<= 1) { const float y = __shfl_up(x, o); if (lane >= o) x += y; }
      if (lane == 63) vec[256 + wv] = x;
    } else {
#pragma unroll
      for (int o = 1; o < 64; o <<= 1) { const float y = __shfl_down(x, o); if (lane + o < 64) x += y; }
      if (lane == 0) vec[258 + wv] = x;
    }
    gb = x; gcol = ig;
  }
  __syncthreads();
  if (tid < 256) {
    const int dir = tid >> 7, wv = (tid >> 6) & 1;
    if (dir == 0) { if (wv == 1) gb += vec[256]; } else { if (wv == 0) gb += vec[259]; }
    gcol = gcol - gb;
    float x = gcol;
    if (dir == 0) {
#pragma unroll
      for (int o = 1; o < 64; o <<= 1) { const float y = __shfl_up(x, o); if (lane >= o) x = fmaxf(x, y); }
      if (lane == 63) vec[260 + wv] = x;
    } else {
#pragma unroll
      for (int o = 1; o < 64; o <<= 1) { const float y = __shfl_down(x, o); if (lane + o < 64) x = fmaxf(x, y); }
      if (lane == 0) vec[262 + wv] = x;
    }
    gcm = x;
  }
  __syncthreads();
  if (tid < 256) {
    const int dir = tid >> 7, t = tid & 127, wv = (tid >> 6) & 1;
    if (dir == 0) { if (wv == 1) gcm = fmaxf(gcm, vec[260]); } else { if (wv == 0) gcm = fmaxf(gcm, vec[263]); }
    const float mx = fmaxf(vec[260 + 2 * dir], vec[261 + 2 * dir]);
    const float tot = vec[256 + 2 * dir] + vec[257 + 2 * dir];
    float* gv = gvec + ((size_t)(dir * 8 + bh) * SEQ + c * 128 + t) * 3;
    gv[0] = gb; gv[1] = gcol; gv[2] = gcm;
    vec[dir * 128 + t] = __expf(gcol - mx);
    if (t == 0) { scal[(dir * 8 + bh) * 128 + c] = tot; scal[2048 + (dir * 8 + bh) * 128 + c] = tot + mx; }
  }
  __syncthreads();
#pragma unroll
  for (int j = 0; j < 5; ++j) { const int rr = r0 + 32 * j;
    if (rr < 132) { *(LAS u32x4*)(lds + PA_RAWK + rr * 256 + c8 * 2) = rk[j]; *(LAS u32x4*)(lds + PA_KB + rr * 256 + c8 * 2) = rq[j]; } }
#pragma unroll
  for (int j = 0; j < 4; ++j) { const int r = r0 + 32 * j; *(LAS u32x4*)(lds + PA_V + (r >> 6) * 16384 + v_st(r & 63, c8)) = rv[j]; }
  __syncthreads();
  const float* conv_w = karg<A_CONVW>(); const float* conv_b = karg<A_CONVB>();
  {
    const int ch = h * 128 + c8;
    float w[5][8], bias[8];
#pragma unroll
    for (int j = 0; j < 5; ++j) { const f32x4 a = *(const f32x4*)(conv_w + j * 1024 + ch), bq = *(const f32x4*)(conv_w + j * 1024 + ch + 4);
      w[j][0] = a[0]; w[j][1] = a[1]; w[j][2] = a[2]; w[j][3] = a[3]; w[j][4] = bq[0]; w[j][5] = bq[1]; w[j][6] = bq[2]; w[j][7] = bq[3]; }
    { const f32x4 a = *(const f32x4*)(conv_b + ch), bq = *(const f32x4*)(conv_b + ch + 4); bias[0] = a[0]; bias[1] = a[1]; bias[2] = a[2]; bias[3] = a[3]; bias[4] = bq[0]; bias[5] = bq[1]; bias[6] = bq[2]; bias[7] = bq[3]; }
#pragma unroll
    for (int ps = 0; ps < 4; ++ps) {
      const int r = r0 + 32 * ps;
      float a[8];
#pragma unroll
      for (int e = 0; e < 8; ++e) a[e] = bias[e];
#pragma unroll
      for (int j = 0; j < 5; ++j) { const u32x4 xv = *(const LAS u32x4*)(lds + PA_KB + (r + j) * 256 + c8 * 2);
        a[0] += w[j][0] * bflo(xv[0]); a[1] += w[j][1] * bfhi(xv[0]); a[2] += w[j][2] * bflo(xv[1]); a[3] += w[j][3] * bfhi(xv[1]);
        a[4] += w[j][4] * bflo(xv[2]); a[5] += w[j][5] * bfhi(xv[2]); a[6] += w[j][6] * bflo(xv[3]); a[7] += w[j][7] * bfhi(xv[3]); }
      const float qs = 0.08838834764831845f;
#pragma unroll
      for (int e = 0; e < 8; ++e) a[e] = siluf_(a[e]) * qs;
      *(u32x4*)(qkpost + (size_t)(row0 + r) * 1024 + ch) = (u32x4){cvtpk(a[0], a[1]), cvtpk(a[2], a[3]), cvtpk(a[4], a[5]), cvtpk(a[6], a[7])};
    }
  }
  __syncthreads();
  {
    const int ch = 512 + h * 128 + c8;
    float w[5][8], bias[8];
#pragma unroll
    for (int j = 0; j < 5; ++j) { const f32x4 a = *(const f32x4*)(conv_w + j * 1024 + ch), bq = *(const f32x4*)(conv_w + j * 1024 + ch + 4);
      w[j][0] = a[0]; w[j][1] = a[1]; w[j][2] = a[2]; w[j][3] = a[3]; w[j][4] = bq[0]; w[j][5] = bq[1]; w[j][6] = bq[2]; w[j][7] = bq[3]; }
    { const f32x4 a = *(const f32x4*)(conv_b + ch), bq = *(const f32x4*)(conv_b + ch + 4); bias[0] = a[0]; bias[1] = a[1]; bias[2] = a[2]; bias[3] = a[3]; bias[4] = bq[0]; bias[5] = bq[1]; bias[6] = bq[2]; bias[7] = bq[3]; }
#pragma unroll
    for (int ps = 0; ps < 4; ++ps) {
      const int r = r0 + 32 * ps;
      float a[8];
#pragma unroll
      for (int e = 0; e < 8; ++e) a[e] = bias[e];
#pragma unroll
      for (int j = 0; j < 5; ++j) { const u32x4 xv = *(const LAS u32x4*)(lds + PA_RAWK + (r + j) * 256 + c8 * 2);
        a[0] += w[j][0] * bflo(xv[0]); a[1] += w[j][1] * bfhi(xv[0]); a[2] += w[j][2] * bflo(xv[1]); a[3] += w[j][3] * bfhi(xv[1]);
        a[4] += w[j][4] * bflo(xv[2]); a[5] += w[j][5] * bfhi(xv[2]); a[6] += w[j][6] * bflo(xv[3]); a[7] += w[j][7] * bfhi(xv[3]); }
#pragma unroll
      for (int e = 0; e < 8; ++e) a[e] = siluf_(a[e]);
      *(u32x4*)(qkpost + (size_t)(row0 + r) * 1024 + ch) = (u32x4){cvtpk(a[0], a[1]), cvtpk(a[2], a[3]), cvtpk(a[4], a[5]), cvtpk(a[6], a[7])};
      const float wf = vec[r], wb = vec[128 + r];
      const u32x4 kf = {cvtpk(a[0] * wf, a[1] * wf), cvtpk(a[2] * wf, a[3] * wf), cvtpk(a[4] * wf, a[5] * wf), cvtpk(a[6] * wf, a[7] * wf)};
      const u32x4 kb = {cvtpk(a[0] * wb, a[1] * wb), cvtpk(a[2] * wb, a[3] * wb), cvtpk(a[4] * wb, a[5] * wb), cvtpk(a[6] * wb, a[7] * wb)};
      const int io = (r >> 6) * 16384 + v_st(r & 63, c8);
      *(LAS u32x4*)(lds + PA_KF + io) = kf; *(LAS u32x4*)(lds + PA_KB + io) = kb;
    }
  }
  __syncthreads();
  {
    const int dir = wid >> 2, dkb = wid & 3;
    const int ka = (int)(uintptr_t)(lds + (dir ? PA_KB : PA_KF)) + v_rd_base(lane) + dkb * 512;
    const int va = (int)(uintptr_t)(lds + PA_V) + v_rd_base(lane);
    f32x16 o[4] = {};
#define PA_STEP(TILE, KS) do { s16x4 al, ah, l0, h0, l1, h1, l2, h2, l3, h3;                                                   \
      al = tr_read<v_rd_off(0, KS, 0)>(ka + TILE * 16384); ah = tr_read<v_rd_off(0, KS, 1)>(ka + TILE * 16384);                 \
      l0 = tr_read<v_rd_off(0, KS, 0)>(va + TILE * 16384); h0 = tr_read<v_rd_off(0, KS, 1)>(va + TILE * 16384);                 \
      l1 = tr_read<v_rd_off(1, KS, 0)>(va + TILE * 16384); h1 = tr_read<v_rd_off(1, KS, 1)>(va + TILE * 16384);                 \
      l2 = tr_read<v_rd_off(2, KS, 0)>(va + TILE * 16384); h2 = tr_read<v_rd_off(2, KS, 1)>(va + TILE * 16384);                 \
      l3 = tr_read<v_rd_off(3, KS, 0)>(va + TILE * 16384); h3 = tr_read<v_rd_off(3, KS, 1)>(va + TILE * 16384);                 \
      asm volatile("s_waitcnt lgkmcnt(0)" ::: "memory"); SBAR();                                                                \
      const bf16x8 A = PKLH(al, ah);                                                                                            \
      o[0] = MFMA32(A, PKLH(l0, h0), o[0]); o[1] = MFMA32(A, PKLH(l1, h1), o[1]); o[2] = MFMA32(A, PKLH(l2, h2), o[2]); o[3] = MFMA32(A, PKLH(l3, h3), o[3]); } while (0)
    PA_STEP(0, 0); PA_STEP(0, 1); PA_STEP(0, 2); PA_STEP(0, 3); PA_STEP(1, 0); PA_STEP(1, 1); PA_STEP(1, 2); PA_STEP(1, 3);
#undef PA_STEP
    bf16_t* Cd = Cbuf + ((size_t)(dir * 8 + bh) * 128 + c) * 16384;
#pragma unroll
    for (int r = 0; r < 16; ++r) { const int dk = dkb * 32 + crow(r, hi);
#pragma unroll
      for (int d0 = 0; d0 < 4; ++d0) Cd[dk * 128 + d0 * 32 + r32] = f2bf(o[d0][r]); }
  }
  if (tid < 256) {
    const int dir = tid >> 7, dk = tid & 127; const LAS unsigned char* img = lds + (dir ? PA_KB : PA_KF);
    float n = 0.f;
#pragma unroll 8
    for (int s = 0; s < 128; ++s) n += bf2f(*(const LAS unsigned short*)(img + (s >> 6) * 16384 + v_st(s & 63, dk)));
    nvec[((size_t)(dir * 8 + bh) * 128 + c) * 128 + dk] = n;
  }
  __syncthreads();
}

DI void phase_scan(const Ctx& p, int bid, int G) {
  const int tid = tid_fresh(); unsigned char* ws = p.ws;
  const float* scal = (const float*)(ws + WS_SCAL); float* mprev = (float*)(ws + WS_SCAL) + 4096; float* nvec = (float*)(ws + WS_NVEC); bf16_t* Cbuf = (bf16_t*)p.out;
  for (int gid = bid * NTHREADS + tid, it = 0; gid < 131072; gid += G * NTHREADS, ++it) {
    const int seq = gid >> 13, e2c = gid & 8191, dir = seq >> 3;
    const bool ex = (it == 0) && (gid < 1024);
    const int seqn = (gid & 1023) >> 6, e2 = gid & 63, dirn = seqn >> 3;
    float m = 0.f, a0 = 0.f, a1 = 0.f, mN = 0.f, n0 = 0.f, n1 = 0.f;
    for (int sb = 0; sb < 128; sb += 8) {
      unsigned raw[8]; f32x2 rawn[8];
#pragma unroll
      for (int q = 0; q < 8; ++q) { const int c = dir ? 127 - (sb + q) : sb + q; raw[q] = *(const unsigned*)(Cbuf + ((size_t)seq * 128 + c) * 16384 + e2c * 2); }
      if (ex) {
#pragma unroll
        for (int q = 0; q < 8; ++q) { const int c = dirn ? 127 - (sb + q) : sb + q; rawn[q] = *(const f32x2*)(nvec + ((size_t)seqn * 128 + c) * 128 + e2 * 2); }
      }
#pragma unroll
      for (int q = 0; q < 8; ++q) {
        const int c = dir ? 127 - (sb + q) : sb + q;
        const float be = scal[seq * 128 + c], ml = scal[2048 + seq * 128 + c];
        *(unsigned*)(Cbuf + ((size_t)seq * 128 + c) * 16384 + e2c * 2) = cvtpk(a0, a1);
        if (e2c == 0) mprev[seq * 128 + c] = m;
        const float mn = fmaxf(be + m, ml), al = __expf(be + m - mn), bt = __expf(ml - mn);
        a0 = al * a0 + bt * bflo(raw[q]); a1 = al * a1 + bt * bfhi(raw[q]);
        m = mn;
      }
      if (ex) {
#pragma unroll
        for (int q = 0; q < 8; ++q) {
          const int c = dirn ? 127 - (sb + q) : sb + q;
          const float be = scal[seqn * 128 + c], ml = scal[2048 + seqn * 128 + c];
          *(f32x2*)(nvec + ((size_t)seqn * 128 + c) * 128 + e2 * 2) = (f32x2){n0, n1};
          const float mn = fmaxf(be + mN, ml), al = __expf(be + mN - mn), bt = __expf(ml - mn);
          n0 = al * n0 + bt * rawn[q][0]; n1 = al * n1 + bt * rawn[q][1];
          mN = mn;
        }
      }
    }
  }
}

DI void qkt8(f32x16& p0, f32x16& p1, const LAS unsigned char* Ks, const bf16x8* qr, int r32, int hi) {
  p0 = f32x16{}; p1 = f32x16{};
#pragma unroll
  for (int d0 = 0; d0 < 8; ++d0) { const int cb = (d0 * 16 + hi * 8) * 2;
    const bf16x8 b0 = *(const LAS bf16x8*)(Ks + KSWZ(r32, cb)), b1 = *(const LAS bf16x8*)(Ks + KSWZ(32 + r32, cb));
    p0 = MFMA32(b0, qr[d0], p0); p1 = MFMA32(b1, qr[d0], p1); }
}
DI v8i kfrag8(const LAS unsigned char* K8, int row, int s, int hi) {
  const int c = 4 * s + 2 * hi;
  const u32x4 lo = *(const LAS u32x4*)(K8 + row * 256 + ((c ^ (row & 15)) << 4)), hi4 = *(const LAS u32x4*)(K8 + row * 256 + (((c + 1) ^ (row & 15)) << 4));
  return (v8i){(int)lo[0], (int)lo[1], (int)lo[2], (int)lo[3], (int)hi4[0], (int)hi4[1], (int)hi4[2], (int)hi4[3]};
}
#define MFMA8(a, b, c) __builtin_amdgcn_mfma_scale_f32_32x32x64_f8f6f4((a), (b), (c), 0, 0, 0, 127, 0, 123)
DI void qkt12(f32x16& p0, f32x16& p1, const LAS unsigned char* K8, const v8i* qr, int r32, int hi) {
  p0 = f32x16{}; p1 = f32x16{};
#pragma unroll
  for (int s = 0; s < 3; ++s) {
    const v8i a0 = kfrag8(K8, r32, s, hi), a1 = kfrag8(K8, 32 + r32, s, hi);
    p0 = MFMA8(a0, qr[s], p0); p1 = MFMA8(a1, qr[s], p1);
  }
}

DI void glds16(const void* gsrc, unsigned lds_dst) {
  unsigned keep;
  asm volatile("s_mov_b32 %0, m0\n\ts_mov_b32 m0, %2\n\ts_nop 0\n\tglobal_load_lds_dwordx4 %1, off\n\ts_mov_b32 m0, %0" : "=&s"(keep) : "v"(gsrc), "s"(lds_dst) : "memory");
}
constexpr int AT_KN = 0, AT_V = 49152, AT_WS = 73728;
constexpr float ATT_THR = 3.f;
DI void partialSM(f32x16& p0, f32x16& p1, float& m_reg, float& mn, float& alpha) {
  float pmax = p0[0];
#pragma unroll
  for (int r = 1; r < 16; ++r) pmax = fmaxf(pmax, p0[r]);
#pragma unroll
  for (int r = 0; r < 16; ++r) pmax = fmaxf(pmax, p1[r]);
  pmax = half_swap_max(pmax);
  if (__builtin_expect(__all(pmax - m_reg <= ATT_THR), 1)) { mn = m_reg; alpha = 1.f; }
  else { mn = fmaxf(m_reg, pmax); alpha = __builtin_amdgcn_exp2f(m_reg - mn); m_reg = mn; }
  const float mo = mn - 5.f;
#pragma unroll
  for (int r = 0; r < 16; ++r) { p0[r] = p0[r] - mo; p1[r] = p1[r] - mo; }
#pragma unroll
  for (int r = 0; r < 16; ++r) p0[r] = __builtin_amdgcn_exp2f(p0[r]);
}
DI void finishSM(f32x16& p0, f32x16& p1, v8i& pa) {
#pragma unroll
  for (int r = 0; r < 16; ++r) p1[r] = __builtin_amdgcn_exp2f(p1[r]);
#pragma unroll
  for (int q = 0; q < 4; ++q) {
    int w = __builtin_amdgcn_cvt_pk_fp8_f32(p0[4 * q], p0[4 * q + 1], pa[q], false); pa[q] = __builtin_amdgcn_cvt_pk_fp8_f32(p0[4 * q + 2], p0[4 * q + 3], w, true);
    w = __builtin_amdgcn_cvt_pk_fp8_f32(p1[4 * q], p1[4 * q + 1], pa[4 + q], false); pa[4 + q] = __builtin_amdgcn_cvt_pk_fp8_f32(p1[4 * q + 2], p1[4 * q + 3], w, true);
  }
}
DI void pv8(f32x16* o, f32x16& lsum, const LAS unsigned char* Vt, v8i pa, int r32, int hi) {
  { const v8i ones = {0x38383838, 0x38383838, 0x38383838, 0x38383838, 0x38383838, 0x38383838, 0x38383838, 0x38383838};
    lsum = __builtin_amdgcn_mfma_scale_f32_32x32x64_f8f6f4(pa, ones, lsum, 0, 0, 0, 122, 0, 127); }
#pragma unroll
  for (int d0 = 0; d0 < 4; ++d0) {
    const int n = 32 * d0 + r32, x = (n >> 2) & 3;
    const u32x4 lo = *(const LAS u32x4*)(Vt + n * 64 + (((2 * hi) ^ x) << 4)), h4 = *(const LAS u32x4*)(Vt + n * 64 + (((2 * hi + 1) ^ x) << 4));
    const v8i bv = {(int)lo[0], (int)lo[1], (int)lo[2], (int)lo[3], (int)h4[0], (int)h4[1], (int)h4[2], (int)h4[3]};
    o[d0] = __builtin_amdgcn_mfma_scale_f32_32x32x64_f8f6f4(pa, bv, o[d0], 0, 0, 0, 122, 0, 127);
  }
}
DI void attn_unit(const unsigned char* Qb, const unsigned char* Knh, const unsigned char* Vh, bf16_t* Ob, LAS unsigned char* lds) {
  const int tid = tid_fresh(), wid = __builtin_amdgcn_readfirstlane(tid >> 6), lane = tid & 63, r32 = lane & 31, hi = lane >> 5;
  LAS float* wsf = (LAS float*)(lds + AT_WS) + wid * 64; LAS float* al_l = wsf + 32;
  constexpr int NT = SEQ / 64;
  unsigned offKn, offV;
  { const int row = wid * 4 + (lane >> 4); int lg = (lane & 15) ^ (row & 15); lg = lg < 12 ? lg : 0; offKn = (unsigned)(row * 192 + lg * 16); }
  { const int n = wid * 16 + (lane >> 2), c = (lane & 3) ^ ((n >> 2) & 3); offV = (unsigned)(n * 64 + c * 16); }
  const unsigned ldsw = (unsigned)wid * 1024u, lds0 = (unsigned)(uintptr_t)lds;
#define DMA16(gptr, ldsoff) glds16((gptr), (unsigned)__builtin_amdgcn_readfirstlane((int)(lds0 + (unsigned)(ldsoff))))
#define ISSUE_K(t, ks) do { const int t_ = (t) < NT ? (t) : NT - 1; const char* kn_ = (const char*)Knh + (size_t)t_ * (64 * 192) + offKn; \
    DMA16(kn_, AT_KN + (ks) * 16384 + ldsw); DMA16(kn_ + 32 * 192, AT_KN + (ks) * 16384 + 8192 + ldsw); } while (0)
#define ISSUE_V(t, vs) do { const int t_ = (t) < NT ? (t) : NT - 1; DMA16((const char*)Vh + (size_t)t_ * 8192 + offV, AT_V + (vs) * 8192 + ldsw); } while (0)
#define WAIT_BAR(N) asm volatile("s_waitcnt vmcnt(" #N ") lgkmcnt(0)\n\ts_barrier" ::: "memory")
#define RESC(a) do { if (__any((a) < 1.f)) { if (hi == 0) al_l[r32] = (a); asm volatile("s_waitcnt lgkmcnt(0)" ::: "memory"); \
    _Pragma("unroll") for (int r = 0; r < 16; ++r) { const float a_ = al_l[crow(r, hi)]; lsum[r] *= a_; _Pragma("unroll") for (int d = 0; d < 4; ++d) o[d][r] *= a_; } } } while (0)
  const bool trail = wid >= 4;
  ISSUE_K(0, 0); ISSUE_K(1, 1); ISSUE_V(0, 0);
  float m_reg = -1e30f; f32x16 lsum = {}; f32x16 o[4] = {}; v8i qr[3];
  { const unsigned char* Qw = Qb + (size_t)(wid * 32 + r32) * 192 + hi * 32;
#pragma unroll
    for (int s_ = 0; s_ < 3; ++s_) { const u32x4 lo = *(const u32x4*)(Qw + s_ * 64), h4 = *(const u32x4*)(Qw + s_ * 64 + 16);
      qr[s_] = (v8i){(int)lo[0], (int)lo[1], (int)lo[2], (int)lo[3], (int)h4[0], (int)h4[1], (int)h4[2], (int)h4[3]}; } }
  f32x16 pA0, pA1, pB0, pB1; float mnA, mnB, alA, alB; v8i pa = {};
  asm volatile("s_waitcnt vmcnt(0)" ::: "memory");
  __builtin_amdgcn_s_barrier();
  if (trail) __builtin_amdgcn_s_barrier();
  ISSUE_K(2, 2);
  qkt12(pA0, pA1, lds + AT_KN, qr, r32, hi);
  WAIT_BAR(3);
  ISSUE_V(1, 1);
  partialSM(pA0, pA1, m_reg, mnA, alA);
  WAIT_BAR(3);
  int s1 = 1;
  for (int j = 1; j + 1 < NT; j += 2) {
    const int s0 = s1 == 0 ? 2 : s1 - 1, s2 = s1 == 2 ? 0 : s1 + 1;
    ISSUE_K(j + 2, s0);
    SBAR(); qkt12(pB0, pB1, lds + AT_KN + s1 * 16384, qr, r32, hi);
    finishSM(pA0, pA1, pa); SBAR();
    WAIT_BAR(3);
    ISSUE_V(j + 1, s2);
    pv8(o, lsum, lds + AT_V + s0 * 8192, pa, r32, hi); partialSM(pB0, pB1, m_reg, mnB, alB);
    RESC(alB);
    WAIT_BAR(3);
    ISSUE_K(j + 3, s1);
    SBAR(); qkt12(pA0, pA1, lds + AT_KN + s2 * 16384, qr, r32, hi);
    finishSM(pB0, pB1, pa); SBAR();
    WAIT_BAR(3);
    ISSUE_V(j + 2, s0);
    pv8(o, lsum, lds + AT_V + s1 * 8192, pa, r32, hi); partialSM(pA0, pA1, m_reg, mnA, alA);
    RESC(alA);
    WAIT_BAR(3);
    s1 = s0;
  }
  {
    const int s0 = s1 == 0 ? 2 : s1 - 1, s2 = s1 == 2 ? 0 : s1 + 1;
    ISSUE_K(NT + 1, s0);
    SBAR(); qkt12(pB0, pB1, lds + AT_KN + s1 * 16384, qr, r32, hi);
    finishSM(pA0, pA1, pa); SBAR();
    WAIT_BAR(3);
    ISSUE_V(NT, s2);
    pv8(o, lsum, lds + AT_V + s0 * 8192, pa, r32, hi); partialSM(pB0, pB1, m_reg, mnB, alB);
    RESC(alB);
    WAIT_BAR(3);
    if (!trail) __builtin_amdgcn_s_barrier();
    finishSM(pB0, pB1, pa); SBAR();
    pv8(o, lsum, lds + AT_V + s1 * 8192, pa, r32, hi);
  }
  float rli[16];
#pragma unroll
  for (int r = 0; r < 16; ++r) rli[r] = __builtin_amdgcn_rcpf(lsum[r]);
  bf16_t* Ow = Ob + (size_t)(wid * 32) * 1024;
#pragma unroll
  for (int r = 0; r < 16; ++r) { const int orow = crow(r, hi);
#pragma unroll
    for (int d0 = 0; d0 < 4; ++d0) Ow[(size_t)orow * 1024 + d0 * 32 + r32] = f2bf(o[d0][r] * rli[r]); }
  asm volatile("s_waitcnt vmcnt(0) lgkmcnt(0)\n\ts_barrier" ::: "memory");
#undef DMA16
#undef ISSUE_K
#undef ISSUE_V
#undef WAIT_BAR
#undef RESC
}
DI void phase_attn(const Ctx& p, int bid, int G, LAS unsigned char* lds) {
  unsigned char* ws = p.ws;
  const unsigned char* qatt = ws + WS_QATT; const unsigned char* k8 = ws + WS_KN; const unsigned char* va = ws + WS_VA;
  bf16_t* hcat = (bf16_t*)(ws + WS_H);
  for (int u = bid; u < 512; u += G) {
    const int bh = u & 7, qb = u >> 3, b = bh >> 2, h = bh & 3;
    attn_unit(qatt + ((size_t)bh * SEQ + qb * 256) * 192, k8 + (size_t)bh * SEQ * 192, va + (size_t)bh * SEQ * 128,
              hcat + (size_t)(b * SEQ + qb * 256) * 1024 + 512 + h * 128, lds);
  }
}

constexpr int PC_K = 0, PC_V = 32768, PC_CF = 65536, PC_CB = 98304, PC_VEC = 131072;
template <bool DRY = false> DI void mlstmC_unit(const Ctx& p, int b, int h, int c, LAS unsigned char* lds) {
  const int tid = tid_fresh(), lane = tid & 63, wid = __builtin_amdgcn_readfirstlane(tid >> 6), r32 = lane & 31, hi = lane >> 5;
  unsigned char* ws = p.ws;
  const bf16_t* qkpost = (const bf16_t*)(ws + WS_U); const bf16_t* vmp = (const bf16_t*)(ws + WS_VM); bf16_t* hcat = (bf16_t*)(ws + WS_H);
  const float* gvec = (const float*)(ws + WS_GVEC); const float* nvec = (const float*)(ws + WS_NVEC); const float* mprev = (const float*)(ws + WS_SCAL) + 4096;
  const bf16_t* Cbuf = (const bf16_t*)p.out;
  LAS float* vec = (LAS float*)(lds + PC_VEC);
  const int bh = b * 4 + h, row0 = b * SEQ + c * 128;
  if (tid < 256) {
    const int dir = tid >> 7, t = tid & 127;
    const float* gv = gvec + ((size_t)(dir * 8 + bh) * SEQ + c * 128 + t) * 3;
    const float gb = gv[0], gcol = gv[1], gcm = gv[2], mp = mprev[(dir * 8 + bh) * 128 + c];
    const float M = fmaxf(mp, gcm);
    vec[dir * 128 + t] = gcol * LOG2E; vec[256 + dir * 128 + t] = M * LOG2E; vec[512 + dir * 128 + t] = __expf(mp - M); vec[768 + dir * 128 + t] = __expf(-(gb + M));
    vec[1024 + dir * 128 + t] = nvec[((size_t)(dir * 8 + bh) * 128 + c) * 128 + t];
  }
  {
    const int r0 = tid >> 4, c8 = (tid & 15) * 8;
    const bf16_t* Cf = Cbuf + ((size_t)(0 * 8 + bh) * 128 + c) * 16384; const bf16_t* Cb = Cbuf + ((size_t)(1 * 8 + bh) * 128 + c) * 16384;
#pragma unroll
    for (int ps = 0; ps < 4; ++ps) {
      const int r = r0 + 32 * ps, tile = r >> 6, rr = r & 63;
      *(LAS u32x4*)(lds + PC_K + tile * 16384 + KSWZ(rr, c8 * 2)) = *(const u32x4*)(qkpost + (size_t)(row0 + r) * 1024 + 512 + h * 128 + c8);
      *(LAS u32x4*)(lds + PC_V + tile * 16384 + v_st(rr, c8)) = *(const u32x4*)(vmp + (size_t)(row0 + r) * 512 + h * 128 + c8);
      *(LAS u32x4*)(lds + PC_CF + tile * 16384 + v_st(rr, c8)) = *(const u32x4*)(Cf + r * 128 + c8);
      *(LAS u32x4*)(lds + PC_CB + tile * 16384 + v_st(rr, c8)) = *(const u32x4*)(Cb + r * 128 + c8);
    }
  }
  const int dir = wid >> 2, tb = wid & 3, t = tb * 32 + r32;
  bf16x8 qr[8];
  { const bf16_t* Qw = qkpost + (size_t)(row0 + t) * 1024 + h * 128 + hi * 8;
#pragma unroll
    for (int d0 = 0; d0 < 8; ++d0) qr[d0] = *(const bf16x8*)(Qw + d0 * 16); }
  __syncthreads();
  const LAS float* vcol = vec + dir * 128; const LAS float* va_ = vec + 512 + dir * 128; const LAS float* vn = vec + 1024 + dir * 128;
  float qn = 0.f;
#pragma unroll
  for (int d0 = 0; d0 < 8; ++d0)
#pragma unroll
    for (int j = 0; j < 8; ++j) qn += bf2f((unsigned short)qr[d0][j]) * vn[d0 * 16 + hi * 8 + j];
  qn = half_swap_sum(qn);
  asm volatile("" : "+v"(qn));
  SBAR();
  f32x16 o[4] = {};
  {
    const int vbc = (int)(uintptr_t)(lds + (dir ? PC_CB : PC_CF)) + v_rd_base(lane);
    pv_d0(o, vbc, qr[0], qr[1], qr[2], qr[3]);
    pv_d0(o, vbc + 16384, qr[4], qr[5], qr[6], qr[7]);
  }
#pragma unroll
  for (int d = 0; d < 4; ++d)
#pragma unroll
    for (int r = 0; r < 16; ++r) o[d][r] *= va_[tb * 32 + crow(r, hi)];
  SBAR();
  const float Mt = vec[256 + dir * 128 + t], at = va_[t], flt = vec[768 + dir * 128 + t];
  float rsum = 0.f;
  const int vbv = (int)(uintptr_t)(lds + PC_V) + v_rd_base(lane);
#pragma unroll
  for (int kt = 0; kt < 2; ++kt) {
    const bool need = dir == 0 ? (kt * 64 <= tb * 32 + 31) : (kt * 64 + 63 >= tb * 32);
    if (need) {
      f32x16 p0, p1; qkt8(p0, p1, lds + PC_K + kt * 16384, qr, r32, hi);
#pragma unroll
      for (int r = 0; r < 16; ++r) {
        const int s0 = kt * 64 + crow(r, hi), s1 = s0 + 32;
        const bool ok0 = dir == 0 ? (s0 <= t) : (s0 >= t), ok1 = dir == 0 ? (s1 <= t) : (s1 >= t);
        const float w0 = __builtin_amdgcn_exp2f(vcol[s0] - Mt), w1 = __builtin_amdgcn_exp2f(vcol[s1] - Mt);
        p0[r] = ok0 ? p0[r] * w0 : 0.f; p1[r] = ok1 ? p1[r] * w1 : 0.f;
        rsum += p0[r] + p1[r];
      }
      bf16x8 pa0, pa1, pa2, pa3; pack_p(p0, p1, pa0, pa1, pa2, pa3);
      pv_d0(o, vbv + kt * 16384, pa0, pa1, pa2, pa3);
    }
  }
  rsum = half_swap_sum(rsum);
  {
    const float den = at * qn + rsum, dn = fmaxf(fabsf(den), flt);
    LAS float* rd = vec + 1280 + dir * 128;
    if (hi == 0) rd[t] = 1.f / dn;
    asm volatile("s_waitcnt lgkmcnt(0)" ::: "memory");
#pragma unroll
    for (int d = 0; d < 4; ++d)
#pragma unroll
      for (int r = 0; r < 16; ++r) o[d][r] *= rd[tb * 32 + crow(r, hi)];
  }
  __syncthreads();
  {
    LAS float* hst = (LAS float*)(lds + dir * 65536);
#pragma unroll
    for (int r = 0; r < 16; ++r) { const int tr = tb * 32 + crow(r, hi);
#pragma unroll
      for (int d = 0; d < 4; ++d) hst[tr * 128 + d * 32 + r32] = o[d][r]; }
  }
  __syncthreads();
  {
    const int rg = tid >> 5, cl = tid & 31;
    const f32x4 g = *(const f32x4*)(karg<A_MHG>() + h * 128 + 4 * cl);
    u32x2 sgv[8];
#pragma unroll
    for (int ps = 0; ps < 8; ++ps) sgv[ps] = *(const u32x2*)(hcat + (size_t)(row0 + ps * 16 + rg) * 1024 + h * 128 + 4 * cl);
#pragma unroll
    for (int ps = 0; ps < 8; ++ps) {
      const int tr = ps * 16 + rg;
      const f32x4 xf = *(const LAS f32x4*)(lds + (tr * 128 + 4 * cl) * 4), xb = *(const LAS f32x4*)(lds + 65536 + (tr * 128 + 4 * cl) * 4);
      f32x4 x = xf + xb;
      float s = (x[0] + x[1]) + (x[2] + x[3]);
#pragma unroll
      for (int o_ = 1; o_ < 32; o_ <<= 1) s += __shfl_xor(s, o_);
      const float mu = s * (1.f / 128.f); x = x - mu;
      float q = (x[0] * x[0] + x[1] * x[1]) + (x[2] * x[2] + x[3] * x[3]);
#pragma unroll
      for (int o_ = 1; o_ < 32; o_ <<= 1) q += __shfl_xor(q, o_);
      const float rstd = rsqrtf(q * (1.f / 128.f) + LN_EPS);
      u32x2* dst = (u32x2*)(hcat + (size_t)(row0 + tr) * 1024 + h * 128 + 4 * cl);
      const u32x2 sg = sgv[ps];
      const f32x4 y = x * rstd * g;
      if (DRY) dst = (u32x2*)((bf16_t*)(ws + WS_QKPRE) + (size_t)(row0 + tr) * 1024 + h * 128 + 4 * cl);
      *dst = (u32x2){cvtpk(y[0] * bflo(sg[0]), y[1] * bfhi(sg[0])), cvtpk(y[2] * bflo(sg[1]), y[3] * bfhi(sg[1]))};
    }
  }
  __syncthreads();
}

template <bool DRY = false> DI void phase_hanorm(const Ctx& p, int bid, int G) {
  const int tid = tid_fresh(), lane = tid & 63, wave = tid >> 6; bf16_t* hcat = (bf16_t*)(p.ws + WS_H);
  const f32x4 g0 = *(const f32x4*)(karg<A_ANG>() + 8 * lane), g1 = *(const f32x4*)(karg<A_ANG>() + 8 * lane + 4);
  u32x4 wn = {0u, 0u, 0u, 0u};
  { const int row = bid * 8 + wave; if (row < T) wn = *(const u32x4*)(hcat + (size_t)row * 1024 + 512 + 8 * lane); }
  for (int row = bid * 8 + wave; row < T; row += G * 8) {
    u32x4* ptr = (u32x4*)(hcat + (size_t)row * 1024 + 512 + 8 * lane);
    const u32x4 w = wn;
    if (row + G * 8 < T) wn = *(const u32x4*)(hcat + (size_t)(row + G * 8) * 1024 + 512 + 8 * lane);
    float v[8] = {bflo(w[0]), bfhi(w[0]), bflo(w[1]), bfhi(w[1]), bflo(w[2]), bfhi(w[2]), bflo(w[3]), bfhi(w[3])};
    float s = 0.f;
#pragma unroll
    for (int e = 0; e < 8; ++e) s += v[e] * v[e];
    const float rs = rsqrtf(wave_sum(s) * (1.f / 512.f) + RMS_EPS);
    if (DRY) ptr = (u32x4*)((bf16_t*)(p.ws + WS_QKPRE) + (size_t)row * 1024 + 512 + 8 * lane);
    *ptr = (u32x4){cvtpk(v[0] * rs * g0[0], v[1] * rs * g0[1]), cvtpk(v[2] * rs * g0[2], v[3] * rs * g0[3]), cvtpk(v[4] * rs * g1[0], v[5] * rs * g1[1]), cvtpk(v[6] * rs * g1[2], v[7] * rs * g1[3])};
  }
}

template <bool DRY = false> DI void phase_route(const Ctx& p, int bid, int G, LAS unsigned char* lds) {
  const int tid = tid_fresh(), lane = tid & 63, wave = tid >> 6; unsigned char* ws = p.ws;
  LAS float* wreT = (LAS float*)lds;
  LAS float* wrgT = (LAS float*)(lds + 131072);
  LAS int* rec = (LAS int*)(lds + 147456);
  LAS int* lcnt = (LAS int*)(lds + 147456 + 2048);
  { const f32x4* wrt = (const f32x4*)(ws + WS_WRT);
    for (int i = tid; i < 36 * 256; i += NTHREADS) ((LAS f32x4*)lds)[i] = wrt[i]; }
  const float* ln1_g = karg<A_LN1G>(); const float* ln1_b = karg<A_LN1B>(); const float* b_rg = karg<A_BRG>(); const float* b_re = karg<A_BRE>();
  const float* mod = (const float*)(ws + WS_MOD); bf16_t* U = (bf16_t*)(ws + WS_U);
  int* cnt = (int*)(ws + WS_CNT) + (DRY ? 32 * CNT_STRIDE : 0);
  int* ltok = (int*)(ws + (DRY ? WS_HDN : WS_LTOK)); float* lw = (float*)(ws + (DRY ? WS_HDN + 8 * MiB : WS_LW));
  int* toke = (int*)(ws + WS_TOKE) + (DRY ? 2 * T : 0); int* tokp = (int*)(ws + WS_TOKP) + (DRY ? 2 * T : 0);
  const int nk = T / (G * 8);
  for (int k0 = 0; k0 < nk; k0 += 16) {
    if (tid < 32) lcnt[tid] = 0;
    __syncthreads();
    u32x2 zn[4];
    { const u32x2* zr = (const u32x2*)((const bf16_t*)p.out + (size_t)(bid * 8 + wave + k0 * G * 8) * 1024) + lane;
#pragma unroll
      for (int j = 0; j < 4; ++j) zn[j] = zr[64 * j]; }
    for (int kk = 0; kk < 16 && k0 + kk < nk; ++kk) {
      const int row = bid * 8 + wave + (k0 + kk) * G * 8, b = row >> 14;
      u32x2* x1r = (u32x2*)((bf16_t*)(ws + (DRY ? 384 * MiB : WS_H)) + (size_t)row * 1024) + lane;
      f32x4 v[4]; float s = 0.f;
#pragma unroll
      for (int j = 0; j < 4; ++j) { const u32x2 raw = zn[j]; v[j] = (f32x4){bflo(raw[0]), bfhi(raw[0]), bflo(raw[1]), bfhi(raw[1])}; s += (v[j][0] + v[j][1]) + (v[j][2] + v[j][3]); }
      if (kk + 1 < 16 && k0 + kk + 1 < nk) { const u32x2* zr = (const u32x2*)((const bf16_t*)p.out + (size_t)(row + G * 8) * 1024) + lane;
#pragma unroll
        for (int j = 0; j < 4; ++j) zn[j] = zr[64 * j]; }
      float mean = wave_sum(s) * (1.f / 1024.f), s2 = 0.f;
#pragma unroll
      for (int j = 0; j < 4; ++j) { v[j] = v[j] - mean; s2 += (v[j][0] * v[j][0] + v[j][1] * v[j][1]) + (v[j][2] * v[j][2] + v[j][3] * v[j][3]); }
      float rstd = rsqrtf(wave_sum(s2) * (1.f / 1024.f) + LN_EPS);
      s = 0.f;
#pragma unroll
      for (int j = 0; j < 4; ++j) { const int col = 4 * lane + 256 * j;
        v[j] = v[j] * rstd * *(const f32x4*)(ln1_g + col) + *(const f32x4*)(ln1_b + col);
        x1r[64 * j] = (u32x2){cvtpk(v[j][0], v[j][1]), cvtpk(v[j][2], v[j][3])};
        s += (v[j][0] + v[j][1]) + (v[j][2] + v[j][3]); }
      mean = wave_sum(s) * (1.f / 1024.f); s2 = 0.f;
#pragma unroll
      for (int j = 0; j < 4; ++j) { v[j] = v[j] - mean; s2 += (v[j][0] * v[j][0] + v[j][1] * v[j][1]) + (v[j][2] * v[j][2] + v[j][3] * v[j][3]); }
      rstd = rsqrtf(wave_sum(s2) * (1.f / 1024.f) + LN_EPS);
      u32x2* o8 = (u32x2*)(U + (size_t)row * 1024) + lane;
      float gl[4] = {0.f, 0.f, 0.f, 0.f};
#pragma unroll
      for (int j = 0; j < 4; ++j) { const int col = 4 * lane + 256 * j;
        v[j] = v[j] * rstd * (*(const f32x4*)(mod + b * 6144 + 4096 + col) + 1.f) + *(const f32x4*)(mod + b * 6144 + 3072 + col);
        o8[64 * j] = (u32x2){cvtpk(v[j][0], v[j][1]), cvtpk(v[j][2], v[j][3])};
#pragma unroll
        for (int e = 0; e < 4; ++e) { const f32x4 w = *(const LAS f32x4*)(wrgT + e * 1024 + col); gl[e] += v[j][0] * w[0] + v[j][1] * w[1] + v[j][2] * w[2] + v[j][3] * w[3]; } }
#pragma unroll
      for (int e = 0; e < 4; ++e) gl[e] = wave_sum(gl[e]) + b_rg[e];
      int gi = 0; float gm = gl[0];
#pragma unroll
      for (int e = 1; e < 4; ++e) if (gl[e] > gm) { gm = gl[e]; gi = e; }
      float gs = 0.f;
#pragma unroll
      for (int e = 0; e < 4; ++e) gs += __expf(gl[e] - gm);
      const float gw = 1.f / gs;
      float el[8] = {0.f, 0.f, 0.f, 0.f, 0.f, 0.f, 0.f, 0.f};
#pragma unroll
      for (int j = 0; j < 4; ++j) { const int col = 4 * lane + 256 * j;
#pragma unroll
        for (int e = 0; e < 8; ++e) { const f32x4 w = *(const LAS f32x4*)(wreT + (gi * 8 + e) * 1024 + col); el[e] += v[j][0] * w[0] + v[j][1] * w[1] + v[j][2] * w[2] + v[j][3] * w[3]; } }
#pragma unroll
      for (int e = 0; e < 8; ++e) el[e] = wave_sum(el[e]) + b_re[gi * 8 + e];
      int i1 = 0; float v1 = el[0];
#pragma unroll
      for (int e = 1; e < 8; ++e) if (el[e] > v1) { v1 = el[e]; i1 = e; }
      int i2 = (i1 == 0) ? 1 : 0; float v2 = (i1 == 0) ? el[1] : el[0];
#pragma unroll
      for (int e = 0; e < 8; ++e) if (e != i1 && el[e] > v2) { v2 = el[e]; i2 = e; }
      const float p1 = 1.f / (1.f + __expf(v2 - v1)), p2 = 1.f - p1;
      if (lane == 0) {
        const int e1 = gi * 8 + i1, e2 = gi * 8 + i2, li = kk * 8 + wave;
        const int q1 = __hip_atomic_fetch_add(&lcnt[e1], 1, __ATOMIC_RELAXED, __HIP_MEMORY_SCOPE_WORKGROUP), q2 = __hip_atomic_fetch_add(&lcnt[e2], 1, __ATOMIC_RELAXED, __HIP_MEMORY_SCOPE_WORKGROUP);
        rec[li * 4 + 0] = e1 | (e2 << 8); rec[li * 4 + 1] = q1 | (q2 << 16); rec[li * 4 + 2] = __float_as_int(p1 * gw); rec[li * 4 + 3] = __float_as_int(p2 * gw);
      }
    }
    __syncthreads();
    if (tid < 32) { const int n = lcnt[tid]; lcnt[32 + tid] = n ? atomicAdd(&cnt[tid * CNT_STRIDE], n) : 0; }
    __syncthreads();
    if (tid < 128 && k0 + (tid >> 3) < nk) {
      const int li = tid, row = bid * 8 + (li & 7) + (k0 + (li >> 3)) * G * 8;
      const int ee = rec[li * 4], qq = rec[li * 4 + 1], e1 = ee & 255, e2 = ee >> 8, q1 = lcnt[32 + e1] + (qq & 0xffff), q2 = lcnt[32 + e2] + (qq >> 16);
      ltok[(size_t)e1 * T + q1] = row; lw[(size_t)e1 * T + q1] = __int_as_float(rec[li * 4 + 2]);
      ltok[(size_t)e2 * T + q2] = row; lw[(size_t)e2 * T + q2] = __int_as_float(rec[li * 4 + 3]);
      toke[row * 2] = e1; toke[row * 2 + 1] = e2; tokp[row * 2] = q1; tokp[row * 2 + 1] = q2;
    }
    __syncthreads();
  }
}

constexpr int MOE_TS = 131072;
DI void moe_table(const Ctx& p, LAS unsigned char* lds) {
  LAS int* ts = (LAS int*)(lds + MOE_TS); const int* cnt = (const int*)(p.ws + WS_CNT);
  if (threadIdx.x < 64) {
    const int lane = threadIdx.x; const int n = lane < 32 ? (cnt[lane * CNT_STRIDE] + 255) >> 8 : 0; int a = n;
#pragma unroll
    for (int o = 1; o < 32; o <<= 1) { const int t = __shfl_up(a, o); a += lane >= o ? t : 0; }
    if (lane < 32) ts[lane] = a - n;
    if (lane == 31) ts[32] = a;
  }
  __syncthreads();
}

template <bool DRY = false> DI void phase_final(const Ctx& p, int bid, int G, LAS unsigned char* lds) {
  const int tid = tid_fresh(), lane = tid & 63, wave = tid >> 6; unsigned char* ws = p.ws;
  const LAS int* ts = (const LAS int*)(lds + MOE_TS); const float* ln2_g = karg<A_LN2G>(); const float* ln2_b = karg<A_LN2B>();
  const float* mod = (const float*)(ws + WS_MOD); const bf16_t* ybuf = (const bf16_t*)(ws + WS_YBUF); const int* toke = (const int*)(ws + WS_TOKE); const int* tokp = (const int*)(ws + WS_TOKP);
  const int stride = G * 8; int row = bid * 8 + wave;
  size_t s0n = 0, s1n = 0;
  u32x2 an[4], cn[4], xn[4];
  auto slots = [&](int r, size_t& a, size_t& c) { a = (size_t)ts[toke[r * 2]] * 256 + tokp[r * 2]; c = (size_t)ts[toke[r * 2 + 1]] * 256 + tokp[r * 2 + 1]; };
  auto loadrow = [&](int r, size_t a, size_t c) {
    const u32x2* x1r = (const u32x2*)((const bf16_t*)(ws + WS_H) + (size_t)r * 1024) + lane;
    const u32x2* y0 = (const u32x2*)(ybuf + a * 1024) + lane; const u32x2* y1 = (const u32x2*)(ybuf + c * 1024) + lane;
#pragma unroll
    for (int j = 0; j < 4; ++j) { an[j] = y0[64 * j]; cn[j] = y1[64 * j]; xn[j] = x1r[64 * j]; } };
  if (row < T) { size_t a, c; slots(row, a, c); loadrow(row, a, c); if (row + stride < T) slots(row + stride, s0n, s1n); }
  for (; row < T; row += stride) {
    const int b = row >> 14;
    f32x4 v[4]; float s = 0.f;
#pragma unroll
    for (int j = 0; j < 4; ++j) { const int col = 4 * lane + 256 * j;
      const u32x2 a = an[j], c = cn[j], xw = xn[j];
      const f32x4 y = {bflo(a[0]) + bflo(c[0]), bfhi(a[0]) + bfhi(c[0]), bflo(a[1]) + bflo(c[1]), bfhi(a[1]) + bfhi(c[1])};
      const f32x4 x1v = {bflo(xw[0]), bfhi(xw[0]), bflo(xw[1]), bfhi(xw[1])};
      v[j] = x1v * ALPHA + (*(const f32x4*)(mod + b * 6144 + 5120 + col) + 1.f) * y;
      s += (v[j][0] + v[j][1]) + (v[j][2] + v[j][3]); }
    if (row + stride < T) { loadrow(row + stride, s0n, s1n); if (row + 2 * stride < T) slots(row + 2 * stride, s0n, s1n); }
    const float mean = wave_sum(s) * (1.f / 1024.f); float s2 = 0.f;
#pragma unroll
    for (int j = 0; j < 4; ++j) { v[j] = v[j] - mean; s2 += (v[j][0] * v[j][0] + v[j][1] * v[j][1]) + (v[j][2] * v[j][2] + v[j][3] * v[j][3]); }
    const float rstd = rsqrtf(wave_sum(s2) * (1.f / 1024.f) + LN_EPS);
    f32x4* xr = (f32x4*)(p.out + (size_t)row * 1024) + lane;
#pragma unroll
    for (int j = 0; j < 4; ++j) { const int col = 4 * lane + 256 * j; xr[64 * j] = v[j] * rstd * *(const f32x4*)(ln2_g + col) + *(const f32x4*)(ln2_b + col); }
  }
}


#define XB_TMO      128
#define XB_XCNT(j)  (256  + 64 * (j))
#define XB_XSUB(j)  (1280 + 64 * (j))
#define XB_XGEN(j)  (2304 + 64 * (j))
#define XB_TOP      3328
#define XB_TOPGEN   3392
#define XCD_BAR_WORDS 3456
#define XB_SPIN_CAP (1u << 18)
DI unsigned xb_ld(unsigned* p)              { return __hip_atomic_load(p, __ATOMIC_RELAXED, __HIP_MEMORY_SCOPE_AGENT); }
DI unsigned xb_add(unsigned* p, unsigned v) { return __hip_atomic_fetch_add(p, v, __ATOMIC_RELAXED, __HIP_MEMORY_SCOPE_AGENT); }
DI unsigned xb_xcc_id() { return (unsigned)__builtin_amdgcn_s_getreg((3 << 11) | 20) & 0xFu; }
#define XB_SPIN(cond, bar) do { unsigned _sp = 0; while (cond) { __builtin_amdgcn_s_sleep(1); \
    if ((++_sp & 255u) == 0u) { if (xb_ld(&(bar)[XB_TMO])) break; if (_sp > XB_SPIN_CAP) { atomicAdd(&(bar)[XB_TMO], 1u); break; } } } } while (0)
struct XcdBarrier { unsigned* bar; unsigned x; volatile LAS unsigned* st; };
DI XcdBarrier xcd_barrier_post(unsigned* bar, volatile LAS unsigned* st) {
  XcdBarrier b; b.bar = bar; b.x = xb_xcc_id(); b.st = st;
  if (threadIdx.x == 0) (void)xb_add(&bar[XB_XCNT(b.x)], 1u);
  return b;
}
DI void xcd_barrier_complete(unsigned* bar, unsigned x, unsigned& nloc, unsigned& nx) {
  const unsigned G = gridDim.x * gridDim.y * gridDim.z;
  unsigned sum, cnt, mine, sp = 0u;
  for (;;) {
    sum = 0u; cnt = 0u; mine = 0u;
#pragma unroll
    for (unsigned j = 0; j < 16; ++j) { const unsigned c = xb_ld(&bar[XB_XCNT(j)]); sum += c; cnt += (c > 0u) ? 1u : 0u; mine = (j == x) ? c : mine; }
    if (sum == G) break;
    __builtin_amdgcn_s_sleep(1);
    if ((++sp & 255u) == 0u) { if (xb_ld(&bar[XB_TMO])) break; if (sp > XB_SPIN_CAP) { atomicAdd(&bar[XB_TMO], 1u); break; } }
  }
  nloc = mine > 0u ? mine : 1u; nx = cnt > 0u ? cnt : 1u;
}
DI void xcd_barrier(const XcdBarrier& b) {
  asm volatile("s_waitcnt vmcnt(0)" ::: "memory");
  __syncthreads();
  if (threadIdx.x == 0) {
    unsigned* bar = b.bar;
    __builtin_amdgcn_s_waitcnt(0);
    unsigned nloc = b.st[0], nx = b.st[1];
    if (nloc == 0u) { xcd_barrier_complete(bar, b.x, nloc, nx); b.st[0] = nloc; b.st[1] = nx; }
    const unsigned old = xb_add(&bar[XB_XSUB(b.x)], 1u);
    const unsigned gen = old / nloc;
    if (old + 1u == (gen + 1u) * nloc) {
      __builtin_amdgcn_fence(__ATOMIC_RELEASE, "agent");
      asm volatile("s_waitcnt vmcnt(0)" ::: "memory");
      const unsigned og = xb_add(&bar[XB_TOP], 1u);
      const unsigned tg = og / nx;
      if (og + 1u == (tg + 1u) * nx) xb_add(&bar[XB_TOPGEN], 1u);
      else XB_SPIN(xb_ld(&bar[XB_TOPGEN]) == tg, bar);
      __builtin_amdgcn_fence(__ATOMIC_ACQUIRE, "agent");
      xb_add(&bar[XB_XGEN(b.x)], 1u);
      asm volatile("s_waitcnt vmcnt(0)" ::: "memory");
    } else {
      XB_SPIN(xb_ld(&bar[XB_XGEN(b.x)]) == gen, bar);
      __builtin_amdgcn_fence(__ATOMIC_ACQUIRE, "agent");
      asm volatile("s_waitcnt vmcnt(0)" ::: "memory");
    }
  }
  __syncthreads();
}

__device__ unsigned g_bar_counter = 0;
DI void grid_barrier(const unsigned G) {
  asm volatile("s_waitcnt vmcnt(0)" ::: "memory");
  __syncthreads();
  if (threadIdx.x == 0) {
    __builtin_amdgcn_fence(__ATOMIC_RELEASE, "agent");
    asm volatile("s_waitcnt vmcnt(0)" ::: "memory");
    const unsigned old = __hip_atomic_fetch_add(&g_bar_counter, 1u, __ATOMIC_RELAXED, __HIP_MEMORY_SCOPE_AGENT);
    const unsigned target = (old / G + 1u) * G;
    unsigned sp = 0;
    while ((int)(__hip_atomic_load(&g_bar_counter, __ATOMIC_RELAXED, __HIP_MEMORY_SCOPE_AGENT) - target) < 0) { __builtin_amdgcn_s_sleep(1); if (++sp > (1u << 24)) break; }
    __builtin_amdgcn_fence(__ATOMIC_ACQUIRE, "agent");
    asm volatile("s_waitcnt vmcnt(0)" ::: "memory");
  }
  __syncthreads();
}

#define KERNEL_HEAD extern __shared__ __attribute__((aligned(16))) unsigned char lds_raw[]; LAS unsigned char* lds = (LAS unsigned char*)lds_raw; const int bid = blockIdx.x, G = gridDim.x; \
  Ctx p; p.ws = karg<A_WS, unsigned char>(); p.out = karg<A_OUT, float>();
#ifdef MULTI_LAUNCH
__global__ void __launch_bounds__(NTHREADS, 2) k_prep(Params) { KERNEL_HEAD phase_prep(p, bid, G, lds); }
__global__ void __launch_bounds__(NTHREADS, 2) k_lnmod(Params) { KERNEL_HEAD (void)lds; phase_lnmod(p, bid, G); }
__global__ void __launch_bounds__(NTHREADS, 2) k_inproj(Params) { KERNEL_HEAD
  unsigned char* ws = p.ws;
  g8::DenseOrder S; S.init(T, N_INP, 1024, ws + WS_WIN, G, bid);
  EpiIn E{(bf16_t*)(ws + WS_QKPRE), (bf16_t*)(ws + WS_VM), (bf16_t*)(ws + WS_H), (bf16_t*)(ws + WS_CQ), (bf16_t*)(ws + WS_CKV), (unsigned char*)(ws + WS_KN), (float*)(ws + WS_GATES),
          (float*)(ws + WS_SSQQ), (float*)(ws + WS_SSQKV), (const float*)(ws + WS_ROPE), karg<A_GATEB>()};
  g8::gemm_phase(lds, (const char*)(ws + WS_U), 1024, S, E);
}
__global__ void __launch_bounds__(NTHREADS, 2) k_mid1(Params) { KERNEL_HEAD
  unsigned char* ws = p.ws;
  { g8::DenseOrder S; S.init(T, 768, 384, ws + WS_WUQ, G, bid); EpiUQ E{(unsigned char*)(ws + WS_QATT), (const float*)(ws + WS_SSQQ), (const float*)(ws + WS_ROPE)};
    g8::gemm_phase(lds, (const char*)(ws + WS_CQ), 384, S, E); }
}
__global__ void __launch_bounds__(NTHREADS, 2) k_mid2(Params) { KERNEL_HEAD
  unsigned char* ws = p.ws;
  { g8::DenseOrder S; S.init(T, 1024, 256, ws + WS_WUKV, G, bid); EpiUKV E{(unsigned char*)(ws + WS_KN), (unsigned char*)(ws + WS_VA), (const float*)(ws + WS_SSQKV)};
    g8::gemm_phase(lds, (const char*)(ws + WS_CKV), 256, S, E); }
}
__global__ void __launch_bounds__(NTHREADS, 2) k_mid3(Params) { KERNEL_HEAD
  for (int u = bid; u < 1024; u += G) { const int c = u & 127, bh = u >> 7; mlstmA_unit(p, bh >> 2, bh & 3, c, lds); }
}
__global__ void __launch_bounds__(NTHREADS, 2) k_scan_attn(Params) { KERNEL_HEAD phase_scan(p, bid, G); phase_attn(p, bid, G, lds); }
__global__ void __launch_bounds__(NTHREADS, 2) k_mlstm_out(Params) { KERNEL_HEAD
  for (int u = bid; u < 1024; u += G) { const int c = u & 127, bh = u >> 7; mlstmC_unit(p, bh >> 2, bh & 3, c, lds); }
  phase_hanorm(p, bid, G);
}
__global__ void __launch_bounds__(NTHREADS, 2) k_outproj(Params) { KERNEL_HEAD
  unsigned char* ws = p.ws;
  g8::DenseOrder S; S.init(T, 1024, 1024, ws + WS_WOUT, G, bid); EpiOut E{karg<A_X>(), (const float*)(ws + WS_MOD), (bf16_t*)p.out};
  g8::gemm_phase(lds, (const char*)(ws + WS_H), 1024, S, E);
}
__global__ void __launch_bounds__(NTHREADS, 2) k_route(Params) { KERNEL_HEAD phase_route(p, bid, G, lds); }
__global__ void __launch_bounds__(NTHREADS, 2) k_moe_gu(Params) { KERNEL_HEAD
  unsigned char* ws = p.ws; moe_table(p, lds);
  MoeOrderGU S; S.tstart = (const LAS int*)(lds + MOE_TS); S.cnt = (const int*)(ws + WS_CNT); S.G = G; S.c = bid; S.ltok = (const int*)(ws + WS_LTOK); S.Bt = (const char*)(ws + WS_WGU);
  EpiGU E{(bf16_t*)(ws + WS_HDN)};
  g8::gemm_phase(lds, (const char*)(ws + WS_U), 1024, S, E);
}
__global__ void __launch_bounds__(NTHREADS, 2) k_moe_dn(Params) { KERNEL_HEAD
  unsigned char* ws = p.ws; moe_table(p, lds);
  MoeOrderDN S; S.tstart = (const LAS int*)(lds + MOE_TS); S.cnt = (const int*)(ws + WS_CNT); S.G = G; S.c = bid; S.Bt = (const char*)(ws + WS_WDN);
  EpiDN E{(bf16_t*)(ws + WS_YBUF), (const float*)(ws + WS_LW)};
  g8::gemm_phase(lds, (const char*)(ws + WS_HDN), 512, S, E);
}
__global__ void __launch_bounds__(NTHREADS, 2) k_final(Params) { KERNEL_HEAD moe_table(p, lds); phase_final(p, bid, G, lds); }

#endif

__global__ void __launch_bounds__(NTHREADS, 2) k_mega(Params) { KERNEL_HEAD
  unsigned char* ws = p.ws;
  if (bid == 0) for (int i = threadIdx.x; i < XCD_BAR_WORDS; i += NTHREADS) ((unsigned*)(ws + WS_BAR))[i] = 0u;
  if (threadIdx.x < 64) ((LAS unsigned*)(lds + LDS_BARST))[threadIdx.x] = 0u;
  XcdBarrier xbar; xbar.bar = (unsigned*)(ws + WS_BAR); xbar.x = 0; xbar.st = (volatile LAS unsigned*)(lds + LDS_BARST);
  bool xb_ready = false;
#define PHASE_SEP() do { asm volatile("" ::: "memory"); if (!xb_ready) { grid_barrier((unsigned)G); xbar = xcd_barrier_post((unsigned*)(ws + WS_BAR), (volatile LAS unsigned*)(lds + LDS_BARST)); xb_ready = true; } \
    else xcd_barrier(xbar); asm volatile("" ::: "memory"); } while (0)
#define REP(n) for (int rep_ = 0; rep_ < ((n) == DBL_PHASE ? 2 : 1); ++rep_)
  REP(0) phase_prep(p, bid, G, lds);
  PHASE_SEP();
#if MEGA_STOP == 1
  return;
#endif
  REP(1) phase_lnmod(p, bid, G);
  PHASE_SEP();
#if MEGA_STOP == 2
  return;
#endif
  REP(2) { g8::DenseOrder S; S.init(T, N_INP, 1024, ws + WS_WIN, G, bid);
    EpiIn E{(bf16_t*)(ws + WS_QKPRE), (bf16_t*)(ws + WS_VM), (bf16_t*)(ws + WS_H), (bf16_t*)(ws + WS_CQ), (bf16_t*)(ws + WS_CKV), (unsigned char*)(ws + WS_KN), (float*)(ws + WS_GATES),
            (float*)(ws + WS_SSQQ), (float*)(ws + WS_SSQKV), (const float*)(ws + WS_ROPE), karg<A_GATEB>()};
    g8::gemm_phase(lds, (const char*)(ws + WS_U), 1024, S, E);
    { const int first = S.nwg % G, nb = G - first;
      if (bid >= first) { const int tid = tid_fresh(), lane = tid & 63, wave = __builtin_amdgcn_readfirstlane(tid >> 6);
        prep_items(PREP_ITEMS - PREP_DEFER + (bid - first) * 8 + wave, PREP_ITEMS, nb * 8, lane, ws, (LAS float*)(lds + wave * 16384)); } } }
  PHASE_SEP();
#if MEGA_STOP == 3
  return;
#endif
  REP(3) { REP(31) { g8::DenseOrder S; S.init(T, 768, 384, ws + WS_WUQ, G, bid); EpiUQ E{(unsigned char*)(ws + WS_QATT), (const float*)(ws + WS_SSQQ), (const float*)(ws + WS_ROPE)};
    g8::gemm_phase(lds, (const char*)(ws + WS_CQ), 384, S, E); }
  __syncthreads();
  REP(32) { g8::DenseOrder S; S.init(T, 1024, 256, ws + WS_WUKV, G, bid); EpiUKV E{(unsigned char*)(ws + WS_KN), (unsigned char*)(ws + WS_VA), (const float*)(ws + WS_SSQKV)};
    g8::gemm_phase(lds, (const char*)(ws + WS_CKV), 256, S, E); }
  __syncthreads();
  REP(33) for (int u = bid; u < 1024; u += G) { const int c = u & 127, bh = u >> 7; mlstmA_unit(p, bh >> 2, bh & 3, c, lds); } }
  PHASE_SEP();
#if MEGA_STOP == 4
  return;
#endif
  phase_scan(p, bid, G);
  REP(4) phase_attn(p, bid, G, lds);
  PHASE_SEP();
#if MEGA_STOP == 5
  return;
#endif
#if DBL_PHASE == 5
  for (int u = bid; u < 1024; u += G) { const int c = u & 127, bh = u >> 7; mlstmC_unit<true>(p, bh >> 2, bh & 3, c, lds); }
#endif
#if DBL_PHASE == 55
  phase_hanorm<true>(p, bid, G);
#endif
  for (int u = bid; u < 1024; u += G) { const int c = u & 127, bh = u >> 7; mlstmC_unit(p, bh >> 2, bh & 3, c, lds); }
  phase_hanorm(p, bid, G);
  PHASE_SEP();
#if MEGA_STOP == 6
  return;
#endif
  REP(6) { g8::DenseOrder S; S.init(T, 1024, 1024, ws + WS_WOUT, G, bid); EpiOut E{karg<A_X>(), (const float*)(ws + WS_MOD), (bf16_t*)p.out};
    g8::gemm_phase(lds, (const char*)(ws + WS_H), 1024, S, E); }
  PHASE_SEP();
#if MEGA_STOP == 7
  return;
#endif
#if DBL_PHASE == 7
  phase_route<true>(p, bid, G, lds);
#endif
  phase_route(p, bid, G, lds);
  PHASE_SEP();
#if MEGA_STOP == 8
  return;
#endif
  moe_table(p, lds);
  REP(8) { MoeOrderGU S; S.tstart = (const LAS int*)(lds + MOE_TS); S.cnt = (const int*)(ws + WS_CNT); S.G = G; S.c = bid; S.ltok = (const int*)(ws + WS_LTOK); S.Bt = (const char*)(ws + WS_WGU);
    EpiGU E{(bf16_t*)(ws + WS_HDN)};
    g8::gemm_phase(lds, (const char*)(ws + WS_U), 1024, S, E); }
  PHASE_SEP();
#if MEGA_STOP == 9
  return;
#endif
  REP(9) { MoeOrderDN S; S.tstart = (const LAS int*)(lds + MOE_TS); S.cnt = (const int*)(ws + WS_CNT); S.G = G; S.c = bid; S.Bt = (const char*)(ws + WS_WDN);
    EpiDN E{(bf16_t*)(ws + WS_YBUF), (const float*)(ws + WS_LW)};
    g8::gemm_phase(lds, (const char*)(ws + WS_HDN), 512, S, E); }
  PHASE_SEP();
#if MEGA_STOP == 10
  return;
#endif
#if DBL_PHASE == 10
  phase_final<true>(p, bid, G, lds);
#endif
  phase_final(p, bid, G, lds);
#undef REP
#undef PHASE_SEP
}

#ifdef PROBE_OFF
__global__ void __launch_bounds__(NTHREADS, 2) k_probe(Params p, size_t off, size_t n, int is_f32, int from_out) {
  const unsigned char* base = from_out ? (const unsigned char*)p.out : p.ws + off;
  for (size_t i = (size_t)blockIdx.x * NTHREADS + threadIdx.x; i < (size_t)T * D; i += (size_t)gridDim.x * NTHREADS) {
    const size_t j = i % n; float v = is_f32 ? ((const float*)base)[j] : bf2f(((const unsigned short*)base)[j]);
    if (!(fabsf(v) < 1e30f)) v = 777.f;
    if (from_out) { if (j != i) break; ((float*)p.out)[i] = v; } else p.out[i] = v;
  }
}
#endif
extern "C" void kernel_launch(void* const* d_in, const int* in_sizes, int n_in, void* d_out, int out_size, void* d_ws, size_t ws_size, hipStream_t stream) {
  static int ok = 0, grid = 256;
  typedef void (*kfn)(Params);
#ifndef MULTI_LAUNCH
  const kfn kernels[] = {k_mega};
#else
  const kfn kernels[] = {k_prep, k_lnmod, k_inproj, k_mid1, k_mid2, k_mid3, k_scan_attn, k_mlstm_out, k_outproj, k_route, k_moe_gu, k_moe_dn, k_final};
#endif
  if (ok == 0) {
    if (n_in != 27 || in_sizes[0] != T * D || out_size != T * D || ws_size < WS_END) { fprintf(stderr, "kernel_launch: unexpected shapes (n_in %d, in0 %d, out %d, ws %zu)\n", n_in, n_in > 0 ? in_sizes[0] : -1, out_size, ws_size); ok = -1; return; }
    for (kfn k : kernels) if (hipFuncSetAttribute((const void*)k, hipFuncAttributeMaxDynamicSharedMemorySize, LDS_BYTES) != hipSuccess) { fprintf(stderr, "kernel_launch: hipFuncSetAttribute failed\n"); ok = -1; return; }
    int dev = 0, cus = 0, per_cu = 0;
    if (hipGetDevice(&dev) != hipSuccess || hipDeviceGetAttribute(&cus, hipDeviceAttributeMultiprocessorCount, dev) != hipSuccess) { fprintf(stderr, "kernel_launch: device query failed\n"); ok = -1; return; }
    if (hipOccupancyMaxActiveBlocksPerMultiprocessor(&per_cu, (const void*)kernels[0], NTHREADS, LDS_BYTES) != hipSuccess || per_cu < 1) { fprintf(stderr, "kernel_launch: occupancy query says %d blocks/CU\n", per_cu); (void)hipGetLastError(); per_cu = 1; }
    grid = cus < 256 ? cus : 256;
    fprintf(stderr, "kernel_launch: %d CUs, %d blocks/CU by the occupancy query, grid %d\n", cus, per_cu, grid);
    ok = 1;
  }
  if (ok < 0) return;
  Params p{};
  p.x = (const float*)d_in[0]; p.c = (const float*)d_in[1]; p.pos = (const int*)d_in[2]; p.w_ada = (const float*)d_in[3]; p.b_ada = (const float*)d_in[4]; p.w_in = (const float*)d_in[5];
  p.conv_w = (const float*)d_in[6]; p.conv_b = (const float*)d_in[7]; p.gate_b = (const float*)d_in[8]; p.mh_g = (const float*)d_in[9]; p.qn_g = (const float*)d_in[10]; p.kvn_g = (const float*)d_in[11];
  p.w_uq = (const float*)d_in[12]; p.w_ukv = (const float*)d_in[13]; p.an_g = (const float*)d_in[14]; p.w_out = (const float*)d_in[15]; p.ln1_g = (const float*)d_in[16]; p.ln1_b = (const float*)d_in[17];
  p.w_rg = (const float*)d_in[18]; p.b_rg = (const float*)d_in[19]; p.w_re = (const float*)d_in[20]; p.b_re = (const float*)d_in[21]; p.w_gate = (const float*)d_in[22]; p.w_up = (const float*)d_in[23];
  p.w_down = (const float*)d_in[24]; p.ln2_g = (const float*)d_in[25]; p.ln2_b = (const float*)d_in[26];
  p.out = (float*)d_out; p.ws = (unsigned char*)d_ws;
#ifndef NKERN
#define NKERN 6
#endif
  { int ik = 0; for (kfn k : kernels) { if (ik++ >= NKERN) break; hipLaunchKernelGGL(k, dim3(grid), dim3(NTHREADS), LDS_BYTES, stream, p); } }
#ifdef PROBE_OFF
  hipLaunchKernelGGL(k_probe, dim3(1024), dim3(NTHREADS), 0, stream, p, (size_t)(PROBE_OFF), (size_t)(PROBE_N), PROBE_F32, 0);
#endif
  const hipError_t le = hipPeekAtLastError();
  if (le != hipSuccess) fprintf(stderr, "kernel_launch: launch failed: %s\n", hipGetErrorName(le));
}
```

```cpp
#define NKERN 99
#ifndef MEGA_STOP
#define MEGA_STOP 0
#endif
#ifndef DBL_PHASE
#define DBL_PHASE -1
#endif
#include <hip/hip_runtime.h>
#include <cstdio>
#include <cstdint>
#include <cmath>

#define DI __device__ __forceinline__
#define LAS __attribute__((address_space(3)))
typedef unsigned short bf16_t;
typedef short bf16x8 __attribute__((ext_vector_type(8)));
typedef short s16x4 __attribute__((ext_vector_type(4)));
typedef float f32x4 __attribute__((ext_vector_type(4)));
typedef float f32x2 __attribute__((ext_vector_type(2)));
typedef float f32x16 __attribute__((ext_vector_type(16)));
typedef unsigned u32x4 __attribute__((ext_vector_type(4)));
typedef unsigned u32x2 __attribute__((ext_vector_type(2)));

constexpr int BATCH = 2, SEQ = 16384, T = BATCH * SEQ, D = 1024;
constexpr int NCH = SEQ / 128;
constexpr int N_IN = 2768, N_INP = 2816;
constexpr int NEXP = 32;
constexpr float LN_EPS = 1e-5f, RMS_EPS = 1e-6f;
constexpr float ALPHA = 1.189207115002721f;
constexpr float LOG2E = 1.4426950408889634f;
constexpr float QSCALE = 0.07216878364870323f * LOG2E * 16.f;
constexpr int NTHREADS = 512;
constexpr int LDS_BYTES = 148 * 1024;

constexpr size_t MiB = 1u << 20;
constexpr size_t WS_WIN = 0, WS_WUQ = 6 * MiB, WS_WUKV = 7 * MiB, WS_WOUT = 8 * MiB, WS_WGU = 10 * MiB, WS_WDN = 74 * MiB;
constexpr size_t WS_MOD = 106 * MiB, WS_CNT = 106 * MiB + 65536, WS_ROPE = 107 * MiB, WS_GATES = 115 * MiB, WS_GVEC = 117 * MiB;
constexpr size_t WS_SSQQ = 120 * MiB, WS_SSQKV = 122 * MiB, WS_NVEC = 123 * MiB, WS_SCAL = 124 * MiB, WS_TOKE = 125 * MiB, WS_TOKP = 125 * MiB + 512 * 1024;
constexpr size_t WS_U = 128 * MiB, WS_H = 192 * MiB, WS_QKPRE = 256 * MiB, WS_VM = 320 * MiB, WS_CQ = 352 * MiB, WS_CKV = 376 * MiB;
constexpr size_t WS_KROPE = 392 * MiB, WS_QATT = 396 * MiB, WS_KN = 444 * MiB, WS_VA = 476 * MiB, WS_END = 512 * MiB;
constexpr size_t WS_BAR = 106 * MiB + 131072, CTL_ZERO_OFF = WS_CNT, CTL_ZERO_BYTES = 131072;
constexpr int LDS_BARST = LDS_BYTES - 256;
constexpr size_t WS_LTOK = 256 * MiB, WS_LW = 260 * MiB, WS_HDN = 264 * MiB, WS_YBUF = 336 * MiB;
constexpr int MAXTILES = 288;
constexpr int CNT_STRIDE = 64;
constexpr size_t WS_WRT = 126 * MiB;

struct Params {
  const float* x; const float* c; const int* pos; const float* w_ada; const float* b_ada; const float* w_in; const float* conv_w; const float* conv_b;
  const float* gate_b; const float* mh_g; const float* qn_g; const float* kvn_g; const float* w_uq; const float* w_ukv; const float* an_g; const float* w_out;
  const float* ln1_g; const float* ln1_b; const float* w_rg; const float* b_rg; const float* w_re; const float* b_re; const float* w_gate; const float* w_up;
  const float* w_down; const float* ln2_g; const float* ln2_b;
  float* out; unsigned char* ws;
};

enum { A_X = 0, A_C, A_POS, A_WADA, A_BADA, A_WIN, A_CONVW, A_CONVB, A_GATEB, A_MHG, A_QNG, A_KVNG, A_WUQ, A_WUKV, A_ANG, A_WOUT, A_LN1G, A_LN1B, A_WRG, A_BRG, A_WRE, A_BRE,
       A_WGATE, A_WUP, A_WDOWN, A_LN2G, A_LN2B, A_OUT, A_WS };
template <int IDX, class Tp = const float> __device__ __forceinline__ Tp* karg() {
  const unsigned long long k = (unsigned long long)__builtin_amdgcn_kernarg_segment_ptr();
  unsigned long long v;
  asm volatile("s_load_dwordx2 %0, %1, %2\n\ts_waitcnt lgkmcnt(0)" : "=s"(v) : "s"(k), "i"(IDX * 8) : "memory");
  return (Tp*)v;
}
struct Ctx { unsigned char* ws; float* out; };
DI unsigned cvtpk(float lo, float hi) { unsigned r; asm volatile("v_cvt_pk_bf16_f32 %0, %1, %2" : "=v"(r) : "v"(lo), "v"(hi)); return r; }
DI unsigned short f2bf(float f) { unsigned u = __float_as_uint(f); return (unsigned short)((u + 0x7fffu + ((u >> 16) & 1u)) >> 16); }
typedef int v8i __attribute__((ext_vector_type(8)));
DI u32x2 cvt8(f32x4 a, f32x4 b) {
  int w0 = __builtin_amdgcn_cvt_pk_fp8_f32(a[0], a[1], 0, false); w0 = __builtin_amdgcn_cvt_pk_fp8_f32(a[2], a[3], w0, true);
  int w1 = __builtin_amdgcn_cvt_pk_fp8_f32(b[0], b[1], 0, false); w1 = __builtin_amdgcn_cvt_pk_fp8_f32(b[2], b[3], w1, true);
  return (u32x2){(unsigned)w0, (unsigned)w1};
}
DI float bf2f(unsigned short v) { return __uint_as_float(((unsigned)v) << 16); }
DI float bflo(unsigned w) { return __uint_as_float(w << 16); }
DI float bfhi(unsigned w) { return __uint_as_float(w & 0xffff0000u); }
DI int tid_fresh() { int t = threadIdx.x; asm volatile("" : "+v"(t)); return t; }
DI float wave_sum(float v) {
#pragma unroll
  for (int o = 1; o < 64; o <<= 1) v += __shfl_xor(v, o);
  return v;
}
DI float sigmoidf_(float x) { return 1.f / (1.f + __expf(-x)); }
DI float siluf_(float x) { return x / (1.f + __expf(-x)); }
DI float logsigmoidf_(float x) { return fminf(x, 0.f) - log1pf(__expf(-fabsf(x))); }
DI int crow(int r, int hi) { return (r & 3) + 8 * (r >> 2) + 4 * hi; }
#define SBAR() __builtin_amdgcn_sched_barrier(0)
#define KSWZ(row, colB) ((row) * 256 + ((colB) ^ (((row) & 15) << 4)))
#define KRSWZ(row, colB) ((row) * 128 + ((colB) ^ ((((row) >> 1) & 7) << 4)))
#define MFMA32(a, b, c) __builtin_amdgcn_mfma_f32_32x32x16_bf16((a), (b), (c), 0, 0, 0)

DI int v_st(int k, int c) { const int kk = (k & ~0xC) | ((k & 4) << 1) | ((k & 8) >> 1); return ((kk >> 3) * 4 + (c >> 5)) * 512 + ((kk & 7) * 32 + (c & 31)) * 2; }
DI int v_rd_base(int lane) { return ((lane & 3) << 3) | (((lane >> 2) & 3) << 6) | (((lane >> 4) & 1) << 5) | (((lane >> 5) & 1) << 8); }
constexpr int v_rd_off(int d0, int ks, int half) { return d0 * 512 + ks * 4096 + half * 2048; }
template <int OFF> DI s16x4 tr_read(int vb) {
  s16x4 r; asm volatile("ds_read_b64_tr_b16 %0, %1 offset:%2" : "=&v"(r) : "v"(vb), "i"(OFF) : "memory"); return r;
}
#define PKLH(L, H) (bf16x8){L[0], L[1], L[2], L[3], H[0], H[1], H[2], H[3]}
template <int KS> DI bf16x8 tr_frag_nowait(int vb, s16x4& l, s16x4& h) { l = tr_read<v_rd_off(0, KS, 0)>(vb); h = tr_read<v_rd_off(0, KS, 1)>(vb); return PKLH(l, h); }
template <int D0> DI void pv_one(f32x16& od, int vb, bf16x8 pa0, bf16x8 pa1, bf16x8 pa2, bf16x8 pa3) {
  const s16x4 l0 = tr_read<v_rd_off(D0, 0, 0)>(vb), h0 = tr_read<v_rd_off(D0, 0, 1)>(vb), l1 = tr_read<v_rd_off(D0, 1, 0)>(vb), h1 = tr_read<v_rd_off(D0, 1, 1)>(vb);
  const s16x4 l2 = tr_read<v_rd_off(D0, 2, 0)>(vb), h2 = tr_read<v_rd_off(D0, 2, 1)>(vb), l3 = tr_read<v_rd_off(D0, 3, 0)>(vb), h3 = tr_read<v_rd_off(D0, 3, 1)>(vb);
  asm volatile("s_waitcnt lgkmcnt(0)" ::: "memory"); SBAR();
  od = MFMA32(pa0, PKLH(l0, h0), od); od = MFMA32(pa1, PKLH(l1, h1), od); od = MFMA32(pa2, PKLH(l2, h2), od); od = MFMA32(pa3, PKLH(l3, h3), od);
}
DI void pv_d0(f32x16* o, int vb, bf16x8 pa0, bf16x8 pa1, bf16x8 pa2, bf16x8 pa3) {
  pv_one<0>(o[0], vb, pa0, pa1, pa2, pa3); pv_one<1>(o[1], vb, pa0, pa1, pa2, pa3); pv_one<2>(o[2], vb, pa0, pa1, pa2, pa3); pv_one<3>(o[3], vb, pa0, pa1, pa2, pa3);
}
DI void pack_p(const f32x16& p0, const f32x16& p1, bf16x8& pa0, bf16x8& pa1, bf16x8& pa2, bf16x8& pa3) {
#define PK4(P, BASE, OUT) do { unsigned a0 = cvtpk(P[BASE + 0], P[BASE + 1]), a1 = cvtpk(P[BASE + 2], P[BASE + 3]);   \
    unsigned b0 = cvtpk(P[BASE + 4], P[BASE + 5]), b1 = cvtpk(P[BASE + 6], P[BASE + 7]);                              \
    auto r0 = __builtin_amdgcn_permlane32_swap(a0, b0, false, false); auto r1 = __builtin_amdgcn_permlane32_swap(a1, b1, false, false); \
    u32x4 w = {r0[0], r1[0], r0[1], r1[1]}; OUT = *reinterpret_cast<bf16x8*>(&w); } while (0)
  PK4(p0, 0, pa0); PK4(p0, 8, pa1); PK4(p1, 0, pa2); PK4(p1, 8, pa3);
#undef PK4
}
DI float half_swap_sum(float v) { auto rr = __builtin_amdgcn_permlane32_swap(__float_as_uint(v), __float_as_uint(v), false, false); return __uint_as_float(rr[0]) + __uint_as_float(rr[1]); }
DI float half_swap_max(float v) { auto rr = __builtin_amdgcn_permlane32_swap(__float_as_uint(v), __float_as_uint(v), false, false); return fmaxf(__uint_as_float(rr[0]), __uint_as_float(rr[1])); }

namespace g8 {
constexpr int BM = 256, BK = 64, HALF = 128, HTB = HALF * BK * 2, STAGE_BYTES = 8 * HTB;
DI int lds_byte(int r, int c) { const int st = (r >> 4) * 2 + (c >> 5), rr = r & 15, cc = c & 31, ob = rr * 64 + cc * 2; return st * 1024 + (ob ^ (((ob >> 9) & 1) << 5)); }
DI void stage_rc(int b, int& R, int& C) { const int st = b / 1024, sb = b % 1024, swz = sb ^ (((sb >> 9) & 1) << 5); R = (st >> 1) * 16 + swz / 64; C = (st & 1) * 32 + (swz % 64) / 2; }
DI int perm32(int rho) { const int n = rho >> 4, i = rho & 15; return 8 * (i >> 2) + 4 * n + (i & 3); }
struct Unit { int pm, pn, e, j; };

template <class Epi, class Sched>
DI void gemm_phase(LAS unsigned char* lds, const char* Abase, const int Kc, const Sched& S, const Epi& E) {
  constexpr bool GATHER = Sched::GATHER;
  int K = Kc; asm volatile("" : "+s"(K));
  const int tid = tid_fresh(), wid = __builtin_amdgcn_readfirstlane(tid >> 6), lane = tid & 63, wr = wid >> 2, wc = wid & 3, fr = lane & 15, fq = lane >> 4;
  const int nt = K / BK;
  unsigned voffA[2], voffB[2];
#pragma unroll
  for (int i = 0; i < 2; ++i) { int R, C; stage_rc(tid * 16 + i * 8192, R, C); const int Rb = Epi::PERM ? ((R & ~31) + perm32(R & 31)) : R; voffA[i] = (unsigned)(R * K + C) * 2u; voffB[i] = (unsigned)(Rb * K + C) * 2u; }
  const size_t kstep = (size_t)(BK * 2);
  const size_t hstepB = (size_t)HALF * K * 2;
  const unsigned ldsw = (unsigned)wid * 1024u;
  const int aoff = lds_byte(wr * 64 + fr, fq * 8), boff = lds_byte(wc * 32 + fr, fq * 8);
#define G8_SA(b, h) (((b) * 2 + (h)) * HTB)
#define G8_SB(b, h) ((4 + (b) * 2 + (h)) * HTB)
#define G8_STAGEB(bufoff, gptr) do { _Pragma("unroll") for (int _i = 0; _i < 2; ++_i) \
    __builtin_amdgcn_global_load_lds((const unsigned*)((const char*)(gptr) + voffB[_i]), (LAS unsigned*)(lds + (bufoff) + ldsw + _i * 8192), 16, 0, 0); } while (0)
#define G8_STAGEA(bufoff, kb, NXT, h) do { _Pragma("unroll") for (int _i = 0; _i < 2; ++_i) { const char* _src; \
    if constexpr (GATHER) _src = Abase + (size_t)(kb) + (size_t)((NXT) ? o2[h][_i] : cuA[h][_i]); else _src = ((NXT) ? a2b : cA) + (size_t)(kb) + (size_t)(h) * hstepB + voffA[_i]; \
    __builtin_amdgcn_global_load_lds((const unsigned*)_src, (LAS unsigned*)(lds + (bufoff) + ldsw + _i * 8192), 16, 0, 0); } } while (0)
#define G8_LDA(dst, b, h) do { _Pragma("unroll") for (int m = 0; m < 4; ++m) _Pragma("unroll") for (int k = 0; k < 2; ++k) dst[m][k] = *(const LAS bf16x8*)(lds + G8_SA(b, h) + aoff + m * 2048 + k * 1024); } while (0)
#define G8_LDB(dst, b, h) do { _Pragma("unroll") for (int n = 0; n < 2; ++n) _Pragma("unroll") for (int k = 0; k < 2; ++k) dst[n][k] = *(const LAS bf16x8*)(lds + G8_SB(b, h) + boff + n * 2048 + k * 1024); } while (0)
#define G8_MMA(ai, bj, At, Bt) do { __builtin_amdgcn_s_setprio(1); _Pragma("unroll") for (int m = 0; m < 4; ++m) _Pragma("unroll") for (int n = 0; n < 2; ++n) _Pragma("unroll") for (int k = 0; k < 2; ++k) \
    acc[ai][bj][m][n] = __builtin_amdgcn_mfma_f32_16x16x32_bf16(Bt[n][k], At[m][k], acc[ai][bj][m][n], 0, 0, 0); __builtin_amdgcn_s_setprio(0); } while (0)
#define G8_WAIT_V(n) asm volatile("s_waitcnt vmcnt(" #n ")" ::: "memory")
#define G8_WAIT_L(n) asm volatile("s_waitcnt lgkmcnt(" #n ")" ::: "memory")
#define G8_BAR __builtin_amdgcn_s_barrier()
#define G8_SCHED __builtin_amdgcn_sched_barrier(0)
#define G8_GOFF(dst, u) do { _Pragma("unroll") for (int _i = 0; _i < 2; ++_i) { int _R, _C; stage_rc(tid * 16 + _i * 8192, _R, _C); \
    _Pragma("unroll") for (int _h = 0; _h < 2; ++_h) dst[_h][_i] = S.a_off(u, _R + 128 * _h) + (unsigned)_C * 2u; } } while (0)
  Unit cur, nxt; int ui = 0;
  if (!S.next(0, cur)) return;
  f32x4 acc[2][2][4][2];
#pragma unroll
  for (int a = 0; a < 2; ++a)
#pragma unroll
    for (int b = 0; b < 2; ++b)
#pragma unroll
      for (int m = 0; m < 4; ++m)
#pragma unroll
        for (int n = 0; n < 2; ++n) acc[a][b][m][n] = (f32x4){0.f, 0.f, 0.f, 0.f};
  bf16x8 At[4][2], B0[2][2], B1[2][2];
  unsigned cuA[2][2], nxA[2][2], o2[2][2];
  const char* cA = Abase; const char* nA = Abase; const char* a2b = Abase;
  if constexpr (GATHER) { G8_GOFF(cuA, cur); } else { cA = Abase + S.a_off(cur, 0); }
  const char* cB = S.b_base(cur);
  (void)voffA; (void)nxA; (void)o2; (void)nA; (void)a2b;
  G8_STAGEB(G8_SB(0, 0), cB); G8_STAGEB(G8_SB(0, 1), cB + hstepB); G8_STAGEA(G8_SA(0, 0), 0, false, 0); G8_STAGEA(G8_SA(0, 1), 0, false, 1);
  if (wr == 1) G8_BAR;
  G8_WAIT_V(2); G8_BAR;
  G8_STAGEB(G8_SB(1, 0), cB + kstep); G8_STAGEA(G8_SA(1, 0), kstep, false, 0); G8_STAGEB(G8_SB(1, 1), cB + hstepB + kstep);
  G8_WAIT_V(6); G8_BAR;
  for (;;) {
    const bool has_next = S.next(ui + 1, nxt);
    const char* nB = cB;
    if (has_next) {
      nB = S.b_base(nxt);
      if constexpr (GATHER) { G8_GOFF(nxA, nxt); } else { nA = Abase + S.a_off(nxt, 0); }
    } else {
      if constexpr (GATHER) {
#pragma unroll
        for (int h = 0; h < 2; ++h)
#pragma unroll
          for (int i = 0; i < 2; ++i) nxA[h][i] = cuA[h][i];
      } else nA = cA;
    }
    for (int t = 0; t < nt; t += 2) {
      const bool last = (t == nt - 2);
      const size_t k1 = (size_t)(t + 1) * kstep;
      const size_t k2 = last ? 0 : (size_t)(t + 2) * kstep, k3 = k2 + kstep;
      if constexpr (GATHER) {
#pragma unroll
        for (int h = 0; h < 2; ++h)
#pragma unroll
          for (int i = 0; i < 2; ++i) o2[h][i] = last ? nxA[h][i] : cuA[h][i];
      } else a2b = last ? nA : cA;
      const char* b2 = last ? nB : cB + (size_t)(t + 2) * kstep; const char* b3 = b2 + kstep;
      G8_LDB(B0, 0, 0); G8_LDB(B1, 0, 1); G8_SCHED; G8_LDA(At, 0, 0); G8_STAGEA(G8_SA(1, 1), k1, false, 1);
      G8_WAIT_V(8); G8_WAIT_L(0); G8_BAR; G8_MMA(0, 0, At, B0); G8_MMA(0, 1, At, B1); G8_BAR; G8_SCHED;
      G8_LDA(At, 0, 1); G8_STAGEB(G8_SB(0, 0), b2); G8_STAGEB(G8_SB(0, 1), b2 + hstepB); G8_STAGEA(G8_SA(0, 0), k2, true, 0);
      G8_WAIT_V(8); G8_WAIT_L(0); G8_BAR; G8_MMA(1, 0, At, B0); G8_MMA(1, 1, At, B1); G8_BAR; G8_SCHED;
      G8_LDB(B0, 1, 0); G8_LDB(B1, 1, 1); G8_SCHED; G8_LDA(At, 1, 0); G8_STAGEA(G8_SA(0, 1), k2, true, 1);
      G8_WAIT_V(8); G8_WAIT_L(0); G8_BAR; G8_MMA(0, 0, At, B0); G8_MMA(0, 1, At, B1); G8_BAR; G8_SCHED;
      G8_LDA(At, 1, 1); G8_STAGEB(G8_SB(1, 0), b3); G8_STAGEB(G8_SB(1, 1), b3 + hstepB); G8_STAGEA(G8_SA(1, 0), k3, true, 0);
      G8_WAIT_V(8); G8_WAIT_L(0); G8_BAR; G8_MMA(1, 0, At, B0); G8_MMA(1, 1, At, B1); G8_BAR; G8_SCHED;
    }
    if (wr == 0) G8_BAR;
    G8_SCHED; asm volatile("s_nop 15\n\ts_nop 7" ::: "memory"); G8_SCHED;
    E(acc, cur, wr, wc, fr, fq);
    if (!has_next) break;
#pragma unroll
    for (int a = 0; a < 2; ++a)
#pragma unroll
      for (int b = 0; b < 2; ++b)
#pragma unroll
        for (int m = 0; m < 4; ++m)
#pragma unroll
          for (int n = 0; n < 2; ++n) acc[a][b][m][n] = (f32x4){0.f, 0.f, 0.f, 0.f};
    cur = nxt; cB = nB; ++ui;
    if constexpr (GATHER) {
#pragma unroll
      for (int h = 0; h < 2; ++h)
#pragma unroll
        for (int i = 0; i < 2; ++i) cuA[h][i] = nxA[h][i];
    } else cA = nA;
    if (wr == 1) G8_BAR;
  }
  G8_WAIT_V(0);
  G8_BAR;
#undef G8_SA
#undef G8_SB
#undef G8_STAGEA
#undef G8_STAGEB
#undef G8_LDA
#undef G8_LDB
#undef G8_MMA
#undef G8_WAIT_V
#undef G8_WAIT_L
#undef G8_BAR
#undef G8_SCHED
#undef G8_GOFF
}

struct DenseOrder {
  static constexpr bool GATHER = false;
  int nM, nN, nwg, G, c, K; const char* Bt;
  DI void init(int M, int N, int K_, const void* Bt_, int G_, int c_) { nM = M / BM; nN = N / BM; nwg = nM * nN; G = G_; c = c_; K = K_; Bt = (const char*)Bt_; }
  DI bool next(int i, Unit& u) const {
    const long L = (long)i * G + c; if (L >= nwg) return false;
    int wgid = (int)L; { const int q = nwg / 8, r = nwg % 8, xcd = wgid % 8, off = wgid / 8; wgid = (xcd < r ? xcd * (q + 1) : r * (q + 1) + (xcd - r) * q) + off; }
    const int nig = 8 * nN, gid = wgid / nig, fm = gid * 8, gsz = (nM - fm) < 8 ? (nM - fm) : 8;
    u.pm = fm + ((wgid % nig) % gsz); u.pn = (wgid % nig) / gsz; u.e = 0; u.j = 0; return true;
  }
  DI unsigned a_off(const Unit& u, int R) const { return (unsigned)(u.pm * BM + R) * (unsigned)(K * 2); }
  DI const char* b_base(const Unit& u) const { return Bt + (size_t)u.pn * BM * K * 2; }
};
}
using g8::Unit;

struct EpiIn {
  static constexpr bool PERM = true;
  bf16_t* qkpre; bf16_t* vm; bf16_t* hcat; bf16_t* cq; bf16_t* ckv; unsigned char* krope  ; float* gates; float* ssq_q; float* ssq_kv; const float* rope; const float* gate_b;
  DI void operator()(const f32x4 (&acc)[2][2][4][2], const Unit& u, int wr, int wc, int fr, int fq) const {
#pragma unroll
    for (int bj = 0; bj < 2; ++bj) {
      const int cw = u.pn * 256 + bj * 128 + wc * 32, c0 = cw + 8 * fq;
#pragma unroll
      for (int ai = 0; ai < 2; ++ai)
#pragma unroll
        for (int m = 0; m < 4; ++m) {
          const int row = u.pm * 256 + ai * 128 + wr * 64 + m * 16 + fr;
          const f32x4 v0 = acc[ai][bj][m][0], v1 = acc[ai][bj][m][1];
          if (cw < 1024) { u32x4 w = {cvtpk(v0[0], v0[1]), cvtpk(v0[2], v0[3]), cvtpk(v1[0], v1[1]), cvtpk(v1[2], v1[3])}; *(u32x4*)(qkpre + (size_t)row * 1024 + c0) = w; }
          else if (cw < 1536) { u32x4 w = {cvtpk(v0[0], v0[1]), cvtpk(v0[2], v0[3]), cvtpk(v1[0], v1[1]), cvtpk(v1[2], v1[3])}; *(u32x4*)(vm + (size_t)row * 512 + (c0 - 1024)) = w; }
          else if (cw < 2048) { u32x4 w = {cvtpk(sigmoidf_(v0[0]), sigmoidf_(v0[1])), cvtpk(sigmoidf_(v0[2]), sigmoidf_(v0[3])), cvtpk(sigmoidf_(v1[0]), sigmoidf_(v1[1])), cvtpk(sigmoidf_(v1[2]), sigmoidf_(v1[3]))};
                                *(u32x4*)(hcat + (size_t)row * 1024 + (c0 - 1536)) = w; }
          else if (cw < 2688) {
            u32x4 w = {cvtpk(v0[0], v0[1]), cvtpk(v0[2], v0[3]), cvtpk(v1[0], v1[1]), cvtpk(v1[2], v1[3])};
            float s = v0[0] * v0[0] + v0[1] * v0[1] + v0[2] * v0[2] + v0[3] * v0[3] + v1[0] * v1[0] + v1[1] * v1[1] + v1[2] * v1[2] + v1[3] * v1[3];
            s += __shfl_xor(s, 16); s += __shfl_xor(s, 32);
            if (cw < 2432) { *(u32x4*)(cq + (size_t)row * 384 + (c0 - 2048)) = w; if (fq == 0) ssq_q[(size_t)row * 12 + ((cw - 2048) >> 5)] = s; }
            else { *(u32x4*)(ckv + (size_t)row * 256 + (c0 - 2432)) = w; if (fq == 0) ssq_kv[(size_t)row * 8 + ((cw - 2432) >> 5)] = s; }
          }
          else if (cw < 2752) {
            const int i0 = (c0 - 2688) >> 1;
            const f32x4 cs0 = *(const f32x4*)(rope + (size_t)row * 64 + 2 * i0), cs1 = *(const f32x4*)(rope + (size_t)row * 64 + 2 * i0 + 4);
            const float a0 = v0[0] * cs0[0] - v0[1] * cs0[1], b0 = v0[1] * cs0[0] + v0[0] * cs0[1];
            const float a1 = v0[2] * cs0[2] - v0[3] * cs0[3], b1 = v0[3] * cs0[2] + v0[2] * cs0[3];
            const float a2 = v1[0] * cs1[0] - v1[1] * cs1[1], b2 = v1[1] * cs1[0] + v1[0] * cs1[1];
            const float a3 = v1[2] * cs1[2] - v1[3] * cs1[3], b3 = v1[3] * cs1[2] + v1[2] * cs1[3];
            const u32x2 w = cvt8((f32x4){a0, b0, a1, b1}, (f32x4){a2, b2, a3, b3});
            const int b_ = row >> 14, s_ = row & (SEQ - 1);
#pragma unroll
            for (int hh = 0; hh < 4; ++hh) *(u32x2*)(krope + ((size_t)(b_ * 4 + hh) * SEQ + s_) * 192 + 128 + (c0 - 2688)) = w;
          }
          else if (cw == 2752) {
            if (fq < 2) { const f32x4 g0 = *(const f32x4*)(gate_b + 8 * fq), g1 = *(const f32x4*)(gate_b + 8 * fq + 4);
              *(f32x4*)(gates + (size_t)row * 16 + 8 * fq) = v0 + g0; *(f32x4*)(gates + (size_t)row * 16 + 8 * fq + 4) = v1 + g1; }
          }
        }
    }
  }
};
struct EpiUQ {
  static constexpr bool PERM = true;
  unsigned char* qatt; const float* ssq_q; const float* rope;
  DI void operator()(const f32x4 (&acc)[2][2][4][2], const Unit& u, int wr, int wc, int fr, int fq) const {
    float rs[2][4];
#pragma unroll
    for (int ai = 0; ai < 2; ++ai)
#pragma unroll
      for (int m = 0; m < 4; ++m) {
        const int row = u.pm * 256 + ai * 128 + wr * 64 + m * 16 + fr;
        const f32x4 q0 = *(const f32x4*)(ssq_q + (size_t)row * 12), q1 = *(const f32x4*)(ssq_q + (size_t)row * 12 + 4), q2 = *(const f32x4*)(ssq_q + (size_t)row * 12 + 8);
        const float ss = (q0[0] + q0[1] + q0[2] + q0[3]) + (q1[0] + q1[1] + q1[2] + q1[3]) + (q2[0] + q2[1] + q2[2] + q2[3]);
        rs[ai][m] = rsqrtf(ss * (1.f / 384.f) + RMS_EPS) * QSCALE;
        asm volatile("" ::: "memory");
      }
#pragma unroll
    for (int bj = 0; bj < 2; ++bj) {
      const int cw = u.pn * 256 + bj * 128 + wc * 32, h = cw / 192, dw = cw - h * 192, d = dw + 8 * fq;
#pragma unroll
      for (int ai = 0; ai < 2; ++ai)
#pragma unroll
        for (int m = 0; m < 4; ++m) {
          const int row = u.pm * 256 + ai * 128 + wr * 64 + m * 16 + fr, b = row >> 14, s = row & (SEQ - 1);
          const f32x4 v0 = acc[ai][bj][m][0] * rs[ai][m], v1 = acc[ai][bj][m][1] * rs[ai][m];
          u32x2 w;
          if (dw < 128) { w = cvt8(v0, v1); }
          else {
            const int i0 = (d - 128) >> 1;
            const f32x4 cs0 = *(const f32x4*)(rope + (size_t)row * 64 + 2 * i0), cs1 = *(const f32x4*)(rope + (size_t)row * 64 + 2 * i0 + 4);
            const float a0 = v0[0] * cs0[0] - v0[1] * cs0[1], b0 = v0[1] * cs0[0] + v0[0] * cs0[1];
            const float a1 = v0[2] * cs0[2] - v0[3] * cs0[3], b1 = v0[3] * cs0[2] + v0[2] * cs0[3];
            const float a2 = v1[0] * cs1[0] - v1[1] * cs1[1], b2 = v1[1] * cs1[0] + v1[0] * cs1[1];
            const float a3 = v1[2] * cs1[2] - v1[3] * cs1[3], b3 = v1[3] * cs1[2] + v1[2] * cs1[3];
            w = cvt8((f32x4){a0, b0, a1, b1}, (f32x4){a2, b2, a3, b3});
          }
          *(u32x2*)(qatt + ((size_t)(b * 4 + h) * SEQ + s) * 192 + d) = w;
          asm volatile("" ::: "memory");
        }
    }
  }
};
struct EpiUKV {
  static constexpr bool PERM = true;
  unsigned char* kn; unsigned char* vt8; const float* ssq_kv;
  DI void operator()(const f32x4 (&acc)[2][2][4][2], const Unit& u, int wr, int wc, int fr, int fq) const {
#pragma unroll
    for (int ai = 0; ai < 2; ++ai)
#pragma unroll
      for (int m = 0; m < 4; ++m) {
        const int row = u.pm * 256 + ai * 128 + wr * 64 + m * 16 + fr, b = row >> 14, s = row & (SEQ - 1);
        const f32x4 q0 = *(const f32x4*)(ssq_kv + (size_t)row * 8), q1 = *(const f32x4*)(ssq_kv + (size_t)row * 8 + 4);
        const float ss = (q0[0] + q0[1] + q0[2] + q0[3]) + (q1[0] + q1[1] + q1[2] + q1[3]);
        const float rs = rsqrtf(ss * (1.f / 256.f) + RMS_EPS);
        { const f32x4 v0 = acc[ai][0][m][0] * rs, v1 = acc[ai][0][m][1] * rs;
          *(u32x2*)(kn + ((size_t)(b * 4 + u.pn) * SEQ + s) * 192 + wc * 32 + 8 * fq) = cvt8(v0, v1); }
        { const f32x4 v0 = acc[ai][1][m][0] * rs, v1 = acc[ai][1][m][1] * rs;
          const u32x2 w = cvt8(v0, v1);
          const int k = s & 63, kq = k & 31, pos = 32 * ((kq >> 2) & 1) + (kq & 3) + 4 * (kq >> 3) + 16 * (k >> 5);
          unsigned char* dst = vt8 + ((size_t)((b * 4 + u.pn) * 256 + (s >> 6)) * 128 + wc * 32 + 8 * fq) * 64 + pos;
          dst[0] = (unsigned char)w[0]; dst[64] = (unsigned char)(w[0] >> 8); dst[128] = (unsigned char)(w[0] >> 16); dst[192] = (unsigned char)(w[0] >> 24);
          dst[256] = (unsigned char)w[1]; dst[320] = (unsigned char)(w[1] >> 8); dst[384] = (unsigned char)(w[1] >> 16); dst[448] = (unsigned char)(w[1] >> 24); }
        asm volatile("" ::: "memory");
      }
  }
};
struct EpiOut {
  static constexpr bool PERM = true;
  const float* x; const float* mod; bf16_t* z;
  DI void operator()(const f32x4 (&acc)[2][2][4][2], const Unit& u, int wr, int wc, int fr, int fq) const {
#pragma unroll
    for (int ai = 0; ai < 2; ++ai)
#pragma unroll
      for (int m = 0; m < 4; ++m) {
        const int row = u.pm * 256 + ai * 128 + wr * 64 + m * 16 + fr, b = row >> 14;
#pragma unroll
        for (int bj = 0; bj < 2; ++bj) {
          const int c = u.pn * 256 + bj * 128 + wc * 32 + 8 * fq;
          const unsigned off = (unsigned)row * 1024u + (unsigned)c;
          const f32x4 x0 = *(const f32x4*)(x + off), x1 = *(const f32x4*)(x + off + 4), g0 = *(const f32x4*)(mod + b * 6144 + 2048 + c), g1 = *(const f32x4*)(mod + b * 6144 + 2048 + c + 4);
          const f32x4 z0 = x0 * ALPHA + (g0 + 1.f) * acc[ai][bj][m][0], z1 = x1 * ALPHA + (g1 + 1.f) * acc[ai][bj][m][1];
          *(u32x4*)(z + off) = (u32x4){cvtpk(z0[0], z0[1]), cvtpk(z0[2], z0[3]), cvtpk(z1[0], z1[1]), cvtpk(z1[2], z1[3])};
        }
        asm volatile("" ::: "memory");
      }
  }
};
struct EpiGU {
  static constexpr bool PERM = true;
  bf16_t* hdn;
  DI void operator()(const f32x4 (&acc)[2][2][4][2], const Unit& u, int wr, int wc, int fr, int fq) const {
    const unsigned base = ((unsigned)u.pm * 256u + wr * 64 + fr) * 1024u + (unsigned)(u.pn * 256 + wc * 32 + 8 * fq);
#pragma unroll
    for (int ai = 0; ai < 2; ++ai)
#pragma unroll
      for (int m = 0; m < 4; ++m) {
#pragma unroll
        for (int bj = 0; bj < 2; ++bj) {
          const f32x4 g = acc[ai][bj][m][0], up = acc[ai][bj][m][1];
          const u32x2 w = {cvtpk(siluf_(g[0]) * up[0], siluf_(g[1]) * up[1]), cvtpk(siluf_(g[2]) * up[2], siluf_(g[3]) * up[3])};
          *(u32x2*)((char*)hdn + (base + (unsigned)((ai * 128 + m * 16) * 1024 + bj * 128))) = w;
        }
      }
  }
};
struct EpiDN {
  static constexpr bool PERM = true;
  bf16_t* ybuf; const float* lw;
  DI void operator()(const f32x4 (&acc)[2][2][4][2], const Unit& u, int wr, int wc, int fr, int fq) const {
    const unsigned base = ((unsigned)u.pm * 256u + wr * 64 + fr) * 2048u + (unsigned)(u.pn * 256 + wc * 32 + 8 * fq) * 2u;
    const unsigned wbase = ((unsigned)u.e * (unsigned)T + (unsigned)(u.j * 256 + wr * 64 + fr)) * 4u;
#pragma unroll
    for (int ai = 0; ai < 2; ++ai)
#pragma unroll
      for (int m = 0; m < 4; ++m) {
        const float wgt = *(const float*)((const char*)lw + (wbase + (unsigned)((ai * 128 + m * 16) * 4)));
#pragma unroll
        for (int bj = 0; bj < 2; ++bj) {
          const f32x4 v0 = acc[ai][bj][m][0] * wgt, v1 = acc[ai][bj][m][1] * wgt;
          const u32x4 w = {cvtpk(v0[0], v0[1]), cvtpk(v0[2], v0[3]), cvtpk(v1[0], v1[1]), cvtpk(v1[2], v1[3])};
          *(u32x4*)((char*)ybuf + (base + (unsigned)((ai * 128 + m * 16) * 2048 + bj * 256))) = w;
        }
        asm volatile("" ::: "memory");
      }
  }
};
struct MoeOrderBase {
  const LAS int* tstart; const int* cnt; int G, c;
  DI bool next(int i, Unit& u) const {
    const int L = i * G + c, NT = tstart[32]; if (L >= NT * 4) return false;
    const int tile = L >> 2; int e = 0;
    for (int k = 1; k < 32; ++k) e = (tstart[k] <= tile) ? k : e;
    u.pm = tile; u.pn = L & 3; u.e = e; u.j = tile - tstart[e]; return true;
  }
};
struct MoeOrderGU : MoeOrderBase {
  static constexpr bool GATHER = true;
  const int* ltok; const char* Bt;
  DI unsigned a_off(const Unit& u, int R) const { const int n = cnt[u.e * CNT_STRIDE]; int idx = u.j * 256 + R; idx = idx < n ? idx : n - 1; return (unsigned)ltok[(size_t)u.e * T + idx] * 2048u; }
  DI const char* b_base(const Unit& u) const { return Bt + ((size_t)u.e * 1024 + u.pn * 256) * 2048; }
};
struct MoeOrderDN : MoeOrderBase {
  static constexpr bool GATHER = false;
  const char* Bt;
  DI unsigned a_off(const Unit& u, int R) const { return (unsigned)(u.pm * 256 + R) * 1024u; }
  DI const char* b_base(const Unit& u) const { return Bt + ((size_t)u.e * 1024 + u.pn * 256) * 1024; }
};

struct TDesc { const float* src; const float* kscale; bf16_t* dst; int ld, K, k0, n0, ok; };
DI TDesc tdesc(int r, int lane, unsigned char* ws) {
  constexpr int I_IN = 16 * 88, I_UQ = 6 * 24, I_UKV = 4 * 32, I_OUT = 16 * 32, I_GU = 32 * 16 * 32;
  TDesc d; d.kscale = nullptr; int sc, kb, nb; const float* W;
  if (r < I_IN) { kb = r / 88; nb = r % 88; const int n = nb * 32 + (lane & 31);
    sc = n < 2048 ? n : n < 2432 ? 2064 + (n - 2048) : n < 2688 ? 2448 + (n - 2432) : n < 2752 ? 2704 + ((n - 2688) & 1) * 32 + ((n - 2688) >> 1) : n < 2768 ? 2048 + (n - 2752) : -1;
    W = karg<A_WIN>(); d.ld = N_IN; d.K = 1024; d.dst = (bf16_t*)(ws + WS_WIN); }
  else if ((r -= I_IN) < I_UQ) { kb = r / 24; nb = r % 24; const int n = nb * 32 + (lane & 31), h = n / 192, dd = n - h * 192;
    sc = dd < 128 ? n : h * 192 + 128 + ((dd - 128) & 1) * 32 + ((dd - 128) >> 1);
    W = karg<A_WUQ>(); d.ld = 768; d.K = 384; d.dst = (bf16_t*)(ws + WS_WUQ); d.kscale = karg<A_QNG>(); }
  else if ((r -= I_UQ) < I_UKV) { kb = r / 32; nb = r % 32; sc = nb * 32 + (lane & 31); W = karg<A_WUKV>(); d.ld = 1024; d.K = 256; d.dst = (bf16_t*)(ws + WS_WUKV); d.kscale = karg<A_KVNG>(); }
  else if ((r -= I_UKV) < I_OUT) { kb = r / 32; nb = r % 32; sc = nb * 32 + (lane & 31); W = karg<A_WOUT>(); d.ld = 1024; d.K = 1024; d.dst = (bf16_t*)(ws + WS_WOUT); }
  else if ((r -= I_OUT) < I_GU) { const int e = r / 512, q = r % 512; kb = q / 32; nb = q % 32;
    const int lr = nb * 32 + (lane & 31), up = (lr >> 2) & 1; sc = (lr >> 3) * 4 + (lr & 3);
    W = (up ? karg<A_WUP>() : karg<A_WGATE>()) + (size_t)e * 1024 * 512; d.ld = 512; d.K = 1024; d.dst = (bf16_t*)(ws + WS_WGU) + (size_t)e * 1024 * 1024; }
  else { r -= I_GU; const int e = r / 256, q = r % 256; kb = q / 32; nb = q % 32; sc = nb * 32 + (lane & 31);
    W = karg<A_WDOWN>() + (size_t)e * 512 * 1024; d.ld = 1024; d.K = 512; d.dst = (bf16_t*)(ws + WS_WDN) + (size_t)e * 1024 * 512; }
  d.k0 = 64 * kb; d.n0 = 32 * nb; d.ok = sc >= 0;
  d.src = W + (size_t)(d.k0 + (lane >> 5)) * d.ld + (sc >= 0 ? sc : 0);
  return d;
}
DI void tload(const TDesc& d, float (&v)[32]) {
#pragma unroll
  for (int i = 0; i < 32; ++i) v[i] = d.src[(size_t)(2 * i) * d.ld];
}
DI void tstore(const TDesc& d, float (&v)[32], LAS float* scr, int lane) {
  if (d.kscale) {
#pragma unroll
    for (int i = 0; i < 32; ++i) v[i] *= d.kscale[d.k0 + 2 * i + (lane >> 5)];
  }
#pragma unroll
  for (int i = 0; i < 32; ++i) scr[(2 * i + (lane >> 5)) * 33 + (lane & 31)] = d.ok ? v[i] : 0.f;
  asm volatile("s_waitcnt lgkmcnt(0)" ::: "memory");
  const int c = lane & 7;
#pragma unroll
  for (int j = 0; j < 4; ++j) { const int n = (lane >> 3) + 8 * j; const LAS float* s = scr + (8 * c) * 33 + n;
    u32x4 o; o.x = cvtpk(s[0 * 33], s[1 * 33]); o.y = cvtpk(s[2 * 33], s[3 * 33]); o.z = cvtpk(s[4 * 33], s[5 * 33]); o.w = cvtpk(s[6 * 33], s[7 * 33]);
    *(u32x4*)(d.dst + (size_t)(d.n0 + n) * d.K + d.k0 + 8 * c) = o; }
  asm volatile("s_waitcnt lgkmcnt(0)" ::: "memory");
}
constexpr int PREP_ITEMS = 16 * 88 + 6 * 24 + 4 * 32 + 16 * 32 + 32 * 16 * 32 + 32 * 8 * 32;
constexpr int PREP_DEFER = 8192;
DI void prep_items(int it, const int end, const int stride, const int lane, unsigned char* ws, LAS float* scr) {
  TDesc dA, dB; float vA[32], vB[32];
  if (it < end) { dA = tdesc(it, lane, ws); tload(dA, vA); }
  while (it < end) {
    if (it + stride < end) { dB = tdesc(it + stride, lane, ws); tload(dB, vB); }
    tstore(dA, vA, scr, lane);
    it += stride; if (it >= end) break;
    if (it + stride < end) { dA = tdesc(it + stride, lane, ws); tload(dA, vA); }
    tstore(dB, vB, scr, lane);
    it += stride;
  }
}
DI void phase_prep(const Ctx& p, int bid, int G, LAS unsigned char* lds) {
  const int tid = tid_fresh(), lane = tid & 63, wave = __builtin_amdgcn_readfirstlane(tid >> 6);
  unsigned char* ws = p.ws;
  LAS float* scr = (LAS float*)(lds + wave * 16384);
  LAS float* cact = (LAS float*)(lds + 131072);
  for (int i = tid; i < 2048; i += NTHREADS) cact[i] = siluf_(karg<A_C>()[i]);
  __syncthreads();
  const int gw = bid * 8 + wave, NGW = G * 8;
  constexpr int I_MOD = 192;
  if (bid < I_MOD) {
    const int kg = lane >> 3, cc = lane & 7, col = bid * 32 + 4 * cc; const float* w_ada = karg<A_WADA>() + col;
    f32x4 a0 = {0.f, 0.f, 0.f, 0.f}, a1 = {0.f, 0.f, 0.f, 0.f};
#pragma unroll
    for (int j = 0; j < 16; ++j) { const int k = wave * 128 + kg + 8 * j; const f32x4 w = *(const f32x4*)(w_ada + (size_t)k * 6144); a0 += w * cact[k]; a1 += w * cact[1024 + k]; }
#pragma unroll
    for (int e = 0; e < 4; ++e) {
#pragma unroll
      for (int o = 8; o < 64; o <<= 1) { a0[e] += __shfl_xor(a0[e], o); a1[e] += __shfl_xor(a1[e], o); } }
    LAS f32x4* part = (LAS f32x4*)(lds + 131072 + 8192);
    if (kg == 0) { part[(wave * 8 + cc) * 2] = a0; part[(wave * 8 + cc) * 2 + 1] = a1; }
    __syncthreads();
    if (wave == 0 && kg == 0) { float* mod = (float*)(ws + WS_MOD); const f32x4 bb = *(const f32x4*)(karg<A_BADA>() + col);
      f32x4 s0 = part[cc * 2], s1 = part[cc * 2 + 1];
#pragma unroll
      for (int w = 1; w < 8; ++w) { s0 += part[(w * 8 + cc) * 2]; s1 += part[(w * 8 + cc) * 2 + 1]; }
      *(f32x4*)(mod + col) = s0 + bb; *(f32x4*)(mod + 6144 + col) = s1 + bb; }
  }
#ifndef DBL_PREP
#define DBL_PREP 0
#endif
  for (int rp_ = 0; rp_ < (DBL_PREP == 1 ? 2 : 1); ++rp_) prep_items(gw, PREP_ITEMS - PREP_DEFER, NGW, lane, ws, scr);
  {
    const float INV[32] = {1.000000000e+00f, 7.498942018e-01f, 5.623413324e-01f, 4.216965139e-01f, 3.162277639e-01f, 2.371373773e-01f, 1.778279394e-01f, 1.333521456e-01f,
                           1.000000015e-01f, 7.498942316e-02f, 5.623413250e-02f, 4.216964915e-02f, 3.162277490e-02f, 2.371373773e-02f, 1.778279431e-02f, 1.333521400e-02f,
                           9.999999776e-03f, 7.498942316e-03f, 5.623413250e-03f, 4.216964822e-03f, 3.162277630e-03f, 2.371373819e-03f, 1.778279431e-03f, 1.333521446e-03f,
                           1.000000047e-03f, 7.498941850e-04f, 5.623413017e-04f, 4.216965172e-04f, 3.162277571e-04f, 2.371373703e-04f, 1.778279402e-04f, 1.333521504e-04f};
    f32x2* rope = (f32x2*)(ws + WS_ROPE); const int* pos = karg<A_POS, const int>();
    for (int rp_ = 0; rp_ < (DBL_PREP == 2 ? 2 : 1); ++rp_)
    for (int i = bid * NTHREADS + tid; i < T * 32; i += G * NTHREADS) {
      const int t = i >> 5, fi = i & 31;
      const float ang = (float)pos[t] * INV[fi];
      float sn, cs; sincosf(ang, &sn, &cs); rope[i] = (f32x2){cs, sn};
    }
  }
  if (bid == 0) for (int i = tid; i < 64 * CNT_STRIDE; i += NTHREADS) ((int*)(ws + WS_CNT))[i] = 0;
  { const float* w_re = karg<A_WRE>(); const float* w_rg = karg<A_WRG>(); float* wrt = (float*)(ws + WS_WRT);
    for (int i = bid * NTHREADS + tid; i < 36 * 1024; i += G * NTHREADS) { const int e = i >> 10, k = i & 1023; wrt[i] = e < 32 ? w_re[k * 32 + e] : w_rg[k * 4 + (e - 32)]; } }
}

DI void phase_lnmod(const Ctx& p, int bid, int G) {
  const int tid = tid_fresh(), lane = tid & 63, wave = tid >> 6;
  const float* mod = (const float*)(p.ws + WS_MOD); bf16_t* U = (bf16_t*)(p.ws + WS_U); const float* xin = karg<A_X>();
  f32x4 vn[4];
  { const int row = bid * 8 + wave; if (row < T) { const f32x4* xr = (const f32x4*)(xin + (size_t)row * 1024) + lane;
#pragma unroll
      for (int j = 0; j < 4; ++j) vn[j] = xr[64 * j]; } }
  for (int row = bid * 8 + wave; row < T; row += G * 8) {
    const int b = row >> 14;
    f32x4 v[4]; float s = 0.f;
#pragma unroll
    for (int j = 0; j < 4; ++j) { v[j] = vn[j]; s += (v[j][0] + v[j][1]) + (v[j][2] + v[j][3]); }
    if (row + G * 8 < T) { const f32x4* xr = (const f32x4*)(xin + (size_t)(row + G * 8) * 1024) + lane;
#pragma unroll
      for (int j = 0; j < 4; ++j) vn[j] = xr[64 * j]; }
    const float mean = wave_sum(s) * (1.f / 1024.f); float s2 = 0.f;
#pragma unroll
    for (int j = 0; j < 4; ++j) { v[j] = v[j] - mean; s2 += (v[j][0] * v[j][0] + v[j][1] * v[j][1]) + (v[j][2] * v[j][2] + v[j][3] * v[j][3]); }
    const float rstd = rsqrtf(wave_sum(s2) * (1.f / 1024.f) + LN_EPS);
    u32x2* o8 = (u32x2*)(U + (size_t)row * 1024) + lane;
#pragma unroll
    for (int j = 0; j < 4; ++j) {
      const int col = 4 * lane + 256 * j;
      const f32x4 sh = *(const f32x4*)(mod + b * 6144 + col), sc = *(const f32x4*)(mod + b * 6144 + 1024 + col);
      const f32x4 y = v[j] * rstd * (sc + 1.f) + sh;
      o8[64 * j] = (u32x2){cvtpk(y[0], y[1]), cvtpk(y[2], y[3])};
    }
  }
}

constexpr int PA_V = 0, PA_KF = 32768, PA_KB = 65536, PA_RAWK = 100352, PA_VEC = 135168;
DI void mlstmA_unit(const Ctx& p, int b, int h, int c, LAS unsigned char* lds) {
  const int tid = tid_fresh(), lane = tid & 63, wid = __builtin_amdgcn_readfirstlane(tid >> 6), r32 = lane & 31, hi = lane >> 5;
  unsigned char* ws = p.ws;
  const bf16_t* qkpre = (const bf16_t*)(ws + WS_QKPRE); const bf16_t* vmp = (const bf16_t*)(ws + WS_VM); bf16_t* qkpost = (bf16_t*)(ws + WS_U);
  const float* gates = (const float*)(ws + WS_GATES); float* gvec = (float*)(ws + WS_GVEC); float* nvec = (float*)(ws + WS_NVEC); float* scal = (float*)(ws + WS_SCAL);
  bf16_t* Cbuf = (bf16_t*)p.out;
  LAS float* vec = (LAS float*)(lds + PA_VEC);
  const int bh = b * 4 + h, row0 = b * SEQ + c * 128;
  const int r0 = tid >> 4, c8 = (tid & 15) * 8;
  u32x4 rk[5], rq[5], rv[4];
#pragma unroll
  for (int j = 0; j < 5; ++j) {
    const int rr = r0 + 32 * j, sj = c * 128 + rr - 2; const bool ok = rr < 132 && sj >= 0 && sj < SEQ;
    const bf16_t* src = qkpre + (size_t)(b * SEQ + (ok ? sj : 0)) * 1024 + h * 128 + c8;
    rk[j] = ok ? *(const u32x4*)(src + 512) : (u32x4){0u, 0u, 0u, 0u}; rq[j] = ok ? *(const u32x4*)src : (u32x4){0u, 0u, 0u, 0u};
  }
#pragma unroll
  for (int j = 0; j < 4; ++j) rv[j] = *(const u32x4*)(vmp + (size_t)(row0 + r0 + 32 * j) * 512 + h * 128 + c8);
  float gb = 0.f, gcol = 0.f, gcm = 0.f;
  if (tid < 256) {
    const int dir = tid >> 7, t = tid & 127, wv = (tid >> 6) & 1;
    const float ig = gates[(size_t)(row0 + t) * 16 + (dir * 2) * 4 + h], fg = gates[(size_t)(row0 + t) * 16 + (dir * 2 + 1) * 4 + h];
    float x = logsigmoidf_(fg);
    if (dir == 0) {
#pragma unroll
      for (int o = 1; o < 64; o <<= 1) { const float y = __shfl_up(x, o); if (lane >= o) x += y; }
      if (lane == 63) vec[256 + wv] = x;
    } else {
#pragma unroll
      for (int o = 1; o < 64; o <<= 1) { const float y = __shfl_down(x, o); if (lane + o < 64) x += y; }
      if (lane == 0) vec[258 + wv] = x;
    }
    gb = x; gcol = ig;
  }
  __syncthreads();
  if (tid < 256) {
    const int dir = tid >> 7, wv = (tid >> 6) & 1;
    if (dir == 0) { if (wv == 1) gb += vec[256]; } else { if (wv == 0) gb += vec[259]; }
    gcol = gcol - gb;
    float x = gcol;
    if (dir == 0) {
#pragma unroll
      for (int o = 1; o < 64; o <<= 1) { const float y = __shfl_up(x, o); if (lane >= o) x = fmaxf(x, y); }
      if (lane == 63) vec[260 + wv] = x;
    } else {
#pragma unroll
      for (int o = 1; o < 64; o <<= 1) { const float y = __shfl_down(x, o); if (lane + o < 64) x = fmaxf(x, y); }
      if (lane == 0) vec[262 + wv] = x;
    }
    gcm = x;
  }
  __syncthreads();
  if (tid < 256) {
    const int dir = tid >> 7, t = tid & 127, wv = (tid >> 6) & 1;
    if (dir == 0) { if (wv == 1) gcm = fmaxf(gcm, vec[260]); } else { if (wv == 0) gcm = fmaxf(gcm, vec[263]); }
    const float mx = fmaxf(vec[260 + 2 * dir], vec[261 + 2 * dir]);
    const float tot = vec[256 + 2 * dir] + vec[257 + 2 * dir];
    float* gv = gvec + ((size_t)(dir * 8 + bh) * SEQ + c * 128 + t) * 3;
    gv[0] = gb; gv[1] = gcol; gv[2] = gcm;
    vec[dir * 128 + t] = __expf(gcol - mx);
    if (t == 0) { scal[(dir * 8 + bh) * 128 + c] = tot; scal[2048 + (dir * 8 + bh) * 128 + c] = tot + mx; }
  }
  __syncthreads();
#pragma unroll
  for (int j = 0; j < 5; ++j) { const int rr = r0 + 32 * j;
    if (rr < 132) { *(LAS u32x4*)(lds + PA_RAWK + rr * 256 + c8 * 2) = rk[j]; *(LAS u32x4*)(lds + PA_KB + rr * 256 + c8 * 2) = rq[j]; } }
#pragma unroll
  for (int j = 0; j < 4; ++j) { const int r = r0 + 32 * j; *(LAS u32x4*)(lds + PA_V + (r >> 6) * 16384 + v_st(r & 63, c8)) = rv[j]; }
  __syncthreads();
  const float* conv_w = karg<A_CONVW>(); const float* conv_b = karg<A_CONVB>();
  {
    const int ch = h * 128 + c8;
    float w[5][8], bias[8];
#pragma unroll
    for (int j = 0; j < 5; ++j) { const f32x4 a = *(const f32x4*)(conv_w + j * 1024 + ch), bq = *(const f32x4*)(conv_w + j * 1024 + ch + 4);
      w[j][0] = a[0]; w[j][1] = a[1]; w[j][2] = a[2]; w[j][3] = a[3]; w[j][4] = bq[0]; w[j][5] = bq[1]; w[j][6] = bq[2]; w[j][7] = bq[3]; }
    { const f32x4 a = *(const f32x4*)(conv_b + ch), bq = *(const f32x4*)(conv_b + ch + 4); bias[0] = a[0]; bias[1] = a[1]; bias[2] = a[2]; bias[3] = a[3]; bias[4] = bq[0]; bias[5] = bq[1]; bias[6] = bq[2]; bias[7] = bq[3]; }
#pragma unroll
    for (int ps = 0; ps < 4; ++ps) {
      const int r = r0 + 32 * ps;
      float a[8];
#pragma unroll
      for (int e = 0; e < 8; ++e) a[e] = bias[e];
#pragma unroll
      for (int j = 0; j < 5; ++j) { const u32x4 xv = *(const LAS u32x4*)(lds + PA_KB + (r + j) * 256 + c8 * 2);
        a[0] += w[j][0] * bflo(xv[0]); a[1] += w[j][1] * bfhi(xv[0]); a[2] += w[j][2] * bflo(xv[1]); a[3] += w[j][3] * bfhi(xv[1]);
        a[4] += w[j][4] * bflo(xv[2]); a[5] += w[j][5] * bfhi(xv[2]); a[6] += w[j][6] * bflo(xv[3]); a[7] += w[j][7] * bfhi(xv[3]); }
      const float qs = 0.08838834764831845f;
#pragma unroll
      for (int e = 0; e < 8; ++e) a[e] = siluf_(a[e]) * qs;
      *(u32x4*)(qkpost + (size_t)(row0 + r) * 1024 + ch) = (u32x4){cvtpk(a[0], a[1]), cvtpk(a[2], a[3]), cvtpk(a[4], a[5]), cvtpk(a[6], a[7])};
    }
  }
  __syncthreads();
  {
    const int ch = 512 + h * 128 + c8;
    float w[5][8], bias[8];
#pragma unroll
    for (int j = 0; j < 5; ++j) { const f32x4 a = *(const f32x4*)(conv_w + j * 1024 + ch), bq = *(const f32x4*)(conv_w + j * 1024 + ch + 4);
      w[j][0] = a[0]; w[j][1] = a[1]; w[j][2] = a[2]; w[j][3] = a[3]; w[j][4] = bq[0]; w[j][5] = bq[1]; w[j][6] = bq[2]; w[j][7] = bq[3]; }
    { const f32x4 a = *(const f32x4*)(conv_b + ch), bq = *(const f32x4*)(conv_b + ch + 4); bias[0] = a[0]; bias[1] = a[1]; bias[2] = a[2]; bias[3] = a[3]; bias[4] = bq[0]; bias[5] = bq[1]; bias[6] = bq[2]; bias[7] = bq[3]; }
#pragma unroll
    for (int ps = 0; ps < 4; ++ps) {
      const int r = r0 + 32 * ps;
      float a[8];
#pragma unroll
      for (int e = 0; e < 8; ++e) a[e] = bias[e];
#pragma unroll
      for (int j = 0; j < 5; ++j) { const u32x4 xv = *(const LAS u32x4*)(lds + PA_RAWK + (r + j) * 256 + c8 * 2);
        a[0] += w[j][0] * bflo(xv[0]); a[1] += w[j][1] * bfhi(xv[0]); a[2] += w[j][2] * bflo(xv[1]); a[3] += w[j][3] * bfhi(xv[1]);
        a[4] += w[j][4] * bflo(xv[2]); a[5] += w[j][5] * bfhi(xv[2]); a[6] += w[j][6] * bflo(xv[3]); a[7] += w[j][7] * bfhi(xv[3]); }
#pragma unroll
      for (int e = 0; e < 8; ++e) a[e] = siluf_(a[e]);
      *(u32x4*)(qkpost + (size_t)(row0 + r) * 1024 + ch) = (u32x4){cvtpk(a[0], a[1]), cvtpk(a[2], a[3]), cvtpk(a[4], a[5]), cvtpk(a[6], a[7])};
      const float wf = vec[r], wb = vec[128 + r];
      const u32x4 kf = {cvtpk(a[0] * wf, a[1] * wf), cvtpk(a[2] * wf, a[3] * wf), cvtpk(a[4] * wf, a[5] * wf), cvtpk(a[6] * wf, a[7] * wf)};
      const u32x4 kb = {cvtpk(a[0] * wb, a[1] * wb), cvtpk(a[2] * wb, a[3] * wb), cvtpk(a[4] * wb, a[5] * wb), cvtpk(a[6] * wb, a[7] * wb)};
      const int io = (r >> 6) * 16384 + v_st(r & 63, c8);
      *(LAS u32x4*)(lds + PA_KF + io) = kf; *(LAS u32x4*)(lds + PA_KB + io) = kb;
    }
  }
  __syncthreads();
  {
    const int dir = wid >> 2, dkb = wid & 3;
    const int ka = (int)(uintptr_t)(lds + (dir ? PA_KB : PA_KF)) + v_rd_base(lane) + dkb * 512;
    const int va = (int)(uintptr_t)(lds + PA_V) + v_rd_base(lane);
    f32x16 o[4] = {};
#define PA_STEP(TILE, KS) do { s16x4 al, ah, l0, h0, l1, h1, l2, h2, l3, h3;                                                   \
      al = tr_read<v_rd_off(0, KS, 0)>(ka + TILE * 16384); ah = tr_read<v_rd_off(0, KS, 1)>(ka + TILE * 16384);                 \
      l0 = tr_read<v_rd_off(0, KS, 0)>(va + TILE * 16384); h0 = tr_read<v_rd_off(0, KS, 1)>(va + TILE * 16384);                 \
      l1 = tr_read<v_rd_off(1, KS, 0)>(va + TILE * 16384); h1 = tr_read<v_rd_off(1, KS, 1)>(va + TILE * 16384);                 \
      l2 = tr_read<v_rd_off(2, KS, 0)>(va + TILE * 16384); h2 = tr_read<v_rd_off(2, KS, 1)>(va + TILE * 16384);                 \
      l3 = tr_read<v_rd_off(3, KS, 0)>(va + TILE * 16384); h3 = tr_read<v_rd_off(3, KS, 1)>(va + TILE * 16384);                 \
      asm volatile("s_waitcnt lgkmcnt(0)" ::: "memory"); SBAR();                                                                \
      const bf16x8 A = PKLH(al, ah);                                                                                            \
      o[0] = MFMA32(A, PKLH(l0, h0), o[0]); o[1] = MFMA32(A, PKLH(l1, h1), o[1]); o[2] = MFMA32(A, PKLH(l2, h2), o[2]); o[3] = MFMA32(A, PKLH(l3, h3), o[3]); } while (0)
    PA_STEP(0, 0); PA_STEP(0, 1); PA_STEP(0, 2); PA_STEP(0, 3); PA_STEP(1, 0); PA_STEP(1, 1); PA_STEP(1, 2); PA_STEP(1, 3);
#undef PA_STEP
    bf16_t* Cd = Cbuf + ((size_t)(dir * 8 + bh) * 128 + c) * 16384;
#pragma unroll
    for (int r = 0; r < 16; ++r) { const int dk = dkb * 32 + crow(r, hi);
#pragma unroll
      for (int d0 = 0; d0 < 4; ++d0) Cd[dk * 128 + d0 * 32 + r32] = f2bf(o[d0][r]); }
  }
  if (tid < 256) {
    const int dir = tid >> 7, dk = tid & 127; const LAS unsigned char* img = lds + (dir ? PA_KB : PA_KF);
    float n = 0.f;
#pragma unroll 8
    for (int s = 0; s < 128; ++s) n += bf2f(*(const LAS unsigned short*)(img + (s >> 6) * 16384 + v_st(s & 63, dk)));
    nvec[((size_t)(dir * 8 + bh) * 128 + c) * 128 + dk] = n;
  }
  __syncthreads();
}

DI void phase_scan(const Ctx& p, int bid, int G) {
  const int tid = tid_fresh(); unsigned char* ws = p.ws;
  const float* scal = (const float*)(ws + WS_SCAL); float* mprev = (float*)(ws + WS_SCAL) + 4096; float* nvec = (float*)(ws + WS_NVEC); bf16_t* Cbuf = (bf16_t*)p.out;
  for (int gid = bid * NTHREADS + tid, it = 0; gid < 131072; gid += G * NTHREADS, ++it) {
    const int seq = gid >> 13, e2c = gid & 8191, dir = seq >> 3;
    const bool ex = (it == 0) && (gid < 1024);
    const int seqn = (gid & 1023) >> 6, e2 = gid & 63, dirn = seqn >> 3;
    float m = 0.f, a0 = 0.f, a1 = 0.f, mN = 0.f, n0 = 0.f, n1 = 0.f;
    for (int sb = 0; sb < 128; sb += 8) {
      unsigned raw[8]; f32x2 rawn[8];
#pragma unroll
      for (int q = 0; q < 8; ++q) { const int c = dir ? 127 - (sb + q) : sb + q; raw[q] = *(const unsigned*)(Cbuf + ((size_t)seq * 128 + c) * 16384 + e2c * 2); }
      if (ex) {
#pragma unroll
        for (int q = 0; q < 8; ++q) { const int c = dirn ? 127 - (sb + q) : sb + q; rawn[q] = *(const f32x2*)(nvec + ((size_t)seqn * 128 + c) * 128 + e2 * 2); }
      }
#pragma unroll
      for (int q = 0; q < 8; ++q) {
        const int c = dir ? 127 - (sb + q) : sb + q;
        const float be = scal[seq * 128 + c], ml = scal[2048 + seq * 128 + c];
        *(unsigned*)(Cbuf + ((size_t)seq * 128 + c) * 16384 + e2c * 2) = cvtpk(a0, a1);
        if (e2c == 0) mprev[seq * 128 + c] = m;
        const float mn = fmaxf(be + m, ml), al = __expf(be + m - mn), bt = __expf(ml - mn);
        a0 = al * a0 + bt * bflo(raw[q]); a1 = al * a1 + bt * bfhi(raw[q]);
        m = mn;
      }
      if (ex) {
#pragma unroll
        for (int q = 0; q < 8; ++q) {
          const int c = dirn ? 127 - (sb + q) : sb + q;
          const float be = scal[seqn * 128 + c], ml = scal[2048 + seqn * 128 + c];
          *(f32x2*)(nvec + ((size_t)seqn * 128 + c) * 128 + e2 * 2) = (f32x2){n0, n1};
          const float mn = fmaxf(be + mN, ml), al = __expf(be + mN - mn), bt = __expf(ml - mn);
          n0 = al * n0 + bt * rawn[q][0]; n1 = al * n1 + bt * rawn[q][1];
          mN = mn;
        }
      }
    }
  }
}

DI void qkt8(f32x16& p0, f32x16& p1, const LAS unsigned char* Ks, const bf16x8* qr, int r32, int hi) {
  p0 = f32x16{}; p1 = f32x16{};
#pragma unroll
  for (int d0 = 0; d0 < 8; ++d0) { const int cb = (d0 * 16 + hi * 8) * 2;
    const bf16x8 b0 = *(const LAS bf16x8*)(Ks + KSWZ(r32, cb)), b1 = *(const LAS bf16x8*)(Ks + KSWZ(32 + r32, cb));
    p0 = MFMA32(b0, qr[d0], p0); p1 = MFMA32(b1, qr[d0], p1); }
}
DI v8i kfrag8(const LAS unsigned char* K8, int row, int s, int hi) {
  const int c = 4 * s + 2 * hi;
  const u32x4 lo = *(const LAS u32x4*)(K8 + row * 256 + ((c ^ (row & 15)) << 4)), hi4 = *(const LAS u32x4*)(K8 + row * 256 + (((c + 1) ^ (row & 15)) << 4));
  return (v8i){(int)lo[0], (int)lo[1], (int)lo[2], (int)lo[3], (int)hi4[0], (int)hi4[1], (int)hi4[2], (int)hi4[3]};
}
#define MFMA8(a, b, c) __builtin_amdgcn_mfma_scale_f32_32x32x64_f8f6f4((a), (b), (c), 0, 0, 0, 127, 0, 123)
DI void qkt12(f32x16& p0, f32x16& p1, const LAS unsigned char* K8, const v8i* qr, int r32, int hi) {
  p0 = f32x16{}; p1 = f32x16{};
#pragma unroll
  for (int s = 0; s < 3; ++s) {
    const v8i a0 = kfrag8(K8, r32, s, hi), a1 = kfrag8(K8, 32 + r32, s, hi);
    p0 = MFMA8(a0, qr[s], p0); p1 = MFMA8(a1, qr[s], p1);
  }
}

DI void glds16(const void* gsrc, unsigned lds_dst) {
  unsigned keep;
  asm volatile("s_mov_b32 %0, m0\n\ts_mov_b32 m0, %2\n\ts_nop 0\n\tglobal_load_lds_dwordx4 %1, off\n\ts_mov_b32 m0, %0" : "=&s"(keep) : "v"(gsrc), "s"(lds_dst) : "memory");
}
constexpr int AT_KN = 0, AT_V = 49152, AT_WS = 73728;
constexpr float ATT_THR = 3.f;
DI void partialSM(f32x16& p0, f32x16& p1, float& m_reg, float& mn, float& alpha) {
  float pmax = p0[0];
#pragma unroll
  for (int r = 1; r < 16; ++r) pmax = fmaxf(pmax, p0[r]);
#pragma unroll
  for (int r = 0; r < 16; ++r) pmax = fmaxf(pmax, p1[r]);
  pmax = half_swap_max(pmax);
  if (__builtin_expect(__all(pmax - m_reg <= ATT_THR), 1)) { mn = m_reg; alpha = 1.f; }
  else { mn = fmaxf(m_reg, pmax); alpha = __builtin_amdgcn_exp2f(m_reg - mn); m_reg = mn; }
  const float mo = mn - 5.f;
#pragma unroll
  for (int r = 0; r < 16; ++r) { p0[r] = p0[r] - mo; p1[r] = p1[r] - mo; }
#pragma unroll
  for (int r = 0; r < 16; ++r) p0[r] = __builtin_amdgcn_exp2f(p0[r]);
}
DI void finishSM(f32x16& p0, f32x16& p1, v8i& pa) {
#pragma unroll
  for (int r = 0; r < 16; ++r) p1[r] = __builtin_amdgcn_exp2f(p1[r]);
#pragma unroll
  for (int q = 0; q < 4; ++q) {
    int w = __builtin_amdgcn_cvt_pk_fp8_f32(p0[4 * q], p0[4 * q + 1], pa[q], false); pa[q] = __builtin_amdgcn_cvt_pk_fp8_f32(p0[4 * q + 2], p0[4 * q + 3], w, true);
    w = __builtin_amdgcn_cvt_pk_fp8_f32(p1[4 * q], p1[4 * q + 1], pa[4 + q], false); pa[4 + q] = __builtin_amdgcn_cvt_pk_fp8_f32(p1[4 * q + 2], p1[4 * q + 3], w, true);
  }
}
DI void pv8(f32x16* o, f32x16& lsum, const LAS unsigned char* Vt, v8i pa, int r32, int hi) {
  { const v8i ones = {0x38383838, 0x38383838, 0x38383838, 0x38383838, 0x38383838, 0x38383838, 0x38383838, 0x38383838};
    lsum = __builtin_amdgcn_mfma_scale_f32_32x32x64_f8f6f4(pa, ones, lsum, 0, 0, 0, 122, 0, 127); }
#pragma unroll
  for (int d0 = 0; d0 < 4; ++d0) {
    const int n = 32 * d0 + r32, x = (n >> 2) & 3;
    const u32x4 lo = *(const LAS u32x4*)(Vt + n * 64 + (((2 * hi) ^ x) << 4)), h4 = *(const LAS u32x4*)(Vt + n * 64 + (((2 * hi + 1) ^ x) << 4));
    const v8i bv = {(int)lo[0], (int)lo[1], (int)lo[2], (int)lo[3], (int)h4[0], (int)h4[1], (int)h4[2], (int)h4[3]};
    o[d0] = __builtin_amdgcn_mfma_scale_f32_32x32x64_f8f6f4(pa, bv, o[d0], 0, 0, 0, 122, 0, 127);
  }
}
DI void attn_unit(const unsigned char* Qb, const unsigned char* Knh, const unsigned char* Vh, bf16_t* Ob, LAS unsigned char* lds) {
  const int tid = tid_fresh(), wid = __builtin_amdgcn_readfirstlane(tid >> 6), lane = tid & 63, r32 = lane & 31, hi = lane >> 5;
  LAS float* wsf = (LAS float*)(lds + AT_WS) + wid * 64; LAS float* al_l = wsf + 32;
  constexpr int NT = SEQ / 64;
  unsigned offKn, offV;
  { const int row = wid * 4 + (lane >> 4); int lg = (lane & 15) ^ (row & 15); lg = lg < 12 ? lg : 0; offKn = (unsigned)(row * 192 + lg * 16); }
  { const int n = wid * 16 + (lane >> 2), c = (lane & 3) ^ ((n >> 2) & 3); offV = (unsigned)(n * 64 + c * 16); }
  const unsigned ldsw = (unsigned)wid * 1024u, lds0 = (unsigned)(uintptr_t)lds;
#define DMA16(gptr, ldsoff) glds16((gptr), (unsigned)__builtin_amdgcn_readfirstlane((int)(lds0 + (unsigned)(ldsoff))))
#define ISSUE_K(t, ks) do { const int t_ = (t) < NT ? (t) : NT - 1; const char* kn_ = (const char*)Knh + (size_t)t_ * (64 * 192) + offKn; \
    DMA16(kn_, AT_KN + (ks) * 16384 + ldsw); DMA16(kn_ + 32 * 192, AT_KN + (ks) * 16384 + 8192 + ldsw); } while (0)
#define ISSUE_V(t, vs) do { const int t_ = (t) < NT ? (t) : NT - 1; DMA16((const char*)Vh + (size_t)t_ * 8192 + offV, AT_V + (vs) * 8192 + ldsw); } while (0)
#define WAIT_BAR(N) asm volatile("s_waitcnt vmcnt(" #N ") lgkmcnt(0)\n\ts_barrier" ::: "memory")
#define RESC(a) do { if (__any((a) < 1.f)) { if (hi == 0) al_l[r32] = (a); asm volatile("s_waitcnt lgkmcnt(0)" ::: "memory"); \
    _Pragma("unroll") for (int r = 0; r < 16; ++r) { const float a_ = al_l[crow(r, hi)]; lsum[r] *= a_; _Pragma("unroll") for (int d = 0; d < 4; ++d) o[d][r] *= a_; } } } while (0)
  const bool trail = wid >= 4;
  ISSUE_K(0, 0); ISSUE_K(1, 1); ISSUE_V(0, 0);
  float m_reg = -1e30f; f32x16 lsum = {}; f32x16 o[4] = {}; v8i qr[3];
  { const unsigned char* Qw = Qb + (size_t)(wid * 32 + r32) * 192 + hi * 32;
#pragma unroll
    for (int s_ = 0; s_ < 3; ++s_) { const u32x4 lo = *(const u32x4*)(Qw + s_ * 64), h4 = *(const u32x4*)(Qw + s_ * 64 + 16);
      qr[s_] = (v8i){(int)lo[0], (int)lo[1], (int)lo[2], (int)lo[3], (int)h4[0], (int)h4[1], (int)h4[2], (int)h4[3]}; } }
  f32x16 pA0, pA1, pB0, pB1; float mnA, mnB, alA, alB; v8i pa = {};
  asm volatile("s_waitcnt vmcnt(0)" ::: "memory");
  __builtin_amdgcn_s_barrier();
  if (trail) __builtin_amdgcn_s_barrier();
  ISSUE_K(2, 2);
  qkt12(pA0, pA1, lds + AT_KN, qr, r32, hi);
  WAIT_BAR(3);
  ISSUE_V(1, 1);
  partialSM(pA0, pA1, m_reg, mnA, alA);
  WAIT_BAR(3);
  int s1 = 1;
  for (int j = 1; j + 1 < NT; j += 2) {
    const int s0 = s1 == 0 ? 2 : s1 - 1, s2 = s1 == 2 ? 0 : s1 + 1;
    ISSUE_K(j + 2, s0);
    SBAR(); qkt12(pB0, pB1, lds + AT_KN + s1 * 16384, qr, r32, hi);
    finishSM(pA0, pA1, pa); SBAR();
    WAIT_BAR(3);
    ISSUE_V(j + 1, s2);
    pv8(o, lsum, lds + AT_V + s0 * 8192, pa, r32, hi); partialSM(pB0, pB1, m_reg, mnB, alB);
    RESC(alB);
    WAIT_BAR(3);
    ISSUE_K(j + 3, s1);
    SBAR(); qkt12(pA0, pA1, lds + AT_KN + s2 * 16384, qr, r32, hi);
    finishSM(pB0, pB1, pa); SBAR();
    WAIT_BAR(3);
    ISSUE_V(j + 2, s0);
    pv8(o, lsum, lds + AT_V + s1 * 8192, pa, r32, hi); partialSM(pA0, pA1, m_reg, mnA, alA);
    RESC(alA);
    WAIT_BAR(3);
    s1 = s0;
  }
  {
    const int s0 = s1 == 0 ? 2 : s1 - 1, s2 = s1 == 2 ? 0 : s1 + 1;
    ISSUE_K(NT + 1, s0);
    SBAR(); qkt12(pB0, pB1, lds + AT_KN + s1 * 16384, qr, r32, hi);
    finishSM(pA0, pA1, pa); SBAR();
    WAIT_BAR(3);
    ISSUE_V(NT, s2);
    pv8(o, lsum, lds + AT_V + s0 * 8192, pa, r32, hi); partialSM(pB0, pB1, m_reg, mnB, alB);
    RESC(alB);
    WAIT_BAR(3);
    if (!trail) __builtin_amdgcn_s_barrier();
    finishSM(pB0, pB1, pa); SBAR();
    pv8(o, lsum, lds + AT_V + s1 * 8192, pa, r32, hi);
  }
  float rli[16];
#pragma unroll
  for (int r = 0; r < 16; ++r) rli[r] = __builtin_amdgcn_rcpf(lsum[r]);
  bf16_t* Ow = Ob + (size_t)(wid * 32) * 1024;
#pragma unroll
  for (int r = 0; r < 16; ++r) { const int orow = crow(r, hi);
#pragma unroll
    for (int d0 = 0; d0 < 4; ++d0) Ow[(size_t)orow * 1024 + d0 * 32 + r32] = f2bf(o[d0][r] * rli[r]); }
  asm volatile("s_waitcnt vmcnt(0) lgkmcnt(0)\n\ts_barrier" ::: "memory");
#undef DMA16
#undef ISSUE_K
#undef ISSUE_V
#undef WAIT_BAR
#undef RESC
}
DI void phase_attn(const Ctx& p, int bid, int G, LAS unsigned char* lds) {
  unsigned char* ws = p.ws;
  const unsigned char* qatt = ws + WS_QATT; const unsigned char* k8 = ws + WS_KN; const unsigned char* va = ws + WS_VA;
  bf16_t* hcat = (bf16_t*)(ws + WS_H);
  for (int u = bid; u < 512; u += G) {
    const int bh = u & 7, qb = u >> 3, b = bh >> 2, h = bh & 3;
    attn_unit(qatt + ((size_t)bh * SEQ + qb * 256) * 192, k8 + (size_t)bh * SEQ * 192, va + (size_t)bh * SEQ * 128,
              hcat + (size_t)(b * SEQ + qb * 256) * 1024 + 512 + h * 128, lds);
  }
}

constexpr int PC_K = 0, PC_V = 32768, PC_CF = 65536, PC_CB = 98304, PC_VEC = 131072;
template <bool DRY = false> DI void mlstmC_unit(const Ctx& p, int b, int h, int c, LAS unsigned char* lds) {
  const int tid = tid_fresh(), lane = tid & 63, wid = __builtin_amdgcn_readfirstlane(tid >> 6), r32 = lane & 31, hi = lane >> 5;
  unsigned char* ws = p.ws;
  const bf16_t* qkpost = (const bf16_t*)(ws + WS_U); const bf16_t* vmp = (const bf16_t*)(ws + WS_VM); bf16_t* hcat = (bf16_t*)(ws + WS_H);
  const float* gvec = (const float*)(ws + WS_GVEC); const float* nvec = (const float*)(ws + WS_NVEC); const float* mprev = (const float*)(ws + WS_SCAL) + 4096;
  const bf16_t* Cbuf = (const bf16_t*)p.out;
  LAS float* vec = (LAS float*)(lds + PC_VEC);
  const int bh = b * 4 + h, row0 = b * SEQ + c * 128;
  if (tid < 256) {
    const int dir = tid >> 7, t = tid & 127;
    const float* gv = gvec + ((size_t)(dir * 8 + bh) * SEQ + c * 128 + t) * 3;
    const float gb = gv[0], gcol = gv[1], gcm = gv[2], mp = mprev[(dir * 8 + bh) * 128 + c];
    const float M = fmaxf(mp, gcm);
    vec[dir * 128 + t] = gcol * LOG2E; vec[256 + dir * 128 + t] = M * LOG2E; vec[512 + dir * 128 + t] = __expf(mp - M); vec[768 + dir * 128 + t] = __expf(-(gb + M));
    vec[1024 + dir * 128 + t] = nvec[((size_t)(dir * 8 + bh) * 128 + c) * 128 + t];
  }
  {
    const int r0 = tid >> 4, c8 = (tid & 15) * 8;
    const bf16_t* Cf = Cbuf + ((size_t)(0 * 8 + bh) * 128 + c) * 16384; const bf16_t* Cb = Cbuf + ((size_t)(1 * 8 + bh) * 128 + c) * 16384;
#pragma unroll
    for (int ps = 0; ps < 4; ++ps) {
      const int r = r0 + 32 * ps, tile = r >> 6, rr = r & 63;
      *(LAS u32x4*)(lds + PC_K + tile * 16384 + KSWZ(rr, c8 * 2)) = *(const u32x4*)(qkpost + (size_t)(row0 + r) * 1024 + 512 + h * 128 + c8);
      *(LAS u32x4*)(lds + PC_V + tile * 16384 + v_st(rr, c8)) = *(const u32x4*)(vmp + (size_t)(row0 + r) * 512 + h * 128 + c8);
      *(LAS u32x4*)(lds + PC_CF + tile * 16384 + v_st(rr, c8)) = *(const u32x4*)(Cf + r * 128 + c8);
      *(LAS u32x4*)(lds + PC_CB + tile * 16384 + v_st(rr, c8)) = *(const u32x4*)(Cb + r * 128 + c8);
    }
  }
  const int dir = wid >> 2, tb = wid & 3, t = tb * 32 + r32;
  bf16x8 qr[8];
  { const bf16_t* Qw = qkpost + (size_t)(row0 + t) * 1024 + h * 128 + hi * 8;
#pragma unroll
    for (int d0 = 0; d0 < 8; ++d0) qr[d0] = *(const bf16x8*)(Qw + d0 * 16); }
  __syncthreads();
  const LAS float* vcol = vec + dir * 128; const LAS float* va_ = vec + 512 + dir * 128; const LAS float* vn = vec + 1024 + dir * 128;
  float qn = 0.f;
#pragma unroll
  for (int d0 = 0; d0 < 8; ++d0)
#pragma unroll
    for (int j = 0; j < 8; ++j) qn += bf2f((unsigned short)qr[d0][j]) * vn[d0 * 16 + hi * 8 + j];
  qn = half_swap_sum(qn);
  asm volatile("" : "+v"(qn));
  SBAR();
  f32x16 o[4] = {};
  {
    const int vbc = (int)(uintptr_t)(lds + (dir ? PC_CB : PC_CF)) + v_rd_base(lane);
    pv_d0(o, vbc, qr[0], qr[1], qr[2], qr[3]);
    pv_d0(o, vbc + 16384, qr[4], qr[5], qr[6], qr[7]);
  }
#pragma unroll
  for (int d = 0; d < 4; ++d)
#pragma unroll
    for (int r = 0; r < 16; ++r) o[d][r] *= va_[tb * 32 + crow(r, hi)];
  SBAR();
  const float Mt = vec[256 + dir * 128 + t], at = va_[t], flt = vec[768 + dir * 128 + t];
  float rsum = 0.f;
  const int vbv = (int)(uintptr_t)(lds + PC_V) + v_rd_base(lane);
#pragma unroll
  for (int kt = 0; kt < 2; ++kt) {
    const bool need = dir == 0 ? (kt * 64 <= tb * 32 + 31) : (kt * 64 + 63 >= tb * 32);
    if (need) {
      f32x16 p0, p1; qkt8(p0, p1, lds + PC_K + kt * 16384, qr, r32, hi);
#pragma unroll
      for (int r = 0; r < 16; ++r) {
        const int s0 = kt * 64 + crow(r, hi), s1 = s0 + 32;
        const bool ok0 = dir == 0 ? (s0 <= t) : (s0 >= t), ok1 = dir == 0 ? (s1 <= t) : (s1 >= t);
        const float w0 = __builtin_amdgcn_exp2f(vcol[s0] - Mt), w1 = __builtin_amdgcn_exp2f(vcol[s1] - Mt);
        p0[r] = ok0 ? p0[r] * w0 : 0.f; p1[r] = ok1 ? p1[r] * w1 : 0.f;
        rsum += p0[r] + p1[r];
      }
      bf16x8 pa0, pa1, pa2, pa3; pack_p(p0, p1, pa0, pa1, pa2, pa3);
      pv_d0(o, vbv + kt * 16384, pa0, pa1, pa2, pa3);
    }
  }
  rsum = half_swap_sum(rsum);
  {
    const float den = at * qn + rsum, dn = fmaxf(fabsf(den), flt);
    LAS float* rd = vec + 1280 + dir * 128;
    if (hi == 0) rd[t] = 1.f / dn;
    asm volatile("s_waitcnt lgkmcnt(0)" ::: "memory");
#pragma unroll
    for (int d = 0; d < 4; ++d)
#pragma unroll
      for (int r = 0; r < 16; ++r) o[d][r] *= rd[tb * 32 + crow(r, hi)];
  }
  __syncthreads();
  {
    LAS float* hst = (LAS float*)(lds + dir * 65536);
#pragma unroll
    for (int r = 0; r < 16; ++r) { const int tr = tb * 32 + crow(r, hi);
#pragma unroll
      for (int d = 0; d < 4; ++d) hst[tr * 128 + d * 32 + r32] = o[d][r]; }
  }
  __syncthreads();
  {
    const int rg = tid >> 5, cl = tid & 31;
    const f32x4 g = *(const f32x4*)(karg<A_MHG>() + h * 128 + 4 * cl);
    u32x2 sgv[8];
#pragma unroll
    for (int ps = 0; ps < 8; ++ps) sgv[ps] = *(const u32x2*)(hcat + (size_t)(row0 + ps * 16 + rg) * 1024 + h * 128 + 4 * cl);
#pragma unroll
    for (int ps = 0; ps < 8; ++ps) {
      const int tr = ps * 16 + rg;
      const f32x4 xf = *(const LAS f32x4*)(lds + (tr * 128 + 4 * cl) * 4), xb = *(const LAS f32x4*)(lds + 65536 + (tr * 128 + 4 * cl) * 4);
      f32x4 x = xf + xb;
      float s = (x[0] + x[1]) + (x[2] + x[3]);
#pragma unroll
      for (int o_ = 1; o_ < 32; o_ <<= 1) s += __shfl_xor(s, o_);
      const float mu = s * (1.f / 128.f); x = x - mu;
      float q = (x[0] * x[0] + x[1] * x[1]) + (x[2] * x[2] + x[3] * x[3]);
#pragma unroll
      for (int o_ = 1; o_ < 32; o_ <<= 1) q += __shfl_xor(q, o_);
      const float rstd = rsqrtf(q * (1.f / 128.f) + LN_EPS);
      u32x2* dst = (u32x2*)(hcat + (size_t)(row0 + tr) * 1024 + h * 128 + 4 * cl);
      const u32x2 sg = sgv[ps];
      const f32x4 y = x * rstd * g;
      if (DRY) dst = (u32x2*)((bf16_t*)(ws + WS_QKPRE) + (size_t)(row0 + tr) * 1024 + h * 128 + 4 * cl);
      *dst = (u32x2){cvtpk(y[0] * bflo(sg[0]), y[1] * bfhi(sg[0])), cvtpk(y[2] * bflo(sg[1]), y[3] * bfhi(sg[1]))};
    }
  }
  __syncthreads();
}

template <bool DRY = false> DI void phase_hanorm(const Ctx& p, int bid, int G) {
  const int tid = tid_fresh(), lane = tid & 63, wave = tid >> 6; bf16_t* hcat = (bf16_t*)(p.ws + WS_H);
  const f32x4 g0 = *(const f32x4*)(karg<A_ANG>() + 8 * lane), g1 = *(const f32x4*)(karg<A_ANG>() + 8 * lane + 4);
  u32x4 wn = {0u, 0u, 0u, 0u};
  { const int row = bid * 8 + wave; if (row < T) wn = *(const u32x4*)(hcat + (size_t)row * 1024 + 512 + 8 * lane); }
  for (int row = bid * 8 + wave; row < T; row += G * 8) {
    u32x4* ptr = (u32x4*)(hcat + (size_t)row * 1024 + 512 + 8 * lane);
    const u32x4 w = wn;
    if (row + G * 8 < T) wn = *(const u32x4*)(hcat + (size_t)(row + G * 8) * 1024 + 512 + 8 * lane);
    float v[8] = {bflo(w[0]), bfhi(w[0]), bflo(w[1]), bfhi(w[1]), bflo(w[2]), bfhi(w[2]), bflo(w[3]), bfhi(w[3])};
    float s = 0.f;
#pragma unroll
    for (int e = 0; e < 8; ++e) s += v[e] * v[e];
    const float rs = rsqrtf(wave_sum(s) * (1.f / 512.f) + RMS_EPS);
    if (DRY) ptr = (u32x4*)((bf16_t*)(p.ws + WS_QKPRE) + (size_t)row * 1024 + 512 + 8 * lane);
    *ptr = (u32x4){cvtpk(v[0] * rs * g0[0], v[1] * rs * g0[1]), cvtpk(v[2] * rs * g0[2], v[3] * rs * g0[3]), cvtpk(v[4] * rs * g1[0], v[5] * rs * g1[1]), cvtpk(v[6] * rs * g1[2], v[7] * rs * g1[3])};
  }
}

template <bool DRY = false> DI void phase_route(const Ctx& p, int bid, int G, LAS unsigned char* lds) {
  const int tid = tid_fresh(), lane = tid & 63, wave = tid >> 6; unsigned char* ws = p.ws;
  LAS float* wreT = (LAS float*)lds;
  LAS float* wrgT = (LAS float*)(lds + 131072);
  LAS int* rec = (LAS int*)(lds + 147456);
  LAS int* lcnt = (LAS int*)(lds + 147456 + 2048);
  { const f32x4* wrt = (const f32x4*)(ws + WS_WRT);
    for (int i = tid; i < 36 * 256; i += NTHREADS) ((LAS f32x4*)lds)[i] = wrt[i]; }
  const float* ln1_g = karg<A_LN1G>(); const float* ln1_b = karg<A_LN1B>(); const float* b_rg = karg<A_BRG>(); const float* b_re = karg<A_BRE>();
  const float* mod = (const float*)(ws + WS_MOD); bf16_t* U = (bf16_t*)(ws + WS_U);
  int* cnt = (int*)(ws + WS_CNT) + (DRY ? 32 * CNT_STRIDE : 0);
  int* ltok = (int*)(ws + (DRY ? WS_HDN : WS_LTOK)); float* lw = (float*)(ws + (DRY ? WS_HDN + 8 * MiB : WS_LW));
  int* toke = (int*)(ws + WS_TOKE) + (DRY ? 2 * T : 0); int* tokp = (int*)(ws + WS_TOKP) + (DRY ? 2 * T : 0);
  const int nk = T / (G * 8);
  for (int k0 = 0; k0 < nk; k0 += 16) {
    if (tid < 32) lcnt[tid] = 0;
    __syncthreads();
    u32x2 zn[4];
    { const u32x2* zr = (const u32x2*)((const bf16_t*)p.out + (size_t)(bid * 8 + wave + k0 * G * 8) * 1024) + lane;
#pragma unroll
      for (int j = 0; j < 4; ++j) zn[j] = zr[64 * j]; }
    for (int kk = 0; kk < 16 && k0 + kk < nk; ++kk) {
      const int row = bid * 8 + wave + (k0 + kk) * G * 8, b = row >> 14;
      u32x2* x1r = (u32x2*)((bf16_t*)(ws + (DRY ? 384 * MiB : WS_H)) + (size_t)row * 1024) + lane;
      f32x4 v[4]; float s = 0.f;
#pragma unroll
      for (int j = 0; j < 4; ++j) { const u32x2 raw = zn[j]; v[j] = (f32x4){bflo(raw[0]), bfhi(raw[0]), bflo(raw[1]), bfhi(raw[1])}; s += (v[j][0] + v[j][1]) + (v[j][2] + v[j][3]); }
      if (kk + 1 < 16 && k0 + kk + 1 < nk) { const u32x2* zr = (const u32x2*)((const bf16_t*)p.out + (size_t)(row + G * 8) * 1024) + lane;
#pragma unroll
        for (int j = 0; j < 4; ++j) zn[j] = zr[64 * j]; }
      float mean = wave_sum(s) * (1.f / 1024.f), s2 = 0.f;
#pragma unroll
      for (int j = 0; j < 4; ++j) { v[j] = v[j] - mean; s2 += (v[j][0] * v[j][0] + v[j][1] * v[j][1]) + (v[j][2] * v[j][2] + v[j][3] * v[j][3]); }
      float rstd = rsqrtf(wave_sum(s2) * (1.f / 1024.f) + LN_EPS);
      s = 0.f;
#pragma unroll
      for (int j = 0; j < 4; ++j) { const int col = 4 * lane + 256 * j;
        v[j] = v[j] * rstd * *(const f32x4*)(ln1_g + col) + *(const f32x4*)(ln1_b + col);
        x1r[64 * j] = (u32x2){cvtpk(v[j][0], v[j][1]), cvtpk(v[j][2], v[j][3])};
        s += (v[j][0] + v[j][1]) + (v[j][2] + v[j][3]); }
      mean = wave_sum(s) * (1.f / 1024.f); s2 = 0.f;
#pragma unroll
      for (int j = 0; j < 4; ++j) { v[j] = v[j] - mean; s2 += (v[j][0] * v[j][0] + v[j][1] * v[j][1]) + (v[j][2] * v[j][2] + v[j][3] * v[j][3]); }
      rstd = rsqrtf(wave_sum(s2) * (1.f / 1024.f) + LN_EPS);
      u32x2* o8 = (u32x2*)(U + (size_t)row * 1024) + lane;
      float gl[4] = {0.f, 0.f, 0.f, 0.f};
#pragma unroll
      for (int j = 0; j < 4; ++j) { const int col = 4 * lane + 256 * j;
        v[j] = v[j] * rstd * (*(const f32x4*)(mod + b * 6144 + 4096 + col) + 1.f) + *(const f32x4*)(mod + b * 6144 + 3072 + col);
        o8[64 * j] = (u32x2){cvtpk(v[j][0], v[j][1]), cvtpk(v[j][2], v[j][3])};
#pragma unroll
        for (int e = 0; e < 4; ++e) { const f32x4 w = *(const LAS f32x4*)(wrgT + e * 1024 + col); gl[e] += v[j][0] * w[0] + v[j][1] * w[1] + v[j][2] * w[2] + v[j][3] * w[3]; } }
#pragma unroll
      for (int e = 0; e < 4; ++e) gl[e] = wave_sum(gl[e]) + b_rg[e];
      int gi = 0; float gm = gl[0];
#pragma unroll
      for (int e = 1; e < 4; ++e) if (gl[e] > gm) { gm = gl[e]; gi = e; }
      float gs = 0.f;
#pragma unroll
      for (int e = 0; e < 4; ++e) gs += __expf(gl[e] - gm);
      const float gw = 1.f / gs;
      float el[8] = {0.f, 0.f, 0.f, 0.f, 0.f, 0.f, 0.f, 0.f};
#pragma unroll
      for (int j = 0; j < 4; ++j) { const int col = 4 * lane + 256 * j;
#pragma unroll
        for (int e = 0; e < 8; ++e) { const f32x4 w = *(const LAS f32x4*)(wreT + (gi * 8 + e) * 1024 + col); el[e] += v[j][0] * w[0] + v[j][1] * w[1] + v[j][2] * w[2] + v[j][3] * w[3]; } }
#pragma unroll
      for (int e = 0; e < 8; ++e) el[e] = wave_sum(el[e]) + b_re[gi * 8 + e];
      int i1 = 0; float v1 = el[0];
#pragma unroll
      for (int e = 1; e < 8; ++e) if (el[e] > v1) { v1 = el[e]; i1 = e; }
      int i2 = (i1 == 0) ? 1 : 0; float v2 = (i1 == 0) ? el[1] : el[0];
#pragma unroll
      for (int e = 0; e < 8; ++e) if (e != i1 && el[e] > v2) { v2 = el[e]; i2 = e; }
      const float p1 = 1.f / (1.f + __expf(v2 - v1)), p2 = 1.f - p1;
      if (lane == 0) {
        const int e1 = gi * 8 + i1, e2 = gi * 8 + i2, li = kk * 8 + wave;
        const int q1 = __hip_atomic_fetch_add(&lcnt[e1], 1, __ATOMIC_RELAXED, __HIP_MEMORY_SCOPE_WORKGROUP), q2 = __hip_atomic_fetch_add(&lcnt[e2], 1, __ATOMIC_RELAXED, __HIP_MEMORY_SCOPE_WORKGROUP);
        rec[li * 4 + 0] = e1 | (e2 << 8); rec[li * 4 + 1] = q1 | (q2 << 16); rec[li * 4 + 2] = __float_as_int(p1 * gw); rec[li * 4 + 3] = __float_as_int(p2 * gw);
      }
    }
    __syncthreads();
    if (tid < 32) { const int n = lcnt[tid]; lcnt[32 + tid] = n ? atomicAdd(&cnt[tid * CNT_STRIDE], n) : 0; }
    __syncthreads();
    if (tid < 128 && k0 + (tid >> 3) < nk) {
      const int li = tid, row = bid * 8 + (li & 7) + (k0 + (li >> 3)) * G * 8;
      const int ee = rec[li * 4], qq = rec[li * 4 + 1], e1 = ee & 255, e2 = ee >> 8, q1 = lcnt[32 + e1] + (qq & 0xffff), q2 = lcnt[32 + e2] + (qq >> 16);
      ltok[(size_t)e1 * T + q1] = row; lw[(size_t)e1 * T + q1] = __int_as_float(rec[li * 4 + 2]);
      ltok[(size_t)e2 * T + q2] = row; lw[(size_t)e2 * T + q2] = __int_as_float(rec[li * 4 + 3]);
      toke[row * 2] = e1; toke[row * 2 + 1] = e2; tokp[row * 2] = q1; tokp[row * 2 + 1] = q2;
    }
    __syncthreads();
  }
}

constexpr int MOE_TS = 131072;
DI void moe_table(const Ctx& p, LAS unsigned char* lds) {
  LAS int* ts = (LAS int*)(lds + MOE_TS); const int* cnt = (const int*)(p.ws + WS_CNT);
  if (threadIdx.x < 64) {
    const int lane = threadIdx.x; const int n = lane < 32 ? (cnt[lane * CNT_STRIDE] + 255) >> 8 : 0; int a = n;
#pragma unroll
    for (int o = 1; o < 32; o <<= 1) { const int t = __shfl_up(a, o); a += lane >= o ? t : 0; }
    if (lane < 32) ts[lane] = a - n;
    if (lane == 31) ts[32] = a;
  }
  __syncthreads();
}

template <bool DRY = false> DI void phase_final(const Ctx& p, int bid, int G, LAS unsigned char* lds) {
  const int tid = tid_fresh(), lane = tid & 63, wave = tid >> 6; unsigned char* ws = p.ws;
  const LAS int* ts = (const LAS int*)(lds + MOE_TS); const float* ln2_g = karg<A_LN2G>(); const float* ln2_b = karg<A_LN2B>();
  const float* mod = (const float*)(ws + WS_MOD); const bf16_t* ybuf = (const bf16_t*)(ws + WS_YBUF); const int* toke = (const int*)(ws + WS_TOKE); const int* tokp = (const int*)(ws + WS_TOKP);
  const int stride = G * 8; int row = bid * 8 + wave;
  size_t s0n = 0, s1n = 0;
  u32x2 an[4], cn[4], xn[4];
  auto slots = [&](int r, size_t& a, size_t& c) { a = (size_t)ts[toke[r * 2]] * 256 + tokp[r * 2]; c = (size_t)ts[toke[r * 2 + 1]] * 256 + tokp[r * 2 + 1]; };
  auto loadrow = [&](int r, size_t a, size_t c) {
    const u32x2* x1r = (const u32x2*)((const bf16_t*)(ws + WS_H) + (size_t)r * 1024) + lane;
    const u32x2* y0 = (const u32x2*)(ybuf + a * 1024) + lane; const u32x2* y1 = (const u32x2*)(ybuf + c * 1024) + lane;
#pragma unroll
    for (int j = 0; j < 4; ++j) { an[j] = y0[64 * j]; cn[j] = y1[64 * j]; xn[j] = x1r[64 * j]; } };
  if (row < T) { size_t a, c; slots(row, a, c); loadrow(row, a, c); if (row + stride < T) slots(row + stride, s0n, s1n); }
  for (; row < T; row += stride) {
    const int b = row >> 14;
    f32x4 v[4]; float s = 0.f;
#pragma unroll
    for (int j = 0; j < 4; ++j) { const int col = 4 * lane + 256 * j;
      const u32x2 a = an[j], c = cn[j], xw = xn[j];
      const f32x4 y = {bflo(a[0]) + bflo(c[0]), bfhi(a[0]) + bfhi(c[0]), bflo(a[1]) + bflo(c[1]), bfhi(a[1]) + bfhi(c[1])};
      const f32x4 x1v = {bflo(xw[0]), bfhi(xw[0]), bflo(xw[1]), bfhi(xw[1])};
      v[j] = x1v * ALPHA + (*(const f32x4*)(mod + b * 6144 + 5120 + col) + 1.f) * y;
      s += (v[j][0] + v[j][1]) + (v[j][2] + v[j][3]); }
    if (row + stride < T) { loadrow(row + stride, s0n, s1n); if (row + 2 * stride < T) slots(row + 2 * stride, s0n, s1n); }
    const float mean = wave_sum(s) * (1.f / 1024.f); float s2 = 0.f;
#pragma unroll
    for (int j = 0; j < 4; ++j) { v[j] = v[j] - mean; s2 += (v[j][0] * v[j][0] + v[j][1] * v[j][1]) + (v[j][2] * v[j][2] + v[j][3] * v[j][3]); }
    const float rstd = rsqrtf(wave_sum(s2) * (1.f / 1024.f) + LN_EPS);
    f32x4* xr = (f32x4*)(p.out + (size_t)row * 1024) + lane;
#pragma unroll
    for (int j = 0; j < 4; ++j) { const int col = 4 * lane + 256 * j; xr[64 * j] = v[j] * rstd * *(const f32x4*)(ln2_g + col) + *(const f32x4*)(ln2_b + col); }
  }
}


#define XB_TMO      128
#define XB_XCNT(j)  (256  + 64 * (j))
#define XB_XSUB(j)  (1280 + 64 * (j))
#define XB_XGEN(j)  (2304 + 64 * (j))
#define XB_TOP      3328
#define XB_TOPGEN   3392
#define XCD_BAR_WORDS 3456
#define XB_SPIN_CAP (1u << 18)
DI unsigned xb_ld(unsigned* p)              { return __hip_atomic_load(p, __ATOMIC_RELAXED, __HIP_MEMORY_SCOPE_AGENT); }
DI unsigned xb_add(unsigned* p, unsigned v) { return __hip_atomic_fetch_add(p, v, __ATOMIC_RELAXED, __HIP_MEMORY_SCOPE_AGENT); }
DI unsigned xb_xcc_id() { return (unsigned)__builtin_amdgcn_s_getreg((3 << 11) | 20) & 0xFu; }
#define XB_SPIN(cond, bar) do { unsigned _sp = 0; while (cond) { __builtin_amdgcn_s_sleep(1); \
    if ((++_sp & 255u) == 0u) { if (xb_ld(&(bar)[XB_TMO])) break; if (_sp > XB_SPIN_CAP) { atomicAdd(&(bar)[XB_TMO], 1u); break; } } } } while (0)
struct XcdBarrier { unsigned* bar; unsigned x; volatile LAS unsigned* st; };
DI XcdBarrier xcd_barrier_post(unsigned* bar, volatile LAS unsigned* st) {
  XcdBarrier b; b.bar = bar; b.x = xb_xcc_id(); b.st = st;
  if (threadIdx.x == 0) (void)xb_add(&bar[XB_XCNT(b.x)], 1u);
  return b;
}
DI void xcd_barrier_complete(unsigned* bar, unsigned x, unsigned& nloc, unsigned& nx) {
  const unsigned G = gridDim.x * gridDim.y * gridDim.z;
  unsigned sum, cnt, mine, sp = 0u;
  for (;;) {
    sum = 0u; cnt = 0u; mine = 0u;
#pragma unroll
    for (unsigned j = 0; j < 16; ++j) { const unsigned c = xb_ld(&bar[XB_XCNT(j)]); sum += c; cnt += (c > 0u) ? 1u : 0u; mine = (j == x) ? c : mine; }
    if (sum == G) break;
    __builtin_amdgcn_s_sleep(1);
    if ((++sp & 255u) == 0u) { if (xb_ld(&bar[XB_TMO])) break; if (sp > XB_SPIN_CAP) { atomicAdd(&bar[XB_TMO], 1u); break; } }
  }
  nloc = mine > 0u ? mine : 1u; nx = cnt > 0u ? cnt : 1u;
}
DI void xcd_barrier(const XcdBarrier& b) {
  asm volatile("s_waitcnt vmcnt(0)" ::: "memory");
  __syncthreads();
  if (threadIdx.x == 0) {
    unsigned* bar = b.bar;
    __builtin_amdgcn_s_waitcnt(0);
    unsigned nloc = b.st[0], nx = b.st[1];
    if (nloc == 0u) { xcd_barrier_complete(bar, b.x, nloc, nx); b.st[0] = nloc; b.st[1] = nx; }
    const unsigned old = xb_add(&bar[XB_XSUB(b.x)], 1u);
    const unsigned gen = old / nloc;
    if (old + 1u == (gen + 1u) * nloc) {
      __builtin_amdgcn_fence(__ATOMIC_RELEASE, "agent");
      asm volatile("s_waitcnt vmcnt(0)" ::: "memory");
      const unsigned og = xb_add(&bar[XB_TOP], 1u);
      const unsigned tg = og / nx;
      if (og + 1u == (tg + 1u) * nx) xb_add(&bar[XB_TOPGEN], 1u);
      else XB_SPIN(xb_ld(&bar[XB_TOPGEN]) == tg, bar);
      __builtin_amdgcn_fence(__ATOMIC_ACQUIRE, "agent");
      xb_add(&bar[XB_XGEN(b.x)], 1u);
      asm volatile("s_waitcnt vmcnt(0)" ::: "memory");
    } else {
      XB_SPIN(xb_ld(&bar[XB_XGEN(b.x)]) == gen, bar);
      __builtin_amdgcn_fence(__ATOMIC_ACQUIRE, "agent");
      asm volatile("s_waitcnt vmcnt(0)" ::: "memory");
    }
  }
  __syncthreads();
}

__device__ unsigned g_bar_counter = 0;
DI void grid_barrier(const unsigned G) {
  asm volatile("s_waitcnt vmcnt(0)" ::: "memory");
  __syncthreads();
  if (threadIdx.x == 0) {
    __builtin_amdgcn_fence(__ATOMIC_RELEASE, "agent");
    asm volatile("s_waitcnt vmcnt(0)" ::: "memory");
    const unsigned old = __hip_atomic_fetch_add(&g_bar_counter, 1u, __ATOMIC_RELAXED, __HIP_MEMORY_SCOPE_AGENT);
    const unsigned target = (old / G + 1u) * G;
    unsigned sp = 0;
    while ((int)(__hip_atomic_load(&g_bar_counter, __ATOMIC_RELAXED, __HIP_MEMORY_SCOPE_AGENT) - target) < 0) { __builtin_amdgcn_s_sleep(1); if (++sp > (1u << 24)) break; }
    __builtin_amdgcn_fence(__ATOMIC_ACQUIRE, "agent");
    asm volatile("s_waitcnt vmcnt(0)" ::: "memory");
  }
  __syncthreads();
}

#define KERNEL_HEAD extern __shared__ __attribute__((aligned(16))) unsigned char lds_raw[]; LAS unsigned char* lds = (LAS unsigned char*)lds_raw; const int bid = blockIdx.x, G = gridDim.x; \
  Ctx p; p.ws = karg<A_WS, unsigned char>(); p.out = karg<A_OUT, float>();
#ifdef MULTI_LAUNCH
__global__ void __launch_bounds__(NTHREADS, 2) k_prep(Params) { KERNEL_HEAD phase_prep(p, bid, G, lds); }
__global__ void __launch_bounds__(NTHREADS, 2) k_lnmod(Params) { KERNEL_HEAD (void)lds; phase_lnmod(p, bid, G); }
__global__ void __launch_bounds__(NTHREADS, 2) k_inproj(Params) { KERNEL_HEAD
  unsigned char* ws = p.ws;
  g8::DenseOrder S; S.init(T, N_INP, 1024, ws + WS_WIN, G, bid);
  EpiIn E{(bf16_t*)(ws + WS_QKPRE), (bf16_t*)(ws + WS_VM), (bf16_t*)(ws + WS_H), (bf16_t*)(ws + WS_CQ), (bf16_t*)(ws + WS_CKV), (unsigned char*)(ws + WS_KN), (float*)(ws + WS_GATES),
          (float*)(ws + WS_SSQQ), (float*)(ws + WS_SSQKV), (const float*)(ws + WS_ROPE), karg<A_GATEB>()};
  g8::gemm_phase(lds, (const char*)(ws + WS_U), 1024, S, E);
}
__global__ void __launch_bounds__(NTHREADS, 2) k_mid1(Params) { KERNEL_HEAD
  unsigned char* ws = p.ws;
  { g8::DenseOrder S; S.init(T, 768, 384, ws + WS_WUQ, G, bid); EpiUQ E{(unsigned char*)(ws + WS_QATT), (const float*)(ws + WS_SSQQ), (const float*)(ws + WS_ROPE)};
    g8::gemm_phase(lds, (const char*)(ws + WS_CQ), 384, S, E); }
}
__global__ void __launch_bounds__(NTHREADS, 2) k_mid2(Params) { KERNEL_HEAD
  unsigned char* ws = p.ws;
  { g8::DenseOrder S; S.init(T, 1024, 256, ws + WS_WUKV, G, bid); EpiUKV E{(unsigned char*)(ws + WS_KN), (unsigned char*)(ws + WS_VA), (const float*)(ws + WS_SSQKV)};
    g8::gemm_phase(lds, (const char*)(ws + WS_CKV), 256, S, E); }
}
__global__ void __launch_bounds__(NTHREADS, 2) k_mid3(Params) { KERNEL_HEAD
  for (int u = bid; u < 1024; u += G) { const int c = u & 127, bh = u >> 7; mlstmA_unit(p, bh >> 2, bh & 3, c, lds); }
}
__global__ void __launch_bounds__(NTHREADS, 2) k_scan_attn(Params) { KERNEL_HEAD phase_scan(p, bid, G); phase_attn(p, bid, G, lds); }
__global__ void __launch_bounds__(NTHREADS, 2) k_mlstm_out(Params) { KERNEL_HEAD
  for (int u = bid; u < 1024; u += G) { const int c = u & 127, bh = u >> 7; mlstmC_unit(p, bh >> 2, bh & 3, c, lds); }
  phase_hanorm(p, bid, G);
}
__global__ void __launch_bounds__(NTHREADS, 2) k_outproj(Params) { KERNEL_HEAD
  unsigned char* ws = p.ws;
  g8::DenseOrder S; S.init(T, 1024, 1024, ws + WS_WOUT, G, bid); EpiOut E{karg<A_X>(), (const float*)(ws + WS_MOD), (bf16_t*)p.out};
  g8::gemm_phase(lds, (const char*)(ws + WS_H), 1024, S, E);
}
__global__ void __launch_bounds__(NTHREADS, 2) k_route(Params) { KERNEL_HEAD phase_route(p, bid, G, lds); }
__global__ void __launch_bounds__(NTHREADS, 2) k_moe_gu(Params) { KERNEL_HEAD
  unsigned char* ws = p.ws; moe_table(p, lds);
  MoeOrderGU S; S.tstart = (const LAS int*)(lds + MOE_TS); S.cnt = (const int*)(ws + WS_CNT); S.G = G; S.c = bid; S.ltok = (const int*)(ws + WS_LTOK); S.Bt = (const char*)(ws + WS_WGU);
  EpiGU E{(bf16_t*)(ws + WS_HDN)};
  g8::gemm_phase(lds, (const char*)(ws + WS_U), 1024, S, E);
}
__global__ void __launch_bounds__(NTHREADS, 2) k_moe_dn(Params) { KERNEL_HEAD
  unsigned char* ws = p.ws; moe_table(p, lds);
  MoeOrderDN S; S.tstart = (const LAS int*)(lds + MOE_TS); S.cnt = (const int*)(ws + WS_CNT); S.G = G; S.c = bid; S.Bt = (const char*)(ws + WS_WDN);
  EpiDN E{(bf16_t*)(ws + WS_YBUF), (const float*)(ws + WS_LW)};
  g8::gemm_phase(lds, (const char*)(ws + WS_HDN), 512, S, E);
}
__global__ void __launch_bounds__(NTHREADS, 2) k_final(Params) { KERNEL_HEAD moe_table(p, lds); phase_final(p, bid, G, lds); }

#endif

__global__ void __launch_bounds__(NTHREADS, 2) k_mega(Params) { KERNEL_HEAD
  unsigned char* ws = p.ws;
  if (bid == 0) for (int i = threadIdx.x; i < XCD_BAR_WORDS; i += NTHREADS) ((unsigned*)(ws + WS_BAR))[i] = 0u;
  if (threadIdx.x < 64) ((LAS unsigned*)(lds + LDS_BARST))[threadIdx.x] = 0u;
  XcdBarrier xbar; xbar.bar = (unsigned*)(ws + WS_BAR); xbar.x = 0; xbar.st = (volatile LAS unsigned*)(lds + LDS_BARST);
  bool xb_ready = false;
#define PHASE_SEP() do { asm volatile("" ::: "memory"); if (!xb_ready) { grid_barrier((unsigned)G); xbar = xcd_barrier_post((unsigned*)(ws + WS_BAR), (volatile LAS unsigned*)(lds + LDS_BARST)); xb_ready = true; } \
    else xcd_barrier(xbar); asm volatile("" ::: "memory"); } while (0)
#define REP(n) for (int rep_ = 0; rep_ < ((n) == DBL_PHASE ? 2 : 1); ++rep_)
  REP(0) phase_prep(p, bid, G, lds);
  PHASE_SEP();
#if MEGA_STOP == 1
  return;
#endif
  REP(1) phase_lnmod(p, bid, G);
  PHASE_SEP();
#if MEGA_STOP == 2
  return;
#endif
  REP(2) { g8::DenseOrder S; S.init(T, N_INP, 1024, ws + WS_WIN, G, bid);
    EpiIn E{(bf16_t*)(ws + WS_QKPRE), (bf16_t*)(ws + WS_VM), (bf16_t*)(ws + WS_H), (bf16_t*)(ws + WS_CQ), (bf16_t*)(ws + WS_CKV), (unsigned char*)(ws + WS_KN), (float*)(ws + WS_GATES),
            (float*)(ws + WS_SSQQ), (float*)(ws + WS_SSQKV), (const float*)(ws + WS_ROPE), karg<A_GATEB>()};
    g8::gemm_phase(lds, (const char*)(ws + WS_U), 1024, S, E);
    { const int first = S.nwg % G, nb = G - first;
      if (bid >= first) { const int tid = tid_fresh(), lane = tid & 63, wave = __builtin_amdgcn_readfirstlane(tid >> 6);
        prep_items(PREP_ITEMS - PREP_DEFER + (bid - first) * 8 + wave, PREP_ITEMS, nb * 8, lane, ws, (LAS float*)(lds + wave * 16384)); } } }
  PHASE_SEP();
#if MEGA_STOP == 3
  return;
#endif
  const bool mfirst = ((bid >> 3) & 1) != 0;
  if (mfirst) { for (int u = bid; u < 1024; u += G) { const int c = u & 127, bh = u >> 7; mlstmA_unit(p, bh >> 2, bh & 3, c, lds); } __syncthreads(); }
  { g8::DenseOrder S; S.init(T, 768, 384, ws + WS_WUQ, G, bid); EpiUQ E{(unsigned char*)(ws + WS_QATT), (const float*)(ws + WS_SSQQ), (const float*)(ws + WS_ROPE)};
    g8::gemm_phase(lds, (const char*)(ws + WS_CQ), 384, S, E); }
  __syncthreads();
  { g8::DenseOrder S; S.init(T, 1024, 256, ws + WS_WUKV, G, bid); EpiUKV E{(unsigned char*)(ws + WS_KN), (unsigned char*)(ws + WS_VA), (const float*)(ws + WS_SSQKV)};
    g8::gemm_phase(lds, (const char*)(ws + WS_CKV), 256, S, E); }
  __syncthreads();
  if (!mfirst) { for (int u = bid; u < 1024; u += G) { const int c = u & 127, bh = u >> 7; mlstmA_unit(p, bh >> 2, bh & 3, c, lds); } }
  PHASE_SEP();
#if MEGA_STOP == 4
  return;
#endif
  phase_scan(p, bid, G);
  REP(4) phase_attn(p, bid, G, lds);
  PHASE_SEP();
#if MEGA_STOP == 5
  return;
#endif
#if DBL_PHASE == 5
  for (int u = bid; u < 1024; u += G) { const int c = u & 127, bh = u >> 7; mlstmC_unit<true>(p, bh >> 2, bh & 3, c, lds); }
#endif
#if DBL_PHASE == 55
  phase_hanorm<true>(p, bid, G);
#endif
  for (int u = bid; u < 1024; u += G) { const int c = u & 127, bh = u >> 7; mlstmC_unit(p, bh >> 2, bh & 3, c, lds); }
  phase_hanorm(p, bid, G);
  PHASE_SEP();
#if MEGA_STOP == 6
  return;
#endif
  REP(6) { g8::DenseOrder S; S.init(T, 1024, 1024, ws + WS_WOUT, G, bid); EpiOut E{karg<A_X>(), (const float*)(ws + WS_MOD), (bf16_t*)p.out};
    g8::gemm_phase(lds, (const char*)(ws + WS_H), 1024, S, E); }
  PHASE_SEP();
#if MEGA_STOP == 7
  return;
#endif
#if DBL_PHASE == 7
  phase_route<true>(p, bid, G, lds);
#endif
  phase_route(p, bid, G, lds);
  PHASE_SEP();
#if MEGA_STOP == 8
  return;
#endif
  moe_table(p, lds);
  REP(8) { MoeOrderGU S; S.tstart = (const LAS int*)(lds + MOE_TS); S.cnt = (const int*)(ws + WS_CNT); S.G = G; S.c = bid; S.ltok = (const int*)(ws + WS_LTOK); S.Bt = (const char*)(ws + WS_WGU);
    EpiGU E{(bf16_t*)(ws + WS_HDN)};
    g8::gemm_phase(lds, (const char*)(ws + WS_U), 1024, S, E); }
  PHASE_SEP();
#if MEGA_STOP == 9
  return;
#endif
  REP(9) { MoeOrderDN S; S.tstart = (const LAS int*)(lds + MOE_TS); S.cnt = (const int*)(ws + WS_CNT); S.G = G; S.c = bid; S.Bt = (const char*)(ws + WS_WDN);
    EpiDN E{(bf16_t*)(ws + WS_YBUF), (const float*)(ws + WS_LW)};
    g8::gemm_phase(lds, (const char*)(ws + WS_HDN), 512, S, E); }
  PHASE_SEP();
#if MEGA_STOP == 10
  return;
#endif
#if DBL_PHASE == 10
  phase_final<true>(p, bid, G, lds);
#endif
  phase_final(p, bid, G, lds);
#undef REP
#undef PHASE_SEP
}

#ifdef PROBE_OFF
__global__ void __launch_bounds__(NTHREADS, 2) k_probe(Params p, size_t off, size_t n, int is_f32, int from_out) {
  const unsigned char* base = from_out ? (const unsigned char*)p.out : p.ws + off;
  for (size_t i = (size_t)blockIdx.x * NTHREADS + threadIdx.x; i < (size_t)T * D; i += (size_t)gridDim.x * NTHREADS) {
    const size_t j = i % n; float v = is_f32 ? ((const float*)base)[j] : bf2f(((const unsigned short*)base)[j]);
    if (!(fabsf(v) < 1e30f)) v = 777.f;
    if (from_out) { if (j != i) break; ((float*)p.out)[i] = v; } else p.out[i] = v;
  }
}
#endif
extern "C" void kernel_launch(void* const* d_in, const int* in_sizes, int n_in, void* d_out, int out_size, void* d_ws, size_t ws_size, hipStream_t stream) {
  static int ok = 0, grid = 256;
  typedef void (*kfn)(Params);
#ifndef MULTI_LAUNCH
  const kfn kernels[] = {k_mega};
#else
  const kfn kernels[] = {k_prep, k_lnmod, k_inproj, k_mid1, k_mid2, k_mid3, k_scan_attn, k_mlstm_out, k_outproj, k_route, k_moe_gu, k_moe_dn, k_final};
#endif
  if (ok == 0) {
    if (n_in != 27 || in_sizes[0] != T * D || out_size != T * D || ws_size < WS_END) { fprintf(stderr, "kernel_launch: unexpected shapes (n_in %d, in0 %d, out %d, ws %zu)\n", n_in, n_in > 0 ? in_sizes[0] : -1, out_size, ws_size); ok = -1; return; }
    for (kfn k : kernels) if (hipFuncSetAttribute((const void*)k, hipFuncAttributeMaxDynamicSharedMemorySize, LDS_BYTES) != hipSuccess) { fprintf(stderr, "kernel_launch: hipFuncSetAttribute failed\n"); ok = -1; return; }
    int dev = 0, cus = 0, per_cu = 0;
    if (hipGetDevice(&dev) != hipSuccess || hipDeviceGetAttribute(&cus, hipDeviceAttributeMultiprocessorCount, dev) != hipSuccess) { fprintf(stderr, "kernel_launch: device query failed\n"); ok = -1; return; }
    if (hipOccupancyMaxActiveBlocksPerMultiprocessor(&per_cu, (const void*)kernels[0], NTHREADS, LDS_BYTES) != hipSuccess || per_cu < 1) { fprintf(stderr, "kernel_launch: occupancy query says %d blocks/CU\n", per_cu); (void)hipGetLastError(); per_cu = 1; }
    grid = cus < 256 ? cus : 256;
    fprintf(stderr, "kernel_launch: %d CUs, %d blocks/CU by the occupancy query, grid %d\n", cus, per_cu, grid);
    ok = 1;
  }
  if (ok < 0) return;
  Params p{};
  p.x = (const float*)d_in[0]; p.c = (const float*)d_in[1]; p.pos = (const int*)d_in[2]; p.w_ada = (const float*)d_in[3]; p.b_ada = (const float*)d_in[4]; p.w_in = (const float*)d_in[5];
  p.conv_w = (const float*)d_in[6]; p.conv_b = (const float*)d_in[7]; p.gate_b = (const float*)d_in[8]; p.mh_g = (const float*)d_in[9]; p.qn_g = (const float*)d_in[10]; p.kvn_g = (const float*)d_in[11];
  p.w_uq = (const float*)d_in[12]; p.w_ukv = (const float*)d_in[13]; p.an_g = (const float*)d_in[14]; p.w_out = (const float*)d_in[15]; p.ln1_g = (const float*)d_in[16]; p.ln1_b = (const float*)d_in[17];
  p.w_rg = (const float*)d_in[18]; p.b_rg = (const float*)d_in[19]; p.w_re = (const float*)d_in[20]; p.b_re = (const float*)d_in[21]; p.w_gate = (const float*)d_in[22]; p.w_up = (const float*)d_in[23];
  p.w_down = (const float*)d_in[24]; p.ln2_g = (const float*)d_in[25]; p.ln2_b = (const float*)d_in[26];
  p.out = (float*)d_out; p.ws = (unsigned char*)d_ws;
#ifndef NKERN
#define NKERN 6
#endif
  { int ik = 0; for (kfn k : kernels) { if (ik++ >= NKERN) break; hipLaunchKernelGGL(k, dim3(grid), dim3(NTHREADS), LDS_BYTES, stream, p); } }
#ifdef PROBE_OFF
  hipLaunchKernelGGL(k_probe, dim3(1024), dim3(NTHREADS), 0, stream, p, (size_t)(PROBE_OFF), (size_t)(PROBE_N), PROBE_F32, 0);
#endif
  const hipError_t le = hipPeekAtLastError();
  if (le != hipSuccess) fprintf(stderr, "kernel_launch: launch failed: %s\n", hipGetErrorName(le));
}
```

```cpp
#define NKERN 99
#ifndef MEGA_STOP
#define MEGA_STOP 0
#endif
#ifndef DBL_PHASE
#define DBL_PHASE -1
#endif
#include <hip/hip_runtime.h>
#include <cstdio>
#include <cstdint>
#include <cmath>

#define DI __device__ __forceinline__
#define LAS __attribute__((address_space(3)))
typedef unsigned short bf16_t;
typedef short bf16x8 __attribute__((ext_vector_type(8)));
typedef short s16x4 __attribute__((ext_vector_type(4)));
typedef float f32x4 __attribute__((ext_vector_type(4)));
typedef float f32x2 __attribute__((ext_vector_type(2)));
typedef float f32x16 __attribute__((ext_vector_type(16)));
typedef unsigned u32x4 __attribute__((ext_vector_type(4)));
typedef unsigned u32x2 __attribute__((ext_vector_type(2)));

constexpr int BATCH = 2, SEQ = 16384, T = BATCH * SEQ, D = 1024;
constexpr int NCH = SEQ / 128;
constexpr int N_IN = 2768, N_INP = 2816;
constexpr int NEXP = 32;
constexpr float LN_EPS = 1e-5f, RMS_EPS = 1e-6f;
constexpr float ALPHA = 1.189207115002721f;
constexpr float LOG2E = 1.4426950408889634f;
constexpr float QSCALE = 0.07216878364870323f * LOG2E * 16.f;
constexpr int NTHREADS = 512;
constexpr int LDS_BYTES = 148 * 1024;

constexpr size_t MiB = 1u << 20;
constexpr size_t WS_WIN = 0, WS_WUQ = 6 * MiB, WS_WUKV = 7 * MiB, WS_WOUT = 8 * MiB, WS_WGU = 10 * MiB, WS_WDN = 74 * MiB;
constexpr size_t WS_MOD = 106 * MiB, WS_CNT = 106 * MiB + 65536, WS_ROPE = 107 * MiB, WS_GATES = 115 * MiB, WS_GVEC = 117 * MiB;
constexpr size_t WS_SSQQ = 120 * MiB, WS_SSQKV = 122 * MiB, WS_NVEC = 123 * MiB, WS_SCAL = 124 * MiB, WS_TOKE = 125 * MiB, WS_TOKP = 125 * MiB + 512 * 1024;
constexpr size_t WS_U = 128 * MiB, WS_H = 192 * MiB, WS_QKPRE = 256 * MiB, WS_VM = 320 * MiB, WS_CQ = 352 * MiB, WS_CKV = 376 * MiB;
constexpr size_t WS_KROPE = 392 * MiB, WS_QATT = 396 * MiB, WS_KN = 444 * MiB, WS_VA = 476 * MiB, WS_END = 512 * MiB;
constexpr size_t WS_BAR = 106 * MiB + 131072, CTL_ZERO_OFF = WS_CNT, CTL_ZERO_BYTES = 131072;
constexpr int LDS_BARST = LDS_BYTES - 256;
constexpr size_t WS_LTOK = 256 * MiB, WS_LW = 260 * MiB, WS_HDN = 264 * MiB, WS_YBUF = 336 * MiB;
constexpr int MAXTILES = 288;
constexpr int CNT_STRIDE = 64;
constexpr size_t WS_WRT = 126 * MiB;

struct Params {
  const float* x; const float* c; const int* pos; const float* w_ada; const float* b_ada; const float* w_in; const float* conv_w; const float* conv_b;
  const float* gate_b; const float* mh_g; const float* qn_g; const float* kvn_g; const float* w_uq; const float* w_ukv; const float* an_g; const float* w_out;
  const float* ln1_g; const float* ln1_b; const float* w_rg; const float* b_rg; const float* w_re; const float* b_re; const float* w_gate; const float* w_up;
  const float* w_down; const float* ln2_g; const float* ln2_b;
  float* out; unsigned char* ws;
};

enum { A_X = 0, A_C, A_POS, A_WADA, A_BADA, A_WIN, A_CONVW, A_CONVB, A_GATEB, A_MHG, A_QNG, A_KVNG, A_WUQ, A_WUKV, A_ANG, A_WOUT, A_LN1G, A_LN1B, A_WRG, A_BRG, A_WRE, A_BRE,
       A_WGATE, A_WUP, A_WDOWN, A_LN2G, A_LN2B, A_OUT, A_WS };
template <int IDX, class Tp = const float> __device__ __forceinline__ Tp* karg() {
  const unsigned long long k = (unsigned long long)__builtin_amdgcn_kernarg_segment_ptr();
  unsigned long long v;
  asm volatile("s_load_dwordx2 %0, %1, %2\n\ts_waitcnt lgkmcnt(0)" : "=s"(v) : "s"(k), "i"(IDX * 8) : "memory");
  return (Tp*)v;
}
struct Ctx { unsigned char* ws; float* out; };
DI unsigned cvtpk(float lo, float hi) { unsigned r; asm volatile("v_cvt_pk_bf16_f32 %0, %1, %2" : "=v"(r) : "v"(lo), "v"(hi)); return r; }
DI unsigned short f2bf(float f) { unsigned u = __float_as_uint(f); return (unsigned short)((u + 0x7fffu + ((u >> 16) & 1u)) >> 16); }
typedef int v8i __attribute__((ext_vector_type(8)));
DI u32x2 cvt8(f32x4 a, f32x4 b) {
  int w0 = __builtin_amdgcn_cvt_pk_fp8_f32(a[0], a[1], 0, false); w0 = __builtin_amdgcn_cvt_pk_fp8_f32(a[2], a[3], w0, true);
  int w1 = __builtin_amdgcn_cvt_pk_fp8_f32(b[0], b[1], 0, false); w1 = __builtin_amdgcn_cvt_pk_fp8_f32(b[2], b[3], w1, true);
  return (u32x2){(unsigned)w0, (unsigned)w1};
}
DI float bf2f(unsigned short v) { return __uint_as_float(((unsigned)v) << 16); }
DI float bflo(unsigned w) { return __uint_as_float(w << 16); }
DI float bfhi(unsigned w) { return __uint_as_float(w & 0xffff0000u); }
DI int tid_fresh() { int t = threadIdx.x; asm volatile("" : "+v"(t)); return t; }
DI float wave_sum(float v) {
#pragma unroll
  for (int o = 1; o < 64; o <<= 1) v += __shfl_xor(v, o);
  return v;
}
DI float sigmoidf_(float x) { return 1.f / (1.f + __expf(-x)); }
DI float siluf_(float x) { return x / (1.f + __expf(-x)); }
DI float logsigmoidf_(float x) { return fminf(x, 0.f) - log1pf(__expf(-fabsf(x))); }
DI int crow(int r, int hi) { return (r & 3) + 8 * (r >> 2) + 4 * hi; }
#define SBAR() __builtin_amdgcn_sched_barrier(0)
#define KSWZ(row, colB) ((row) * 256 + ((colB) ^ (((row) & 15) << 4)))
#define KRSWZ(row, colB) ((row) * 128 + ((colB) ^ ((((row) >> 1) & 7) << 4)))
#define MFMA32(a, b, c) __builtin_amdgcn_mfma_f32_32x32x16_bf16((a), (b), (c), 0, 0, 0)

DI int v_st(int k, int c) { const int kk = (k & ~0xC) | ((k & 4) << 1) | ((k & 8) >> 1); return ((kk >> 3) * 4 + (c >> 5)) * 512 + ((kk & 7) * 32 + (c & 31)) * 2; }
DI int v_rd_base(int lane) { return ((lane & 3) << 3) | (((lane >> 2) & 3) << 6) | (((lane >> 4) & 1) << 5) | (((lane >> 5) & 1) << 8); }
constexpr int v_rd_off(int d0, int ks, int half) { return d0 * 512 + ks * 4096 + half * 2048; }
template <int OFF> DI s16x4 tr_read(int vb) {
  s16x4 r; asm volatile("ds_read_b64_tr_b16 %0, %1 offset:%2" : "=&v"(r) : "v"(vb), "i"(OFF) : "memory"); return r;
}
#define PKLH(L, H) (bf16x8){L[0], L[1], L[2], L[3], H[0], H[1], H[2], H[3]}
template <int KS> DI bf16x8 tr_frag_nowait(int vb, s16x4& l, s16x4& h) { l = tr_read<v_rd_off(0, KS, 0)>(vb); h = tr_read<v_rd_off(0, KS, 1)>(vb); return PKLH(l, h); }
template <int D0> DI void pv_one(f32x16& od, int vb, bf16x8 pa0, bf16x8 pa1, bf16x8 pa2, bf16x8 pa3) {
  const s16x4 l0 = tr_read<v_rd_off(D0, 0, 0)>(vb), h0 = tr_read<v_rd_off(D0, 0, 1)>(vb), l1 = tr_read<v_rd_off(D0, 1, 0)>(vb), h1 = tr_read<v_rd_off(D0, 1, 1)>(vb);
  const s16x4 l2 = tr_read<v_rd_off(D0, 2, 0)>(vb), h2 = tr_read<v_rd_off(D0, 2, 1)>(vb), l3 = tr_read<v_rd_off(D0, 3, 0)>(vb), h3 = tr_read<v_rd_off(D0, 3, 1)>(vb);
  asm volatile("s_waitcnt lgkmcnt(0)" ::: "memory"); SBAR();
  od = MFMA32(pa0, PKLH(l0, h0), od); od = MFMA32(pa1, PKLH(l1, h1), od); od = MFMA32(pa2, PKLH(l2, h2), od); od = MFMA32(pa3, PKLH(l3, h3), od);
}
DI void pv_d0(f32x16* o, int vb, bf16x8 pa0, bf16x8 pa1, bf16x8 pa2, bf16x8 pa3) {
  pv_one<0>(o[0], vb, pa0, pa1, pa2, pa3); pv_one<1>(o[1], vb, pa0, pa1, pa2, pa3); pv_one<2>(o[2], vb, pa0, pa1, pa2, pa3); pv_one<3>(o[3], vb, pa0, pa1, pa2, pa3);
}
DI void pack_p(const f32x16& p0, const f32x16& p1, bf16x8& pa0, bf16x8& pa1, bf16x8& pa2, bf16x8& pa3) {
#define PK4(P, BASE, OUT) do { unsigned a0 = cvtpk(P[BASE + 0], P[BASE + 1]), a1 = cvtpk(P[BASE + 2], P[BASE + 3]);   \
    unsigned b0 = cvtpk(P[BASE + 4], P[BASE + 5]), b1 = cvtpk(P[BASE + 6], P[BASE + 7]);                              \
    auto r0 = __builtin_amdgcn_permlane32_swap(a0, b0, false, false); auto r1 = __builtin_amdgcn_permlane32_swap(a1, b1, false, false); \
    u32x4 w = {r0[0], r1[0], r0[1], r1[1]}; OUT = *reinterpret_cast<bf16x8*>(&w); } while (0)
  PK4(p0, 0, pa0); PK4(p0, 8, pa1); PK4(p1, 0, pa2); PK4(p1, 8, pa3);
#undef PK4
}
DI float half_swap_sum(float v) { auto rr = __builtin_amdgcn_permlane32_swap(__float_as_uint(v), __float_as_uint(v), false, false); return __uint_as_float(rr[0]) + __uint_as_float(rr[1]); }
DI float half_swap_max(float v) { auto rr = __builtin_amdgcn_permlane32_swap(__float_as_uint(v), __float_as_uint(v), false, false); return fmaxf(__uint_as_float(rr[0]), __uint_as_float(rr[1])); }

namespace g8 {
constexpr int BM = 256, BK = 64, HALF = 128, HTB = HALF * BK * 2, STAGE_BYTES = 8 * HTB;
DI int lds_byte(int r, int c) { const int st = (r >> 4) * 2 + (c >> 5), rr = r & 15, cc = c & 31, ob = rr * 64 + cc * 2; return st * 1024 + (ob ^ (((ob >> 9) & 1) << 5)); }
DI void stage_rc(int b, int& R, int& C) { const int st = b / 1024, sb = b % 1024, swz = sb ^ (((sb >> 9) & 1) << 5); R = (st >> 1) * 16 + swz / 64; C = (st & 1) * 32 + (swz % 64) / 2; }
DI int perm32(int rho) { const int n = rho >> 4, i = rho & 15; return 8 * (i >> 2) + 4 * n + (i & 3); }
struct Unit { int pm, pn, e, j; };

template <class Epi, class Sched>
DI void gemm_phase(LAS unsigned char* lds, const char* Abase, const int Kc, const Sched& S, const Epi& E) {
  constexpr bool GATHER = Sched::GATHER;
  int K = Kc; asm volatile("" : "+s"(K));
  const int tid = tid_fresh(), wid = __builtin_amdgcn_readfirstlane(tid >> 6), lane = tid & 63, wr = wid >> 2, wc = wid & 3, fr = lane & 15, fq = lane >> 4;
  const int nt = K / BK;
  unsigned voffA[2], voffB[2];
#pragma unroll
  for (int i = 0; i < 2; ++i) { int R, C; stage_rc(tid * 16 + i * 8192, R, C); const int Rb = Epi::PERM ? ((R & ~31) + perm32(R & 31)) : R; voffA[i] = (unsigned)(R * K + C) * 2u; voffB[i] = (unsigned)(Rb * K + C) * 2u; }
  const size_t kstep = (size_t)(BK * 2);
  const size_t hstepB = (size_t)HALF * K * 2;
  const unsigned ldsw = (unsigned)wid * 1024u;
  const int aoff = lds_byte(wr * 64 + fr, fq * 8), boff = lds_byte(wc * 32 + fr, fq * 8);
#define G8_SA(b, h) (((b) * 2 + (h)) * HTB)
#define G8_SB(b, h) ((4 + (b) * 2 + (h)) * HTB)
#define G8_STAGEB(bufoff, gptr) do { _Pragma("unroll") for (int _i = 0; _i < 2; ++_i) \
    __builtin_amdgcn_global_load_lds((const unsigned*)((const char*)(gptr) + voffB[_i]), (LAS unsigned*)(lds + (bufoff) + ldsw + _i * 8192), 16, 0, 0); } while (0)
#define G8_STAGEA(bufoff, kb, NXT, h) do { _Pragma("unroll") for (int _i = 0; _i < 2; ++_i) { const char* _src; \
    if constexpr (GATHER) _src = Abase + (size_t)(kb) + (size_t)((NXT) ? o2[h][_i] : cuA[h][_i]); else _src = ((NXT) ? a2b : cA) + (size_t)(kb) + (size_t)(h) * hstepB + voffA[_i]; \
    __builtin_amdgcn_global_load_lds((const unsigned*)_src, (LAS unsigned*)(lds + (bufoff) + ldsw + _i * 8192), 16, 0, 0); } } while (0)
#define G8_LDA(dst, b, h) do { _Pragma("unroll") for (int m = 0; m < 4; ++m) _Pragma("unroll") for (int k = 0; k < 2; ++k) dst[m][k] = *(const LAS bf16x8*)(lds + G8_SA(b, h) + aoff + m * 2048 + k * 1024); } while (0)
#define G8_LDB(dst, b, h) do { _Pragma("unroll") for (int n = 0; n < 2; ++n) _Pragma("unroll") for (int k = 0; k < 2; ++k) dst[n][k] = *(const LAS bf16x8*)(lds + G8_SB(b, h) + boff + n * 2048 + k * 1024); } while (0)
#define G8_MMA(ai, bj, At, Bt) do { __builtin_amdgcn_s_setprio(1); _Pragma("unroll") for (int m = 0; m < 4; ++m) _Pragma("unroll") for (int n = 0; n < 2; ++n) _Pragma("unroll") for (int k = 0; k < 2; ++k) \
    acc[ai][bj][m][n] = __builtin_amdgcn_mfma_f32_16x16x32_bf16(Bt[n][k], At[m][k], acc[ai][bj][m][n], 0, 0, 0); __builtin_amdgcn_s_setprio(0); } while (0)
#define G8_WAIT_V(n) asm volatile("s_waitcnt vmcnt(" #n ")" ::: "memory")
#define G8_WAIT_L(n) asm volatile("s_waitcnt lgkmcnt(" #n ")" ::: "memory")
#define G8_BAR __builtin_amdgcn_s_barrier()
#define G8_SCHED __builtin_amdgcn_sched_barrier(0)
#define G8_GOFF(dst, u) do { _Pragma("unroll") for (int _i = 0; _i < 2; ++_i) { int _R, _C; stage_rc(tid * 16 + _i * 8192, _R, _C); \
    _Pragma("unroll") for (int _h = 0; _h < 2; ++_h) dst[_h][_i] = S.a_off(u, _R + 128 * _h) + (unsigned)_C * 2u; } } while (0)
  Unit cur, nxt; int ui = 0;
  if (!S.next(0, cur)) return;
  f32x4 acc[2][2][4][2];
#pragma unroll
  for (int a = 0; a < 2; ++a)
#pragma unroll
    for (int b = 0; b < 2; ++b)
#pragma unroll
      for (int m = 0; m < 4; ++m)
#pragma unroll
        for (int n = 0; n < 2; ++n) acc[a][b][m][n] = (f32x4){0.f, 0.f, 0.f, 0.f};
  bf16x8 At[4][2], B0[2][2], B1[2][2];
  unsigned cuA[2][2], nxA[2][2], o2[2][2];
  const char* cA = Abase; const char* nA = Abase; const char* a2b = Abase;
  if constexpr (GATHER) { G8_GOFF(cuA, cur); } else { cA = Abase + S.a_off(cur, 0); }
  const char* cB = S.b_base(cur);
  (void)voffA; (void)nxA; (void)o2; (void)nA; (void)a2b;
  G8_STAGEB(G8_SB(0, 0), cB); G8_STAGEB(G8_SB(0, 1), cB + hstepB); G8_STAGEA(G8_SA(0, 0), 0, false, 0); G8_STAGEA(G8_SA(0, 1), 0, false, 1);
  if (wr == 1) G8_BAR;
  G8_WAIT_V(2); G8_BAR;
  G8_STAGEB(G8_SB(1, 0), cB + kstep); G8_STAGEA(G8_SA(1, 0), kstep, false, 0); G8_STAGEB(G8_SB(1, 1), cB + hstepB + kstep);
  G8_WAIT_V(6); G8_BAR;
  for (;;) {
    const bool has_next = S.next(ui + 1, nxt);
    const char* nB = cB;
    if (has_next) {
      nB = S.b_base(nxt);
      if constexpr (GATHER) { G8_GOFF(nxA, nxt); } else { nA = Abase + S.a_off(nxt, 0); }
    } else {
      if constexpr (GATHER) {
#pragma unroll
        for (int h = 0; h < 2; ++h)
#pragma unroll
          for (int i = 0; i < 2; ++i) nxA[h][i] = cuA[h][i];
      } else nA = cA;
    }
    for (int t = 0; t < nt; t += 2) {
      const bool last = (t == nt - 2);
      const size_t k1 = (size_t)(t + 1) * kstep;
      const size_t k2 = last ? 0 : (size_t)(t + 2) * kstep, k3 = k2 + kstep;
      if constexpr (GATHER) {
#pragma unroll
        for (int h = 0; h < 2; ++h)
#pragma unroll
          for (int i = 0; i < 2; ++i) o2[h][i] = last ? nxA[h][i] : cuA[h][i];
      } else a2b = last ? nA : cA;
      const char* b2 = last ? nB : cB + (size_t)(t + 2) * kstep; const char* b3 = b2 + kstep;
      G8_LDB(B0, 0, 0); G8_LDB(B1, 0, 1); G8_SCHED; G8_LDA(At, 0, 0); G8_STAGEA(G8_SA(1, 1), k1, false, 1);
      G8_WAIT_V(8); G8_WAIT_L(0); G8_BAR; G8_MMA(0, 0, At, B0); G8_MMA(0, 1, At, B1); G8_BAR; G8_SCHED;
      G8_LDA(At, 0, 1); G8_STAGEB(G8_SB(0, 0), b2); G8_STAGEB(G8_SB(0, 1), b2 + hstepB); G8_STAGEA(G8_SA(0, 0), k2, true, 0);
      G8_WAIT_V(8); G8_WAIT_L(0); G8_BAR; G8_MMA(1, 0, At, B0); G8_MMA(1, 1, At, B1); G8_BAR; G8_SCHED;
      G8_LDB(B0, 1, 0); G8_LDB(B1, 1, 1); G8_SCHED; G8_LDA(At, 1, 0); G8_STAGEA(G8_SA(0, 1), k2, true, 1);
      G8_WAIT_V(8); G8_WAIT_L(0); G8_BAR; G8_MMA(0, 0, At, B0); G8_MMA(0, 1, At, B1); G8_BAR; G8_SCHED;
      G8_LDA(At, 1, 1); G8_STAGEB(G8_SB(1, 0), b3); G8_STAGEB(G8_SB(1, 1), b3 + hstepB); G8_STAGEA(G8_SA(1, 0), k3, true, 0);
      G8_WAIT_V(8); G8_WAIT_L(0); G8_BAR; G8_MMA(1, 0, At, B0); G8_MMA(1, 1, At, B1); G8_BAR; G8_SCHED;
    }
    if (wr == 0) G8_BAR;
    G8_SCHED; asm volatile("s_nop 15\n\ts_nop 7" ::: "memory"); G8_SCHED;
    E(acc, cur, wr, wc, fr, fq);
    if (!has_next) break;
#pragma unroll
    for (int a = 0; a < 2; ++a)
#pragma unroll
      for (int b = 0; b < 2; ++b)
#pragma unroll
        for (int m = 0; m < 4; ++m)
#pragma unroll
          for (int n = 0; n < 2; ++n) acc[a][b][m][n] = (f32x4){0.f, 0.f, 0.f, 0.f};
    cur = nxt; cB = nB; ++ui;
    if constexpr (GATHER) {
#pragma unroll
      for (int h = 0; h < 2; ++h)
#pragma unroll
        for (int i = 0; i < 2; ++i) cuA[h][i] = nxA[h][i];
    } else cA = nA;
    if (wr == 1) G8_BAR;
  }
  G8_WAIT_V(0);
  G8_BAR;
#undef G8_SA
#undef G8_SB
#undef G8_STAGEA
#undef G8_STAGEB
#undef G8_LDA
#undef G8_LDB
#undef G8_MMA
#undef G8_WAIT_V
#undef G8_WAIT_L
#undef G8_BAR
#undef G8_SCHED
#undef G8_GOFF
}

struct DenseOrder {
  static constexpr bool GATHER = false;
  int nM, nN, nwg, G, c, K; const char* Bt;
  DI void init(int M, int N, int K_, const void* Bt_, int G_, int c_) { nM = M / BM; nN = N / BM; nwg = nM * nN; G = G_; c = c_; K = K_; Bt = (const char*)Bt_; }
  DI bool next(int i, Unit& u) const {
    const long L = (long)i * G + c; if (L >= nwg) return false;
    int wgid = (int)L; { const int q = nwg / 8, r = nwg % 8, xcd = wgid % 8, off = wgid / 8; wgid = (xcd < r ? xcd * (q + 1) : r * (q + 1) + (xcd - r) * q) + off; }
    const int nig = 8 * nN, gid = wgid / nig, fm = gid * 8, gsz = (nM - fm) < 8 ? (nM - fm) : 8;
    u.pm = fm + ((wgid % nig) % gsz); u.pn = (wgid % nig) / gsz; u.e = 0; u.j = 0; return true;
  }
  DI unsigned a_off(const Unit& u, int R) const { return (unsigned)(u.pm * BM + R) * (unsigned)(K * 2); }
  DI const char* b_base(const Unit& u) const { return Bt + (size_t)u.pn * BM * K * 2; }
};
}
using g8::Unit;

struct EpiIn {
  static constexpr bool PERM = true;
  bf16_t* qkpre; bf16_t* vm; bf16_t* hcat; bf16_t* cq; bf16_t* ckv; unsigned char* krope  ; float* gates; float* ssq_q; float* ssq_kv; const float* rope; const float* gate_b;
  DI void operator()(const f32x4 (&acc)[2][2][4][2], const Unit& u, int wr, int wc, int fr, int fq) const {
#pragma unroll
    for (int bj = 0; bj < 2; ++bj) {
      const int cw = u.pn * 256 + bj * 128 + wc * 32, c0 = cw + 8 * fq;
#pragma unroll
      for (int ai = 0; ai < 2; ++ai)
#pragma unroll
        for (int m = 0; m < 4; ++m) {
          const int row = u.pm * 256 + ai * 128 + wr * 64 + m * 16 + fr;
          const f32x4 v0 = acc[ai][bj][m][0], v1 = acc[ai][bj][m][1];
          if (cw < 1024) { u32x4 w = {cvtpk(v0[0], v0[1]), cvtpk(v0[2], v0[3]), cvtpk(v1[0], v1[1]), cvtpk(v1[2], v1[3])}; *(u32x4*)(qkpre + (size_t)row * 1024 + c0) = w; }
          else if (cw < 1536) { u32x4 w = {cvtpk(v0[0], v0[1]), cvtpk(v0[2], v0[3]), cvtpk(v1[0], v1[1]), cvtpk(v1[2], v1[3])}; *(u32x4*)(vm + (size_t)row * 512 + (c0 - 1024)) = w; }
          else if (cw < 2048) { u32x4 w = {cvtpk(sigmoidf_(v0[0]), sigmoidf_(v0[1])), cvtpk(sigmoidf_(v0[2]), sigmoidf_(v0[3])), cvtpk(sigmoidf_(v1[0]), sigmoidf_(v1[1])), cvtpk(sigmoidf_(v1[2]), sigmoidf_(v1[3]))};
                                *(u32x4*)(hcat + (size_t)row * 1024 + (c0 - 1536)) = w; }
          else if (cw < 2688) {
            u32x4 w = {cvtpk(v0[0], v0[1]), cvtpk(v0[2], v0[3]), cvtpk(v1[0], v1[1]), cvtpk(v1[2], v1[3])};
            float s = v0[0] * v0[0] + v0[1] * v0[1] + v0[2] * v0[2] + v0[3] * v0[3] + v1[0] * v1[0] + v1[1] * v1[1] + v1[2] * v1[2] + v1[3] * v1[3];
            s += __shfl_xor(s, 16); s += __shfl_xor(s, 32);
            if (cw < 2432) { *(u32x4*)(cq + (size_t)row * 384 + (c0 - 2048)) = w; if (fq == 0) ssq_q[(size_t)row * 12 + ((cw - 2048) >> 5)] = s; }
            else { *(u32x4*)(ckv + (size_t)row * 256 + (c0 - 2432)) = w; if (fq == 0) ssq_kv[(size_t)row * 8 + ((cw - 2432) >> 5)] = s; }
          }
          else if (cw < 2752) {
            const int i0 = (c0 - 2688) >> 1;
            const f32x4 cs0 = *(const f32x4*)(rope + (size_t)row * 64 + 2 * i0), cs1 = *(const f32x4*)(rope + (size_t)row * 64 + 2 * i0 + 4);
            const float a0 = v0[0] * cs0[0] - v0[1] * cs0[1], b0 = v0[1] * cs0[0] + v0[0] * cs0[1];
            const float a1 = v0[2] * cs0[2] - v0[3] * cs0[3], b1 = v0[3] * cs0[2] + v0[2] * cs0[3];
            const float a2 = v1[0] * cs1[0] - v1[1] * cs1[1], b2 = v1[1] * cs1[0] + v1[0] * cs1[1];
            const float a3 = v1[2] * cs1[2] - v1[3] * cs1[3], b3 = v1[3] * cs1[2] + v1[2] * cs1[3];
            const u32x2 w = cvt8((f32x4){a0, b0, a1, b1}, (f32x4){a2, b2, a3, b3});
            const int b_ = row >> 14, s_ = row & (SEQ - 1);
#pragma unroll
            for (int hh = 0; hh < 4; ++hh) *(u32x2*)(krope + ((size_t)(b_ * 4 + hh) * SEQ + s_) * 192 + 128 + (c0 - 2688)) = w;
          }
          else if (cw == 2752) {
            if (fq < 2) { const f32x4 g0 = *(const f32x4*)(gate_b + 8 * fq), g1 = *(const f32x4*)(gate_b + 8 * fq + 4);
              *(f32x4*)(gates + (size_t)row * 16 + 8 * fq) = v0 + g0; *(f32x4*)(gates + (size_t)row * 16 + 8 * fq + 4) = v1 + g1; }
          }
        }
    }
  }
};
struct EpiUQ {
  static constexpr bool PERM = true;
  unsigned char* qatt; const float* ssq_q; const float* rope;
  DI void operator()(const f32x4 (&acc)[2][2][4][2], const Unit& u, int wr, int wc, int fr, int fq) const {
    float rs[2][4];
#pragma unroll
    for (int ai = 0; ai < 2; ++ai)
#pragma unroll
      for (int m = 0; m < 4; ++m) {
        const int row = u.pm * 256 + ai * 128 + wr * 64 + m * 16 + fr;
        const f32x4 q0 = *(const f32x4*)(ssq_q + (size_t)row * 12), q1 = *(const f32x4*)(ssq_q + (size_t)row * 12 + 4), q2 = *(const f32x4*)(ssq_q + (size_t)row * 12 + 8);
        const float ss = (q0[0] + q0[1] + q0[2] + q0[3]) + (q1[0] + q1[1] + q1[2] + q1[3]) + (q2[0] + q2[1] + q2[2] + q2[3]);
        rs[ai][m] = rsqrtf(ss * (1.f / 384.f) + RMS_EPS) * QSCALE;
        asm volatile("" ::: "memory");
      }
#pragma unroll
    for (int bj = 0; bj < 2; ++bj) {
      const int cw = u.pn * 256 + bj * 128 + wc * 32, h = cw / 192, dw = cw - h * 192, d = dw + 8 * fq;
#pragma unroll
      for (int ai = 0; ai < 2; ++ai)
#pragma unroll
        for (int m = 0; m < 4; ++m) {
          const int row = u.pm * 256 + ai * 128 + wr * 64 + m * 16 + fr, b = row >> 14, s = row & (SEQ - 1);
          const f32x4 v0 = acc[ai][bj][m][0] * rs[ai][m], v1 = acc[ai][bj][m][1] * rs[ai][m];
          u32x2 w;
          if (dw < 128) { w = cvt8(v0, v1); }
          else {
            const int i0 = (d - 128) >> 1;
            const f32x4 cs0 = *(const f32x4*)(rope + (size_t)row * 64 + 2 * i0), cs1 = *(const f32x4*)(rope + (size_t)row * 64 + 2 * i0 + 4);
            const float a0 = v0[0] * cs0[0] - v0[1] * cs0[1], b0 = v0[1] * cs0[0] + v0[0] * cs0[1];
            const float a1 = v0[2] * cs0[2] - v0[3] * cs0[3], b1 = v0[3] * cs0[2] + v0[2] * cs0[3];
            const float a2 = v1[0] * cs1[0] - v1[1] * cs1[1], b2 = v1[1] * cs1[0] + v1[0] * cs1[1];
            const float a3 = v1[2] * cs1[2] - v1[3] * cs1[3], b3 = v1[3] * cs1[2] + v1[2] * cs1[3];
            w = cvt8((f32x4){a0, b0, a1, b1}, (f32x4){a2, b2, a3, b3});
          }
          *(u32x2*)(qatt + ((size_t)(b * 4 + h) * SEQ + s) * 192 + d) = w;
          asm volatile("" ::: "memory");
        }
    }
  }
};
struct EpiUKV {
  static constexpr bool PERM = true;
  unsigned char* kn; unsigned char* vt8; const float* ssq_kv;
  DI void operator()(const f32x4 (&acc)[2][2][4][2], const Unit& u, int wr, int wc, int fr, int fq) const {
#pragma unroll
    for (int ai = 0; ai < 2; ++ai)
#pragma unroll
      for (int m = 0; m < 4; ++m) {
        const int row = u.pm * 256 + ai * 128 + wr * 64 + m * 16 + fr, b = row >> 14, s = row & (SEQ - 1);
        const f32x4 q0 = *(const f32x4*)(ssq_kv + (size_t)row * 8), q1 = *(const f32x4*)(ssq_kv + (size_t)row * 8 + 4);
        const float ss = (q0[0] + q0[1] + q0[2] + q0[3]) + (q1[0] + q1[1] + q1[2] + q1[3]);
        const float rs = rsqrtf(ss * (1.f / 256.f) + RMS_EPS);
        { const f32x4 v0 = acc[ai][0][m][0] * rs, v1 = acc[ai][0][m][1] * rs;
          *(u32x2*)(kn + ((size_t)(b * 4 + u.pn) * SEQ + s) * 192 + wc * 32 + 8 * fq) = cvt8(v0, v1); }
        { const f32x4 v0 = acc[ai][1][m][0] * rs, v1 = acc[ai][1][m][1] * rs;
          const u32x2 w = cvt8(v0, v1);
          const int k = s & 63, kq = k & 31, pos = 32 * ((kq >> 2) & 1) + (kq & 3) + 4 * (kq >> 3) + 16 * (k >> 5);
          unsigned char* dst = vt8 + ((size_t)((b * 4 + u.pn) * 256 + (s >> 6)) * 128 + wc * 32 + 8 * fq) * 64 + pos;
          dst[0] = (unsigned char)w[0]; dst[64] = (unsigned char)(w[0] >> 8); dst[128] = (unsigned char)(w[0] >> 16); dst[192] = (unsigned char)(w[0] >> 24);
          dst[256] = (unsigned char)w[1]; dst[320] = (unsigned char)(w[1] >> 8); dst[384] = (unsigned char)(w[1] >> 16); dst[448] = (unsigned char)(w[1] >> 24); }
        asm volatile("" ::: "memory");
      }
  }
};
struct EpiOut {
  static constexpr bool PERM = true;
  const float* x; const float* mod; bf16_t* z;
  DI void operator()(const f32x4 (&acc)[2][2][4][2], const Unit& u, int wr, int wc, int fr, int fq) const {
#pragma unroll
    for (int ai = 0; ai < 2; ++ai)
#pragma unroll
      for (int m = 0; m < 4; ++m) {
        const int row = u.pm * 256 + ai * 128 + wr * 64 + m * 16 + fr, b = row >> 14;
#pragma unroll
        for (int bj = 0; bj < 2; ++bj) {
          const int c = u.pn * 256 + bj * 128 + wc * 32 + 8 * fq;
          const unsigned off = (unsigned)row * 1024u + (unsigned)c;
          const f32x4 x0 = *(const f32x4*)(x + off), x1 = *(const f32x4*)(x + off + 4), g0 = *(const f32x4*)(mod + b * 6144 + 2048 + c), g1 = *(const f32x4*)(mod + b * 6144 + 2048 + c + 4);
          const f32x4 z0 = x0 * ALPHA + (g0 + 1.f) * acc[ai][bj][m][0], z1 = x1 * ALPHA + (g1 + 1.f) * acc[ai][bj][m][1];
          *(u32x4*)(z + off) = (u32x4){cvtpk(z0[0], z0[1]), cvtpk(z0[2], z0[3]), cvtpk(z1[0], z1[1]), cvtpk(z1[2], z1[3])};
        }
        asm volatile("" ::: "memory");
      }
  }
};
struct EpiGU {
  static constexpr bool PERM = true;
  bf16_t* hdn;
  DI void operator()(const f32x4 (&acc)[2][2][4][2], const Unit& u, int wr, int wc, int fr, int fq) const {
    const unsigned base = ((unsigned)u.pm * 256u + wr * 64 + fr) * 1024u + (unsigned)(u.pn * 256 + wc * 32 + 8 * fq);
#pragma unroll
    for (int ai = 0; ai < 2; ++ai)
#pragma unroll
      for (int m = 0; m < 4; ++m) {
#pragma unroll
        for (int bj = 0; bj < 2; ++bj) {
          const f32x4 g = acc[ai][bj][m][0], up = acc[ai][bj][m][1];
          const u32x2 w = {cvtpk(siluf_(g[0]) * up[0], siluf_(g[1]) * up[1]), cvtpk(siluf_(g[2]) * up[2], siluf_(g[3]) * up[3])};
          *(u32x2*)((char*)hdn + (base + (unsigned)((ai * 128 + m * 16) * 1024 + bj * 128))) = w;
        }
      }
  }
};
struct EpiDN {
  static constexpr bool PERM = true;
  bf16_t* ybuf; const float* lw;
  DI void operator()(const f32x4 (&acc)[2][2][4][2], const Unit& u, int wr, int wc, int fr, int fq) const {
    const unsigned base = ((unsigned)u.pm * 256u + wr * 64 + fr) * 2048u + (unsigned)(u.pn * 256 + wc * 32 + 8 * fq) * 2u;
    const unsigned wbase = ((unsigned)u.e * (unsigned)T + (unsigned)(u.j * 256 + wr * 64 + fr)) * 4u;
#pragma unroll
    for (int ai = 0; ai < 2; ++ai)
#pragma unroll
      for (int m = 0; m < 4; ++m) {
        const float wgt = *(const float*)((const char*)lw + (wbase + (unsigned)((ai * 128 + m * 16) * 4)));
#pragma unroll
        for (int bj = 0; bj < 2; ++bj) {
          const f32x4 v0 = acc[ai][bj][m][0] * wgt, v1 = acc[ai][bj][m][1] * wgt;
          const u32x4 w = {cvtpk(v0[0], v0[1]), cvtpk(v0[2], v0[3]), cvtpk(v1[0], v1[1]), cvtpk(v1[2], v1[3])};
          *(u32x4*)((char*)ybuf + (base + (unsigned)((ai * 128 + m * 16) * 2048 + bj * 256))) = w;
        }
        asm volatile("" ::: "memory");
      }
  }
};
struct MoeOrderBase {
  const LAS int* tstart; const int* cnt; int G, c;
  DI bool next(int i, Unit& u) const {
    const int L = i * G + c, NT = tstart[32]; if (L >= NT * 4) return false;
    const int tile = L >> 2; int e = 0;
    for (int k = 1; k < 32; ++k) e = (tstart[k] <= tile) ? k : e;
    u.pm = tile; u.pn = L & 3; u.e = e; u.j = tile - tstart[e]; return true;
  }
};
struct MoeOrderGU : MoeOrderBase {
  static constexpr bool GATHER = true;
  const int* ltok; const char* Bt;
  DI unsigned a_off(const Unit& u, int R) const { const int n = cnt[u.e * CNT_STRIDE]; int idx = u.j * 256 + R; idx = idx < n ? idx : n - 1; return (unsigned)ltok[(size_t)u.e * T + idx] * 2048u; }
  DI const char* b_base(const Unit& u) const { return Bt + ((size_t)u.e * 1024 + u.pn * 256) * 2048; }
};
struct MoeOrderDN : MoeOrderBase {
  static constexpr bool GATHER = false;
  const char* Bt;
  DI unsigned a_off(const Unit& u, int R) const { return (unsigned)(u.pm * 256 + R) * 1024u; }
  DI const char* b_base(const Unit& u) const { return Bt + ((size_t)u.e * 1024 + u.pn * 256) * 1024; }
};

struct TDesc { const float* src; const float* kscale; bf16_t* dst; int ld, K, k0, n0, ok; };
DI TDesc tdesc(int r, int lane, unsigned char* ws) {
  constexpr int I_IN = 16 * 88, I_UQ = 6 * 24, I_UKV = 4 * 32, I_OUT = 16 * 32, I_GU = 32 * 16 * 32;
  TDesc d; d.kscale = nullptr; int sc, kb, nb; const float* W;
  if (r < I_IN) { kb = r / 88; nb = r % 88; const int n = nb * 32 + (lane & 31);
    sc = n < 2048 ? n : n < 2432 ? 2064 + (n - 2048) : n < 2688 ? 2448 + (n - 2432) : n < 2752 ? 2704 + ((n - 2688) & 1) * 32 + ((n - 2688) >> 1) : n < 2768 ? 2048 + (n - 2752) : -1;
    W = karg<A_WIN>(); d.ld = N_IN; d.K = 1024; d.dst = (bf16_t*)(ws + WS_WIN); }
  else if ((r -= I_IN) < I_UQ) { kb = r / 24; nb = r % 24; const int n = nb * 32 + (lane & 31), h = n / 192, dd = n - h * 192;
    sc = dd < 128 ? n : h * 192 + 128 + ((dd - 128) & 1) * 32 + ((dd - 128) >> 1);
    W = karg<A_WUQ>(); d.ld = 768; d.K = 384; d.dst = (bf16_t*)(ws + WS_WUQ); d.kscale = karg<A_QNG>(); }
  else if ((r -= I_UQ) < I_UKV) { kb = r / 32; nb = r % 32; sc = nb * 32 + (lane & 31); W = karg<A_WUKV>(); d.ld = 1024; d.K = 256; d.dst = (bf16_t*)(ws + WS_WUKV); d.kscale = karg<A_KVNG>(); }
  else if ((r -= I_UKV) < I_OUT) { kb = r / 32; nb = r % 32; sc = nb * 32 + (lane & 31); W = karg<A_WOUT>(); d.ld = 1024; d.K = 1024; d.dst = (bf16_t*)(ws + WS_WOUT); }
  else if ((r -= I_OUT) < I_GU) { const int e = r / 512, q = r % 512; kb = q / 32; nb = q % 32;
    const int lr = nb * 32 + (lane & 31), up = (lr >> 2) & 1; sc = (lr >> 3) * 4 + (lr & 3);
    W = (up ? karg<A_WUP>() : karg<A_WGATE>()) + (size_t)e * 1024 * 512; d.ld = 512; d.K = 1024; d.dst = (bf16_t*)(ws + WS_WGU) + (size_t)e * 1024 * 1024; }
  else { r -= I_GU; const int e = r / 256, q = r % 256; kb = q / 32; nb = q % 32; sc = nb * 32 + (lane & 31);
    W = karg<A_WDOWN>() + (size_t)e * 512 * 1024; d.ld = 1024; d.K = 512; d.dst = (bf16_t*)(ws + WS_WDN) + (size_t)e * 1024 * 512; }
  d.k0 = 64 * kb; d.n0 = 32 * nb; d.ok = sc >= 0;
  d.src = W + (size_t)(d.k0 + (lane >> 5)) * d.ld + (sc >= 0 ? sc : 0);
  return d;
}
DI void tload(const TDesc& d, float (&v)[32]) {
#pragma unroll
  for (int i = 0; i < 32; ++i) v[i] = d.src[(size_t)(2 * i) * d.ld];
}
DI void tstore(const TDesc& d, float (&v)[32], LAS float* scr, int lane) {
  if (d.kscale) {
#pragma unroll
    for (int i = 0; i < 32; ++i) v[i] *= d.kscale[d.k0 + 2 * i + (lane >> 5)];
  }
#pragma unroll
  for (int i = 0; i < 32; ++i) scr[(2 * i + (lane >> 5)) * 33 + (lane & 31)] = d.ok ? v[i] : 0.f;
  asm volatile("s_waitcnt lgkmcnt(0)" ::: "memory");
  const int c = lane & 7;
#pragma unroll
  for (int j = 0; j < 4; ++j) { const int n = (lane >> 3) + 8 * j; const LAS float* s = scr + (8 * c) * 33 + n;
    u32x4 o; o.x = cvtpk(s[0 * 33], s[1 * 33]); o.y = cvtpk(s[2 * 33], s[3 * 33]); o.z = cvtpk(s[4 * 33], s[5 * 33]); o.w = cvtpk(s[6 * 33], s[7 * 33]);
    *(u32x4*)(d.dst + (size_t)(d.n0 + n) * d.K + d.k0 + 8 * c) = o; }
  asm volatile("s_waitcnt lgkmcnt(0)" ::: "memory");
}
constexpr int PREP_ITEMS = 16 * 88 + 6 * 24 + 4 * 32 + 16 * 32 + 32 * 16 * 32 + 32 * 8 * 32;
constexpr int PREP_DEFER = 8192;
DI void prep_items(int it, const int end, const int stride, const int lane, unsigned char* ws, LAS float* scr) {
  TDesc dA, dB; float vA[32], vB[32];
  if (it < end) { dA = tdesc(it, lane, ws); tload(dA, vA); }
  while (it < end) {
    if (it + stride < end) { dB = tdesc(it + stride, lane, ws); tload(dB, vB); }
    tstore(dA, vA, scr, lane);
    it += stride; if (it >= end) break;
    if (it + stride < end) { dA = tdesc(it + stride, lane, ws); tload(dA, vA); }
    tstore(dB, vB, scr, lane);
    it += stride;
  }
}
DI void phase_prep(const Ctx& p, int bid, int G, LAS unsigned char* lds) {
  const int tid = tid_fresh(), lane = tid & 63, wave = __builtin_amdgcn_readfirstlane(tid >> 6);
  unsigned char* ws = p.ws;
  LAS float* scr = (LAS float*)(lds + wave * 16384);
  LAS float* cact = (LAS float*)(lds + 131072);
  for (int i = tid; i < 2048; i += NTHREADS) cact[i] = siluf_(karg<A_C>()[i]);
  __syncthreads();
  const int gw = bid * 8 + wave, NGW = G * 8;
  constexpr int I_MOD = 192;
  if (bid < I_MOD) {
    const int kg = lane >> 3, cc = lane & 7, col = bid * 32 + 4 * cc; const float* w_ada = karg<A_WADA>() + col;
    f32x4 a0 = {0.f, 0.f, 0.f, 0.f}, a1 = {0.f, 0.f, 0.f, 0.f};
#pragma unroll
    for (int j = 0; j < 16; ++j) { const int k = wave * 128 + kg + 8 * j; const f32x4 w = *(const f32x4*)(w_ada + (size_t)k * 6144); a0 += w * cact[k]; a1 += w * cact[1024 + k]; }
#pragma unroll
    for (int e = 0; e < 4; ++e) {
#pragma unroll
      for (int o = 8; o < 64; o <<= 1) { a0[e] += __shfl_xor(a0[e], o); a1[e] += __shfl_xor(a1[e], o); } }
    LAS f32x4* part = (LAS f32x4*)(lds + 131072 + 8192);
    if (kg == 0) { part[(wave * 8 + cc) * 2] = a0; part[(wave * 8 + cc) * 2 + 1] = a1; }
    __syncthreads();
    if (wave == 0 && kg == 0) { float* mod = (float*)(ws + WS_MOD); const f32x4 bb = *(const f32x4*)(karg<A_BADA>() + col);
      f32x4 s0 = part[cc * 2], s1 = part[cc * 2 + 1];
#pragma unroll
      for (int w = 1; w < 8; ++w) { s0 += part[(w * 8 + cc) * 2]; s1 += part[(w * 8 + cc) * 2 + 1]; }
      *(f32x4*)(mod + col) = s0 + bb; *(f32x4*)(mod + 6144 + col) = s1 + bb; }
  }
#ifndef DBL_PREP
#define DBL_PREP 0
#endif
  for (int rp_ = 0; rp_ < (DBL_PREP == 1 ? 2 : 1); ++rp_) prep_items(gw, PREP_ITEMS - PREP_DEFER, NGW, lane, ws, scr);
  {
    const float INV[32] = {1.000000000e+00f, 7.498942018e-01f, 5.623413324e-01f, 4.216965139e-01f, 3.162277639e-01f, 2.371373773e-01f, 1.778279394e-01f, 1.333521456e-01f,
                           1.000000015e-01f, 7.498942316e-02f, 5.623413250e-02f, 4.216964915e-02f, 3.162277490e-02f, 2.371373773e-02f, 1.778279431e-02f, 1.333521400e-02f,
                           9.999999776e-03f, 7.498942316e-03f, 5.623413250e-03f, 4.216964822e-03f, 3.162277630e-03f, 2.371373819e-03f, 1.778279431e-03f, 1.333521446e-03f,
                           1.000000047e-03f, 7.498941850e-04f, 5.623413017e-04f, 4.216965172e-04f, 3.162277571e-04f, 2.371373703e-04f, 1.778279402e-04f, 1.333521504e-04f};
    f32x2* rope = (f32x2*)(ws + WS_ROPE); const int* pos = karg<A_POS, const int>();
    for (int rp_ = 0; rp_ < (DBL_PREP == 2 ? 2 : 1); ++rp_)
    for (int i = bid * NTHREADS + tid; i < T * 32; i += G * NTHREADS) {
      const int t = i >> 5, fi = i & 31;
      const float ang = (float)pos[t] * INV[fi];
      float sn, cs; sincosf(ang, &sn, &cs); rope[i] = (f32x2){cs, sn};
    }
  }
  if (bid == 0) for (int i = tid; i < 64 * CNT_STRIDE; i += NTHREADS) ((int*)(ws + WS_CNT))[i] = 0;
  { const float* w_re = karg<A_WRE>(); const float* w_rg = karg<A_WRG>(); float* wrt = (float*)(ws + WS_WRT);
    for (int i = bid * NTHREADS + tid; i < 36 * 1024; i += G * NTHREADS) { const int e = i >> 10, k = i & 1023; wrt[i] = e < 32 ? w_re[k * 32 + e] : w_rg[k * 4 + (e - 32)]; } }
}

DI void phase_lnmod(const Ctx& p, int bid, int G) {
  const int tid = tid_fresh(), lane = tid & 63, wave = tid >> 6;
  const float* mod = (const float*)(p.ws + WS_MOD); bf16_t* U = (bf16_t*)(p.ws + WS_U); const float* xin = karg<A_X>();
  f32x4 vn[4];
  { const int row = bid * 8 + wave; if (row < T) { const f32x4* xr = (const f32x4*)(xin + (size_t)row * 1024) + lane;
#pragma unroll
      for (int j = 0; j < 4; ++j) vn[j] = xr[64 * j]; } }
  for (int row = bid * 8 + wave; row < T; row += G * 8) {
    const int b = row >> 14;
    f32x4 v[4]; float s = 0.f;
#pragma unroll
    for (int j = 0; j < 4; ++j) { v[j] = vn[j]; s += (v[j][0] + v[j][1]) + (v[j][2] + v[j][3]); }
    if (row + G * 8 < T) { const f32x4* xr = (const f32x4*)(xin + (size_t)(row + G * 8) * 1024) + lane;
#pragma unroll
      for (int j = 0; j < 4; ++j) vn[j] = xr[64 * j]; }
    const float mean = wave_sum(s) * (1.f / 1024.f); float s2 = 0.f;
#pragma unroll
    for (int j = 0; j < 4; ++j) { v[j] = v[j] - mean; s2 += (v[j][0] * v[j][0] + v[j][1] * v[j][1]) + (v[j][2] * v[j][2] + v[j][3] * v[j][3]); }
    const float rstd = rsqrtf(wave_sum(s2) * (1.f / 1024.f) + LN_EPS);
    u32x2* o8 = (u32x2*)(U + (size_t)row * 1024) + lane;
#pragma unroll
    for (int j = 0; j < 4; ++j) {
      const int col = 4 * lane + 256 * j;
      const f32x4 sh = *(const f32x4*)(mod + b * 6144 + col), sc = *(const f32x4*)(mod + b * 6144 + 1024 + col);
      const f32x4 y = v[j] * rstd * (sc + 1.f) + sh;
      o8[64 * j] = (u32x2){cvtpk(y[0], y[1]), cvtpk(y[2], y[3])};
    }
  }
}

constexpr int PA_V = 0, PA_KF = 32768, PA_KB = 65536, PA_RAWK = 100352, PA_VEC = 135168;
DI void mlstmA_unit(const Ctx& p, int b, int h, int c, LAS unsigned char* lds) {
  const int tid = tid_fresh(), lane = tid & 63, wid = __builtin_amdgcn_readfirstlane(tid >> 6), r32 = lane & 31, hi = lane >> 5;
  unsigned char* ws = p.ws;
  const bf16_t* qkpre = (const bf16_t*)(ws + WS_QKPRE); const bf16_t* vmp = (const bf16_t*)(ws + WS_VM); bf16_t* qkpost = (bf16_t*)(ws + WS_U);
  const float* gates = (const float*)(ws + WS_GATES); float* gvec = (float*)(ws + WS_GVEC); float* nvec = (float*)(ws + WS_NVEC); float* scal = (float*)(ws + WS_SCAL);
  bf16_t* Cbuf = (bf16_t*)p.out;
  LAS float* vec = (LAS float*)(lds + PA_VEC);
  const int bh = b * 4 + h, row0 = b * SEQ + c * 128;
  const int r0 = tid >> 4, c8 = (tid & 15) * 8;
  u32x4 rk[5], rq[5], rv[4];
#pragma unroll
  for (int j = 0; j < 5; ++j) {
    const int rr = r0 + 32 * j, sj = c * 128 + rr - 2; const bool ok = rr < 132 && sj >= 0 && sj < SEQ;
    const bf16_t* src = qkpre + (size_t)(b * SEQ + (ok ? sj : 0)) * 1024 + h * 128 + c8;
    rk[j] = ok ? *(const u32x4*)(src + 512) : (u32x4){0u, 0u, 0u, 0u}; rq[j] = ok ? *(const u32x4*)src : (u32x4){0u, 0u, 0u, 0u};
  }
#pragma unroll
  for (int j = 0; j < 4; ++j) rv[j] = *(const u32x4*)(vmp + (size_t)(row0 + r0 + 32 * j) * 512 + h * 128 + c8);
  float gb = 0.f, gcol = 0.f, gcm = 0.f;
  if (tid < 256) {
    const int dir = tid >> 7, t = tid & 127, wv = (tid >> 6) & 1;
    const float ig = gates[(size_t)(row0 + t) * 16 + (dir * 2) * 4 + h], fg = gates[(size_t)(row0 + t) * 16 + (dir * 2 + 1) * 4 + h];
    float x = logsigmoidf_(fg);
    if (dir == 0) {
#pragma unroll
      for (int o = 1; o < 64; o <<= 1) { const float y = __shfl_up(x, o); if (lane >= o) x += y; }
      if (lane == 63) vec[256 + wv] = x;
    } else {
#pragma unroll
      for (int o = 1; o < 64; o <<= 1) { const float y = __shfl_down(x, o); if (lane + o < 64) x += y; }
      if (lane == 0) vec[258 + wv] = x;
    }
    gb = x; gcol = ig;
  }
  __syncthreads();
  if (tid < 256) {
    const int dir = tid >> 7, wv = (tid >> 6) & 1;
    if (dir == 0) { if (wv == 1) gb += vec[256]; } else { if (wv == 0) gb += vec[259]; }
    gcol = gcol - gb;
    float x = gcol;
    if (dir == 0) {
#pragma unroll
      for (int o = 1; o < 64; o <<= 1) { const float y = __shfl_up(x, o); if (lane >= o) x = fmaxf(x, y); }
      if (lane == 63) vec[260 + wv] = x;
    } else {
#pragma unroll
      for (int o = 1; o < 64; o <<= 1) { const float y = __shfl_down(x, o); if (lane + o < 64) x = fmaxf(x, y); }
      if (lane == 0) vec[262 + wv] = x;
    }
    gcm = x;
  }
  __syncthreads();
  if (tid < 256) {
    const int dir = tid >> 7, t = tid & 127, wv = (tid >> 6) & 1;
    if (dir == 0) { if (wv == 1) gcm = fmaxf(gcm, vec[260]); } else { if (wv == 0) gcm = fmaxf(gcm, vec[263]); }
    const float mx = fmaxf(vec[260 + 2 * dir], vec[261 + 2 * dir]);
    const float tot = vec[256 + 2 * dir] + vec[257 + 2 * dir];
    float* gv = gvec + ((size_t)(dir * 8 + bh) * SEQ + c * 128 + t) * 3;
    gv[0] = gb; gv[1] = gcol; gv[2] = gcm;
    vec[dir * 128 + t] = __expf(gcol - mx);
    if (t == 0) { scal[(dir * 8 + bh) * 128 + c] = tot; scal[2048 + (dir * 8 + bh) * 128 + c] = tot + mx; }
  }
  __syncthreads();
#pragma unroll
  for (int j = 0; j < 5; ++j) { const int rr = r0 + 32 * j;
    if (rr < 132) { *(LAS u32x4*)(lds + PA_RAWK + rr * 256 + c8 * 2) = rk[j]; *(LAS u32x4*)(lds + PA_KB + rr * 256 + c8 * 2) = rq[j]; } }
#pragma unroll
  for (int j = 0; j < 4; ++j) { const int r = r0 + 32 * j; *(LAS u32x4*)(lds + PA_V + (r >> 6) * 16384 + v_st(r & 63, c8)) = rv[j]; }
  __syncthreads();
  const float* conv_w = karg<A_CONVW>(); const float* conv_b = karg<A_CONVB>();
  {
    const int ch = h * 128 + c8;
    float w[5][8], bias[8];
#pragma unroll
    for (int j = 0; j < 5; ++j) { const f32x4 a = *(const f32x4*)(conv_w + j * 1024 + ch), bq = *(const f32x4*)(conv_w + j * 1024 + ch + 4);
      w[j][0] = a[0]; w[j][1] = a[1]; w[j][2] = a[2]; w[j][3] = a[3]; w[j][4] = bq[0]; w[j][5] = bq[1]; w[j][6] = bq[2]; w[j][7] = bq[3]; }
    { const f32x4 a = *(const f32x4*)(conv_b + ch), bq = *(const f32x4*)(conv_b + ch + 4); bias[0] = a[0]; bias[1] = a[1]; bias[2] = a[2]; bias[3] = a[3]; bias[4] = bq[0]; bias[5] = bq[1]; bias[6] = bq[2]; bias[7] = bq[3]; }
#pragma unroll
    for (int ps = 0; ps < 4; ++ps) {
      const int r = r0 + 32 * ps;
      float a[8];
#pragma unroll
      for (int e = 0; e < 8; ++e) a[e] = bias[e];
#pragma unroll
      for (int j = 0; j < 5; ++j) { const u32x4 xv = *(const LAS u32x4*)(lds + PA_KB + (r + j) * 256 + c8 * 2);
        a[0] += w[j][0] * bflo(xv[0]); a[1] += w[j][1] * bfhi(xv[0]); a[2] += w[j][2] * bflo(xv[1]); a[3] += w[j][3] * bfhi(xv[1]);
        a[4] += w[j][4] * bflo(xv[2]); a[5] += w[j][5] * bfhi(xv[2]); a[6] += w[j][6] * bflo(xv[3]); a[7] += w[j][7] * bfhi(xv[3]); }
      const float qs = 0.08838834764831845f;
#pragma unroll
      for (int e = 0; e < 8; ++e) a[e] = siluf_(a[e]) * qs;
      *(u32x4*)(qkpost + (size_t)(row0 + r) * 1024 + ch) = (u32x4){cvtpk(a[0], a[1]), cvtpk(a[2], a[3]), cvtpk(a[4], a[5]), cvtpk(a[6], a[7])};
    }
  }
  __syncthreads();
  {
    const int ch = 512 + h * 128 + c8;
    float w[5][8], bias[8];
#pragma unroll
    for (int j = 0; j < 5; ++j) { const f32x4 a = *(const f32x4*)(conv_w + j * 1024 + ch), bq = *(const f32x4*)(conv_w + j * 1024 + ch + 4);
      w[j][0] = a[0]; w[j][1] = a[1]; w[j][2] = a[2]; w[j][3] = a[3]; w[j][4] = bq[0]; w[j][5] = bq[1]; w[j][6] = bq[2]; w[j][7] = bq[3]; }
    { const f32x4 a = *(const f32x4*)(conv_b + ch), bq = *(const f32x4*)(conv_b + ch + 4); bias[0] = a[0]; bias[1] = a[1]; bias[2] = a[2]; bias[3] = a[3]; bias[4] = bq[0]; bias[5] = bq[1]; bias[6] = bq[2]; bias[7] = bq[3]; }
#pragma unroll
    for (int ps = 0; ps < 4; ++ps) {
      const int r = r0 + 32 * ps;
      float a[8];
#pragma unroll
      for (int e = 0; e < 8; ++e) a[e] = bias[e];
#pragma unroll
      for (int j = 0; j < 5; ++j) { const u32x4 xv = *(const LAS u32x4*)(lds + PA_RAWK + (r + j) * 256 + c8 * 2);
        a[0] += w[j][0] * bflo(xv[0]); a[1] += w[j][1] * bfhi(xv[0]); a[2] += w[j][2] * bflo(xv[1]); a[3] += w[j][3] * bfhi(xv[1]);
        a[4] += w[j][4] * bflo(xv[2]); a[5] += w[j][5] * bfhi(xv[2]); a[6] += w[j][6] * bflo(xv[3]); a[7] += w[j][7] * bfhi(xv[3]); }
#pragma unroll
      for (int e = 0; e < 8; ++e) a[e] = siluf_(a[e]);
      *(u32x4*)(qkpost + (size_t)(row0 + r) * 1024 + ch) = (u32x4){cvtpk(a[0], a[1]), cvtpk(a[2], a[3]), cvtpk(a[4], a[5]), cvtpk(a[6], a[7])};
      const float wf = vec[r], wb = vec[128 + r];
      const u32x4 kf = {cvtpk(a[0] * wf, a[1] * wf), cvtpk(a[2] * wf, a[3] * wf), cvtpk(a[4] * wf, a[5] * wf), cvtpk(a[6] * wf, a[7] * wf)};
      const u32x4 kb = {cvtpk(a[0] * wb, a[1] * wb), cvtpk(a[2] * wb, a[3] * wb), cvtpk(a[4] * wb, a[5] * wb), cvtpk(a[6] * wb, a[7] * wb)};
      const int io = (r >> 6) * 16384 + v_st(r & 63, c8);
      *(LAS u32x4*)(lds + PA_KF + io) = kf; *(LAS u32x4*)(lds + PA_KB + io) = kb;
    }
  }
  __syncthreads();
  {
    const int dir = wid >> 2, dkb = wid & 3;
    const int ka = (int)(uintptr_t)(lds + (dir ? PA_KB : PA_KF)) + v_rd_base(lane) + dkb * 512;
    const int va = (int)(uintptr_t)(lds + PA_V) + v_rd_base(lane);
    f32x16 o[4] = {};
#define PA_STEP(TILE, KS) do { s16x4 al, ah, l0, h0, l1, h1, l2, h2, l3, h3;                                                   \
      al = tr_read<v_rd_off(0, KS, 0)>(ka + TILE * 16384); ah = tr_read<v_rd_off(0, KS, 1)>(ka + TILE * 16384);                 \
      l0 = tr_read<v_rd_off(0, KS, 0)>(va + TILE * 16384); h0 = tr_read<v_rd_off(0, KS, 1)>(va + TILE * 16384);                 \
      l1 = tr_read<v_rd_off(1, KS, 0)>(va + TILE * 16384); h1 = tr_read<v_rd_off(1, KS, 1)>(va + TILE * 16384);                 \
      l2 = tr_read<v_rd_off(2, KS, 0)>(va + TILE * 16384); h2 = tr_read<v_rd_off(2, KS, 1)>(va + TILE * 16384);                 \
      l3 = tr_read<v_rd_off(3, KS, 0)>(va + TILE * 16384); h3 = tr_read<v_rd_off(3, KS, 1)>(va + TILE * 16384);                 \
      asm volatile("s_waitcnt lgkmcnt(0)" ::: "memory"); SBAR();                                                                \
      const bf16x8 A = PKLH(al, ah);                                                                                            \
      o[0] = MFMA32(A, PKLH(l0, h0), o[0]); o[1] = MFMA32(A, PKLH(l1, h1), o[1]); o[2] = MFMA32(A, PKLH(l2, h2), o[2]); o[3] = MFMA32(A, PKLH(l3, h3), o[3]); } while (0)
    PA_STEP(0, 0); PA_STEP(0, 1); PA_STEP(0, 2); PA_STEP(0, 3); PA_STEP(1, 0); PA_STEP(1, 1); PA_STEP(1, 2); PA_STEP(1, 3);
#undef PA_STEP
    bf16_t* Cd = Cbuf + ((size_t)(dir * 8 + bh) * 128 + c) * 16384;
#pragma unroll
    for (int r = 0; r < 16; ++r) { const int dk = dkb * 32 + crow(r, hi);
#pragma unroll
      for (int d0 = 0; d0 < 4; ++d0) Cd[dk * 128 + d0 * 32 + r32] = f2bf(o[d0][r]); }
  }
  if (tid < 256) {
    const int dir = tid >> 7, dk = tid & 127; const LAS unsigned char* img = lds + (dir ? PA_KB : PA_KF);
    float n = 0.f;
#pragma unroll 8
    for (int s = 0; s < 128; ++s) n += bf2f(*(const LAS unsigned short*)(img + (s >> 6) * 16384 + v_st(s & 63, dk)));
    nvec[((size_t)(dir * 8 + bh) * 128 + c) * 128 + dk] = n;
  }
  __syncthreads();
}

DI void phase_scan(const Ctx& p, int bid, int G) {
  const int tid = tid_fresh(); unsigned char* ws = p.ws;
  const float* scal = (const float*)(ws + WS_SCAL); float* mprev = (float*)(ws + WS_SCAL) + 4096; float* nvec = (float*)(ws + WS_NVEC); bf16_t* Cbuf = (bf16_t*)p.out;
  for (int gid = bid * NTHREADS + tid, it = 0; gid < 131072; gid += G * NTHREADS, ++it) {
    const int seq = gid >> 13, e2c = gid & 8191, dir = seq >> 3;
    const bool ex = (it == 0) && (gid < 1024);
    const int seqn = (gid & 1023) >> 6, e2 = gid & 63, dirn = seqn >> 3;
    float m = 0.f, a0 = 0.f, a1 = 0.f, mN = 0.f, n0 = 0.f, n1 = 0.f;
    for (int sb = 0; sb < 128; sb += 8) {
      unsigned raw[8]; f32x2 rawn[8];
#pragma unroll
      for (int q = 0; q < 8; ++q) { const int c = dir ? 127 - (sb + q) : sb + q; raw[q] = *(const unsigned*)(Cbuf + ((size_t)seq * 128 + c) * 16384 + e2c * 2); }
      if (ex) {
#pragma unroll
        for (int q = 0; q < 8; ++q) { const int c = dirn ? 127 - (sb + q) : sb + q; rawn[q] = *(const f32x2*)(nvec + ((size_t)seqn * 128 + c) * 128 + e2 * 2); }
      }
#pragma unroll
      for (int q = 0; q < 8; ++q) {
        const int c = dir ? 127 - (sb + q) : sb + q;
        const float be = scal[seq * 128 + c], ml = scal[2048 + seq * 128 + c];
        *(unsigned*)(Cbuf + ((size_t)seq * 128 + c) * 16384 + e2c * 2) = cvtpk(a0, a1);
        if (e2c == 0) mprev[seq * 128 + c] = m;
        const float mn = fmaxf(be + m, ml), al = __expf(be + m - mn), bt = __expf(ml - mn);
        a0 = al * a0 + bt * bflo(raw[q]); a1 = al * a1 + bt * bfhi(raw[q]);
        m = mn;
      }
      if (ex) {
#pragma unroll
        for (int q = 0; q < 8; ++q) {
          const int c = dirn ? 127 - (sb + q) : sb + q;
          const float be = scal[seqn * 128 + c], ml = scal[2048 + seqn * 128 + c];
          *(f32x2*)(nvec + ((size_t)seqn * 128 + c) * 128 + e2 * 2) = (f32x2){n0, n1};
          const float mn = fmaxf(be + mN, ml), al = __expf(be + mN - mn), bt = __expf(ml - mn);
          n0 = al * n0 + bt * rawn[q][0]; n1 = al * n1 + bt * rawn[q][1];
          mN = mn;
        }
      }
    }
  }
}

DI void qkt8(f32x16& p0, f32x16& p1, const LAS unsigned char* Ks, const bf16x8* qr, int r32, int hi) {
  p0 = f32x16{}; p1 = f32x16{};
#pragma unroll
  for (int d0 = 0; d0 < 8; ++d0) { const int cb = (d0 * 16 + hi * 8) * 2;
    const bf16x8 b0 = *(const LAS bf16x8*)(Ks + KSWZ(r32, cb)), b1 = *(const LAS bf16x8*)(Ks + KSWZ(32 + r32, cb));
    p0 = MFMA32(b0, qr[d0], p0); p1 = MFMA32(b1, qr[d0], p1); }
}
DI v8i kfrag8(const LAS unsigned char* K8, int row, int s, int hi) {
  const int c = 4 * s + 2 * hi;
  const u32x4 lo = *(const LAS u32x4*)(K8 + row * 256 + ((c ^ (row & 15)) << 4)), hi4 = *(const LAS u32x4*)(K8 + row * 256 + (((c + 1) ^ (row & 15)) << 4));
  return (v8i){(int)lo[0], (int)lo[1], (int)lo[2], (int)lo[3], (int)hi4[0], (int)hi4[1], (int)hi4[2], (int)hi4[3]};
}
#define MFMA8(a, b, c) __builtin_amdgcn_mfma_scale_f32_32x32x64_f8f6f4((a), (b), (c), 0, 0, 0, 127, 0, 123)
DI void qkt12(f32x16& p0, f32x16& p1, const LAS unsigned char* K8, const v8i* qr, int r32, int hi) {
  p0 = f32x16{}; p1 = f32x16{};
#pragma unroll
  for (int s = 0; s < 3; ++s) {
    const v8i a0 = kfrag8(K8, r32, s, hi), a1 = kfrag8(K8, 32 + r32, s, hi);
    p0 = MFMA8(a0, qr[s], p0); p1 = MFMA8(a1, qr[s], p1);
  }
}

DI void glds16(const void* gsrc, unsigned lds_dst) {
  unsigned keep;
  asm volatile("s_mov_b32 %0, m0\n\ts_mov_b32 m0, %2\n\ts_nop 0\n\tglobal_load_lds_dwordx4 %1, off\n\ts_mov_b32 m0, %0" : "=&s"(keep) : "v"(gsrc), "s"(lds_dst) : "memory");
}
constexpr int AT_KN = 0, AT_V = 49152, AT_WS = 73728;
constexpr float ATT_THR = 3.f;
DI void partialSM(f32x16& p0, f32x16& p1, float& m_reg, float& mn, float& alpha) {
  float pmax = p0[0];
#pragma unroll
  for (int r = 1; r < 16; ++r) pmax = fmaxf(pmax, p0[r]);
#pragma unroll
  for (int r = 0; r < 16; ++r) pmax = fmaxf(pmax, p1[r]);
  pmax = half_swap_max(pmax);
  if (__builtin_expect(__all(pmax - m_reg <= ATT_THR), 1)) { mn = m_reg; alpha = 1.f; }
  else { mn = fmaxf(m_reg, pmax); alpha = __builtin_amdgcn_exp2f(m_reg - mn); m_reg = mn; }
  const float mo = mn - 5.f;
#pragma unroll
  for (int r = 0; r < 16; ++r) { p0[r] = p0[r] - mo; p1[r] = p1[r] - mo; }
#pragma unroll
  for (int r = 0; r < 16; ++r) p0[r] = __builtin_amdgcn_exp2f(p0[r]);
}
DI void finishSM(f32x16& p0, f32x16& p1, v8i& pa) {
#pragma unroll
  for (int r = 0; r < 16; ++r) p1[r] = __builtin_amdgcn_exp2f(p1[r]);
#pragma unroll
  for (int q = 0; q < 4; ++q) {
    int w = __builtin_amdgcn_cvt_pk_fp8_f32(p0[4 * q], p0[4 * q + 1], pa[q], false); pa[q] = __builtin_amdgcn_cvt_pk_fp8_f32(p0[4 * q + 2], p0[4 * q + 3], w, true);
    w = __builtin_amdgcn_cvt_pk_fp8_f32(p1[4 * q], p1[4 * q + 1], pa[4 + q], false); pa[4 + q] = __builtin_amdgcn_cvt_pk_fp8_f32(p1[4 * q + 2], p1[4 * q + 3], w, true);
  }
}
DI void pv8(f32x16* o, f32x16& lsum, const LAS unsigned char* Vt, v8i pa, int r32, int hi) {
  { const v8i ones = {0x38383838, 0x38383838, 0x38383838, 0x38383838, 0x38383838, 0x38383838, 0x38383838, 0x38383838};
    lsum = __builtin_amdgcn_mfma_scale_f32_32x32x64_f8f6f4(pa, ones, lsum, 0, 0, 0, 122, 0, 127); }
#pragma unroll
  for (int d0 = 0; d0 < 4; ++d0) {
    const int n = 32 * d0 + r32, x = (n >> 2) & 3;
    const u32x4 lo = *(const LAS u32x4*)(Vt + n * 64 + (((2 * hi) ^ x) << 4)), h4 = *(const LAS u32x4*)(Vt + n * 64 + (((2 * hi + 1) ^ x) << 4));
    const v8i bv = {(int)lo[0], (int)lo[1], (int)lo[2], (int)lo[3], (int)h4[0], (int)h4[1], (int)h4[2], (int)h4[3]};
    o[d0] = __builtin_amdgcn_mfma_scale_f32_32x32x64_f8f6f4(pa, bv, o[d0], 0, 0, 0, 122, 0, 127);
  }
}
DI void attn_unit(const unsigned char* Qb, const unsigned char* Knh, const unsigned char* Vh, bf16_t* Ob, LAS unsigned char* lds) {
  const int tid = tid_fresh(), wid = __builtin_amdgcn_readfirstlane(tid >> 6), lane = tid & 63, r32 = lane & 31, hi = lane >> 5;
  LAS float* wsf = (LAS float*)(lds + AT_WS) + wid * 64; LAS float* al_l = wsf + 32;
  constexpr int NT = SEQ / 64;
  unsigned offKn, offV;
  { const int row = wid * 4 + (lane >> 4); int lg = (lane & 15) ^ (row & 15); lg = lg < 12 ? lg : 0; offKn = (unsigned)(row * 192 + lg * 16); }
  { const int n = wid * 16 + (lane >> 2), c = (lane & 3) ^ ((n >> 2) & 3); offV = (unsigned)(n * 64 + c * 16); }
  const unsigned ldsw = (unsigned)wid * 1024u, lds0 = (unsigned)(uintptr_t)lds;
#define DMA16(gptr, ldsoff) glds16((gptr), (unsigned)__builtin_amdgcn_readfirstlane((int)(lds0 + (unsigned)(ldsoff))))
#define ISSUE_K(t, ks) do { const int t_ = (t) < NT ? (t) : NT - 1; const char* kn_ = (const char*)Knh + (size_t)t_ * (64 * 192) + offKn; \
    DMA16(kn_, AT_KN + (ks) * 16384 + ldsw); DMA16(kn_ + 32 * 192, AT_KN + (ks) * 16384 + 8192 + ldsw); } while (0)
#define ISSUE_V(t, vs) do { const int t_ = (t) < NT ? (t) : NT - 1; DMA16((const char*)Vh + (size_t)t_ * 8192 + offV, AT_V + (vs) * 8192 + ldsw); } while (0)
#define WAIT_BAR(N) asm volatile("s_waitcnt vmcnt(" #N ") lgkmcnt(0)\n\ts_barrier" ::: "memory")
#define RESC(a) do { if (__any((a) < 1.f)) { if (hi == 0) al_l[r32] = (a); asm volatile("s_waitcnt lgkmcnt(0)" ::: "memory"); \
    _Pragma("unroll") for (int r = 0; r < 16; ++r) { const float a_ = al_l[crow(r, hi)]; lsum[r] *= a_; _Pragma("unroll") for (int d = 0; d < 4; ++d) o[d][r] *= a_; } } } while (0)
  const bool trail = wid >= 4;
  ISSUE_K(0, 0); ISSUE_K(1, 1); ISSUE_V(0, 0);
  float m_reg = -1e30f; f32x16 lsum = {}; f32x16 o[4] = {}; v8i qr[3];
  { const unsigned char* Qw = Qb + (size_t)(wid * 32 + r32) * 192 + hi * 32;
#pragma unroll
    for (int s_ = 0; s_ < 3; ++s_) { const u32x4 lo = *(const u32x4*)(Qw + s_ * 64), h4 = *(const u32x4*)(Qw + s_ * 64 + 16);
      qr[s_] = (v8i){(int)lo[0], (int)lo[1], (int)lo[2], (int)lo[3], (int)h4[0], (int)h4[1], (int)h4[2], (int)h4[3]}; } }
  f32x16 pA0, pA1, pB0, pB1; float mnA, mnB, alA, alB; v8i pa = {};
  asm volatile("s_waitcnt vmcnt(0)" ::: "memory");
  __builtin_amdgcn_s_barrier();
  if (trail) __builtin_amdgcn_s_barrier();
  ISSUE_K(2, 2);
  qkt12(pA0, pA1, lds + AT_KN, qr, r32, hi);
  WAIT_BAR(3);
  ISSUE_V(1, 1);
  partialSM(pA0, pA1, m_reg, mnA, alA);
  WAIT_BAR(3);
  int s1 = 1;
  for (int j = 1; j + 1 < NT; j += 2) {
    const int s0 = s1 == 0 ? 2 : s1 - 1, s2 = s1 == 2 ? 0 : s1 + 1;
    ISSUE_K(j + 2, s0);
    SBAR(); qkt12(pB0, pB1, lds + AT_KN + s1 * 16384, qr, r32, hi);
    finishSM(pA0, pA1, pa); SBAR();
    WAIT_BAR(3);
    ISSUE_V(j + 1, s2);
    pv8(o, lsum, lds + AT_V + s0 * 8192, pa, r32, hi); partialSM(pB0, pB1, m_reg, mnB, alB);
    RESC(alB);
    WAIT_BAR(3);
    ISSUE_K(j + 3, s1);
    SBAR(); qkt12(pA0, pA1, lds + AT_KN + s2 * 16384, qr, r32, hi);
    finishSM(pB0, pB1, pa); SBAR();
    WAIT_BAR(3);
    ISSUE_V(j + 2, s0);
    pv8(o, lsum, lds + AT_V + s1 * 8192, pa, r32, hi); partialSM(pA0, pA1, m_reg, mnA, alA);
    RESC(alA);
    WAIT_BAR(3);
    s1 = s0;
  }
  {
    const int s0 = s1 == 0 ? 2 : s1 - 1, s2 = s1 == 2 ? 0 : s1 + 1;
    ISSUE_K(NT + 1, s0);
    SBAR(); qkt12(pB0, pB1, lds + AT_KN + s1 * 16384, qr, r32, hi);
    finishSM(pA0, pA1, pa); SBAR();
    WAIT_BAR(3);
    ISSUE_V(NT, s2);
    pv8(o, lsum, lds + AT_V + s0 * 8192, pa, r32, hi); partialSM(pB0, pB1, m_reg, mnB, alB);
    RESC(alB);
    WAIT_BAR(3);
    if (!trail) __builtin_amdgcn_s_barrier();
    finishSM(pB0, pB1, pa); SBAR();
    pv8(o, lsum, lds + AT_V + s1 * 8192, pa, r32, hi);
  }
  float rli[16];
#pragma unroll
  for (int r = 0; r < 16; ++r) rli[r] = __builtin_amdgcn_rcpf(lsum[r]);
  bf16_t* Ow = Ob + (size_t)(wid * 32) * 1024;
#pragma unroll
  for (int r = 0; r < 16; ++r) { const int orow = crow(r, hi);
#pragma unroll
    for (int d0 = 0; d0 < 4; ++d0) Ow[(size_t)orow * 1024 + d0 * 32 + r32] = f2bf(o[d0][r] * rli[r]); }
  asm volatile("s_waitcnt vmcnt(0) lgkmcnt(0)\n\ts_barrier" ::: "memory");
#undef DMA16
#undef ISSUE_K
#undef ISSUE_V
#undef WAIT_BAR
#undef RESC
}
DI void phase_attn(const Ctx& p, int bid, int G, LAS unsigned char* lds) {
  unsigned char* ws = p.ws;
  const unsigned char* qatt = ws + WS_QATT; const unsigned char* k8 = ws + WS_KN; const unsigned char* va = ws + WS_VA;
  bf16_t* hcat = (bf16_t*)(ws + WS_H);
  for (int u = bid; u < 512; u += G) {
    const int bh = u & 7, qb = u >> 3, b = bh >> 2, h = bh & 3;
    attn_unit(qatt + ((size_t)bh * SEQ + qb * 256) * 192, k8 + (size_t)bh * SEQ * 192, va + (size_t)bh * SEQ * 128,
              hcat + (size_t)(b * SEQ + qb * 256) * 1024 + 512 + h * 128, lds);
  }
}

constexpr int PC_K = 0, PC_V = 32768, PC_CF = 65536, PC_CB = 98304, PC_VEC = 131072;
template <bool DRY = false> DI void mlstmC_unit(const Ctx& p, int b, int h, int c, LAS unsigned char* lds) {
  const int tid = tid_fresh(), lane = tid & 63, wid = __builtin_amdgcn_readfirstlane(tid >> 6), r32 = lane & 31, hi = lane >> 5;
  unsigned char* ws = p.ws;
  const bf16_t* qkpost = (const bf16_t*)(ws + WS_U); const bf16_t* vmp = (const bf16_t*)(ws + WS_VM); bf16_t* hcat = (bf16_t*)(ws + WS_H);
  const float* gvec = (const float*)(ws + WS_GVEC); const float* nvec = (const float*)(ws + WS_NVEC); const float* mprev = (const float*)(ws + WS_SCAL) + 4096;
  const bf16_t* Cbuf = (const bf16_t*)p.out;
  LAS float* vec = (LAS float*)(lds + PC_VEC);
  const int bh = b * 4 + h, row0 = b * SEQ + c * 128;
  if (tid < 256) {
    const int dir = tid >> 7, t = tid & 127;
    const float* gv = gvec + ((size_t)(dir * 8 + bh) * SEQ + c * 128 + t) * 3;
    const float gb = gv[0], gcol = gv[1], gcm = gv[2], mp = mprev[(dir * 8 + bh) * 128 + c];
    const float M = fmaxf(mp, gcm);
    vec[dir * 128 + t] = gcol * LOG2E; vec[256 + dir * 128 + t] = M * LOG2E; vec[512 + dir * 128 + t] = __expf(mp - M); vec[768 + dir * 128 + t] = __expf(-(gb + M));
    vec[1024 + dir * 128 + t] = nvec[((size_t)(dir * 8 + bh) * 128 + c) * 128 + t];
  }
  {
    const int r0 = tid >> 4, c8 = (tid & 15) * 8;
    const bf16_t* Cf = Cbuf + ((size_t)(0 * 8 + bh) * 128 + c) * 16384; const bf16_t* Cb = Cbuf + ((size_t)(1 * 8 + bh) * 128 + c) * 16384;
#pragma unroll
    for (int ps = 0; ps < 4; ++ps) {
      const int r = r0 + 32 * ps, tile = r >> 6, rr = r & 63;
      *(LAS u32x4*)(lds + PC_K + tile * 16384 + KSWZ(rr, c8 * 2)) = *(const u32x4*)(qkpost + (size_t)(row0 + r) * 1024 + 512 + h * 128 + c8);
      *(LAS u32x4*)(lds + PC_V + tile * 16384 + v_st(rr, c8)) = *(const u32x4*)(vmp + (size_t)(row0 + r) * 512 + h * 128 + c8);
      *(LAS u32x4*)(lds + PC_CF + tile * 16384 + v_st(rr, c8)) = *(const u32x4*)(Cf + r * 128 + c8);
      *(LAS u32x4*)(lds + PC_CB + tile * 16384 + v_st(rr, c8)) = *(const u32x4*)(Cb + r * 128 + c8);
    }
  }
  const int dir = wid >> 2, tb = wid & 3, t = tb * 32 + r32;
  bf16x8 qr[8];
  { const bf16_t* Qw = qkpost + (size_t)(row0 + t) * 1024 + h * 128 + hi * 8;
#pragma unroll
    for (int d0 = 0; d0 < 8; ++d0) qr[d0] = *(const bf16x8*)(Qw + d0 * 16); }
  __syncthreads();
  const LAS float* vcol = vec + dir * 128; const LAS float* va_ = vec + 512 + dir * 128; const LAS float* vn = vec + 1024 + dir * 128;
  float qn = 0.f;
#pragma unroll
  for (int d0 = 0; d0 < 8; ++d0)
#pragma unroll
    for (int j = 0; j < 8; ++j) qn += bf2f((unsigned short)qr[d0][j]) * vn[d0 * 16 + hi * 8 + j];
  qn = half_swap_sum(qn);
  asm volatile("" : "+v"(qn));
  SBAR();
  f32x16 o[4] = {};
  {
    const int vbc = (int)(uintptr_t)(lds + (dir ? PC_CB : PC_CF)) + v_rd_base(lane);
    pv_d0(o, vbc, qr[0], qr[1], qr[2], qr[3]);
    pv_d0(o, vbc + 16384, qr[4], qr[5], qr[6], qr[7]);
  }
#pragma unroll
  for (int d = 0; d < 4; ++d)
#pragma unroll
    for (int r = 0; r < 16; ++r) o[d][r] *= va_[tb * 32 + crow(r, hi)];
  SBAR();
  const float Mt = vec[256 + dir * 128 + t], at = va_[t], flt = vec[768 + dir * 128 + t];
  float rsum = 0.f;
  const int vbv = (int)(uintptr_t)(lds + PC_V) + v_rd_base(lane);
#pragma unroll
  for (int kt = 0; kt < 2; ++kt) {
    const bool need = dir == 0 ? (kt * 64 <= tb * 32 + 31) : (kt * 64 + 63 >= tb * 32);
    if (need) {
      f32x16 p0, p1; qkt8(p0, p1, lds + PC_K + kt * 16384, qr, r32, hi);
#pragma unroll
      for (int r = 0; r < 16; ++r) {
        const int s0 = kt * 64 + crow(r, hi), s1 = s0 + 32;
        const bool ok0 = dir == 0 ? (s0 <= t) : (s0 >= t), ok1 = dir == 0 ? (s1 <= t) : (s1 >= t);
        const float w0 = __builtin_amdgcn_exp2f(vcol[s0] - Mt), w1 = __builtin_amdgcn_exp2f(vcol[s1] - Mt);
        p0[r] = ok0 ? p0[r] * w0 : 0.f; p1[r] = ok1 ? p1[r] * w1 : 0.f;
        rsum += p0[r] + p1[r];
      }
      bf16x8 pa0, pa1, pa2, pa3; pack_p(p0, p1, pa0, pa1, pa2, pa3);
      pv_d0(o, vbv + kt * 16384, pa0, pa1, pa2, pa3);
    }
  }
  rsum = half_swap_sum(rsum);
  {
    const float den = at * qn + rsum, dn = fmaxf(fabsf(den), flt);
    LAS float* rd = vec + 1280 + dir * 128;
    if (hi == 0) rd[t] = 1.f / dn;
    asm volatile("s_waitcnt lgkmcnt(0)" ::: "memory");
#pragma unroll
    for (int d = 0; d < 4; ++d)
#pragma unroll
      for (int r = 0; r < 16; ++r) o[d][r] *= rd[tb * 32 + crow(r, hi)];
  }
  __syncthreads();
  {
    LAS float* hst = (LAS float*)(lds + dir * 65536);
#pragma unroll
    for (int r = 0; r < 16; ++r) { const int tr = tb * 32 + crow(r, hi);
#pragma unroll
      for (int d = 0; d < 4; ++d) hst[tr * 128 + d * 32 + r32] = o[d][r]; }
  }
  __syncthreads();
  {
    const int rg = tid >> 5, cl = tid & 31;
    const f32x4 g = *(const f32x4*)(karg<A_MHG>() + h * 128 + 4 * cl);
    u32x2 sgv[8];
#pragma unroll
    for (int ps = 0; ps < 8; ++ps) sgv[ps] = *(const u32x2*)(hcat + (size_t)(row0 + ps * 16 + rg) * 1024 + h * 128 + 4 * cl);
#pragma unroll
    for (int ps = 0; ps < 8; ++ps) {
      const int tr = ps * 16 + rg;
      const f32x4 xf = *(const LAS f32x4*)(lds + (tr * 128 + 4 * cl) * 4), xb = *(const LAS f32x4*)(lds + 65536 + (tr * 128 + 4 * cl) * 4);
      f32x4 x = xf + xb;
      float s = (x[0] + x[1]) + (x[2] + x[3]);
#pragma unroll
      for (int o_ = 1; o_ < 32; o_ <<= 1) s += __shfl_xor(s, o_);
      const float mu = s * (1.f / 128.f); x = x - mu;
      float q = (x[0] * x[0] + x[1] * x[1]) + (x[2] * x[2] + x[3] * x[3]);
#pragma unroll
      for (int o_ = 1; o_ < 32; o_ <<= 1) q += __shfl_xor(q, o_);
      const float rstd = rsqrtf(q * (1.f / 128.f) + LN_EPS);
      u32x2* dst = (u32x2*)(hcat + (size_t)(row0 + tr) * 1024 + h * 128 + 4 * cl);
      const u32x2 sg = sgv[ps];
      const f32x4 y = x * rstd * g;
      if (DRY) dst = (u32x2*)((bf16_t*)(ws + WS_QKPRE) + (size_t)(row0 + tr) * 1024 + h * 128 + 4 * cl);
      *dst = (u32x2){cvtpk(y[0] * bflo(sg[0]), y[1] * bfhi(sg[0])), cvtpk(y[2] * bflo(sg[1]), y[3] * bfhi(sg[1]))};
    }
  }
  __syncthreads();
}

template <bool DRY = false> DI void phase_hanorm(const Ctx& p, int bid, int G) {
  const int tid = tid_fresh(), lane = tid & 63, wave = tid >> 6; bf16_t* hcat = (bf16_t*)(p.ws + WS_H);
  const f32x4 g0 = *(const f32x4*)(karg<A_ANG>() + 8 * lane), g1 = *(const f32x4*)(karg<A_ANG>() + 8 * lane + 4);
  u32x4 wn = {0u, 0u, 0u, 0u};
  { const int row = bid * 8 + wave; if (row < T) wn = *(const u32x4*)(hcat + (size_t)row * 1024 + 512 + 8 * lane); }
  for (int row = bid * 8 + wave; row < T; row += G * 8) {
    u32x4* ptr = (u32x4*)(hcat + (size_t)row * 1024 + 512 + 8 * lane);
    const u32x4 w = wn;
    if (row + G * 8 < T) wn = *(const u32x4*)(hcat + (size_t)(row + G * 8) * 1024 + 512 + 8 * lane);
    float v[8] = {bflo(w[0]), bfhi(w[0]), bflo(w[1]), bfhi(w[1]), bflo(w[2]), bfhi(w[2]), bflo(w[3]), bfhi(w[3])};
    float s = 0.f;
#pragma unroll
    for (int e = 0; e < 8; ++e) s += v[e] * v[e];
    const float rs = rsqrtf(wave_sum(s) * (1.f / 512.f) + RMS_EPS);
    if (DRY) ptr = (u32x4*)((bf16_t*)(p.ws + WS_QKPRE) + (size_t)row * 1024 + 512 + 8 * lane);
    *ptr = (u32x4){cvtpk(v[0] * rs * g0[0], v[1] * rs * g0[1]), cvtpk(v[2] * rs * g0[2], v[3] * rs * g0[3]), cvtpk(v[4] * rs * g1[0], v[5] * rs * g1[1]), cvtpk(v[6] * rs * g1[2], v[7] * rs * g1[3])};
  }
}

template <bool DRY = false> DI void phase_route(const Ctx& p, int bid, int G, LAS unsigned char* lds) {
  const int tid = tid_fresh(), lane = tid & 63, wave = tid >> 6; unsigned char* ws = p.ws;
  LAS float* wreT = (LAS float*)lds;
  LAS float* wrgT = (LAS float*)(lds + 131072);
  LAS int* rec = (LAS int*)(lds + 147456);
  LAS int* lcnt = (LAS int*)(lds + 147456 + 2048);
  { const f32x4* wrt = (const f32x4*)(ws + WS_WRT);
    for (int i = tid; i < 36 * 256; i += NTHREADS) ((LAS f32x4*)lds)[i] = wrt[i]; }
  const float* ln1_g = karg<A_LN1G>(); const float* ln1_b = karg<A_LN1B>(); const float* b_rg = karg<A_BRG>(); const float* b_re = karg<A_BRE>();
  const float* mod = (const float*)(ws + WS_MOD); bf16_t* U = (bf16_t*)(ws + WS_U);
  int* cnt = (int*)(ws + WS_CNT) + (DRY ? 32 * CNT_STRIDE : 0);
  int* ltok = (int*)(ws + (DRY ? WS_HDN : WS_LTOK)); float* lw = (float*)(ws + (DRY ? WS_HDN + 8 * MiB : WS_LW));
  int* toke = (int*)(ws + WS_TOKE) + (DRY ? 2 * T : 0); int* tokp = (int*)(ws + WS_TOKP) + (DRY ? 2 * T : 0);
  const int nk = T / (G * 8);
  __syncthreads();
  f32x4 wg[4][4];
#pragma unroll
  for (int e = 0; e < 4; ++e)
#pragma unroll
    for (int j = 0; j < 4; ++j) wg[e][j] = *(const LAS f32x4*)(wrgT + e * 1024 + 4 * lane + 256 * j);
  for (int k0 = 0; k0 < nk; k0 += 16) {
    if (tid < 32) lcnt[tid] = 0;
    __syncthreads();
    u32x2 zn[4];
    { const u32x2* zr = (const u32x2*)((const bf16_t*)p.out + (size_t)(bid * 8 + wave + k0 * G * 8) * 1024) + lane;
#pragma unroll
      for (int j = 0; j < 4; ++j) zn[j] = zr[64 * j]; }
    for (int kk = 0; kk < 16 && k0 + kk < nk; ++kk) {
      const int row = bid * 8 + wave + (k0 + kk) * G * 8, b = row >> 14;
      u32x2* x1r = (u32x2*)((bf16_t*)(ws + (DRY ? 384 * MiB : WS_H)) + (size_t)row * 1024) + lane;
      f32x4 v[4]; float s = 0.f;
#pragma unroll
      for (int j = 0; j < 4; ++j) { const u32x2 raw = zn[j]; v[j] = (f32x4){bflo(raw[0]), bfhi(raw[0]), bflo(raw[1]), bfhi(raw[1])}; s += (v[j][0] + v[j][1]) + (v[j][2] + v[j][3]); }
      if (kk + 1 < 16 && k0 + kk + 1 < nk) { const u32x2* zr = (const u32x2*)((const bf16_t*)p.out + (size_t)(row + G * 8) * 1024) + lane;
#pragma unroll
        for (int j = 0; j < 4; ++j) zn[j] = zr[64 * j]; }
      float mean = wave_sum(s) * (1.f / 1024.f), s2 = 0.f;
#pragma unroll
      for (int j = 0; j < 4; ++j) { v[j] = v[j] - mean; s2 += (v[j][0] * v[j][0] + v[j][1] * v[j][1]) + (v[j][2] * v[j][2] + v[j][3] * v[j][3]); }
      float rstd = rsqrtf(wave_sum(s2) * (1.f / 1024.f) + LN_EPS);
      s = 0.f;
#pragma unroll
      for (int j = 0; j < 4; ++j) { const int col = 4 * lane + 256 * j;
        v[j] = v[j] * rstd * *(const f32x4*)(ln1_g + col) + *(const f32x4*)(ln1_b + col);
        x1r[64 * j] = (u32x2){cvtpk(v[j][0], v[j][1]), cvtpk(v[j][2], v[j][3])};
        s += (v[j][0] + v[j][1]) + (v[j][2] + v[j][3]); }
      mean = wave_sum(s) * (1.f / 1024.f); s2 = 0.f;
#pragma unroll
      for (int j = 0; j < 4; ++j) { v[j] = v[j] - mean; s2 += (v[j][0] * v[j][0] + v[j][1] * v[j][1]) + (v[j][2] * v[j][2] + v[j][3] * v[j][3]); }
      rstd = rsqrtf(wave_sum(s2) * (1.f / 1024.f) + LN_EPS);
      u32x2* o8 = (u32x2*)(U + (size_t)row * 1024) + lane;
      float gl[4] = {0.f, 0.f, 0.f, 0.f};
#pragma unroll
      for (int j = 0; j < 4; ++j) { const int col = 4 * lane + 256 * j;
        v[j] = v[j] * rstd * (*(const f32x4*)(mod + b * 6144 + 4096 + col) + 1.f) + *(const f32x4*)(mod + b * 6144 + 3072 + col);
        o8[64 * j] = (u32x2){cvtpk(v[j][0], v[j][1]), cvtpk(v[j][2], v[j][3])};
#pragma unroll
        for (int e = 0; e < 4; ++e) { const f32x4 w = wg[e][j]; gl[e] += v[j][0] * w[0] + v[j][1] * w[1] + v[j][2] * w[2] + v[j][3] * w[3]; } }
#pragma unroll
      for (int e = 0; e < 4; ++e) gl[e] = wave_sum(gl[e]) + b_rg[e];
      int gi = 0; float gm = gl[0];
#pragma unroll
      for (int e = 1; e < 4; ++e) if (gl[e] > gm) { gm = gl[e]; gi = e; }
      float gs = 0.f;
#pragma unroll
      for (int e = 0; e < 4; ++e) gs += __expf(gl[e] - gm);
      const float gw = 1.f / gs;
      float el[8] = {0.f, 0.f, 0.f, 0.f, 0.f, 0.f, 0.f, 0.f};
#pragma unroll
      for (int j = 0; j < 4; ++j) { const int col = 4 * lane + 256 * j;
#pragma unroll
        for (int e = 0; e < 8; ++e) { const f32x4 w = *(const LAS f32x4*)(wreT + (gi * 8 + e) * 1024 + col); el[e] += v[j][0] * w[0] + v[j][1] * w[1] + v[j][2] * w[2] + v[j][3] * w[3]; } }
#pragma unroll
      for (int e = 0; e < 8; ++e) el[e] = wave_sum(el[e]) + b_re[gi * 8 + e];
      int i1 = 0; float v1 = el[0];
#pragma unroll
      for (int e = 1; e < 8; ++e) if (el[e] > v1) { v1 = el[e]; i1 = e; }
      int i2 = (i1 == 0) ? 1 : 0; float v2 = (i1 == 0) ? el[1] : el[0];
#pragma unroll
      for (int e = 0; e < 8; ++e) if (e != i1 && el[e] > v2) { v2 = el[e]; i2 = e; }
      const float p1 = 1.f / (1.f + __expf(v2 - v1)), p2 = 1.f - p1;
      if (lane == 0) {
        const int e1 = gi * 8 + i1, e2 = gi * 8 + i2, li = kk * 8 + wave;
        const int q1 = __hip_atomic_fetch_add(&lcnt[e1], 1, __ATOMIC_RELAXED, __HIP_MEMORY_SCOPE_WORKGROUP), q2 = __hip_atomic_fetch_add(&lcnt[e2], 1, __ATOMIC_RELAXED, __HIP_MEMORY_SCOPE_WORKGROUP);
        rec[li * 4 + 0] = e1 | (e2 << 8); rec[li * 4 + 1] = q1 | (q2 << 16); rec[li * 4 + 2] = __float_as_int(p1 * gw); rec[li * 4 + 3] = __float_as_int(p2 * gw);
      }
    }
    __syncthreads();
    if (tid < 32) { const int n = lcnt[tid]; lcnt[32 + tid] = n ? atomicAdd(&cnt[tid * CNT_STRIDE], n) : 0; }
    __syncthreads();
    if (tid < 128 && k0 + (tid >> 3) < nk) {
      const int li = tid, row = bid * 8 + (li & 7) + (k0 + (li >> 3)) * G * 8;
      const int ee = rec[li * 4], qq = rec[li * 4 + 1], e1 = ee & 255, e2 = ee >> 8, q1 = lcnt[32 + e1] + (qq & 0xffff), q2 = lcnt[32 + e2] + (qq >> 16);
      ltok[(size_t)e1 * T + q1] = row; lw[(size_t)e1 * T + q1] = __int_as_float(rec[li * 4 + 2]);
      ltok[(size_t)e2 * T + q2] = row; lw[(size_t)e2 * T + q2] = __int_as_float(rec[li * 4 + 3]);
      toke[row * 2] = e1; toke[row * 2 + 1] = e2; tokp[row * 2] = q1; tokp[row * 2 + 1] = q2;
    }
    __syncthreads();
  }
}

constexpr int MOE_TS = 131072;
DI void moe_table(const Ctx& p, LAS unsigned char* lds) {
  LAS int* ts = (LAS int*)(lds + MOE_TS); const int* cnt = (const int*)(p.ws + WS_CNT);
  if (threadIdx.x < 64) {
    const int lane = threadIdx.x; const int n = lane < 32 ? (cnt[lane * CNT_STRIDE] + 255) >> 8 : 0; int a = n;
#pragma unroll
    for (int o = 1; o < 32; o <<= 1) { const int t = __shfl_up(a, o); a += lane >= o ? t : 0; }
    if (lane < 32) ts[lane] = a - n;
    if (lane == 31) ts[32] = a;
  }
  __syncthreads();
}

template <bool DRY = false> DI void phase_final(const Ctx& p, int bid, int G, LAS unsigned char* lds) {
  const int tid = tid_fresh(), lane = tid & 63, wave = tid >> 6; unsigned char* ws = p.ws;
  const LAS int* ts = (const LAS int*)(lds + MOE_TS); const float* ln2_g = karg<A_LN2G>(); const float* ln2_b = karg<A_LN2B>();
  const float* mod = (const float*)(ws + WS_MOD); const bf16_t* ybuf = (const bf16_t*)(ws + WS_YBUF); const int* toke = (const int*)(ws + WS_TOKE); const int* tokp = (const int*)(ws + WS_TOKP);
  const int stride = G * 8; int row = bid * 8 + wave;
  size_t s0n = 0, s1n = 0;
  u32x2 an[4], cn[4], xn[4];
  auto slots = [&](int r, size_t& a, size_t& c) { a = (size_t)ts[toke[r * 2]] * 256 + tokp[r * 2]; c = (size_t)ts[toke[r * 2 + 1]] * 256 + tokp[r * 2 + 1]; };
  auto loadrow = [&](int r, size_t a, size_t c) {
    const u32x2* x1r = (const u32x2*)((const bf16_t*)(ws + WS_H) + (size_t)r * 1024) + lane;
    const u32x2* y0 = (const u32x2*)(ybuf + a * 1024) + lane; const u32x2* y1 = (const u32x2*)(ybuf + c * 1024) + lane;
#pragma unroll
    for (int j = 0; j < 4; ++j) { an[j] = y0[64 * j]; cn[j] = y1[64 * j]; xn[j] = x1r[64 * j]; } };
  if (row < T) { size_t a, c; slots(row, a, c); loadrow(row, a, c); if (row + stride < T) slots(row + stride, s0n, s1n); }
  for (; row < T; row += stride) {
    const int b = row >> 14;
    f32x4 v[4]; float s = 0.f;
#pragma unroll
    for (int j = 0; j < 4; ++j) { const int col = 4 * lane + 256 * j;
      const u32x2 a = an[j], c = cn[j], xw = xn[j];
      const f32x4 y = {bflo(a[0]) + bflo(c[0]), bfhi(a[0]) + bfhi(c[0]), bflo(a[1]) + bflo(c[1]), bfhi(a[1]) + bfhi(c[1])};
      const f32x4 x1v = {bflo(xw[0]), bfhi(xw[0]), bflo(xw[1]), bfhi(xw[1])};
      v[j] = x1v * ALPHA + (*(const f32x4*)(mod + b * 6144 + 5120 + col) + 1.f) * y;
      s += (v[j][0] + v[j][1]) + (v[j][2] + v[j][3]); }
    if (row + stride < T) { loadrow(row + stride, s0n, s1n); if (row + 2 * stride < T) slots(row + 2 * stride, s0n, s1n); }
    const float mean = wave_sum(s) * (1.f / 1024.f); float s2 = 0.f;
#pragma unroll
    for (int j = 0; j < 4; ++j) { v[j] = v[j] - mean; s2 += (v[j][0] * v[j][0] + v[j][1] * v[j][1]) + (v[j][2] * v[j][2] + v[j][3] * v[j][3]); }
    const float rstd = rsqrtf(wave_sum(s2) * (1.f / 1024.f) + LN_EPS);
    f32x4* xr = (f32x4*)(p.out + (size_t)row * 1024) + lane;
#pragma unroll
    for (int j = 0; j < 4; ++j) { const int col = 4 * lane + 256 * j; xr[64 * j] = v[j] * rstd * *(const f32x4*)(ln2_g + col) + *(const f32x4*)(ln2_b + col); }
  }
}


#define XB_TMO      128
#define XB_XCNT(j)  (256  + 64 * (j))
#define XB_XSUB(j)  (1280 + 64 * (j))
#define XB_XGEN(j)  (2304 + 64 * (j))
#define XB_TOP      3328
#define XB_TOPGEN   3392
#define XCD_BAR_WORDS 3456
#define XB_SPIN_CAP (1u << 18)
DI unsigned xb_ld(unsigned* p)              { return __hip_atomic_load(p, __ATOMIC_RELAXED, __HIP_MEMORY_SCOPE_AGENT); }
DI unsigned xb_add(unsigned* p, unsigned v) { return __hip_atomic_fetch_add(p, v, __ATOMIC_RELAXED, __HIP_MEMORY_SCOPE_AGENT); }
DI unsigned xb_xcc_id() { return (unsigned)__builtin_amdgcn_s_getreg((3 << 11) | 20) & 0xFu; }
#define XB_SPIN(cond, bar) do { unsigned _sp = 0; while (cond) { __builtin_amdgcn_s_sleep(1); \
    if ((++_sp & 255u) == 0u) { if (xb_ld(&(bar)[XB_TMO])) break; if (_sp > XB_SPIN_CAP) { atomicAdd(&(bar)[XB_TMO], 1u); break; } } } } while (0)
struct XcdBarrier { unsigned* bar; unsigned x; volatile LAS unsigned* st; };
DI XcdBarrier xcd_barrier_post(unsigned* bar, volatile LAS unsigned* st) {
  XcdBarrier b; b.bar = bar; b.x = xb_xcc_id(); b.st = st;
  if (threadIdx.x == 0) (void)xb_add(&bar[XB_XCNT(b.x)], 1u);
  return b;
}
DI void xcd_barrier_complete(unsigned* bar, unsigned x, unsigned& nloc, unsigned& nx) {
  const unsigned G = gridDim.x * gridDim.y * gridDim.z;
  unsigned sum, cnt, mine, sp = 0u;
  for (;;) {
    sum = 0u; cnt = 0u; mine = 0u;
#pragma unroll
    for (unsigned j = 0; j < 16; ++j) { const unsigned c = xb_ld(&bar[XB_XCNT(j)]); sum += c; cnt += (c > 0u) ? 1u : 0u; mine = (j == x) ? c : mine; }
    if (sum == G) break;
    __builtin_amdgcn_s_sleep(1);
    if ((++sp & 255u) == 0u) { if (xb_ld(&bar[XB_TMO])) break; if (sp > XB_SPIN_CAP) { atomicAdd(&bar[XB_TMO], 1u); break; } }
  }
  nloc = mine > 0u ? mine : 1u; nx = cnt > 0u ? cnt : 1u;
}
DI void xcd_barrier(const XcdBarrier& b) {
  asm volatile("s_waitcnt vmcnt(0)" ::: "memory");
  __syncthreads();
  if (threadIdx.x == 0) {
    unsigned* bar = b.bar;
    __builtin_amdgcn_s_waitcnt(0);
    unsigned nloc = b.st[0], nx = b.st[1];
    if (nloc == 0u) { xcd_barrier_complete(bar, b.x, nloc, nx); b.st[0] = nloc; b.st[1] = nx; }
    const unsigned old = xb_add(&bar[XB_XSUB(b.x)], 1u);
    const unsigned gen = old / nloc;
    if (old + 1u == (gen + 1u) * nloc) {
      __builtin_amdgcn_fence(__ATOMIC_RELEASE, "agent");
      asm volatile("s_waitcnt vmcnt(0)" ::: "memory");
      const unsigned og = xb_add(&bar[XB_TOP], 1u);
      const unsigned tg = og / nx;
      if (og + 1u == (tg + 1u) * nx) xb_add(&bar[XB_TOPGEN], 1u);
      else XB_SPIN(xb_ld(&bar[XB_TOPGEN]) == tg, bar);
      __builtin_amdgcn_fence(__ATOMIC_ACQUIRE, "agent");
      xb_add(&bar[XB_XGEN(b.x)], 1u);
      asm volatile("s_waitcnt vmcnt(0)" ::: "memory");
    } else {
      XB_SPIN(xb_ld(&bar[XB_XGEN(b.x)]) == gen, bar);
      __builtin_amdgcn_fence(__ATOMIC_ACQUIRE, "agent");
      asm volatile("s_waitcnt vmcnt(0)" ::: "memory");
    }
  }
  __syncthreads();
}

__device__ unsigned g_bar_counter = 0;
DI void grid_barrier(const unsigned G) {
  asm volatile("s_waitcnt vmcnt(0)" ::: "memory");
  __syncthreads();
  if (threadIdx.x == 0) {
    __builtin_amdgcn_fence(__ATOMIC_RELEASE, "agent");
    asm volatile("s_waitcnt vmcnt(0)" ::: "memory");
    const unsigned old = __hip_atomic_fetch_add(&g_bar_counter, 1u, __ATOMIC_RELAXED, __HIP_MEMORY_SCOPE_AGENT);
    const unsigned target = (old / G + 1u) * G;
    unsigned sp = 0;
    while ((int)(__hip_atomic_load(&g_bar_counter, __ATOMIC_RELAXED, __HIP_MEMORY_SCOPE_AGENT) - target) < 0) { __builtin_amdgcn_s_sleep(1); if (++sp > (1u << 24)) break; }
    __builtin_amdgcn_fence(__ATOMIC_ACQUIRE, "agent");
    asm volatile("s_waitcnt vmcnt(0)" ::: "memory");
  }
  __syncthreads();
}

#define KERNEL_HEAD extern __shared__ __attribute__((aligned(16))) unsigned char lds_raw[]; LAS unsigned char* lds = (LAS unsigned char*)lds_raw; const int bid = blockIdx.x, G = gridDim.x; \
  Ctx p; p.ws = karg<A_WS, unsigned char>(); p.out = karg<A_OUT, float>();
#ifdef MULTI_LAUNCH
__global__ void __launch_bounds__(NTHREADS, 2) k_prep(Params) { KERNEL_HEAD phase_prep(p, bid, G, lds); }
__global__ void __launch_bounds__(NTHREADS, 2) k_lnmod(Params) { KERNEL_HEAD (void)lds; phase_lnmod(p, bid, G); }
__global__ void __launch_bounds__(NTHREADS, 2) k_inproj(Params) { KERNEL_HEAD
  unsigned char* ws = p.ws;
  g8::DenseOrder S; S.init(T, N_INP, 1024, ws + WS_WIN, G, bid);
  EpiIn E{(bf16_t*)(ws + WS_QKPRE), (bf16_t*)(ws + WS_VM), (bf16_t*)(ws + WS_H), (bf16_t*)(ws + WS_CQ), (bf16_t*)(ws + WS_CKV), (unsigned char*)(ws + WS_KN), (float*)(ws + WS_GATES),
          (float*)(ws + WS_SSQQ), (float*)(ws + WS_SSQKV), (const float*)(ws + WS_ROPE), karg<A_GATEB>()};
  g8::gemm_phase(lds, (const char*)(ws + WS_U), 1024, S, E);
}
__global__ void __launch_bounds__(NTHREADS, 2) k_mid1(Params) { KERNEL_HEAD
  unsigned char* ws = p.ws;
  { g8::DenseOrder S; S.init(T, 768, 384, ws + WS_WUQ, G, bid); EpiUQ E{(unsigned char*)(ws + WS_QATT), (const float*)(ws + WS_SSQQ), (const float*)(ws + WS_ROPE)};
    g8::gemm_phase(lds, (const char*)(ws + WS_CQ), 384, S, E); }
}
__global__ void __launch_bounds__(NTHREADS, 2) k_mid2(Params) { KERNEL_HEAD
  unsigned char* ws = p.ws;
  { g8::DenseOrder S; S.init(T, 1024, 256, ws + WS_WUKV, G, bid); EpiUKV E{(unsigned char*)(ws + WS_KN), (unsigned char*)(ws + WS_VA), (const float*)(ws + WS_SSQKV)};
    g8::gemm_phase(lds, (const char*)(ws + WS_CKV), 256, S, E); }
}
__global__ void __launch_bounds__(NTHREADS, 2) k_mid3(Params) { KERNEL_HEAD
  for (int u = bid; u < 1024; u += G) { const int c = u & 127, bh = u >> 7; mlstmA_unit(p, bh >> 2, bh & 3, c, lds); }
}
__global__ void __launch_bounds__(NTHREADS, 2) k_scan_attn(Params) { KERNEL_HEAD phase_scan(p, bid, G); phase_attn(p, bid, G, lds); }
__global__ void __launch_bounds__(NTHREADS, 2) k_mlstm_out(Params) { KERNEL_HEAD
  for (int u = bid; u < 1024; u += G) { const int c = u & 127, bh = u >> 7; mlstmC_unit(p, bh >> 2, bh & 3, c, lds); }
  phase_hanorm(p, bid, G);
}
__global__ void __launch_bounds__(NTHREADS, 2) k_outproj(Params) { KERNEL_HEAD
  unsigned char* ws = p.ws;
  g8::DenseOrder S; S.init(T, 1024, 1024, ws + WS_WOUT, G, bid); EpiOut E{karg<A_X>(), (const float*)(ws + WS_MOD), (bf16_t*)p.out};
  g8::gemm_phase(lds, (const char*)(ws + WS_H), 1024, S, E);
}
__global__ void __launch_bounds__(NTHREADS, 2) k_route(Params) { KERNEL_HEAD phase_route(p, bid, G, lds); }
__global__ void __launch_bounds__(NTHREADS, 2) k_moe_gu(Params) { KERNEL_HEAD
  unsigned char* ws = p.ws; moe_table(p, lds);
  MoeOrderGU S; S.tstart = (const LAS int*)(lds + MOE_TS); S.cnt = (const int*)(ws + WS_CNT); S.G = G; S.c = bid; S.ltok = (const int*)(ws + WS_LTOK); S.Bt = (const char*)(ws + WS_WGU);
  EpiGU E{(bf16_t*)(ws + WS_HDN)};
  g8::gemm_phase(lds, (const char*)(ws + WS_U), 1024, S, E);
}
__global__ void __launch_bounds__(NTHREADS, 2) k_moe_dn(Params) { KERNEL_HEAD
  unsigned char* ws = p.ws; moe_table(p, lds);
  MoeOrderDN S; S.tstart = (const LAS int*)(lds + MOE_TS); S.cnt = (const int*)(ws + WS_CNT); S.G = G; S.c = bid; S.Bt = (const char*)(ws + WS_WDN);
  EpiDN E{(bf16_t*)(ws + WS_YBUF), (const float*)(ws + WS_LW)};
  g8::gemm_phase(lds, (const char*)(ws + WS_HDN), 512, S, E);
}
__global__ void __launch_bounds__(NTHREADS, 2) k_final(Params) { KERNEL_HEAD moe_table(p, lds); phase_final(p, bid, G, lds); }

#endif

__global__ void __launch_bounds__(NTHREADS, 2) k_mega(Params) { KERNEL_HEAD
  unsigned char* ws = p.ws;
  if (bid == 0) for (int i = threadIdx.x; i < XCD_BAR_WORDS; i += NTHREADS) ((unsigned*)(ws + WS_BAR))[i] = 0u;
  if (threadIdx.x < 64) ((LAS unsigned*)(lds + LDS_BARST))[threadIdx.x] = 0u;
  XcdBarrier xbar; xbar.bar = (unsigned*)(ws + WS_BAR); xbar.x = 0; xbar.st = (volatile LAS unsigned*)(lds + LDS_BARST);
  bool xb_ready = false;
#define PHASE_SEP() do { asm volatile("" ::: "memory"); if (!xb_ready) { grid_barrier((unsigned)G); xbar = xcd_barrier_post((unsigned*)(ws + WS_BAR), (volatile LAS unsigned*)(lds + LDS_BARST)); xb_ready = true; } \
    else xcd_barrier(xbar); asm volatile("" ::: "memory"); } while (0)
#define REP(n) for (int rep_ = 0; rep_ < ((n) == DBL_PHASE ? 2 : 1); ++rep_)
  REP(0) phase_prep(p, bid, G, lds);
  PHASE_SEP();
#if MEGA_STOP == 1
  return;
#endif
  REP(1) phase_lnmod(p, bid, G);
  PHASE_SEP();
#if MEGA_STOP == 2
  return;
#endif
  REP(2) { g8::DenseOrder S; S.init(T, N_INP, 1024, ws + WS_WIN, G, bid);
    EpiIn E{(bf16_t*)(ws + WS_QKPRE), (bf16_t*)(ws + WS_VM), (bf16_t*)(ws + WS_H), (bf16_t*)(ws + WS_CQ), (bf16_t*)(ws + WS_CKV), (unsigned char*)(ws + WS_KN), (float*)(ws + WS_GATES),
            (float*)(ws + WS_SSQQ), (float*)(ws + WS_SSQKV), (const float*)(ws + WS_ROPE), karg<A_GATEB>()};
    g8::gemm_phase(lds, (const char*)(ws + WS_U), 1024, S, E);
    { const int first = S.nwg % G, nb = G - first;
      if (bid >= first) { const int tid = tid_fresh(), lane = tid & 63, wave = __builtin_amdgcn_readfirstlane(tid >> 6);
        prep_items(PREP_ITEMS - PREP_DEFER + (bid - first) * 8 + wave, PREP_ITEMS, nb * 8, lane, ws, (LAS float*)(lds + wave * 16384)); } } }
  PHASE_SEP();
#if MEGA_STOP == 3
  return;
#endif
  const bool mfirst = ((bid >> 3) & 1) != 0;
  if (mfirst) { for (int u = bid; u < 1024; u += G) { const int c = u & 127, bh = u >> 7; mlstmA_unit(p, bh >> 2, bh & 3, c, lds); } __syncthreads(); }
  { g8::DenseOrder S; S.init(T, 768, 384, ws + WS_WUQ, G, bid); EpiUQ E{(unsigned char*)(ws + WS_QATT), (const float*)(ws + WS_SSQQ), (const float*)(ws + WS_ROPE)};
    g8::gemm_phase(lds, (const char*)(ws + WS_CQ), 384, S, E); }
  __syncthreads();
  { g8::DenseOrder S; S.init(T, 1024, 256, ws + WS_WUKV, G, bid); EpiUKV E{(unsigned char*)(ws + WS_KN), (unsigned char*)(ws + WS_VA), (const float*)(ws + WS_SSQKV)};
    g8::gemm_phase(lds, (const char*)(ws + WS_CKV), 256, S, E); }
  __syncthreads();
  if (!mfirst) { for (int u = bid; u < 1024; u += G) { const int c = u & 127, bh = u >> 7; mlstmA_unit(p, bh >> 2, bh & 3, c, lds); } }
  PHASE_SEP();
#if MEGA_STOP == 4
  return;
#endif
  phase_scan(p, bid, G);
  REP(4) phase_attn(p, bid, G, lds);
  PHASE_SEP();
#if MEGA_STOP == 5
  return;
#endif
#if DBL_PHASE == 5
  for (int u = bid; u < 1024; u += G) { const int c = u & 127, bh = u >> 7; mlstmC_unit<true>(p, bh >> 2, bh & 3, c, lds); }
#endif
#if DBL_PHASE == 55
  phase_hanorm<true>(p, bid, G);
#endif
  for (int u = bid; u < 1024; u += G) { const int c = u & 127, bh = u >> 7; mlstmC_unit(p, bh >> 2, bh & 3, c, lds); }
  phase_hanorm(p, bid, G);
  PHASE_SEP();
#if MEGA_STOP == 6
  return;
#endif
  REP(6) { g8::DenseOrder S; S.init(T, 1024, 1024, ws + WS_WOUT, G, bid); EpiOut E{karg<A_X>(), (const float*)(ws + WS_MOD), (bf16_t*)p.out};
    g8::gemm_phase(lds, (const char*)(ws + WS_H), 1024, S, E); }
  PHASE_SEP();
#if MEGA_STOP == 7
  return;
#endif
#if DBL_PHASE == 7
  phase_route<true>(p, bid, G, lds);
#endif
  phase_route(p, bid, G, lds);
  PHASE_SEP();
#if MEGA_STOP == 8
  return;
#endif
  moe_table(p, lds);
  REP(8) { MoeOrderGU S; S.tstart = (const LAS int*)(lds + MOE_TS); S.cnt = (const int*)(ws + WS_CNT); S.G = G; S.c = bid; S.ltok = (const int*)(ws + WS_LTOK); S.Bt = (const char*)(ws + WS_WGU);
    EpiGU E{(bf16_t*)(ws + WS_HDN)};
    g8::gemm_phase(lds, (const char*)(ws + WS_U), 1024, S, E); }
  PHASE_SEP();
#if MEGA_STOP == 9
  return;
#endif
  REP(9) { MoeOrderDN S; S.tstart = (const LAS int*)(lds + MOE_TS); S.cnt = (const int*)(ws + WS_CNT); S.G = G; S.c = bid; S.Bt = (const char*)(ws + WS_WDN);
    EpiDN E{(bf16_t*)(ws + WS_YBUF), (const float*)(ws + WS_LW)};
    g8::gemm_phase(lds, (const char*)(ws + WS_HDN), 512, S, E); }
  PHASE_SEP();
#if MEGA_STOP == 10
  return;
#endif
#if DBL_PHASE == 10
  phase_final<true>(p, bid, G, lds);
#endif
  phase_final(p, bid, G, lds);
#undef REP
#undef PHASE_SEP
}

#ifdef PROBE_OFF
__global__ void __launch_bounds__(NTHREADS, 2) k_probe(Params p, size_t off, size_t n, int is_f32, int from_out) {
  const unsigned char* base = from_out ? (const unsigned char*)p.out : p.ws + off;
  for (size_t i = (size_t)blockIdx.x * NTHREADS + threadIdx.x; i < (size_t)T * D; i += (size_t)gridDim.x * NTHREADS) {
    const size_t j = i % n; float v = is_f32 ? ((const float*)base)[j] : bf2f(((const unsigned short*)base)[j]);
    if (!(fabsf(v) < 1e30f)) v = 777.f;
    if (from_out) { if (j != i) break; ((float*)p.out)[i] = v; } else p.out[i] = v;
  }
}
#endif
extern "C" void kernel_launch(void* const* d_in, const int* in_sizes, int n_in, void* d_out, int out_size, void* d_ws, size_t ws_size, hipStream_t stream) {
  static int ok = 0, grid = 256;
  typedef void (*kfn)(Params);
#ifndef MULTI_LAUNCH
  const kfn kernels[] = {k_mega};
#else
  const kfn kernels[] = {k_prep, k_lnmod, k_inproj, k_mid1, k_mid2, k_mid3, k_scan_attn, k_mlstm_out, k_outproj, k_route, k_moe_gu, k_moe_dn, k_final};
#endif
  if (ok == 0) {
    if (n_in != 27 || in_sizes[0] != T * D || out_size != T * D || ws_size < WS_END) { fprintf(stderr, "kernel_launch: unexpected shapes (n_in %d, in0 %d, out %d, ws %zu)\n", n_in, n_in > 0 ? in_sizes[0] : -1, out_size, ws_size); ok = -1; return; }
    for (kfn k : kernels) if (hipFuncSetAttribute((const void*)k, hipFuncAttributeMaxDynamicSharedMemorySize, LDS_BYTES) != hipSuccess) { fprintf(stderr, "kernel_launch: hipFuncSetAttribute failed\n"); ok = -1; return; }
    int dev = 0, cus = 0, per_cu = 0;
    if (hipGetDevice(&dev) != hipSuccess || hipDeviceGetAttribute(&cus, hipDeviceAttributeMultiprocessorCount, dev) != hipSuccess) { fprintf(stderr, "kernel_launch: device query failed\n"); ok = -1; return; }
    if (hipOccupancyMaxActiveBlocksPerMultiprocessor(&per_cu, (const void*)kernels[0], NTHREADS, LDS_BYTES) != hipSuccess || per_cu < 1) { fprintf(stderr, "kernel_launch: occupancy query says %d blocks/CU\n", per_cu); (void)hipGetLastError(); per_cu = 1; }
    grid = cus < 256 ? cus : 256;
    fprintf(stderr, "kernel_launch: %d CUs, %d blocks/CU by the occupancy query, grid %d\n", cus, per_cu, grid);
    ok = 1;
  }
  if (ok < 0) return;
  Params p{};
  p.x = (const float*)d_in[0]; p.c = (const float*)d_in[1]; p.pos = (const int*)d_in[2]; p.w_ada = (const float*)d_in[3]; p.b_ada = (const float*)d_in[4]; p.w_in = (const float*)d_in[5];
  p.conv_w = (const float*)d_in[6]; p.conv_b = (const float*)d_in[7]; p.gate_b = (const float*)d_in[8]; p.mh_g = (const float*)d_in[9]; p.qn_g = (const float*)d_in[10]; p.kvn_g = (const float*)d_in[11];
  p.w_uq = (const float*)d_in[12]; p.w_ukv = (const float*)d_in[13]; p.an_g = (const float*)d_in[14]; p.w_out = (const float*)d_in[15]; p.ln1_g = (const float*)d_in[16]; p.ln1_b = (const float*)d_in[17];
  p.w_rg = (const float*)d_in[18]; p.b_rg = (const float*)d_in[19]; p.w_re = (const float*)d_in[20]; p.b_re = (const float*)d_in[21]; p.w_gate = (const float*)d_in[22]; p.w_up = (const float*)d_in[23];
  p.w_down = (const float*)d_in[24]; p.ln2_g = (const float*)d_in[25]; p.ln2_b = (const float*)d_in[26];
  p.out = (float*)d_out; p.ws = (unsigned char*)d_ws;
#ifndef NKERN
#define NKERN 6
#endif
  { int ik = 0; for (kfn k : kernels) { if (ik++ >= NKERN) break; hipLaunchKernelGGL(k, dim3(grid), dim3(NTHREADS), LDS_BYTES, stream, p); } }
#ifdef PROBE_OFF
  hipLaunchKernelGGL(k_probe, dim3(1024), dim3(NTHREADS), 0, stream, p, (size_t)(PROBE_OFF), (size_t)(PROBE_N), PROBE_F32, 0);
#endif
  const hipError_t le = hipPeekAtLastError();
  if (le != hipSuccess) fprintf(stderr, "kernel_launch: launch failed: %s\n", hipGetErrorName(le));
}
```

```cpp
#define NKERN 99
#ifndef MEGA_STOP
#define MEGA_STOP 0
#endif
#ifndef DBL_PHASE
#define DBL_PHASE -1
#endif
#include <hip/hip_runtime.h>
#include <cstdio>
#include <cstdint>
#include <cmath>

#define DI __device__ __forceinline__
#define LAS __attribute__((address_space(3)))
typedef unsigned short bf16_t;
typedef short bf16x8 __attribute__((ext_vector_type(8)));
typedef short s16x4 __attribute__((ext_vector_type(4)));
typedef float f32x4 __attribute__((ext_vector_type(4)));
typedef float f32x2 __attribute__((ext_vector_type(2)));
typedef float f32x16 __attribute__((ext_vector_type(16)));
typedef unsigned u32x4 __attribute__((ext_vector_type(4)));
typedef unsigned u32x2 __attribute__((ext_vector_type(2)));

constexpr int BATCH = 2, SEQ = 16384, T = BATCH * SEQ, D = 1024;
constexpr int NCH = SEQ / 128;
constexpr int N_IN = 2768, N_INP = 2816;
constexpr int NEXP = 32;
constexpr float LN_EPS = 1e-5f, RMS_EPS = 1e-6f;
constexpr float ALPHA = 1.189207115002721f;
constexpr float LOG2E = 1.4426950408889634f;
constexpr float QSCALE = 0.07216878364870323f * LOG2E * 16.f;
constexpr int NTHREADS = 512;
constexpr int LDS_BYTES = 148 * 1024;

constexpr size_t MiB = 1u << 20;
constexpr size_t WS_WIN = 0, WS_WUQ = 6 * MiB, WS_WUKV = 7 * MiB, WS_WOUT = 8 * MiB, WS_WGU = 10 * MiB, WS_WDN = 74 * MiB;
constexpr size_t WS_MOD = 106 * MiB, WS_CNT = 106 * MiB + 65536, WS_ROPE = 107 * MiB, WS_GATES = 115 * MiB, WS_GVEC = 117 * MiB;
constexpr size_t WS_SSQQ = 120 * MiB, WS_SSQKV = 122 * MiB, WS_NVEC = 123 * MiB, WS_SCAL = 124 * MiB, WS_TOKE = 125 * MiB, WS_TOKP = 125 * MiB + 512 * 1024;
constexpr size_t WS_U = 128 * MiB, WS_H = 192 * MiB, WS_QKPRE = 256 * MiB, WS_VM = 320 * MiB, WS_CQ = 352 * MiB, WS_CKV = 376 * MiB;
constexpr size_t WS_KROPE = 392 * MiB, WS_QATT = 396 * MiB, WS_KN = 444 * MiB, WS_VA = 476 * MiB, WS_END = 512 * MiB;
constexpr size_t WS_BAR = 106 * MiB + 131072, CTL_ZERO_OFF = WS_CNT, CTL_ZERO_BYTES = 131072;
constexpr int LDS_BARST = LDS_BYTES - 256;
constexpr size_t WS_LTOK = 256 * MiB, WS_LW = 260 * MiB, WS_HDN = 264 * MiB, WS_YBUF = 336 * MiB;
constexpr int MAXTILES = 288;
constexpr int CNT_STRIDE = 64;
constexpr size_t WS_WRT = 126 * MiB;

struct Params {
  const float* x; const float* c; const int* pos; const float* w_ada; const float* b_ada; const float* w_in; const float* conv_w; const float* conv_b;
  const float* gate_b; const float* mh_g; const float* qn_g; const float* kvn_g; const float* w_uq; const float* w_ukv; const float* an_g; const float* w_out;
  const float* ln1_g; const float* ln1_b; const float* w_rg; const float* b_rg; const float* w_re; const float* b_re; const float* w_gate; const float* w_up;
  const float* w_down; const float* ln2_g; const float* ln2_b;
  float* out; unsigned char* ws;
};

enum { A_X = 0, A_C, A_POS, A_WADA, A_BADA, A_WIN, A_CONVW, A_CONVB, A_GATEB, A_MHG, A_QNG, A_KVNG, A_WUQ, A_WUKV, A_ANG, A_WOUT, A_LN1G, A_LN1B, A_WRG, A_BRG, A_WRE, A_BRE,
       A_WGATE, A_WUP, A_WDOWN, A_LN2G, A_LN2B, A_OUT, A_WS };
template <int IDX, class Tp = const float> __device__ __forceinline__ Tp* karg() {
  const unsigned long long k = (unsigned long long)__builtin_amdgcn_kernarg_segment_ptr();
  unsigned long long v;
  asm volatile("s_load_dwordx2 %0, %1, %2\n\ts_waitcnt lgkmcnt(0)" : "=s"(v) : "s"(k), "i"(IDX * 8) : "memory");
  return (Tp*)v;
}
struct Ctx { unsigned char* ws; float* out; };
DI unsigned cvtpk(float lo, float hi) { unsigned r; asm volatile("v_cvt_pk_bf16_f32 %0, %1, %2" : "=v"(r) : "v"(lo), "v"(hi)); return r; }
DI unsigned short f2bf(float f) { unsigned u = __float_as_uint(f); return (unsigned short)((u + 0x7fffu + ((u >> 16) & 1u)) >> 16); }
typedef int v8i __attribute__((ext_vector_type(8)));
typedef int v4i_ __attribute__((ext_vector_type(4)));
DI u32x2 cvt8(f32x4 a, f32x4 b) {
  int w0 = __builtin_amdgcn_cvt_pk_fp8_f32(a[0], a[1], 0, false); w0 = __builtin_amdgcn_cvt_pk_fp8_f32(a[2], a[3], w0, true);
  int w1 = __builtin_amdgcn_cvt_pk_fp8_f32(b[0], b[1], 0, false); w1 = __builtin_amdgcn_cvt_pk_fp8_f32(b[2], b[3], w1, true);
  return (u32x2){(unsigned)w0, (unsigned)w1};
}
DI float bf2f(unsigned short v) { return __uint_as_float(((unsigned)v) << 16); }
DI float bflo(unsigned w) { return __uint_as_float(w << 16); }
DI float bfhi(unsigned w) { return __uint_as_float(w & 0xffff0000u); }
DI int tid_fresh() { int t = threadIdx.x; asm volatile("" : "+v"(t)); return t; }
DI float wave_sum(float v) {
#pragma unroll
  for (int o = 1; o < 64; o <<= 1) v += __shfl_xor(v, o);
  return v;
}
DI float sigmoidf_(float x) { return 1.f / (1.f + __expf(-x)); }
DI float siluf_(float x) { return x / (1.f + __expf(-x)); }
DI float logsigmoidf_(float x) { return fminf(x, 0.f) - log1pf(__expf(-fabsf(x))); }
DI int crow(int r, int hi) { return (r & 3) + 8 * (r >> 2) + 4 * hi; }
#define SBAR() __builtin_amdgcn_sched_barrier(0)
#define KSWZ(row, colB) ((row) * 256 + ((colB) ^ (((row) & 15) << 4)))
#define KRSWZ(row, colB) ((row) * 128 + ((colB) ^ ((((row) >> 1) & 7) << 4)))
#define MFMA32(a, b, c) __builtin_amdgcn_mfma_f32_32x32x16_bf16((a), (b), (c), 0, 0, 0)

DI int v_st(int k, int c) { const int kk = (k & ~0xC) | ((k & 4) << 1) | ((k & 8) >> 1); return ((kk >> 3) * 4 + (c >> 5)) * 512 + ((kk & 7) * 32 + (c & 31)) * 2; }
DI int v_rd_base(int lane) { return ((lane & 3) << 3) | (((lane >> 2) & 3) << 6) | (((lane >> 4) & 1) << 5) | (((lane >> 5) & 1) << 8); }
constexpr int v_rd_off(int d0, int ks, int half) { return d0 * 512 + ks * 4096 + half * 2048; }
template <int OFF> DI s16x4 tr_read(int vb) {
  s16x4 r; asm volatile("ds_read_b64_tr_b16 %0, %1 offset:%2" : "=&v"(r) : "v"(vb), "i"(OFF) : "memory"); return r;
}
#define PKLH(L, H) (bf16x8){L[0], L[1], L[2], L[3], H[0], H[1], H[2], H[3]}
template <int KS> DI bf16x8 tr_frag_nowait(int vb, s16x4& l, s16x4& h) { l = tr_read<v_rd_off(0, KS, 0)>(vb); h = tr_read<v_rd_off(0, KS, 1)>(vb); return PKLH(l, h); }
template <int D0> DI void pv_one(f32x16& od, int vb, bf16x8 pa0, bf16x8 pa1, bf16x8 pa2, bf16x8 pa3) {
  const s16x4 l0 = tr_read<v_rd_off(D0, 0, 0)>(vb), h0 = tr_read<v_rd_off(D0, 0, 1)>(vb), l1 = tr_read<v_rd_off(D0, 1, 0)>(vb), h1 = tr_read<v_rd_off(D0, 1, 1)>(vb);
  const s16x4 l2 = tr_read<v_rd_off(D0, 2, 0)>(vb), h2 = tr_read<v_rd_off(D0, 2, 1)>(vb), l3 = tr_read<v_rd_off(D0, 3, 0)>(vb), h3 = tr_read<v_rd_off(D0, 3, 1)>(vb);
  asm volatile("s_waitcnt lgkmcnt(0)" ::: "memory"); SBAR();
  od = MFMA32(pa0, PKLH(l0, h0), od); od = MFMA32(pa1, PKLH(l1, h1), od); od = MFMA32(pa2, PKLH(l2, h2), od); od = MFMA32(pa3, PKLH(l3, h3), od);
}
DI void pv_d0(f32x16* o, int vb, bf16x8 pa0, bf16x8 pa1, bf16x8 pa2, bf16x8 pa3) {
  pv_one<0>(o[0], vb, pa0, pa1, pa2, pa3); pv_one<1>(o[1], vb, pa0, pa1, pa2, pa3); pv_one<2>(o[2], vb, pa0, pa1, pa2, pa3); pv_one<3>(o[3], vb, pa0, pa1, pa2, pa3);
}
DI void pack_p(const f32x16& p0, const f32x16& p1, bf16x8& pa0, bf16x8& pa1, bf16x8& pa2, bf16x8& pa3) {
#define PK4(P, BASE, OUT) do { unsigned a0 = cvtpk(P[BASE + 0], P[BASE + 1]), a1 = cvtpk(P[BASE + 2], P[BASE + 3]);   \
    unsigned b0 = cvtpk(P[BASE + 4], P[BASE + 5]), b1 = cvtpk(P[BASE + 6], P[BASE + 7]);                              \
    auto r0 = __builtin_amdgcn_permlane32_swap(a0, b0, false, false); auto r1 = __builtin_amdgcn_permlane32_swap(a1, b1, false, false); \
    u32x4 w = {r0[0], r1[0], r0[1], r1[1]}; OUT = *reinterpret_cast<bf16x8*>(&w); } while (0)
  PK4(p0, 0, pa0); PK4(p0, 8, pa1); PK4(p1, 0, pa2); PK4(p1, 8, pa3);
#undef PK4
}
DI float half_swap_sum(float v) { auto rr = __builtin_amdgcn_permlane32_swap(__float_as_uint(v), __float_as_uint(v), false, false); return __uint_as_float(rr[0]) + __uint_as_float(rr[1]); }
DI float half_swap_max(float v) { auto rr = __builtin_amdgcn_permlane32_swap(__float_as_uint(v), __float_as_uint(v), false, false); return fmaxf(__uint_as_float(rr[0]), __uint_as_float(rr[1])); }

namespace g8 {
constexpr int BM = 256, BK = 64, HALF = 128, HTB = HALF * BK * 2, STAGE_BYTES = 8 * HTB;
DI int lds_byte(int r, int c) { const int st = (r >> 4) * 2 + (c >> 5), rr = r & 15, cc = c & 31, ob = rr * 64 + cc * 2; return st * 1024 + (ob ^ (((ob >> 9) & 1) << 5)); }
DI void stage_rc(int b, int& R, int& C) { const int st = b / 1024, sb = b % 1024, swz = sb ^ (((sb >> 9) & 1) << 5); R = (st >> 1) * 16 + swz / 64; C = (st & 1) * 32 + (swz % 64) / 2; }
DI int perm32(int rho) { const int n = rho >> 4, i = rho & 15; return 8 * (i >> 2) + 4 * n + (i & 3); }
struct Unit { int pm, pn, e, j; };

template <class Epi, class Sched>
DI void gemm_phase(LAS unsigned char* lds, const char* Abase, const int Kc, const Sched& S, const Epi& E) {
  constexpr bool GATHER = Sched::GATHER, FP8 = Epi::FP8; constexpr int NBJ = Epi::NBJ;
  int K = Kc; asm volatile("" : "+s"(K));
  const int tid = tid_fresh(), wid = __builtin_amdgcn_readfirstlane(tid >> 6), lane = tid & 63, wr = wid >> 2, wc = wid & 3, fr = lane & 15, fq = lane >> 4;
  const int nt = K / BK;
  unsigned voffA[2], voffB[2];
#pragma unroll
  for (int i = 0; i < 2; ++i) { int R, C; stage_rc(tid * 16 + i * 8192, R, C); const int Rb = Epi::PERM ? ((R & ~31) + perm32(R & 31)) : R; voffA[i] = (unsigned)(R * K + C) * 2u; voffB[i] = (unsigned)(Rb * K + C) * 2u; }
  const size_t kstep = (size_t)(BK * 2);
  const size_t hstepB = (size_t)HALF * K * 2;
  const unsigned ldsw = (unsigned)wid * 1024u;
  const int aoff = lds_byte(wr * 64 + fr, fq * 8), boff = lds_byte(wc * 32 + fr, fq * 8);
#define G8_SA(b, h) (((b) * 2 + (h)) * HTB)
#define G8_SB(b, h) ((4 + (b) * 2 + (h)) * HTB)
#define G8_STAGEB(bufoff, gptr) do { _Pragma("unroll") for (int _i = 0; _i < 2; ++_i) \
    __builtin_amdgcn_global_load_lds((const unsigned*)((const char*)(gptr) + voffB[_i]), (LAS unsigned*)(lds + (bufoff) + ldsw + _i * 8192), 16, 0, 0); } while (0)
#define G8_STAGEA(bufoff, kb, NXT, h) do { _Pragma("unroll") for (int _i = 0; _i < 2; ++_i) { const char* _src; \
    if constexpr (GATHER) _src = Abase + (size_t)(kb) + (size_t)((NXT) ? o2[h][_i] : cuA[h][_i]); else _src = ((NXT) ? a2b : cA) + (size_t)(kb) + (size_t)(h) * hstepB + voffA[_i]; \
    __builtin_amdgcn_global_load_lds((const unsigned*)_src, (LAS unsigned*)(lds + (bufoff) + ldsw + _i * 8192), 16, 0, 0); } } while (0)
#define G8_LD8(ptr) __builtin_shufflevector(*(const LAS v4i_*)(ptr), *(const LAS v4i_*)((ptr) + 1024), 0, 1, 2, 3, 4, 5, 6, 7)
#define G8_LDA(dst, b, h) do { if constexpr (FP8) { _Pragma("unroll") for (int m = 0; m < 4; ++m) dst##8[m] = G8_LD8(lds + G8_SA(b, h) + aoff + m * 2048); } \
    else { _Pragma("unroll") for (int m = 0; m < 4; ++m) _Pragma("unroll") for (int k = 0; k < 2; ++k) dst[m][k] = *(const LAS bf16x8*)(lds + G8_SA(b, h) + aoff + m * 2048 + k * 1024); } } while (0)
#define G8_LDB(dst, b, h) do { if constexpr (FP8) { _Pragma("unroll") for (int n = 0; n < 2; ++n) dst##8[n] = G8_LD8(lds + G8_SB(b, h) + boff + n * 2048); } \
    else { _Pragma("unroll") for (int n = 0; n < 2; ++n) _Pragma("unroll") for (int k = 0; k < 2; ++k) dst[n][k] = *(const LAS bf16x8*)(lds + G8_SB(b, h) + boff + n * 2048 + k * 1024); } } while (0)
#define G8_MMA(ai, bj, At, Bt) do { __builtin_amdgcn_s_setprio(1); \
    if constexpr (FP8) { _Pragma("unroll") for (int m = 0; m < 4; ++m) _Pragma("unroll") for (int n = 0; n < 2; ++n) \
        acc[ai][bj][m][n] = __builtin_amdgcn_mfma_scale_f32_16x16x128_f8f6f4(Bt##8[n], At##8[m], acc[ai][bj][m][n], 0, 0, 0, 122, 0, Epi::ASCALE); } \
    else { _Pragma("unroll") for (int m = 0; m < 4; ++m) _Pragma("unroll") for (int n = 0; n < 2; ++n) _Pragma("unroll") for (int k = 0; k < 2; ++k) \
        acc[ai][bj][m][n] = __builtin_amdgcn_mfma_f32_16x16x32_bf16(Bt[n][k], At[m][k], acc[ai][bj][m][n], 0, 0, 0); } \
    __builtin_amdgcn_s_setprio(0); } while (0)
#define G8_WAIT_V(n) asm volatile("s_waitcnt vmcnt(" #n ")" ::: "memory")
#define G8_WAIT_M do { if constexpr (NBJ == 2) G8_WAIT_V(8); else G8_WAIT_V(6); } while (0)
#define G8_WAIT_L(n) asm volatile("s_waitcnt lgkmcnt(" #n ")" ::: "memory")
#define G8_BAR __builtin_amdgcn_s_barrier()
#define G8_SCHED __builtin_amdgcn_sched_barrier(0)
#define G8_GOFF(dst, u) do { _Pragma("unroll") for (int _i = 0; _i < 2; ++_i) { int _R, _C; stage_rc(tid * 16 + _i * 8192, _R, _C); \
    _Pragma("unroll") for (int _h = 0; _h < 2; ++_h) dst[_h][_i] = S.a_off(u, _R + 128 * _h) + (unsigned)_C * 2u; } } while (0)
  Unit cur, nxt; int ui = 0;
  if (!S.next(0, cur)) return;
  f32x4 acc[2][NBJ][4][2];
#pragma unroll
  for (int a = 0; a < 2; ++a)
#pragma unroll
    for (int b = 0; b < NBJ; ++b)
#pragma unroll
      for (int m = 0; m < 4; ++m)
#pragma unroll
        for (int n = 0; n < 2; ++n) acc[a][b][m][n] = (f32x4){0.f, 0.f, 0.f, 0.f};
  bf16x8 At[4][2], B0[2][2], B1[2][2]; v8i At8[4], B08[2], B18[2]; (void)At; (void)B0; (void)B1; (void)At8; (void)B08; (void)B18;
  unsigned cuA[2][2], nxA[2][2], o2[2][2];
  const char* cA = Abase; const char* nA = Abase; const char* a2b = Abase;
  if constexpr (GATHER) { G8_GOFF(cuA, cur); } else { cA = Abase + S.a_off(cur, 0); }
  const char* cB = S.b_base(cur);
  (void)voffA; (void)nxA; (void)o2; (void)nA; (void)a2b;
  G8_STAGEB(G8_SB(0, 0), cB); if constexpr (NBJ == 2) G8_STAGEB(G8_SB(0, 1), cB + hstepB); G8_STAGEA(G8_SA(0, 0), 0, false, 0); G8_STAGEA(G8_SA(0, 1), 0, false, 1);
  if (wr == 1) G8_BAR;
  G8_WAIT_V(2); G8_BAR;
  G8_STAGEB(G8_SB(1, 0), cB + kstep); G8_STAGEA(G8_SA(1, 0), kstep, false, 0); if constexpr (NBJ == 2) G8_STAGEB(G8_SB(1, 1), cB + hstepB + kstep);
  if constexpr (NBJ == 2) G8_WAIT_V(6); else G8_WAIT_V(4);
  G8_BAR;
  for (;;) {
    const bool has_next = S.next(ui + 1, nxt);
    const char* nB = cB;
    if (has_next) {
      nB = S.b_base(nxt);
      if constexpr (GATHER) { G8_GOFF(nxA, nxt); } else { nA = Abase + S.a_off(nxt, 0); }
    } else {
      if constexpr (GATHER) {
#pragma unroll
        for (int h = 0; h < 2; ++h)
#pragma unroll
          for (int i = 0; i < 2; ++i) nxA[h][i] = cuA[h][i];
      } else nA = cA;
    }
    for (int t = 0; t < nt; t += 2) {
      const bool last = (t == nt - 2);
      const size_t k1 = (size_t)(t + 1) * kstep;
      const size_t k2 = last ? 0 : (size_t)(t + 2) * kstep, k3 = k2 + kstep;
      if constexpr (GATHER) {
#pragma unroll
        for (int h = 0; h < 2; ++h)
#pragma unroll
          for (int i = 0; i < 2; ++i) o2[h][i] = last ? nxA[h][i] : cuA[h][i];
      } else a2b = last ? nA : cA;
      const char* b2 = last ? nB : cB + (size_t)(t + 2) * kstep; const char* b3 = b2 + kstep;
      G8_LDB(B0, 0, 0); if constexpr (NBJ == 2) G8_LDB(B1, 0, 1); G8_SCHED; G8_LDA(At, 0, 0); G8_STAGEA(G8_SA(1, 1), k1, false, 1);
      G8_WAIT_M; G8_WAIT_L(0); G8_BAR; G8_MMA(0, 0, At, B0); if constexpr (NBJ == 2) G8_MMA(0, 1, At, B1); G8_BAR; G8_SCHED;
      G8_LDA(At, 0, 1); G8_STAGEB(G8_SB(0, 0), b2); if constexpr (NBJ == 2) G8_STAGEB(G8_SB(0, 1), b2 + hstepB); G8_STAGEA(G8_SA(0, 0), k2, true, 0);
      G8_WAIT_M; G8_WAIT_L(0); G8_BAR; G8_MMA(1, 0, At, B0); if constexpr (NBJ == 2) G8_MMA(1, 1, At, B1); G8_BAR; G8_SCHED;
      G8_LDB(B0, 1, 0); if constexpr (NBJ == 2) G8_LDB(B1, 1, 1); G8_SCHED; G8_LDA(At, 1, 0); G8_STAGEA(G8_SA(0, 1), k2, true, 1);
      G8_WAIT_M; G8_WAIT_L(0); G8_BAR; G8_MMA(0, 0, At, B0); if constexpr (NBJ == 2) G8_MMA(0, 1, At, B1); G8_BAR; G8_SCHED;
      G8_LDA(At, 1, 1); G8_STAGEB(G8_SB(1, 0), b3); if constexpr (NBJ == 2) G8_STAGEB(G8_SB(1, 1), b3 + hstepB); G8_STAGEA(G8_SA(1, 0), k3, true, 0);
      G8_WAIT_M; G8_WAIT_L(0); G8_BAR; G8_MMA(1, 0, At, B0); if constexpr (NBJ == 2) G8_MMA(1, 1, At, B1); G8_BAR; G8_SCHED;
    }
    if (wr == 0) G8_BAR;
    G8_SCHED; asm volatile("s_nop 15\n\ts_nop 7" ::: "memory"); G8_SCHED;
    E(acc, cur, wr, wc, fr, fq);
    if (!has_next) break;
#pragma unroll
    for (int a = 0; a < 2; ++a)
#pragma unroll
      for (int b = 0; b < NBJ; ++b)
#pragma unroll
        for (int m = 0; m < 4; ++m)
#pragma unroll
          for (int n = 0; n < 2; ++n) acc[a][b][m][n] = (f32x4){0.f, 0.f, 0.f, 0.f};
    cur = nxt; cB = nB; ++ui;
    if constexpr (GATHER) {
#pragma unroll
      for (int h = 0; h < 2; ++h)
#pragma unroll
        for (int i = 0; i < 2; ++i) cuA[h][i] = nxA[h][i];
    } else cA = nA;
    if (wr == 1) G8_BAR;
  }
  G8_WAIT_V(0);
  G8_BAR;
#undef G8_SA
#undef G8_SB
#undef G8_STAGEA
#undef G8_STAGEB
#undef G8_LDA
#undef G8_LD8
#undef G8_WAIT_M
#undef G8_LDB
#undef G8_MMA
#undef G8_WAIT_V
#undef G8_WAIT_L
#undef G8_BAR
#undef G8_SCHED
#undef G8_GOFF
}

struct DenseOrder {
  static constexpr bool GATHER = false;
  int nM, nN, nwg, G, c, K; const char* Bt;
  DI void init(int M, int N, int K_, const void* Bt_, int G_, int c_) { nM = M / BM; nN = N / BM; nwg = nM * nN; G = G_; c = c_; K = K_; Bt = (const char*)Bt_; }
  DI bool next(int i, Unit& u) const {
    const long L = (long)i * G + c; if (L >= nwg) return false;
    int wgid = (int)L; { const int q = nwg / 8, r = nwg % 8, xcd = wgid % 8, off = wgid / 8; wgid = (xcd < r ? xcd * (q + 1) : r * (q + 1) + (xcd - r) * q) + off; }
    const int nig = 8 * nN, gid = wgid / nig, fm = gid * 8, gsz = (nM - fm) < 8 ? (nM - fm) : 8;
    u.pm = fm + ((wgid % nig) % gsz); u.pn = (wgid % nig) / gsz; u.e = 0; u.j = 0; return true;
  }
  DI unsigned a_off(const Unit& u, int R) const { return (unsigned)(u.pm * BM + R) * (unsigned)(K * 2); }
  DI const char* b_base(const Unit& u) const { return Bt + (size_t)u.pn * BM * K * 2; }
};
}
using g8::Unit;

struct EpiIn {
  static constexpr bool PERM = true, FP8 = false; static constexpr int NBJ = 2;
  bf16_t* qkpre; bf16_t* vm; bf16_t* hcat; bf16_t* cq; bf16_t* ckv; unsigned char* krope  ; float* gates; float* ssq_q; float* ssq_kv; const float* rope; const float* gate_b;
  DI void operator()(const f32x4 (&acc)[2][2][4][2], const Unit& u, int wr, int wc, int fr, int fq) const {
#pragma unroll
    for (int bj = 0; bj < 2; ++bj) {
      const int cw = u.pn * 256 + bj * 128 + wc * 32, c0 = cw + 8 * fq;
#pragma unroll
      for (int ai = 0; ai < 2; ++ai)
#pragma unroll
        for (int m = 0; m < 4; ++m) {
          const int row = u.pm * 256 + ai * 128 + wr * 64 + m * 16 + fr;
          const f32x4 v0 = acc[ai][bj][m][0], v1 = acc[ai][bj][m][1];
          if (cw < 1024) { u32x4 w = {cvtpk(v0[0], v0[1]), cvtpk(v0[2], v0[3]), cvtpk(v1[0], v1[1]), cvtpk(v1[2], v1[3])}; *(u32x4*)(qkpre + (size_t)row * 1024 + c0) = w; }
          else if (cw < 1536) { u32x4 w = {cvtpk(v0[0], v0[1]), cvtpk(v0[2], v0[3]), cvtpk(v1[0], v1[1]), cvtpk(v1[2], v1[3])}; *(u32x4*)(vm + (size_t)row * 512 + (c0 - 1024)) = w; }
          else if (cw < 2048) { u32x4 w = {cvtpk(sigmoidf_(v0[0]), sigmoidf_(v0[1])), cvtpk(sigmoidf_(v0[2]), sigmoidf_(v0[3])), cvtpk(sigmoidf_(v1[0]), sigmoidf_(v1[1])), cvtpk(sigmoidf_(v1[2]), sigmoidf_(v1[3]))};
                                *(u32x4*)(hcat + (size_t)row * 1024 + (c0 - 1536)) = w; }
          else if (cw < 2688) {
            u32x4 w = {cvtpk(v0[0], v0[1]), cvtpk(v0[2], v0[3]), cvtpk(v1[0], v1[1]), cvtpk(v1[2], v1[3])};
            float s = v0[0] * v0[0] + v0[1] * v0[1] + v0[2] * v0[2] + v0[3] * v0[3] + v1[0] * v1[0] + v1[1] * v1[1] + v1[2] * v1[2] + v1[3] * v1[3];
            s += __shfl_xor(s, 16); s += __shfl_xor(s, 32);
            if (cw < 2432) { *(u32x4*)(cq + (size_t)row * 384 + (c0 - 2048)) = w; if (fq == 0) ssq_q[(size_t)row * 12 + ((cw - 2048) >> 5)] = s; }
            else { *(u32x4*)(ckv + (size_t)row * 256 + (c0 - 2432)) = w; if (fq == 0) ssq_kv[(size_t)row * 8 + ((cw - 2432) >> 5)] = s; }
          }
          else if (cw < 2752) {
            const int i0 = (c0 - 2688) >> 1;
            const f32x4 cs0 = *(const f32x4*)(rope + (size_t)row * 64 + 2 * i0), cs1 = *(const f32x4*)(rope + (size_t)row * 64 + 2 * i0 + 4);
            const float a0 = v0[0] * cs0[0] - v0[1] * cs0[1], b0 = v0[1] * cs0[0] + v0[0] * cs0[1];
            const float a1 = v0[2] * cs0[2] - v0[3] * cs0[3], b1 = v0[3] * cs0[2] + v0[2] * cs0[3];
            const float a2 = v1[0] * cs1[0] - v1[1] * cs1[1], b2 = v1[1] * cs1[0] + v1[0] * cs1[1];
            const float a3 = v1[2] * cs1[2] - v1[3] * cs1[3], b3 = v1[3] * cs1[2] + v1[2] * cs1[3];
            const u32x2 w = cvt8((f32x4){a0, b0, a1, b1}, (f32x4){a2, b2, a3, b3});
            const int b_ = row >> 14, s_ = row & (SEQ - 1);
#pragma unroll
            for (int hh = 0; hh < 4; ++hh) *(u32x2*)(krope + ((size_t)(b_ * 4 + hh) * SEQ + s_) * 192 + 128 + (c0 - 2688)) = w;
          }
          else if (cw == 2752) {
            if (fq < 2) { const f32x4 g0 = *(const f32x4*)(gate_b + 8 * fq), g1 = *(const f32x4*)(gate_b + 8 * fq + 4);
              *(f32x4*)(gates + (size_t)row * 16 + 8 * fq) = v0 + g0; *(f32x4*)(gates + (size_t)row * 16 + 8 * fq + 4) = v1 + g1; }
          }
        }
    }
  }
};
struct EpiUQ {
  static constexpr bool PERM = true, FP8 = false; static constexpr int NBJ = 2;
  unsigned char* qatt; const float* ssq_q; const float* rope;
  DI void operator()(const f32x4 (&acc)[2][2][4][2], const Unit& u, int wr, int wc, int fr, int fq) const {
    float rs[2][4];
#pragma unroll
    for (int ai = 0; ai < 2; ++ai)
#pragma unroll
      for (int m = 0; m < 4; ++m) {
        const int row = u.pm * 256 + ai * 128 + wr * 64 + m * 16 + fr;
        const f32x4 q0 = *(const f32x4*)(ssq_q + (size_t)row * 12), q1 = *(const f32x4*)(ssq_q + (size_t)row * 12 + 4), q2 = *(const f32x4*)(ssq_q + (size_t)row * 12 + 8);
        const float ss = (q0[0] + q0[1] + q0[2] + q0[3]) + (q1[0] + q1[1] + q1[2] + q1[3]) + (q2[0] + q2[1] + q2[2] + q2[3]);
        rs[ai][m] = rsqrtf(ss * (1.f / 384.f) + RMS_EPS) * QSCALE;
        asm volatile("" ::: "memory");
      }
#pragma unroll
    for (int bj = 0; bj < 2; ++bj) {
      const int cw = u.pn * 256 + bj * 128 + wc * 32, h = cw / 192, dw = cw - h * 192, d = dw + 8 * fq;
#pragma unroll
      for (int ai = 0; ai < 2; ++ai)
#pragma unroll
        for (int m = 0; m < 4; ++m) {
          const int row = u.pm * 256 + ai * 128 + wr * 64 + m * 16 + fr, b = row >> 14, s = row & (SEQ - 1);
          const f32x4 v0 = acc[ai][bj][m][0] * rs[ai][m], v1 = acc[ai][bj][m][1] * rs[ai][m];
          u32x2 w;
          if (dw < 128) { w = cvt8(v0, v1); }
          else {
            const int i0 = (d - 128) >> 1;
            const f32x4 cs0 = *(const f32x4*)(rope + (size_t)row * 64 + 2 * i0), cs1 = *(const f32x4*)(rope + (size_t)row * 64 + 2 * i0 + 4);
            const float a0 = v0[0] * cs0[0] - v0[1] * cs0[1], b0 = v0[1] * cs0[0] + v0[0] * cs0[1];
            const float a1 = v0[2] * cs0[2] - v0[3] * cs0[3], b1 = v0[3] * cs0[2] + v0[2] * cs0[3];
            const float a2 = v1[0] * cs1[0] - v1[1] * cs1[1], b2 = v1[1] * cs1[0] + v1[0] * cs1[1];
            const float a3 = v1[2] * cs1[2] - v1[3] * cs1[3], b3 = v1[3] * cs1[2] + v1[2] * cs1[3];
            w = cvt8((f32x4){a0, b0, a1, b1}, (f32x4){a2, b2, a3, b3});
          }
          *(u32x2*)(qatt + ((size_t)(b * 4 + h) * SEQ + s) * 192 + d) = w;
          asm volatile("" ::: "memory");
        }
    }
  }
};
struct EpiUKV {
  static constexpr bool PERM = true, FP8 = false; static constexpr int NBJ = 2;
  unsigned char* kn; unsigned char* vt8; const float* ssq_kv;
  DI void operator()(const f32x4 (&acc)[2][2][4][2], const Unit& u, int wr, int wc, int fr, int fq) const {
#pragma unroll
    for (int ai = 0; ai < 2; ++ai)
#pragma unroll
      for (int m = 0; m < 4; ++m) {
        const int row = u.pm * 256 + ai * 128 + wr * 64 + m * 16 + fr, b = row >> 14, s = row & (SEQ - 1);
        const f32x4 q0 = *(const f32x4*)(ssq_kv + (size_t)row * 8), q1 = *(const f32x4*)(ssq_kv + (size_t)row * 8 + 4);
        const float ss = (q0[0] + q0[1] + q0[2] + q0[3]) + (q1[0] + q1[1] + q1[2] + q1[3]);
        const float rs = rsqrtf(ss * (1.f / 256.f) + RMS_EPS);
        { const f32x4 v0 = acc[ai][0][m][0] * rs, v1 = acc[ai][0][m][1] * rs;
          *(u32x2*)(kn + ((size_t)(b * 4 + u.pn) * SEQ + s) * 192 + wc * 32 + 8 * fq) = cvt8(v0, v1); }
        { const f32x4 v0 = acc[ai][1][m][0] * rs, v1 = acc[ai][1][m][1] * rs;
          const u32x2 w = cvt8(v0, v1);
          const int k = s & 63, kq = k & 31, pos = 32 * ((kq >> 2) & 1) + (kq & 3) + 4 * (kq >> 3) + 16 * (k >> 5);
          unsigned char* dst = vt8 + ((size_t)((b * 4 + u.pn) * 256 + (s >> 6)) * 128 + wc * 32 + 8 * fq) * 64 + pos;
          dst[0] = (unsigned char)w[0]; dst[64] = (unsigned char)(w[0] >> 8); dst[128] = (unsigned char)(w[0] >> 16); dst[192] = (unsigned char)(w[0] >> 24);
          dst[256] = (unsigned char)w[1]; dst[320] = (unsigned char)(w[1] >> 8); dst[384] = (unsigned char)(w[1] >> 16); dst[448] = (unsigned char)(w[1] >> 24); }
        asm volatile("" ::: "memory");
      }
  }
};
struct EpiOut {
  static constexpr bool PERM = true, FP8 = false; static constexpr int NBJ = 2;
  const float* x; const float* mod; bf16_t* z;
  DI void operator()(const f32x4 (&acc)[2][2][4][2], const Unit& u, int wr, int wc, int fr, int fq) const {
#pragma unroll
    for (int ai = 0; ai < 2; ++ai)
#pragma unroll
      for (int m = 0; m < 4; ++m) {
        const int row = u.pm * 256 + ai * 128 + wr * 64 + m * 16 + fr, b = row >> 14;
#pragma unroll
        for (int bj = 0; bj < 2; ++bj) {
          const int c = u.pn * 256 + bj * 128 + wc * 32 + 8 * fq;
          const unsigned off = (unsigned)row * 1024u + (unsigned)c;
          const f32x4 x0 = *(const f32x4*)(x + off), x1 = *(const f32x4*)(x + off + 4), g0 = *(const f32x4*)(mod + b * 6144 + 2048 + c), g1 = *(const f32x4*)(mod + b * 6144 + 2048 + c + 4);
          const f32x4 z0 = x0 * ALPHA + (g0 + 1.f) * acc[ai][bj][m][0], z1 = x1 * ALPHA + (g1 + 1.f) * acc[ai][bj][m][1];
          *(u32x4*)(z + off) = (u32x4){cvtpk(z0[0], z0[1]), cvtpk(z0[2], z0[3]), cvtpk(z1[0], z1[1]), cvtpk(z1[2], z1[3])};
        }
        asm volatile("" ::: "memory");
      }
  }
};
struct EpiGU {
  static constexpr bool PERM = true, FP8 = true; static constexpr int NBJ = 1, ASCALE = 127;
  unsigned char* hdn;
  DI void operator()(const f32x4 (&acc)[2][1][4][2], const Unit& u, int wr, int wc, int fr, int fq) const {
    const unsigned base = ((unsigned)u.pm * 256u + wr * 64 + fr) * 512u + (unsigned)((u.pn * 128 + wc * 32 + 8 * fq) >> 1);
#pragma unroll
    for (int ai = 0; ai < 2; ++ai)
#pragma unroll
      for (int m = 0; m < 4; ++m) {
        const f32x4 g = acc[ai][0][m][0], up = acc[ai][0][m][1] * 8.f;
        int w = __builtin_amdgcn_cvt_pk_fp8_f32(siluf_(g[0]) * up[0], siluf_(g[1]) * up[1], 0, false); w = __builtin_amdgcn_cvt_pk_fp8_f32(siluf_(g[2]) * up[2], siluf_(g[3]) * up[3], w, true);
        *(int*)(hdn + (base + (unsigned)((ai * 128 + m * 16) * 512))) = w;
      }
  }
};
struct EpiDN {
  static constexpr bool PERM = true, FP8 = true; static constexpr int NBJ = 1, ASCALE = 124;
  bf16_t* ybuf; const float* lw;
  DI void operator()(const f32x4 (&acc)[2][1][4][2], const Unit& u, int wr, int wc, int fr, int fq) const {
    const unsigned base = ((unsigned)u.pm * 256u + wr * 64 + fr) * 2048u + (unsigned)(u.pn * 128 + wc * 32 + 8 * fq) * 2u;
    const unsigned wbase = ((unsigned)u.e * (unsigned)T + (unsigned)(u.j * 256 + wr * 64 + fr)) * 4u;
#pragma unroll
    for (int ai = 0; ai < 2; ++ai)
#pragma unroll
      for (int m = 0; m < 4; ++m) {
        const float wgt = *(const float*)((const char*)lw + (wbase + (unsigned)((ai * 128 + m * 16) * 4)));
        const f32x4 v0 = acc[ai][0][m][0] * wgt, v1 = acc[ai][0][m][1] * wgt;
        const u32x4 w = {cvtpk(v0[0], v0[1]), cvtpk(v0[2], v0[3]), cvtpk(v1[0], v1[1]), cvtpk(v1[2], v1[3])};
        *(u32x4*)((char*)ybuf + (base + (unsigned)((ai * 128 + m * 16) * 2048))) = w;
        asm volatile("" ::: "memory");
      }
  }
};
struct MoeOrderBase {
  const LAS int* tstart; const int* cnt; int G, c;
  DI bool next(int i, Unit& u) const {
    const int L = i * G + c, NT = tstart[32]; if (L >= NT * 8) return false;
    const int tile = L >> 3; int e = 0;
    for (int k = 1; k < 32; ++k) e = (tstart[k] <= tile) ? k : e;
    u.pm = tile; u.pn = L & 7; u.e = e; u.j = tile - tstart[e]; return true;
  }
};
struct MoeOrderGU : MoeOrderBase {
  static constexpr bool GATHER = true;
  const int* ltok; const char* Bt;
  DI unsigned a_off(const Unit& u, int R) const { const int n = cnt[u.e * CNT_STRIDE]; int idx = u.j * 256 + R; idx = idx < n ? idx : n - 1; return (unsigned)ltok[(size_t)u.e * T + idx] * 1024u; }
  DI const char* b_base(const Unit& u) const { return Bt + ((size_t)u.e * 1024 + u.pn * 128) * 1024; }
};
struct MoeOrderDN : MoeOrderBase {
  static constexpr bool GATHER = false;
  const char* Bt;
  DI unsigned a_off(const Unit& u, int R) const { return (unsigned)(u.pm * 256 + R) * 512u; }
  DI const char* b_base(const Unit& u) const { return Bt + ((size_t)u.e * 1024 + u.pn * 128) * 512; }
};

struct TDesc { const float* src; const float* kscale; bf16_t* dst; int ld, K, k0, n0, ok, fp8; };
DI TDesc tdesc(int r, int lane, unsigned char* ws) {
  constexpr int I_IN = 16 * 88, I_UQ = 6 * 24, I_UKV = 4 * 32, I_OUT = 16 * 32, I_GU = 32 * 16 * 32;
  TDesc d; d.kscale = nullptr; d.fp8 = 0; int sc, kb, nb; const float* W;
  if (r < I_IN) { kb = r / 88; nb = r % 88; const int n = nb * 32 + (lane & 31);
    sc = n < 2048 ? n : n < 2432 ? 2064 + (n - 2048) : n < 2688 ? 2448 + (n - 2432) : n < 2752 ? 2704 + ((n - 2688) & 1) * 32 + ((n - 2688) >> 1) : n < 2768 ? 2048 + (n - 2752) : -1;
    W = karg<A_WIN>(); d.ld = N_IN; d.K = 1024; d.dst = (bf16_t*)(ws + WS_WIN); }
  else if ((r -= I_IN) < I_UQ) { kb = r / 24; nb = r % 24; const int n = nb * 32 + (lane & 31), h = n / 192, dd = n - h * 192;
    sc = dd < 128 ? n : h * 192 + 128 + ((dd - 128) & 1) * 32 + ((dd - 128) >> 1);
    W = karg<A_WUQ>(); d.ld = 768; d.K = 384; d.dst = (bf16_t*)(ws + WS_WUQ); d.kscale = karg<A_QNG>(); }
  else if ((r -= I_UQ) < I_UKV) { kb = r / 32; nb = r % 32; sc = nb * 32 + (lane & 31); W = karg<A_WUKV>(); d.ld = 1024; d.K = 256; d.dst = (bf16_t*)(ws + WS_WUKV); d.kscale = karg<A_KVNG>(); }
  else if ((r -= I_UKV) < I_OUT) { kb = r / 32; nb = r % 32; sc = nb * 32 + (lane & 31); W = karg<A_WOUT>(); d.ld = 1024; d.K = 1024; d.dst = (bf16_t*)(ws + WS_WOUT); }
  else if ((r -= I_OUT) < I_GU) { const int e = r / 512, q = r % 512; kb = q / 32; nb = q % 32;
    const int lr = nb * 32 + (lane & 31), up = (lr >> 2) & 1; sc = (lr >> 3) * 4 + (lr & 3);
    W = (up ? karg<A_WUP>() : karg<A_WGATE>()) + (size_t)e * 1024 * 512; d.ld = 512; d.K = 1024; d.fp8 = 1; d.dst = (bf16_t*)(ws + WS_WGU + (size_t)e * 1024 * 1024); }
  else { r -= I_GU; const int e = r / 256, q = r % 256; kb = q / 32; nb = q % 32; sc = nb * 32 + (lane & 31);
    W = karg<A_WDOWN>() + (size_t)e * 512 * 1024; d.ld = 1024; d.K = 512; d.fp8 = 1; d.dst = (bf16_t*)(ws + WS_WDN + (size_t)e * 1024 * 512); }
  d.k0 = 64 * kb; d.n0 = 32 * nb; d.ok = sc >= 0;
  d.src = W + (size_t)(d.k0 + (lane >> 5)) * d.ld + (sc >= 0 ? sc : 0);
  return d;
}
DI void tload(const TDesc& d, float (&v)[32]) {
#pragma unroll
  for (int i = 0; i < 32; ++i) v[i] = d.src[(size_t)(2 * i) * d.ld];
}
DI void tstore(const TDesc& d, float (&v)[32], LAS float* scr, int lane) {
  if (d.kscale) {
#pragma unroll
    for (int i = 0; i < 32; ++i) v[i] *= d.kscale[d.k0 + 2 * i + (lane >> 5)];
  }
#pragma unroll
  for (int i = 0; i < 32; ++i) scr[(2 * i + (lane >> 5)) * 33 + (lane & 31)] = d.ok ? v[i] : 0.f;
  asm volatile("s_waitcnt lgkmcnt(0)" ::: "memory");
  const int c = lane & 7;
#pragma unroll
  for (int j = 0; j < 4; ++j) { const int n = (lane >> 3) + 8 * j; const LAS float* s = scr + (8 * c) * 33 + n;
    if (d.fp8) { *(u32x2*)((unsigned char*)d.dst + (size_t)(d.n0 + n) * d.K + d.k0 + 8 * c) =
        cvt8((f32x4){s[0 * 33], s[1 * 33], s[2 * 33], s[3 * 33]} * 32.f, (f32x4){s[4 * 33], s[5 * 33], s[6 * 33], s[7 * 33]} * 32.f); }
    else { u32x4 o; o.x = cvtpk(s[0 * 33], s[1 * 33]); o.y = cvtpk(s[2 * 33], s[3 * 33]); o.z = cvtpk(s[4 * 33], s[5 * 33]); o.w = cvtpk(s[6 * 33], s[7 * 33]);
      *(u32x4*)(d.dst + (size_t)(d.n0 + n) * d.K + d.k0 + 8 * c) = o; } }
  asm volatile("s_waitcnt lgkmcnt(0)" ::: "memory");
}
constexpr int PREP_ITEMS = 16 * 88 + 6 * 24 + 4 * 32 + 16 * 32 + 32 * 16 * 32 + 32 * 8 * 32;
constexpr int PREP_DEFER = 8192;
DI void prep_items(int it, const int end, const int stride, const int lane, unsigned char* ws, LAS float* scr) {
  TDesc dA, dB; float vA[32], vB[32];
  if (it < end) { dA = tdesc(it, lane, ws); tload(dA, vA); }
  while (it < end) {
    if (it + stride < end) { dB = tdesc(it + stride, lane, ws); tload(dB, vB); }
    tstore(dA, vA, scr, lane);
    it += stride; if (it >= end) break;
    if (it + stride < end) { dA = tdesc(it + stride, lane, ws); tload(dA, vA); }
    tstore(dB, vB, scr, lane);
    it += stride;
  }
}
DI void phase_prep(const Ctx& p, int bid, int G, LAS unsigned char* lds) {
  const int tid = tid_fresh(), lane = tid & 63, wave = __builtin_amdgcn_readfirstlane(tid >> 6);
  unsigned char* ws = p.ws;
  LAS float* scr = (LAS float*)(lds + wave * 16384);
  LAS float* cact = (LAS float*)(lds + 131072);
  for (int i = tid; i < 2048; i += NTHREADS) cact[i] = siluf_(karg<A_C>()[i]);
  __syncthreads();
  const int gw = bid * 8 + wave, NGW = G * 8;
  constexpr int I_MOD = 192;
  if (bid < I_MOD) {
    const int kg = lane >> 3, cc = lane & 7, col = bid * 32 + 4 * cc; const float* w_ada = karg<A_WADA>() + col;
    f32x4 a0 = {0.f, 0.f, 0.f, 0.f}, a1 = {0.f, 0.f, 0.f, 0.f};
#pragma unroll
    for (int j = 0; j < 16; ++j) { const int k = wave * 128 + kg + 8 * j; const f32x4 w = *(const f32x4*)(w_ada + (size_t)k * 6144); a0 += w * cact[k]; a1 += w * cact[1024 + k]; }
#pragma unroll
    for (int e = 0; e < 4; ++e) {
#pragma unroll
      for (int o = 8; o < 64; o <<= 1) { a0[e] += __shfl_xor(a0[e], o); a1[e] += __shfl_xor(a1[e], o); } }
    LAS f32x4* part = (LAS f32x4*)(lds + 131072 + 8192);
    if (kg == 0) { part[(wave * 8 + cc) * 2] = a0; part[(wave * 8 + cc) * 2 + 1] = a1; }
    __syncthreads();
    if (wave == 0 && kg == 0) { float* mod = (float*)(ws + WS_MOD); const f32x4 bb = *(const f32x4*)(karg<A_BADA>() + col);
      f32x4 s0 = part[cc * 2], s1 = part[cc * 2 + 1];
#pragma unroll
      for (int w = 1; w < 8; ++w) { s0 += part[(w * 8 + cc) * 2]; s1 += part[(w * 8 + cc) * 2 + 1]; }
      *(f32x4*)(mod + col) = s0 + bb; *(f32x4*)(mod + 6144 + col) = s1 + bb; }
  }
#ifndef DBL_PREP
#define DBL_PREP 0
#endif
  for (int rp_ = 0; rp_ < (DBL_PREP == 1 ? 2 : 1); ++rp_) prep_items(gw, PREP_ITEMS - PREP_DEFER, NGW, lane, ws, scr);
  {
    const float INV[32] = {1.000000000e+00f, 7.498942018e-01f, 5.623413324e-01f, 4.216965139e-01f, 3.162277639e-01f, 2.371373773e-01f, 1.778279394e-01f, 1.333521456e-01f,
                           1.000000015e-01f, 7.498942316e-02f, 5.623413250e-02f, 4.216964915e-02f, 3.162277490e-02f, 2.371373773e-02f, 1.778279431e-02f, 1.333521400e-02f,
                           9.999999776e-03f, 7.498942316e-03f, 5.623413250e-03f, 4.216964822e-03f, 3.162277630e-03f, 2.371373819e-03f, 1.778279431e-03f, 1.333521446e-03f,
                           1.000000047e-03f, 7.498941850e-04f, 5.623413017e-04f, 4.216965172e-04f, 3.162277571e-04f, 2.371373703e-04f, 1.778279402e-04f, 1.333521504e-04f};
    f32x2* rope = (f32x2*)(ws + WS_ROPE); const int* pos = karg<A_POS, const int>();
    for (int rp_ = 0; rp_ < (DBL_PREP == 2 ? 2 : 1); ++rp_)
    for (int i = bid * NTHREADS + tid; i < T * 32; i += G * NTHREADS) {
      const int t = i >> 5, fi = i & 31;
      const float ang = (float)pos[t] * INV[fi];
      float sn, cs; sincosf(ang, &sn, &cs); rope[i] = (f32x2){cs, sn};
    }
  }
  if (bid == 0) for (int i = tid; i < 64 * CNT_STRIDE; i += NTHREADS) ((int*)(ws + WS_CNT))[i] = 0;
  { const float* w_re = karg<A_WRE>(); const float* w_rg = karg<A_WRG>(); float* wrt = (float*)(ws + WS_WRT);
    for (int i = bid * NTHREADS + tid; i < 36 * 1024; i += G * NTHREADS) { const int e = i >> 10, k = i & 1023; wrt[i] = e < 32 ? w_re[k * 32 + e] : w_rg[k * 4 + (e - 32)]; } }
}

DI void phase_lnmod(const Ctx& p, int bid, int G) {
  const int tid = tid_fresh(), lane = tid & 63, wave = tid >> 6;
  const float* mod = (const float*)(p.ws + WS_MOD); bf16_t* U = (bf16_t*)(p.ws + WS_U); const float* xin = karg<A_X>();
  f32x4 vn[4];
  { const int row = bid * 8 + wave; if (row < T) { const f32x4* xr = (const f32x4*)(xin + (size_t)row * 1024) + lane;
#pragma unroll
      for (int j = 0; j < 4; ++j) vn[j] = xr[64 * j]; } }
  for (int row = bid * 8 + wave; row < T; row += G * 8) {
    const int b = row >> 14;
    f32x4 v[4]; float s = 0.f;
#pragma unroll
    for (int j = 0; j < 4; ++j) { v[j] = vn[j]; s += (v[j][0] + v[j][1]) + (v[j][2] + v[j][3]); }
    if (row + G * 8 < T) { const f32x4* xr = (const f32x4*)(xin + (size_t)(row + G * 8) * 1024) + lane;
#pragma unroll
      for (int j = 0; j < 4; ++j) vn[j] = xr[64 * j]; }
    const float mean = wave_sum(s) * (1.f / 1024.f); float s2 = 0.f;
#pragma unroll
    for (int j = 0; j < 4; ++j) { v[j] = v[j] - mean; s2 += (v[j][0] * v[j][0] + v[j][1] * v[j][1]) + (v[j][2] * v[j][2] + v[j][3] * v[j][3]); }
    const float rstd = rsqrtf(wave_sum(s2) * (1.f / 1024.f) + LN_EPS);
    u32x2* o8 = (u32x2*)(U + (size_t)row * 1024) + lane;
#pragma unroll
    for (int j = 0; j < 4; ++j) {
      const int col = 4 * lane + 256 * j;
      const f32x4 sh = *(const f32x4*)(mod + b * 6144 + col), sc = *(const f32x4*)(mod + b * 6144 + 1024 + col);
      const f32x4 y = v[j] * rstd * (sc + 1.f) + sh;
      o8[64 * j] = (u32x2){cvtpk(y[0], y[1]), cvtpk(y[2], y[3])};
    }
  }
}

constexpr int PA_V = 0, PA_KF = 32768, PA_KB = 65536, PA_RAWK = 100352, PA_VEC = 135168;
DI void mlstmA_unit(const Ctx& p, int b, int h, int c, LAS unsigned char* lds) {
  const int tid = tid_fresh(), lane = tid & 63, wid = __builtin_amdgcn_readfirstlane(tid >> 6), r32 = lane & 31, hi = lane >> 5;
  unsigned char* ws = p.ws;
  const bf16_t* qkpre = (const bf16_t*)(ws + WS_QKPRE); const bf16_t* vmp = (const bf16_t*)(ws + WS_VM); bf16_t* qkpost = (bf16_t*)(ws + WS_U);
  const float* gates = (const float*)(ws + WS_GATES); float* gvec = (float*)(ws + WS_GVEC); float* nvec = (float*)(ws + WS_NVEC); float* scal = (float*)(ws + WS_SCAL);
  bf16_t* Cbuf = (bf16_t*)p.out;
  LAS float* vec = (LAS float*)(lds + PA_VEC);
  const int bh = b * 4 + h, row0 = b * SEQ + c * 128;
  const int r0 = tid >> 4, c8 = (tid & 15) * 8;
  u32x4 rk[5], rq[5], rv[4];
#pragma unroll
  for (int j = 0; j < 5; ++j) {
    const int rr = r0 + 32 * j, sj = c * 128 + rr - 2; const bool ok = rr < 132 && sj >= 0 && sj < SEQ;
    const bf16_t* src = qkpre + (size_t)(b * SEQ + (ok ? sj : 0)) * 1024 + h * 128 + c8;
    rk[j] = ok ? *(const u32x4*)(src + 512) : (u32x4){0u, 0u, 0u, 0u}; rq[j] = ok ? *(const u32x4*)src : (u32x4){0u, 0u, 0u, 0u};
  }
#pragma unroll
  for (int j = 0; j < 4; ++j) rv[j] = *(const u32x4*)(vmp + (size_t)(row0 + r0 + 32 * j) * 512 + h * 128 + c8);
  float gb = 0.f, gcol = 0.f, gcm = 0.f;
  if (tid < 256) {
    const int dir = tid >> 7, t = tid & 127, wv = (tid >> 6) & 1;
    const float ig = gates[(size_t)(row0 + t) * 16 + (dir * 2) * 4 + h], fg = gates[(size_t)(row0 + t) * 16 + (dir * 2 + 1) * 4 + h];
    float x = logsigmoidf_(fg);
    if (dir == 0) {
#pragma unroll
      for (int o = 1; o < 64; o <<= 1) { const float y = __shfl_up(x, o); if (lane >= o) x += y; }
      if (lane == 63) vec[256 + wv] = x;
    } else {
#pragma unroll
      for (int o = 1; o < 64; o <<= 1) { const float y = __shfl_down(x, o); if (lane + o < 64) x += y; }
      if (lane == 0) vec[258 + wv] = x;
    }
    gb = x; gcol = ig;
  }
  __syncthreads();
  if (tid < 256) {
    const int dir = tid >> 7, wv = (tid >> 6) & 1;
    if (dir == 0) { if (wv == 1) gb += vec[256]; } else { if (wv == 0) gb += vec[259]; }
    gcol = gcol - gb;
    float x = gcol;
    if (dir == 0) {
#pragma unroll
      for (int o = 1; o < 64; o <<= 1) { const float y = __shfl_up(x, o); if (lane >= o) x = fmaxf(x, y); }
      if (lane == 63) vec[260 + wv] = x;
    } else {
#pragma unroll
      for (int o = 1; o < 64; o <<= 1) { const float y = __shfl_down(x, o); if (lane + o < 64) x = fmaxf(x, y); }
      if (lane == 0) vec[262 + wv] = x;
    }
    gcm = x;
  }
  __syncthreads();
  if (tid < 256) {
    const int dir = tid >> 7, t = tid & 127, wv = (tid >> 6) & 1;
    if (dir == 0) { if (wv == 1) gcm = fmaxf(gcm, vec[260]); } else { if (wv == 0) gcm = fmaxf(gcm, vec[263]); }
    const float mx = fmaxf(vec[260 + 2 * dir], vec[261 + 2 * dir]);
    const float tot = vec[256 + 2 * dir] + vec[257 + 2 * dir];
    float* gv = gvec + ((size_t)(dir * 8 + bh) * SEQ + c * 128 + t) * 3;
    gv[0] = gb; gv[1] = gcol; gv[2] = gcm;
    vec[dir * 128 + t] = __expf(gcol - mx);
    if (t == 0) { scal[(dir * 8 + bh) * 128 + c] = tot; scal[2048 + (dir * 8 + bh) * 128 + c] = tot + mx; }
  }
  __syncthreads();
#pragma unroll
  for (int j = 0; j < 5; ++j) { const int rr = r0 + 32 * j;
    if (rr < 132) { *(LAS u32x4*)(lds + PA_RAWK + rr * 256 + c8 * 2) = rk[j]; *(LAS u32x4*)(lds + PA_KB + rr * 256 + c8 * 2) = rq[j]; } }
#pragma unroll
  for (int j = 0; j < 4; ++j) { const int r = r0 + 32 * j; *(LAS u32x4*)(lds + PA_V + (r >> 6) * 16384 + v_st(r & 63, c8)) = rv[j]; }
  __syncthreads();
  const float* conv_w = karg<A_CONVW>(); const float* conv_b = karg<A_CONVB>();
  {
    const int ch = h * 128 + c8;
    float w[5][8], bias[8];
#pragma unroll
    for (int j = 0; j < 5; ++j) { const f32x4 a = *(const f32x4*)(conv_w + j * 1024 + ch), bq = *(const f32x4*)(conv_w + j * 1024 + ch + 4);
      w[j][0] = a[0]; w[j][1] = a[1]; w[j][2] = a[2]; w[j][3] = a[3]; w[j][4] = bq[0]; w[j][5] = bq[1]; w[j][6] = bq[2]; w[j][7] = bq[3]; }
    { const f32x4 a = *(const f32x4*)(conv_b + ch), bq = *(const f32x4*)(conv_b + ch + 4); bias[0] = a[0]; bias[1] = a[1]; bias[2] = a[2]; bias[3] = a[3]; bias[4] = bq[0]; bias[5] = bq[1]; bias[6] = bq[2]; bias[7] = bq[3]; }
#pragma unroll
    for (int ps = 0; ps < 4; ++ps) {
      const int r = r0 + 32 * ps;
      float a[8];
#pragma unroll
      for (int e = 0; e < 8; ++e) a[e] = bias[e];
#pragma unroll
      for (int j = 0; j < 5; ++j) { const u32x4 xv = *(const LAS u32x4*)(lds + PA_KB + (r + j) * 256 + c8 * 2);
        a[0] += w[j][0] * bflo(xv[0]); a[1] += w[j][1] * bfhi(xv[0]); a[2] += w[j][2] * bflo(xv[1]); a[3] += w[j][3] * bfhi(xv[1]);
        a[4] += w[j][4] * bflo(xv[2]); a[5] += w[j][5] * bfhi(xv[2]); a[6] += w[j][6] * bflo(xv[3]); a[7] += w[j][7] * bfhi(xv[3]); }
      const float qs = 0.08838834764831845f;
#pragma unroll
      for (int e = 0; e < 8; ++e) a[e] = siluf_(a[e]) * qs;
      *(u32x4*)(qkpost + (size_t)(row0 + r) * 1024 + ch) = (u32x4){cvtpk(a[0], a[1]), cvtpk(a[2], a[3]), cvtpk(a[4], a[5]), cvtpk(a[6], a[7])};
    }
  }
  __syncthreads();
  {
    const int ch = 512 + h * 128 + c8;
    float w[5][8], bias[8];
#pragma unroll
    for (int j = 0; j < 5; ++j) { const f32x4 a = *(const f32x4*)(conv_w + j * 1024 + ch), bq = *(const f32x4*)(conv_w + j * 1024 + ch + 4);
      w[j][0] = a[0]; w[j][1] = a[1]; w[j][2] = a[2]; w[j][3] = a[3]; w[j][4] = bq[0]; w[j][5] = bq[1]; w[j][6] = bq[2]; w[j][7] = bq[3]; }
    { const f32x4 a = *(const f32x4*)(conv_b + ch), bq = *(const f32x4*)(conv_b + ch + 4); bias[0] = a[0]; bias[1] = a[1]; bias[2] = a[2]; bias[3] = a[3]; bias[4] = bq[0]; bias[5] = bq[1]; bias[6] = bq[2]; bias[7] = bq[3]; }
#pragma unroll
    for (int ps = 0; ps < 4; ++ps) {
      const int r = r0 + 32 * ps;
      float a[8];
#pragma unroll
      for (int e = 0; e < 8; ++e) a[e] = bias[e];
#pragma unroll
      for (int j = 0; j < 5; ++j) { const u32x4 xv = *(const LAS u32x4*)(lds + PA_RAWK + (r + j) * 256 + c8 * 2);
        a[0] += w[j][0] * bflo(xv[0]); a[1] += w[j][1] * bfhi(xv[0]); a[2] += w[j][2] * bflo(xv[1]); a[3] += w[j][3] * bfhi(xv[1]);
        a[4] += w[j][4] * bflo(xv[2]); a[5] += w[j][5] * bfhi(xv[2]); a[6] += w[j][6] * bflo(xv[3]); a[7] += w[j][7] * bfhi(xv[3]); }
#pragma unroll
      for (int e = 0; e < 8; ++e) a[e] = siluf_(a[e]);
      *(u32x4*)(qkpost + (size_t)(row0 + r) * 1024 + ch) = (u32x4){cvtpk(a[0], a[1]), cvtpk(a[2], a[3]), cvtpk(a[4], a[5]), cvtpk(a[6], a[7])};
      const float wf = vec[r], wb = vec[128 + r];
      const u32x4 kf = {cvtpk(a[0] * wf, a[1] * wf), cvtpk(a[2] * wf, a[3] * wf), cvtpk(a[4] * wf, a[5] * wf), cvtpk(a[6] * wf, a[7] * wf)};
      const u32x4 kb = {cvtpk(a[0] * wb, a[1] * wb), cvtpk(a[2] * wb, a[3] * wb), cvtpk(a[4] * wb, a[5] * wb), cvtpk(a[6] * wb, a[7] * wb)};
      const int io = (r >> 6) * 16384 + v_st(r & 63, c8);
      *(LAS u32x4*)(lds + PA_KF + io) = kf; *(LAS u32x4*)(lds + PA_KB + io) = kb;
    }
  }
  __syncthreads();
  {
    const int dir = wid >> 2, dkb = wid & 3;
    const int ka = (int)(uintptr_t)(lds + (dir ? PA_KB : PA_KF)) + v_rd_base(lane) + dkb * 512;
    const int va = (int)(uintptr_t)(lds + PA_V) + v_rd_base(lane);
    f32x16 o[4] = {};
#define PA_STEP(TILE, KS) do { s16x4 al, ah, l0, h0, l1, h1, l2, h2, l3, h3;                                                   \
      al = tr_read<v_rd_off(0, KS, 0)>(ka + TILE * 16384); ah = tr_read<v_rd_off(0, KS, 1)>(ka + TILE * 16384);                 \
      l0 = tr_read<v_rd_off(0, KS, 0)>(va + TILE * 16384); h0 = tr_read<v_rd_off(0, KS, 1)>(va + TILE * 16384);                 \
      l1 = tr_read<v_rd_off(1, KS, 0)>(va + TILE * 16384); h1 = tr_read<v_rd_off(1, KS, 1)>(va + TILE * 16384);                 \
      l2 = tr_read<v_rd_off(2, KS, 0)>(va + TILE * 16384); h2 = tr_read<v_rd_off(2, KS, 1)>(va + TILE * 16384);                 \
      l3 = tr_read<v_rd_off(3, KS, 0)>(va + TILE * 16384); h3 = tr_read<v_rd_off(3, KS, 1)>(va + TILE * 16384);                 \
      asm volatile("s_waitcnt lgkmcnt(0)" ::: "memory"); SBAR();                                                                \
      const bf16x8 A = PKLH(al, ah);                                                                                            \
      o[0] = MFMA32(A, PKLH(l0, h0), o[0]); o[1] = MFMA32(A, PKLH(l1, h1), o[1]); o[2] = MFMA32(A, PKLH(l2, h2), o[2]); o[3] = MFMA32(A, PKLH(l3, h3), o[3]); } while (0)
    PA_STEP(0, 0); PA_STEP(0, 1); PA_STEP(0, 2); PA_STEP(0, 3); PA_STEP(1, 0); PA_STEP(1, 1); PA_STEP(1, 2); PA_STEP(1, 3);
#undef PA_STEP
    bf16_t* Cd = Cbuf + ((size_t)(dir * 8 + bh) * 128 + c) * 16384;
#pragma unroll
    for (int r = 0; r < 16; ++r) { const int dk = dkb * 32 + crow(r, hi);
#pragma unroll
      for (int d0 = 0; d0 < 4; ++d0) Cd[dk * 128 + d0 * 32 + r32] = f2bf(o[d0][r]); }
  }
  if (tid < 256) {
    const int dir = tid >> 7, dk = tid & 127; const LAS unsigned char* img = lds + (dir ? PA_KB : PA_KF);
    float n = 0.f;
#pragma unroll 8
    for (int s = 0; s < 128; ++s) n += bf2f(*(const LAS unsigned short*)(img + (s >> 6) * 16384 + v_st(s & 63, dk)));
    nvec[((size_t)(dir * 8 + bh) * 128 + c) * 128 + dk] = n;
  }
  __syncthreads();
}

DI void phase_scan(const Ctx& p, int bid, int G) {
  const int tid = tid_fresh(); unsigned char* ws = p.ws;
  const float* scal = (const float*)(ws + WS_SCAL); float* mprev = (float*)(ws + WS_SCAL) + 4096; float* nvec = (float*)(ws + WS_NVEC); bf16_t* Cbuf = (bf16_t*)p.out;
  for (int gid = bid * NTHREADS + tid, it = 0; gid < 131072; gid += G * NTHREADS, ++it) {
    const int seq = gid >> 13, e2c = gid & 8191, dir = seq >> 3;
    const bool ex = (it == 0) && (gid < 1024);
    const int seqn = (gid & 1023) >> 6, e2 = gid & 63, dirn = seqn >> 3;
    float m = 0.f, a0 = 0.f, a1 = 0.f, mN = 0.f, n0 = 0.f, n1 = 0.f;
    for (int sb = 0; sb < 128; sb += 8) {
      unsigned raw[8]; f32x2 rawn[8];
#pragma unroll
      for (int q = 0; q < 8; ++q) { const int c = dir ? 127 - (sb + q) : sb + q; raw[q] = *(const unsigned*)(Cbuf + ((size_t)seq * 128 + c) * 16384 + e2c * 2); }
      if (ex) {
#pragma unroll
        for (int q = 0; q < 8; ++q) { const int c = dirn ? 127 - (sb + q) : sb + q; rawn[q] = *(const f32x2*)(nvec + ((size_t)seqn * 128 + c) * 128 + e2 * 2); }
      }
#pragma unroll
      for (int q = 0; q < 8; ++q) {
        const int c = dir ? 127 - (sb + q) : sb + q;
        const float be = scal[seq * 128 + c], ml = scal[2048 + seq * 128 + c];
        *(unsigned*)(Cbuf + ((size_t)seq * 128 + c) * 16384 + e2c * 2) = cvtpk(a0, a1);
        if (e2c == 0) mprev[seq * 128 + c] = m;
        const float mn = fmaxf(be + m, ml), al = __expf(be + m - mn), bt = __expf(ml - mn);
        a0 = al * a0 + bt * bflo(raw[q]); a1 = al * a1 + bt * bfhi(raw[q]);
        m = mn;
      }
      if (ex) {
#pragma unroll
        for (int q = 0; q < 8; ++q) {
          const int c = dirn ? 127 - (sb + q) : sb + q;
          const float be = scal[seqn * 128 + c], ml = scal[2048 + seqn * 128 + c];
          *(f32x2*)(nvec + ((size_t)seqn * 128 + c) * 128 + e2 * 2) = (f32x2){n0, n1};
          const float mn = fmaxf(be + mN, ml), al = __expf(be + mN - mn), bt = __expf(ml - mn);
          n0 = al * n0 + bt * rawn[q][0]; n1 = al * n1 + bt * rawn[q][1];
          mN = mn;
        }
      }
    }
  }
}

DI void qkt8(f32x16& p0, f32x16& p1, const LAS unsigned char* Ks, const bf16x8* qr, int r32, int hi) {
  p0 = f32x16{}; p1 = f32x16{};
#pragma unroll
  for (int d0 = 0; d0 < 8; ++d0) { const int cb = (d0 * 16 + hi * 8) * 2;
    const bf16x8 b0 = *(const LAS bf16x8*)(Ks + KSWZ(r32, cb)), b1 = *(const LAS bf16x8*)(Ks + KSWZ(32 + r32, cb));
    p0 = MFMA32(b0, qr[d0], p0); p1 = MFMA32(b1, qr[d0], p1); }
}
DI v8i kfrag8(const LAS unsigned char* K8, int row, int s, int hi) {
  const int c = 4 * s + 2 * hi;
  const u32x4 lo = *(const LAS u32x4*)(K8 + row * 256 + ((c ^ (row & 15)) << 4)), hi4 = *(const LAS u32x4*)(K8 + row * 256 + (((c + 1) ^ (row & 15)) << 4));
  return (v8i){(int)lo[0], (int)lo[1], (int)lo[2], (int)lo[3], (int)hi4[0], (int)hi4[1], (int)hi4[2], (int)hi4[3]};
}
#define MFMA8(a, b, c) __builtin_amdgcn_mfma_scale_f32_32x32x64_f8f6f4((a), (b), (c), 0, 0, 0, 127, 0, 123)
DI void qkt12(f32x16& p0, f32x16& p1, const LAS unsigned char* K8, const v8i* qr, int r32, int hi) {
  p0 = f32x16{}; p1 = f32x16{};
#pragma unroll
  for (int s = 0; s < 3; ++s) {
    const v8i a0 = kfrag8(K8, r32, s, hi), a1 = kfrag8(K8, 32 + r32, s, hi);
    p0 = MFMA8(a0, qr[s], p0); p1 = MFMA8(a1, qr[s], p1);
  }
}

DI void glds16(const void* gsrc, unsigned lds_dst) {
  unsigned keep;
  asm volatile("s_mov_b32 %0, m0\n\ts_mov_b32 m0, %2\n\ts_nop 0\n\tglobal_load_lds_dwordx4 %1, off\n\ts_mov_b32 m0, %0" : "=&s"(keep) : "v"(gsrc), "s"(lds_dst) : "memory");
}
constexpr int AT_KN = 0, AT_V = 49152, AT_WS = 73728;
constexpr float ATT_THR = 3.f;
DI void partialSM(f32x16& p0, f32x16& p1, float& m_reg, float& mn, float& alpha) {
  float pmax = p0[0];
#pragma unroll
  for (int r = 1; r < 16; ++r) pmax = fmaxf(pmax, p0[r]);
#pragma unroll
  for (int r = 0; r < 16; ++r) pmax = fmaxf(pmax, p1[r]);
  pmax = half_swap_max(pmax);
  if (__builtin_expect(__all(pmax - m_reg <= ATT_THR), 1)) { mn = m_reg; alpha = 1.f; }
  else { mn = fmaxf(m_reg, pmax); alpha = __builtin_amdgcn_exp2f(m_reg - mn); m_reg = mn; }
  const float mo = mn - 5.f;
#pragma unroll
  for (int r = 0; r < 16; ++r) { p0[r] = p0[r] - mo; p1[r] = p1[r] - mo; }
#pragma unroll
  for (int r = 0; r < 16; ++r) p0[r] = __builtin_amdgcn_exp2f(p0[r]);
}
DI void finishSM(f32x16& p0, f32x16& p1, v8i& pa) {
#pragma unroll
  for (int r = 0; r < 16; ++r) p1[r] = __builtin_amdgcn_exp2f(p1[r]);
#pragma unroll
  for (int q = 0; q < 4; ++q) {
    int w = __builtin_amdgcn_cvt_pk_fp8_f32(p0[4 * q], p0[4 * q + 1], pa[q], false); pa[q] = __builtin_amdgcn_cvt_pk_fp8_f32(p0[4 * q + 2], p0[4 * q + 3], w, true);
    w = __builtin_amdgcn_cvt_pk_fp8_f32(p1[4 * q], p1[4 * q + 1], pa[4 + q], false); pa[4 + q] = __builtin_amdgcn_cvt_pk_fp8_f32(p1[4 * q + 2], p1[4 * q + 3], w, true);
  }
}
DI void pv8(f32x16* o, f32x16& lsum, const LAS unsigned char* Vt, v8i pa, int r32, int hi) {
  { const v8i ones = {0x38383838, 0x38383838, 0x38383838, 0x38383838, 0x38383838, 0x38383838, 0x38383838, 0x38383838};
    lsum = __builtin_amdgcn_mfma_scale_f32_32x32x64_f8f6f4(pa, ones, lsum, 0, 0, 0, 122, 0, 127); }
#pragma unroll
  for (int d0 = 0; d0 < 4; ++d0) {
    const int n = 32 * d0 + r32, x = (n >> 2) & 3;
    const u32x4 lo = *(const LAS u32x4*)(Vt + n * 64 + (((2 * hi) ^ x) << 4)), h4 = *(const LAS u32x4*)(Vt + n * 64 + (((2 * hi + 1) ^ x) << 4));
    const v8i bv = {(int)lo[0], (int)lo[1], (int)lo[2], (int)lo[3], (int)h4[0], (int)h4[1], (int)h4[2], (int)h4[3]};
    o[d0] = __builtin_amdgcn_mfma_scale_f32_32x32x64_f8f6f4(pa, bv, o[d0], 0, 0, 0, 122, 0, 127);
  }
}
DI void attn_unit(const unsigned char* Qb, const unsigned char* Knh, const unsigned char* Vh, bf16_t* Ob, LAS unsigned char* lds) {
  const int tid = tid_fresh(), wid = __builtin_amdgcn_readfirstlane(tid >> 6), lane = tid & 63, r32 = lane & 31, hi = lane >> 5;
  LAS float* wsf = (LAS float*)(lds + AT_WS) + wid * 64; LAS float* al_l = wsf + 32;
  constexpr int NT = SEQ / 64;
  unsigned offKn, offV;
  { const int row = wid * 4 + (lane >> 4); int lg = (lane & 15) ^ (row & 15); lg = lg < 12 ? lg : 0; offKn = (unsigned)(row * 192 + lg * 16); }
  { const int n = wid * 16 + (lane >> 2), c = (lane & 3) ^ ((n >> 2) & 3); offV = (unsigned)(n * 64 + c * 16); }
  const unsigned ldsw = (unsigned)wid * 1024u, lds0 = (unsigned)(uintptr_t)lds;
#define DMA16(gptr, ldsoff) glds16((gptr), (unsigned)__builtin_amdgcn_readfirstlane((int)(lds0 + (unsigned)(ldsoff))))
#define ISSUE_K(t, ks) do { const int t_ = (t) < NT ? (t) : NT - 1; const char* kn_ = (const char*)Knh + (size_t)t_ * (64 * 192) + offKn; \
    DMA16(kn_, AT_KN + (ks) * 16384 + ldsw); DMA16(kn_ + 32 * 192, AT_KN + (ks) * 16384 + 8192 + ldsw); } while (0)
#define ISSUE_V(t, vs) do { const int t_ = (t) < NT ? (t) : NT - 1; DMA16((const char*)Vh + (size_t)t_ * 8192 + offV, AT_V + (vs) * 8192 + ldsw); } while (0)
#define WAIT_BAR(N) asm volatile("s_waitcnt vmcnt(" #N ") lgkmcnt(0)\n\ts_barrier" ::: "memory")
#define RESC(a) do { if (__any((a) < 1.f)) { if (hi == 0) al_l[r32] = (a); asm volatile("s_waitcnt lgkmcnt(0)" ::: "memory"); \
    _Pragma("unroll") for (int r = 0; r < 16; ++r) { const float a_ = al_l[crow(r, hi)]; lsum[r] *= a_; _Pragma("unroll") for (int d = 0; d < 4; ++d) o[d][r] *= a_; } } } while (0)
  const bool trail = wid >= 4;
  ISSUE_K(0, 0); ISSUE_K(1, 1); ISSUE_V(0, 0);
  float m_reg = -1e30f; f32x16 lsum = {}; f32x16 o[4] = {}; v8i qr[3];
  { const unsigned char* Qw = Qb + (size_t)(wid * 32 + r32) * 192 + hi * 32;
#pragma unroll
    for (int s_ = 0; s_ < 3; ++s_) { const u32x4 lo = *(const u32x4*)(Qw + s_ * 64), h4 = *(const u32x4*)(Qw + s_ * 64 + 16);
      qr[s_] = (v8i){(int)lo[0], (int)lo[1], (int)lo[2], (int)lo[3], (int)h4[0], (int)h4[1], (int)h4[2], (int)h4[3]}; } }
  f32x16 pA0, pA1, pB0, pB1; float mnA, mnB, alA, alB; v8i pa = {};
  asm volatile("s_waitcnt vmcnt(0)" ::: "memory");
  __builtin_amdgcn_s_barrier();
  if (trail) __builtin_amdgcn_s_barrier();
  ISSUE_K(2, 2);
  qkt12(pA0, pA1, lds + AT_KN, qr, r32, hi);
  WAIT_BAR(3);
  ISSUE_V(1, 1);
  partialSM(pA0, pA1, m_reg, mnA, alA);
  WAIT_BAR(3);
  int s1 = 1;
  for (int j = 1; j + 1 < NT; j += 2) {
    const int s0 = s1 == 0 ? 2 : s1 - 1, s2 = s1 == 2 ? 0 : s1 + 1;
    ISSUE_K(j + 2, s0);
    SBAR(); qkt12(pB0, pB1, lds + AT_KN + s1 * 16384, qr, r32, hi);
    finishSM(pA0, pA1, pa); SBAR();
    WAIT_BAR(3);
    ISSUE_V(j + 1, s2);
    pv8(o, lsum, lds + AT_V + s0 * 8192, pa, r32, hi); partialSM(pB0, pB1, m_reg, mnB, alB);
    RESC(alB);
    WAIT_BAR(3);
    ISSUE_K(j + 3, s1);
    SBAR(); qkt12(pA0, pA1, lds + AT_KN + s2 * 16384, qr, r32, hi);
    finishSM(pB0, pB1, pa); SBAR();
    WAIT_BAR(3);
    ISSUE_V(j + 2, s0);
    pv8(o, lsum, lds + AT_V + s1 * 8192, pa, r32, hi); partialSM(pA0, pA1, m_reg, mnA, alA);
    RESC(alA);
    WAIT_BAR(3);
    s1 = s0;
  }
  {
    const int s0 = s1 == 0 ? 2 : s1 - 1, s2 = s1 == 2 ? 0 : s1 + 1;
    ISSUE_K(NT + 1, s0);
    SBAR(); qkt12(pB0, pB1, lds + AT_KN + s1 * 16384, qr, r32, hi);
    finishSM(pA0, pA1, pa); SBAR();
    WAIT_BAR(3);
    ISSUE_V(NT, s2);
    pv8(o, lsum, lds + AT_V + s0 * 8192, pa, r32, hi); partialSM(pB0, pB1, m_reg, mnB, alB);
    RESC(alB);
    WAIT_BAR(3);
    if (!trail) __builtin_amdgcn_s_barrier();
    finishSM(pB0, pB1, pa); SBAR();
    pv8(o, lsum, lds + AT_V + s1 * 8192, pa, r32, hi);
  }
  float rli[16];
#pragma unroll
  for (int r = 0; r < 16; ++r) rli[r] = __builtin_amdgcn_rcpf(lsum[r]);
  bf16_t* Ow = Ob + (size_t)(wid * 32) * 1024;
#pragma unroll
  for (int r = 0; r < 16; ++r) { const int orow = crow(r, hi);
#pragma unroll
    for (int d0 = 0; d0 < 4; ++d0) Ow[(size_t)orow * 1024 + d0 * 32 + r32] = f2bf(o[d0][r] * rli[r]); }
  asm volatile("s_waitcnt vmcnt(0) lgkmcnt(0)\n\ts_barrier" ::: "memory");
#undef DMA16
#undef ISSUE_K
#undef ISSUE_V
#undef WAIT_BAR
#undef RESC
}
DI void phase_attn(const Ctx& p, int bid, int G, LAS unsigned char* lds) {
  unsigned char* ws = p.ws;
  const unsigned char* qatt = ws + WS_QATT; const unsigned char* k8 = ws + WS_KN; const unsigned char* va = ws + WS_VA;
  bf16_t* hcat = (bf16_t*)(ws + WS_H);
  for (int u = bid; u < 512; u += G) {
    const int bh = u & 7, qb = u >> 3, b = bh >> 2, h = bh & 3;
    attn_unit(qatt + ((size_t)bh * SEQ + qb * 256) * 192, k8 + (size_t)bh * SEQ * 192, va + (size_t)bh * SEQ * 128,
              hcat + (size_t)(b * SEQ + qb * 256) * 1024 + 512 + h * 128, lds);
  }
}

constexpr int PC_K = 0, PC_V = 32768, PC_CF = 65536, PC_CB = 98304, PC_VEC = 131072;
template <bool DRY = false> DI void mlstmC_unit(const Ctx& p, int b, int h, int c, LAS unsigned char* lds) {
  const int tid = tid_fresh(), lane = tid & 63, wid = __builtin_amdgcn_readfirstlane(tid >> 6), r32 = lane & 31, hi = lane >> 5;
  unsigned char* ws = p.ws;
  const bf16_t* qkpost = (const bf16_t*)(ws + WS_U); const bf16_t* vmp = (const bf16_t*)(ws + WS_VM); bf16_t* hcat = (bf16_t*)(ws + WS_H);
  const float* gvec = (const float*)(ws + WS_GVEC); const float* nvec = (const float*)(ws + WS_NVEC); const float* mprev = (const float*)(ws + WS_SCAL) + 4096;
  const bf16_t* Cbuf = (const bf16_t*)p.out;
  LAS float* vec = (LAS float*)(lds + PC_VEC);
  const int bh = b * 4 + h, row0 = b * SEQ + c * 128;
  if (tid < 256) {
    const int dir = tid >> 7, t = tid & 127;
    const float* gv = gvec + ((size_t)(dir * 8 + bh) * SEQ + c * 128 + t) * 3;
    const float gb = gv[0], gcol = gv[1], gcm = gv[2], mp = mprev[(dir * 8 + bh) * 128 + c];
    const float M = fmaxf(mp, gcm);
    vec[dir * 128 + t] = gcol * LOG2E; vec[256 + dir * 128 + t] = M * LOG2E; vec[512 + dir * 128 + t] = __expf(mp - M); vec[768 + dir * 128 + t] = __expf(-(gb + M));
    vec[1024 + dir * 128 + t] = nvec[((size_t)(dir * 8 + bh) * 128 + c) * 128 + t];
  }
  {
    const int r0 = tid >> 4, c8 = (tid & 15) * 8;
    const bf16_t* Cf = Cbuf + ((size_t)(0 * 8 + bh) * 128 + c) * 16384; const bf16_t* Cb = Cbuf + ((size_t)(1 * 8 + bh) * 128 + c) * 16384;
#pragma unroll
    for (int ps = 0; ps < 4; ++ps) {
      const int r = r0 + 32 * ps, tile = r >> 6, rr = r & 63;
      *(LAS u32x4*)(lds + PC_K + tile * 16384 + KSWZ(rr, c8 * 2)) = *(const u32x4*)(qkpost + (size_t)(row0 + r) * 1024 + 512 + h * 128 + c8);
      *(LAS u32x4*)(lds + PC_V + tile * 16384 + v_st(rr, c8)) = *(const u32x4*)(vmp + (size_t)(row0 + r) * 512 + h * 128 + c8);
      *(LAS u32x4*)(lds + PC_CF + tile * 16384 + v_st(rr, c8)) = *(const u32x4*)(Cf + r * 128 + c8);
      *(LAS u32x4*)(lds + PC_CB + tile * 16384 + v_st(rr, c8)) = *(const u32x4*)(Cb + r * 128 + c8);
    }
  }
  const int dir = wid >> 2, tb = wid & 3, t = tb * 32 + r32;
  bf16x8 qr[8];
  { const bf16_t* Qw = qkpost + (size_t)(row0 + t) * 1024 + h * 128 + hi * 8;
#pragma unroll
    for (int d0 = 0; d0 < 8; ++d0) qr[d0] = *(const bf16x8*)(Qw + d0 * 16); }
  __syncthreads();
  const LAS float* vcol = vec + dir * 128; const LAS float* va_ = vec + 512 + dir * 128; const LAS float* vn = vec + 1024 + dir * 128;
  float qn = 0.f;
#pragma unroll
  for (int d0 = 0; d0 < 8; ++d0)
#pragma unroll
    for (int j = 0; j < 8; ++j) qn += bf2f((unsigned short)qr[d0][j]) * vn[d0 * 16 + hi * 8 + j];
  qn = half_swap_sum(qn);
  asm volatile("" : "+v"(qn));
  SBAR();
  f32x16 o[4] = {};
  {
    const int vbc = (int)(uintptr_t)(lds + (dir ? PC_CB : PC_CF)) + v_rd_base(lane);
    pv_d0(o, vbc, qr[0], qr[1], qr[2], qr[3]);
    pv_d0(o, vbc + 16384, qr[4], qr[5], qr[6], qr[7]);
  }
#pragma unroll
  for (int d = 0; d < 4; ++d)
#pragma unroll
    for (int r = 0; r < 16; ++r) o[d][r] *= va_[tb * 32 + crow(r, hi)];
  SBAR();
  const float Mt = vec[256 + dir * 128 + t], at = va_[t], flt = vec[768 + dir * 128 + t];
  float rsum = 0.f;
  const int vbv = (int)(uintptr_t)(lds + PC_V) + v_rd_base(lane);
#pragma unroll
  for (int kt = 0; kt < 2; ++kt) {
    const bool need = dir == 0 ? (kt * 64 <= tb * 32 + 31) : (kt * 64 + 63 >= tb * 32);
    if (need) {
      f32x16 p0, p1; qkt8(p0, p1, lds + PC_K + kt * 16384, qr, r32, hi);
#pragma unroll
      for (int r = 0; r < 16; ++r) {
        const int s0 = kt * 64 + crow(r, hi), s1 = s0 + 32;
        const bool ok0 = dir == 0 ? (s0 <= t) : (s0 >= t), ok1 = dir == 0 ? (s1 <= t) : (s1 >= t);
        const float w0 = __builtin_amdgcn_exp2f(vcol[s0] - Mt), w1 = __builtin_amdgcn_exp2f(vcol[s1] - Mt);
        p0[r] = ok0 ? p0[r] * w0 : 0.f; p1[r] = ok1 ? p1[r] * w1 : 0.f;
        rsum += p0[r] + p1[r];
      }
      bf16x8 pa0, pa1, pa2, pa3; pack_p(p0, p1, pa0, pa1, pa2, pa3);
      pv_d0(o, vbv + kt * 16384, pa0, pa1, pa2, pa3);
    }
  }
  rsum = half_swap_sum(rsum);
  {
    const float den = at * qn + rsum, dn = fmaxf(fabsf(den), flt);
    LAS float* rd = vec + 1280 + dir * 128;
    if (hi == 0) rd[t] = 1.f / dn;
    asm volatile("s_waitcnt lgkmcnt(0)" ::: "memory");
#pragma unroll
    for (int d = 0; d < 4; ++d)
#pragma unroll
      for (int r = 0; r < 16; ++r) o[d][r] *= rd[tb * 32 + crow(r, hi)];
  }
  __syncthreads();
  {
    LAS float* hst = (LAS float*)(lds + dir * 65536);
#pragma unroll
    for (int r = 0; r < 16; ++r) { const int tr = tb * 32 + crow(r, hi);
#pragma unroll
      for (int d = 0; d < 4; ++d) hst[tr * 128 + d * 32 + r32] = o[d][r]; }
  }
  __syncthreads();
  {
    const int rg = tid >> 5, cl = tid & 31;
    const f32x4 g = *(const f32x4*)(karg<A_MHG>() + h * 128 + 4 * cl);
    u32x2 sgv[8];
#pragma unroll
    for (int ps = 0; ps < 8; ++ps) sgv[ps] = *(const u32x2*)(hcat + (size_t)(row0 + ps * 16 + rg) * 1024 + h * 128 + 4 * cl);
#pragma unroll
    for (int ps = 0; ps < 8; ++ps) {
      const int tr = ps * 16 + rg;
      const f32x4 xf = *(const LAS f32x4*)(lds + (tr * 128 + 4 * cl) * 4), xb = *(const LAS f32x4*)(lds + 65536 + (tr * 128 + 4 * cl) * 4);
      f32x4 x = xf + xb;
      float s = (x[0] + x[1]) + (x[2] + x[3]);
#pragma unroll
      for (int o_ = 1; o_ < 32; o_ <<= 1) s += __shfl_xor(s, o_);
      const float mu = s * (1.f / 128.f); x = x - mu;
      float q = (x[0] * x[0] + x[1] * x[1]) + (x[2] * x[2] + x[3] * x[3]);
#pragma unroll
      for (int o_ = 1; o_ < 32; o_ <<= 1) q += __shfl_xor(q, o_);
      const float rstd = rsqrtf(q * (1.f / 128.f) + LN_EPS);
      u32x2* dst = (u32x2*)(hcat + (size_t)(row0 + tr) * 1024 + h * 128 + 4 * cl);
      const u32x2 sg = sgv[ps];
      const f32x4 y = x * rstd * g;
      if (DRY) dst = (u32x2*)((bf16_t*)(ws + WS_QKPRE) + (size_t)(row0 + tr) * 1024 + h * 128 + 4 * cl);
      *dst = (u32x2){cvtpk(y[0] * bflo(sg[0]), y[1] * bfhi(sg[0])), cvtpk(y[2] * bflo(sg[1]), y[3] * bfhi(sg[1]))};
    }
  }
  __syncthreads();
}

template <bool DRY = false> DI void phase_hanorm(const Ctx& p, int bid, int G) {
  const int tid = tid_fresh(), lane = tid & 63, wave = tid >> 6; bf16_t* hcat = (bf16_t*)(p.ws + WS_H);
  const f32x4 g0 = *(const f32x4*)(karg<A_ANG>() + 8 * lane), g1 = *(const f32x4*)(karg<A_ANG>() + 8 * lane + 4);
  u32x4 wn = {0u, 0u, 0u, 0u};
  { const int row = bid * 8 + wave; if (row < T) wn = *(const u32x4*)(hcat + (size_t)row * 1024 + 512 + 8 * lane); }
  for (int row = bid * 8 + wave; row < T; row += G * 8) {
    u32x4* ptr = (u32x4*)(hcat + (size_t)row * 1024 + 512 + 8 * lane);
    const u32x4 w = wn;
    if (row + G * 8 < T) wn = *(const u32x4*)(hcat + (size_t)(row + G * 8) * 1024 + 512 + 8 * lane);
    float v[8] = {bflo(w[0]), bfhi(w[0]), bflo(w[1]), bfhi(w[1]), bflo(w[2]), bfhi(w[2]), bflo(w[3]), bfhi(w[3])};
    float s = 0.f;
#pragma unroll
    for (int e = 0; e < 8; ++e) s += v[e] * v[e];
    const float rs = rsqrtf(wave_sum(s) * (1.f / 512.f) + RMS_EPS);
    if (DRY) ptr = (u32x4*)((bf16_t*)(p.ws + WS_QKPRE) + (size_t)row * 1024 + 512 + 8 * lane);
    *ptr = (u32x4){cvtpk(v[0] * rs * g0[0], v[1] * rs * g0[1]), cvtpk(v[2] * rs * g0[2], v[3] * rs * g0[3]), cvtpk(v[4] * rs * g1[0], v[5] * rs * g1[1]), cvtpk(v[6] * rs * g1[2], v[7] * rs * g1[3])};
  }
}

template <bool DRY = false> DI void phase_route(const Ctx& p, int bid, int G, LAS unsigned char* lds) {
  const int tid = tid_fresh(), lane = tid & 63, wave = tid >> 6; unsigned char* ws = p.ws;
  LAS float* wreT = (LAS float*)lds;
  LAS float* wrgT = (LAS float*)(lds + 131072);
  LAS int* rec = (LAS int*)(lds + 147456);
  LAS int* lcnt = (LAS int*)(lds + 147456 + 2048);
  { const f32x4* wrt = (const f32x4*)(ws + WS_WRT);
    for (int i = tid; i < 36 * 256; i += NTHREADS) ((LAS f32x4*)lds)[i] = wrt[i]; }
  const float* ln1_g = karg<A_LN1G>(); const float* ln1_b = karg<A_LN1B>(); const float* b_rg = karg<A_BRG>(); const float* b_re = karg<A_BRE>();
  const float* mod = (const float*)(ws + WS_MOD); bf16_t* U = (bf16_t*)(ws + WS_U);
  int* cnt = (int*)(ws + WS_CNT) + (DRY ? 32 * CNT_STRIDE : 0);
  int* ltok = (int*)(ws + (DRY ? WS_HDN : WS_LTOK)); float* lw = (float*)(ws + (DRY ? WS_HDN + 8 * MiB : WS_LW));
  int* toke = (int*)(ws + WS_TOKE) + (DRY ? 2 * T : 0); int* tokp = (int*)(ws + WS_TOKP) + (DRY ? 2 * T : 0);
  const int nk = T / (G * 8);
  __syncthreads();
  f32x4 wg[4][4];
#pragma unroll
  for (int e = 0; e < 4; ++e)
#pragma unroll
    for (int j = 0; j < 4; ++j) wg[e][j] = *(const LAS f32x4*)(wrgT + e * 1024 + 4 * lane + 256 * j);
  for (int k0 = 0; k0 < nk; k0 += 16) {
    if (tid < 32) lcnt[tid] = 0;
    __syncthreads();
    u32x2 zn[4];
    { const u32x2* zr = (const u32x2*)((const bf16_t*)p.out + (size_t)(bid * 8 + wave + k0 * G * 8) * 1024) + lane;
#pragma unroll
      for (int j = 0; j < 4; ++j) zn[j] = zr[64 * j]; }
    for (int kk = 0; kk < 16 && k0 + kk < nk; ++kk) {
      const int row = bid * 8 + wave + (k0 + kk) * G * 8, b = row >> 14;
      u32x2* x1r = (u32x2*)((bf16_t*)(ws + (DRY ? 384 * MiB : WS_H)) + (size_t)row * 1024) + lane;
      f32x4 v[4]; float s = 0.f;
#pragma unroll
      for (int j = 0; j < 4; ++j) { const u32x2 raw = zn[j]; v[j] = (f32x4){bflo(raw[0]), bfhi(raw[0]), bflo(raw[1]), bfhi(raw[1])}; s += (v[j][0] + v[j][1]) + (v[j][2] + v[j][3]); }
      if (kk + 1 < 16 && k0 + kk + 1 < nk) { const u32x2* zr = (const u32x2*)((const bf16_t*)p.out + (size_t)(row + G * 8) * 1024) + lane;
#pragma unroll
        for (int j = 0; j < 4; ++j) zn[j] = zr[64 * j]; }
      float mean = wave_sum(s) * (1.f / 1024.f), s2 = 0.f;
#pragma unroll
      for (int j = 0; j < 4; ++j) { v[j] = v[j] - mean; s2 += (v[j][0] * v[j][0] + v[j][1] * v[j][1]) + (v[j][2] * v[j][2] + v[j][3] * v[j][3]); }
      float rstd = rsqrtf(wave_sum(s2) * (1.f / 1024.f) + LN_EPS);
      s = 0.f;
#pragma unroll
      for (int j = 0; j < 4; ++j) { const int col = 4 * lane + 256 * j;
        v[j] = v[j] * rstd * *(const f32x4*)(ln1_g + col) + *(const f32x4*)(ln1_b + col);
        x1r[64 * j] = (u32x2){cvtpk(v[j][0], v[j][1]), cvtpk(v[j][2], v[j][3])};
        s += (v[j][0] + v[j][1]) + (v[j][2] + v[j][3]); }
      mean = wave_sum(s) * (1.f / 1024.f); s2 = 0.f;
#pragma unroll
      for (int j = 0; j < 4; ++j) { v[j] = v[j] - mean; s2 += (v[j][0] * v[j][0] + v[j][1] * v[j][1]) + (v[j][2] * v[j][2] + v[j][3] * v[j][3]); }
      rstd = rsqrtf(wave_sum(s2) * (1.f / 1024.f) + LN_EPS);
      int* o8 = (int*)((unsigned char*)U + (size_t)row * 1024) + lane;
      float gl[4] = {0.f, 0.f, 0.f, 0.f};
#pragma unroll
      for (int j = 0; j < 4; ++j) { const int col = 4 * lane + 256 * j;
        v[j] = v[j] * rstd * (*(const f32x4*)(mod + b * 6144 + 4096 + col) + 1.f) + *(const f32x4*)(mod + b * 6144 + 3072 + col);
        { int w8 = __builtin_amdgcn_cvt_pk_fp8_f32(v[j][0], v[j][1], 0, false); o8[64 * j] = __builtin_amdgcn_cvt_pk_fp8_f32(v[j][2], v[j][3], w8, true); }
#pragma unroll
        for (int e = 0; e < 4; ++e) { const f32x4 w = wg[e][j]; gl[e] += v[j][0] * w[0] + v[j][1] * w[1] + v[j][2] * w[2] + v[j][3] * w[3]; } }
#pragma unroll
      for (int e = 0; e < 4; ++e) gl[e] = wave_sum(gl[e]) + b_rg[e];
      int gi = 0; float gm = gl[0];
#pragma unroll
      for (int e = 1; e < 4; ++e) if (gl[e] > gm) { gm = gl[e]; gi = e; }
      float gs = 0.f;
#pragma unroll
      for (int e = 0; e < 4; ++e) gs += __expf(gl[e] - gm);
      const float gw = 1.f / gs;
      float el[8] = {0.f, 0.f, 0.f, 0.f, 0.f, 0.f, 0.f, 0.f};
#pragma unroll
      for (int j = 0; j < 4; ++j) { const int col = 4 * lane + 256 * j;
#pragma unroll
        for (int e = 0; e < 8; ++e) { const f32x4 w = *(const LAS f32x4*)(wreT + (gi * 8 + e) * 1024 + col); el[e] += v[j][0] * w[0] + v[j][1] * w[1] + v[j][2] * w[2] + v[j][3] * w[3]; } }
#pragma unroll
      for (int e = 0; e < 8; ++e) el[e] = wave_sum(el[e]) + b_re[gi * 8 + e];
      int i1 = 0; float v1 = el[0];
#pragma unroll
      for (int e = 1; e < 8; ++e) if (el[e] > v1) { v1 = el[e]; i1 = e; }
      int i2 = (i1 == 0) ? 1 : 0; float v2 = (i1 == 0) ? el[1] : el[0];
#pragma unroll
      for (int e = 0; e < 8; ++e) if (e != i1 && el[e] > v2) { v2 = el[e]; i2 = e; }
      const float p1 = 1.f / (1.f + __expf(v2 - v1)), p2 = 1.f - p1;
      if (lane == 0) {
        const int e1 = gi * 8 + i1, e2 = gi * 8 + i2, li = kk * 8 + wave;
        const int q1 = __hip_atomic_fetch_add(&lcnt[e1], 1, __ATOMIC_RELAXED, __HIP_MEMORY_SCOPE_WORKGROUP), q2 = __hip_atomic_fetch_add(&lcnt[e2], 1, __ATOMIC_RELAXED, __HIP_MEMORY_SCOPE_WORKGROUP);
        rec[li * 4 + 0] = e1 | (e2 << 8); rec[li * 4 + 1] = q1 | (q2 << 16); rec[li * 4 + 2] = __float_as_int(p1 * gw); rec[li * 4 + 3] = __float_as_int(p2 * gw);
      }
    }
    __syncthreads();
    if (tid < 32) { const int n = lcnt[tid]; lcnt[32 + tid] = n ? atomicAdd(&cnt[tid * CNT_STRIDE], n) : 0; }
    __syncthreads();
    if (tid < 128 && k0 + (tid >> 3) < nk) {
      const int li = tid, row = bid * 8 + (li & 7) + (k0 + (li >> 3)) * G * 8;
      const int ee = rec[li * 4], qq = rec[li * 4 + 1], e1 = ee & 255, e2 = ee >> 8, q1 = lcnt[32 + e1] + (qq & 0xffff), q2 = lcnt[32 + e2] + (qq >> 16);
      ltok[(size_t)e1 * T + q1] = row; lw[(size_t)e1 * T + q1] = __int_as_float(rec[li * 4 + 2]);
      ltok[(size_t)e2 * T + q2] = row; lw[(size_t)e2 * T + q2] = __int_as_float(rec[li * 4 + 3]);
      toke[row * 2] = e1; toke[row * 2 + 1] = e2; tokp[row * 2] = q1; tokp[row * 2 + 1] = q2;
    }
    __syncthreads();
  }
}

constexpr int MOE_TS = 131072;
DI void moe_table(const Ctx& p, LAS unsigned char* lds) {
  LAS int* ts = (LAS int*)(lds + MOE_TS); const int* cnt = (const int*)(p.ws + WS_CNT);
  if (threadIdx.x < 64) {
    const int lane = threadIdx.x; const int n = lane < 32 ? (cnt[lane * CNT_STRIDE] + 255) >> 8 : 0; int a = n;
#pragma unroll
    for (int o = 1; o < 32; o <<= 1) { const int t = __shfl_up(a, o); a += lane >= o ? t : 0; }
    if (lane < 32) ts[lane] = a - n;
    if (lane == 31) ts[32] = a;
  }
  __syncthreads();
}

template <bool DRY = false> DI void phase_final(const Ctx& p, int bid, int G, LAS unsigned char* lds) {
  const int tid = tid_fresh(), lane = tid & 63, wave = tid >> 6; unsigned char* ws = p.ws;
  const LAS int* ts = (const LAS int*)(lds + MOE_TS); const float* ln2_g = karg<A_LN2G>(); const float* ln2_b = karg<A_LN2B>();
  const float* mod = (const float*)(ws + WS_MOD); const bf16_t* ybuf = (const bf16_t*)(ws + WS_YBUF); const int* toke = (const int*)(ws + WS_TOKE); const int* tokp = (const int*)(ws + WS_TOKP);
  const int stride = G * 8; int row = bid * 8 + wave;
  size_t s0n = 0, s1n = 0;
  u32x2 an[4], cn[4], xn[4];
  auto slots = [&](int r, size_t& a, size_t& c) { a = (size_t)ts[toke[r * 2]] * 256 + tokp[r * 2]; c = (size_t)ts[toke[r * 2 + 1]] * 256 + tokp[r * 2 + 1]; };
  auto loadrow = [&](int r, size_t a, size_t c) {
    const u32x2* x1r = (const u32x2*)((const bf16_t*)(ws + WS_H) + (size_t)r * 1024) + lane;
    const u32x2* y0 = (const u32x2*)(ybuf + a * 1024) + lane; const u32x2* y1 = (const u32x2*)(ybuf + c * 1024) + lane;
#pragma unroll
    for (int j = 0; j < 4; ++j) { an[j] = y0[64 * j]; cn[j] = y1[64 * j]; xn[j] = x1r[64 * j]; } };
  if (row < T) { size_t a, c; slots(row, a, c); loadrow(row, a, c); if (row + stride < T) slots(row + stride, s0n, s1n); }
  for (; row < T; row += stride) {
    const int b = row >> 14;
    f32x4 v[4]; float s = 0.f;
#pragma unroll
    for (int j = 0; j < 4; ++j) { const int col = 4 * lane + 256 * j;
      const u32x2 a = an[j], c = cn[j], xw = xn[j];
      const f32x4 y = {bflo(a[0]) + bflo(c[0]), bfhi(a[0]) + bfhi(c[0]), bflo(a[1]) + bflo(c[1]), bfhi(a[1]) + bfhi(c[1])};
      const f32x4 x1v = {bflo(xw[0]), bfhi(xw[0]), bflo(xw[1]), bfhi(xw[1])};
      v[j] = x1v * ALPHA + (*(const f32x4*)(mod + b * 6144 + 5120 + col) + 1.f) * y;
      s += (v[j][0] + v[j][1]) + (v[j][2] + v[j][3]); }
    if (row + stride < T) { loadrow(row + stride, s0n, s1n); if (row + 2 * stride < T) slots(row + 2 * stride, s0n, s1n); }
    const float mean = wave_sum(s) * (1.f / 1024.f); float s2 = 0.f;
#pragma unroll
    for (int j = 0; j < 4; ++j) { v[j] = v[j] - mean; s2 += (v[j][0] * v[j][0] + v[j][1] * v[j][1]) + (v[j][2] * v[j][2] + v[j][3] * v[j][3]); }
    const float rstd = rsqrtf(wave_sum(s2) * (1.f / 1024.f) + LN_EPS);
    f32x4* xr = (f32x4*)(p.out + (size_t)row * 1024) + lane;
#pragma unroll
    for (int j = 0; j < 4; ++j) { const int col = 4 * lane + 256 * j; xr[64 * j] = v[j] * rstd * *(const f32x4*)(ln2_g + col) + *(const f32x4*)(ln2_b + col); }
  }
}


#define XB_TMO      128
#define XB_XCNT(j)  (256  + 64 * (j))
#define XB_XSUB(j)  (1280 + 64 * (j))
#define XB_XGEN(j)  (2304 + 64 * (j))
#define XB_TOP      3328
#define XB_TOPGEN   3392
#define XCD_BAR_WORDS 3456
#define XB_SPIN_CAP (1u << 18)
DI unsigned xb_ld(unsigned* p)              { return __hip_atomic_load(p, __ATOMIC_RELAXED, __HIP_MEMORY_SCOPE_AGENT); }
DI unsigned xb_add(unsigned* p, unsigned v) { return __hip_atomic_fetch_add(p, v, __ATOMIC_RELAXED, __HIP_MEMORY_SCOPE_AGENT); }
DI unsigned xb_xcc_id() { return (unsigned)__builtin_amdgcn_s_getreg((3 << 11) | 20) & 0xFu; }
#define XB_SPIN(cond, bar) do { unsigned _sp = 0; while (cond) { __builtin_amdgcn_s_sleep(1); \
    if ((++_sp & 255u) == 0u) { if (xb_ld(&(bar)[XB_TMO])) break; if (_sp > XB_SPIN_CAP) { atomicAdd(&(bar)[XB_TMO], 1u); break; } } } } while (0)
struct XcdBarrier { unsigned* bar; unsigned x; volatile LAS unsigned* st; };
DI XcdBarrier xcd_barrier_post(unsigned* bar, volatile LAS unsigned* st) {
  XcdBarrier b; b.bar = bar; b.x = xb_xcc_id(); b.st = st;
  if (threadIdx.x == 0) (void)xb_add(&bar[XB_XCNT(b.x)], 1u);
  return b;
}
DI void xcd_barrier_complete(unsigned* bar, unsigned x, unsigned& nloc, unsigned& nx) {
  const unsigned G = gridDim.x * gridDim.y * gridDim.z;
  unsigned sum, cnt, mine, sp = 0u;
  for (;;) {
    sum = 0u; cnt = 0u; mine = 0u;
#pragma unroll
    for (unsigned j = 0; j < 16; ++j) { const unsigned c = xb_ld(&bar[XB_XCNT(j)]); sum += c; cnt += (c > 0u) ? 1u : 0u; mine = (j == x) ? c : mine; }
    if (sum == G) break;
    __builtin_amdgcn_s_sleep(1);
    if ((++sp & 255u) == 0u) { if (xb_ld(&bar[XB_TMO])) break; if (sp > XB_SPIN_CAP) { atomicAdd(&bar[XB_TMO], 1u); break; } }
  }
  nloc = mine > 0u ? mine : 1u; nx = cnt > 0u ? cnt : 1u;
}
DI void xcd_barrier(const XcdBarrier& b) {
  asm volatile("s_waitcnt vmcnt(0)" ::: "memory");
  __syncthreads();
  if (threadIdx.x == 0) {
    unsigned* bar = b.bar;
    __builtin_amdgcn_s_waitcnt(0);
    unsigned nloc = b.st[0], nx = b.st[1];
    if (nloc == 0u) { xcd_barrier_complete(bar, b.x, nloc, nx); b.st[0] = nloc; b.st[1] = nx; }
    const unsigned old = xb_add(&bar[XB_XSUB(b.x)], 1u);
    const unsigned gen = old / nloc;
    if (old + 1u == (gen + 1u) * nloc) {
      __builtin_amdgcn_fence(__ATOMIC_RELEASE, "agent");
      asm volatile("s_waitcnt vmcnt(0)" ::: "memory");
      const unsigned og = xb_add(&bar[XB_TOP], 1u);
      const unsigned tg = og / nx;
      if (og + 1u == (tg + 1u) * nx) xb_add(&bar[XB_TOPGEN], 1u);
      else XB_SPIN(xb_ld(&bar[XB_TOPGEN]) == tg, bar);
      __builtin_amdgcn_fence(__ATOMIC_ACQUIRE, "agent");
      xb_add(&bar[XB_XGEN(b.x)], 1u);
      asm volatile("s_waitcnt vmcnt(0)" ::: "memory");
    } else {
      XB_SPIN(xb_ld(&bar[XB_XGEN(b.x)]) == gen, bar);
      __builtin_amdgcn_fence(__ATOMIC_ACQUIRE, "agent");
      asm volatile("s_waitcnt vmcnt(0)" ::: "memory");
    }
  }
  __syncthreads();
}

__device__ unsigned g_bar_counter = 0;
DI void grid_barrier(const unsigned G) {
  asm volatile("s_waitcnt vmcnt(0)" ::: "memory");
  __syncthreads();
  if (threadIdx.x == 0) {
    __builtin_amdgcn_fence(__ATOMIC_RELEASE, "agent");
    asm volatile("s_waitcnt vmcnt(0)" ::: "memory");
    const unsigned old = __hip_atomic_fetch_add(&g_bar_counter, 1u, __ATOMIC_RELAXED, __HIP_MEMORY_SCOPE_AGENT);
    const unsigned target = (old / G + 1u) * G;
    unsigned sp = 0;
    while ((int)(__hip_atomic_load(&g_bar_counter, __ATOMIC_RELAXED, __HIP_MEMORY_SCOPE_AGENT) - target) < 0) { __builtin_amdgcn_s_sleep(1); if (++sp > (1u << 24)) break; }
    __builtin_amdgcn_fence(__ATOMIC_ACQUIRE, "agent");
    asm volatile("s_waitcnt vmcnt(0)" ::: "memory");
  }
  __syncthreads();
}

#define KERNEL_HEAD extern __shared__ __attribute__((aligned(16))) unsigned char lds_raw[]; LAS unsigned char* lds = (LAS unsigned char*)lds_raw; const int bid = blockIdx.x, G = gridDim.x; \
  Ctx p; p.ws = karg<A_WS, unsigned char>(); p.out = karg<A_OUT, float>();
#ifdef MULTI_LAUNCH
__global__ void __launch_bounds__(NTHREADS, 2) k_prep(Params) { KERNEL_HEAD phase_prep(p, bid, G, lds); }
__global__ void __launch_bounds__(NTHREADS, 2) k_lnmod(Params) { KERNEL_HEAD (void)lds; phase_lnmod(p, bid, G); }
__global__ void __launch_bounds__(NTHREADS, 2) k_inproj(Params) { KERNEL_HEAD
  unsigned char* ws = p.ws;
  g8::DenseOrder S; S.init(T, N_INP, 1024, ws + WS_WIN, G, bid);
  EpiIn E{(bf16_t*)(ws + WS_QKPRE), (bf16_t*)(ws + WS_VM), (bf16_t*)(ws + WS_H), (bf16_t*)(ws + WS_CQ), (bf16_t*)(ws + WS_CKV), (unsigned char*)(ws + WS_KN), (float*)(ws + WS_GATES),
          (float*)(ws + WS_SSQQ), (float*)(ws + WS_SSQKV), (const float*)(ws + WS_ROPE), karg<A_GATEB>()};
  g8::gemm_phase(lds, (const char*)(ws + WS_U), 1024, S, E);
}
__global__ void __launch_bounds__(NTHREADS, 2) k_mid1(Params) { KERNEL_HEAD
  unsigned char* ws = p.ws;
  { g8::DenseOrder S; S.init(T, 768, 384, ws + WS_WUQ, G, bid); EpiUQ E{(unsigned char*)(ws + WS_QATT), (const float*)(ws + WS_SSQQ), (const float*)(ws + WS_ROPE)};
    g8::gemm_phase(lds, (const char*)(ws + WS_CQ), 384, S, E); }
}
__global__ void __launch_bounds__(NTHREADS, 2) k_mid2(Params) { KERNEL_HEAD
  unsigned char* ws = p.ws;
  { g8::DenseOrder S; S.init(T, 1024, 256, ws + WS_WUKV, G, bid); EpiUKV E{(unsigned char*)(ws + WS_KN), (unsigned char*)(ws + WS_VA), (const float*)(ws + WS_SSQKV)};
    g8::gemm_phase(lds, (const char*)(ws + WS_CKV), 256, S, E); }
}
__global__ void __launch_bounds__(NTHREADS, 2) k_mid3(Params) { KERNEL_HEAD
  for (int u = bid; u < 1024; u += G) { const int c = u & 127, bh = u >> 7; mlstmA_unit(p, bh >> 2, bh & 3, c, lds); }
}
__global__ void __launch_bounds__(NTHREADS, 2) k_scan_attn(Params) { KERNEL_HEAD phase_scan(p, bid, G); phase_attn(p, bid, G, lds); }
__global__ void __launch_bounds__(NTHREADS, 2) k_mlstm_out(Params) { KERNEL_HEAD
  for (int u = bid; u < 1024; u += G) { const int c = u & 127, bh = u >> 7; mlstmC_unit(p, bh >> 2, bh & 3, c, lds); }
  phase_hanorm(p, bid, G);
}
__global__ void __launch_bounds__(NTHREADS, 2) k_outproj(Params) { KERNEL_HEAD
  unsigned char* ws = p.ws;
  g8::DenseOrder S; S.init(T, 1024, 1024, ws + WS_WOUT, G, bid); EpiOut E{karg<A_X>(), (const float*)(ws + WS_MOD), (bf16_t*)p.out};
  g8::gemm_phase(lds, (const char*)(ws + WS_H), 1024, S, E);
}
__global__ void __launch_bounds__(NTHREADS, 2) k_route(Params) { KERNEL_HEAD phase_route(p, bid, G, lds); }
__global__ void __launch_bounds__(NTHREADS, 2) k_moe_gu(Params) { KERNEL_HEAD
  unsigned char* ws = p.ws; moe_table(p, lds);
  MoeOrderGU S; S.tstart = (const LAS int*)(lds + MOE_TS); S.cnt = (const int*)(ws + WS_CNT); S.G = G; S.c = bid; S.ltok = (const int*)(ws + WS_LTOK); S.Bt = (const char*)(ws + WS_WGU);
  EpiGU E{(unsigned char*)(ws + WS_HDN)};
  g8::gemm_phase(lds, (const char*)(ws + WS_U), 512  , S, E);
}
__global__ void __launch_bounds__(NTHREADS, 2) k_moe_dn(Params) { KERNEL_HEAD
  unsigned char* ws = p.ws; moe_table(p, lds);
  MoeOrderDN S; S.tstart = (const LAS int*)(lds + MOE_TS); S.cnt = (const int*)(ws + WS_CNT); S.G = G; S.c = bid; S.Bt = (const char*)(ws + WS_WDN);
  EpiDN E{(bf16_t*)(ws + WS_YBUF), (const float*)(ws + WS_LW)};
  g8::gemm_phase(lds, (const char*)(ws + WS_HDN), 256  , S, E);
}
__global__ void __launch_bounds__(NTHREADS, 2) k_final(Params) { KERNEL_HEAD moe_table(p, lds); phase_final(p, bid, G, lds); }

#endif

__global__ void __launch_bounds__(NTHREADS, 2) k_mega(Params) { KERNEL_HEAD
  unsigned char* ws = p.ws;
  if (bid == 0) for (int i = threadIdx.x; i < XCD_BAR_WORDS; i += NTHREADS) ((unsigned*)(ws + WS_BAR))[i] = 0u;
  if (threadIdx.x < 64) ((LAS unsigned*)(lds + LDS_BARST))[threadIdx.x] = 0u;
  XcdBarrier xbar; xbar.bar = (unsigned*)(ws + WS_BAR); xbar.x = 0; xbar.st = (volatile LAS unsigned*)(lds + LDS_BARST);
  bool xb_ready = false;
#define PHASE_SEP() do { asm volatile("" ::: "memory"); if (!xb_ready) { grid_barrier((unsigned)G); xbar = xcd_barrier_post((unsigned*)(ws + WS_BAR), (volatile LAS unsigned*)(lds + LDS_BARST)); xb_ready = true; } \
    else xcd_barrier(xbar); asm volatile("" ::: "memory"); } while (0)
#define REP(n) for (int rep_ = 0; rep_ < ((n) == DBL_PHASE ? 2 : 1); ++rep_)
  REP(0) phase_prep(p, bid, G, lds);
  PHASE_SEP();
#if MEGA_STOP == 1
  return;
#endif
  REP(1) phase_lnmod(p, bid, G);
  PHASE_SEP();
#if MEGA_STOP == 2
  return;
#endif
  REP(2) { g8::DenseOrder S; S.init(T, N_INP, 1024, ws + WS_WIN, G, bid);
    EpiIn E{(bf16_t*)(ws + WS_QKPRE), (bf16_t*)(ws + WS_VM), (bf16_t*)(ws + WS_H), (bf16_t*)(ws + WS_CQ), (bf16_t*)(ws + WS_CKV), (unsigned char*)(ws + WS_KN), (float*)(ws + WS_GATES),
            (float*)(ws + WS_SSQQ), (float*)(ws + WS_SSQKV), (const float*)(ws + WS_ROPE), karg<A_GATEB>()};
    g8::gemm_phase(lds, (const char*)(ws + WS_U), 1024, S, E);
    { const int first = S.nwg % G, nb = G - first;
      if (bid >= first) { const int tid = tid_fresh(), lane = tid & 63, wave = __builtin_amdgcn_readfirstlane(tid >> 6);
        prep_items(PREP_ITEMS - PREP_DEFER + (bid - first) * 8 + wave, PREP_ITEMS, nb * 8, lane, ws, (LAS float*)(lds + wave * 16384)); } } }
  PHASE_SEP();
#if MEGA_STOP == 3
  return;
#endif
  const bool mfirst = ((bid >> 3) & 1) != 0;
  if (mfirst) { for (int u = bid; u < 1024; u += G) { const int c = u & 127, bh = u >> 7; mlstmA_unit(p, bh >> 2, bh & 3, c, lds); } __syncthreads(); }
  { g8::DenseOrder S; S.init(T, 768, 384, ws + WS_WUQ, G, bid); EpiUQ E{(unsigned char*)(ws + WS_QATT), (const float*)(ws + WS_SSQQ), (const float*)(ws + WS_ROPE)};
    g8::gemm_phase(lds, (const char*)(ws + WS_CQ), 384, S, E); }
  __syncthreads();
  { g8::DenseOrder S; S.init(T, 1024, 256, ws + WS_WUKV, G, bid); EpiUKV E{(unsigned char*)(ws + WS_KN), (unsigned char*)(ws + WS_VA), (const float*)(ws + WS_SSQKV)};
    g8::gemm_phase(lds, (const char*)(ws + WS_CKV), 256, S, E); }
  __syncthreads();
  if (!mfirst) { for (int u = bid; u < 1024; u += G) { const int c = u & 127, bh = u >> 7; mlstmA_unit(p, bh >> 2, bh & 3, c, lds); } }
  PHASE_SEP();
#if MEGA_STOP == 4
  return;
#endif
  phase_scan(p, bid, G);
  REP(4) phase_attn(p, bid, G, lds);
  PHASE_SEP();
#if MEGA_STOP == 5
  return;
#endif
#if DBL_PHASE == 5
  for (int u = bid; u < 1024; u += G) { const int c = u & 127, bh = u >> 7; mlstmC_unit<true>(p, bh >> 2, bh & 3, c, lds); }
#endif
#if DBL_PHASE == 55
  phase_hanorm<true>(p, bid, G);
#endif
  for (int u = bid; u < 1024; u += G) { const int c = u & 127, bh = u >> 7; mlstmC_unit(p, bh >> 2, bh & 3, c, lds); }
  phase_hanorm(p, bid, G);
  PHASE_SEP();
#if MEGA_STOP == 6
  return;
#endif
  REP(6) { g8::DenseOrder S; S.init(T, 1024, 1024, ws + WS_WOUT, G, bid); EpiOut E{karg<A_X>(), (const float*)(ws + WS_MOD), (bf16_t*)p.out};
    g8::gemm_phase(lds, (const char*)(ws + WS_H), 1024, S, E); }
  PHASE_SEP();
#if MEGA_STOP == 7
  return;
#endif
#if DBL_PHASE == 7
  phase_route<true>(p, bid, G, lds);
#endif
  phase_route(p, bid, G, lds);
  PHASE_SEP();
#if MEGA_STOP == 8
  return;
#endif
  moe_table(p, lds);
  REP(8) { MoeOrderGU S; S.tstart = (const LAS int*)(lds + MOE_TS); S.cnt = (const int*)(ws + WS_CNT); S.G = G; S.c = bid; S.ltok = (const int*)(ws + WS_LTOK); S.Bt = (const char*)(ws + WS_WGU);
    EpiGU E{(unsigned char*)(ws + WS_HDN)};
    g8::gemm_phase(lds, (const char*)(ws + WS_U), 512  , S, E); }
  PHASE_SEP();
#if MEGA_STOP == 9
  return;
#endif
  REP(9) { MoeOrderDN S; S.tstart = (const LAS int*)(lds + MOE_TS); S.cnt = (const int*)(ws + WS_CNT); S.G = G; S.c = bid; S.Bt = (const char*)(ws + WS_WDN);
    EpiDN E{(bf16_t*)(ws + WS_YBUF), (const float*)(ws + WS_LW)};
    g8::gemm_phase(lds, (const char*)(ws + WS_HDN), 256  , S, E); }
  PHASE_SEP();
#if MEGA_STOP == 10
  return;
#endif
#if DBL_PHASE == 10
  phase_final<true>(p, bid, G, lds);
#endif
  phase_final(p, bid, G, lds);
#undef REP
#undef PHASE_SEP
}

#ifdef PROBE_OFF
__global__ void __launch_bounds__(NTHREADS, 2) k_probe(Params p, size_t off, size_t n, int is_f32, int from_out) {
  const unsigned char* base = from_out ? (const unsigned char*)p.out : p.ws + off;
  for (size_t i = (size_t)blockIdx.x * NTHREADS + threadIdx.x; i < (size_t)T * D; i += (size_t)gridDim.x * NTHREADS) {
    const size_t j = i % n; float v = is_f32 ? ((const float*)base)[j] : bf2f(((const unsigned short*)base)[j]);
    if (!(fabsf(v) < 1e30f)) v = 777.f;
    if (from_out) { if (j != i) break; ((float*)p.out)[i] = v; } else p.out[i] = v;
  }
}
#endif
extern "C" void kernel_launch(void* const* d_in, const int* in_sizes, int n_in, void* d_out, int out_size, void* d_ws, size_t ws_size, hipStream_t stream) {
  static int ok = 0, grid = 256;
  typedef void (*kfn)(Params);
#ifndef MULTI_LAUNCH
  const kfn kernels[] = {k_mega};
#else
  const kfn kernels[] = {k_prep, k_lnmod, k_inproj, k_mid1, k_mid2, k_mid3, k_scan_attn, k_mlstm_out, k_outproj, k_route, k_moe_gu, k_moe_dn, k_final};
#endif
  if (ok == 0) {
    if (n_in != 27 || in_sizes[0] != T * D || out_size != T * D || ws_size < WS_END) { fprintf(stderr, "kernel_launch: unexpected shapes (n_in %d, in0 %d, out %d, ws %zu)\n", n_in, n_in > 0 ? in_sizes[0] : -1, out_size, ws_size); ok = -1; return; }
    for (kfn k : kernels) if (hipFuncSetAttribute((const void*)k, hipFuncAttributeMaxDynamicSharedMemorySize, LDS_BYTES) != hipSuccess) { fprintf(stderr, "kernel_launch: hipFuncSetAttribute failed\n"); ok = -1; return; }
    int dev = 0, cus = 0, per_cu = 0;
    if (hipGetDevice(&dev) != hipSuccess || hipDeviceGetAttribute(&cus, hipDeviceAttributeMultiprocessorCount, dev) != hipSuccess) { fprintf(stderr, "kernel_launch: device query failed\n"); ok = -1; return; }
    if (hipOccupancyMaxActiveBlocksPerMultiprocessor(&per_cu, (const void*)kernels[0], NTHREADS, LDS_BYTES) != hipSuccess || per_cu < 1) { fprintf(stderr, "kernel_launch: occupancy query says %d blocks/CU\n", per_cu); (void)hipGetLastError(); per_cu = 1; }
    grid = cus < 256 ? cus : 256;
    fprintf(stderr, "kernel_launch: %d CUs, %d blocks/CU by the occupancy query, grid %d\n", cus, per_cu, grid);
    ok = 1;
  }
  if (ok < 0) return;
  Params p{};
  p.x = (const float*)d_in[0]; p.c = (const float*)d_in[1]; p.pos = (const int*)d_in[2]; p.w_ada = (const float*)d_in[3]; p.b_ada = (const float*)d_in[4]; p.w_in = (const float*)d_in[5];
  p.conv_w = (const float*)d_in[6]; p.conv_b = (const float*)d_in[7]; p.gate_b = (const float*)d_in[8]; p.mh_g = (const float*)d_in[9]; p.qn_g = (const float*)d_in[10]; p.kvn_g = (const float*)d_in[11];
  p.w_uq = (const float*)d_in[12]; p.w_ukv = (const float*)d_in[13]; p.an_g = (const float*)d_in[14]; p.w_out = (const float*)d_in[15]; p.ln1_g = (const float*)d_in[16]; p.ln1_b = (const float*)d_in[17];
  p.w_rg = (const float*)d_in[18]; p.b_rg = (const float*)d_in[19]; p.w_re = (const float*)d_in[20]; p.b_re = (const float*)d_in[21]; p.w_gate = (const float*)d_in[22]; p.w_up = (const float*)d_in[23];
  p.w_down = (const float*)d_in[24]; p.ln2_g = (const float*)d_in[25]; p.ln2_b = (const float*)d_in[26];
  p.out = (float*)d_out; p.ws = (unsigned char*)d_ws;
#ifndef NKERN
#define NKERN 6
#endif
  { int ik = 0; for (kfn k : kernels) { if (ik++ >= NKERN) break; hipLaunchKernelGGL(k, dim3(grid), dim3(NTHREADS), LDS_BYTES, stream, p); } }
#ifdef PROBE_OFF
  hipLaunchKernelGGL(k_probe, dim3(1024), dim3(NTHREADS), 0, stream, p, (size_t)(PROBE_OFF), (size_t)(PROBE_N), PROBE_F32, 0);
#endif
  const hipError_t le = hipPeekAtLastError();
  if (le != hipSuccess) fprintf(stderr, "kernel_launch: launch failed: %s\n", hipGetErrorName(le));
}
```

```cpp
#define NKERN 99
#ifndef MEGA_STOP
#define MEGA_STOP 0
#endif
#ifndef DBL_PHASE
#define DBL_PHASE -1
#endif
#include <hip/hip_runtime.h>
#include <cstdio>
#include <cstdint>
#include <cmath>

#define DI __device__ __forceinline__
#define LAS __attribute__((address_space(3)))
typedef unsigned short bf16_t;
typedef short bf16x8 __attribute__((ext_vector_type(8)));
typedef short s16x4 __attribute__((ext_vector_type(4)));
typedef float f32x4 __attribute__((ext_vector_type(4)));
typedef float f32x2 __attribute__((ext_vector_type(2)));
typedef float f32x16 __attribute__((ext_vector_type(16)));
typedef unsigned u32x4 __attribute__((ext_vector_type(4)));
typedef unsigned u32x2 __attribute__((ext_vector_type(2)));

constexpr int BATCH = 2, SEQ = 16384, T = BATCH * SEQ, D = 1024;
constexpr int NCH = SEQ / 128;
constexpr int N_IN = 2768, N_INP = 2816;
constexpr int NEXP = 32;
constexpr float LN_EPS = 1e-5f, RMS_EPS = 1e-6f;
constexpr float ALPHA = 1.189207115002721f;
constexpr float LOG2E = 1.4426950408889634f;
constexpr float QSCALE = 0.07216878364870323f * LOG2E * 16.f;
constexpr int NTHREADS = 512;
constexpr int LDS_BYTES = 148 * 1024;

constexpr size_t MiB = 1u << 20;
constexpr size_t WS_WIN = 0, WS_WUQ = 6 * MiB, WS_WUKV = 7 * MiB, WS_WOUT = 8 * MiB, WS_WGU = 10 * MiB, WS_WDN = 74 * MiB;
constexpr size_t WS_MOD = 106 * MiB, WS_CNT = 106 * MiB + 65536, WS_ROPE = 107 * MiB, WS_GATES = 115 * MiB, WS_GVEC = 117 * MiB;
constexpr size_t WS_SSQQ = 120 * MiB, WS_SSQKV = 122 * MiB, WS_NVEC = 123 * MiB, WS_SCAL = 124 * MiB, WS_TOKE = 125 * MiB, WS_TOKP = 125 * MiB + 512 * 1024;
constexpr size_t WS_U = 128 * MiB, WS_H = 192 * MiB, WS_QKPRE = 256 * MiB, WS_VM = 320 * MiB, WS_CQ = 352 * MiB, WS_CKV = 376 * MiB;
constexpr size_t WS_KROPE = 392 * MiB, WS_QATT = 396 * MiB, WS_KN = 444 * MiB, WS_VA = 476 * MiB, WS_END = 512 * MiB;
constexpr size_t WS_BAR = 106 * MiB + 131072, CTL_ZERO_OFF = WS_CNT, CTL_ZERO_BYTES = 131072;
constexpr int LDS_BARST = LDS_BYTES - 256;
constexpr size_t WS_LTOK = 256 * MiB, WS_LW = 260 * MiB, WS_HDN = 264 * MiB, WS_YBUF = 336 * MiB;
constexpr int MAXTILES = 288;
constexpr int CNT_STRIDE = 64;
constexpr size_t WS_WRT = 126 * MiB;

struct Params {
  const float* x; const float* c; const int* pos; const float* w_ada; const float* b_ada; const float* w_in; const float* conv_w; const float* conv_b;
  const float* gate_b; const float* mh_g; const float* qn_g; const float* kvn_g; const float* w_uq; const float* w_ukv; const float* an_g; const float* w_out;
  const float* ln1_g; const float* ln1_b; const float* w_rg; const float* b_rg; const float* w_re; const float* b_re; const float* w_gate; const float* w_up;
  const float* w_down; const float* ln2_g; const float* ln2_b;
  float* out; unsigned char* ws;
};

enum { A_X = 0, A_C, A_POS, A_WADA, A_BADA, A_WIN, A_CONVW, A_CONVB, A_GATEB, A_MHG, A_QNG, A_KVNG, A_WUQ, A_WUKV, A_ANG, A_WOUT, A_LN1G, A_LN1B, A_WRG, A_BRG, A_WRE, A_BRE,
       A_WGATE, A_WUP, A_WDOWN, A_LN2G, A_LN2B, A_OUT, A_WS };
template <int IDX, class Tp = const float> __device__ __forceinline__ Tp* karg() {
  const unsigned long long k = (unsigned long long)__builtin_amdgcn_kernarg_segment_ptr();
  unsigned long long v;
  asm volatile("s_load_dwordx2 %0, %1, %2\n\ts_waitcnt lgkmcnt(0)" : "=s"(v) : "s"(k), "i"(IDX * 8) : "memory");
  return (Tp*)v;
}
struct Ctx { unsigned char* ws; float* out; };
DI unsigned cvtpk(float lo, float hi) { unsigned r; asm volatile("v_cvt_pk_bf16_f32 %0, %1, %2" : "=v"(r) : "v"(lo), "v"(hi)); return r; }
DI unsigned short f2bf(float f) { unsigned u = __float_as_uint(f); return (unsigned short)((u + 0x7fffu + ((u >> 16) & 1u)) >> 16); }
typedef int v8i __attribute__((ext_vector_type(8)));
typedef int v4i_ __attribute__((ext_vector_type(4)));
DI u32x2 cvt8(f32x4 a, f32x4 b) {
  int w0 = __builtin_amdgcn_cvt_pk_fp8_f32(a[0], a[1], 0, false); w0 = __builtin_amdgcn_cvt_pk_fp8_f32(a[2], a[3], w0, true);
  int w1 = __builtin_amdgcn_cvt_pk_fp8_f32(b[0], b[1], 0, false); w1 = __builtin_amdgcn_cvt_pk_fp8_f32(b[2], b[3], w1, true);
  return (u32x2){(unsigned)w0, (unsigned)w1};
}
DI float bf2f(unsigned short v) { return __uint_as_float(((unsigned)v) << 16); }
DI float bflo(unsigned w) { return __uint_as_float(w << 16); }
DI float bfhi(unsigned w) { return __uint_as_float(w & 0xffff0000u); }
DI int tid_fresh() { int t = threadIdx.x; asm volatile("" : "+v"(t)); return t; }
DI float wave_sum(float v) {
#pragma unroll
  for (int o = 1; o < 64; o <<= 1) v += __shfl_xor(v, o);
  return v;
}
DI float sigmoidf_(float x) { return 1.f / (1.f + __expf(-x)); }
DI float siluf_(float x) { return x / (1.f + __expf(-x)); }
DI float logsigmoidf_(float x) { return fminf(x, 0.f) - log1pf(__expf(-fabsf(x))); }
DI int crow(int r, int hi) { return (r & 3) + 8 * (r >> 2) + 4 * hi; }
#define SBAR() __builtin_amdgcn_sched_barrier(0)
#define KSWZ(row, colB) ((row) * 256 + ((colB) ^ (((row) & 15) << 4)))
#define KRSWZ(row, colB) ((row) * 128 + ((colB) ^ ((((row) >> 1) & 7) << 4)))
#define MFMA32(a, b, c) __builtin_amdgcn_mfma_f32_32x32x16_bf16((a), (b), (c), 0, 0, 0)

DI int v_st(int k, int c) { const int kk = (k & ~0xC) | ((k & 4) << 1) | ((k & 8) >> 1); return ((kk >> 3) * 4 + (c >> 5)) * 512 + ((kk & 7) * 32 + (c & 31)) * 2; }
DI int v_rd_base(int lane) { return ((lane & 3) << 3) | (((lane >> 2) & 3) << 6) | (((lane >> 4) & 1) << 5) | (((lane >> 5) & 1) << 8); }
constexpr int v_rd_off(int d0, int ks, int half) { return d0 * 512 + ks * 4096 + half * 2048; }
template <int OFF> DI s16x4 tr_read(int vb) {
  s16x4 r; asm volatile("ds_read_b64_tr_b16 %0, %1 offset:%2" : "=&v"(r) : "v"(vb), "i"(OFF) : "memory"); return r;
}
#define PKLH(L, H) (bf16x8){L[0], L[1], L[2], L[3], H[0], H[1], H[2], H[3]}
template <int KS> DI bf16x8 tr_frag_nowait(int vb, s16x4& l, s16x4& h) { l = tr_read<v_rd_off(0, KS, 0)>(vb); h = tr_read<v_rd_off(0, KS, 1)>(vb); return PKLH(l, h); }
template <int D0> DI void pv_one(f32x16& od, int vb, bf16x8 pa0, bf16x8 pa1, bf16x8 pa2, bf16x8 pa3) {
  const s16x4 l0 = tr_read<v_rd_off(D0, 0, 0)>(vb), h0 = tr_read<v_rd_off(D0, 0, 1)>(vb), l1 = tr_read<v_rd_off(D0, 1, 0)>(vb), h1 = tr_read<v_rd_off(D0, 1, 1)>(vb);
  const s16x4 l2 = tr_read<v_rd_off(D0, 2, 0)>(vb), h2 = tr_read<v_rd_off(D0, 2, 1)>(vb), l3 = tr_read<v_rd_off(D0, 3, 0)>(vb), h3 = tr_read<v_rd_off(D0, 3, 1)>(vb);
  asm volatile("s_waitcnt lgkmcnt(0)" ::: "memory"); SBAR();
  od = MFMA32(pa0, PKLH(l0, h0), od); od = MFMA32(pa1, PKLH(l1, h1), od); od = MFMA32(pa2, PKLH(l2, h2), od); od = MFMA32(pa3, PKLH(l3, h3), od);
}
DI void pv_d0(f32x16* o, int vb, bf16x8 pa0, bf16x8 pa1, bf16x8 pa2, bf16x8 pa3) {
  pv_one<0>(o[0], vb, pa0, pa1, pa2, pa3); pv_one<1>(o[1], vb, pa0, pa1, pa2, pa3); pv_one<2>(o[2], vb, pa0, pa1, pa2, pa3); pv_one<3>(o[3], vb, pa0, pa1, pa2, pa3);
}
DI void pack_p(const f32x16& p0, const f32x16& p1, bf16x8& pa0, bf16x8& pa1, bf16x8& pa2, bf16x8& pa3) {
#define PK4(P, BASE, OUT) do { unsigned a0 = cvtpk(P[BASE + 0], P[BASE + 1]), a1 = cvtpk(P[BASE + 2], P[BASE + 3]);   \
    unsigned b0 = cvtpk(P[BASE + 4], P[BASE + 5]), b1 = cvtpk(P[BASE + 6], P[BASE + 7]);                              \
    auto r0 = __builtin_amdgcn_permlane32_swap(a0, b0, false, false); auto r1 = __builtin_amdgcn_permlane32_swap(a1, b1, false, false); \
    u32x4 w = {r0[0], r1[0], r0[1], r1[1]}; OUT = *reinterpret_cast<bf16x8*>(&w); } while (0)
  PK4(p0, 0, pa0); PK4(p0, 8, pa1); PK4(p1, 0, pa2); PK4(p1, 8, pa3);
#undef PK4
}
DI float half_swap_sum(float v) { auto rr = __builtin_amdgcn_permlane32_swap(__float_as_uint(v), __float_as_uint(v), false, false); return __uint_as_float(rr[0]) + __uint_as_float(rr[1]); }
DI float half_swap_max(float v) { auto rr = __builtin_amdgcn_permlane32_swap(__float_as_uint(v), __float_as_uint(v), false, false); return fmaxf(__uint_as_float(rr[0]), __uint_as_float(rr[1])); }

namespace g8 {
constexpr int BM = 256, BK = 64, HALF = 128, HTB = HALF * BK * 2, STAGE_BYTES = 8 * HTB;
DI int lds_byte(int r, int c) { const int st = (r >> 4) * 2 + (c >> 5), rr = r & 15, cc = c & 31, ob = rr * 64 + cc * 2; return st * 1024 + (ob ^ (((ob >> 9) & 1) << 5)); }
DI void stage_rc(int b, int& R, int& C) { const int st = b / 1024, sb = b % 1024, swz = sb ^ (((sb >> 9) & 1) << 5); R = (st >> 1) * 16 + swz / 64; C = (st & 1) * 32 + (swz % 64) / 2; }
DI int perm32(int rho) { const int n = rho >> 4, i = rho & 15; return 8 * (i >> 2) + 4 * n + (i & 3); }
struct Unit { int pm, pn, e, j; };

struct NoPre {};
template <class E, class = void> struct PreOf { typedef NoPre type; static constexpr bool has = false; };
template <class E> struct PreOf<E, std::void_t<typename E::Pre>> { typedef typename E::Pre type; static constexpr bool has = true; };
template <class Epi, class Sched>
DI void gemm_phase(LAS unsigned char* lds, const char* Abase, const int Kc, const Sched& S, const Epi& E) {
  constexpr bool GATHER = Sched::GATHER, FP8 = Epi::FP8; constexpr int NBJ = Epi::NBJ;
  int K = Kc; asm volatile("" : "+s"(K));
  const int tid = tid_fresh(), wid = __builtin_amdgcn_readfirstlane(tid >> 6), lane = tid & 63, wr = wid >> 2, wc = wid & 3, fr = lane & 15, fq = lane >> 4;
  const int nt = K / BK;
  unsigned voffA[2], voffB[2];
#pragma unroll
  for (int i = 0; i < 2; ++i) { int R, C; stage_rc(tid * 16 + i * 8192, R, C); const int Rb = Epi::PERM ? ((R & ~31) + perm32(R & 31)) : R; voffA[i] = (unsigned)(R * K + C) * 2u; voffB[i] = (unsigned)(Rb * K + C) * 2u; }
  const size_t kstep = (size_t)(BK * 2);
  const size_t hstepB = (size_t)HALF * K * 2;
  const unsigned ldsw = (unsigned)wid * 1024u;
  const int aoff = lds_byte(wr * 64 + fr, fq * 8), boff = lds_byte(wc * 32 + fr, fq * 8);
#define G8_SA(b, h) (((b) * 2 + (h)) * HTB)
#define G8_SB(b, h) ((4 + (b) * 2 + (h)) * HTB)
#define G8_STAGEB(bufoff, gptr) do { _Pragma("unroll") for (int _i = 0; _i < 2; ++_i) \
    __builtin_amdgcn_global_load_lds((const unsigned*)((const char*)(gptr) + voffB[_i]), (LAS unsigned*)(lds + (bufoff) + ldsw + _i * 8192), 16, 0, 0); } while (0)
#define G8_STAGEA(bufoff, kb, NXT, h) do { _Pragma("unroll") for (int _i = 0; _i < 2; ++_i) { const char* _src; \
    if constexpr (GATHER) _src = Abase + (size_t)(kb) + (size_t)((NXT) ? o2[h][_i] : cuA[h][_i]); else _src = ((NXT) ? a2b : cA) + (size_t)(kb) + (size_t)(h) * hstepB + voffA[_i]; \
    __builtin_amdgcn_global_load_lds((const unsigned*)_src, (LAS unsigned*)(lds + (bufoff) + ldsw + _i * 8192), 16, 0, 0); } } while (0)
#define G8_LD8(ptr) __builtin_shufflevector(*(const LAS v4i_*)(ptr), *(const LAS v4i_*)((ptr) + 1024), 0, 1, 2, 3, 4, 5, 6, 7)
#define G8_LDA(dst, b, h) do { if constexpr (FP8) { _Pragma("unroll") for (int m = 0; m < 4; ++m) dst##8[m] = G8_LD8(lds + G8_SA(b, h) + aoff + m * 2048); } \
    else { _Pragma("unroll") for (int m = 0; m < 4; ++m) _Pragma("unroll") for (int k = 0; k < 2; ++k) dst[m][k] = *(const LAS bf16x8*)(lds + G8_SA(b, h) + aoff + m * 2048 + k * 1024); } } while (0)
#define G8_LDB(dst, b, h) do { if constexpr (FP8) { _Pragma("unroll") for (int n = 0; n < 2; ++n) dst##8[n] = G8_LD8(lds + G8_SB(b, h) + boff + n * 2048); } \
    else { _Pragma("unroll") for (int n = 0; n < 2; ++n) _Pragma("unroll") for (int k = 0; k < 2; ++k) dst[n][k] = *(const LAS bf16x8*)(lds + G8_SB(b, h) + boff + n * 2048 + k * 1024); } } while (0)
#define G8_MMA(ai, bj, At, Bt) do { __builtin_amdgcn_s_setprio(1); \
    if constexpr (FP8) { _Pragma("unroll") for (int m = 0; m < 4; ++m) _Pragma("unroll") for (int n = 0; n < 2; ++n) \
        acc[ai][bj][m][n] = __builtin_amdgcn_mfma_scale_f32_16x16x128_f8f6f4(Bt##8[n], At##8[m], acc[ai][bj][m][n], 0, 0, 0, 122, 0, Epi::ASCALE); } \
    else { _Pragma("unroll") for (int m = 0; m < 4; ++m) _Pragma("unroll") for (int n = 0; n < 2; ++n) _Pragma("unroll") for (int k = 0; k < 2; ++k) \
        acc[ai][bj][m][n] = __builtin_amdgcn_mfma_f32_16x16x32_bf16(Bt[n][k], At[m][k], acc[ai][bj][m][n], 0, 0, 0); } \
    __builtin_amdgcn_s_setprio(0); } while (0)
#define G8_WAIT_V(n) asm volatile("s_waitcnt vmcnt(" #n ")" ::: "memory")
#define G8_WAIT_M do { if constexpr (NBJ == 2) G8_WAIT_V(8); else G8_WAIT_V(6); } while (0)
#define G8_WAIT_L(n) asm volatile("s_waitcnt lgkmcnt(" #n ")" ::: "memory")
#define G8_BAR __builtin_amdgcn_s_barrier()
#define G8_SCHED __builtin_amdgcn_sched_barrier(0)
#define G8_GOFF(dst, u) do { _Pragma("unroll") for (int _i = 0; _i < 2; ++_i) { int _R, _C; stage_rc(tid * 16 + _i * 8192, _R, _C); \
    _Pragma("unroll") for (int _h = 0; _h < 2; ++_h) dst[_h][_i] = S.a_off(u, _R + 128 * _h) + (unsigned)_C * 2u; } } while (0)
  Unit cur, nxt; int ui = 0;
  if (!S.next(0, cur)) return;
  typename PreOf<Epi>::type pre; (void)pre;
  if constexpr (PreOf<Epi>::has) E.pre(cur, wr, fr, pre);
  f32x4 acc[2][NBJ][4][2];
#pragma unroll
  for (int a = 0; a < 2; ++a)
#pragma unroll
    for (int b = 0; b < NBJ; ++b)
#pragma unroll
      for (int m = 0; m < 4; ++m)
#pragma unroll
        for (int n = 0; n < 2; ++n) acc[a][b][m][n] = (f32x4){0.f, 0.f, 0.f, 0.f};
  bf16x8 At[4][2], B0[2][2], B1[2][2]; v8i At8[4], B08[2], B18[2]; (void)At; (void)B0; (void)B1; (void)At8; (void)B08; (void)B18;
  unsigned cuA[2][2], nxA[2][2], o2[2][2];
  const char* cA = Abase; const char* nA = Abase; const char* a2b = Abase;
  if constexpr (GATHER) { G8_GOFF(cuA, cur); } else { cA = Abase + S.a_off(cur, 0); }
  const char* cB = S.b_base(cur);
  (void)voffA; (void)nxA; (void)o2; (void)nA; (void)a2b;
  G8_STAGEB(G8_SB(0, 0), cB); if constexpr (NBJ == 2) G8_STAGEB(G8_SB(0, 1), cB + hstepB); G8_STAGEA(G8_SA(0, 0), 0, false, 0); G8_STAGEA(G8_SA(0, 1), 0, false, 1);
  if (wr == 1) G8_BAR;
  G8_WAIT_V(2); G8_BAR;
  G8_STAGEB(G8_SB(1, 0), cB + kstep); G8_STAGEA(G8_SA(1, 0), kstep, false, 0); if constexpr (NBJ == 2) G8_STAGEB(G8_SB(1, 1), cB + hstepB + kstep);
  if constexpr (NBJ == 2) G8_WAIT_V(6); else G8_WAIT_V(4);
  G8_BAR;
  for (;;) {
    const bool has_next = S.next(ui + 1, nxt);
    const char* nB = cB;
    if (has_next) {
      nB = S.b_base(nxt);
      if constexpr (GATHER) { G8_GOFF(nxA, nxt); } else { nA = Abase + S.a_off(nxt, 0); }
    } else {
      if constexpr (GATHER) {
#pragma unroll
        for (int h = 0; h < 2; ++h)
#pragma unroll
          for (int i = 0; i < 2; ++i) nxA[h][i] = cuA[h][i];
      } else nA = cA;
    }
    for (int t = 0; t < nt; t += 2) {
      const bool last = (t == nt - 2);
      const size_t k1 = (size_t)(t + 1) * kstep;
      const size_t k2 = last ? 0 : (size_t)(t + 2) * kstep, k3 = k2 + kstep;
      if constexpr (GATHER) {
#pragma unroll
        for (int h = 0; h < 2; ++h)
#pragma unroll
          for (int i = 0; i < 2; ++i) o2[h][i] = last ? nxA[h][i] : cuA[h][i];
      } else a2b = last ? nA : cA;
      const char* b2 = last ? nB : cB + (size_t)(t + 2) * kstep; const char* b3 = b2 + kstep;
      G8_LDB(B0, 0, 0); if constexpr (NBJ == 2) G8_LDB(B1, 0, 1); G8_SCHED; G8_LDA(At, 0, 0); G8_STAGEA(G8_SA(1, 1), k1, false, 1);
      G8_WAIT_M; G8_WAIT_L(0); G8_BAR; G8_MMA(0, 0, At, B0); if constexpr (NBJ == 2) G8_MMA(0, 1, At, B1); G8_BAR; G8_SCHED;
      G8_LDA(At, 0, 1); G8_STAGEB(G8_SB(0, 0), b2); if constexpr (NBJ == 2) G8_STAGEB(G8_SB(0, 1), b2 + hstepB); G8_STAGEA(G8_SA(0, 0), k2, true, 0);
      G8_WAIT_M; G8_WAIT_L(0); G8_BAR; G8_MMA(1, 0, At, B0); if constexpr (NBJ == 2) G8_MMA(1, 1, At, B1); G8_BAR; G8_SCHED;
      G8_LDB(B0, 1, 0); if constexpr (NBJ == 2) G8_LDB(B1, 1, 1); G8_SCHED; G8_LDA(At, 1, 0); G8_STAGEA(G8_SA(0, 1), k2, true, 1);
      G8_WAIT_M; G8_WAIT_L(0); G8_BAR; G8_MMA(0, 0, At, B0); if constexpr (NBJ == 2) G8_MMA(0, 1, At, B1); G8_BAR; G8_SCHED;
      G8_LDA(At, 1, 1); G8_STAGEB(G8_SB(1, 0), b3); if constexpr (NBJ == 2) G8_STAGEB(G8_SB(1, 1), b3 + hstepB); G8_STAGEA(G8_SA(1, 0), k3, true, 0);
      G8_WAIT_M; G8_WAIT_L(0); G8_BAR; G8_MMA(1, 0, At, B0); if constexpr (NBJ == 2) G8_MMA(1, 1, At, B1); G8_BAR; G8_SCHED;
    }
    if (wr == 0) G8_BAR;
    G8_SCHED; asm volatile("s_nop 15\n\ts_nop 7" ::: "memory"); G8_SCHED;
    if constexpr (PreOf<Epi>::has) E(acc, cur, wr, wc, fr, fq, pre); else E(acc, cur, wr, wc, fr, fq);
    if (!has_next) break;
#pragma unroll
    for (int a = 0; a < 2; ++a)
#pragma unroll
      for (int b = 0; b < NBJ; ++b)
#pragma unroll
        for (int m = 0; m < 4; ++m)
#pragma unroll
          for (int n = 0; n < 2; ++n) acc[a][b][m][n] = (f32x4){0.f, 0.f, 0.f, 0.f};
    cur = nxt; cB = nB; ++ui;
    if constexpr (PreOf<Epi>::has) E.pre(cur, wr, fr, pre);
    if constexpr (GATHER) {
#pragma unroll
      for (int h = 0; h < 2; ++h)
#pragma unroll
        for (int i = 0; i < 2; ++i) cuA[h][i] = nxA[h][i];
    } else cA = nA;
    if (wr == 1) G8_BAR;
  }
  G8_WAIT_V(0);
  G8_BAR;
#undef G8_SA
#undef G8_SB
#undef G8_STAGEA
#undef G8_STAGEB
#undef G8_LDA
#undef G8_LD8
#undef G8_WAIT_M
#undef G8_LDB
#undef G8_MMA
#undef G8_WAIT_V
#undef G8_WAIT_L
#undef G8_BAR
#undef G8_SCHED
#undef G8_GOFF
}

struct DenseOrder {
  static constexpr bool GATHER = false;
  int nM, nN, nwg, G, c, K; const char* Bt;
  DI void init(int M, int N, int K_, const void* Bt_, int G_, int c_) { nM = M / BM; nN = N / BM; nwg = nM * nN; G = G_; c = c_; K = K_; Bt = (const char*)Bt_; }
  DI bool next(int i, Unit& u) const {
    const long L = (long)i * G + c; if (L >= nwg) return false;
    int wgid = (int)L; { const int q = nwg / 8, r = nwg % 8, xcd = wgid % 8, off = wgid / 8; wgid = (xcd < r ? xcd * (q + 1) : r * (q + 1) + (xcd - r) * q) + off; }
    const int nig = 8 * nN, gid = wgid / nig, fm = gid * 8, gsz = (nM - fm) < 8 ? (nM - fm) : 8;
    u.pm = fm + ((wgid % nig) % gsz); u.pn = (wgid % nig) / gsz; u.e = 0; u.j = 0; return true;
  }
  DI unsigned a_off(const Unit& u, int R) const { return (unsigned)(u.pm * BM + R) * (unsigned)(K * 2); }
  DI const char* b_base(const Unit& u) const { return Bt + (size_t)u.pn * BM * K * 2; }
};
}
using g8::Unit;

struct EpiIn {
  static constexpr bool PERM = true, FP8 = false; static constexpr int NBJ = 2;
  bf16_t* qkpre; bf16_t* vm; bf16_t* hcat; bf16_t* cq; bf16_t* ckv; unsigned char* krope  ; float* gates; float* ssq_q; float* ssq_kv; const float* rope; const float* gate_b;
  DI void operator()(const f32x4 (&acc)[2][2][4][2], const Unit& u, int wr, int wc, int fr, int fq) const {
#pragma unroll
    for (int bj = 0; bj < 2; ++bj) {
      const int cw = u.pn * 256 + bj * 128 + wc * 32, c0 = cw + 8 * fq;
#pragma unroll
      for (int ai = 0; ai < 2; ++ai)
#pragma unroll
        for (int m = 0; m < 4; ++m) {
          const int row = u.pm * 256 + ai * 128 + wr * 64 + m * 16 + fr;
          const f32x4 v0 = acc[ai][bj][m][0], v1 = acc[ai][bj][m][1];
          if (cw < 1024) { u32x4 w = {cvtpk(v0[0], v0[1]), cvtpk(v0[2], v0[3]), cvtpk(v1[0], v1[1]), cvtpk(v1[2], v1[3])}; *(u32x4*)(qkpre + (size_t)row * 1024 + c0) = w; }
          else if (cw < 1536) { u32x4 w = {cvtpk(v0[0], v0[1]), cvtpk(v0[2], v0[3]), cvtpk(v1[0], v1[1]), cvtpk(v1[2], v1[3])}; *(u32x4*)(vm + (size_t)row * 512 + (c0 - 1024)) = w; }
          else if (cw < 2048) { u32x4 w = {cvtpk(sigmoidf_(v0[0]), sigmoidf_(v0[1])), cvtpk(sigmoidf_(v0[2]), sigmoidf_(v0[3])), cvtpk(sigmoidf_(v1[0]), sigmoidf_(v1[1])), cvtpk(sigmoidf_(v1[2]), sigmoidf_(v1[3]))};
                                *(u32x4*)(hcat + (size_t)row * 1024 + (c0 - 1536)) = w; }
          else if (cw < 2688) {
            u32x4 w = {cvtpk(v0[0], v0[1]), cvtpk(v0[2], v0[3]), cvtpk(v1[0], v1[1]), cvtpk(v1[2], v1[3])};
            float s = v0[0] * v0[0] + v0[1] * v0[1] + v0[2] * v0[2] + v0[3] * v0[3] + v1[0] * v1[0] + v1[1] * v1[1] + v1[2] * v1[2] + v1[3] * v1[3];
            s += __shfl_xor(s, 16); s += __shfl_xor(s, 32);
            if (cw < 2432) { *(u32x4*)(cq + (size_t)row * 384 + (c0 - 2048)) = w; if (fq == 0) ssq_q[(size_t)row * 12 + ((cw - 2048) >> 5)] = s; }
            else { *(u32x4*)(ckv + (size_t)row * 256 + (c0 - 2432)) = w; if (fq == 0) ssq_kv[(size_t)row * 8 + ((cw - 2432) >> 5)] = s; }
          }
          else if (cw < 2752) {
            const int i0 = (c0 - 2688) >> 1;
            const f32x4 cs0 = *(const f32x4*)(rope + (size_t)row * 64 + 2 * i0), cs1 = *(const f32x4*)(rope + (size_t)row * 64 + 2 * i0 + 4);
            const float a0 = v0[0] * cs0[0] - v0[1] * cs0[1], b0 = v0[1] * cs0[0] + v0[0] * cs0[1];
            const float a1 = v0[2] * cs0[2] - v0[3] * cs0[3], b1 = v0[3] * cs0[2] + v0[2] * cs0[3];
            const float a2 = v1[0] * cs1[0] - v1[1] * cs1[1], b2 = v1[1] * cs1[0] + v1[0] * cs1[1];
            const float a3 = v1[2] * cs1[2] - v1[3] * cs1[3], b3 = v1[3] * cs1[2] + v1[2] * cs1[3];
            const u32x2 w = cvt8((f32x4){a0, b0, a1, b1}, (f32x4){a2, b2, a3, b3});
            const int b_ = row >> 14, s_ = row & (SEQ - 1);
#pragma unroll
            for (int hh = 0; hh < 4; ++hh) *(u32x2*)(krope + ((size_t)(b_ * 4 + hh) * SEQ + s_) * 192 + 128 + (c0 - 2688)) = w;
          }
          else if (cw == 2752) {
            if (fq < 2) { const f32x4 g0 = *(const f32x4*)(gate_b + 8 * fq), g1 = *(const f32x4*)(gate_b + 8 * fq + 4);
              *(f32x4*)(gates + (size_t)row * 16 + 8 * fq) = v0 + g0; *(f32x4*)(gates + (size_t)row * 16 + 8 * fq + 4) = v1 + g1; }
          }
        }
    }
  }
};
struct EpiUQ {
  static constexpr bool PERM = true, FP8 = false; static constexpr int NBJ = 2;
  unsigned char* qatt; const float* ssq_q; const float* rope;
  DI void operator()(const f32x4 (&acc)[2][2][4][2], const Unit& u, int wr, int wc, int fr, int fq) const {
    float rs[2][4];
#pragma unroll
    for (int ai = 0; ai < 2; ++ai)
#pragma unroll
      for (int m = 0; m < 4; ++m) {
        const int row = u.pm * 256 + ai * 128 + wr * 64 + m * 16 + fr;
        const f32x4 q0 = *(const f32x4*)(ssq_q + (size_t)row * 12), q1 = *(const f32x4*)(ssq_q + (size_t)row * 12 + 4), q2 = *(const f32x4*)(ssq_q + (size_t)row * 12 + 8);
        const float ss = (q0[0] + q0[1] + q0[2] + q0[3]) + (q1[0] + q1[1] + q1[2] + q1[3]) + (q2[0] + q2[1] + q2[2] + q2[3]);
        rs[ai][m] = rsqrtf(ss * (1.f / 384.f) + RMS_EPS) * QSCALE;
        asm volatile("" ::: "memory");
      }
#pragma unroll
    for (int bj = 0; bj < 2; ++bj) {
      const int cw = u.pn * 256 + bj * 128 + wc * 32, h = cw / 192, dw = cw - h * 192, d = dw + 8 * fq;
#pragma unroll
      for (int ai = 0; ai < 2; ++ai)
#pragma unroll
        for (int m = 0; m < 4; ++m) {
          const int row = u.pm * 256 + ai * 128 + wr * 64 + m * 16 + fr, b = row >> 14, s = row & (SEQ - 1);
          const f32x4 v0 = acc[ai][bj][m][0] * rs[ai][m], v1 = acc[ai][bj][m][1] * rs[ai][m];
          u32x2 w;
          if (dw < 128) { w = cvt8(v0, v1); }
          else {
            const int i0 = (d - 128) >> 1;
            const f32x4 cs0 = *(const f32x4*)(rope + (size_t)row * 64 + 2 * i0), cs1 = *(const f32x4*)(rope + (size_t)row * 64 + 2 * i0 + 4);
            const float a0 = v0[0] * cs0[0] - v0[1] * cs0[1], b0 = v0[1] * cs0[0] + v0[0] * cs0[1];
            const float a1 = v0[2] * cs0[2] - v0[3] * cs0[3], b1 = v0[3] * cs0[2] + v0[2] * cs0[3];
            const float a2 = v1[0] * cs1[0] - v1[1] * cs1[1], b2 = v1[1] * cs1[0] + v1[0] * cs1[1];
            const float a3 = v1[2] * cs1[2] - v1[3] * cs1[3], b3 = v1[3] * cs1[2] + v1[2] * cs1[3];
            w = cvt8((f32x4){a0, b0, a1, b1}, (f32x4){a2, b2, a3, b3});
          }
          *(u32x2*)(qatt + ((size_t)(b * 4 + h) * SEQ + s) * 192 + d) = w;
          asm volatile("" ::: "memory");
        }
    }
  }
};
struct EpiUKV {
  static constexpr bool PERM = true, FP8 = false; static constexpr int NBJ = 2;
  unsigned char* kn; unsigned char* vt8; const float* ssq_kv;
  DI void operator()(const f32x4 (&acc)[2][2][4][2], const Unit& u, int wr, int wc, int fr, int fq) const {
#pragma unroll
    for (int ai = 0; ai < 2; ++ai)
#pragma unroll
      for (int m = 0; m < 4; ++m) {
        const int row = u.pm * 256 + ai * 128 + wr * 64 + m * 16 + fr, b = row >> 14, s = row & (SEQ - 1);
        const f32x4 q0 = *(const f32x4*)(ssq_kv + (size_t)row * 8), q1 = *(const f32x4*)(ssq_kv + (size_t)row * 8 + 4);
        const float ss = (q0[0] + q0[1] + q0[2] + q0[3]) + (q1[0] + q1[1] + q1[2] + q1[3]);
        const float rs = rsqrtf(ss * (1.f / 256.f) + RMS_EPS);
        { const f32x4 v0 = acc[ai][0][m][0] * rs, v1 = acc[ai][0][m][1] * rs;
          *(u32x2*)(kn + ((size_t)(b * 4 + u.pn) * SEQ + s) * 192 + wc * 32 + 8 * fq) = cvt8(v0, v1); }
        { const f32x4 v0 = acc[ai][1][m][0] * rs, v1 = acc[ai][1][m][1] * rs;
          const u32x2 w = cvt8(v0, v1);
          const int k = s & 63, kq = k & 31, pos = 32 * ((kq >> 2) & 1) + (kq & 3) + 4 * (kq >> 3) + 16 * (k >> 5);
          unsigned char* dst = vt8 + ((size_t)((b * 4 + u.pn) * 256 + (s >> 6)) * 128 + wc * 32 + 8 * fq) * 64 + pos;
          dst[0] = (unsigned char)w[0]; dst[64] = (unsigned char)(w[0] >> 8); dst[128] = (unsigned char)(w[0] >> 16); dst[192] = (unsigned char)(w[0] >> 24);
          dst[256] = (unsigned char)w[1]; dst[320] = (unsigned char)(w[1] >> 8); dst[384] = (unsigned char)(w[1] >> 16); dst[448] = (unsigned char)(w[1] >> 24); }
        asm volatile("" ::: "memory");
      }
  }
};
struct EpiOut {
  static constexpr bool PERM = true, FP8 = false; static constexpr int NBJ = 2;
  const float* x; const float* mod; bf16_t* z;
  DI void operator()(const f32x4 (&acc)[2][2][4][2], const Unit& u, int wr, int wc, int fr, int fq) const {
#pragma unroll
    for (int ai = 0; ai < 2; ++ai)
#pragma unroll
      for (int m = 0; m < 4; ++m) {
        const int row = u.pm * 256 + ai * 128 + wr * 64 + m * 16 + fr, b = row >> 14;
#pragma unroll
        for (int bj = 0; bj < 2; ++bj) {
          const int c = u.pn * 256 + bj * 128 + wc * 32 + 8 * fq;
          const unsigned off = (unsigned)row * 1024u + (unsigned)c;
          const f32x4 x0 = *(const f32x4*)(x + off), x1 = *(const f32x4*)(x + off + 4), g0 = *(const f32x4*)(mod + b * 6144 + 2048 + c), g1 = *(const f32x4*)(mod + b * 6144 + 2048 + c + 4);
          const f32x4 z0 = x0 * ALPHA + (g0 + 1.f) * acc[ai][bj][m][0], z1 = x1 * ALPHA + (g1 + 1.f) * acc[ai][bj][m][1];
          *(u32x4*)(z + off) = (u32x4){cvtpk(z0[0], z0[1]), cvtpk(z0[2], z0[3]), cvtpk(z1[0], z1[1]), cvtpk(z1[2], z1[3])};
        }
        asm volatile("" ::: "memory");
      }
  }
};
struct EpiGU {
  static constexpr bool PERM = true, FP8 = true; static constexpr int NBJ = 1, ASCALE = 127;
  unsigned char* hdn;
  DI void operator()(const f32x4 (&acc)[2][1][4][2], const Unit& u, int wr, int wc, int fr, int fq) const {
    const unsigned base = ((unsigned)u.pm * 256u + wr * 64 + fr) * 512u + (unsigned)((u.pn * 128 + wc * 32 + 8 * fq) >> 1);
#pragma unroll
    for (int ai = 0; ai < 2; ++ai)
#pragma unroll
      for (int m = 0; m < 4; ++m) {
        const f32x4 g = acc[ai][0][m][0], up = acc[ai][0][m][1] * 8.f;
        int w = __builtin_amdgcn_cvt_pk_fp8_f32(siluf_(g[0]) * up[0], siluf_(g[1]) * up[1], 0, false); w = __builtin_amdgcn_cvt_pk_fp8_f32(siluf_(g[2]) * up[2], siluf_(g[3]) * up[3], w, true);
        *(int*)(hdn + (base + (unsigned)((ai * 128 + m * 16) * 512))) = w;
      }
  }
};
struct EpiDN {
  static constexpr bool PERM = true, FP8 = true; static constexpr int NBJ = 1, ASCALE = 124;
  bf16_t* ybuf; const float* lw;
  struct Pre { float w[2][4]; };
  DI void pre(const Unit& u, int wr, int fr, Pre& P) const {
    const unsigned wbase = ((unsigned)u.e * (unsigned)T + (unsigned)(u.j * 256 + wr * 64 + fr)) * 4u;
#pragma unroll
    for (int ai = 0; ai < 2; ++ai)
#pragma unroll
      for (int m = 0; m < 4; ++m) P.w[ai][m] = *(const float*)((const char*)lw + (wbase + (unsigned)((ai * 128 + m * 16) * 4)));
  }
  DI void operator()(const f32x4 (&acc)[2][1][4][2], const Unit& u, int wr, int wc, int fr, int fq, const Pre& P) const {
    const unsigned base = ((unsigned)u.pm * 256u + wr * 64 + fr) * 2048u + (unsigned)(u.pn * 128 + wc * 32 + 8 * fq) * 2u;
#pragma unroll
    for (int ai = 0; ai < 2; ++ai)
#pragma unroll
      for (int m = 0; m < 4; ++m) {
        const float wgt = P.w[ai][m];
        const f32x4 v0 = acc[ai][0][m][0] * wgt, v1 = acc[ai][0][m][1] * wgt;
        const u32x4 w = {cvtpk(v0[0], v0[1]), cvtpk(v0[2], v0[3]), cvtpk(v1[0], v1[1]), cvtpk(v1[2], v1[3])};
        *(u32x4*)((char*)ybuf + (base + (unsigned)((ai * 128 + m * 16) * 2048))) = w;
        asm volatile("" ::: "memory");
      }
  }
};
struct MoeOrderBase {
  const LAS int* tstart; const int* cnt; int G, c;
  DI bool next(int i, Unit& u) const {
    const int L = i * G + c, NT = tstart[32]; if (L >= NT * 8) return false;
    const int tile = L >> 3; int e = 0;
    for (int k = 1; k < 32; ++k) e = (tstart[k] <= tile) ? k : e;
    u.pm = tile; u.pn = L & 7; u.e = e; u.j = tile - tstart[e]; return true;
  }
};
struct MoeOrderGU : MoeOrderBase {
  static constexpr bool GATHER = true;
  const int* ltok; const char* Bt;
  DI unsigned a_off(const Unit& u, int R) const { const int n = cnt[u.e * CNT_STRIDE]; int idx = u.j * 256 + R; idx = idx < n ? idx : n - 1; return (unsigned)ltok[(size_t)u.e * T + idx] * 1024u; }
  DI const char* b_base(const Unit& u) const { return Bt + ((size_t)u.e * 1024 + u.pn * 128) * 1024; }
};
struct MoeOrderDN : MoeOrderBase {
  static constexpr bool GATHER = false;
  const char* Bt;
  DI unsigned a_off(const Unit& u, int R) const { return (unsigned)(u.pm * 256 + R) * 512u; }
  DI const char* b_base(const Unit& u) const { return Bt + ((size_t)u.e * 1024 + u.pn * 128) * 512; }
};

struct TDesc { const float* src; const float* kscale; bf16_t* dst; int ld, K, k0, n0, ok, fp8; };
DI TDesc tdesc(int r, int lane, unsigned char* ws) {
  constexpr int I_IN = 16 * 88, I_UQ = 6 * 24, I_UKV = 4 * 32, I_OUT = 16 * 32, I_GU = 32 * 16 * 32;
  TDesc d; d.kscale = nullptr; d.fp8 = 0; int sc, kb, nb; const float* W;
  if (r < I_IN) { kb = r / 88; nb = r % 88; const int n = nb * 32 + (lane & 31);
    sc = n < 2048 ? n : n < 2432 ? 2064 + (n - 2048) : n < 2688 ? 2448 + (n - 2432) : n < 2752 ? 2704 + ((n - 2688) & 1) * 32 + ((n - 2688) >> 1) : n < 2768 ? 2048 + (n - 2752) : -1;
    W = karg<A_WIN>(); d.ld = N_IN; d.K = 1024; d.dst = (bf16_t*)(ws + WS_WIN); }
  else if ((r -= I_IN) < I_UQ) { kb = r / 24; nb = r % 24; const int n = nb * 32 + (lane & 31), h = n / 192, dd = n - h * 192;
    sc = dd < 128 ? n : h * 192 + 128 + ((dd - 128) & 1) * 32 + ((dd - 128) >> 1);
    W = karg<A_WUQ>(); d.ld = 768; d.K = 384; d.dst = (bf16_t*)(ws + WS_WUQ); d.kscale = karg<A_QNG>(); }
  else if ((r -= I_UQ) < I_UKV) { kb = r / 32; nb = r % 32; sc = nb * 32 + (lane & 31); W = karg<A_WUKV>(); d.ld = 1024; d.K = 256; d.dst = (bf16_t*)(ws + WS_WUKV); d.kscale = karg<A_KVNG>(); }
  else if ((r -= I_UKV) < I_OUT) { kb = r / 32; nb = r % 32; sc = nb * 32 + (lane & 31); W = karg<A_WOUT>(); d.ld = 1024; d.K = 1024; d.dst = (bf16_t*)(ws + WS_WOUT); }
  else if ((r -= I_OUT) < I_GU) { const int e = r / 512, q = r % 512; kb = q / 32; nb = q % 32;
    const int lr = nb * 32 + (lane & 31), up = (lr >> 2) & 1; sc = (lr >> 3) * 4 + (lr & 3);
    W = (up ? karg<A_WUP>() : karg<A_WGATE>()) + (size_t)e * 1024 * 512; d.ld = 512; d.K = 1024; d.fp8 = 1; d.dst = (bf16_t*)(ws + WS_WGU + (size_t)e * 1024 * 1024); }
  else { r -= I_GU; const int e = r / 256, q = r % 256; kb = q / 32; nb = q % 32; sc = nb * 32 + (lane & 31);
    W = karg<A_WDOWN>() + (size_t)e * 512 * 1024; d.ld = 1024; d.K = 512; d.fp8 = 1; d.dst = (bf16_t*)(ws + WS_WDN + (size_t)e * 1024 * 512); }
  d.k0 = 64 * kb; d.n0 = 32 * nb; d.ok = sc >= 0;
  d.src = W + (size_t)(d.k0 + (lane >> 5)) * d.ld + (sc >= 0 ? sc : 0);
  return d;
}
DI void tload(const TDesc& d, float (&v)[32]) {
#pragma unroll
  for (int i = 0; i < 32; ++i) v[i] = d.src[(size_t)(2 * i) * d.ld];
}
DI void tstore(const TDesc& d, float (&v)[32], LAS float* scr, int lane) {
  if (d.kscale) {
#pragma unroll
    for (int i = 0; i < 32; ++i) v[i] *= d.kscale[d.k0 + 2 * i + (lane >> 5)];
  }
#pragma unroll
  for (int i = 0; i < 32; ++i) scr[(2 * i + (lane >> 5)) * 33 + (lane & 31)] = d.ok ? v[i] : 0.f;
  asm volatile("s_waitcnt lgkmcnt(0)" ::: "memory");
  const int c = lane & 7;
#pragma unroll
  for (int j = 0; j < 4; ++j) { const int n = (lane >> 3) + 8 * j; const LAS float* s = scr + (8 * c) * 33 + n;
    if (d.fp8) { *(u32x2*)((unsigned char*)d.dst + (size_t)(d.n0 + n) * d.K + d.k0 + 8 * c) =
        cvt8((f32x4){s[0 * 33], s[1 * 33], s[2 * 33], s[3 * 33]} * 32.f, (f32x4){s[4 * 33], s[5 * 33], s[6 * 33], s[7 * 33]} * 32.f); }
    else { u32x4 o; o.x = cvtpk(s[0 * 33], s[1 * 33]); o.y = cvtpk(s[2 * 33], s[3 * 33]); o.z = cvtpk(s[4 * 33], s[5 * 33]); o.w = cvtpk(s[6 * 33], s[7 * 33]);
      *(u32x4*)(d.dst + (size_t)(d.n0 + n) * d.K + d.k0 + 8 * c) = o; } }
  asm volatile("s_waitcnt lgkmcnt(0)" ::: "memory");
}
constexpr int PREP_ITEMS = 16 * 88 + 6 * 24 + 4 * 32 + 16 * 32 + 32 * 16 * 32 + 32 * 8 * 32;
constexpr int PREP_DEFER = 8192;
DI void prep_items(int it, const int end, const int stride, const int lane, unsigned char* ws, LAS float* scr) {
  TDesc dA, dB; float vA[32], vB[32];
  if (it < end) { dA = tdesc(it, lane, ws); tload(dA, vA); }
  while (it < end) {
    if (it + stride < end) { dB = tdesc(it + stride, lane, ws); tload(dB, vB); }
    tstore(dA, vA, scr, lane);
    it += stride; if (it >= end) break;
    if (it + stride < end) { dA = tdesc(it + stride, lane, ws); tload(dA, vA); }
    tstore(dB, vB, scr, lane);
    it += stride;
  }
}
DI void phase_prep(const Ctx& p, int bid, int G, LAS unsigned char* lds) {
  const int tid = tid_fresh(), lane = tid & 63, wave = __builtin_amdgcn_readfirstlane(tid >> 6);
  unsigned char* ws = p.ws;
  LAS float* scr = (LAS float*)(lds + wave * 16384);
  LAS float* cact = (LAS float*)(lds + 131072);
  for (int i = tid; i < 2048; i += NTHREADS) cact[i] = siluf_(karg<A_C>()[i]);
  __syncthreads();
  const int gw = bid * 8 + wave, NGW = G * 8;
  constexpr int I_MOD = 192;
  if (bid < I_MOD) {
    const int kg = lane >> 3, cc = lane & 7, col = bid * 32 + 4 * cc; const float* w_ada = karg<A_WADA>() + col;
    f32x4 a0 = {0.f, 0.f, 0.f, 0.f}, a1 = {0.f, 0.f, 0.f, 0.f};
#pragma unroll
    for (int j = 0; j < 16; ++j) { const int k = wave * 128 + kg + 8 * j; const f32x4 w = *(const f32x4*)(w_ada + (size_t)k * 6144); a0 += w * cact[k]; a1 += w * cact[1024 + k]; }
#pragma unroll
    for (int e = 0; e < 4; ++e) {
#pragma unroll
      for (int o = 8; o < 64; o <<= 1) { a0[e] += __shfl_xor(a0[e], o); a1[e] += __shfl_xor(a1[e], o); } }
    LAS f32x4* part = (LAS f32x4*)(lds + 131072 + 8192);
    if (kg == 0) { part[(wave * 8 + cc) * 2] = a0; part[(wave * 8 + cc) * 2 + 1] = a1; }
    __syncthreads();
    if (wave == 0 && kg == 0) { float* mod = (float*)(ws + WS_MOD); const f32x4 bb = *(const f32x4*)(karg<A_BADA>() + col);
      f32x4 s0 = part[cc * 2], s1 = part[cc * 2 + 1];
#pragma unroll
      for (int w = 1; w < 8; ++w) { s0 += part[(w * 8 + cc) * 2]; s1 += part[(w * 8 + cc) * 2 + 1]; }
      *(f32x4*)(mod + col) = s0 + bb; *(f32x4*)(mod + 6144 + col) = s1 + bb; }
  }
#ifndef DBL_PREP
#define DBL_PREP 0
#endif
  for (int rp_ = 0; rp_ < (DBL_PREP == 1 ? 2 : 1); ++rp_) prep_items(gw, PREP_ITEMS - PREP_DEFER, NGW, lane, ws, scr);
  {
    const float INV[32] = {1.000000000e+00f, 7.498942018e-01f, 5.623413324e-01f, 4.216965139e-01f, 3.162277639e-01f, 2.371373773e-01f, 1.778279394e-01f, 1.333521456e-01f,
                           1.000000015e-01f, 7.498942316e-02f, 5.623413250e-02f, 4.216964915e-02f, 3.162277490e-02f, 2.371373773e-02f, 1.778279431e-02f, 1.333521400e-02f,
                           9.999999776e-03f, 7.498942316e-03f, 5.623413250e-03f, 4.216964822e-03f, 3.162277630e-03f, 2.371373819e-03f, 1.778279431e-03f, 1.333521446e-03f,
                           1.000000047e-03f, 7.498941850e-04f, 5.623413017e-04f, 4.216965172e-04f, 3.162277571e-04f, 2.371373703e-04f, 1.778279402e-04f, 1.333521504e-04f};
    f32x2* rope = (f32x2*)(ws + WS_ROPE); const int* pos = karg<A_POS, const int>();
    for (int rp_ = 0; rp_ < (DBL_PREP == 2 ? 2 : 1); ++rp_)
    for (int i = bid * NTHREADS + tid; i < T * 32; i += G * NTHREADS) {
      const int t = i >> 5, fi = i & 31;
      const float ang = (float)pos[t] * INV[fi];
      float sn, cs; sincosf(ang, &sn, &cs); rope[i] = (f32x2){cs, sn};
    }
  }
  if (bid == 0) for (int i = tid; i < 64 * CNT_STRIDE; i += NTHREADS) ((int*)(ws + WS_CNT))[i] = 0;
  { const float* w_re = karg<A_WRE>(); const float* w_rg = karg<A_WRG>(); float* wrt = (float*)(ws + WS_WRT);
    for (int i = bid * NTHREADS + tid; i < 36 * 1024; i += G * NTHREADS) { const int e = i >> 10, k = i & 1023; wrt[i] = e < 32 ? w_re[k * 32 + e] : w_rg[k * 4 + (e - 32)]; } }
}

DI void phase_lnmod(const Ctx& p, int bid, int G) {
  const int tid = tid_fresh(), lane = tid & 63, wave = tid >> 6;
  const float* mod = (const float*)(p.ws + WS_MOD); bf16_t* U = (bf16_t*)(p.ws + WS_U); const float* xin = karg<A_X>();
  f32x4 vn[4];
  { const int row = bid * 8 + wave; if (row < T) { const f32x4* xr = (const f32x4*)(xin + (size_t)row * 1024) + lane;
#pragma unroll
      for (int j = 0; j < 4; ++j) vn[j] = xr[64 * j]; } }
  for (int row = bid * 8 + wave; row < T; row += G * 8) {
    const int b = row >> 14;
    f32x4 v[4]; float s = 0.f;
#pragma unroll
    for (int j = 0; j < 4; ++j) { v[j] = vn[j]; s += (v[j][0] + v[j][1]) + (v[j][2] + v[j][3]); }
    if (row + G * 8 < T) { const f32x4* xr = (const f32x4*)(xin + (size_t)(row + G * 8) * 1024) + lane;
#pragma unroll
      for (int j = 0; j < 4; ++j) vn[j] = xr[64 * j]; }
    const float mean = wave_sum(s) * (1.f / 1024.f); float s2 = 0.f;
#pragma unroll
    for (int j = 0; j < 4; ++j) { v[j] = v[j] - mean; s2 += (v[j][0] * v[j][0] + v[j][1] * v[j][1]) + (v[j][2] * v[j][2] + v[j][3] * v[j][3]); }
    const float rstd = rsqrtf(wave_sum(s2) * (1.f / 1024.f) + LN_EPS);
    u32x2* o8 = (u32x2*)(U + (size_t)row * 1024) + lane;
#pragma unroll
    for (int j = 0; j < 4; ++j) {
      const int col = 4 * lane + 256 * j;
      const f32x4 sh = *(const f32x4*)(mod + b * 6144 + col), sc = *(const f32x4*)(mod + b * 6144 + 1024 + col);
      const f32x4 y = v[j] * rstd * (sc + 1.f) + sh;
      o8[64 * j] = (u32x2){cvtpk(y[0], y[1]), cvtpk(y[2], y[3])};
    }
  }
}

constexpr int PA_V = 0, PA_KF = 32768, PA_KB = 65536, PA_RAWK = 100352, PA_VEC = 135168;
DI void mlstmA_unit(const Ctx& p, int b, int h, int c, LAS unsigned char* lds) {
  const int tid = tid_fresh(), lane = tid & 63, wid = __builtin_amdgcn_readfirstlane(tid >> 6), r32 = lane & 31, hi = lane >> 5;
  unsigned char* ws = p.ws;
  const bf16_t* qkpre = (const bf16_t*)(ws + WS_QKPRE); const bf16_t* vmp = (const bf16_t*)(ws + WS_VM); bf16_t* qkpost = (bf16_t*)(ws + WS_U);
  const float* gates = (const float*)(ws + WS_GATES); float* gvec = (float*)(ws + WS_GVEC); float* nvec = (float*)(ws + WS_NVEC); float* scal = (float*)(ws + WS_SCAL);
  bf16_t* Cbuf = (bf16_t*)p.out;
  LAS float* vec = (LAS float*)(lds + PA_VEC);
  const int bh = b * 4 + h, row0 = b * SEQ + c * 128;
  const int r0 = tid >> 4, c8 = (tid & 15) * 8;
  u32x4 rk[5], rq[5], rv[4];
#pragma unroll
  for (int j = 0; j < 5; ++j) {
    const int rr = r0 + 32 * j, sj = c * 128 + rr - 2; const bool ok = rr < 132 && sj >= 0 && sj < SEQ;
    const bf16_t* src = qkpre + (size_t)(b * SEQ + (ok ? sj : 0)) * 1024 + h * 128 + c8;
    rk[j] = ok ? *(const u32x4*)(src + 512) : (u32x4){0u, 0u, 0u, 0u}; rq[j] = ok ? *(const u32x4*)src : (u32x4){0u, 0u, 0u, 0u};
  }
#pragma unroll
  for (int j = 0; j < 4; ++j) rv[j] = *(const u32x4*)(vmp + (size_t)(row0 + r0 + 32 * j) * 512 + h * 128 + c8);
  float gb = 0.f, gcol = 0.f, gcm = 0.f;
  if (tid < 256) {
    const int dir = tid >> 7, t = tid & 127, wv = (tid >> 6) & 1;
    const float ig = gates[(size_t)(row0 + t) * 16 + (dir * 2) * 4 + h], fg = gates[(size_t)(row0 + t) * 16 + (dir * 2 + 1) * 4 + h];
    float x = logsigmoidf_(fg);
    if (dir == 0) {
#pragma unroll
      for (int o = 1; o < 64; o <<= 1) { const float y = __shfl_up(x, o); if (lane >= o) x += y; }
      if (lane == 63) vec[256 + wv] = x;
    } else {
#pragma unroll
      for (int o = 1; o < 64; o <<= 1) { const float y = __shfl_down(x, o); if (lane + o < 64) x += y; }
      if (lane == 0) vec[258 + wv] = x;
    }
    gb = x; gcol = ig;
  }
  __syncthreads();
  if (tid < 256) {
    const int dir = tid >> 7, wv = (tid >> 6) & 1;
    if (dir == 0) { if (wv == 1) gb += vec[256]; } else { if (wv == 0) gb += vec[259]; }
    gcol = gcol - gb;
    float x = gcol;
    if (dir == 0) {
#pragma unroll
      for (int o = 1; o < 64; o <<= 1) { const float y = __shfl_up(x, o); if (lane >= o) x = fmaxf(x, y); }
      if (lane == 63) vec[260 + wv] = x;
    } else {
#pragma unroll
      for (int o = 1; o < 64; o <<= 1) { const float y = __shfl_down(x, o); if (lane + o < 64) x = fmaxf(x, y); }
      if (lane == 0) vec[262 + wv] = x;
    }
    gcm = x;
  }
  __syncthreads();
  if (tid < 256) {
    const int dir = tid >> 7, t = tid & 127, wv = (tid >> 6) & 1;
    if (dir == 0) { if (wv == 1) gcm = fmaxf(gcm, vec[260]); } else { if (wv == 0) gcm = fmaxf(gcm, vec[263]); }
    const float mx = fmaxf(vec[260 + 2 * dir], vec[261 + 2 * dir]);
    const float tot = vec[256 + 2 * dir] + vec[257 + 2 * dir];
    float* gv = gvec + ((size_t)(dir * 8 + bh) * SEQ + c * 128 + t) * 3;
    gv[0] = gb; gv[1] = gcol; gv[2] = gcm;
    vec[dir * 128 + t] = __expf(gcol - mx);
    if (t == 0) { scal[(dir * 8 + bh) * 128 + c] = tot; scal[2048 + (dir * 8 + bh) * 128 + c] = tot + mx; }
  }
  __syncthreads();
#pragma unroll
  for (int j = 0; j < 5; ++j) { const int rr = r0 + 32 * j;
    if (rr < 132) { *(LAS u32x4*)(lds + PA_RAWK + rr * 256 + c8 * 2) = rk[j]; *(LAS u32x4*)(lds + PA_KB + rr * 256 + c8 * 2) = rq[j]; } }
#pragma unroll
  for (int j = 0; j < 4; ++j) { const int r = r0 + 32 * j; *(LAS u32x4*)(lds + PA_V + (r >> 6) * 16384 + v_st(r & 63, c8)) = rv[j]; }
  __syncthreads();
  const float* conv_w = karg<A_CONVW>(); const float* conv_b = karg<A_CONVB>();
  {
    const int ch = h * 128 + c8;
    float w[5][8], bias[8];
#pragma unroll
    for (int j = 0; j < 5; ++j) { const f32x4 a = *(const f32x4*)(conv_w + j * 1024 + ch), bq = *(const f32x4*)(conv_w + j * 1024 + ch + 4);
      w[j][0] = a[0]; w[j][1] = a[1]; w[j][2] = a[2]; w[j][3] = a[3]; w[j][4] = bq[0]; w[j][5] = bq[1]; w[j][6] = bq[2]; w[j][7] = bq[3]; }
    { const f32x4 a = *(const f32x4*)(conv_b + ch), bq = *(const f32x4*)(conv_b + ch + 4); bias[0] = a[0]; bias[1] = a[1]; bias[2] = a[2]; bias[3] = a[3]; bias[4] = bq[0]; bias[5] = bq[1]; bias[6] = bq[2]; bias[7] = bq[3]; }
#pragma unroll
    for (int ps = 0; ps < 4; ++ps) {
      const int r = r0 + 32 * ps;
      float a[8];
#pragma unroll
      for (int e = 0; e < 8; ++e) a[e] = bias[e];
#pragma unroll
      for (int j = 0; j < 5; ++j) { const u32x4 xv = *(const LAS u32x4*)(lds + PA_KB + (r + j) * 256 + c8 * 2);
        a[0] += w[j][0] * bflo(xv[0]); a[1] += w[j][1] * bfhi(xv[0]); a[2] += w[j][2] * bflo(xv[1]); a[3] += w[j][3] * bfhi(xv[1]);
        a[4] += w[j][4] * bflo(xv[2]); a[5] += w[j][5] * bfhi(xv[2]); a[6] += w[j][6] * bflo(xv[3]); a[7] += w[j][7] * bfhi(xv[3]); }
      const float qs = 0.08838834764831845f;
#pragma unroll
      for (int e = 0; e < 8; ++e) a[e] = siluf_(a[e]) * qs;
      *(u32x4*)(qkpost + (size_t)(row0 + r) * 1024 + ch) = (u32x4){cvtpk(a[0], a[1]), cvtpk(a[2], a[3]), cvtpk(a[4], a[5]), cvtpk(a[6], a[7])};
    }
  }
  __syncthreads();
  {
    const int ch = 512 + h * 128 + c8;
    float w[5][8], bias[8];
#pragma unroll
    for (int j = 0; j < 5; ++j) { const f32x4 a = *(const f32x4*)(conv_w + j * 1024 + ch), bq = *(const f32x4*)(conv_w + j * 1024 + ch + 4);
      w[j][0] = a[0]; w[j][1] = a[1]; w[j][2] = a[2]; w[j][3] = a[3]; w[j][4] = bq[0]; w[j][5] = bq[1]; w[j][6] = bq[2]; w[j][7] = bq[3]; }
    { const f32x4 a = *(const f32x4*)(conv_b + ch), bq = *(const f32x4*)(conv_b + ch + 4); bias[0] = a[0]; bias[1] = a[1]; bias[2] = a[2]; bias[3] = a[3]; bias[4] = bq[0]; bias[5] = bq[1]; bias[6] = bq[2]; bias[7] = bq[3]; }
#pragma unroll
    for (int ps = 0; ps < 4; ++ps) {
      const int r = r0 + 32 * ps;
      float a[8];
#pragma unroll
      for (int e = 0; e < 8; ++e) a[e] = bias[e];
#pragma unroll
      for (int j = 0; j < 5; ++j) { const u32x4 xv = *(const LAS u32x4*)(lds + PA_RAWK + (r + j) * 256 + c8 * 2);
        a[0] += w[j][0] * bflo(xv[0]); a[1] += w[j][1] * bfhi(xv[0]); a[2] += w[j][2] * bflo(xv[1]); a[3] += w[j][3] * bfhi(xv[1]);
        a[4] += w[j][4] * bflo(xv[2]); a[5] += w[j][5] * bfhi(xv[2]); a[6] += w[j][6] * bflo(xv[3]); a[7] += w[j][7] * bfhi(xv[3]); }
#pragma unroll
      for (int e = 0; e < 8; ++e) a[e] = siluf_(a[e]);
      *(u32x4*)(qkpost + (size_t)(row0 + r) * 1024 + ch) = (u32x4){cvtpk(a[0], a[1]), cvtpk(a[2], a[3]), cvtpk(a[4], a[5]), cvtpk(a[6], a[7])};
      const float wf = vec[r], wb = vec[128 + r];
      const u32x4 kf = {cvtpk(a[0] * wf, a[1] * wf), cvtpk(a[2] * wf, a[3] * wf), cvtpk(a[4] * wf, a[5] * wf), cvtpk(a[6] * wf, a[7] * wf)};
      const u32x4 kb = {cvtpk(a[0] * wb, a[1] * wb), cvtpk(a[2] * wb, a[3] * wb), cvtpk(a[4] * wb, a[5] * wb), cvtpk(a[6] * wb, a[7] * wb)};
      const int io = (r >> 6) * 16384 + v_st(r & 63, c8);
      *(LAS u32x4*)(lds + PA_KF + io) = kf; *(LAS u32x4*)(lds + PA_KB + io) = kb;
    }
  }
  __syncthreads();
  {
    const int dir = wid >> 2, dkb = wid & 3;
    const int ka = (int)(uintptr_t)(lds + (dir ? PA_KB : PA_KF)) + v_rd_base(lane) + dkb * 512;
    const int va = (int)(uintptr_t)(lds + PA_V) + v_rd_base(lane);
    f32x16 o[4] = {};
#define PA_STEP(TILE, KS) do { s16x4 al, ah, l0, h0, l1, h1, l2, h2, l3, h3;                                                   \
      al = tr_read<v_rd_off(0, KS, 0)>(ka + TILE * 16384); ah = tr_read<v_rd_off(0, KS, 1)>(ka + TILE * 16384);                 \
      l0 = tr_read<v_rd_off(0, KS, 0)>(va + TILE * 16384); h0 = tr_read<v_rd_off(0, KS, 1)>(va + TILE * 16384);                 \
      l1 = tr_read<v_rd_off(1, KS, 0)>(va + TILE * 16384); h1 = tr_read<v_rd_off(1, KS, 1)>(va + TILE * 16384);                 \
      l2 = tr_read<v_rd_off(2, KS, 0)>(va + TILE * 16384); h2 = tr_read<v_rd_off(2, KS, 1)>(va + TILE * 16384);                 \
      l3 = tr_read<v_rd_off(3, KS, 0)>(va + TILE * 16384); h3 = tr_read<v_rd_off(3, KS, 1)>(va + TILE * 16384);                 \
      asm volatile("s_waitcnt lgkmcnt(0)" ::: "memory"); SBAR();                                                                \
      const bf16x8 A = PKLH(al, ah);                                                                                            \
      o[0] = MFMA32(A, PKLH(l0, h0), o[0]); o[1] = MFMA32(A, PKLH(l1, h1), o[1]); o[2] = MFMA32(A, PKLH(l2, h2), o[2]); o[3] = MFMA32(A, PKLH(l3, h3), o[3]); } while (0)
    PA_STEP(0, 0); PA_STEP(0, 1); PA_STEP(0, 2); PA_STEP(0, 3); PA_STEP(1, 0); PA_STEP(1, 1); PA_STEP(1, 2); PA_STEP(1, 3);
#undef PA_STEP
    bf16_t* Cd = Cbuf + ((size_t)(dir * 8 + bh) * 128 + c) * 16384;
#pragma unroll
    for (int r = 0; r < 16; ++r) { const int dk = dkb * 32 + crow(r, hi);
#pragma unroll
      for (int d0 = 0; d0 < 4; ++d0) Cd[dk * 128 + d0 * 32 + r32] = f2bf(o[d0][r]); }
  }
  if (tid < 256) {
    const int dir = tid >> 7, dk = tid & 127; const LAS unsigned char* img = lds + (dir ? PA_KB : PA_KF);
    float n = 0.f;
#pragma unroll 8
    for (int s = 0; s < 128; ++s) n += bf2f(*(const LAS unsigned short*)(img + (s >> 6) * 16384 + v_st(s & 63, dk)));
    nvec[((size_t)(dir * 8 + bh) * 128 + c) * 128 + dk] = n;
  }
  __syncthreads();
}

DI void phase_scan(const Ctx& p, int bid, int G) {
  const int tid = tid_fresh(); unsigned char* ws = p.ws;
  const float* scal = (const float*)(ws + WS_SCAL); float* mprev = (float*)(ws + WS_SCAL) + 4096; float* nvec = (float*)(ws + WS_NVEC); bf16_t* Cbuf = (bf16_t*)p.out;
  for (int gid = bid * NTHREADS + tid, it = 0; gid < 131072; gid += G * NTHREADS, ++it) {
    const int seq = gid >> 13, e2c = gid & 8191, dir = seq >> 3;
    const bool ex = (it == 0) && (gid < 1024);
    const int seqn = (gid & 1023) >> 6, e2 = gid & 63, dirn = seqn >> 3;
    float m = 0.f, a0 = 0.f, a1 = 0.f, mN = 0.f, n0 = 0.f, n1 = 0.f;
    for (int sb = 0; sb < 128; sb += 8) {
      unsigned raw[8]; f32x2 rawn[8];
#pragma unroll
      for (int q = 0; q < 8; ++q) { const int c = dir ? 127 - (sb + q) : sb + q; raw[q] = *(const unsigned*)(Cbuf + ((size_t)seq * 128 + c) * 16384 + e2c * 2); }
      if (ex) {
#pragma unroll
        for (int q = 0; q < 8; ++q) { const int c = dirn ? 127 - (sb + q) : sb + q; rawn[q] = *(const f32x2*)(nvec + ((size_t)seqn * 128 + c) * 128 + e2 * 2); }
      }
#pragma unroll
      for (int q = 0; q < 8; ++q) {
        const int c = dir ? 127 - (sb + q) : sb + q;
        const float be = scal[seq * 128 + c], ml = scal[2048 + seq * 128 + c];
        *(unsigned*)(Cbuf + ((size_t)seq * 128 + c) * 16384 + e2c * 2) = cvtpk(a0, a1);
        if (e2c == 0) mprev[seq * 128 + c] = m;
        const float mn = fmaxf(be + m, ml), al = __expf(be + m - mn), bt = __expf(ml - mn);
        a0 = al * a0 + bt * bflo(raw[q]); a1 = al * a1 + bt * bfhi(raw[q]);
        m = mn;
      }
      if (ex) {
#pragma unroll
        for (int q = 0; q < 8; ++q) {
          const int c = dirn ? 127 - (sb + q) : sb + q;
          const float be = scal[seqn * 128 + c], ml = scal[2048 + seqn * 128 + c];
          *(f32x2*)(nvec + ((size_t)seqn * 128 + c) * 128 + e2 * 2) = (f32x2){n0, n1};
          const float mn = fmaxf(be + mN, ml), al = __expf(be + mN - mn), bt = __expf(ml - mn);
          n0 = al * n0 + bt * rawn[q][0]; n1 = al * n1 + bt * rawn[q][1];
          mN = mn;
        }
      }
    }
  }
}

DI void qkt8(f32x16& p0, f32x16& p1, const LAS unsigned char* Ks, const bf16x8* qr, int r32, int hi) {
  p0 = f32x16{}; p1 = f32x16{};
#pragma unroll
  for (int d0 = 0; d0 < 8; ++d0) { const int cb = (d0 * 16 + hi * 8) * 2;
    const bf16x8 b0 = *(const LAS bf16x8*)(Ks + KSWZ(r32, cb)), b1 = *(const LAS bf16x8*)(Ks + KSWZ(32 + r32, cb));
    p0 = MFMA32(b0, qr[d0], p0); p1 = MFMA32(b1, qr[d0], p1); }
}
DI v8i kfrag8(const LAS unsigned char* K8, int row, int s, int hi) {
  const int c = 4 * s + 2 * hi;
  const u32x4 lo = *(const LAS u32x4*)(K8 + row * 256 + ((c ^ (row & 15)) << 4)), hi4 = *(const LAS u32x4*)(K8 + row * 256 + (((c + 1) ^ (row & 15)) << 4));
  return (v8i){(int)lo[0], (int)lo[1], (int)lo[2], (int)lo[3], (int)hi4[0], (int)hi4[1], (int)hi4[2], (int)hi4[3]};
}
#define MFMA8(a, b, c) __builtin_amdgcn_mfma_scale_f32_32x32x64_f8f6f4((a), (b), (c), 0, 0, 0, 127, 0, 123)
DI void qkt12(f32x16& p0, f32x16& p1, const LAS unsigned char* K8, const v8i* qr, int r32, int hi) {
  p0 = f32x16{}; p1 = f32x16{};
#pragma unroll
  for (int s = 0; s < 3; ++s) {
    const v8i a0 = kfrag8(K8, r32, s, hi), a1 = kfrag8(K8, 32 + r32, s, hi);
    p0 = MFMA8(a0, qr[s], p0); p1 = MFMA8(a1, qr[s], p1);
  }
}

DI void glds16(const void* gsrc, unsigned lds_dst) {
  unsigned keep;
  asm volatile("s_mov_b32 %0, m0\n\ts_mov_b32 m0, %2\n\ts_nop 0\n\tglobal_load_lds_dwordx4 %1, off\n\ts_mov_b32 m0, %0" : "=&s"(keep) : "v"(gsrc), "s"(lds_dst) : "memory");
}
constexpr int AT_KN = 0, AT_V = 49152, AT_WS = 73728;
constexpr float ATT_THR = 3.f;
DI void partialSM(f32x16& p0, f32x16& p1, float& m_reg, float& mn, float& alpha) {
  float pmax = p0[0];
#pragma unroll
  for (int r = 1; r < 16; ++r) pmax = fmaxf(pmax, p0[r]);
#pragma unroll
  for (int r = 0; r < 16; ++r) pmax = fmaxf(pmax, p1[r]);
  pmax = half_swap_max(pmax);
  if (__builtin_expect(__all(pmax - m_reg <= ATT_THR), 1)) { mn = m_reg; alpha = 1.f; }
  else { mn = fmaxf(m_reg, pmax); alpha = __builtin_amdgcn_exp2f(m_reg - mn); m_reg = mn; }
  const float mo = mn - 5.f;
#pragma unroll
  for (int r = 0; r < 16; ++r) { p0[r] = p0[r] - mo; p1[r] = p1[r] - mo; }
#pragma unroll
  for (int r = 0; r < 16; ++r) p0[r] = __builtin_amdgcn_exp2f(p0[r]);
}
DI void finishSM(f32x16& p0, f32x16& p1, v8i& pa) {
#pragma unroll
  for (int r = 0; r < 16; ++r) p1[r] = __builtin_amdgcn_exp2f(p1[r]);
#pragma unroll
  for (int q = 0; q < 4; ++q) {
    int w = __builtin_amdgcn_cvt_pk_fp8_f32(p0[4 * q], p0[4 * q + 1], pa[q], false); pa[q] = __builtin_amdgcn_cvt_pk_fp8_f32(p0[4 * q + 2], p0[4 * q + 3], w, true);
    w = __builtin_amdgcn_cvt_pk_fp8_f32(p1[4 * q], p1[4 * q + 1], pa[4 + q], false); pa[4 + q] = __builtin_amdgcn_cvt_pk_fp8_f32(p1[4 * q + 2], p1[4 * q + 3], w, true);
  }
}
DI void pv8(f32x16* o, f32x16& lsum, const LAS unsigned char* Vt, v8i pa, int r32, int hi) {
  { const v8i ones = {0x38383838, 0x38383838, 0x38383838, 0x38383838, 0x38383838, 0x38383838, 0x38383838, 0x38383838};
    lsum = __builtin_amdgcn_mfma_scale_f32_32x32x64_f8f6f4(pa, ones, lsum, 0, 0, 0, 122, 0, 127); }
#pragma unroll
  for (int d0 = 0; d0 < 4; ++d0) {
    const int n = 32 * d0 + r32, x = (n >> 2) & 3;
    const u32x4 lo = *(const LAS u32x4*)(Vt + n * 64 + (((2 * hi) ^ x) << 4)), h4 = *(const LAS u32x4*)(Vt + n * 64 + (((2 * hi + 1) ^ x) << 4));
    const v8i bv = {(int)lo[0], (int)lo[1], (int)lo[2], (int)lo[3], (int)h4[0], (int)h4[1], (int)h4[2], (int)h4[3]};
    o[d0] = __builtin_amdgcn_mfma_scale_f32_32x32x64_f8f6f4(pa, bv, o[d0], 0, 0, 0, 122, 0, 127);
  }
}
DI void attn_unit(const unsigned char* Qb, const unsigned char* Knh, const unsigned char* Vh, bf16_t* Ob, LAS unsigned char* lds) {
  const int tid = tid_fresh(), wid = __builtin_amdgcn_readfirstlane(tid >> 6), lane = tid & 63, r32 = lane & 31, hi = lane >> 5;
  LAS float* wsf = (LAS float*)(lds + AT_WS) + wid * 64; LAS float* al_l = wsf + 32;
  constexpr int NT = SEQ / 64;
  unsigned offKn, offV;
  { const int row = wid * 4 + (lane >> 4); int lg = (lane & 15) ^ (row & 15); lg = lg < 12 ? lg : 0; offKn = (unsigned)(row * 192 + lg * 16); }
  { const int n = wid * 16 + (lane >> 2), c = (lane & 3) ^ ((n >> 2) & 3); offV = (unsigned)(n * 64 + c * 16); }
  const unsigned ldsw = (unsigned)wid * 1024u, lds0 = (unsigned)(uintptr_t)lds;
#define DMA16(gptr, ldsoff) glds16((gptr), (unsigned)__builtin_amdgcn_readfirstlane((int)(lds0 + (unsigned)(ldsoff))))
#define ISSUE_K(t, ks) do { const int t_ = (t) < NT ? (t) : NT - 1; const char* kn_ = (const char*)Knh + (size_t)t_ * (64 * 192) + offKn; \
    DMA16(kn_, AT_KN + (ks) * 16384 + ldsw); DMA16(kn_ + 32 * 192, AT_KN + (ks) * 16384 + 8192 + ldsw); } while (0)
#define ISSUE_V(t, vs) do { const int t_ = (t) < NT ? (t) : NT - 1; DMA16((const char*)Vh + (size_t)t_ * 8192 + offV, AT_V + (vs) * 8192 + ldsw); } while (0)
#define WAIT_BAR(N) asm volatile("s_waitcnt vmcnt(" #N ") lgkmcnt(0)\n\ts_barrier" ::: "memory")
#define RESC(a) do { if (__any((a) < 1.f)) { if (hi == 0) al_l[r32] = (a); asm volatile("s_waitcnt lgkmcnt(0)" ::: "memory"); \
    _Pragma("unroll") for (int r = 0; r < 16; ++r) { const float a_ = al_l[crow(r, hi)]; lsum[r] *= a_; _Pragma("unroll") for (int d = 0; d < 4; ++d) o[d][r] *= a_; } } } while (0)
  const bool trail = wid >= 4;
  ISSUE_K(0, 0); ISSUE_K(1, 1); ISSUE_V(0, 0);
  float m_reg = -1e30f; f32x16 lsum = {}; f32x16 o[4] = {}; v8i qr[3];
  { const unsigned char* Qw = Qb + (size_t)(wid * 32 + r32) * 192 + hi * 32;
#pragma unroll
    for (int s_ = 0; s_ < 3; ++s_) { const u32x4 lo = *(const u32x4*)(Qw + s_ * 64), h4 = *(const u32x4*)(Qw + s_ * 64 + 16);
      qr[s_] = (v8i){(int)lo[0], (int)lo[1], (int)lo[2], (int)lo[3], (int)h4[0], (int)h4[1], (int)h4[2], (int)h4[3]}; } }
  f32x16 pA0, pA1, pB0, pB1; float mnA, mnB, alA, alB; v8i pa = {};
  asm volatile("s_waitcnt vmcnt(0)" ::: "memory");
  __builtin_amdgcn_s_barrier();
  if (trail) __builtin_amdgcn_s_barrier();
  ISSUE_K(2, 2);
  qkt12(pA0, pA1, lds + AT_KN, qr, r32, hi);
  WAIT_BAR(3);
  ISSUE_V(1, 1);
  partialSM(pA0, pA1, m_reg, mnA, alA);
  WAIT_BAR(3);
  int s1 = 1;
  for (int j = 1; j + 1 < NT; j += 2) {
    const int s0 = s1 == 0 ? 2 : s1 - 1, s2 = s1 == 2 ? 0 : s1 + 1;
    ISSUE_K(j + 2, s0);
    SBAR(); qkt12(pB0, pB1, lds + AT_KN + s1 * 16384, qr, r32, hi);
    finishSM(pA0, pA1, pa); SBAR();
    WAIT_BAR(3);
    ISSUE_V(j + 1, s2);
    pv8(o, lsum, lds + AT_V + s0 * 8192, pa, r32, hi); partialSM(pB0, pB1, m_reg, mnB, alB);
    RESC(alB);
    WAIT_BAR(3);
    ISSUE_K(j + 3, s1);
    SBAR(); qkt12(pA0, pA1, lds + AT_KN + s2 * 16384, qr, r32, hi);
    finishSM(pB0, pB1, pa); SBAR();
    WAIT_BAR(3);
    ISSUE_V(j + 2, s0);
    pv8(o, lsum, lds + AT_V + s1 * 8192, pa, r32, hi); partialSM(pA0, pA1, m_reg, mnA, alA);
    RESC(alA);
    WAIT_BAR(3);
    s1 = s0;
  }
  {
    const int s0 = s1 == 0 ? 2 : s1 - 1, s2 = s1 == 2 ? 0 : s1 + 1;
    ISSUE_K(NT + 1, s0);
    SBAR(); qkt12(pB0, pB1, lds + AT_KN + s1 * 16384, qr, r32, hi);
    finishSM(pA0, pA1, pa); SBAR();
    WAIT_BAR(3);
    ISSUE_V(NT, s2);
    pv8(o, lsum, lds + AT_V + s0 * 8192, pa, r32, hi); partialSM(pB0, pB1, m_reg, mnB, alB);
    RESC(alB);
    WAIT_BAR(3);
    if (!trail) __builtin_amdgcn_s_barrier();
    finishSM(pB0, pB1, pa); SBAR();
    pv8(o, lsum, lds + AT_V + s1 * 8192, pa, r32, hi);
  }
  float rli[16];
#pragma unroll
  for (int r = 0; r < 16; ++r) rli[r] = __builtin_amdgcn_rcpf(lsum[r]);
  bf16_t* Ow = Ob + (size_t)(wid * 32) * 1024;
#pragma unroll
  for (int r = 0; r < 16; ++r) { const int orow = crow(r, hi);
#pragma unroll
    for (int d0 = 0; d0 < 4; ++d0) Ow[(size_t)orow * 1024 + d0 * 32 + r32] = f2bf(o[d0][r] * rli[r]); }
  asm volatile("s_waitcnt vmcnt(0) lgkmcnt(0)\n\ts_barrier" ::: "memory");
#undef DMA16
#undef ISSUE_K
#undef ISSUE_V
#undef WAIT_BAR
#undef RESC
}
DI void phase_attn(const Ctx& p, int bid, int G, LAS unsigned char* lds) {
  unsigned char* ws = p.ws;
  const unsigned char* qatt = ws + WS_QATT; const unsigned char* k8 = ws + WS_KN; const unsigned char* va = ws + WS_VA;
  bf16_t* hcat = (bf16_t*)(ws + WS_H);
  for (int u = bid; u < 512; u += G) {
    const int bh = u & 7, qb = u >> 3, b = bh >> 2, h = bh & 3;
    attn_unit(qatt + ((size_t)bh * SEQ + qb * 256) * 192, k8 + (size_t)bh * SEQ * 192, va + (size_t)bh * SEQ * 128,
              hcat + (size_t)(b * SEQ + qb * 256) * 1024 + 512 + h * 128, lds);
  }
}

constexpr int PC_K = 0, PC_V = 32768, PC_CF = 65536, PC_CB = 98304, PC_VEC = 131072;
template <bool DRY = false> DI void mlstmC_unit(const Ctx& p, int b, int h, int c, LAS unsigned char* lds) {
  const int tid = tid_fresh(), lane = tid & 63, wid = __builtin_amdgcn_readfirstlane(tid >> 6), r32 = lane & 31, hi = lane >> 5;
  unsigned char* ws = p.ws;
  const bf16_t* qkpost = (const bf16_t*)(ws + WS_U); const bf16_t* vmp = (const bf16_t*)(ws + WS_VM); bf16_t* hcat = (bf16_t*)(ws + WS_H);
  const float* gvec = (const float*)(ws + WS_GVEC); const float* nvec = (const float*)(ws + WS_NVEC); const float* mprev = (const float*)(ws + WS_SCAL) + 4096;
  const bf16_t* Cbuf = (const bf16_t*)p.out;
  LAS float* vec = (LAS float*)(lds + PC_VEC);
  const int bh = b * 4 + h, row0 = b * SEQ + c * 128;
  if (tid < 256) {
    const int dir = tid >> 7, t = tid & 127;
    const float* gv = gvec + ((size_t)(dir * 8 + bh) * SEQ + c * 128 + t) * 3;
    const float gb = gv[0], gcol = gv[1], gcm = gv[2], mp = mprev[(dir * 8 + bh) * 128 + c];
    const float M = fmaxf(mp, gcm);
    vec[dir * 128 + t] = gcol * LOG2E; vec[256 + dir * 128 + t] = M * LOG2E; vec[512 + dir * 128 + t] = __expf(mp - M); vec[768 + dir * 128 + t] = __expf(-(gb + M));
    vec[1024 + dir * 128 + t] = nvec[((size_t)(dir * 8 + bh) * 128 + c) * 128 + t];
  }
  {
    const int r0 = tid >> 4, c8 = (tid & 15) * 8;
    const bf16_t* Cf = Cbuf + ((size_t)(0 * 8 + bh) * 128 + c) * 16384; const bf16_t* Cb = Cbuf + ((size_t)(1 * 8 + bh) * 128 + c) * 16384;
#pragma unroll
    for (int ps = 0; ps < 4; ++ps) {
      const int r = r0 + 32 * ps, tile = r >> 6, rr = r & 63;
      *(LAS u32x4*)(lds + PC_K + tile * 16384 + KSWZ(rr, c8 * 2)) = *(const u32x4*)(qkpost + (size_t)(row0 + r) * 1024 + 512 + h * 128 + c8);
      *(LAS u32x4*)(lds + PC_V + tile * 16384 + v_st(rr, c8)) = *(const u32x4*)(vmp + (size_t)(row0 + r) * 512 + h * 128 + c8);
      *(LAS u32x4*)(lds + PC_CF + tile * 16384 + v_st(rr, c8)) = *(const u32x4*)(Cf + r * 128 + c8);
      *(LAS u32x4*)(lds + PC_CB + tile * 16384 + v_st(rr, c8)) = *(const u32x4*)(Cb + r * 128 + c8);
    }
  }
  const int dir = wid >> 2, tb = wid & 3, t = tb * 32 + r32;
  bf16x8 qr[8];
  { const bf16_t* Qw = qkpost + (size_t)(row0 + t) * 1024 + h * 128 + hi * 8;
#pragma unroll
    for (int d0 = 0; d0 < 8; ++d0) qr[d0] = *(const bf16x8*)(Qw + d0 * 16); }
  __syncthreads();
  const LAS float* vcol = vec + dir * 128; const LAS float* va_ = vec + 512 + dir * 128; const LAS float* vn = vec + 1024 + dir * 128;
  float qn = 0.f;
#pragma unroll
  for (int d0 = 0; d0 < 8; ++d0)
#pragma unroll
    for (int j = 0; j < 8; ++j) qn += bf2f((unsigned short)qr[d0][j]) * vn[d0 * 16 + hi * 8 + j];
  qn = half_swap_sum(qn);
  asm volatile("" : "+v"(qn));
  SBAR();
  f32x16 o[4] = {};
  {
    const int vbc = (int)(uintptr_t)(lds + (dir ? PC_CB : PC_CF)) + v_rd_base(lane);
    pv_d0(o, vbc, qr[0], qr[1], qr[2], qr[3]);
    pv_d0(o, vbc + 16384, qr[4], qr[5], qr[6], qr[7]);
  }
#pragma unroll
  for (int d = 0; d < 4; ++d)
#pragma unroll
    for (int r = 0; r < 16; ++r) o[d][r] *= va_[tb * 32 + crow(r, hi)];
  SBAR();
  const float Mt = vec[256 + dir * 128 + t], at = va_[t], flt = vec[768 + dir * 128 + t];
  float rsum = 0.f;
  const int vbv = (int)(uintptr_t)(lds + PC_V) + v_rd_base(lane);
#pragma unroll
  for (int kt = 0; kt < 2; ++kt) {
    const bool need = dir == 0 ? (kt * 64 <= tb * 32 + 31) : (kt * 64 + 63 >= tb * 32);
    if (need) {
      f32x16 p0, p1; qkt8(p0, p1, lds + PC_K + kt * 16384, qr, r32, hi);
#pragma unroll
      for (int r = 0; r < 16; ++r) {
        const int s0 = kt * 64 + crow(r, hi), s1 = s0 + 32;
        const bool ok0 = dir == 0 ? (s0 <= t) : (s0 >= t), ok1 = dir == 0 ? (s1 <= t) : (s1 >= t);
        const float w0 = __builtin_amdgcn_exp2f(vcol[s0] - Mt), w1 = __builtin_amdgcn_exp2f(vcol[s1] - Mt);
        p0[r] = ok0 ? p0[r] * w0 : 0.f; p1[r] = ok1 ? p1[r] * w1 : 0.f;
        rsum += p0[r] + p1[r];
      }
      bf16x8 pa0, pa1, pa2, pa3; pack_p(p0, p1, pa0, pa1, pa2, pa3);
      pv_d0(o, vbv + kt * 16384, pa0, pa1, pa2, pa3);
    }
  }
  rsum = half_swap_sum(rsum);
  {
    const float den = at * qn + rsum, dn = fmaxf(fabsf(den), flt);
    LAS float* rd = vec + 1280 + dir * 128;
    if (hi == 0) rd[t] = 1.f / dn;
    asm volatile("s_waitcnt lgkmcnt(0)" ::: "memory");
#pragma unroll
    for (int d = 0; d < 4; ++d)
#pragma unroll
      for (int r = 0; r < 16; ++r) o[d][r] *= rd[tb * 32 + crow(r, hi)];
  }
  __syncthreads();
  {
    LAS float* hst = (LAS float*)(lds + dir * 65536);
#pragma unroll
    for (int r = 0; r < 16; ++r) { const int tr = tb * 32 + crow(r, hi);
#pragma unroll
      for (int d = 0; d < 4; ++d) hst[tr * 128 + d * 32 + r32] = o[d][r]; }
  }
  __syncthreads();
  {
    const int rg = tid >> 5, cl = tid & 31;
    const f32x4 g = *(const f32x4*)(karg<A_MHG>() + h * 128 + 4 * cl);
    u32x2 sgv[8];
#pragma unroll
    for (int ps = 0; ps < 8; ++ps) sgv[ps] = *(const u32x2*)(hcat + (size_t)(row0 + ps * 16 + rg) * 1024 + h * 128 + 4 * cl);
#pragma unroll
    for (int ps = 0; ps < 8; ++ps) {
      const int tr = ps * 16 + rg;
      const f32x4 xf = *(const LAS f32x4*)(lds + (tr * 128 + 4 * cl) * 4), xb = *(const LAS f32x4*)(lds + 65536 + (tr * 128 + 4 * cl) * 4);
      f32x4 x = xf + xb;
      float s = (x[0] + x[1]) + (x[2] + x[3]);
#pragma unroll
      for (int o_ = 1; o_ < 32; o_ <<= 1) s += __shfl_xor(s, o_);
      const float mu = s * (1.f / 128.f); x = x - mu;
      float q = (x[0] * x[0] + x[1] * x[1]) + (x[2] * x[2] + x[3] * x[3]);
#pragma unroll
      for (int o_ = 1; o_ < 32; o_ <<= 1) q += __shfl_xor(q, o_);
      const float rstd = rsqrtf(q * (1.f / 128.f) + LN_EPS);
      u32x2* dst = (u32x2*)(hcat + (size_t)(row0 + tr) * 1024 + h * 128 + 4 * cl);
      const u32x2 sg = sgv[ps];
      const f32x4 y = x * rstd * g;
      if (DRY) dst = (u32x2*)((bf16_t*)(ws + WS_QKPRE) + (size_t)(row0 + tr) * 1024 + h * 128 + 4 * cl);
      *dst = (u32x2){cvtpk(y[0] * bflo(sg[0]), y[1] * bfhi(sg[0])), cvtpk(y[2] * bflo(sg[1]), y[3] * bfhi(sg[1]))};
    }
  }
  __syncthreads();
}

template <bool DRY = false> DI void phase_hanorm(const Ctx& p, int bid, int G) {
  const int tid = tid_fresh(), lane = tid & 63, wave = tid >> 6; bf16_t* hcat = (bf16_t*)(p.ws + WS_H);
  const f32x4 g0 = *(const f32x4*)(karg<A_ANG>() + 8 * lane), g1 = *(const f32x4*)(karg<A_ANG>() + 8 * lane + 4);
  u32x4 wn = {0u, 0u, 0u, 0u};
  { const int row = bid * 8 + wave; if (row < T) wn = *(const u32x4*)(hcat + (size_t)row * 1024 + 512 + 8 * lane); }
  for (int row = bid * 8 + wave; row < T; row += G * 8) {
    u32x4* ptr = (u32x4*)(hcat + (size_t)row * 1024 + 512 + 8 * lane);
    const u32x4 w = wn;
    if (row + G * 8 < T) wn = *(const u32x4*)(hcat + (size_t)(row + G * 8) * 1024 + 512 + 8 * lane);
    float v[8] = {bflo(w[0]), bfhi(w[0]), bflo(w[1]), bfhi(w[1]), bflo(w[2]), bfhi(w[2]), bflo(w[3]), bfhi(w[3])};
    float s = 0.f;
#pragma unroll
    for (int e = 0; e < 8; ++e) s += v[e] * v[e];
    const float rs = rsqrtf(wave_sum(s) * (1.f / 512.f) + RMS_EPS);
    if (DRY) ptr = (u32x4*)((bf16_t*)(p.ws + WS_QKPRE) + (size_t)row * 1024 + 512 + 8 * lane);
    *ptr = (u32x4){cvtpk(v[0] * rs * g0[0], v[1] * rs * g0[1]), cvtpk(v[2] * rs * g0[2], v[3] * rs * g0[3]), cvtpk(v[4] * rs * g1[0], v[5] * rs * g1[1]), cvtpk(v[6] * rs * g1[2], v[7] * rs * g1[3])};
  }
}

template <bool DRY = false> DI void phase_route(const Ctx& p, int bid, int G, LAS unsigned char* lds) {
  const int tid = tid_fresh(), lane = tid & 63, wave = tid >> 6; unsigned char* ws = p.ws;
  LAS float* wreT = (LAS float*)lds;
  LAS float* wrgT = (LAS float*)(lds + 131072);
  LAS int* rec = (LAS int*)(lds + 147456);
  LAS int* lcnt = (LAS int*)(lds + 147456 + 2048);
  { const f32x4* wrt = (const f32x4*)(ws + WS_WRT);
    for (int i = tid; i < 36 * 256; i += NTHREADS) ((LAS f32x4*)lds)[i] = wrt[i]; }
  const float* ln1_g = karg<A_LN1G>(); const float* ln1_b = karg<A_LN1B>(); const float* b_rg = karg<A_BRG>(); const float* b_re = karg<A_BRE>();
  const float* mod = (const float*)(ws + WS_MOD); bf16_t* U = (bf16_t*)(ws + WS_U);
  int* cnt = (int*)(ws + WS_CNT) + (DRY ? 32 * CNT_STRIDE : 0);
  int* ltok = (int*)(ws + (DRY ? WS_HDN : WS_LTOK)); float* lw = (float*)(ws + (DRY ? WS_HDN + 8 * MiB : WS_LW));
  int* toke = (int*)(ws + WS_TOKE) + (DRY ? 2 * T : 0); int* tokp = (int*)(ws + WS_TOKP) + (DRY ? 2 * T : 0);
  const int nk = T / (G * 8);
  __syncthreads();
  f32x4 wg[4][4];
#pragma unroll
  for (int e = 0; e < 4; ++e)
#pragma unroll
    for (int j = 0; j < 4; ++j) wg[e][j] = *(const LAS f32x4*)(wrgT + e * 1024 + 4 * lane + 256 * j);
  for (int k0 = 0; k0 < nk; k0 += 16) {
    if (tid < 32) lcnt[tid] = 0;
    __syncthreads();
    u32x2 zn[4];
    { const u32x2* zr = (const u32x2*)((const bf16_t*)p.out + (size_t)(bid * 8 + wave + k0 * G * 8) * 1024) + lane;
#pragma unroll
      for (int j = 0; j < 4; ++j) zn[j] = zr[64 * j]; }
    for (int kk = 0; kk < 16 && k0 + kk < nk; ++kk) {
      const int row = bid * 8 + wave + (k0 + kk) * G * 8, b = row >> 14;
      u32x2* x1r = (u32x2*)((bf16_t*)(ws + (DRY ? 384 * MiB : WS_H)) + (size_t)row * 1024) + lane;
      f32x4 v[4]; float s = 0.f;
#pragma unroll
      for (int j = 0; j < 4; ++j) { const u32x2 raw = zn[j]; v[j] = (f32x4){bflo(raw[0]), bfhi(raw[0]), bflo(raw[1]), bfhi(raw[1])}; s += (v[j][0] + v[j][1]) + (v[j][2] + v[j][3]); }
      if (kk + 1 < 16 && k0 + kk + 1 < nk) { const u32x2* zr = (const u32x2*)((const bf16_t*)p.out + (size_t)(row + G * 8) * 1024) + lane;
#pragma unroll
        for (int j = 0; j < 4; ++j) zn[j] = zr[64 * j]; }
      float mean = wave_sum(s) * (1.f / 1024.f), s2 = 0.f;
#pragma unroll
      for (int j = 0; j < 4; ++j) { v[j] = v[j] - mean; s2 += (v[j][0] * v[j][0] + v[j][1] * v[j][1]) + (v[j][2] * v[j][2] + v[j][3] * v[j][3]); }
      float rstd = rsqrtf(wave_sum(s2) * (1.f / 1024.f) + LN_EPS);
      s = 0.f;
#pragma unroll
      for (int j = 0; j < 4; ++j) { const int col = 4 * lane + 256 * j;
        v[j] = v[j] * rstd * *(const f32x4*)(ln1_g + col) + *(const f32x4*)(ln1_b + col);
        x1r[64 * j] = (u32x2){cvtpk(v[j][0], v[j][1]), cvtpk(v[j][2], v[j][3])};
        s += (v[j][0] + v[j][1]) + (v[j][2] + v[j][3]); }
      mean = wave_sum(s) * (1.f / 1024.f); s2 = 0.f;
#pragma unroll
      for (int j = 0; j < 4; ++j) { v[j] = v[j] - mean; s2 += (v[j][0] * v[j][0] + v[j][1] * v[j][1]) + (v[j][2] * v[j][2] + v[j][3] * v[j][3]); }
      rstd = rsqrtf(wave_sum(s2) * (1.f / 1024.f) + LN_EPS);
      int* o8 = (int*)((unsigned char*)U + (size_t)row * 1024) + lane;
      float gl[4] = {0.f, 0.f, 0.f, 0.f};
#pragma unroll
      for (int j = 0; j < 4; ++j) { const int col = 4 * lane + 256 * j;
        v[j] = v[j] * rstd * (*(const f32x4*)(mod + b * 6144 + 4096 + col) + 1.f) + *(const f32x4*)(mod + b * 6144 + 3072 + col);
        { int w8 = __builtin_amdgcn_cvt_pk_fp8_f32(v[j][0], v[j][1], 0, false); o8[64 * j] = __builtin_amdgcn_cvt_pk_fp8_f32(v[j][2], v[j][3], w8, true); }
#pragma unroll
        for (int e = 0; e < 4; ++e) { const f32x4 w = wg[e][j]; gl[e] += v[j][0] * w[0] + v[j][1] * w[1] + v[j][2] * w[2] + v[j][3] * w[3]; } }
#pragma unroll
      for (int e = 0; e < 4; ++e) gl[e] = wave_sum(gl[e]) + b_rg[e];
      int gi = 0; float gm = gl[0];
#pragma unroll
      for (int e = 1; e < 4; ++e) if (gl[e] > gm) { gm = gl[e]; gi = e; }
      float gs = 0.f;
#pragma unroll
      for (int e = 0; e < 4; ++e) gs += __expf(gl[e] - gm);
      const float gw = 1.f / gs;
      float el[8] = {0.f, 0.f, 0.f, 0.f, 0.f, 0.f, 0.f, 0.f};
#pragma unroll
      for (int j = 0; j < 4; ++j) { const int col = 4 * lane + 256 * j;
#pragma unroll
        for (int e = 0; e < 8; ++e) { const f32x4 w = *(const LAS f32x4*)(wreT + (gi * 8 + e) * 1024 + col); el[e] += v[j][0] * w[0] + v[j][1] * w[1] + v[j][2] * w[2] + v[j][3] * w[3]; } }
#pragma unroll
      for (int e = 0; e < 8; ++e) el[e] = wave_sum(el[e]) + b_re[gi * 8 + e];
      int i1 = 0; float v1 = el[0];
#pragma unroll
      for (int e = 1; e < 8; ++e) if (el[e] > v1) { v1 = el[e]; i1 = e; }
      int i2 = (i1 == 0) ? 1 : 0; float v2 = (i1 == 0) ? el[1] : el[0];
#pragma unroll
      for (int e = 0; e < 8; ++e) if (e != i1 && el[e] > v2) { v2 = el[e]; i2 = e; }
      const float p1 = 1.f / (1.f + __expf(v2 - v1)), p2 = 1.f - p1;
      if (lane == 0) {
        const int e1 = gi * 8 + i1, e2 = gi * 8 + i2, li = kk * 8 + wave;
        const int q1 = __hip_atomic_fetch_add(&lcnt[e1], 1, __ATOMIC_RELAXED, __HIP_MEMORY_SCOPE_WORKGROUP), q2 = __hip_atomic_fetch_add(&lcnt[e2], 1, __ATOMIC_RELAXED, __HIP_MEMORY_SCOPE_WORKGROUP);
        rec[li * 4 + 0] = e1 | (e2 << 8); rec[li * 4 + 1] = q1 | (q2 << 16); rec[li * 4 + 2] = __float_as_int(p1 * gw); rec[li * 4 + 3] = __float_as_int(p2 * gw);
      }
    }
    __syncthreads();
    if (tid < 32) { const int n = lcnt[tid]; lcnt[32 + tid] = n ? atomicAdd(&cnt[tid * CNT_STRIDE], n) : 0; }
    __syncthreads();
    if (tid < 128 && k0 + (tid >> 3) < nk) {
      const int li = tid, row = bid * 8 + (li & 7) + (k0 + (li >> 3)) * G * 8;
      const int ee = rec[li * 4], qq = rec[li * 4 + 1], e1 = ee & 255, e2 = ee >> 8, q1 = lcnt[32 + e1] + (qq & 0xffff), q2 = lcnt[32 + e2] + (qq >> 16);
      ltok[(size_t)e1 * T + q1] = row; lw[(size_t)e1 * T + q1] = __int_as_float(rec[li * 4 + 2]);
      ltok[(size_t)e2 * T + q2] = row; lw[(size_t)e2 * T + q2] = __int_as_float(rec[li * 4 + 3]);
      toke[row * 2] = e1; toke[row * 2 + 1] = e2; tokp[row * 2] = q1; tokp[row * 2 + 1] = q2;
    }
    __syncthreads();
  }
}

constexpr int MOE_TS = 131072;
DI void moe_table(const Ctx& p, LAS unsigned char* lds) {
  LAS int* ts = (LAS int*)(lds + MOE_TS); const int* cnt = (const int*)(p.ws + WS_CNT);
  if (threadIdx.x < 64) {
    const int lane = threadIdx.x; const int n = lane < 32 ? (cnt[lane * CNT_STRIDE] + 255) >> 8 : 0; int a = n;
#pragma unroll
    for (int o = 1; o < 32; o <<= 1) { const int t = __shfl_up(a, o); a += lane >= o ? t : 0; }
    if (lane < 32) ts[lane] = a - n;
    if (lane == 31) ts[32] = a;
  }
  __syncthreads();
}

template <bool DRY = false> DI void phase_final(const Ctx& p, int bid, int G, LAS unsigned char* lds) {
  const int tid = tid_fresh(), lane = tid & 63, wave = tid >> 6; unsigned char* ws = p.ws;
  const LAS int* ts = (const LAS int*)(lds + MOE_TS); const float* ln2_g = karg<A_LN2G>(); const float* ln2_b = karg<A_LN2B>();
  const float* mod = (const float*)(ws + WS_MOD); const bf16_t* ybuf = (const bf16_t*)(ws + WS_YBUF); const int* toke = (const int*)(ws + WS_TOKE); const int* tokp = (const int*)(ws + WS_TOKP);
  const int stride = G * 8; int row = bid * 8 + wave;
  size_t s0n = 0, s1n = 0;
  u32x2 an[4], cn[4], xn[4];
  auto slots = [&](int r, size_t& a, size_t& c) { a = (size_t)ts[toke[r * 2]] * 256 + tokp[r * 2]; c = (size_t)ts[toke[r * 2 + 1]] * 256 + tokp[r * 2 + 1]; };
  auto loadrow = [&](int r, size_t a, size_t c) {
    const u32x2* x1r = (const u32x2*)((const bf16_t*)(ws + WS_H) + (size_t)r * 1024) + lane;
    const u32x2* y0 = (const u32x2*)(ybuf + a * 1024) + lane; const u32x2* y1 = (const u32x2*)(ybuf + c * 1024) + lane;
#pragma unroll
    for (int j = 0; j < 4; ++j) { an[j] = y0[64 * j]; cn[j] = y1[64 * j]; xn[j] = x1r[64 * j]; } };
  if (row < T) { size_t a, c; slots(row, a, c); loadrow(row, a, c); if (row + stride < T) slots(row + stride, s0n, s1n); }
  for (; row < T; row += stride) {
    const int b = row >> 14;
    f32x4 v[4]; float s = 0.f;
#pragma unroll
    for (int j = 0; j < 4; ++j) { const int col = 4 * lane + 256 * j;
      const u32x2 a = an[j], c = cn[j], xw = xn[j];
      const f32x4 y = {bflo(a[0]) + bflo(c[0]), bfhi(a[0]) + bfhi(c[0]), bflo(a[1]) + bflo(c[1]), bfhi(a[1]) + bfhi(c[1])};
      const f32x4 x1v = {bflo(xw[0]), bfhi(xw[0]), bflo(xw[1]), bfhi(xw[1])};
      v[j] = x1v * ALPHA + (*(const f32x4*)(mod + b * 6144 + 5120 + col) + 1.f) * y;
      s += (v[j][0] + v[j][1]) + (v[j][2] + v[j][3]); }
    if (row + stride < T) { loadrow(row + stride, s0n, s1n); if (row + 2 * stride < T) slots(row + 2 * stride, s0n, s1n); }
    const float mean = wave_sum(s) * (1.f / 1024.f); float s2 = 0.f;
#pragma unroll
    for (int j = 0; j < 4; ++j) { v[j] = v[j] - mean; s2 += (v[j][0] * v[j][0] + v[j][1] * v[j][1]) + (v[j][2] * v[j][2] + v[j][3] * v[j][3]); }
    const float rstd = rsqrtf(wave_sum(s2) * (1.f / 1024.f) + LN_EPS);
    f32x4* xr = (f32x4*)(p.out + (size_t)row * 1024) + lane;
#pragma unroll
    for (int j = 0; j < 4; ++j) { const int col = 4 * lane + 256 * j; xr[64 * j] = v[j] * rstd * *(const f32x4*)(ln2_g + col) + *(const f32x4*)(ln2_b + col); }
  }
}


#define XB_TMO      128
#define XB_XCNT(j)  (256  + 64 * (j))
#define XB_XSUB(j)  (1280 + 64 * (j))
#define XB_XGEN(j)  (2304 + 64 * (j))
#define XB_TOP      3328
#define XB_TOPGEN   3392
#define XCD_BAR_WORDS 3456
#define XB_SPIN_CAP (1u << 18)
DI unsigned xb_ld(unsigned* p)              { return __hip_atomic_load(p, __ATOMIC_RELAXED, __HIP_MEMORY_SCOPE_AGENT); }
DI unsigned xb_add(unsigned* p, unsigned v) { return __hip_atomic_fetch_add(p, v, __ATOMIC_RELAXED, __HIP_MEMORY_SCOPE_AGENT); }
DI unsigned xb_xcc_id() { return (unsigned)__builtin_amdgcn_s_getreg((3 << 11) | 20) & 0xFu; }
#define XB_SPIN(cond, bar) do { unsigned _sp = 0; while (cond) { __builtin_amdgcn_s_sleep(1); \
    if ((++_sp & 255u) == 0u) { if (xb_ld(&(bar)[XB_TMO])) break; if (_sp > XB_SPIN_CAP) { atomicAdd(&(bar)[XB_TMO], 1u); break; } } } } while (0)
struct XcdBarrier { unsigned* bar; unsigned x; volatile LAS unsigned* st; };
DI XcdBarrier xcd_barrier_post(unsigned* bar, volatile LAS unsigned* st) {
  XcdBarrier b; b.bar = bar; b.x = xb_xcc_id(); b.st = st;
  if (threadIdx.x == 0) (void)xb_add(&bar[XB_XCNT(b.x)], 1u);
  return b;
}
DI void xcd_barrier_complete(unsigned* bar, unsigned x, unsigned& nloc, unsigned& nx) {
  const unsigned G = gridDim.x * gridDim.y * gridDim.z;
  unsigned sum, cnt, mine, sp = 0u;
  for (;;) {
    sum = 0u; cnt = 0u; mine = 0u;
#pragma unroll
    for (unsigned j = 0; j < 16; ++j) { const unsigned c = xb_ld(&bar[XB_XCNT(j)]); sum += c; cnt += (c > 0u) ? 1u : 0u; mine = (j == x) ? c : mine; }
    if (sum == G) break;
    __builtin_amdgcn_s_sleep(1);
    if ((++sp & 255u) == 0u) { if (xb_ld(&bar[XB_TMO])) break; if (sp > XB_SPIN_CAP) { atomicAdd(&bar[XB_TMO], 1u); break; } }
  }
  nloc = mine > 0u ? mine : 1u; nx = cnt > 0u ? cnt : 1u;
}
DI void xcd_barrier(const XcdBarrier& b) {
  asm volatile("s_waitcnt vmcnt(0)" ::: "memory");
  __syncthreads();
  if (threadIdx.x == 0) {
    unsigned* bar = b.bar;
    __builtin_amdgcn_s_waitcnt(0);
    unsigned nloc = b.st[0], nx = b.st[1];
    if (nloc == 0u) { xcd_barrier_complete(bar, b.x, nloc, nx); b.st[0] = nloc; b.st[1] = nx; }
    const unsigned old = xb_add(&bar[XB_XSUB(b.x)], 1u);
    const unsigned gen = old / nloc;
    if (old + 1u == (gen + 1u) * nloc) {
      __builtin_amdgcn_fence(__ATOMIC_RELEASE, "agent");
      asm volatile("s_waitcnt vmcnt(0)" ::: "memory");
      const unsigned og = xb_add(&bar[XB_TOP], 1u);
      const unsigned tg = og / nx;
      if (og + 1u == (tg + 1u) * nx) xb_add(&bar[XB_TOPGEN], 1u);
      else XB_SPIN(xb_ld(&bar[XB_TOPGEN]) == tg, bar);
      __builtin_amdgcn_fence(__ATOMIC_ACQUIRE, "agent");
      xb_add(&bar[XB_XGEN(b.x)], 1u);
      asm volatile("s_waitcnt vmcnt(0)" ::: "memory");
    } else {
      XB_SPIN(xb_ld(&bar[XB_XGEN(b.x)]) == gen, bar);
      __builtin_amdgcn_fence(__ATOMIC_ACQUIRE, "agent");
      asm volatile("s_waitcnt vmcnt(0)" ::: "memory");
    }
  }
  __syncthreads();
}

__device__ unsigned g_bar_counter = 0;
DI void grid_barrier(const unsigned G) {
  asm volatile("s_waitcnt vmcnt(0)" ::: "memory");
  __syncthreads();
  if (threadIdx.x == 0) {
    __builtin_amdgcn_fence(__ATOMIC_RELEASE, "agent");
    asm volatile("s_waitcnt vmcnt(0)" ::: "memory");
    const unsigned old = __hip_atomic_fetch_add(&g_bar_counter, 1u, __ATOMIC_RELAXED, __HIP_MEMORY_SCOPE_AGENT);
    const unsigned target = (old / G + 1u) * G;
    unsigned sp = 0;
    while ((int)(__hip_atomic_load(&g_bar_counter, __ATOMIC_RELAXED, __HIP_MEMORY_SCOPE_AGENT) - target) < 0) { __builtin_amdgcn_s_sleep(1); if (++sp > (1u << 24)) break; }
    __builtin_amdgcn_fence(__ATOMIC_ACQUIRE, "agent");
    asm volatile("s_waitcnt vmcnt(0)" ::: "memory");
  }
  __syncthreads();
}

#define KERNEL_HEAD extern __shared__ __attribute__((aligned(16))) unsigned char lds_raw[]; LAS unsigned char* lds = (LAS unsigned char*)lds_raw; const int bid = blockIdx.x, G = gridDim.x; \
  Ctx p; p.ws = karg<A_WS, unsigned char>(); p.out = karg<A_OUT, float>();
#ifdef MULTI_LAUNCH
__global__ void __launch_bounds__(NTHREADS, 2) k_prep(Params) { KERNEL_HEAD phase_prep(p, bid, G, lds); }
__global__ void __launch_bounds__(NTHREADS, 2) k_lnmod(Params) { KERNEL_HEAD (void)lds; phase_lnmod(p, bid, G); }
__global__ void __launch_bounds__(NTHREADS, 2) k_inproj(Params) { KERNEL_HEAD
  unsigned char* ws = p.ws;
  g8::DenseOrder S; S.init(T, N_INP, 1024, ws + WS_WIN, G, bid);
  EpiIn E{(bf16_t*)(ws + WS_QKPRE), (bf16_t*)(ws + WS_VM), (bf16_t*)(ws + WS_H), (bf16_t*)(ws + WS_CQ), (bf16_t*)(ws + WS_CKV), (unsigned char*)(ws + WS_KN), (float*)(ws + WS_GATES),
          (float*)(ws + WS_SSQQ), (float*)(ws + WS_SSQKV), (const float*)(ws + WS_ROPE), karg<A_GATEB>()};
  g8::gemm_phase(lds, (const char*)(ws + WS_U), 1024, S, E);
}
__global__ void __launch_bounds__(NTHREADS, 2) k_mid1(Params) { KERNEL_HEAD
  unsigned char* ws = p.ws;
  { g8::DenseOrder S; S.init(T, 768, 384, ws + WS_WUQ, G, bid); EpiUQ E{(unsigned char*)(ws + WS_QATT), (const float*)(ws + WS_SSQQ), (const float*)(ws + WS_ROPE)};
    g8::gemm_phase(lds, (const char*)(ws + WS_CQ), 384, S, E); }
}
__global__ void __launch_bounds__(NTHREADS, 2) k_mid2(Params) { KERNEL_HEAD
  unsigned char* ws = p.ws;
  { g8::DenseOrder S; S.init(T, 1024, 256, ws + WS_WUKV, G, bid); EpiUKV E{(unsigned char*)(ws + WS_KN), (unsigned char*)(ws + WS_VA), (const float*)(ws + WS_SSQKV)};
    g8::gemm_phase(lds, (const char*)(ws + WS_CKV), 256, S, E); }
}
__global__ void __launch_bounds__(NTHREADS, 2) k_mid3(Params) { KERNEL_HEAD
  for (int u = bid; u < 1024; u += G) { const int c = u & 127, bh = u >> 7; mlstmA_unit(p, bh >> 2, bh & 3, c, lds); }
}
__global__ void __launch_bounds__(NTHREADS, 2) k_scan_attn(Params) { KERNEL_HEAD phase_scan(p, bid, G); phase_attn(p, bid, G, lds); }
__global__ void __launch_bounds__(NTHREADS, 2) k_mlstm_out(Params) { KERNEL_HEAD
  for (int u = bid; u < 1024; u += G) { const int c = u & 127, bh = u >> 7; mlstmC_unit(p, bh >> 2, bh & 3, c, lds); }
  phase_hanorm(p, bid, G);
}
__global__ void __launch_bounds__(NTHREADS, 2) k_outproj(Params) { KERNEL_HEAD
  unsigned char* ws = p.ws;
  g8::DenseOrder S; S.init(T, 1024, 1024, ws + WS_WOUT, G, bid); EpiOut E{karg<A_X>(), (const float*)(ws + WS_MOD), (bf16_t*)p.out};
  g8::gemm_phase(lds, (const char*)(ws + WS_H), 1024, S, E);
}
__global__ void __launch_bounds__(NTHREADS, 2) k_route(Params) { KERNEL_HEAD phase_route(p, bid, G, lds); }
__global__ void __launch_bounds__(NTHREADS, 2) k_moe_gu(Params) { KERNEL_HEAD
  unsigned char* ws = p.ws; moe_table(p, lds);
  MoeOrderGU S; S.tstart = (const LAS int*)(lds + MOE_TS); S.cnt = (const int*)(ws + WS_CNT); S.G = G; S.c = bid; S.ltok = (const int*)(ws + WS_LTOK); S.Bt = (const char*)(ws + WS_WGU);
  EpiGU E{(unsigned char*)(ws + WS_HDN)};
  g8::gemm_phase(lds, (const char*)(ws + WS_U), 512  , S, E);
}
__global__ void __launch_bounds__(NTHREADS, 2) k_moe_dn(Params) { KERNEL_HEAD
  unsigned char* ws = p.ws; moe_table(p, lds);
  MoeOrderDN S; S.tstart = (const LAS int*)(lds + MOE_TS); S.cnt = (const int*)(ws + WS_CNT); S.G = G; S.c = bid; S.Bt = (const char*)(ws + WS_WDN);
  EpiDN E{(bf16_t*)(ws + WS_YBUF), (const float*)(ws + WS_LW)};
  g8::gemm_phase(lds, (const char*)(ws + WS_HDN), 256  , S, E);
}
__global__ void __launch_bounds__(NTHREADS, 2) k_final(Params) { KERNEL_HEAD moe_table(p, lds); phase_final(p, bid, G, lds); }

#endif

__global__ void __launch_bounds__(NTHREADS, 2) k_mega(Params) { KERNEL_HEAD
  unsigned char* ws = p.ws;
  if (bid == 0) for (int i = threadIdx.x; i < XCD_BAR_WORDS; i += NTHREADS) ((unsigned*)(ws + WS_BAR))[i] = 0u;
  if (threadIdx.x < 64) ((LAS unsigned*)(lds + LDS_BARST))[threadIdx.x] = 0u;
  XcdBarrier xbar; xbar.bar = (unsigned*)(ws + WS_BAR); xbar.x = 0; xbar.st = (volatile LAS unsigned*)(lds + LDS_BARST);
  bool xb_ready = false;
#define PHASE_SEP() do { asm volatile("" ::: "memory"); if (!xb_ready) { grid_barrier((unsigned)G); xbar = xcd_barrier_post((unsigned*)(ws + WS_BAR), (volatile LAS unsigned*)(lds + LDS_BARST)); xb_ready = true; } \
    else xcd_barrier(xbar); asm volatile("" ::: "memory"); } while (0)
#define REP(n) for (int rep_ = 0; rep_ < ((n) == DBL_PHASE ? 2 : 1); ++rep_)
  REP(0) phase_prep(p, bid, G, lds);
  PHASE_SEP();
#if MEGA_STOP == 1
  return;
#endif
  REP(1) phase_lnmod(p, bid, G);
  PHASE_SEP();
#if MEGA_STOP == 2
  return;
#endif
  REP(2) { g8::DenseOrder S; S.init(T, N_INP, 1024, ws + WS_WIN, G, bid);
    EpiIn E{(bf16_t*)(ws + WS_QKPRE), (bf16_t*)(ws + WS_VM), (bf16_t*)(ws + WS_H), (bf16_t*)(ws + WS_CQ), (bf16_t*)(ws + WS_CKV), (unsigned char*)(ws + WS_KN), (float*)(ws + WS_GATES),
            (float*)(ws + WS_SSQQ), (float*)(ws + WS_SSQKV), (const float*)(ws + WS_ROPE), karg<A_GATEB>()};
    g8::gemm_phase(lds, (const char*)(ws + WS_U), 1024, S, E);
    { const int first = S.nwg % G, nb = G - first;
      if (bid >= first) { const int tid = tid_fresh(), lane = tid & 63, wave = __builtin_amdgcn_readfirstlane(tid >> 6);
        prep_items(PREP_ITEMS - PREP_DEFER + (bid - first) * 8 + wave, PREP_ITEMS, nb * 8, lane, ws, (LAS float*)(lds + wave * 16384)); } } }
  PHASE_SEP();
#if MEGA_STOP == 3
  return;
#endif
  const bool mfirst = ((bid >> 3) & 1) != 0;
  if (mfirst) { for (int u = bid; u < 1024; u += G) { const int c = u & 127, bh = u >> 7; mlstmA_unit(p, bh >> 2, bh & 3, c, lds); } __syncthreads(); }
  { g8::DenseOrder S; S.init(T, 768, 384, ws + WS_WUQ, G, bid); EpiUQ E{(unsigned char*)(ws + WS_QATT), (const float*)(ws + WS_SSQQ), (const float*)(ws + WS_ROPE)};
    g8::gemm_phase(lds, (const char*)(ws + WS_CQ), 384, S, E); }
  __syncthreads();
  { g8::DenseOrder S; S.init(T, 1024, 256, ws + WS_WUKV, G, bid); EpiUKV E{(unsigned char*)(ws + WS_KN), (unsigned char*)(ws + WS_VA), (const float*)(ws + WS_SSQKV)};
    g8::gemm_phase(lds, (const char*)(ws + WS_CKV), 256, S, E); }
  __syncthreads();
  if (!mfirst) { for (int u = bid; u < 1024; u += G) { const int c = u & 127, bh = u >> 7; mlstmA_unit(p, bh >> 2, bh & 3, c, lds); } }
  PHASE_SEP();
#if MEGA_STOP == 4
  return;
#endif
  phase_scan(p, bid, G);
  REP(4) phase_attn(p, bid, G, lds);
  PHASE_SEP();
#if MEGA_STOP == 5
  return;
#endif
#if DBL_PHASE == 5
  for (int u = bid; u < 1024; u += G) { const int c = u & 127, bh = u >> 7; mlstmC_unit<true>(p, bh >> 2, bh & 3, c, lds); }
#endif
#if DBL_PHASE == 55
  phase_hanorm<true>(p, bid, G);
#endif
  for (int u = bid; u < 1024; u += G) { const int c = u & 127, bh = u >> 7; mlstmC_unit(p, bh >> 2, bh & 3, c, lds); }
  phase_hanorm(p, bid, G);
  PHASE_SEP();
#if MEGA_STOP == 6
  return;
#endif
  REP(6) { g8::DenseOrder S; S.init(T, 1024, 1024, ws + WS_WOUT, G, bid); EpiOut E{karg<A_X>(), (const float*)(ws + WS_MOD), (bf16_t*)p.out};
    g8::gemm_phase(lds, (const char*)(ws + WS_H), 1024, S, E); }
  PHASE_SEP();
#if MEGA_STOP == 7
  return;
#endif
#if DBL_PHASE == 7
  phase_route<true>(p, bid, G, lds);
#endif
  phase_route(p, bid, G, lds);
  PHASE_SEP();
#if MEGA_STOP == 8
  return;
#endif
  moe_table(p, lds);
  REP(8) { MoeOrderGU S; S.tstart = (const LAS int*)(lds + MOE_TS); S.cnt = (const int*)(ws + WS_CNT); S.G = G; S.c = bid; S.ltok = (const int*)(ws + WS_LTOK); S.Bt = (const char*)(ws + WS_WGU);
    EpiGU E{(unsigned char*)(ws + WS_HDN)};
    g8::gemm_phase(lds, (const char*)(ws + WS_U), 512  , S, E); }
  PHASE_SEP();
#if MEGA_STOP == 9
  return;
#endif
  REP(9) { MoeOrderDN S; S.tstart = (const LAS int*)(lds + MOE_TS); S.cnt = (const int*)(ws + WS_CNT); S.G = G; S.c = bid; S.Bt = (const char*)(ws + WS_WDN);
    EpiDN E{(bf16_t*)(ws + WS_YBUF), (const float*)(ws + WS_LW)};
    g8::gemm_phase(lds, (const char*)(ws + WS_HDN), 256  , S, E); }
  PHASE_SEP();
#if MEGA_STOP == 10
  return;
#endif
#if DBL_PHASE == 10
  phase_final<true>(p, bid, G, lds);
#endif
  phase_final(p, bid, G, lds);
#undef REP
#undef PHASE_SEP
}

#ifdef PROBE_OFF
__global__ void __launch_bounds__(NTHREADS, 2) k_probe(Params p, size_t off, size_t n, int is_f32, int from_out) {
  const unsigned char* base = from_out ? (const unsigned char*)p.out : p.ws + off;
  for (size_t i = (size_t)blockIdx.x * NTHREADS + threadIdx.x; i < (size_t)T * D; i += (size_t)gridDim.x * NTHREADS) {
    const size_t j = i % n; float v = is_f32 ? ((const float*)base)[j] : bf2f(((const unsigned short*)base)[j]);
    if (!(fabsf(v) < 1e30f)) v = 777.f;
    if (from_out) { if (j != i) break; ((float*)p.out)[i] = v; } else p.out[i] = v;
  }
}
#endif
extern "C" void kernel_launch(void* const* d_in, const int* in_sizes, int n_in, void* d_out, int out_size, void* d_ws, size_t ws_size, hipStream_t stream) {
  static int ok = 0, grid = 256;
  typedef void (*kfn)(Params);
#ifndef MULTI_LAUNCH
  const kfn kernels[] = {k_mega};
#else
  const kfn kernels[] = {k_prep, k_lnmod, k_inproj, k_mid1, k_mid2, k_mid3, k_scan_attn, k_mlstm_out, k_outproj, k_route, k_moe_gu, k_moe_dn, k_final};
#endif
  if (ok == 0) {
    if (n_in != 27 || in_sizes[0] != T * D || out_size != T * D || ws_size < WS_END) { fprintf(stderr, "kernel_launch: unexpected shapes (n_in %d, in0 %d, out %d, ws %zu)\n", n_in, n_in > 0 ? in_sizes[0] : -1, out_size, ws_size); ok = -1; return; }
    for (kfn k : kernels) if (hipFuncSetAttribute((const void*)k, hipFuncAttributeMaxDynamicSharedMemorySize, LDS_BYTES) != hipSuccess) { fprintf(stderr, "kernel_launch: hipFuncSetAttribute failed\n"); ok = -1; return; }
    int dev = 0, cus = 0, per_cu = 0;
    if (hipGetDevice(&dev) != hipSuccess || hipDeviceGetAttribute(&cus, hipDeviceAttributeMultiprocessorCount, dev) != hipSuccess) { fprintf(stderr, "kernel_launch: device query failed\n"); ok = -1; return; }
    if (hipOccupancyMaxActiveBlocksPerMultiprocessor(&per_cu, (const void*)kernels[0], NTHREADS, LDS_BYTES) != hipSuccess || per_cu < 1) { fprintf(stderr, "kernel_launch: occupancy query says %d blocks/CU\n", per_cu); (void)hipGetLastError(); per_cu = 1; }
    grid = cus < 256 ? cus : 256;
    fprintf(stderr, "kernel_launch: %d CUs, %d blocks/CU by the occupancy query, grid %d\n", cus, per_cu, grid);
    ok = 1;
  }
  if (ok < 0) return;
  Params p{};
  p.x = (const float*)d_in[0]; p.c = (const float*)d_in[1]; p.pos = (const int*)d_in[2]; p.w_ada = (const float*)d_in[3]; p.b_ada = (const float*)d_in[4]; p.w_in = (const float*)d_in[5];
  p.conv_w = (const float*)d_in[6]; p.conv_b = (const float*)d_in[7]; p.gate_b = (const float*)d_in[8]; p.mh_g = (const float*)d_in[9]; p.qn_g = (const float*)d_in[10]; p.kvn_g = (const float*)d_in[11];
  p.w_uq = (const float*)d_in[12]; p.w_ukv = (const float*)d_in[13]; p.an_g = (const float*)d_in[14]; p.w_out = (const float*)d_in[15]; p.ln1_g = (const float*)d_in[16]; p.ln1_b = (const float*)d_in[17];
  p.w_rg = (const float*)d_in[18]; p.b_rg = (const float*)d_in[19]; p.w_re = (const float*)d_in[20]; p.b_re = (const float*)d_in[21]; p.w_gate = (const float*)d_in[22]; p.w_up = (const float*)d_in[23];
  p.w_down = (const float*)d_in[24]; p.ln2_g = (const float*)d_in[25]; p.ln2_b = (const float*)d_in[26];
  p.out = (float*)d_out; p.ws = (unsigned char*)d_ws;
#ifndef NKERN
#define NKERN 6
#endif
  { int ik = 0; for (kfn k : kernels) { if (ik++ >= NKERN) break; hipLaunchKernelGGL(k, dim3(grid), dim3(NTHREADS), LDS_BYTES, stream, p); } }
#ifdef PROBE_OFF
  hipLaunchKernelGGL(k_probe, dim3(1024), dim3(NTHREADS), 0, stream, p, (size_t)(PROBE_OFF), (size_t)(PROBE_N), PROBE_F32, 0);
#endif
  const hipError_t le = hipPeekAtLastError();
  if (le != hipSuccess) fprintf(stderr, "kernel_launch: launch failed: %s\n", hipGetErrorName(le));
}
```

```cpp
#define NKERN 99
#ifndef MEGA_STOP
#define MEGA_STOP 0
#endif
#ifndef DBL_PHASE
#define DBL_PHASE -1
#endif
#include <hip/hip_runtime.h>
#include <cstdio>
#include <cstdint>
#include <cmath>

#define DI __device__ __forceinline__
#define LAS __attribute__((address_space(3)))
typedef unsigned short bf16_t;
typedef short bf16x8 __attribute__((ext_vector_type(8)));
typedef short s16x4 __attribute__((ext_vector_type(4)));
typedef float f32x4 __attribute__((ext_vector_type(4)));
typedef float f32x2 __attribute__((ext_vector_type(2)));
typedef float f32x16 __attribute__((ext_vector_type(16)));
typedef unsigned u32x4 __attribute__((ext_vector_type(4)));
typedef unsigned u32x2 __attribute__((ext_vector_type(2)));

constexpr int BATCH = 2, SEQ = 16384, T = BATCH * SEQ, D = 1024;
constexpr int NCH = SEQ / 128;
constexpr int N_IN = 2768, N_INP = 2816;
constexpr int NEXP = 32;
constexpr float LN_EPS = 1e-5f, RMS_EPS = 1e-6f;
constexpr float ALPHA = 1.189207115002721f;
constexpr float LOG2E = 1.4426950408889634f;
constexpr float QSCALE = 0.07216878364870323f * LOG2E * 16.f;
constexpr int NTHREADS = 512;
constexpr int LDS_BYTES = 148 * 1024;

constexpr size_t MiB = 1u << 20;
constexpr size_t WS_WIN = 0, WS_WUQ = 6 * MiB, WS_WUKV = 7 * MiB, WS_WOUT = 8 * MiB, WS_WGU = 10 * MiB, WS_WDN = 74 * MiB;
constexpr size_t WS_MOD = 106 * MiB, WS_CNT = 106 * MiB + 65536, WS_ROPE = 107 * MiB, WS_GATES = 115 * MiB, WS_GVEC = 117 * MiB;
constexpr size_t WS_SSQQ = 120 * MiB, WS_SSQKV = 122 * MiB, WS_NVEC = 123 * MiB, WS_SCAL = 124 * MiB, WS_TOKE = 125 * MiB, WS_TOKP = 125 * MiB + 512 * 1024;
constexpr size_t WS_U = 128 * MiB, WS_H = 192 * MiB, WS_QKPRE = 256 * MiB, WS_VM = 320 * MiB, WS_CQ = 352 * MiB, WS_CKV = 376 * MiB;
constexpr size_t WS_KROPE = 392 * MiB, WS_QATT = 396 * MiB, WS_KN = 444 * MiB, WS_VA = 476 * MiB, WS_END = 512 * MiB;
constexpr size_t WS_BAR = 106 * MiB + 131072, CTL_ZERO_OFF = WS_CNT, CTL_ZERO_BYTES = 131072;
constexpr int LDS_BARST = LDS_BYTES - 256;
constexpr size_t WS_LTOK = 256 * MiB, WS_LW = 260 * MiB, WS_HDN = 264 * MiB, WS_YBUF = 336 * MiB;
constexpr int MAXTILES = 288;
constexpr int CNT_STRIDE = 64;
constexpr size_t WS_WRT = 126 * MiB;

struct Params {
  const float* x; const float* c; const int* pos; const float* w_ada; const float* b_ada; const float* w_in; const float* conv_w; const float* conv_b;
  const float* gate_b; const float* mh_g; const float* qn_g; const float* kvn_g; const float* w_uq; const float* w_ukv; const float* an_g; const float* w_out;
  const float* ln1_g; const float* ln1_b; const float* w_rg; const float* b_rg; const float* w_re; const float* b_re; const float* w_gate; const float* w_up;
  const float* w_down; const float* ln2_g; const float* ln2_b;
  float* out; unsigned char* ws;
};

enum { A_X = 0, A_C, A_POS, A_WADA, A_BADA, A_WIN, A_CONVW, A_CONVB, A_GATEB, A_MHG, A_QNG, A_KVNG, A_WUQ, A_WUKV, A_ANG, A_WOUT, A_LN1G, A_LN1B, A_WRG, A_BRG, A_WRE, A_BRE,
       A_WGATE, A_WUP, A_WDOWN, A_LN2G, A_LN2B, A_OUT, A_WS };
template <int IDX, class Tp = const float> __device__ __forceinline__ Tp* karg() {
  const unsigned long long k = (unsigned long long)__builtin_amdgcn_kernarg_segment_ptr();
  unsigned long long v;
  asm volatile("s_load_dwordx2 %0, %1, %2\n\ts_waitcnt lgkmcnt(0)" : "=s"(v) : "s"(k), "i"(IDX * 8) : "memory");
  return (Tp*)v;
}
struct Ctx { unsigned char* ws; float* out; };
DI unsigned cvtpk(float lo, float hi) { unsigned r; asm volatile("v_cvt_pk_bf16_f32 %0, %1, %2" : "=v"(r) : "v"(lo), "v"(hi)); return r; }
DI unsigned short f2bf(float f) { unsigned u = __float_as_uint(f); return (unsigned short)((u + 0x7fffu + ((u >> 16) & 1u)) >> 16); }
typedef int v8i __attribute__((ext_vector_type(8)));
typedef int v4i_ __attribute__((ext_vector_type(4)));
DI u32x2 cvt8(f32x4 a, f32x4 b) {
  int w0 = __builtin_amdgcn_cvt_pk_fp8_f32(a[0], a[1], 0, false); w0 = __builtin_amdgcn_cvt_pk_fp8_f32(a[2], a[3], w0, true);
  int w1 = __builtin_amdgcn_cvt_pk_fp8_f32(b[0], b[1], 0, false); w1 = __builtin_amdgcn_cvt_pk_fp8_f32(b[2], b[3], w1, true);
  return (u32x2){(unsigned)w0, (unsigned)w1};
}
DI float bf2f(unsigned short v) { return __uint_as_float(((unsigned)v) << 16); }
DI float bflo(unsigned w) { return __uint_as_float(w << 16); }
DI float bfhi(unsigned w) { return __uint_as_float(w & 0xffff0000u); }
DI int tid_fresh() { int t = threadIdx.x; asm volatile("" : "+v"(t)); return t; }
DI float sigmoidf_(float x) { return 1.f / (1.f + __expf(-x)); }
DI float siluf_(float x) { return x / (1.f + __expf(-x)); }
DI float logsigmoidf_(float x) { return fminf(x, 0.f) - log1pf(__expf(-fabsf(x))); }
DI int crow(int r, int hi) { return (r & 3) + 8 * (r >> 2) + 4 * hi; }
#define SBAR() __builtin_amdgcn_sched_barrier(0)
#define KSWZ(row, colB) ((row) * 256 + ((colB) ^ (((row) & 15) << 4)))
#define KRSWZ(row, colB) ((row) * 128 + ((colB) ^ ((((row) >> 1) & 7) << 4)))
#define MFMA32(a, b, c) __builtin_amdgcn_mfma_f32_32x32x16_bf16((a), (b), (c), 0, 0, 0)

DI int v_st(int k, int c) { const int kk = (k & ~0xC) | ((k & 4) << 1) | ((k & 8) >> 1); return ((kk >> 3) * 4 + (c >> 5)) * 512 + ((kk & 7) * 32 + (c & 31)) * 2; }
DI int v_rd_base(int lane) { return ((lane & 3) << 3) | (((lane >> 2) & 3) << 6) | (((lane >> 4) & 1) << 5) | (((lane >> 5) & 1) << 8); }
constexpr int v_rd_off(int d0, int ks, int half) { return d0 * 512 + ks * 4096 + half * 2048; }
template <int OFF> DI s16x4 tr_read(int vb) {
  s16x4 r; asm volatile("ds_read_b64_tr_b16 %0, %1 offset:%2" : "=&v"(r) : "v"(vb), "i"(OFF) : "memory"); return r;
}
#define PKLH(L, H) (bf16x8){L[0], L[1], L[2], L[3], H[0], H[1], H[2], H[3]}
template <int KS> DI bf16x8 tr_frag_nowait(int vb, s16x4& l, s16x4& h) { l = tr_read<v_rd_off(0, KS, 0)>(vb); h = tr_read<v_rd_off(0, KS, 1)>(vb); return PKLH(l, h); }
template <int D0> DI void pv_one(f32x16& od, int vb, bf16x8 pa0, bf16x8 pa1, bf16x8 pa2, bf16x8 pa3) {
  const s16x4 l0 = tr_read<v_rd_off(D0, 0, 0)>(vb), h0 = tr_read<v_rd_off(D0, 0, 1)>(vb), l1 = tr_read<v_rd_off(D0, 1, 0)>(vb), h1 = tr_read<v_rd_off(D0, 1, 1)>(vb);
  const s16x4 l2 = tr_read<v_rd_off(D0, 2, 0)>(vb), h2 = tr_read<v_rd_off(D0, 2, 1)>(vb), l3 = tr_read<v_rd_off(D0, 3, 0)>(vb), h3 = tr_read<v_rd_off(D0, 3, 1)>(vb);
  asm volatile("s_waitcnt lgkmcnt(0)" ::: "memory"); SBAR();
  od = MFMA32(pa0, PKLH(l0, h0), od); od = MFMA32(pa1, PKLH(l1, h1), od); od = MFMA32(pa2, PKLH(l2, h2), od); od = MFMA32(pa3, PKLH(l3, h3), od);
}
DI void pv_d0(f32x16* o, int vb, bf16x8 pa0, bf16x8 pa1, bf16x8 pa2, bf16x8 pa3) {
  pv_one<0>(o[0], vb, pa0, pa1, pa2, pa3); pv_one<1>(o[1], vb, pa0, pa1, pa2, pa3); pv_one<2>(o[2], vb, pa0, pa1, pa2, pa3); pv_one<3>(o[3], vb, pa0, pa1, pa2, pa3);
}
DI void pack_p(const f32x16& p0, const f32x16& p1, bf16x8& pa0, bf16x8& pa1, bf16x8& pa2, bf16x8& pa3) {
#define PK4(P, BASE, OUT) do { unsigned a0 = cvtpk(P[BASE + 0], P[BASE + 1]), a1 = cvtpk(P[BASE + 2], P[BASE + 3]);   \
    unsigned b0 = cvtpk(P[BASE + 4], P[BASE + 5]), b1 = cvtpk(P[BASE + 6], P[BASE + 7]);                              \
    auto r0 = __builtin_amdgcn_permlane32_swap(a0, b0, false, false); auto r1 = __builtin_amdgcn_permlane32_swap(a1, b1, false, false); \
    u32x4 w = {r0[0], r1[0], r0[1], r1[1]}; OUT = *reinterpret_cast<bf16x8*>(&w); } while (0)
  PK4(p0, 0, pa0); PK4(p0, 8, pa1); PK4(p1, 0, pa2); PK4(p1, 8, pa3);
#undef PK4
}
DI float half_swap_sum(float v) { auto rr = __builtin_amdgcn_permlane32_swap(__float_as_uint(v), __float_as_uint(v), false, false); return __uint_as_float(rr[0]) + __uint_as_float(rr[1]); }
template <int CTRL> DI float dpp_mov(float v) { return __int_as_float(__builtin_amdgcn_update_dpp(0, __float_as_int(v), CTRL, 0xF, 0xF, true)); }
DI float row_sum16(float v) { v += dpp_mov<0xB1>(v); v += dpp_mov<0x4E>(v); v += dpp_mov<0x141>(v); v += dpp_mov<0x140>(v); return v; }
DI float xsum16(float v) { auto rr = __builtin_amdgcn_permlane16_swap(__float_as_uint(v), __float_as_uint(v), false, false); return __uint_as_float(rr[0]) + __uint_as_float(rr[1]); }
DI float half_sum32(float v) { return xsum16(row_sum16(v)); }
DI float wave_sum(float v) { return half_swap_sum(half_sum32(v)); }
DI float half_swap_max(float v) { auto rr = __builtin_amdgcn_permlane32_swap(__float_as_uint(v), __float_as_uint(v), false, false); return fmaxf(__uint_as_float(rr[0]), __uint_as_float(rr[1])); }

namespace g8 {
constexpr int BM = 256, BK = 64, HALF = 128, HTB = HALF * BK * 2, STAGE_BYTES = 8 * HTB;
DI int lds_byte(int r, int c) { const int st = (r >> 4) * 2 + (c >> 5), rr = r & 15, cc = c & 31, ob = rr * 64 + cc * 2; return st * 1024 + (ob ^ (((ob >> 9) & 1) << 5)); }
DI void stage_rc(int b, int& R, int& C) { const int st = b / 1024, sb = b % 1024, swz = sb ^ (((sb >> 9) & 1) << 5); R = (st >> 1) * 16 + swz / 64; C = (st & 1) * 32 + (swz % 64) / 2; }
DI int perm32(int rho) { const int n = rho >> 4, i = rho & 15; return 8 * (i >> 2) + 4 * n + (i & 3); }
struct Unit { int pm, pn, e, j; };

struct NoPre {};
template <class E, class = void> struct PreOf { typedef NoPre type; static constexpr bool has = false; };
template <class E> struct PreOf<E, std::void_t<typename E::Pre>> { typedef typename E::Pre type; static constexpr bool has = true; };
template <class Epi, class Sched>
DI void gemm_phase(LAS unsigned char* lds, const char* Abase, const int Kc, const Sched& S, const Epi& E) {
  constexpr bool GATHER = Sched::GATHER, FP8 = Epi::FP8; constexpr int NBJ = Epi::NBJ;
  int K = Kc; asm volatile("" : "+s"(K));
  const int tid = tid_fresh(), wid = __builtin_amdgcn_readfirstlane(tid >> 6), lane = tid & 63, wr = wid >> 2, wc = wid & 3, fr = lane & 15, fq = lane >> 4;
  const int nt = K / BK;
  unsigned voffA[2], voffB[2];
#pragma unroll
  for (int i = 0; i < 2; ++i) { int R, C; stage_rc(tid * 16 + i * 8192, R, C); const int Rb = Epi::PERM ? ((R & ~31) + perm32(R & 31)) : R; voffA[i] = (unsigned)(R * K + C) * 2u; voffB[i] = (unsigned)(Rb * K + C) * 2u; }
  const size_t kstep = (size_t)(BK * 2);
  const size_t hstepB = (size_t)HALF * K * 2;
  const unsigned ldsw = (unsigned)wid * 1024u;
  const int aoff = lds_byte(wr * 64 + fr, fq * 8), boff = lds_byte(wc * 32 + fr, fq * 8);
#define G8_SA(b, h) (((b) * 2 + (h)) * HTB)
#define G8_SB(b, h) ((4 + (b) * 2 + (h)) * HTB)
#define G8_STAGEB(bufoff, gptr) do { _Pragma("unroll") for (int _i = 0; _i < 2; ++_i) \
    __builtin_amdgcn_global_load_lds((const unsigned*)((const char*)(gptr) + voffB[_i]), (LAS unsigned*)(lds + (bufoff) + ldsw + _i * 8192), 16, 0, 0); } while (0)
#define G8_STAGEA(bufoff, kb, NXT, h) do { _Pragma("unroll") for (int _i = 0; _i < 2; ++_i) { const char* _src; \
    if constexpr (GATHER) _src = Abase + (size_t)(kb) + (size_t)((NXT) ? o2[h][_i] : cuA[h][_i]); else _src = ((NXT) ? a2b : cA) + (size_t)(kb) + (size_t)(h) * hstepB + voffA[_i]; \
    __builtin_amdgcn_global_load_lds((const unsigned*)_src, (LAS unsigned*)(lds + (bufoff) + ldsw + _i * 8192), 16, 0, 0); } } while (0)
#define G8_LD8(ptr) __builtin_shufflevector(*(const LAS v4i_*)(ptr), *(const LAS v4i_*)((ptr) + 1024), 0, 1, 2, 3, 4, 5, 6, 7)
#define G8_LDA(dst, b, h) do { if constexpr (FP8) { _Pragma("unroll") for (int m = 0; m < 4; ++m) dst##8[m] = G8_LD8(lds + G8_SA(b, h) + aoff + m * 2048); } \
    else { _Pragma("unroll") for (int m = 0; m < 4; ++m) _Pragma("unroll") for (int k = 0; k < 2; ++k) dst[m][k] = *(const LAS bf16x8*)(lds + G8_SA(b, h) + aoff + m * 2048 + k * 1024); } } while (0)
#define G8_LDB(dst, b, h) do { if constexpr (FP8) { _Pragma("unroll") for (int n = 0; n < 2; ++n) dst##8[n] = G8_LD8(lds + G8_SB(b, h) + boff + n * 2048); } \
    else { _Pragma("unroll") for (int n = 0; n < 2; ++n) _Pragma("unroll") for (int k = 0; k < 2; ++k) dst[n][k] = *(const LAS bf16x8*)(lds + G8_SB(b, h) + boff + n * 2048 + k * 1024); } } while (0)
#define G8_MMA(ai, bj, At, Bt) do { __builtin_amdgcn_s_setprio(1); \
    if constexpr (FP8) { _Pragma("unroll") for (int m = 0; m < 4; ++m) _Pragma("unroll") for (int n = 0; n < 2; ++n) \
        acc[ai][bj][m][n] = __builtin_amdgcn_mfma_scale_f32_16x16x128_f8f6f4(Bt##8[n], At##8[m], acc[ai][bj][m][n], 0, 0, 0, 122, 0, Epi::ASCALE); } \
    else { _Pragma("unroll") for (int m = 0; m < 4; ++m) _Pragma("unroll") for (int n = 0; n < 2; ++n) _Pragma("unroll") for (int k = 0; k < 2; ++k) \
        acc[ai][bj][m][n] = __builtin_amdgcn_mfma_f32_16x16x32_bf16(Bt[n][k], At[m][k], acc[ai][bj][m][n], 0, 0, 0); } \
    __builtin_amdgcn_s_setprio(0); } while (0)
#define G8_WAIT_V(n) asm volatile("s_waitcnt vmcnt(" #n ")" ::: "memory")
#define G8_WAIT_M do { if constexpr (NBJ == 2) G8_WAIT_V(8); else G8_WAIT_V(6); } while (0)
#define G8_WAIT_L(n) asm volatile("s_waitcnt lgkmcnt(" #n ")" ::: "memory")
#define G8_BAR __builtin_amdgcn_s_barrier()
#define G8_SCHED __builtin_amdgcn_sched_barrier(0)
#define G8_GOFF(dst, u) do { _Pragma("unroll") for (int _i = 0; _i < 2; ++_i) { int _R, _C; stage_rc(tid * 16 + _i * 8192, _R, _C); \
    _Pragma("unroll") for (int _h = 0; _h < 2; ++_h) dst[_h][_i] = S.a_off(u, _R + 128 * _h) + (unsigned)_C * 2u; } } while (0)
  Unit cur, nxt; int ui = 0;
  if (!S.next(0, cur)) return;
  typename PreOf<Epi>::type pre; (void)pre;
  if constexpr (PreOf<Epi>::has) E.pre(cur, wr, fr, pre);
  f32x4 acc[2][NBJ][4][2];
#pragma unroll
  for (int a = 0; a < 2; ++a)
#pragma unroll
    for (int b = 0; b < NBJ; ++b)
#pragma unroll
      for (int m = 0; m < 4; ++m)
#pragma unroll
        for (int n = 0; n < 2; ++n) acc[a][b][m][n] = (f32x4){0.f, 0.f, 0.f, 0.f};
  bf16x8 At[4][2], B0[2][2], B1[2][2]; v8i At8[4], B08[2], B18[2]; (void)At; (void)B0; (void)B1; (void)At8; (void)B08; (void)B18;
  unsigned cuA[2][2], nxA[2][2], o2[2][2];
  const char* cA = Abase; const char* nA = Abase; const char* a2b = Abase;
  if constexpr (GATHER) { G8_GOFF(cuA, cur); } else { cA = Abase + S.a_off(cur, 0); }
  const char* cB = S.b_base(cur);
  (void)voffA; (void)nxA; (void)o2; (void)nA; (void)a2b;
  G8_STAGEB(G8_SB(0, 0), cB); if constexpr (NBJ == 2) G8_STAGEB(G8_SB(0, 1), cB + hstepB); G8_STAGEA(G8_SA(0, 0), 0, false, 0); G8_STAGEA(G8_SA(0, 1), 0, false, 1);
  if (wr == 1) G8_BAR;
  G8_WAIT_V(2); G8_BAR;
  G8_STAGEB(G8_SB(1, 0), cB + kstep); G8_STAGEA(G8_SA(1, 0), kstep, false, 0); if constexpr (NBJ == 2) G8_STAGEB(G8_SB(1, 1), cB + hstepB + kstep);
  if constexpr (NBJ == 2) G8_WAIT_V(6); else G8_WAIT_V(4);
  G8_BAR;
  for (;;) {
    const bool has_next = S.next(ui + 1, nxt);
    const char* nB = cB;
    if (has_next) {
      nB = S.b_base(nxt);
      if constexpr (GATHER) { G8_GOFF(nxA, nxt); } else { nA = Abase + S.a_off(nxt, 0); }
    } else {
      if constexpr (GATHER) {
#pragma unroll
        for (int h = 0; h < 2; ++h)
#pragma unroll
          for (int i = 0; i < 2; ++i) nxA[h][i] = cuA[h][i];
      } else nA = cA;
    }
    for (int t = 0; t < nt; t += 2) {
      const bool last = (t == nt - 2);
      const size_t k1 = (size_t)(t + 1) * kstep;
      const size_t k2 = last ? 0 : (size_t)(t + 2) * kstep, k3 = k2 + kstep;
      if constexpr (GATHER) {
#pragma unroll
        for (int h = 0; h < 2; ++h)
#pragma unroll
          for (int i = 0; i < 2; ++i) o2[h][i] = last ? nxA[h][i] : cuA[h][i];
      } else a2b = last ? nA : cA;
      const char* b2 = last ? nB : cB + (size_t)(t + 2) * kstep; const char* b3 = b2 + kstep;
      G8_LDB(B0, 0, 0); if constexpr (NBJ == 2) G8_LDB(B1, 0, 1); G8_SCHED; G8_LDA(At, 0, 0); G8_STAGEA(G8_SA(1, 1), k1, false, 1);
      G8_WAIT_M; G8_WAIT_L(0); G8_BAR; G8_MMA(0, 0, At, B0); if constexpr (NBJ == 2) G8_MMA(0, 1, At, B1); G8_BAR; G8_SCHED;
      G8_LDA(At, 0, 1); G8_STAGEB(G8_SB(0, 0), b2); if constexpr (NBJ == 2) G8_STAGEB(G8_SB(0, 1), b2 + hstepB); G8_STAGEA(G8_SA(0, 0), k2, true, 0);
      G8_WAIT_M; G8_WAIT_L(0); G8_BAR; G8_MMA(1, 0, At, B0); if constexpr (NBJ == 2) G8_MMA(1, 1, At, B1); G8_BAR; G8_SCHED;
      G8_LDB(B0, 1, 0); if constexpr (NBJ == 2) G8_LDB(B1, 1, 1); G8_SCHED; G8_LDA(At, 1, 0); G8_STAGEA(G8_SA(0, 1), k2, true, 1);
      G8_WAIT_M; G8_WAIT_L(0); G8_BAR; G8_MMA(0, 0, At, B0); if constexpr (NBJ == 2) G8_MMA(0, 1, At, B1); G8_BAR; G8_SCHED;
      G8_LDA(At, 1, 1); G8_STAGEB(G8_SB(1, 0), b3); if constexpr (NBJ == 2) G8_STAGEB(G8_SB(1, 1), b3 + hstepB); G8_STAGEA(G8_SA(1, 0), k3, true, 0);
      G8_WAIT_M; G8_WAIT_L(0); G8_BAR; G8_MMA(1, 0, At, B0); if constexpr (NBJ == 2) G8_MMA(1, 1, At, B1); G8_BAR; G8_SCHED;
    }
    if (wr == 0) G8_BAR;
    G8_SCHED; asm volatile("s_nop 15\n\ts_nop 7" ::: "memory"); G8_SCHED;
    if constexpr (PreOf<Epi>::has) E(acc, cur, wr, wc, fr, fq, pre); else E(acc, cur, wr, wc, fr, fq);
    if (!has_next) break;
#pragma unroll
    for (int a = 0; a < 2; ++a)
#pragma unroll
      for (int b = 0; b < NBJ; ++b)
#pragma unroll
        for (int m = 0; m < 4; ++m)
#pragma unroll
          for (int n = 0; n < 2; ++n) acc[a][b][m][n] = (f32x4){0.f, 0.f, 0.f, 0.f};
    cur = nxt; cB = nB; ++ui;
    if constexpr (PreOf<Epi>::has) E.pre(cur, wr, fr, pre);
    if constexpr (GATHER) {
#pragma unroll
      for (int h = 0; h < 2; ++h)
#pragma unroll
        for (int i = 0; i < 2; ++i) cuA[h][i] = nxA[h][i];
    } else cA = nA;
    if (wr == 1) G8_BAR;
  }
  G8_WAIT_V(0);
  G8_BAR;
#undef G8_SA
#undef G8_SB
#undef G8_STAGEA
#undef G8_STAGEB
#undef G8_LDA
#undef G8_LD8
#undef G8_WAIT_M
#undef G8_LDB
#undef G8_MMA
#undef G8_WAIT_V
#undef G8_WAIT_L
#undef G8_BAR
#undef G8_SCHED
#undef G8_GOFF
}

struct DenseOrder {
  static constexpr bool GATHER = false;
  int nM, nN, nwg, G, c, K; const char* Bt;
  DI void init(int M, int N, int K_, const void* Bt_, int G_, int c_) { nM = M / BM; nN = N / BM; nwg = nM * nN; G = G_; c = c_; K = K_; Bt = (const char*)Bt_; }
  DI bool next(int i, Unit& u) const {
    const long L = (long)i * G + c; if (L >= nwg) return false;
    int wgid = (int)L; { const int q = nwg / 8, r = nwg % 8, xcd = wgid % 8, off = wgid / 8; wgid = (xcd < r ? xcd * (q + 1) : r * (q + 1) + (xcd - r) * q) + off; }
    const int nig = 8 * nN, gid = wgid / nig, fm = gid * 8, gsz = (nM - fm) < 8 ? (nM - fm) : 8;
    u.pm = fm + ((wgid % nig) % gsz); u.pn = (wgid % nig) / gsz; u.e = 0; u.j = 0; return true;
  }
  DI unsigned a_off(const Unit& u, int R) const { return (unsigned)(u.pm * BM + R) * (unsigned)(K * 2); }
  DI const char* b_base(const Unit& u) const { return Bt + (size_t)u.pn * BM * K * 2; }
};
}
using g8::Unit;

struct EpiIn {
  static constexpr bool PERM = true, FP8 = false; static constexpr int NBJ = 2;
  bf16_t* qkpre; bf16_t* vm; bf16_t* hcat; bf16_t* cq; bf16_t* ckv; unsigned char* krope  ; float* gates; float* ssq_q; float* ssq_kv; const float* rope; const float* gate_b;
  DI void operator()(const f32x4 (&acc)[2][2][4][2], const Unit& u, int wr, int wc, int fr, int fq) const {
#pragma unroll
    for (int bj = 0; bj < 2; ++bj) {
      const int cw = u.pn * 256 + bj * 128 + wc * 32, c0 = cw + 8 * fq;
#pragma unroll
      for (int ai = 0; ai < 2; ++ai)
#pragma unroll
        for (int m = 0; m < 4; ++m) {
          const int row = u.pm * 256 + ai * 128 + wr * 64 + m * 16 + fr;
          const f32x4 v0 = acc[ai][bj][m][0], v1 = acc[ai][bj][m][1];
          if (cw < 1024) { u32x4 w = {cvtpk(v0[0], v0[1]), cvtpk(v0[2], v0[3]), cvtpk(v1[0], v1[1]), cvtpk(v1[2], v1[3])}; *(u32x4*)(qkpre + (size_t)row * 1024 + c0) = w; }
          else if (cw < 1536) { u32x4 w = {cvtpk(v0[0], v0[1]), cvtpk(v0[2], v0[3]), cvtpk(v1[0], v1[1]), cvtpk(v1[2], v1[3])}; *(u32x4*)(vm + (size_t)row * 512 + (c0 - 1024)) = w; }
          else if (cw < 2048) { u32x4 w = {cvtpk(sigmoidf_(v0[0]), sigmoidf_(v0[1])), cvtpk(sigmoidf_(v0[2]), sigmoidf_(v0[3])), cvtpk(sigmoidf_(v1[0]), sigmoidf_(v1[1])), cvtpk(sigmoidf_(v1[2]), sigmoidf_(v1[3]))};
                                *(u32x4*)(hcat + (size_t)row * 1024 + (c0 - 1536)) = w; }
          else if (cw < 2688) {
            u32x4 w = {cvtpk(v0[0], v0[1]), cvtpk(v0[2], v0[3]), cvtpk(v1[0], v1[1]), cvtpk(v1[2], v1[3])};
            float s = v0[0] * v0[0] + v0[1] * v0[1] + v0[2] * v0[2] + v0[3] * v0[3] + v1[0] * v1[0] + v1[1] * v1[1] + v1[2] * v1[2] + v1[3] * v1[3];
            s = half_swap_sum(xsum16(s));
            if (cw < 2432) { *(u32x4*)(cq + (size_t)row * 384 + (c0 - 2048)) = w; if (fq == 0) ssq_q[(size_t)row * 12 + ((cw - 2048) >> 5)] = s; }
            else { *(u32x4*)(ckv + (size_t)row * 256 + (c0 - 2432)) = w; if (fq == 0) ssq_kv[(size_t)row * 8 + ((cw - 2432) >> 5)] = s; }
          }
          else if (cw < 2752) {
            const int i0 = (c0 - 2688) >> 1;
            const f32x4 cs0 = *(const f32x4*)(rope + (size_t)row * 64 + 2 * i0), cs1 = *(const f32x4*)(rope + (size_t)row * 64 + 2 * i0 + 4);
            const float a0 = v0[0] * cs0[0] - v0[1] * cs0[1], b0 = v0[1] * cs0[0] + v0[0] * cs0[1];
            const float a1 = v0[2] * cs0[2] - v0[3] * cs0[3], b1 = v0[3] * cs0[2] + v0[2] * cs0[3];
            const float a2 = v1[0] * cs1[0] - v1[1] * cs1[1], b2 = v1[1] * cs1[0] + v1[0] * cs1[1];
            const float a3 = v1[2] * cs1[2] - v1[3] * cs1[3], b3 = v1[3] * cs1[2] + v1[2] * cs1[3];
            const u32x2 w = cvt8((f32x4){a0, b0, a1, b1}, (f32x4){a2, b2, a3, b3});
            const int b_ = row >> 14, s_ = row & (SEQ - 1);
#pragma unroll
            for (int hh = 0; hh < 4; ++hh) *(u32x2*)(krope + ((size_t)(b_ * 4 + hh) * SEQ + s_) * 192 + 128 + (c0 - 2688)) = w;
          }
          else if (cw == 2752) {
            if (fq < 2) { const f32x4 g0 = *(const f32x4*)(gate_b + 8 * fq), g1 = *(const f32x4*)(gate_b + 8 * fq + 4);
              *(f32x4*)(gates + (size_t)row * 16 + 8 * fq) = v0 + g0; *(f32x4*)(gates + (size_t)row * 16 + 8 * fq + 4) = v1 + g1; }
          }
        }
    }
  }
};
struct EpiUQ {
  static constexpr bool PERM = true, FP8 = false; static constexpr int NBJ = 2;
  unsigned char* qatt; const float* ssq_q; const float* rope;
  DI void operator()(const f32x4 (&acc)[2][2][4][2], const Unit& u, int wr, int wc, int fr, int fq) const {
    float rs[2][4];
#pragma unroll
    for (int ai = 0; ai < 2; ++ai)
#pragma unroll
      for (int m = 0; m < 4; ++m) {
        const int row = u.pm * 256 + ai * 128 + wr * 64 + m * 16 + fr;
        const f32x4 q0 = *(const f32x4*)(ssq_q + (size_t)row * 12), q1 = *(const f32x4*)(ssq_q + (size_t)row * 12 + 4), q2 = *(const f32x4*)(ssq_q + (size_t)row * 12 + 8);
        const float ss = (q0[0] + q0[1] + q0[2] + q0[3]) + (q1[0] + q1[1] + q1[2] + q1[3]) + (q2[0] + q2[1] + q2[2] + q2[3]);
        rs[ai][m] = rsqrtf(ss * (1.f / 384.f) + RMS_EPS) * QSCALE;
        asm volatile("" ::: "memory");
      }
#pragma unroll
    for (int bj = 0; bj < 2; ++bj) {
      const int cw = u.pn * 256 + bj * 128 + wc * 32, h = cw / 192, dw = cw - h * 192, d = dw + 8 * fq;
#pragma unroll
      for (int ai = 0; ai < 2; ++ai)
#pragma unroll
        for (int m = 0; m < 4; ++m) {
          const int row = u.pm * 256 + ai * 128 + wr * 64 + m * 16 + fr, b = row >> 14, s = row & (SEQ - 1);
          const f32x4 v0 = acc[ai][bj][m][0] * rs[ai][m], v1 = acc[ai][bj][m][1] * rs[ai][m];
          u32x2 w;
          if (dw < 128) { w = cvt8(v0, v1); }
          else {
            const int i0 = (d - 128) >> 1;
            const f32x4 cs0 = *(const f32x4*)(rope + (size_t)row * 64 + 2 * i0), cs1 = *(const f32x4*)(rope + (size_t)row * 64 + 2 * i0 + 4);
            const float a0 = v0[0] * cs0[0] - v0[1] * cs0[1], b0 = v0[1] * cs0[0] + v0[0] * cs0[1];
            const float a1 = v0[2] * cs0[2] - v0[3] * cs0[3], b1 = v0[3] * cs0[2] + v0[2] * cs0[3];
            const float a2 = v1[0] * cs1[0] - v1[1] * cs1[1], b2 = v1[1] * cs1[0] + v1[0] * cs1[1];
            const float a3 = v1[2] * cs1[2] - v1[3] * cs1[3], b3 = v1[3] * cs1[2] + v1[2] * cs1[3];
            w = cvt8((f32x4){a0, b0, a1, b1}, (f32x4){a2, b2, a3, b3});
          }
          *(u32x2*)(qatt + ((size_t)(b * 4 + h) * SEQ + s) * 192 + d) = w;
          asm volatile("" ::: "memory");
        }
    }
  }
};
struct EpiUKV {
  static constexpr bool PERM = true, FP8 = false; static constexpr int NBJ = 2;
  unsigned char* kn; unsigned char* vt8; const float* ssq_kv;
  DI void operator()(const f32x4 (&acc)[2][2][4][2], const Unit& u, int wr, int wc, int fr, int fq) const {
#pragma unroll
    for (int ai = 0; ai < 2; ++ai)
#pragma unroll
      for (int m = 0; m < 4; ++m) {
        const int row = u.pm * 256 + ai * 128 + wr * 64 + m * 16 + fr, b = row >> 14, s = row & (SEQ - 1);
        const f32x4 q0 = *(const f32x4*)(ssq_kv + (size_t)row * 8), q1 = *(const f32x4*)(ssq_kv + (size_t)row * 8 + 4);
        const float ss = (q0[0] + q0[1] + q0[2] + q0[3]) + (q1[0] + q1[1] + q1[2] + q1[3]);
        const float rs = rsqrtf(ss * (1.f / 256.f) + RMS_EPS);
        { const f32x4 v0 = acc[ai][0][m][0] * rs, v1 = acc[ai][0][m][1] * rs;
          *(u32x2*)(kn + ((size_t)(b * 4 + u.pn) * SEQ + s) * 192 + wc * 32 + 8 * fq) = cvt8(v0, v1); }
        { const f32x4 v0 = acc[ai][1][m][0] * rs, v1 = acc[ai][1][m][1] * rs;
          const u32x2 w = cvt8(v0, v1);
          const int k = s & 63, kq = k & 31, pos = 32 * ((kq >> 2) & 1) + (kq & 3) + 4 * (kq >> 3) + 16 * (k >> 5);
          unsigned char* dst = vt8 + ((size_t)((b * 4 + u.pn) * 256 + (s >> 6)) * 128 + wc * 32 + 8 * fq) * 64 + pos;
          dst[0] = (unsigned char)w[0]; dst[64] = (unsigned char)(w[0] >> 8); dst[128] = (unsigned char)(w[0] >> 16); dst[192] = (unsigned char)(w[0] >> 24);
          dst[256] = (unsigned char)w[1]; dst[320] = (unsigned char)(w[1] >> 8); dst[384] = (unsigned char)(w[1] >> 16); dst[448] = (unsigned char)(w[1] >> 24); }
        asm volatile("" ::: "memory");
      }
  }
};
struct EpiOut {
  static constexpr bool PERM = true, FP8 = false; static constexpr int NBJ = 2;
  const float* x; const float* mod; bf16_t* z;
  DI void operator()(const f32x4 (&acc)[2][2][4][2], const Unit& u, int wr, int wc, int fr, int fq) const {
#pragma unroll
    for (int ai = 0; ai < 2; ++ai)
#pragma unroll
      for (int m = 0; m < 4; ++m) {
        const int row = u.pm * 256 + ai * 128 + wr * 64 + m * 16 + fr, b = row >> 14;
#pragma unroll
        for (int bj = 0; bj < 2; ++bj) {
          const int c = u.pn * 256 + bj * 128 + wc * 32 + 8 * fq;
          const unsigned off = (unsigned)row * 1024u + (unsigned)c;
          const f32x4 x0 = *(const f32x4*)(x + off), x1 = *(const f32x4*)(x + off + 4), g0 = *(const f32x4*)(mod + b * 6144 + 2048 + c), g1 = *(const f32x4*)(mod + b * 6144 + 2048 + c + 4);
          const f32x4 z0 = x0 * ALPHA + (g0 + 1.f) * acc[ai][bj][m][0], z1 = x1 * ALPHA + (g1 + 1.f) * acc[ai][bj][m][1];
          *(u32x4*)(z + off) = (u32x4){cvtpk(z0[0], z0[1]), cvtpk(z0[2], z0[3]), cvtpk(z1[0], z1[1]), cvtpk(z1[2], z1[3])};
        }
        asm volatile("" ::: "memory");
      }
  }
};
struct EpiGU {
  static constexpr bool PERM = true, FP8 = true; static constexpr int NBJ = 1, ASCALE = 127;
  unsigned char* hdn;
  DI void operator()(const f32x4 (&acc)[2][1][4][2], const Unit& u, int wr, int wc, int fr, int fq) const {
    const unsigned base = ((unsigned)u.pm * 256u + wr * 64 + fr) * 512u + (unsigned)((u.pn * 128 + wc * 32 + 8 * fq) >> 1);
#pragma unroll
    for (int ai = 0; ai < 2; ++ai)
#pragma unroll
      for (int m = 0; m < 4; ++m) {
        const f32x4 g = acc[ai][0][m][0], up = acc[ai][0][m][1] * 8.f;
        int w = __builtin_amdgcn_cvt_pk_fp8_f32(siluf_(g[0]) * up[0], siluf_(g[1]) * up[1], 0, false); w = __builtin_amdgcn_cvt_pk_fp8_f32(siluf_(g[2]) * up[2], siluf_(g[3]) * up[3], w, true);
        *(int*)(hdn + (base + (unsigned)((ai * 128 + m * 16) * 512))) = w;
      }
  }
};
struct EpiDN {
  static constexpr bool PERM = true, FP8 = true; static constexpr int NBJ = 1, ASCALE = 124;
  bf16_t* ybuf; const float* lw;
  struct Pre { float w[2][4]; };
  DI void pre(const Unit& u, int wr, int fr, Pre& P) const {
    const unsigned wbase = ((unsigned)u.e * (unsigned)T + (unsigned)(u.j * 256 + wr * 64 + fr)) * 4u;
#pragma unroll
    for (int ai = 0; ai < 2; ++ai)
#pragma unroll
      for (int m = 0; m < 4; ++m) P.w[ai][m] = *(const float*)((const char*)lw + (wbase + (unsigned)((ai * 128 + m * 16) * 4)));
  }
  DI void operator()(const f32x4 (&acc)[2][1][4][2], const Unit& u, int wr, int wc, int fr, int fq, const Pre& P) const {
    const unsigned base = ((unsigned)u.pm * 256u + wr * 64 + fr) * 2048u + (unsigned)(u.pn * 128 + wc * 32 + 8 * fq) * 2u;
#pragma unroll
    for (int ai = 0; ai < 2; ++ai)
#pragma unroll
      for (int m = 0; m < 4; ++m) {
        const float wgt = P.w[ai][m];
        const f32x4 v0 = acc[ai][0][m][0] * wgt, v1 = acc[ai][0][m][1] * wgt;
        const u32x4 w = {cvtpk(v0[0], v0[1]), cvtpk(v0[2], v0[3]), cvtpk(v1[0], v1[1]), cvtpk(v1[2], v1[3])};
        *(u32x4*)((char*)ybuf + (base + (unsigned)((ai * 128 + m * 16) * 2048))) = w;
        asm volatile("" ::: "memory");
      }
  }
};
struct MoeOrderBase {
  const LAS int* tstart; const int* cnt; int G, c;
  DI bool next(int i, Unit& u) const {
    const int L = i * G + c, NT = tstart[32]; if (L >= NT * 8) return false;
    const int tile = L >> 3; int e = 0;
    for (int k = 1; k < 32; ++k) e = (tstart[k] <= tile) ? k : e;
    u.pm = tile; u.pn = L & 7; u.e = e; u.j = tile - tstart[e]; return true;
  }
};
struct MoeOrderGU : MoeOrderBase {
  static constexpr bool GATHER = true;
  const int* ltok; const char* Bt;
  DI unsigned a_off(const Unit& u, int R) const { const int n = cnt[u.e * CNT_STRIDE]; int idx = u.j * 256 + R; idx = idx < n ? idx : n - 1; return (unsigned)ltok[(size_t)u.e * T + idx] * 1024u; }
  DI const char* b_base(const Unit& u) const { return Bt + ((size_t)u.e * 1024 + u.pn * 128) * 1024; }
};
struct MoeOrderDN : MoeOrderBase {
  static constexpr bool GATHER = false;
  const char* Bt;
  DI unsigned a_off(const Unit& u, int R) const { return (unsigned)(u.pm * 256 + R) * 512u; }
  DI const char* b_base(const Unit& u) const { return Bt + ((size_t)u.e * 1024 + u.pn * 128) * 512; }
};

struct TDesc { const float* src; const float* kscale; bf16_t* dst; int ld, K, k0, n0, ok, fp8; };
DI TDesc tdesc(int r, int lane, unsigned char* ws) {
  constexpr int I_IN = 16 * 88, I_UQ = 6 * 24, I_UKV = 4 * 32, I_OUT = 16 * 32, I_GU = 32 * 16 * 32;
  TDesc d; d.kscale = nullptr; d.fp8 = 0; int sc, kb, nb; const float* W;
  if (r < I_IN) { kb = r / 88; nb = r % 88; const int n = nb * 32 + (lane & 31);
    sc = n < 2048 ? n : n < 2432 ? 2064 + (n - 2048) : n < 2688 ? 2448 + (n - 2432) : n < 2752 ? 2704 + ((n - 2688) & 1) * 32 + ((n - 2688) >> 1) : n < 2768 ? 2048 + (n - 2752) : -1;
    W = karg<A_WIN>(); d.ld = N_IN; d.K = 1024; d.dst = (bf16_t*)(ws + WS_WIN); }
  else if ((r -= I_IN) < I_UQ) { kb = r / 24; nb = r % 24; const int n = nb * 32 + (lane & 31), h = n / 192, dd = n - h * 192;
    sc = dd < 128 ? n : h * 192 + 128 + ((dd - 128) & 1) * 32 + ((dd - 128) >> 1);
    W = karg<A_WUQ>(); d.ld = 768; d.K = 384; d.dst = (bf16_t*)(ws + WS_WUQ); d.kscale = karg<A_QNG>(); }
  else if ((r -= I_UQ) < I_UKV) { kb = r / 32; nb = r % 32; sc = nb * 32 + (lane & 31); W = karg<A_WUKV>(); d.ld = 1024; d.K = 256; d.dst = (bf16_t*)(ws + WS_WUKV); d.kscale = karg<A_KVNG>(); }
  else if ((r -= I_UKV) < I_OUT) { kb = r / 32; nb = r % 32; sc = nb * 32 + (lane & 31); W = karg<A_WOUT>(); d.ld = 1024; d.K = 1024; d.dst = (bf16_t*)(ws + WS_WOUT); }
  else if ((r -= I_OUT) < I_GU) { const int e = r / 512, q = r % 512; kb = q / 32; nb = q % 32;
    const int lr = nb * 32 + (lane & 31), up = (lr >> 2) & 1; sc = (lr >> 3) * 4 + (lr & 3);
    W = (up ? karg<A_WUP>() : karg<A_WGATE>()) + (size_t)e * 1024 * 512; d.ld = 512; d.K = 1024; d.fp8 = 1; d.dst = (bf16_t*)(ws + WS_WGU + (size_t)e * 1024 * 1024); }
  else { r -= I_GU; const int e = r / 256, q = r % 256; kb = q / 32; nb = q % 32; sc = nb * 32 + (lane & 31);
    W = karg<A_WDOWN>() + (size_t)e * 512 * 1024; d.ld = 1024; d.K = 512; d.fp8 = 1; d.dst = (bf16_t*)(ws + WS_WDN + (size_t)e * 1024 * 512); }
  d.k0 = 64 * kb; d.n0 = 32 * nb; d.ok = sc >= 0;
  d.src = W + (size_t)(d.k0 + (lane >> 5)) * d.ld + (sc >= 0 ? sc : 0);
  return d;
}
DI void tload(const TDesc& d, float (&v)[32]) {
#pragma unroll
  for (int i = 0; i < 32; ++i) v[i] = d.src[(size_t)(2 * i) * d.ld];
}
DI void tstore(const TDesc& d, float (&v)[32], LAS float* scr, int lane) {
  if (d.kscale) {
#pragma unroll
    for (int i = 0; i < 32; ++i) v[i] *= d.kscale[d.k0 + 2 * i + (lane >> 5)];
  }
#pragma unroll
  for (int i = 0; i < 32; ++i) scr[(2 * i + (lane >> 5)) * 33 + (lane & 31)] = d.ok ? v[i] : 0.f;
  asm volatile("s_waitcnt lgkmcnt(0)" ::: "memory");
  const int c = lane & 7;
#pragma unroll
  for (int j = 0; j < 4; ++j) { const int n = (lane >> 3) + 8 * j; const LAS float* s = scr + (8 * c) * 33 + n;
    if (d.fp8) { *(u32x2*)((unsigned char*)d.dst + (size_t)(d.n0 + n) * d.K + d.k0 + 8 * c) =
        cvt8((f32x4){s[0 * 33], s[1 * 33], s[2 * 33], s[3 * 33]} * 32.f, (f32x4){s[4 * 33], s[5 * 33], s[6 * 33], s[7 * 33]} * 32.f); }
    else { u32x4 o; o.x = cvtpk(s[0 * 33], s[1 * 33]); o.y = cvtpk(s[2 * 33], s[3 * 33]); o.z = cvtpk(s[4 * 33], s[5 * 33]); o.w = cvtpk(s[6 * 33], s[7 * 33]);
      *(u32x4*)(d.dst + (size_t)(d.n0 + n) * d.K + d.k0 + 8 * c) = o; } }
  asm volatile("s_waitcnt lgkmcnt(0)" ::: "memory");
}
constexpr int PREP_ITEMS = 16 * 88 + 6 * 24 + 4 * 32 + 16 * 32 + 32 * 16 * 32 + 32 * 8 * 32;
constexpr int PREP_DEFER = 8192;
DI void prep_items(int it, const int end, const int stride, const int lane, unsigned char* ws, LAS float* scr) {
  TDesc dA, dB; float vA[32], vB[32];
  if (it < end) { dA = tdesc(it, lane, ws); tload(dA, vA); }
  while (it < end) {
    if (it + stride < end) { dB = tdesc(it + stride, lane, ws); tload(dB, vB); }
    tstore(dA, vA, scr, lane);
    it += stride; if (it >= end) break;
    if (it + stride < end) { dA = tdesc(it + stride, lane, ws); tload(dA, vA); }
    tstore(dB, vB, scr, lane);
    it += stride;
  }
}
DI void phase_prep(const Ctx& p, int bid, int G, LAS unsigned char* lds) {
  const int tid = tid_fresh(), lane = tid & 63, wave = __builtin_amdgcn_readfirstlane(tid >> 6);
  unsigned char* ws = p.ws;
  LAS float* scr = (LAS float*)(lds + wave * 16384);
  LAS float* cact = (LAS float*)(lds + 131072);
  for (int i = tid; i < 2048; i += NTHREADS) cact[i] = siluf_(karg<A_C>()[i]);
  __syncthreads();
  const int gw = bid * 8 + wave, NGW = G * 8;
  constexpr int I_MOD = 192;
  if (bid < I_MOD) {
    const int kg = lane >> 3, cc = lane & 7, col = bid * 32 + 4 * cc; const float* w_ada = karg<A_WADA>() + col;
    f32x4 a0 = {0.f, 0.f, 0.f, 0.f}, a1 = {0.f, 0.f, 0.f, 0.f};
#pragma unroll
    for (int j = 0; j < 16; ++j) { const int k = wave * 128 + kg + 8 * j; const f32x4 w = *(const f32x4*)(w_ada + (size_t)k * 6144); a0 += w * cact[k]; a1 += w * cact[1024 + k]; }
#pragma unroll
    for (int e = 0; e < 4; ++e) {
#pragma unroll
      for (int o = 8; o < 64; o <<= 1) { a0[e] += __shfl_xor(a0[e], o); a1[e] += __shfl_xor(a1[e], o); } }
    LAS f32x4* part = (LAS f32x4*)(lds + 131072 + 8192);
    if (kg == 0) { part[(wave * 8 + cc) * 2] = a0; part[(wave * 8 + cc) * 2 + 1] = a1; }
    __syncthreads();
    if (wave == 0 && kg == 0) { float* mod = (float*)(ws + WS_MOD); const f32x4 bb = *(const f32x4*)(karg<A_BADA>() + col);
      f32x4 s0 = part[cc * 2], s1 = part[cc * 2 + 1];
#pragma unroll
      for (int w = 1; w < 8; ++w) { s0 += part[(w * 8 + cc) * 2]; s1 += part[(w * 8 + cc) * 2 + 1]; }
      *(f32x4*)(mod + col) = s0 + bb; *(f32x4*)(mod + 6144 + col) = s1 + bb; }
  }
#ifndef DBL_PREP
#define DBL_PREP 0
#endif
  for (int rp_ = 0; rp_ < (DBL_PREP == 1 ? 2 : 1); ++rp_) prep_items(gw, PREP_ITEMS - PREP_DEFER, NGW, lane, ws, scr);
  {
    const float INV[32] = {1.000000000e+00f, 7.498942018e-01f, 5.623413324e-01f, 4.216965139e-01f, 3.162277639e-01f, 2.371373773e-01f, 1.778279394e-01f, 1.333521456e-01f,
                           1.000000015e-01f, 7.498942316e-02f, 5.623413250e-02f, 4.216964915e-02f, 3.162277490e-02f, 2.371373773e-02f, 1.778279431e-02f, 1.333521400e-02f,
                           9.999999776e-03f, 7.498942316e-03f, 5.623413250e-03f, 4.216964822e-03f, 3.162277630e-03f, 2.371373819e-03f, 1.778279431e-03f, 1.333521446e-03f,
                           1.000000047e-03f, 7.498941850e-04f, 5.623413017e-04f, 4.216965172e-04f, 3.162277571e-04f, 2.371373703e-04f, 1.778279402e-04f, 1.333521504e-04f};
    f32x2* rope = (f32x2*)(ws + WS_ROPE); const int* pos = karg<A_POS, const int>();
    for (int rp_ = 0; rp_ < (DBL_PREP == 2 ? 2 : 1); ++rp_)
    for (int i = bid * NTHREADS + tid; i < T * 32; i += G * NTHREADS) {
      const int t = i >> 5, fi = i & 31;
      const float ang = (float)pos[t] * INV[fi];
      float sn, cs; sincosf(ang, &sn, &cs); rope[i] = (f32x2){cs, sn};
    }
  }
  if (bid == 0) for (int i = tid; i < 64 * CNT_STRIDE; i += NTHREADS) ((int*)(ws + WS_CNT))[i] = 0;
  { const float* w_re = karg<A_WRE>(); const float* w_rg = karg<A_WRG>(); float* wrt = (float*)(ws + WS_WRT);
    for (int i = bid * NTHREADS + tid; i < 36 * 1024; i += G * NTHREADS) { const int e = i >> 10, k = i & 1023; wrt[i] = e < 32 ? w_re[k * 32 + e] : w_rg[k * 4 + (e - 32)]; } }
}

DI void phase_lnmod(const Ctx& p, int bid, int G) {
  const int tid = tid_fresh(), lane = tid & 63, wave = tid >> 6;
  const float* mod = (const float*)(p.ws + WS_MOD); bf16_t* U = (bf16_t*)(p.ws + WS_U); const float* xin = karg<A_X>();
  f32x4 vn[4];
  { const int row = bid * 8 + wave; if (row < T) { const f32x4* xr = (const f32x4*)(xin + (size_t)row * 1024) + lane;
#pragma unroll
      for (int j = 0; j < 4; ++j) vn[j] = xr[64 * j]; } }
  for (int row = bid * 8 + wave; row < T; row += G * 8) {
    const int b = row >> 14;
    f32x4 v[4]; float s = 0.f;
#pragma unroll
    for (int j = 0; j < 4; ++j) { v[j] = vn[j]; s += (v[j][0] + v[j][1]) + (v[j][2] + v[j][3]); }
    if (row + G * 8 < T) { const f32x4* xr = (const f32x4*)(xin + (size_t)(row + G * 8) * 1024) + lane;
#pragma unroll
      for (int j = 0; j < 4; ++j) vn[j] = xr[64 * j]; }
    const float mean = wave_sum(s) * (1.f / 1024.f); float s2 = 0.f;
#pragma unroll
    for (int j = 0; j < 4; ++j) { v[j] = v[j] - mean; s2 += (v[j][0] * v[j][0] + v[j][1] * v[j][1]) + (v[j][2] * v[j][2] + v[j][3] * v[j][3]); }
    const float rstd = rsqrtf(wave_sum(s2) * (1.f / 1024.f) + LN_EPS);
    u32x2* o8 = (u32x2*)(U + (size_t)row * 1024) + lane;
#pragma unroll
    for (int j = 0; j < 4; ++j) {
      const int col = 4 * lane + 256 * j;
      const f32x4 sh = *(const f32x4*)(mod + b * 6144 + col), sc = *(const f32x4*)(mod + b * 6144 + 1024 + col);
      const f32x4 y = v[j] * rstd * (sc + 1.f) + sh;
      o8[64 * j] = (u32x2){cvtpk(y[0], y[1]), cvtpk(y[2], y[3])};
    }
  }
}

constexpr int PA_V = 0, PA_KF = 32768, PA_KB = 65536, PA_RAWK = 100352, PA_VEC = 135168;
DI void mlstmA_unit(const Ctx& p, int b, int h, int c, LAS unsigned char* lds) {
  const int tid = tid_fresh(), lane = tid & 63, wid = __builtin_amdgcn_readfirstlane(tid >> 6), r32 = lane & 31, hi = lane >> 5;
  unsigned char* ws = p.ws;
  const bf16_t* qkpre = (const bf16_t*)(ws + WS_QKPRE); const bf16_t* vmp = (const bf16_t*)(ws + WS_VM); bf16_t* qkpost = (bf16_t*)(ws + WS_U);
  const float* gates = (const float*)(ws + WS_GATES); float* gvec = (float*)(ws + WS_GVEC); float* nvec = (float*)(ws + WS_NVEC); float* scal = (float*)(ws + WS_SCAL);
  bf16_t* Cbuf = (bf16_t*)p.out;
  LAS float* vec = (LAS float*)(lds + PA_VEC);
  const int bh = b * 4 + h, row0 = b * SEQ + c * 128;
  const int r0 = tid >> 4, c8 = (tid & 15) * 8;
  u32x4 rk[5], rq[5], rv[4];
#pragma unroll
  for (int j = 0; j < 5; ++j) {
    const int rr = r0 + 32 * j, sj = c * 128 + rr - 2; const bool ok = rr < 132 && sj >= 0 && sj < SEQ;
    const bf16_t* src = qkpre + (size_t)(b * SEQ + (ok ? sj : 0)) * 1024 + h * 128 + c8;
    rk[j] = ok ? *(const u32x4*)(src + 512) : (u32x4){0u, 0u, 0u, 0u}; rq[j] = ok ? *(const u32x4*)src : (u32x4){0u, 0u, 0u, 0u};
  }
#pragma unroll
  for (int j = 0; j < 4; ++j) rv[j] = *(const u32x4*)(vmp + (size_t)(row0 + r0 + 32 * j) * 512 + h * 128 + c8);
  float gb = 0.f, gcol = 0.f, gcm = 0.f;
  if (tid < 256) {
    const int dir = tid >> 7, t = tid & 127, wv = (tid >> 6) & 1;
    const float ig = gates[(size_t)(row0 + t) * 16 + (dir * 2) * 4 + h], fg = gates[(size_t)(row0 + t) * 16 + (dir * 2 + 1) * 4 + h];
    float x = logsigmoidf_(fg);
    if (dir == 0) {
#pragma unroll
      for (int o = 1; o < 64; o <<= 1) { const float y = __shfl_up(x, o); if (lane >= o) x += y; }
      if (lane == 63) vec[256 + wv] = x;
    } else {
#pragma unroll
      for (int o = 1; o < 64; o <<= 1) { const float y = __shfl_down(x, o); if (lane + o < 64) x += y; }
      if (lane == 0) vec[258 + wv] = x;
    }
    gb = x; gcol = ig;
  }
  __syncthreads();
  if (tid < 256) {
    const int dir = tid >> 7, wv = (tid >> 6) & 1;
    if (dir == 0) { if (wv == 1) gb += vec[256]; } else { if (wv == 0) gb += vec[259]; }
    gcol = gcol - gb;
    float x = gcol;
    if (dir == 0) {
#pragma unroll
      for (int o = 1; o < 64; o <<= 1) { const float y = __shfl_up(x, o); if (lane >= o) x = fmaxf(x, y); }
      if (lane == 63) vec[260 + wv] = x;
    } else {
#pragma unroll
      for (int o = 1; o < 64; o <<= 1) { const float y = __shfl_down(x, o); if (lane + o < 64) x = fmaxf(x, y); }
      if (lane == 0) vec[262 + wv] = x;
    }
    gcm = x;
  }
  __syncthreads();
  if (tid < 256) {
    const int dir = tid >> 7, t = tid & 127, wv = (tid >> 6) & 1;
    if (dir == 0) { if (wv == 1) gcm = fmaxf(gcm, vec[260]); } else { if (wv == 0) gcm = fmaxf(gcm, vec[263]); }
    const float mx = fmaxf(vec[260 + 2 * dir], vec[261 + 2 * dir]);
    const float tot = vec[256 + 2 * dir] + vec[257 + 2 * dir];
    float* gv = gvec + ((size_t)(dir * 8 + bh) * SEQ + c * 128 + t) * 3;
    gv[0] = gb; gv[1] = gcol; gv[2] = gcm;
    vec[dir * 128 + t] = __expf(gcol - mx);
    if (t == 0) { scal[(dir * 8 + bh) * 128 + c] = tot; scal[2048 + (dir * 8 + bh) * 128 + c] = tot + mx; }
  }
  __syncthreads();
#pragma unroll
  for (int j = 0; j < 5; ++j) { const int rr = r0 + 32 * j;
    if (rr < 132) { *(LAS u32x4*)(lds + PA_RAWK + rr * 256 + c8 * 2) = rk[j]; *(LAS u32x4*)(lds + PA_KB + rr * 256 + c8 * 2) = rq[j]; } }
#pragma unroll
  for (int j = 0; j < 4; ++j) { const int r = r0 + 32 * j; *(LAS u32x4*)(lds + PA_V + (r >> 6) * 16384 + v_st(r & 63, c8)) = rv[j]; }
  __syncthreads();
  const float* conv_w = karg<A_CONVW>(); const float* conv_b = karg<A_CONVB>();
  {
    const int ch = h * 128 + c8;
    float w[5][8], bias[8];
#pragma unroll
    for (int j = 0; j < 5; ++j) { const f32x4 a = *(const f32x4*)(conv_w + j * 1024 + ch), bq = *(const f32x4*)(conv_w + j * 1024 + ch + 4);
      w[j][0] = a[0]; w[j][1] = a[1]; w[j][2] = a[2]; w[j][3] = a[3]; w[j][4] = bq[0]; w[j][5] = bq[1]; w[j][6] = bq[2]; w[j][7] = bq[3]; }
    { const f32x4 a = *(const f32x4*)(conv_b + ch), bq = *(const f32x4*)(conv_b + ch + 4); bias[0] = a[0]; bias[1] = a[1]; bias[2] = a[2]; bias[3] = a[3]; bias[4] = bq[0]; bias[5] = bq[1]; bias[6] = bq[2]; bias[7] = bq[3]; }
#pragma unroll
    for (int ps = 0; ps < 4; ++ps) {
      const int r = r0 + 32 * ps;
      float a[8];
#pragma unroll
      for (int e = 0; e < 8; ++e) a[e] = bias[e];
#pragma unroll
      for (int j = 0; j < 5; ++j) { const u32x4 xv = *(const LAS u32x4*)(lds + PA_KB + (r + j) * 256 + c8 * 2);
        a[0] += w[j][0] * bflo(xv[0]); a[1] += w[j][1] * bfhi(xv[0]); a[2] += w[j][2] * bflo(xv[1]); a[3] += w[j][3] * bfhi(xv[1]);
        a[4] += w[j][4] * bflo(xv[2]); a[5] += w[j][5] * bfhi(xv[2]); a[6] += w[j][6] * bflo(xv[3]); a[7] += w[j][7] * bfhi(xv[3]); }
      const float qs = 0.08838834764831845f;
#pragma unroll
      for (int e = 0; e < 8; ++e) a[e] = siluf_(a[e]) * qs;
      *(u32x4*)(qkpost + (size_t)(row0 + r) * 1024 + ch) = (u32x4){cvtpk(a[0], a[1]), cvtpk(a[2], a[3]), cvtpk(a[4], a[5]), cvtpk(a[6], a[7])};
    }
  }
  __syncthreads();
  {
    const int ch = 512 + h * 128 + c8;
    float w[5][8], bias[8];
#pragma unroll
    for (int j = 0; j < 5; ++j) { const f32x4 a = *(const f32x4*)(conv_w + j * 1024 + ch), bq = *(const f32x4*)(conv_w + j * 1024 + ch + 4);
      w[j][0] = a[0]; w[j][1] = a[1]; w[j][2] = a[2]; w[j][3] = a[3]; w[j][4] = bq[0]; w[j][5] = bq[1]; w[j][6] = bq[2]; w[j][7] = bq[3]; }
    { const f32x4 a = *(const f32x4*)(conv_b + ch), bq = *(const f32x4*)(conv_b + ch + 4); bias[0] = a[0]; bias[1] = a[1]; bias[2] = a[2]; bias[3] = a[3]; bias[4] = bq[0]; bias[5] = bq[1]; bias[6] = bq[2]; bias[7] = bq[3]; }
#pragma unroll
    for (int ps = 0; ps < 4; ++ps) {
      const int r = r0 + 32 * ps;
      float a[8];
#pragma unroll
      for (int e = 0; e < 8; ++e) a[e] = bias[e];
#pragma unroll
      for (int j = 0; j < 5; ++j) { const u32x4 xv = *(const LAS u32x4*)(lds + PA_RAWK + (r + j) * 256 + c8 * 2);
        a[0] += w[j][0] * bflo(xv[0]); a[1] += w[j][1] * bfhi(xv[0]); a[2] += w[j][2] * bflo(xv[1]); a[3] += w[j][3] * bfhi(xv[1]);
        a[4] += w[j][4] * bflo(xv[2]); a[5] += w[j][5] * bfhi(xv[2]); a[6] += w[j][6] * bflo(xv[3]); a[7] += w[j][7] * bfhi(xv[3]); }
#pragma unroll
      for (int e = 0; e < 8; ++e) a[e] = siluf_(a[e]);
      *(u32x4*)(qkpost + (size_t)(row0 + r) * 1024 + ch) = (u32x4){cvtpk(a[0], a[1]), cvtpk(a[2], a[3]), cvtpk(a[4], a[5]), cvtpk(a[6], a[7])};
      const float wf = vec[r], wb = vec[128 + r];
      const u32x4 kf = {cvtpk(a[0] * wf, a[1] * wf), cvtpk(a[2] * wf, a[3] * wf), cvtpk(a[4] * wf, a[5] * wf), cvtpk(a[6] * wf, a[7] * wf)};
      const u32x4 kb = {cvtpk(a[0] * wb, a[1] * wb), cvtpk(a[2] * wb, a[3] * wb), cvtpk(a[4] * wb, a[5] * wb), cvtpk(a[6] * wb, a[7] * wb)};
      const int io = (r >> 6) * 16384 + v_st(r & 63, c8);
      *(LAS u32x4*)(lds + PA_KF + io) = kf; *(LAS u32x4*)(lds + PA_KB + io) = kb;
    }
  }
  __syncthreads();
  {
    const int dir = wid >> 2, dkb = wid & 3;
    const int ka = (int)(uintptr_t)(lds + (dir ? PA_KB : PA_KF)) + v_rd_base(lane) + dkb * 512;
    const int va = (int)(uintptr_t)(lds + PA_V) + v_rd_base(lane);
    f32x16 o[4] = {};
#define PA_STEP(TILE, KS) do { s16x4 al, ah, l0, h0, l1, h1, l2, h2, l3, h3;                                                   \
      al = tr_read<v_rd_off(0, KS, 0)>(ka + TILE * 16384); ah = tr_read<v_rd_off(0, KS, 1)>(ka + TILE * 16384);                 \
      l0 = tr_read<v_rd_off(0, KS, 0)>(va + TILE * 16384); h0 = tr_read<v_rd_off(0, KS, 1)>(va + TILE * 16384);                 \
      l1 = tr_read<v_rd_off(1, KS, 0)>(va + TILE * 16384); h1 = tr_read<v_rd_off(1, KS, 1)>(va + TILE * 16384);                 \
      l2 = tr_read<v_rd_off(2, KS, 0)>(va + TILE * 16384); h2 = tr_read<v_rd_off(2, KS, 1)>(va + TILE * 16384);                 \
      l3 = tr_read<v_rd_off(3, KS, 0)>(va + TILE * 16384); h3 = tr_read<v_rd_off(3, KS, 1)>(va + TILE * 16384);                 \
      asm volatile("s_waitcnt lgkmcnt(0)" ::: "memory"); SBAR();                                                                \
      const bf16x8 A = PKLH(al, ah);                                                                                            \
      o[0] = MFMA32(A, PKLH(l0, h0), o[0]); o[1] = MFMA32(A, PKLH(l1, h1), o[1]); o[2] = MFMA32(A, PKLH(l2, h2), o[2]); o[3] = MFMA32(A, PKLH(l3, h3), o[3]); } while (0)
    PA_STEP(0, 0); PA_STEP(0, 1); PA_STEP(0, 2); PA_STEP(0, 3); PA_STEP(1, 0); PA_STEP(1, 1); PA_STEP(1, 2); PA_STEP(1, 3);
#undef PA_STEP
    bf16_t* Cd = Cbuf + ((size_t)(dir * 8 + bh) * 128 + c) * 16384;
#pragma unroll
    for (int r = 0; r < 16; ++r) { const int dk = dkb * 32 + crow(r, hi);
#pragma unroll
      for (int d0 = 0; d0 < 4; ++d0) Cd[dk * 128 + d0 * 32 + r32] = f2bf(o[d0][r]); }
  }
  if (tid < 256) {
    const int dir = tid >> 7, dk = tid & 127; const LAS unsigned char* img = lds + (dir ? PA_KB : PA_KF);
    float n = 0.f;
#pragma unroll 8
    for (int s = 0; s < 128; ++s) n += bf2f(*(const LAS unsigned short*)(img + (s >> 6) * 16384 + v_st(s & 63, dk)));
    nvec[((size_t)(dir * 8 + bh) * 128 + c) * 128 + dk] = n;
  }
  __syncthreads();
}

DI void phase_scan(const Ctx& p, int bid, int G) {
  const int tid = tid_fresh(); unsigned char* ws = p.ws;
  const float* scal = (const float*)(ws + WS_SCAL); float* mprev = (float*)(ws + WS_SCAL) + 4096; float* nvec = (float*)(ws + WS_NVEC); bf16_t* Cbuf = (bf16_t*)p.out;
  for (int gid = bid * NTHREADS + tid, it = 0; gid < 131072; gid += G * NTHREADS, ++it) {
    const int seq = gid >> 13, e2c = gid & 8191, dir = seq >> 3;
    const bool ex = (it == 0) && (gid < 1024);
    const int seqn = (gid & 1023) >> 6, e2 = gid & 63, dirn = seqn >> 3;
    float m = 0.f, a0 = 0.f, a1 = 0.f, mN = 0.f, n0 = 0.f, n1 = 0.f;
    for (int sb = 0; sb < 128; sb += 8) {
      unsigned raw[8]; f32x2 rawn[8];
#pragma unroll
      for (int q = 0; q < 8; ++q) { const int c = dir ? 127 - (sb + q) : sb + q; raw[q] = *(const unsigned*)(Cbuf + ((size_t)seq * 128 + c) * 16384 + e2c * 2); }
      if (ex) {
#pragma unroll
        for (int q = 0; q < 8; ++q) { const int c = dirn ? 127 - (sb + q) : sb + q; rawn[q] = *(const f32x2*)(nvec + ((size_t)seqn * 128 + c) * 128 + e2 * 2); }
      }
#pragma unroll
      for (int q = 0; q < 8; ++q) {
        const int c = dir ? 127 - (sb + q) : sb + q;
        const float be = scal[seq * 128 + c], ml = scal[2048 + seq * 128 + c];
        *(unsigned*)(Cbuf + ((size_t)seq * 128 + c) * 16384 + e2c * 2) = cvtpk(a0, a1);
        if (e2c == 0) mprev[seq * 128 + c] = m;
        const float mn = fmaxf(be + m, ml), al = __expf(be + m - mn), bt = __expf(ml - mn);
        a0 = al * a0 + bt * bflo(raw[q]); a1 = al * a1 + bt * bfhi(raw[q]);
        m = mn;
      }
      if (ex) {
#pragma unroll
        for (int q = 0; q < 8; ++q) {
          const int c = dirn ? 127 - (sb + q) : sb + q;
          const float be = scal[seqn * 128 + c], ml = scal[2048 + seqn * 128 + c];
          *(f32x2*)(nvec + ((size_t)seqn * 128 + c) * 128 + e2 * 2) = (f32x2){n0, n1};
          const float mn = fmaxf(be + mN, ml), al = __expf(be + mN - mn), bt = __expf(ml - mn);
          n0 = al * n0 + bt * rawn[q][0]; n1 = al * n1 + bt * rawn[q][1];
          mN = mn;
        }
      }
    }
  }
}

DI void qkt8(f32x16& p0, f32x16& p1, const LAS unsigned char* Ks, const bf16x8* qr, int r32, int hi) {
  p0 = f32x16{}; p1 = f32x16{};
#pragma unroll
  for (int d0 = 0; d0 < 8; ++d0) { const int cb = (d0 * 16 + hi * 8) * 2;
    const bf16x8 b0 = *(const LAS bf16x8*)(Ks + KSWZ(r32, cb)), b1 = *(const LAS bf16x8*)(Ks + KSWZ(32 + r32, cb));
    p0 = MFMA32(b0, qr[d0], p0); p1 = MFMA32(b1, qr[d0], p1); }
}
DI v8i kfrag8(const LAS unsigned char* K8, int row, int s, int hi) {
  const int c = 4 * s + 2 * hi;
  const u32x4 lo = *(const LAS u32x4*)(K8 + row * 256 + ((c ^ (row & 15)) << 4)), hi4 = *(const LAS u32x4*)(K8 + row * 256 + (((c + 1) ^ (row & 15)) << 4));
  return (v8i){(int)lo[0], (int)lo[1], (int)lo[2], (int)lo[3], (int)hi4[0], (int)hi4[1], (int)hi4[2], (int)hi4[3]};
}
#define MFMA8(a, b, c) __builtin_amdgcn_mfma_scale_f32_32x32x64_f8f6f4((a), (b), (c), 0, 0, 0, 127, 0, 123)
DI void qkt12(f32x16& p0, f32x16& p1, const LAS unsigned char* K8, const v8i* qr, int r32, int hi) {
  p0 = f32x16{}; p1 = f32x16{};
#pragma unroll
  for (int s = 0; s < 3; ++s) {
    const v8i a0 = kfrag8(K8, r32, s, hi), a1 = kfrag8(K8, 32 + r32, s, hi);
    p0 = MFMA8(a0, qr[s], p0); p1 = MFMA8(a1, qr[s], p1);
  }
}

DI void glds16(const void* gsrc, unsigned lds_dst) {
  unsigned keep;
  asm volatile("s_mov_b32 %0, m0\n\ts_mov_b32 m0, %2\n\ts_nop 0\n\tglobal_load_lds_dwordx4 %1, off\n\ts_mov_b32 m0, %0" : "=&s"(keep) : "v"(gsrc), "s"(lds_dst) : "memory");
}
constexpr int AT_KN = 0, AT_V = 49152, AT_WS = 73728;
constexpr float ATT_THR = 3.f;
DI void partialSM(f32x16& p0, f32x16& p1, float& m_reg, float& mn, float& alpha) {
  float pmax = p0[0];
#pragma unroll
  for (int r = 1; r < 16; ++r) pmax = fmaxf(pmax, p0[r]);
#pragma unroll
  for (int r = 0; r < 16; ++r) pmax = fmaxf(pmax, p1[r]);
  pmax = half_swap_max(pmax);
  if (__builtin_expect(__all(pmax - m_reg <= ATT_THR), 1)) { mn = m_reg; alpha = 1.f; }
  else { mn = fmaxf(m_reg, pmax); alpha = __builtin_amdgcn_exp2f(m_reg - mn); m_reg = mn; }
  const float mo = mn - 5.f;
#pragma unroll
  for (int r = 0; r < 16; ++r) { p0[r] = p0[r] - mo; p1[r] = p1[r] - mo; }
#pragma unroll
  for (int r = 0; r < 16; ++r) p0[r] = __builtin_amdgcn_exp2f(p0[r]);
}
DI void finishSM(f32x16& p0, f32x16& p1, v8i& pa) {
#pragma unroll
  for (int r = 0; r < 16; ++r) p1[r] = __builtin_amdgcn_exp2f(p1[r]);
#pragma unroll
  for (int q = 0; q < 4; ++q) {
    int w = __builtin_amdgcn_cvt_pk_fp8_f32(p0[4 * q], p0[4 * q + 1], pa[q], false); pa[q] = __builtin_amdgcn_cvt_pk_fp8_f32(p0[4 * q + 2], p0[4 * q + 3], w, true);
    w = __builtin_amdgcn_cvt_pk_fp8_f32(p1[4 * q], p1[4 * q + 1], pa[4 + q], false); pa[4 + q] = __builtin_amdgcn_cvt_pk_fp8_f32(p1[4 * q + 2], p1[4 * q + 3], w, true);
  }
}
DI void pv8(f32x16* o, f32x16& lsum, const LAS unsigned char* Vt, v8i pa, int r32, int hi) {
  { const v8i ones = {0x38383838, 0x38383838, 0x38383838, 0x38383838, 0x38383838, 0x38383838, 0x38383838, 0x38383838};
    lsum = __builtin_amdgcn_mfma_scale_f32_32x32x64_f8f6f4(pa, ones, lsum, 0, 0, 0, 122, 0, 127); }
#pragma unroll
  for (int d0 = 0; d0 < 4; ++d0) {
    const int n = 32 * d0 + r32, x = (n >> 2) & 3;
    const u32x4 lo = *(const LAS u32x4*)(Vt + n * 64 + (((2 * hi) ^ x) << 4)), h4 = *(const LAS u32x4*)(Vt + n * 64 + (((2 * hi + 1) ^ x) << 4));
    const v8i bv = {(int)lo[0], (int)lo[1], (int)lo[2], (int)lo[3], (int)h4[0], (int)h4[1], (int)h4[2], (int)h4[3]};
    o[d0] = __builtin_amdgcn_mfma_scale_f32_32x32x64_f8f6f4(pa, bv, o[d0], 0, 0, 0, 122, 0, 127);
  }
}
DI void attn_unit(const unsigned char* Qb, const unsigned char* Knh, const unsigned char* Vh, bf16_t* Ob, LAS unsigned char* lds) {
  const int tid = tid_fresh(), wid = __builtin_amdgcn_readfirstlane(tid >> 6), lane = tid & 63, r32 = lane & 31, hi = lane >> 5;
  LAS float* wsf = (LAS float*)(lds + AT_WS) + wid * 64; LAS float* al_l = wsf + 32;
  constexpr int NT = SEQ / 64;
  unsigned offKn, offV;
  { const int row = wid * 4 + (lane >> 4); int lg = (lane & 15) ^ (row & 15); lg = lg < 12 ? lg : 0; offKn = (unsigned)(row * 192 + lg * 16); }
  { const int n = wid * 16 + (lane >> 2), c = (lane & 3) ^ ((n >> 2) & 3); offV = (unsigned)(n * 64 + c * 16); }
  const unsigned ldsw = (unsigned)wid * 1024u, lds0 = (unsigned)(uintptr_t)lds;
#define DMA16(gptr, ldsoff) glds16((gptr), (unsigned)__builtin_amdgcn_readfirstlane((int)(lds0 + (unsigned)(ldsoff))))
#define ISSUE_K(t, ks) do { const int t_ = (t) < NT ? (t) : NT - 1; const char* kn_ = (const char*)Knh + (size_t)t_ * (64 * 192) + offKn; \
    DMA16(kn_, AT_KN + (ks) * 16384 + ldsw); DMA16(kn_ + 32 * 192, AT_KN + (ks) * 16384 + 8192 + ldsw); } while (0)
#define ISSUE_V(t, vs) do { const int t_ = (t) < NT ? (t) : NT - 1; DMA16((const char*)Vh + (size_t)t_ * 8192 + offV, AT_V + (vs) * 8192 + ldsw); } while (0)
#define WAIT_BAR(N) asm volatile("s_waitcnt vmcnt(" #N ") lgkmcnt(0)\n\ts_barrier" ::: "memory")
#define RESC(a) do { if (__any((a) < 1.f)) { if (hi == 0) al_l[r32] = (a); asm volatile("s_waitcnt lgkmcnt(0)" ::: "memory"); \
    _Pragma("unroll") for (int r = 0; r < 16; ++r) { const float a_ = al_l[crow(r, hi)]; lsum[r] *= a_; _Pragma("unroll") for (int d = 0; d < 4; ++d) o[d][r] *= a_; } } } while (0)
  const bool trail = wid >= 4;
  ISSUE_K(0, 0); ISSUE_K(1, 1); ISSUE_V(0, 0);
  float m_reg = -1e30f; f32x16 lsum = {}; f32x16 o[4] = {}; v8i qr[3];
  { const unsigned char* Qw = Qb + (size_t)(wid * 32 + r32) * 192 + hi * 32;
#pragma unroll
    for (int s_ = 0; s_ < 3; ++s_) { const u32x4 lo = *(const u32x4*)(Qw + s_ * 64), h4 = *(const u32x4*)(Qw + s_ * 64 + 16);
      qr[s_] = (v8i){(int)lo[0], (int)lo[1], (int)lo[2], (int)lo[3], (int)h4[0], (int)h4[1], (int)h4[2], (int)h4[3]}; } }
  f32x16 pA0, pA1, pB0, pB1; float mnA, mnB, alA, alB; v8i pa = {};
  asm volatile("s_waitcnt vmcnt(0)" ::: "memory");
  __builtin_amdgcn_s_barrier();
  if (trail) __builtin_amdgcn_s_barrier();
  ISSUE_K(2, 2);
  qkt12(pA0, pA1, lds + AT_KN, qr, r32, hi);
  WAIT_BAR(3);
  ISSUE_V(1, 1);
  partialSM(pA0, pA1, m_reg, mnA, alA);
  WAIT_BAR(3);
  int s1 = 1;
  for (int j = 1; j + 1 < NT; j += 2) {
    const int s0 = s1 == 0 ? 2 : s1 - 1, s2 = s1 == 2 ? 0 : s1 + 1;
    ISSUE_K(j + 2, s0);
    SBAR(); qkt12(pB0, pB1, lds + AT_KN + s1 * 16384, qr, r32, hi);
    finishSM(pA0, pA1, pa); SBAR();
    WAIT_BAR(3);
    ISSUE_V(j + 1, s2);
    pv8(o, lsum, lds + AT_V + s0 * 8192, pa, r32, hi); partialSM(pB0, pB1, m_reg, mnB, alB);
    RESC(alB);
    WAIT_BAR(3);
    ISSUE_K(j + 3, s1);
    SBAR(); qkt12(pA0, pA1, lds + AT_KN + s2 * 16384, qr, r32, hi);
    finishSM(pB0, pB1, pa); SBAR();
    WAIT_BAR(3);
    ISSUE_V(j + 2, s0);
    pv8(o, lsum, lds + AT_V + s1 * 8192, pa, r32, hi); partialSM(pA0, pA1, m_reg, mnA, alA);
    RESC(alA);
    WAIT_BAR(3);
    s1 = s0;
  }
  {
    const int s0 = s1 == 0 ? 2 : s1 - 1, s2 = s1 == 2 ? 0 : s1 + 1;
    ISSUE_K(NT + 1, s0);
    SBAR(); qkt12(pB0, pB1, lds + AT_KN + s1 * 16384, qr, r32, hi);
    finishSM(pA0, pA1, pa); SBAR();
    WAIT_BAR(3);
    ISSUE_V(NT, s2);
    pv8(o, lsum, lds + AT_V + s0 * 8192, pa, r32, hi); partialSM(pB0, pB1, m_reg, mnB, alB);
    RESC(alB);
    WAIT_BAR(3);
    if (!trail) __builtin_amdgcn_s_barrier();
    finishSM(pB0, pB1, pa); SBAR();
    pv8(o, lsum, lds + AT_V + s1 * 8192, pa, r32, hi);
  }
  float rli[16];
#pragma unroll
  for (int r = 0; r < 16; ++r) rli[r] = __builtin_amdgcn_rcpf(lsum[r]);
  bf16_t* Ow = Ob + (size_t)(wid * 32) * 1024;
#pragma unroll
  for (int r = 0; r < 16; ++r) { const int orow = crow(r, hi);
#pragma unroll
    for (int d0 = 0; d0 < 4; ++d0) Ow[(size_t)orow * 1024 + d0 * 32 + r32] = f2bf(o[d0][r] * rli[r]); }
  asm volatile("s_waitcnt vmcnt(0) lgkmcnt(0)\n\ts_barrier" ::: "memory");
#undef DMA16
#undef ISSUE_K
#undef ISSUE_V
#undef WAIT_BAR
#undef RESC
}
DI void phase_attn(const Ctx& p, int bid, int G, LAS unsigned char* lds) {
  unsigned char* ws = p.ws;
  const unsigned char* qatt = ws + WS_QATT; const unsigned char* k8 = ws + WS_KN; const unsigned char* va = ws + WS_VA;
  bf16_t* hcat = (bf16_t*)(ws + WS_H);
  for (int u = bid; u < 512; u += G) {
    const int bh = u & 7, qb = u >> 3, b = bh >> 2, h = bh & 3;
    attn_unit(qatt + ((size_t)bh * SEQ + qb * 256) * 192, k8 + (size_t)bh * SEQ * 192, va + (size_t)bh * SEQ * 128,
              hcat + (size_t)(b * SEQ + qb * 256) * 1024 + 512 + h * 128, lds);
  }
}

constexpr int PC_K = 0, PC_V = 32768, PC_CF = 65536, PC_CB = 98304, PC_VEC = 131072;
template <bool DRY = false> DI void mlstmC_unit(const Ctx& p, int b, int h, int c, LAS unsigned char* lds) {
  const int tid = tid_fresh(), lane = tid & 63, wid = __builtin_amdgcn_readfirstlane(tid >> 6), r32 = lane & 31, hi = lane >> 5;
  unsigned char* ws = p.ws;
  const bf16_t* qkpost = (const bf16_t*)(ws + WS_U); const bf16_t* vmp = (const bf16_t*)(ws + WS_VM); bf16_t* hcat = (bf16_t*)(ws + WS_H);
  const float* gvec = (const float*)(ws + WS_GVEC); const float* nvec = (const float*)(ws + WS_NVEC); const float* mprev = (const float*)(ws + WS_SCAL) + 4096;
  const bf16_t* Cbuf = (const bf16_t*)p.out;
  LAS float* vec = (LAS float*)(lds + PC_VEC);
  const int bh = b * 4 + h, row0 = b * SEQ + c * 128;
  if (tid < 256) {
    const int dir = tid >> 7, t = tid & 127;
    const float* gv = gvec + ((size_t)(dir * 8 + bh) * SEQ + c * 128 + t) * 3;
    const float gb = gv[0], gcol = gv[1], gcm = gv[2], mp = mprev[(dir * 8 + bh) * 128 + c];
    const float M = fmaxf(mp, gcm);
    vec[dir * 128 + t] = gcol * LOG2E; vec[256 + dir * 128 + t] = M * LOG2E; vec[512 + dir * 128 + t] = __expf(mp - M); vec[768 + dir * 128 + t] = __expf(-(gb + M));
    vec[1024 + dir * 128 + t] = nvec[((size_t)(dir * 8 + bh) * 128 + c) * 128 + t];
  }
  {
    const int r0 = tid >> 4, c8 = (tid & 15) * 8;
    const bf16_t* Cf = Cbuf + ((size_t)(0 * 8 + bh) * 128 + c) * 16384; const bf16_t* Cb = Cbuf + ((size_t)(1 * 8 + bh) * 128 + c) * 16384;
#pragma unroll
    for (int ps = 0; ps < 4; ++ps) {
      const int r = r0 + 32 * ps, tile = r >> 6, rr = r & 63;
      *(LAS u32x4*)(lds + PC_K + tile * 16384 + KSWZ(rr, c8 * 2)) = *(const u32x4*)(qkpost + (size_t)(row0 + r) * 1024 + 512 + h * 128 + c8);
      *(LAS u32x4*)(lds + PC_V + tile * 16384 + v_st(rr, c8)) = *(const u32x4*)(vmp + (size_t)(row0 + r) * 512 + h * 128 + c8);
      *(LAS u32x4*)(lds + PC_CF + tile * 16384 + v_st(rr, c8)) = *(const u32x4*)(Cf + r * 128 + c8);
      *(LAS u32x4*)(lds + PC_CB + tile * 16384 + v_st(rr, c8)) = *(const u32x4*)(Cb + r * 128 + c8);
    }
  }
  const int dir = wid >> 2, tb = wid & 3, t = tb * 32 + r32;
  bf16x8 qr[8];
  { const bf16_t* Qw = qkpost + (size_t)(row0 + t) * 1024 + h * 128 + hi * 8;
#pragma unroll
    for (int d0 = 0; d0 < 8; ++d0) qr[d0] = *(const bf16x8*)(Qw + d0 * 16); }
  __syncthreads();
  const LAS float* vcol = vec + dir * 128; const LAS float* va_ = vec + 512 + dir * 128; const LAS float* vn = vec + 1024 + dir * 128;
  float qn = 0.f;
#pragma unroll
  for (int d0 = 0; d0 < 8; ++d0)
#pragma unroll
    for (int j = 0; j < 8; ++j) qn += bf2f((unsigned short)qr[d0][j]) * vn[d0 * 16 + hi * 8 + j];
  qn = half_swap_sum(qn);
  asm volatile("" : "+v"(qn));
  SBAR();
  f32x16 o[4] = {};
  {
    const int vbc = (int)(uintptr_t)(lds + (dir ? PC_CB : PC_CF)) + v_rd_base(lane);
    pv_d0(o, vbc, qr[0], qr[1], qr[2], qr[3]);
    pv_d0(o, vbc + 16384, qr[4], qr[5], qr[6], qr[7]);
  }
#pragma unroll
  for (int d = 0; d < 4; ++d)
#pragma unroll
    for (int r = 0; r < 16; ++r) o[d][r] *= va_[tb * 32 + crow(r, hi)];
  SBAR();
  const float Mt = vec[256 + dir * 128 + t], at = va_[t], flt = vec[768 + dir * 128 + t];
  float rsum = 0.f;
  const int vbv = (int)(uintptr_t)(lds + PC_V) + v_rd_base(lane);
#pragma unroll
  for (int kt = 0; kt < 2; ++kt) {
    const bool need = dir == 0 ? (kt * 64 <= tb * 32 + 31) : (kt * 64 + 63 >= tb * 32);
    if (need) {
      f32x16 p0, p1; qkt8(p0, p1, lds + PC_K + kt * 16384, qr, r32, hi);
#pragma unroll
      for (int r = 0; r < 16; ++r) {
        const int s0 = kt * 64 + crow(r, hi), s1 = s0 + 32;
        const bool ok0 = dir == 0 ? (s0 <= t) : (s0 >= t), ok1 = dir == 0 ? (s1 <= t) : (s1 >= t);
        const float w0 = __builtin_amdgcn_exp2f(vcol[s0] - Mt), w1 = __builtin_amdgcn_exp2f(vcol[s1] - Mt);
        p0[r] = ok0 ? p0[r] * w0 : 0.f; p1[r] = ok1 ? p1[r] * w1 : 0.f;
        rsum += p0[r] + p1[r];
      }
      bf16x8 pa0, pa1, pa2, pa3; pack_p(p0, p1, pa0, pa1, pa2, pa3);
      pv_d0(o, vbv + kt * 16384, pa0, pa1, pa2, pa3);
    }
  }
  rsum = half_swap_sum(rsum);
  {
    const float den = at * qn + rsum, dn = fmaxf(fabsf(den), flt);
    LAS float* rd = vec + 1280 + dir * 128;
    if (hi == 0) rd[t] = 1.f / dn;
    asm volatile("s_waitcnt lgkmcnt(0)" ::: "memory");
#pragma unroll
    for (int d = 0; d < 4; ++d)
#pragma unroll
      for (int r = 0; r < 16; ++r) o[d][r] *= rd[tb * 32 + crow(r, hi)];
  }
  __syncthreads();
  {
    LAS float* hst = (LAS float*)(lds + dir * 65536);
#pragma unroll
    for (int r = 0; r < 16; ++r) { const int tr = tb * 32 + crow(r, hi);
#pragma unroll
      for (int d = 0; d < 4; ++d) hst[tr * 128 + d * 32 + r32] = o[d][r]; }
  }
  __syncthreads();
  {
    const int rg = tid >> 5, cl = tid & 31;
    const f32x4 g = *(const f32x4*)(karg<A_MHG>() + h * 128 + 4 * cl);
    u32x2 sgv[8];
#pragma unroll
    for (int ps = 0; ps < 8; ++ps) sgv[ps] = *(const u32x2*)(hcat + (size_t)(row0 + ps * 16 + rg) * 1024 + h * 128 + 4 * cl);
#pragma unroll
    for (int ps = 0; ps < 8; ++ps) {
      const int tr = ps * 16 + rg;
      const f32x4 xf = *(const LAS f32x4*)(lds + (tr * 128 + 4 * cl) * 4), xb = *(const LAS f32x4*)(lds + 65536 + (tr * 128 + 4 * cl) * 4);
      f32x4 x = xf + xb;
      float s = (x[0] + x[1]) + (x[2] + x[3]);
      s = half_sum32(s);
      const float mu = s * (1.f / 128.f); x = x - mu;
      float q = (x[0] * x[0] + x[1] * x[1]) + (x[2] * x[2] + x[3] * x[3]);
      q = half_sum32(q);
      const float rstd = rsqrtf(q * (1.f / 128.f) + LN_EPS);
      u32x2* dst = (u32x2*)(hcat + (size_t)(row0 + tr) * 1024 + h * 128 + 4 * cl);
      const u32x2 sg = sgv[ps];
      const f32x4 y = x * rstd * g;
      if (DRY) dst = (u32x2*)((bf16_t*)(ws + WS_QKPRE) + (size_t)(row0 + tr) * 1024 + h * 128 + 4 * cl);
      *dst = (u32x2){cvtpk(y[0] * bflo(sg[0]), y[1] * bfhi(sg[0])), cvtpk(y[2] * bflo(sg[1]), y[3] * bfhi(sg[1]))};
    }
  }
  __syncthreads();
}

template <bool DRY = false> DI void phase_hanorm(const Ctx& p, int bid, int G) {
  const int tid = tid_fresh(), lane = tid & 63, wave = tid >> 6; bf16_t* hcat = (bf16_t*)(p.ws + WS_H);
  const f32x4 g0 = *(const f32x4*)(karg<A_ANG>() + 8 * lane), g1 = *(const f32x4*)(karg<A_ANG>() + 8 * lane + 4);
  u32x4 wn = {0u, 0u, 0u, 0u};
  { const int row = bid * 8 + wave; if (row < T) wn = *(const u32x4*)(hcat + (size_t)row * 1024 + 512 + 8 * lane); }
  for (int row = bid * 8 + wave; row < T; row += G * 8) {
    u32x4* ptr = (u32x4*)(hcat + (size_t)row * 1024 + 512 + 8 * lane);
    const u32x4 w = wn;
    if (row + G * 8 < T) wn = *(const u32x4*)(hcat + (size_t)(row + G * 8) * 1024 + 512 + 8 * lane);
    float v[8] = {bflo(w[0]), bfhi(w[0]), bflo(w[1]), bfhi(w[1]), bflo(w[2]), bfhi(w[2]), bflo(w[3]), bfhi(w[3])};
    float s = 0.f;
#pragma unroll
    for (int e = 0; e < 8; ++e) s += v[e] * v[e];
    const float rs = rsqrtf(wave_sum(s) * (1.f / 512.f) + RMS_EPS);
    if (DRY) ptr = (u32x4*)((bf16_t*)(p.ws + WS_QKPRE) + (size_t)row * 1024 + 512 + 8 * lane);
    *ptr = (u32x4){cvtpk(v[0] * rs * g0[0], v[1] * rs * g0[1]), cvtpk(v[2] * rs * g0[2], v[3] * rs * g0[3]), cvtpk(v[4] * rs * g1[0], v[5] * rs * g1[1]), cvtpk(v[6] * rs * g1[2], v[7] * rs * g1[3])};
  }
}

template <bool DRY = false> DI void phase_route(const Ctx& p, int bid, int G, LAS unsigned char* lds) {
  const int tid = tid_fresh(), lane = tid & 63, wave = tid >> 6; unsigned char* ws = p.ws;
  LAS float* wreT = (LAS float*)lds;
  LAS float* wrgT = (LAS float*)(lds + 131072);
  LAS int* rec = (LAS int*)(lds + 147456);
  LAS int* lcnt = (LAS int*)(lds + 147456 + 2048);
  { const f32x4* wrt = (const f32x4*)(ws + WS_WRT);
    for (int i = tid; i < 36 * 256; i += NTHREADS) ((LAS f32x4*)lds)[i] = wrt[i]; }
  const float* ln1_g = karg<A_LN1G>(); const float* ln1_b = karg<A_LN1B>(); const float* b_rg = karg<A_BRG>(); const float* b_re = karg<A_BRE>();
  const float* mod = (const float*)(ws + WS_MOD); bf16_t* U = (bf16_t*)(ws + WS_U);
  int* cnt = (int*)(ws + WS_CNT) + (DRY ? 32 * CNT_STRIDE : 0);
  int* ltok = (int*)(ws + (DRY ? WS_HDN : WS_LTOK)); float* lw = (float*)(ws + (DRY ? WS_HDN + 8 * MiB : WS_LW));
  int* toke = (int*)(ws + WS_TOKE) + (DRY ? 2 * T : 0); int* tokp = (int*)(ws + WS_TOKP) + (DRY ? 2 * T : 0);
  const int nk = T / (G * 8);
  __syncthreads();
  f32x4 wg[4][4];
#pragma unroll
  for (int e = 0; e < 4; ++e)
#pragma unroll
    for (int j = 0; j < 4; ++j) wg[e][j] = *(const LAS f32x4*)(wrgT + e * 1024 + 4 * lane + 256 * j);
  for (int k0 = 0; k0 < nk; k0 += 16) {
    if (tid < 32) lcnt[tid] = 0;
    __syncthreads();
    u32x2 zn[4];
    { const u32x2* zr = (const u32x2*)((const bf16_t*)p.out + (size_t)(bid * 8 + wave + k0 * G * 8) * 1024) + lane;
#pragma unroll
      for (int j = 0; j < 4; ++j) zn[j] = zr[64 * j]; }
    for (int kk = 0; kk < 16 && k0 + kk < nk; ++kk) {
      const int row = bid * 8 + wave + (k0 + kk) * G * 8, b = row >> 14;
      u32x2* x1r = (u32x2*)((bf16_t*)(ws + (DRY ? 384 * MiB : WS_H)) + (size_t)row * 1024) + lane;
      f32x4 v[4]; float s = 0.f;
#pragma unroll
      for (int j = 0; j < 4; ++j) { const u32x2 raw = zn[j]; v[j] = (f32x4){bflo(raw[0]), bfhi(raw[0]), bflo(raw[1]), bfhi(raw[1])}; s += (v[j][0] + v[j][1]) + (v[j][2] + v[j][3]); }
      if (kk + 1 < 16 && k0 + kk + 1 < nk) { const u32x2* zr = (const u32x2*)((const bf16_t*)p.out + (size_t)(row + G * 8) * 1024) + lane;
#pragma unroll
        for (int j = 0; j < 4; ++j) zn[j] = zr[64 * j]; }
      float mean = wave_sum(s) * (1.f / 1024.f), s2 = 0.f;
#pragma unroll
      for (int j = 0; j < 4; ++j) { v[j] = v[j] - mean; s2 += (v[j][0] * v[j][0] + v[j][1] * v[j][1]) + (v[j][2] * v[j][2] + v[j][3] * v[j][3]); }
      float rstd = rsqrtf(wave_sum(s2) * (1.f / 1024.f) + LN_EPS);
      s = 0.f;
#pragma unroll
      for (int j = 0; j < 4; ++j) { const int col = 4 * lane + 256 * j;
        v[j] = v[j] * rstd * *(const f32x4*)(ln1_g + col) + *(const f32x4*)(ln1_b + col);
        x1r[64 * j] = (u32x2){cvtpk(v[j][0], v[j][1]), cvtpk(v[j][2], v[j][3])};
        s += (v[j][0] + v[j][1]) + (v[j][2] + v[j][3]); }
      mean = wave_sum(s) * (1.f / 1024.f); s2 = 0.f;
#pragma unroll
      for (int j = 0; j < 4; ++j) { v[j] = v[j] - mean; s2 += (v[j][0] * v[j][0] + v[j][1] * v[j][1]) + (v[j][2] * v[j][2] + v[j][3] * v[j][3]); }
      rstd = rsqrtf(wave_sum(s2) * (1.f / 1024.f) + LN_EPS);
      int* o8 = (int*)((unsigned char*)U + (size_t)row * 1024) + lane;
      float gl[4] = {0.f, 0.f, 0.f, 0.f};
#pragma unroll
      for (int j = 0; j < 4; ++j) { const int col = 4 * lane + 256 * j;
        v[j] = v[j] * rstd * (*(const f32x4*)(mod + b * 6144 + 4096 + col) + 1.f) + *(const f32x4*)(mod + b * 6144 + 3072 + col);
        { int w8 = __builtin_amdgcn_cvt_pk_fp8_f32(v[j][0], v[j][1], 0, false); o8[64 * j] = __builtin_amdgcn_cvt_pk_fp8_f32(v[j][2], v[j][3], w8, true); }
#pragma unroll
        for (int e = 0; e < 4; ++e) { const f32x4 w = wg[e][j]; gl[e] += v[j][0] * w[0] + v[j][1] * w[1] + v[j][2] * w[2] + v[j][3] * w[3]; } }
#pragma unroll
      for (int e = 0; e < 4; ++e) gl[e] = wave_sum(gl[e]) + b_rg[e];
      int gi = 0; float gm = gl[0];
#pragma unroll
      for (int e = 1; e < 4; ++e) if (gl[e] > gm) { gm = gl[e]; gi = e; }
      float gs = 0.f;
#pragma unroll
      for (int e = 0; e < 4; ++e) gs += __expf(gl[e] - gm);
      const float gw = 1.f / gs;
      float el[8] = {0.f, 0.f, 0.f, 0.f, 0.f, 0.f, 0.f, 0.f};
#pragma unroll
      for (int j = 0; j < 4; ++j) { const int col = 4 * lane + 256 * j;
#pragma unroll
        for (int e = 0; e < 8; ++e) { const f32x4 w = *(const LAS f32x4*)(wreT + (gi * 8 + e) * 1024 + col); el[e] += v[j][0] * w[0] + v[j][1] * w[1] + v[j][2] * w[2] + v[j][3] * w[3]; } }
#pragma unroll
      for (int e = 0; e < 8; ++e) el[e] = wave_sum(el[e]) + b_re[gi * 8 + e];
      int i1 = 0; float v1 = el[0];
#pragma unroll
      for (int e = 1; e < 8; ++e) if (el[e] > v1) { v1 = el[e]; i1 = e; }
      int i2 = (i1 == 0) ? 1 : 0; float v2 = (i1 == 0) ? el[1] : el[0];
#pragma unroll
      for (int e = 0; e < 8; ++e) if (e != i1 && el[e] > v2) { v2 = el[e]; i2 = e; }
      const float p1 = 1.f / (1.f + __expf(v2 - v1)), p2 = 1.f - p1;
      if (lane == 0) {
        const int e1 = gi * 8 + i1, e2 = gi * 8 + i2, li = kk * 8 + wave;
        const int q1 = __hip_atomic_fetch_add(&lcnt[e1], 1, __ATOMIC_RELAXED, __HIP_MEMORY_SCOPE_WORKGROUP), q2 = __hip_atomic_fetch_add(&lcnt[e2], 1, __ATOMIC_RELAXED, __HIP_MEMORY_SCOPE_WORKGROUP);
        rec[li * 4 + 0] = e1 | (e2 << 8); rec[li * 4 + 1] = q1 | (q2 << 16); rec[li * 4 + 2] = __float_as_int(p1 * gw); rec[li * 4 + 3] = __float_as_int(p2 * gw);
      }
    }
    __syncthreads();
    if (tid < 32) { const int n = lcnt[tid]; lcnt[32 + tid] = n ? atomicAdd(&cnt[tid * CNT_STRIDE], n) : 0; }
    __syncthreads();
    if (tid < 128 && k0 + (tid >> 3) < nk) {
      const int li = tid, row = bid * 8 + (li & 7) + (k0 + (li >> 3)) * G * 8;
      const int ee = rec[li * 4], qq = rec[li * 4 + 1], e1 = ee & 255, e2 = ee >> 8, q1 = lcnt[32 + e1] + (qq & 0xffff), q2 = lcnt[32 + e2] + (qq >> 16);
      ltok[(size_t)e1 * T + q1] = row; lw[(size_t)e1 * T + q1] = __int_as_float(rec[li * 4 + 2]);
      ltok[(size_t)e2 * T + q2] = row; lw[(size_t)e2 * T + q2] = __int_as_float(rec[li * 4 + 3]);
      toke[row * 2] = e1; toke[row * 2 + 1] = e2; tokp[row * 2] = q1; tokp[row * 2 + 1] = q2;
    }
    __syncthreads();
  }
}

constexpr int MOE_TS = 131072;
DI void moe_table(const Ctx& p, LAS unsigned char* lds) {
  LAS int* ts = (LAS int*)(lds + MOE_TS); const int* cnt = (const int*)(p.ws + WS_CNT);
  if (threadIdx.x < 64) {
    const int lane = threadIdx.x; const int n = lane < 32 ? (cnt[lane * CNT_STRIDE] + 255) >> 8 : 0; int a = n;
#pragma unroll
    for (int o = 1; o < 32; o <<= 1) { const int t = __shfl_up(a, o); a += lane >= o ? t : 0; }
    if (lane < 32) ts[lane] = a - n;
    if (lane == 31) ts[32] = a;
  }
  __syncthreads();
}

template <bool DRY = false> DI void phase_final(const Ctx& p, int bid, int G, LAS unsigned char* lds) {
  const int tid = tid_fresh(), lane = tid & 63, wave = tid >> 6; unsigned char* ws = p.ws;
  const LAS int* ts = (const LAS int*)(lds + MOE_TS); const float* ln2_g = karg<A_LN2G>(); const float* ln2_b = karg<A_LN2B>();
  const float* mod = (const float*)(ws + WS_MOD); const bf16_t* ybuf = (const bf16_t*)(ws + WS_YBUF); const int* toke = (const int*)(ws + WS_TOKE); const int* tokp = (const int*)(ws + WS_TOKP);
  const int stride = G * 8; int row = bid * 8 + wave;
  size_t s0n = 0, s1n = 0;
  u32x2 an[4], cn[4], xn[4];
  auto slots = [&](int r, size_t& a, size_t& c) { a = (size_t)ts[toke[r * 2]] * 256 + tokp[r * 2]; c = (size_t)ts[toke[r * 2 + 1]] * 256 + tokp[r * 2 + 1]; };
  auto loadrow = [&](int r, size_t a, size_t c) {
    const u32x2* x1r = (const u32x2*)((const bf16_t*)(ws + WS_H) + (size_t)r * 1024) + lane;
    const u32x2* y0 = (const u32x2*)(ybuf + a * 1024) + lane; const u32x2* y1 = (const u32x2*)(ybuf + c * 1024) + lane;
#pragma unroll
    for (int j = 0; j < 4; ++j) { an[j] = y0[64 * j]; cn[j] = y1[64 * j]; xn[j] = x1r[64 * j]; } };
  if (row < T) { size_t a, c; slots(row, a, c); loadrow(row, a, c); if (row + stride < T) slots(row + stride, s0n, s1n); }
  for (; row < T; row += stride) {
    const int b = row >> 14;
    f32x4 v[4]; float s = 0.f;
#pragma unroll
    for (int j = 0; j < 4; ++j) { const int col = 4 * lane + 256 * j;
      const u32x2 a = an[j], c = cn[j], xw = xn[j];
      const f32x4 y = {bflo(a[0]) + bflo(c[0]), bfhi(a[0]) + bfhi(c[0]), bflo(a[1]) + bflo(c[1]), bfhi(a[1]) + bfhi(c[1])};
      const f32x4 x1v = {bflo(xw[0]), bfhi(xw[0]), bflo(xw[1]), bfhi(xw[1])};
      v[j] = x1v * ALPHA + (*(const f32x4*)(mod + b * 6144 + 5120 + col) + 1.f) * y;
      s += (v[j][0] + v[j][1]) + (v[j][2] + v[j][3]); }
    if (row + stride < T) { loadrow(row + stride, s0n, s1n); if (row + 2 * stride < T) slots(row + 2 * stride, s0n, s1n); }
    const float mean = wave_sum(s) * (1.f / 1024.f); float s2 = 0.f;
#pragma unroll
    for (int j = 0; j < 4; ++j) { v[j] = v[j] - mean; s2 += (v[j][0] * v[j][0] + v[j][1] * v[j][1]) + (v[j][2] * v[j][2] + v[j][3] * v[j][3]); }
    const float rstd = rsqrtf(wave_sum(s2) * (1.f / 1024.f) + LN_EPS);
    f32x4* xr = (f32x4*)(p.out + (size_t)row * 1024) + lane;
#pragma unroll
    for (int j = 0; j < 4; ++j) { const int col = 4 * lane + 256 * j; xr[64 * j] = v[j] * rstd * *(const f32x4*)(ln2_g + col) + *(const f32x4*)(ln2_b + col); }
  }
}


#define XB_TMO      128
#define XB_XCNT(j)  (256  + 64 * (j))
#define XB_XSUB(j)  (1280 + 64 * (j))
#define XB_XGEN(j)  (2304 + 64 * (j))
#define XB_TOP      3328
#define XB_TOPGEN   3392
#define XCD_BAR_WORDS 3456
#define XB_SPIN_CAP (1u << 18)
DI unsigned xb_ld(unsigned* p)              { return __hip_atomic_load(p, __ATOMIC_RELAXED, __HIP_MEMORY_SCOPE_AGENT); }
DI unsigned xb_add(unsigned* p, unsigned v) { return __hip_atomic_fetch_add(p, v, __ATOMIC_RELAXED, __HIP_MEMORY_SCOPE_AGENT); }
DI unsigned xb_xcc_id() { return (unsigned)__builtin_amdgcn_s_getreg((3 << 11) | 20) & 0xFu; }
#define XB_SPIN(cond, bar) do { unsigned _sp = 0; while (cond) { __builtin_amdgcn_s_sleep(1); \
    if ((++_sp & 255u) == 0u) { if (xb_ld(&(bar)[XB_TMO])) break; if (_sp > XB_SPIN_CAP) { atomicAdd(&(bar)[XB_TMO], 1u); break; } } } } while (0)
struct XcdBarrier { unsigned* bar; unsigned x; volatile LAS unsigned* st; };
DI XcdBarrier xcd_barrier_post(unsigned* bar, volatile LAS unsigned* st) {
  XcdBarrier b; b.bar = bar; b.x = xb_xcc_id(); b.st = st;
  if (threadIdx.x == 0) (void)xb_add(&bar[XB_XCNT(b.x)], 1u);
  return b;
}
DI void xcd_barrier_complete(unsigned* bar, unsigned x, unsigned& nloc, unsigned& nx) {
  const unsigned G = gridDim.x * gridDim.y * gridDim.z;
  unsigned sum, cnt, mine, sp = 0u;
  for (;;) {
    sum = 0u; cnt = 0u; mine = 0u;
#pragma unroll
    for (unsigned j = 0; j < 16; ++j) { const unsigned c = xb_ld(&bar[XB_XCNT(j)]); sum += c; cnt += (c > 0u) ? 1u : 0u; mine = (j == x) ? c : mine; }
    if (sum == G) break;
    __builtin_amdgcn_s_sleep(1);
    if ((++sp & 255u) == 0u) { if (xb_ld(&bar[XB_TMO])) break; if (sp > XB_SPIN_CAP) { atomicAdd(&bar[XB_TMO], 1u); break; } }
  }
  nloc = mine > 0u ? mine : 1u; nx = cnt > 0u ? cnt : 1u;
}
DI void xcd_barrier(const XcdBarrier& b) {
  asm volatile("s_waitcnt vmcnt(0)" ::: "memory");
  __syncthreads();
  if (threadIdx.x == 0) {
    unsigned* bar = b.bar;
    __builtin_amdgcn_s_waitcnt(0);
    unsigned nloc = b.st[0], nx = b.st[1];
    if (nloc == 0u) { xcd_barrier_complete(bar, b.x, nloc, nx); b.st[0] = nloc; b.st[1] = nx; }
    const unsigned old = xb_add(&bar[XB_XSUB(b.x)], 1u);
    const unsigned gen = old / nloc;
    if (old + 1u == (gen + 1u) * nloc) {
      __builtin_amdgcn_fence(__ATOMIC_RELEASE, "agent");
      asm volatile("s_waitcnt vmcnt(0)" ::: "memory");
      const unsigned og = xb_add(&bar[XB_TOP], 1u);
      const unsigned tg = og / nx;
      if (og + 1u == (tg + 1u) * nx) xb_add(&bar[XB_TOPGEN], 1u);
      else XB_SPIN(xb_ld(&bar[XB_TOPGEN]) == tg, bar);
      __builtin_amdgcn_fence(__ATOMIC_ACQUIRE, "agent");
      xb_add(&bar[XB_XGEN(b.x)], 1u);
      asm volatile("s_waitcnt vmcnt(0)" ::: "memory");
    } else {
      XB_SPIN(xb_ld(&bar[XB_XGEN(b.x)]) == gen, bar);
      __builtin_amdgcn_fence(__ATOMIC_ACQUIRE, "agent");
      asm volatile("s_waitcnt vmcnt(0)" ::: "memory");
    }
  }
  __syncthreads();
}

__device__ unsigned g_bar_counter = 0;
DI void grid_barrier(const unsigned G) {
  asm volatile("s_waitcnt vmcnt(0)" ::: "memory");
  __syncthreads();
  if (threadIdx.x == 0) {
    __builtin_amdgcn_fence(__ATOMIC_RELEASE, "agent");
    asm volatile("s_waitcnt vmcnt(0)" ::: "memory");
    const unsigned old = __hip_atomic_fetch_add(&g_bar_counter, 1u, __ATOMIC_RELAXED, __HIP_MEMORY_SCOPE_AGENT);
    const unsigned target = (old / G + 1u) * G;
    unsigned sp = 0;
    while ((int)(__hip_atomic_load(&g_bar_counter, __ATOMIC_RELAXED, __HIP_MEMORY_SCOPE_AGENT) - target) < 0) { __builtin_amdgcn_s_sleep(1); if (++sp > (1u << 24)) break; }
    __builtin_amdgcn_fence(__ATOMIC_ACQUIRE, "agent");
    asm volatile("s_waitcnt vmcnt(0)" ::: "memory");
  }
  __syncthreads();
}

#define KERNEL_HEAD extern __shared__ __attribute__((aligned(16))) unsigned char lds_raw[]; LAS unsigned char* lds = (LAS unsigned char*)lds_raw; const int bid = blockIdx.x, G = gridDim.x; \
  Ctx p; p.ws = karg<A_WS, unsigned char>(); p.out = karg<A_OUT, float>();
#ifdef MULTI_LAUNCH
__global__ void __launch_bounds__(NTHREADS, 2) k_prep(Params) { KERNEL_HEAD phase_prep(p, bid, G, lds); }
__global__ void __launch_bounds__(NTHREADS, 2) k_lnmod(Params) { KERNEL_HEAD (void)lds; phase_lnmod(p, bid, G); }
__global__ void __launch_bounds__(NTHREADS, 2) k_inproj(Params) { KERNEL_HEAD
  unsigned char* ws = p.ws;
  g8::DenseOrder S; S.init(T, N_INP, 1024, ws + WS_WIN, G, bid);
  EpiIn E{(bf16_t*)(ws + WS_QKPRE), (bf16_t*)(ws + WS_VM), (bf16_t*)(ws + WS_H), (bf16_t*)(ws + WS_CQ), (bf16_t*)(ws + WS_CKV), (unsigned char*)(ws + WS_KN), (float*)(ws + WS_GATES),
          (float*)(ws + WS_SSQQ), (float*)(ws + WS_SSQKV), (const float*)(ws + WS_ROPE), karg<A_GATEB>()};
  g8::gemm_phase(lds, (const char*)(ws + WS_U), 1024, S, E);
}
__global__ void __launch_bounds__(NTHREADS, 2) k_mid1(Params) { KERNEL_HEAD
  unsigned char* ws = p.ws;
  { g8::DenseOrder S; S.init(T, 768, 384, ws + WS_WUQ, G, bid); EpiUQ E{(unsigned char*)(ws + WS_QATT), (const float*)(ws + WS_SSQQ), (const float*)(ws + WS_ROPE)};
    g8::gemm_phase(lds, (const char*)(ws + WS_CQ), 384, S, E); }
}
__global__ void __launch_bounds__(NTHREADS, 2) k_mid2(Params) { KERNEL_HEAD
  unsigned char* ws = p.ws;
  { g8::DenseOrder S; S.init(T, 1024, 256, ws + WS_WUKV, G, bid); EpiUKV E{(unsigned char*)(ws + WS_KN), (unsigned char*)(ws + WS_VA), (const float*)(ws + WS_SSQKV)};
    g8::gemm_phase(lds, (const char*)(ws + WS_CKV), 256, S, E); }
}
__global__ void __launch_bounds__(NTHREADS, 2) k_mid3(Params) { KERNEL_HEAD
  for (int u = bid; u < 1024; u += G) { const int c = u & 127, bh = u >> 7; mlstmA_unit(p, bh >> 2, bh & 3, c, lds); }
}
__global__ void __launch_bounds__(NTHREADS, 2) k_scan_attn(Params) { KERNEL_HEAD phase_scan(p, bid, G); phase_attn(p, bid, G, lds); }
__global__ void __launch_bounds__(NTHREADS, 2) k_mlstm_out(Params) { KERNEL_HEAD
  for (int u = bid; u < 1024; u += G) { const int c = u & 127, bh = u >> 7; mlstmC_unit(p, bh >> 2, bh & 3, c, lds); }
  phase_hanorm(p, bid, G);
}
__global__ void __launch_bounds__(NTHREADS, 2) k_outproj(Params) { KERNEL_HEAD
  unsigned char* ws = p.ws;
  g8::DenseOrder S; S.init(T, 1024, 1024, ws + WS_WOUT, G, bid); EpiOut E{karg<A_X>(), (const float*)(ws + WS_MOD), (bf16_t*)p.out};
  g8::gemm_phase(lds, (const char*)(ws + WS_H), 1024, S, E);
}
__global__ void __launch_bounds__(NTHREADS, 2) k_route(Params) { KERNEL_HEAD phase_route(p, bid, G, lds); }
__global__ void __launch_bounds__(NTHREADS, 2) k_moe_gu(Params) { KERNEL_HEAD
  unsigned char* ws = p.ws; moe_table(p, lds);
  MoeOrderGU S; S.tstart = (const LAS int*)(lds + MOE_TS); S.cnt = (const int*)(ws + WS_CNT); S.G = G; S.c = bid; S.ltok = (const int*)(ws + WS_LTOK); S.Bt = (const char*)(ws + WS_WGU);
  EpiGU E{(unsigned char*)(ws + WS_HDN)};
  g8::gemm_phase(lds, (const char*)(ws + WS_U), 512  , S, E);
}
__global__ void __launch_bounds__(NTHREADS, 2) k_moe_dn(Params) { KERNEL_HEAD
  unsigned char* ws = p.ws; moe_table(p, lds);
  MoeOrderDN S; S.tstart = (const LAS int*)(lds + MOE_TS); S.cnt = (const int*)(ws + WS_CNT); S.G = G; S.c = bid; S.Bt = (const char*)(ws + WS_WDN);
  EpiDN E{(bf16_t*)(ws + WS_YBUF), (const float*)(ws + WS_LW)};
  g8::gemm_phase(lds, (const char*)(ws + WS_HDN), 256  , S, E);
}
__global__ void __launch_bounds__(NTHREADS, 2) k_final(Params) { KERNEL_HEAD moe_table(p, lds); phase_final(p, bid, G, lds); }

#endif

__global__ void __launch_bounds__(NTHREADS, 2) k_mega(Params) { KERNEL_HEAD
  unsigned char* ws = p.ws;
  if (bid == 0) for (int i = threadIdx.x; i < XCD_BAR_WORDS; i += NTHREADS) ((unsigned*)(ws + WS_BAR))[i] = 0u;
  if (threadIdx.x < 64) ((LAS unsigned*)(lds + LDS_BARST))[threadIdx.x] = 0u;
  XcdBarrier xbar; xbar.bar = (unsigned*)(ws + WS_BAR); xbar.x = 0; xbar.st = (volatile LAS unsigned*)(lds + LDS_BARST);
  bool xb_ready = false;
#define PHASE_SEP() do { asm volatile("" ::: "memory"); if (!xb_ready) { grid_barrier((unsigned)G); xbar = xcd_barrier_post((unsigned*)(ws + WS_BAR), (volatile LAS unsigned*)(lds + LDS_BARST)); xb_ready = true; } \
    else xcd_barrier(xbar); asm volatile("" ::: "memory"); } while (0)
#define REP(n) for (int rep_ = 0; rep_ < ((n) == DBL_PHASE ? 2 : 1); ++rep_)
  REP(0) phase_prep(p, bid, G, lds);
  PHASE_SEP();
#if MEGA_STOP == 1
  return;
#endif
  REP(1) phase_lnmod(p, bid, G);
  PHASE_SEP();
#if MEGA_STOP == 2
  return;
#endif
  REP(2) { g8::DenseOrder S; S.init(T, N_INP, 1024, ws + WS_WIN, G, bid);
    EpiIn E{(bf16_t*)(ws + WS_QKPRE), (bf16_t*)(ws + WS_VM), (bf16_t*)(ws + WS_H), (bf16_t*)(ws + WS_CQ), (bf16_t*)(ws + WS_CKV), (unsigned char*)(ws + WS_KN), (float*)(ws + WS_GATES),
            (float*)(ws + WS_SSQQ), (float*)(ws + WS_SSQKV), (const float*)(ws + WS_ROPE), karg<A_GATEB>()};
    g8::gemm_phase(lds, (const char*)(ws + WS_U), 1024, S, E);
    { const int first = S.nwg % G, nb = G - first;
      if (bid >= first) { const int tid = tid_fresh(), lane = tid & 63, wave = __builtin_amdgcn_readfirstlane(tid >> 6);
        prep_items(PREP_ITEMS - PREP_DEFER + (bid - first) * 8 + wave, PREP_ITEMS, nb * 8, lane, ws, (LAS float*)(lds + wave * 16384)); } } }
  PHASE_SEP();
#if MEGA_STOP == 3
  return;
#endif
  const bool mfirst = ((bid >> 3) & 1) != 0;
  if (mfirst) { for (int u = bid; u < 1024; u += G) { const int c = u & 127, bh = u >> 7; mlstmA_unit(p, bh >> 2, bh & 3, c, lds); } __syncthreads(); }
  { g8::DenseOrder S; S.init(T, 768, 384, ws + WS_WUQ, G, bid); EpiUQ E{(unsigned char*)(ws + WS_QATT), (const float*)(ws + WS_SSQQ), (const float*)(ws + WS_ROPE)};
    g8::gemm_phase(lds, (const char*)(ws + WS_CQ), 384, S, E); }
  __syncthreads();
  { g8::DenseOrder S; S.init(T, 1024, 256, ws + WS_WUKV, G, bid); EpiUKV E{(unsigned char*)(ws + WS_KN), (unsigned char*)(ws + WS_VA), (const float*)(ws + WS_SSQKV)};
    g8::gemm_phase(lds, (const char*)(ws + WS_CKV), 256, S, E); }
  __syncthreads();
  if (!mfirst) { for (int u = bid; u < 1024; u += G) { const int c = u & 127, bh = u >> 7; mlstmA_unit(p, bh >> 2, bh & 3, c, lds); } }
  PHASE_SEP();
#if MEGA_STOP == 4
  return;
#endif
  phase_scan(p, bid, G);
  REP(4) phase_attn(p, bid, G, lds);
  PHASE_SEP();
#if MEGA_STOP == 5
  return;
#endif
#if DBL_PHASE == 5
  for (int u = bid; u < 1024; u += G) { const int c = u & 127, bh = u >> 7; mlstmC_unit<true>(p, bh >> 2, bh & 3, c, lds); }
#endif
#if DBL_PHASE == 55
  phase_hanorm<true>(p, bid, G);
#endif
  for (int u = bid; u < 1024; u += G) { const int c = u & 127, bh = u >> 7; mlstmC_unit(p, bh >> 2, bh & 3, c, lds); }
  phase_hanorm(p, bid, G);
  PHASE_SEP();
#if MEGA_STOP == 6
  return;
#endif
  REP(6) { g8::DenseOrder S; S.init(T, 1024, 1024, ws + WS_WOUT, G, bid); EpiOut E{karg<A_X>(), (const float*)(ws + WS_MOD), (bf16_t*)p.out};
    g8::gemm_phase(lds, (const char*)(ws + WS_H), 1024, S, E); }
  PHASE_SEP();
#if MEGA_STOP == 7
  return;
#endif
#if DBL_PHASE == 7
  phase_route<true>(p, bid, G, lds);
#endif
  phase_route(p, bid, G, lds);
  PHASE_SEP();
#if MEGA_STOP == 8
  return;
#endif
  moe_table(p, lds);
  REP(8) { MoeOrderGU S; S.tstart = (const LAS int*)(lds + MOE_TS); S.cnt = (const int*)(ws + WS_CNT); S.G = G; S.c = bid; S.ltok = (const int*)(ws + WS_LTOK); S.Bt = (const char*)(ws + WS_WGU);
    EpiGU E{(unsigned char*)(ws + WS_HDN)};
    g8::gemm_phase(lds, (const char*)(ws + WS_U), 512  , S, E); }
  PHASE_SEP();
#if MEGA_STOP == 9
  return;
#endif
  REP(9) { MoeOrderDN S; S.tstart = (const LAS int*)(lds + MOE_TS); S.cnt = (const int*)(ws + WS_CNT); S.G = G; S.c = bid; S.Bt = (const char*)(ws + WS_WDN);
    EpiDN E{(bf16_t*)(ws + WS_YBUF), (const float*)(ws + WS_LW)};
    g8::gemm_phase(lds, (const char*)(ws + WS_HDN), 256  , S, E); }
  PHASE_SEP();
#if MEGA_STOP == 10
  return;
#endif
#if DBL_PHASE == 10
  phase_final<true>(p, bid, G, lds);
#endif
  phase_final(p, bid, G, lds);
#undef REP
#undef PHASE_SEP
}

#ifdef PROBE_OFF
__global__ void __launch_bounds__(NTHREADS, 2) k_probe(Params p, size_t off, size_t n, int is_f32, int from_out) {
  const unsigned char* base = from_out ? (const unsigned char*)p.out : p.ws + off;
  for (size_t i = (size_t)blockIdx.x * NTHREADS + threadIdx.x; i < (size_t)T * D; i += (size_t)gridDim.x * NTHREADS) {
    const size_t j = i % n; float v = is_f32 ? ((const float*)base)[j] : bf2f(((const unsigned short*)base)[j]);
    if (!(fabsf(v) < 1e30f)) v = 777.f;
    if (from_out) { if (j != i) break; ((float*)p.out)[i] = v; } else p.out[i] = v;
  }
}
#endif
extern "C" void kernel_launch(void* const* d_in, const int* in_sizes, int n_in, void* d_out, int out_size, void* d_ws, size_t ws_size, hipStream_t stream) {
  static int ok = 0, grid = 256;
  typedef void (*kfn)(Params);
#ifndef MULTI_LAUNCH
  const kfn kernels[] = {k_mega};
#else
  const kfn kernels[] = {k_prep, k_lnmod, k_inproj, k_mid1, k_mid2, k_mid3, k_scan_attn, k_mlstm_out, k_outproj, k_route, k_moe_gu, k_moe_dn, k_final};
#endif
  if (ok == 0) {
    if (n_in != 27 || in_sizes[0] != T * D || out_size != T * D || ws_size < WS_END) { fprintf(stderr, "kernel_launch: unexpected shapes (n_in %d, in0 %d, out %d, ws %zu)\n", n_in, n_in > 0 ? in_sizes[0] : -1, out_size, ws_size); ok = -1; return; }
    for (kfn k : kernels) if (hipFuncSetAttribute((const void*)k, hipFuncAttributeMaxDynamicSharedMemorySize, LDS_BYTES) != hipSuccess) { fprintf(stderr, "kernel_launch: hipFuncSetAttribute failed\n"); ok = -1; return; }
    int dev = 0, cus = 0, per_cu = 0;
    if (hipGetDevice(&dev) != hipSuccess || hipDeviceGetAttribute(&cus, hipDeviceAttributeMultiprocessorCount, dev) != hipSuccess) { fprintf(stderr, "kernel_launch: device query failed\n"); ok = -1; return; }
    if (hipOccupancyMaxActiveBlocksPerMultiprocessor(&per_cu, (const void*)kernels[0], NTHREADS, LDS_BYTES) != hipSuccess || per_cu < 1) { fprintf(stderr, "kernel_launch: occupancy query says %d blocks/CU\n", per_cu); (void)hipGetLastError(); per_cu = 1; }
    grid = cus < 256 ? cus : 256;
    fprintf(stderr, "kernel_launch: %d CUs, %d blocks/CU by the occupancy query, grid %d\n", cus, per_cu, grid);
    ok = 1;
  }
  if (ok < 0) return;
  Params p{};
  p.x = (const float*)d_in[0]; p.c = (const float*)d_in[1]; p.pos = (const int*)d_in[2]; p.w_ada = (const float*)d_in[3]; p.b_ada = (const float*)d_in[4]; p.w_in = (const float*)d_in[5];
  p.conv_w = (const float*)d_in[6]; p.conv_b = (const float*)d_in[7]; p.gate_b = (const float*)d_in[8]; p.mh_g = (const float*)d_in[9]; p.qn_g = (const float*)d_in[10]; p.kvn_g = (const float*)d_in[11];
  p.w_uq = (const float*)d_in[12]; p.w_ukv = (const float*)d_in[13]; p.an_g = (const float*)d_in[14]; p.w_out = (const float*)d_in[15]; p.ln1_g = (const float*)d_in[16]; p.ln1_b = (const float*)d_in[17];
  p.w_rg = (const float*)d_in[18]; p.b_rg = (const float*)d_in[19]; p.w_re = (const float*)d_in[20]; p.b_re = (const float*)d_in[21]; p.w_gate = (const float*)d_in[22]; p.w_up = (const float*)d_in[23];
  p.w_down = (const float*)d_in[24]; p.ln2_g = (const float*)d_in[25]; p.ln2_b = (const float*)d_in[26];
  p.out = (float*)d_out; p.ws = (unsigned char*)d_ws;
#ifndef NKERN
#define NKERN 6
#endif
  { int ik = 0; for (kfn k : kernels) { if (ik++ >= NKERN) break; hipLaunchKernelGGL(k, dim3(grid), dim3(NTHREADS), LDS_BYTES, stream, p); } }
#ifdef PROBE_OFF
  hipLaunchKernelGGL(k_probe, dim3(1024), dim3(NTHREADS), 0, stream, p, (size_t)(PROBE_OFF), (size_t)(PROBE_N), PROBE_F32, 0);
#endif
  const hipError_t le = hipPeekAtLastError();
  if (le != hipSuccess) fprintf(stderr, "kernel_launch: launch failed: %s\n", hipGetErrorName(le));
}
```

```cpp
#define NKERN 99
#ifndef MEGA_STOP
#define MEGA_STOP 0
#endif
#ifndef DBL_PHASE
#define DBL_PHASE -1
#endif
#include <hip/hip_runtime.h>
#include <cstdio>
#include <cstdint>
#include <cmath>

#define DI __device__ __forceinline__
#define LAS __attribute__((address_space(3)))
typedef unsigned short bf16_t;
typedef short bf16x8 __attribute__((ext_vector_type(8)));
typedef short s16x4 __attribute__((ext_vector_type(4)));
typedef float f32x4 __attribute__((ext_vector_type(4)));
typedef float f32x2 __attribute__((ext_vector_type(2)));
typedef float f32x16 __attribute__((ext_vector_type(16)));
typedef unsigned u32x4 __attribute__((ext_vector_type(4)));
typedef unsigned u32x2 __attribute__((ext_vector_type(2)));

constexpr int BATCH = 2, SEQ = 16384, T = BATCH * SEQ, D = 1024;
constexpr int NCH = SEQ / 128;
constexpr int N_IN = 2768, N_INP = 2816;
constexpr int NEXP = 32;
constexpr float LN_EPS = 1e-5f, RMS_EPS = 1e-6f;
constexpr float ALPHA = 1.189207115002721f;
constexpr float LOG2E = 1.4426950408889634f;
constexpr float QSCALE = 0.07216878364870323f * LOG2E * 16.f;
constexpr int NTHREADS = 512;
constexpr int LDS_BYTES = 148 * 1024;

constexpr size_t MiB = 1u << 20;
constexpr size_t WS_WIN = 0, WS_WUQ = 6 * MiB, WS_WUKV = 7 * MiB, WS_WOUT = 8 * MiB, WS_WGU = 10 * MiB, WS_WDN = 74 * MiB;
constexpr size_t WS_MOD = 106 * MiB, WS_CNT = 106 * MiB + 65536, WS_ROPE = 107 * MiB, WS_GATES = 115 * MiB, WS_GVEC = 117 * MiB;
constexpr size_t WS_SSQQ = 120 * MiB, WS_SSQKV = 122 * MiB, WS_NVEC = 123 * MiB, WS_SCAL = 124 * MiB, WS_TOKE = 125 * MiB, WS_TOKP = 125 * MiB + 512 * 1024;
constexpr size_t WS_U = 128 * MiB, WS_H = 192 * MiB, WS_QKPRE = 256 * MiB, WS_VM = 320 * MiB, WS_CQ = 352 * MiB, WS_CKV = 376 * MiB;
constexpr size_t WS_KROPE = 392 * MiB, WS_QATT = 396 * MiB, WS_KN = 444 * MiB, WS_VA = 476 * MiB, WS_END = 512 * MiB;
constexpr size_t WS_BAR = 106 * MiB + 131072, CTL_ZERO_OFF = WS_CNT, CTL_ZERO_BYTES = 131072;
constexpr int LDS_BARST = LDS_BYTES - 256;
constexpr size_t WS_LTOK = 256 * MiB, WS_LW = 260 * MiB, WS_HDN = 264 * MiB, WS_YBUF = 336 * MiB;
constexpr int MAXTILES = 288;
constexpr int CNT_STRIDE = 64;
constexpr size_t WS_WRT = 126 * MiB;

struct Params {
  const float* x; const float* c; const int* pos; const float* w_ada; const float* b_ada; const float* w_in; const float* conv_w; const float* conv_b;
  const float* gate_b; const float* mh_g; const float* qn_g; const float* kvn_g; const float* w_uq; const float* w_ukv; const float* an_g; const float* w_out;
  const float* ln1_g; const float* ln1_b; const float* w_rg; const float* b_rg; const float* w_re; const float* b_re; const float* w_gate; const float* w_up;
  const float* w_down; const float* ln2_g; const float* ln2_b;
  float* out; unsigned char* ws;
};

enum { A_X = 0, A_C, A_POS, A_WADA, A_BADA, A_WIN, A_CONVW, A_CONVB, A_GATEB, A_MHG, A_QNG, A_KVNG, A_WUQ, A_WUKV, A_ANG, A_WOUT, A_LN1G, A_LN1B, A_WRG, A_BRG, A_WRE, A_BRE,
       A_WGATE, A_WUP, A_WDOWN, A_LN2G, A_LN2B, A_OUT, A_WS };
template <int IDX, class Tp = const float> __device__ __forceinline__ Tp* karg() {
  const unsigned long long k = (unsigned long long)__builtin_amdgcn_kernarg_segment_ptr();
  unsigned long long v;
  asm volatile("s_load_dwordx2 %0, %1, %2\n\ts_waitcnt lgkmcnt(0)" : "=s"(v) : "s"(k), "i"(IDX * 8) : "memory");
  return (Tp*)v;
}
struct Ctx { unsigned char* ws; float* out; };
DI unsigned cvtpk(float lo, float hi) { unsigned r; asm volatile("v_cvt_pk_bf16_f32 %0, %1, %2" : "=v"(r) : "v"(lo), "v"(hi)); return r; }
DI unsigned short f2bf(float f) { unsigned u = __float_as_uint(f); return (unsigned short)((u + 0x7fffu + ((u >> 16) & 1u)) >> 16); }
typedef int v8i __attribute__((ext_vector_type(8)));
typedef int v4i_ __attribute__((ext_vector_type(4)));
DI u32x2 cvt8(f32x4 a, f32x4 b) {
  int w0 = __builtin_amdgcn_cvt_pk_fp8_f32(a[0], a[1], 0, false); w0 = __builtin_amdgcn_cvt_pk_fp8_f32(a[2], a[3], w0, true);
  int w1 = __builtin_amdgcn_cvt_pk_fp8_f32(b[0], b[1], 0, false); w1 = __builtin_amdgcn_cvt_pk_fp8_f32(b[2], b[3], w1, true);
  return (u32x2){(unsigned)w0, (unsigned)w1};
}
DI float bf2f(unsigned short v) { return __uint_as_float(((unsigned)v) << 16); }
DI float bflo(unsigned w) { return __uint_as_float(w << 16); }
DI float bfhi(unsigned w) { return __uint_as_float(w & 0xffff0000u); }
DI int tid_fresh() { int t = threadIdx.x; asm volatile("" : "+v"(t)); return t; }
DI float sigmoidf_(float x) { return 1.f / (1.f + __expf(-x)); }
DI float siluf_(float x) { return x / (1.f + __expf(-x)); }
DI float logsigmoidf_(float x) { return fminf(x, 0.f) - log1pf(__expf(-fabsf(x))); }
DI int crow(int r, int hi) { return (r & 3) + 8 * (r >> 2) + 4 * hi; }
#define SBAR() __builtin_amdgcn_sched_barrier(0)
#define KSWZ(row, colB) ((row) * 256 + ((colB) ^ (((row) & 15) << 4)))
#define KRSWZ(row, colB) ((row) * 128 + ((colB) ^ ((((row) >> 1) & 7) << 4)))
#define MFMA32(a, b, c) __builtin_amdgcn_mfma_f32_32x32x16_bf16((a), (b), (c), 0, 0, 0)

DI int v_st(int k, int c) { const int kk = (k & ~0xC) | ((k & 4) << 1) | ((k & 8) >> 1); return ((kk >> 3) * 4 + (c >> 5)) * 512 + ((kk & 7) * 32 + (c & 31)) * 2; }
DI int v_rd_base(int lane) { return ((lane & 3) << 3) | (((lane >> 2) & 3) << 6) | (((lane >> 4) & 1) << 5) | (((lane >> 5) & 1) << 8); }
constexpr int v_rd_off(int d0, int ks, int half) { return d0 * 512 + ks * 4096 + half * 2048; }
template <int OFF> DI s16x4 tr_read(int vb) {
  s16x4 r; asm volatile("ds_read_b64_tr_b16 %0, %1 offset:%2" : "=&v"(r) : "v"(vb), "i"(OFF) : "memory"); return r;
}
#define PKLH(L, H) (bf16x8){L[0], L[1], L[2], L[3], H[0], H[1], H[2], H[3]}
template <int KS> DI bf16x8 tr_frag_nowait(int vb, s16x4& l, s16x4& h) { l = tr_read<v_rd_off(0, KS, 0)>(vb); h = tr_read<v_rd_off(0, KS, 1)>(vb); return PKLH(l, h); }
template <int D0> DI void pv_one(f32x16& od, int vb, bf16x8 pa0, bf16x8 pa1, bf16x8 pa2, bf16x8 pa3) {
  const s16x4 l0 = tr_read<v_rd_off(D0, 0, 0)>(vb), h0 = tr_read<v_rd_off(D0, 0, 1)>(vb), l1 = tr_read<v_rd_off(D0, 1, 0)>(vb), h1 = tr_read<v_rd_off(D0, 1, 1)>(vb);
  const s16x4 l2 = tr_read<v_rd_off(D0, 2, 0)>(vb), h2 = tr_read<v_rd_off(D0, 2, 1)>(vb), l3 = tr_read<v_rd_off(D0, 3, 0)>(vb), h3 = tr_read<v_rd_off(D0, 3, 1)>(vb);
  asm volatile("s_waitcnt lgkmcnt(0)" ::: "memory"); SBAR();
  od = MFMA32(pa0, PKLH(l0, h0), od); od = MFMA32(pa1, PKLH(l1, h1), od); od = MFMA32(pa2, PKLH(l2, h2), od); od = MFMA32(pa3, PKLH(l3, h3), od);
}
DI void pv_d0(f32x16* o, int vb, bf16x8 pa0, bf16x8 pa1, bf16x8 pa2, bf16x8 pa3) {
  pv_one<0>(o[0], vb, pa0, pa1, pa2, pa3); pv_one<1>(o[1], vb, pa0, pa1, pa2, pa3); pv_one<2>(o[2], vb, pa0, pa1, pa2, pa3); pv_one<3>(o[3], vb, pa0, pa1, pa2, pa3);
}
DI void pack_p(const f32x16& p0, const f32x16& p1, bf16x8& pa0, bf16x8& pa1, bf16x8& pa2, bf16x8& pa3) {
#define PK4(P, BASE, OUT) do { unsigned a0 = cvtpk(P[BASE + 0], P[BASE + 1]), a1 = cvtpk(P[BASE + 2], P[BASE + 3]);   \
    unsigned b0 = cvtpk(P[BASE + 4], P[BASE + 5]), b1 = cvtpk(P[BASE + 6], P[BASE + 7]);                              \
    auto r0 = __builtin_amdgcn_permlane32_swap(a0, b0, false, false); auto r1 = __builtin_amdgcn_permlane32_swap(a1, b1, false, false); \
    u32x4 w = {r0[0], r1[0], r0[1], r1[1]}; OUT = *reinterpret_cast<bf16x8*>(&w); } while (0)
  PK4(p0, 0, pa0); PK4(p0, 8, pa1); PK4(p1, 0, pa2); PK4(p1, 8, pa3);
#undef PK4
}
DI float half_swap_sum(float v) { auto rr = __builtin_amdgcn_permlane32_swap(__float_as_uint(v), __float_as_uint(v), false, false); return __uint_as_float(rr[0]) + __uint_as_float(rr[1]); }
template <int CTRL> DI float dpp_mov(float v) { return __int_as_float(__builtin_amdgcn_update_dpp(0, __float_as_int(v), CTRL, 0xF, 0xF, true)); }
DI float row_sum16(float v) { v += dpp_mov<0xB1>(v); v += dpp_mov<0x4E>(v); v += dpp_mov<0x141>(v); v += dpp_mov<0x140>(v); return v; }
DI float xsum16(float v) { auto rr = __builtin_amdgcn_permlane16_swap(__float_as_uint(v), __float_as_uint(v), false, false); return __uint_as_float(rr[0]) + __uint_as_float(rr[1]); }
DI float half_sum32(float v) { return xsum16(row_sum16(v)); }
DI float wave_sum(float v) { return half_swap_sum(half_sum32(v)); }
DI float half_swap_max(float v) { auto rr = __builtin_amdgcn_permlane32_swap(__float_as_uint(v), __float_as_uint(v), false, false); return fmaxf(__uint_as_float(rr[0]), __uint_as_float(rr[1])); }

namespace g8 {
constexpr int BM = 256, BK = 64, HALF = 128, HTB = HALF * BK * 2, STAGE_BYTES = 8 * HTB;
DI int lds_byte(int r, int c) { const int st = (r >> 4) * 2 + (c >> 5), rr = r & 15, cc = c & 31, ob = rr * 64 + cc * 2; return st * 1024 + (ob ^ (((ob >> 9) & 1) << 5)); }
DI void stage_rc(int b, int& R, int& C) { const int st = b / 1024, sb = b % 1024, swz = sb ^ (((sb >> 9) & 1) << 5); R = (st >> 1) * 16 + swz / 64; C = (st & 1) * 32 + (swz % 64) / 2; }
DI int perm32(int rho) { const int n = rho >> 4, i = rho & 15; return 8 * (i >> 2) + 4 * n + (i & 3); }
struct Unit { int pm, pn, e, j; };

struct NoPre {};
template <class E, class = void> struct PreOf { typedef NoPre type; static constexpr bool has = false; };
template <class E> struct PreOf<E, std::void_t<typename E::Pre>> { typedef typename E::Pre type; static constexpr bool has = true; };
template <class Epi, class Sched>
DI void gemm_phase(LAS unsigned char* lds, const char* Abase, const int Kc, const Sched& S, const Epi& E) {
  constexpr bool GATHER = Sched::GATHER, FP8 = Epi::FP8; constexpr int NBJ = Epi::NBJ;
  int K = Kc; asm volatile("" : "+s"(K));
  const int tid = tid_fresh(), wid = __builtin_amdgcn_readfirstlane(tid >> 6), lane = tid & 63, wr = wid >> 2, wc = wid & 3, fr = lane & 15, fq = lane >> 4;
  const int nt = K / BK;
  unsigned voffA[2], voffB[2];
#pragma unroll
  for (int i = 0; i < 2; ++i) { int R, C; stage_rc(tid * 16 + i * 8192, R, C); const int Rb = Epi::PERM ? ((R & ~31) + perm32(R & 31)) : R; voffA[i] = (unsigned)(R * K + C) * 2u; voffB[i] = (unsigned)(Rb * K + C) * 2u; }
  const size_t kstep = (size_t)(BK * 2);
  const size_t hstepB = (size_t)HALF * K * 2;
  const unsigned ldsw = (unsigned)wid * 1024u;
  const int aoff = lds_byte(wr * 64 + fr, fq * 8), boff = lds_byte(wc * 32 + fr, fq * 8);
#define G8_SA(b, h) (((b) * 2 + (h)) * HTB)
#define G8_SB(b, h) ((4 + (b) * 2 + (h)) * HTB)
#define G8_STAGEB(bufoff, gptr) do { _Pragma("unroll") for (int _i = 0; _i < 2; ++_i) \
    __builtin_amdgcn_global_load_lds((const unsigned*)((const char*)(gptr) + voffB[_i]), (LAS unsigned*)(lds + (bufoff) + ldsw + _i * 8192), 16, 0, 0); } while (0)
#define G8_STAGEA(bufoff, kb, NXT, h) do { _Pragma("unroll") for (int _i = 0; _i < 2; ++_i) { const char* _src; \
    if constexpr (GATHER) _src = Abase + (size_t)(kb) + (size_t)((NXT) ? o2[h][_i] : cuA[h][_i]); else _src = ((NXT) ? a2b : cA) + (size_t)(kb) + (size_t)(h) * hstepB + voffA[_i]; \
    __builtin_amdgcn_global_load_lds((const unsigned*)_src, (LAS unsigned*)(lds + (bufoff) + ldsw + _i * 8192), 16, 0, 0); } } while (0)
#define G8_LD8(ptr) __builtin_shufflevector(*(const LAS v4i_*)(ptr), *(const LAS v4i_*)((ptr) + 1024), 0, 1, 2, 3, 4, 5, 6, 7)
#define G8_LDA(dst, b, h) do { if constexpr (FP8) { _Pragma("unroll") for (int m = 0; m < 4; ++m) dst##8[m] = G8_LD8(lds + G8_SA(b, h) + aoff + m * 2048); } \
    else { _Pragma("unroll") for (int m = 0; m < 4; ++m) _Pragma("unroll") for (int k = 0; k < 2; ++k) dst[m][k] = *(const LAS bf16x8*)(lds + G8_SA(b, h) + aoff + m * 2048 + k * 1024); } } while (0)
#define G8_LDB(dst, b, h) do { if constexpr (FP8) { _Pragma("unroll") for (int n = 0; n < 2; ++n) dst##8[n] = G8_LD8(lds + G8_SB(b, h) + boff + n * 2048); } \
    else { _Pragma("unroll") for (int n = 0; n < 2; ++n) _Pragma("unroll") for (int k = 0; k < 2; ++k) dst[n][k] = *(const LAS bf16x8*)(lds + G8_SB(b, h) + boff + n * 2048 + k * 1024); } } while (0)
#define G8_MMA(ai, bj, At, Bt) do { __builtin_amdgcn_s_setprio(1); \
    if constexpr (FP8) { _Pragma("unroll") for (int m = 0; m < 4; ++m) _Pragma("unroll") for (int n = 0; n < 2; ++n) \
        acc[ai][bj][m][n] = __builtin_amdgcn_mfma_scale_f32_16x16x128_f8f6f4(Bt##8[n], At##8[m], acc[ai][bj][m][n], 0, 0, 0, 122, 0, Epi::ASCALE); } \
    else { _Pragma("unroll") for (int m = 0; m < 4; ++m) _Pragma("unroll") for (int n = 0; n < 2; ++n) _Pragma("unroll") for (int k = 0; k < 2; ++k) \
        acc[ai][bj][m][n] = __builtin_amdgcn_mfma_f32_16x16x32_bf16(Bt[n][k], At[m][k], acc[ai][bj][m][n], 0, 0, 0); } \
    __builtin_amdgcn_s_setprio(0); } while (0)
#define G8_WAIT_V(n) asm volatile("s_waitcnt vmcnt(" #n ")" ::: "memory")
#define G8_WAIT_M do { if constexpr (NBJ == 2) G8_WAIT_V(8); else G8_WAIT_V(6); } while (0)
#define G8_WAIT_L(n) asm volatile("s_waitcnt lgkmcnt(" #n ")" ::: "memory")
#define G8_BAR __builtin_amdgcn_s_barrier()
#define G8_SCHED __builtin_amdgcn_sched_barrier(0)
#define G8_GOFF(dst, u) do { _Pragma("unroll") for (int _i = 0; _i < 2; ++_i) { int _R, _C; stage_rc(tid * 16 + _i * 8192, _R, _C); \
    _Pragma("unroll") for (int _h = 0; _h < 2; ++_h) dst[_h][_i] = S.a_off(u, _R + 128 * _h) + (unsigned)_C * 2u; } } while (0)
  Unit cur, nxt; int ui = 0;
  if (!S.next(0, cur)) return;
  typename PreOf<Epi>::type pre; (void)pre;
  if constexpr (PreOf<Epi>::has) E.pre(cur, wr, fr, pre);
  f32x4 acc[2][NBJ][4][2];
#pragma unroll
  for (int a = 0; a < 2; ++a)
#pragma unroll
    for (int b = 0; b < NBJ; ++b)
#pragma unroll
      for (int m = 0; m < 4; ++m)
#pragma unroll
        for (int n = 0; n < 2; ++n) acc[a][b][m][n] = (f32x4){0.f, 0.f, 0.f, 0.f};
  bf16x8 At[4][2], B0[2][2], B1[2][2]; v8i At8[4], B08[2], B18[2]; (void)At; (void)B0; (void)B1; (void)At8; (void)B08; (void)B18;
  unsigned cuA[2][2], nxA[2][2], o2[2][2];
  const char* cA = Abase; const char* nA = Abase; const char* a2b = Abase;
  if constexpr (GATHER) { G8_GOFF(cuA, cur); } else { cA = Abase + S.a_off(cur, 0); }
  const char* cB = S.b_base(cur);
  (void)voffA; (void)nxA; (void)o2; (void)nA; (void)a2b;
  G8_STAGEB(G8_SB(0, 0), cB); if constexpr (NBJ == 2) G8_STAGEB(G8_SB(0, 1), cB + hstepB); G8_STAGEA(G8_SA(0, 0), 0, false, 0); G8_STAGEA(G8_SA(0, 1), 0, false, 1);
  if (wr == 1) G8_BAR;
  G8_WAIT_V(2); G8_BAR;
  G8_STAGEB(G8_SB(1, 0), cB + kstep); G8_STAGEA(G8_SA(1, 0), kstep, false, 0); if constexpr (NBJ == 2) G8_STAGEB(G8_SB(1, 1), cB + hstepB + kstep);
  if constexpr (NBJ == 2) G8_WAIT_V(6); else G8_WAIT_V(4);
  G8_BAR;
  for (;;) {
    const bool has_next = S.next(ui + 1, nxt);
    const char* nB = cB;
    if (has_next) {
      nB = S.b_base(nxt);
      if constexpr (GATHER) { G8_GOFF(nxA, nxt); } else { nA = Abase + S.a_off(nxt, 0); }
    } else {
      if constexpr (GATHER) {
#pragma unroll
        for (int h = 0; h < 2; ++h)
#pragma unroll
          for (int i = 0; i < 2; ++i) nxA[h][i] = cuA[h][i];
      } else nA = cA;
    }
    for (int t = 0; t < nt; t += 2) {
      const bool last = (t == nt - 2);
      const size_t k1 = (size_t)(t + 1) * kstep;
      const size_t k2 = last ? 0 : (size_t)(t + 2) * kstep, k3 = k2 + kstep;
      if constexpr (GATHER) {
#pragma unroll
        for (int h = 0; h < 2; ++h)
#pragma unroll
          for (int i = 0; i < 2; ++i) o2[h][i] = last ? nxA[h][i] : cuA[h][i];
      } else a2b = last ? nA : cA;
      const char* b2 = last ? nB : cB + (size_t)(t + 2) * kstep; const char* b3 = b2 + kstep;
      G8_LDB(B0, 0, 0); if constexpr (NBJ == 2) G8_LDB(B1, 0, 1); G8_SCHED; G8_LDA(At, 0, 0); G8_STAGEA(G8_SA(1, 1), k1, false, 1);
      G8_WAIT_M; G8_WAIT_L(0); G8_BAR; G8_MMA(0, 0, At, B0); if constexpr (NBJ == 2) G8_MMA(0, 1, At, B1); G8_BAR; G8_SCHED;
      G8_LDA(At, 0, 1); G8_STAGEB(G8_SB(0, 0), b2); if constexpr (NBJ == 2) G8_STAGEB(G8_SB(0, 1), b2 + hstepB); G8_STAGEA(G8_SA(0, 0), k2, true, 0);
      G8_WAIT_M; G8_WAIT_L(0); G8_BAR; G8_MMA(1, 0, At, B0); if constexpr (NBJ == 2) G8_MMA(1, 1, At, B1); G8_BAR; G8_SCHED;
      G8_LDB(B0, 1, 0); if constexpr (NBJ == 2) G8_LDB(B1, 1, 1); G8_SCHED; G8_LDA(At, 1, 0); G8_STAGEA(G8_SA(0, 1), k2, true, 1);
      G8_WAIT_M; G8_WAIT_L(0); G8_BAR; G8_MMA(0, 0, At, B0); if constexpr (NBJ == 2) G8_MMA(0, 1, At, B1); G8_BAR; G8_SCHED;
      G8_LDA(At, 1, 1); G8_STAGEB(G8_SB(1, 0), b3); if constexpr (NBJ == 2) G8_STAGEB(G8_SB(1, 1), b3 + hstepB); G8_STAGEA(G8_SA(1, 0), k3, true, 0);
      G8_WAIT_M; G8_WAIT_L(0); G8_BAR; G8_MMA(1, 0, At, B0); if constexpr (NBJ == 2) G8_MMA(1, 1, At, B1); G8_BAR; G8_SCHED;
    }
    if (wr == 0) G8_BAR;
    G8_SCHED; asm volatile("s_nop 15\n\ts_nop 7" ::: "memory"); G8_SCHED;
    if constexpr (PreOf<Epi>::has) E(acc, cur, wr, wc, fr, fq, pre); else E(acc, cur, wr, wc, fr, fq);
    if (!has_next) break;
#pragma unroll
    for (int a = 0; a < 2; ++a)
#pragma unroll
      for (int b = 0; b < NBJ; ++b)
#pragma unroll
        for (int m = 0; m < 4; ++m)
#pragma unroll
          for (int n = 0; n < 2; ++n) acc[a][b][m][n] = (f32x4){0.f, 0.f, 0.f, 0.f};
    cur = nxt; cB = nB; ++ui;
    if constexpr (PreOf<Epi>::has) E.pre(cur, wr, fr, pre);
    if constexpr (GATHER) {
#pragma unroll
      for (int h = 0; h < 2; ++h)
#pragma unroll
        for (int i = 0; i < 2; ++i) cuA[h][i] = nxA[h][i];
    } else cA = nA;
    if (wr == 1) G8_BAR;
  }
  G8_WAIT_V(0);
  G8_BAR;
#undef G8_SA
#undef G8_SB
#undef G8_STAGEA
#undef G8_STAGEB
#undef G8_LDA
#undef G8_LD8
#undef G8_WAIT_M
#undef G8_LDB
#undef G8_MMA
#undef G8_WAIT_V
#undef G8_WAIT_L
#undef G8_BAR
#undef G8_SCHED
#undef G8_GOFF
}

struct DenseOrder {
  static constexpr bool GATHER = false;
  int nM, nN, nwg, G, c, K; const char* Bt;
  DI void init(int M, int N, int K_, const void* Bt_, int G_, int c_) { nM = M / BM; nN = N / BM; nwg = nM * nN; G = G_; c = c_; K = K_; Bt = (const char*)Bt_; }
  DI bool next(int i, Unit& u) const {
    const long L = (long)i * G + c; if (L >= nwg) return false;
    int wgid = (int)L; { const int q = nwg / 8, r = nwg % 8, xcd = wgid % 8, off = wgid / 8; wgid = (xcd < r ? xcd * (q + 1) : r * (q + 1) + (xcd - r) * q) + off; }
    const int nig = 8 * nN, gid = wgid / nig, fm = gid * 8, gsz = (nM - fm) < 8 ? (nM - fm) : 8;
    u.pm = fm + ((wgid % nig) % gsz); u.pn = (wgid % nig) / gsz; u.e = 0; u.j = 0; return true;
  }
  DI unsigned a_off(const Unit& u, int R) const { return (unsigned)(u.pm * BM + R) * (unsigned)(K * 2); }
  DI const char* b_base(const Unit& u) const { return Bt + (size_t)u.pn * BM * K * 2; }
};
}
using g8::Unit;

struct EpiIn {
  static constexpr bool PERM = true, FP8 = false; static constexpr int NBJ = 2;
  bf16_t* qkpre; bf16_t* vm; bf16_t* hcat; bf16_t* cq; bf16_t* ckv; unsigned char* krope  ; float* gates; float* ssq_q; float* ssq_kv; const float* rope; const float* gate_b;
  DI void operator()(const f32x4 (&acc)[2][2][4][2], const Unit& u, int wr, int wc, int fr, int fq) const {
#pragma unroll
    for (int bj = 0; bj < 2; ++bj) {
      const int cw = u.pn * 256 + bj * 128 + wc * 32, c0 = cw + 8 * fq;
#pragma unroll
      for (int ai = 0; ai < 2; ++ai)
#pragma unroll
        for (int m = 0; m < 4; ++m) {
          const int row = u.pm * 256 + ai * 128 + wr * 64 + m * 16 + fr;
          const f32x4 v0 = acc[ai][bj][m][0], v1 = acc[ai][bj][m][1];
          if (cw < 1024) { u32x4 w = {cvtpk(v0[0], v0[1]), cvtpk(v0[2], v0[3]), cvtpk(v1[0], v1[1]), cvtpk(v1[2], v1[3])}; *(u32x4*)(qkpre + (size_t)row * 1024 + c0) = w; }
          else if (cw < 1536) { u32x4 w = {cvtpk(v0[0], v0[1]), cvtpk(v0[2], v0[3]), cvtpk(v1[0], v1[1]), cvtpk(v1[2], v1[3])}; *(u32x4*)(vm + (size_t)row * 512 + (c0 - 1024)) = w; }
          else if (cw < 2048) { u32x4 w = {cvtpk(sigmoidf_(v0[0]), sigmoidf_(v0[1])), cvtpk(sigmoidf_(v0[2]), sigmoidf_(v0[3])), cvtpk(sigmoidf_(v1[0]), sigmoidf_(v1[1])), cvtpk(sigmoidf_(v1[2]), sigmoidf_(v1[3]))};
                                *(u32x4*)(hcat + (size_t)row * 1024 + (c0 - 1536)) = w; }
          else if (cw < 2688) {
            u32x4 w = {cvtpk(v0[0], v0[1]), cvtpk(v0[2], v0[3]), cvtpk(v1[0], v1[1]), cvtpk(v1[2], v1[3])};
            float s = v0[0] * v0[0] + v0[1] * v0[1] + v0[2] * v0[2] + v0[3] * v0[3] + v1[0] * v1[0] + v1[1] * v1[1] + v1[2] * v1[2] + v1[3] * v1[3];
            s = half_swap_sum(xsum16(s));
            if (cw < 2432) { *(u32x4*)(cq + (size_t)row * 384 + (c0 - 2048)) = w; if (fq == 0) ssq_q[(size_t)row * 12 + ((cw - 2048) >> 5)] = s; }
            else { *(u32x4*)(ckv + (size_t)row * 256 + (c0 - 2432)) = w; if (fq == 0) ssq_kv[(size_t)row * 8 + ((cw - 2432) >> 5)] = s; }
          }
          else if (cw < 2752) {
            const int i0 = (c0 - 2688) >> 1;
            const f32x4 cs0 = *(const f32x4*)(rope + (size_t)row * 64 + 2 * i0), cs1 = *(const f32x4*)(rope + (size_t)row * 64 + 2 * i0 + 4);
            const float a0 = v0[0] * cs0[0] - v0[1] * cs0[1], b0 = v0[1] * cs0[0] + v0[0] * cs0[1];
            const float a1 = v0[2] * cs0[2] - v0[3] * cs0[3], b1 = v0[3] * cs0[2] + v0[2] * cs0[3];
            const float a2 = v1[0] * cs1[0] - v1[1] * cs1[1], b2 = v1[1] * cs1[0] + v1[0] * cs1[1];
            const float a3 = v1[2] * cs1[2] - v1[3] * cs1[3], b3 = v1[3] * cs1[2] + v1[2] * cs1[3];
            const u32x2 w = cvt8((f32x4){a0, b0, a1, b1}, (f32x4){a2, b2, a3, b3});
            const int b_ = row >> 14, s_ = row & (SEQ - 1);
#pragma unroll
            for (int hh = 0; hh < 4; ++hh) *(u32x2*)(krope + ((size_t)(b_ * 4 + hh) * SEQ + s_) * 192 + 128 + (c0 - 2688)) = w;
          }
          else if (cw == 2752) {
            if (fq < 2) { const f32x4 g0 = *(const f32x4*)(gate_b + 8 * fq), g1 = *(const f32x4*)(gate_b + 8 * fq + 4);
              *(f32x4*)(gates + (size_t)row * 16 + 8 * fq) = v0 + g0; *(f32x4*)(gates + (size_t)row * 16 + 8 * fq + 4) = v1 + g1; }
          }
        }
    }
  }
};
struct EpiUQ {
  static constexpr bool PERM = true, FP8 = false; static constexpr int NBJ = 2;
  unsigned char* qatt; const float* ssq_q; const float* rope;
  DI void operator()(const f32x4 (&acc)[2][2][4][2], const Unit& u, int wr, int wc, int fr, int fq) const {
    float rs[2][4];
#pragma unroll
    for (int ai = 0; ai < 2; ++ai)
#pragma unroll
      for (int m = 0; m < 4; ++m) {
        const int row = u.pm * 256 + ai * 128 + wr * 64 + m * 16 + fr;
        const f32x4 q0 = *(const f32x4*)(ssq_q + (size_t)row * 12), q1 = *(const f32x4*)(ssq_q + (size_t)row * 12 + 4), q2 = *(const f32x4*)(ssq_q + (size_t)row * 12 + 8);
        const float ss = (q0[0] + q0[1] + q0[2] + q0[3]) + (q1[0] + q1[1] + q1[2] + q1[3]) + (q2[0] + q2[1] + q2[2] + q2[3]);
        rs[ai][m] = rsqrtf(ss * (1.f / 384.f) + RMS_EPS) * QSCALE;
        asm volatile("" ::: "memory");
      }
#pragma unroll
    for (int bj = 0; bj < 2; ++bj) {
      const int cw = u.pn * 256 + bj * 128 + wc * 32, h = cw / 192, dw = cw - h * 192, d = dw + 8 * fq;
#pragma unroll
      for (int ai = 0; ai < 2; ++ai)
#pragma unroll
        for (int m = 0; m < 4; ++m) {
          const int row = u.pm * 256 + ai * 128 + wr * 64 + m * 16 + fr, b = row >> 14, s = row & (SEQ - 1);
          const f32x4 v0 = acc[ai][bj][m][0] * rs[ai][m], v1 = acc[ai][bj][m][1] * rs[ai][m];
          u32x2 w;
          if (dw < 128) { w = cvt8(v0, v1); }
          else {
            const int i0 = (d - 128) >> 1;
            const f32x4 cs0 = *(const f32x4*)(rope + (size_t)row * 64 + 2 * i0), cs1 = *(const f32x4*)(rope + (size_t)row * 64 + 2 * i0 + 4);
            const float a0 = v0[0] * cs0[0] - v0[1] * cs0[1], b0 = v0[1] * cs0[0] + v0[0] * cs0[1];
            const float a1 = v0[2] * cs0[2] - v0[3] * cs0[3], b1 = v0[3] * cs0[2] + v0[2] * cs0[3];
            const float a2 = v1[0] * cs1[0] - v1[1] * cs1[1], b2 = v1[1] * cs1[0] + v1[0] * cs1[1];
            const float a3 = v1[2] * cs1[2] - v1[3] * cs1[3], b3 = v1[3] * cs1[2] + v1[2] * cs1[3];
            w = cvt8((f32x4){a0, b0, a1, b1}, (f32x4){a2, b2, a3, b3});
          }
          *(u32x2*)(qatt + ((size_t)(b * 4 + h) * SEQ + s) * 192 + d) = w;
          asm volatile("" ::: "memory");
        }
    }
  }
};
struct EpiUKV {
  static constexpr bool PERM = true, FP8 = false; static constexpr int NBJ = 2;
  unsigned char* kn; unsigned char* vt8; const float* ssq_kv;
  DI void operator()(const f32x4 (&acc)[2][2][4][2], const Unit& u, int wr, int wc, int fr, int fq) const {
#pragma unroll
    for (int ai = 0; ai < 2; ++ai)
#pragma unroll
      for (int m = 0; m < 4; ++m) {
        const int row = u.pm * 256 + ai * 128 + wr * 64 + m * 16 + fr, b = row >> 14, s = row & (SEQ - 1);
        const f32x4 q0 = *(const f32x4*)(ssq_kv + (size_t)row * 8), q1 = *(const f32x4*)(ssq_kv + (size_t)row * 8 + 4);
        const float ss = (q0[0] + q0[1] + q0[2] + q0[3]) + (q1[0] + q1[1] + q1[2] + q1[3]);
        const float rs = rsqrtf(ss * (1.f / 256.f) + RMS_EPS);
        { const f32x4 v0 = acc[ai][0][m][0] * rs, v1 = acc[ai][0][m][1] * rs;
          *(u32x2*)(kn + ((size_t)(b * 4 + u.pn) * SEQ + s) * 192 + wc * 32 + 8 * fq) = cvt8(v0, v1); }
        { const f32x4 v0 = acc[ai][1][m][0] * rs, v1 = acc[ai][1][m][1] * rs;
          const u32x2 w = cvt8(v0, v1);
          const int k = s & 63, kq = k & 31, pos = 32 * ((kq >> 2) & 1) + (kq & 3) + 4 * (kq >> 3) + 16 * (k >> 5);
          unsigned char* dst = vt8 + ((size_t)((b * 4 + u.pn) * 256 + (s >> 6)) * 128 + wc * 32 + 8 * fq) * 64 + pos;
          dst[0] = (unsigned char)w[0]; dst[64] = (unsigned char)(w[0] >> 8); dst[128] = (unsigned char)(w[0] >> 16); dst[192] = (unsigned char)(w[0] >> 24);
          dst[256] = (unsigned char)w[1]; dst[320] = (unsigned char)(w[1] >> 8); dst[384] = (unsigned char)(w[1] >> 16); dst[448] = (unsigned char)(w[1] >> 24); }
        asm volatile("" ::: "memory");
      }
  }
};
struct EpiOut {
  static constexpr bool PERM = true, FP8 = false; static constexpr int NBJ = 2;
  const float* x; const float* mod; bf16_t* z;
  DI void operator()(const f32x4 (&acc)[2][2][4][2], const Unit& u, int wr, int wc, int fr, int fq) const {
#pragma unroll
    for (int ai = 0; ai < 2; ++ai)
#pragma unroll
      for (int m = 0; m < 4; ++m) {
        const int row = u.pm * 256 + ai * 128 + wr * 64 + m * 16 + fr, b = row >> 14;
#pragma unroll
        for (int bj = 0; bj < 2; ++bj) {
          const int c = u.pn * 256 + bj * 128 + wc * 32 + 8 * fq;
          const unsigned off = (unsigned)row * 1024u + (unsigned)c;
          const f32x4 x0 = *(const f32x4*)(x + off), x1 = *(const f32x4*)(x + off + 4), g0 = *(const f32x4*)(mod + b * 6144 + 2048 + c), g1 = *(const f32x4*)(mod + b * 6144 + 2048 + c + 4);
          const f32x4 z0 = x0 * ALPHA + (g0 + 1.f) * acc[ai][bj][m][0], z1 = x1 * ALPHA + (g1 + 1.f) * acc[ai][bj][m][1];
          *(u32x4*)(z + off) = (u32x4){cvtpk(z0[0], z0[1]), cvtpk(z0[2], z0[3]), cvtpk(z1[0], z1[1]), cvtpk(z1[2], z1[3])};
        }
        asm volatile("" ::: "memory");
      }
  }
};
struct EpiGU {
  static constexpr bool PERM = true, FP8 = true; static constexpr int NBJ = 1, ASCALE = 127;
  unsigned char* hdn;
  DI void operator()(const f32x4 (&acc)[2][1][4][2], const Unit& u, int wr, int wc, int fr, int fq) const {
    const unsigned base = ((unsigned)u.pm * 256u + wr * 64 + fr) * 512u + (unsigned)((u.pn * 128 + wc * 32 + 8 * fq) >> 1);
#pragma unroll
    for (int ai = 0; ai < 2; ++ai)
#pragma unroll
      for (int m = 0; m < 4; ++m) {
        const f32x4 g = acc[ai][0][m][0], up = acc[ai][0][m][1] * 8.f;
        int w = __builtin_amdgcn_cvt_pk_fp8_f32(siluf_(g[0]) * up[0], siluf_(g[1]) * up[1], 0, false); w = __builtin_amdgcn_cvt_pk_fp8_f32(siluf_(g[2]) * up[2], siluf_(g[3]) * up[3], w, true);
        *(int*)(hdn + (base + (unsigned)((ai * 128 + m * 16) * 512))) = w;
      }
  }
};
struct EpiDN {
  static constexpr bool PERM = true, FP8 = true; static constexpr int NBJ = 1, ASCALE = 124;
  bf16_t* ybuf; const float* lw;
  struct Pre { float w[2][4]; };
  DI void pre(const Unit& u, int wr, int fr, Pre& P) const {
    const unsigned wbase = ((unsigned)u.e * (unsigned)T + (unsigned)(u.j * 256 + wr * 64 + fr)) * 4u;
#pragma unroll
    for (int ai = 0; ai < 2; ++ai)
#pragma unroll
      for (int m = 0; m < 4; ++m) P.w[ai][m] = *(const float*)((const char*)lw + (wbase + (unsigned)((ai * 128 + m * 16) * 4)));
  }
  DI void operator()(const f32x4 (&acc)[2][1][4][2], const Unit& u, int wr, int wc, int fr, int fq, const Pre& P) const {
    const unsigned base = ((unsigned)u.pm * 256u + wr * 64 + fr) * 2048u + (unsigned)(u.pn * 128 + wc * 32 + 8 * fq) * 2u;
#pragma unroll
    for (int ai = 0; ai < 2; ++ai)
#pragma unroll
      for (int m = 0; m < 4; ++m) {
        const float wgt = P.w[ai][m];
        const f32x4 v0 = acc[ai][0][m][0] * wgt, v1 = acc[ai][0][m][1] * wgt;
        const u32x4 w = {cvtpk(v0[0], v0[1]), cvtpk(v0[2], v0[3]), cvtpk(v1[0], v1[1]), cvtpk(v1[2], v1[3])};
        *(u32x4*)((char*)ybuf + (base + (unsigned)((ai * 128 + m * 16) * 2048))) = w;
        asm volatile("" ::: "memory");
      }
  }
};
struct MoeOrderBase {
  const LAS int* tstart; const int* cnt; int G, c;
  DI bool next(int i, Unit& u) const {
    const int L = i * G + c, NT = tstart[32]; if (L >= NT * 8) return false;
    const int tile = L >> 3; int e = 0;
    for (int k = 1; k < 32; ++k) e = (tstart[k] <= tile) ? k : e;
    u.pm = tile; u.pn = L & 7; u.e = e; u.j = tile - tstart[e]; return true;
  }
};
struct MoeOrderGU : MoeOrderBase {
  static constexpr bool GATHER = true;
  const int* ltok; const char* Bt;
  DI unsigned a_off(const Unit& u, int R) const { const int n = cnt[u.e * CNT_STRIDE]; int idx = u.j * 256 + R; idx = idx < n ? idx : n - 1; return (unsigned)ltok[(size_t)u.e * T + idx] * 1024u; }
  DI const char* b_base(const Unit& u) const { return Bt + ((size_t)u.e * 1024 + u.pn * 128) * 1024; }
};
struct MoeOrderDN : MoeOrderBase {
  static constexpr bool GATHER = false;
  const char* Bt;
  DI unsigned a_off(const Unit& u, int R) const { return (unsigned)(u.pm * 256 + R) * 512u; }
  DI const char* b_base(const Unit& u) const { return Bt + ((size_t)u.e * 1024 + u.pn * 128) * 512; }
};

struct TDesc { const float* src; const float* kscale; bf16_t* dst; int ld, K, k0, n0, ok, fp8; };
DI TDesc tdesc(int r, int lane, unsigned char* ws) {
  constexpr int I_IN = 16 * 88, I_UQ = 6 * 24, I_UKV = 4 * 32, I_OUT = 16 * 32, I_GU = 32 * 16 * 32;
  TDesc d; d.kscale = nullptr; d.fp8 = 0; int sc, kb, nb; const float* W;
  if (r < I_IN) { kb = r / 88; nb = r % 88; const int n = nb * 32 + (lane & 31);
    sc = n < 2048 ? n : n < 2432 ? 2064 + (n - 2048) : n < 2688 ? 2448 + (n - 2432) : n < 2752 ? 2704 + ((n - 2688) & 1) * 32 + ((n - 2688) >> 1) : n < 2768 ? 2048 + (n - 2752) : -1;
    W = karg<A_WIN>(); d.ld = N_IN; d.K = 1024; d.dst = (bf16_t*)(ws + WS_WIN); }
  else if ((r -= I_IN) < I_UQ) { kb = r / 24; nb = r % 24; const int n = nb * 32 + (lane & 31), h = n / 192, dd = n - h * 192;
    sc = dd < 128 ? n : h * 192 + 128 + ((dd - 128) & 1) * 32 + ((dd - 128) >> 1);
    W = karg<A_WUQ>(); d.ld = 768; d.K = 384; d.dst = (bf16_t*)(ws + WS_WUQ); d.kscale = karg<A_QNG>(); }
  else if ((r -= I_UQ) < I_UKV) { kb = r / 32; nb = r % 32; sc = nb * 32 + (lane & 31); W = karg<A_WUKV>(); d.ld = 1024; d.K = 256; d.dst = (bf16_t*)(ws + WS_WUKV); d.kscale = karg<A_KVNG>(); }
  else if ((r -= I_UKV) < I_OUT) { kb = r / 32; nb = r % 32; sc = nb * 32 + (lane & 31); W = karg<A_WOUT>(); d.ld = 1024; d.K = 1024; d.dst = (bf16_t*)(ws + WS_WOUT); }
  else if ((r -= I_OUT) < I_GU) { const int e = r / 512, q = r % 512; kb = q / 32; nb = q % 32;
    const int lr = nb * 32 + (lane & 31), up = (lr >> 2) & 1; sc = (lr >> 3) * 4 + (lr & 3);
    W = (up ? karg<A_WUP>() : karg<A_WGATE>()) + (size_t)e * 1024 * 512; d.ld = 512; d.K = 1024; d.fp8 = 1; d.dst = (bf16_t*)(ws + WS_WGU + (size_t)e * 1024 * 1024); }
  else { r -= I_GU; const int e = r / 256, q = r % 256; kb = q / 32; nb = q % 32; sc = nb * 32 + (lane & 31);
    W = karg<A_WDOWN>() + (size_t)e * 512 * 1024; d.ld = 1024; d.K = 512; d.fp8 = 1; d.dst = (bf16_t*)(ws + WS_WDN + (size_t)e * 1024 * 512); }
  d.k0 = 64 * kb; d.n0 = 32 * nb; d.ok = sc >= 0;
  d.src = W + (size_t)(d.k0 + (lane >> 5)) * d.ld + (sc >= 0 ? sc : 0);
  return d;
}
DI void tload(const TDesc& d, float (&v)[32]) {
#pragma unroll
  for (int i = 0; i < 32; ++i) v[i] = d.src[(size_t)(2 * i) * d.ld];
}
DI void tstore(const TDesc& d, float (&v)[32], LAS float* scr, int lane) {
  if (d.kscale) {
#pragma unroll
    for (int i = 0; i < 32; ++i) v[i] *= d.kscale[d.k0 + 2 * i + (lane >> 5)];
  }
#pragma unroll
  for (int i = 0; i < 32; ++i) scr[(2 * i + (lane >> 5)) * 33 + (lane & 31)] = d.ok ? v[i] : 0.f;
  asm volatile("s_waitcnt lgkmcnt(0)" ::: "memory");
  const int c = lane & 7;
#pragma unroll
  for (int j = 0; j < 4; ++j) { const int n = (lane >> 3) + 8 * j; const LAS float* s = scr + (8 * c) * 33 + n;
    if (d.fp8) { *(u32x2*)((unsigned char*)d.dst + (size_t)(d.n0 + n) * d.K + d.k0 + 8 * c) =
        cvt8((f32x4){s[0 * 33], s[1 * 33], s[2 * 33], s[3 * 33]} * 32.f, (f32x4){s[4 * 33], s[5 * 33], s[6 * 33], s[7 * 33]} * 32.f); }
    else { u32x4 o; o.x = cvtpk(s[0 * 33], s[1 * 33]); o.y = cvtpk(s[2 * 33], s[3 * 33]); o.z = cvtpk(s[4 * 33], s[5 * 33]); o.w = cvtpk(s[6 * 33], s[7 * 33]);
      *(u32x4*)(d.dst + (size_t)(d.n0 + n) * d.K + d.k0 + 8 * c) = o; } }
  asm volatile("s_waitcnt lgkmcnt(0)" ::: "memory");
}
constexpr int PREP_ITEMS = 16 * 88 + 6 * 24 + 4 * 32 + 16 * 32 + 32 * 16 * 32 + 32 * 8 * 32;
constexpr int PREP_DEFER = 8192;
DI void prep_items(int it, const int end, const int stride, const int lane, unsigned char* ws, LAS float* scr) {
  TDesc dA, dB; float vA[32], vB[32];
  if (it < end) { dA = tdesc(it, lane, ws); tload(dA, vA); }
  while (it < end) {
    if (it + stride < end) { dB = tdesc(it + stride, lane, ws); tload(dB, vB); }
    tstore(dA, vA, scr, lane);
    it += stride; if (it >= end) break;
    if (it + stride < end) { dA = tdesc(it + stride, lane, ws); tload(dA, vA); }
    tstore(dB, vB, scr, lane);
    it += stride;
  }
}
DI void phase_prep(const Ctx& p, int bid, int G, LAS unsigned char* lds) {
  const int tid = tid_fresh(), lane = tid & 63, wave = __builtin_amdgcn_readfirstlane(tid >> 6);
  unsigned char* ws = p.ws;
  LAS float* scr = (LAS float*)(lds + wave * 16384);
  LAS float* cact = (LAS float*)(lds + 131072);
  for (int i = tid; i < 2048; i += NTHREADS) cact[i] = siluf_(karg<A_C>()[i]);
  __syncthreads();
  const int gw = bid * 8 + wave, NGW = G * 8;
  constexpr int I_MOD = 192;
  if (bid < I_MOD) {
    const int kg = lane >> 3, cc = lane & 7, col = bid * 32 + 4 * cc; const float* w_ada = karg<A_WADA>() + col;
    f32x4 a0 = {0.f, 0.f, 0.f, 0.f}, a1 = {0.f, 0.f, 0.f, 0.f};
#pragma unroll
    for (int j = 0; j < 16; ++j) { const int k = wave * 128 + kg + 8 * j; const f32x4 w = *(const f32x4*)(w_ada + (size_t)k * 6144); a0 += w * cact[k]; a1 += w * cact[1024 + k]; }
#pragma unroll
    for (int e = 0; e < 4; ++e) {
#pragma unroll
      for (int o = 8; o < 64; o <<= 1) { a0[e] += __shfl_xor(a0[e], o); a1[e] += __shfl_xor(a1[e], o); } }
    LAS f32x4* part = (LAS f32x4*)(lds + 131072 + 8192);
    if (kg == 0) { part[(wave * 8 + cc) * 2] = a0; part[(wave * 8 + cc) * 2 + 1] = a1; }
    __syncthreads();
    if (wave == 0 && kg == 0) { float* mod = (float*)(ws + WS_MOD); const f32x4 bb = *(const f32x4*)(karg<A_BADA>() + col);
      f32x4 s0 = part[cc * 2], s1 = part[cc * 2 + 1];
#pragma unroll
      for (int w = 1; w < 8; ++w) { s0 += part[(w * 8 + cc) * 2]; s1 += part[(w * 8 + cc) * 2 + 1]; }
      *(f32x4*)(mod + col) = s0 + bb; *(f32x4*)(mod + 6144 + col) = s1 + bb; }
  }
#ifndef DBL_PREP
#define DBL_PREP 0
#endif
  for (int rp_ = 0; rp_ < (DBL_PREP == 1 ? 2 : 1); ++rp_) prep_items(gw, PREP_ITEMS - PREP_DEFER, NGW, lane, ws, scr);
  {
    const float INV[32] = {1.000000000e+00f, 7.498942018e-01f, 5.623413324e-01f, 4.216965139e-01f, 3.162277639e-01f, 2.371373773e-01f, 1.778279394e-01f, 1.333521456e-01f,
                           1.000000015e-01f, 7.498942316e-02f, 5.623413250e-02f, 4.216964915e-02f, 3.162277490e-02f, 2.371373773e-02f, 1.778279431e-02f, 1.333521400e-02f,
                           9.999999776e-03f, 7.498942316e-03f, 5.623413250e-03f, 4.216964822e-03f, 3.162277630e-03f, 2.371373819e-03f, 1.778279431e-03f, 1.333521446e-03f,
                           1.000000047e-03f, 7.498941850e-04f, 5.623413017e-04f, 4.216965172e-04f, 3.162277571e-04f, 2.371373703e-04f, 1.778279402e-04f, 1.333521504e-04f};
    f32x2* rope = (f32x2*)(ws + WS_ROPE); const int* pos = karg<A_POS, const int>();
    for (int rp_ = 0; rp_ < (DBL_PREP == 2 ? 2 : 1); ++rp_)
    for (int i = bid * NTHREADS + tid; i < T * 32; i += G * NTHREADS) {
      const int t = i >> 5, fi = i & 31;
      const float ang = (float)pos[t] * INV[fi];
      float sn, cs; sincosf(ang, &sn, &cs); rope[i] = (f32x2){cs, sn};
    }
  }
  if (bid == 0) for (int i = tid; i < 64 * CNT_STRIDE; i += NTHREADS) ((int*)(ws + WS_CNT))[i] = 0;
  { const float* w_re = karg<A_WRE>(); const float* w_rg = karg<A_WRG>(); float* wrt = (float*)(ws + WS_WRT);
    for (int i = bid * NTHREADS + tid; i < 36 * 1024; i += G * NTHREADS) { const int e = i >> 10, k = i & 1023; wrt[i] = e < 32 ? w_re[k * 32 + e] : w_rg[k * 4 + (e - 32)]; } }
}

DI void phase_lnmod(const Ctx& p, int bid, int G) {
  const int tid = tid_fresh(), lane = tid & 63, wave = tid >> 6;
  const float* mod = (const float*)(p.ws + WS_MOD); bf16_t* U = (bf16_t*)(p.ws + WS_U); const float* xin = karg<A_X>();
  f32x4 vn[4];
  { const int row = bid * 8 + wave; if (row < T) { const f32x4* xr = (const f32x4*)(xin + (size_t)row * 1024) + lane;
#pragma unroll
      for (int j = 0; j < 4; ++j) vn[j] = xr[64 * j]; } }
  for (int row = bid * 8 + wave; row < T; row += G * 8) {
    const int b = row >> 14;
    f32x4 sh[4], sc[4];
#pragma unroll
    for (int j = 0; j < 4; ++j) { const int col = 4 * lane + 256 * j; sh[j] = *(const f32x4*)(mod + b * 6144 + col); sc[j] = *(const f32x4*)(mod + b * 6144 + 1024 + col); }
    f32x4 v[4]; float s = 0.f;
#pragma unroll
    for (int j = 0; j < 4; ++j) { v[j] = vn[j]; s += (v[j][0] + v[j][1]) + (v[j][2] + v[j][3]); }
    if (row + G * 8 < T) { const f32x4* xr = (const f32x4*)(xin + (size_t)(row + G * 8) * 1024) + lane;
#pragma unroll
      for (int j = 0; j < 4; ++j) vn[j] = xr[64 * j]; }
    const float mean = wave_sum(s) * (1.f / 1024.f); float s2 = 0.f;
#pragma unroll
    for (int j = 0; j < 4; ++j) { v[j] = v[j] - mean; s2 += (v[j][0] * v[j][0] + v[j][1] * v[j][1]) + (v[j][2] * v[j][2] + v[j][3] * v[j][3]); }
    const float rstd = rsqrtf(wave_sum(s2) * (1.f / 1024.f) + LN_EPS);
    u32x2* o8 = (u32x2*)(U + (size_t)row * 1024) + lane;
#pragma unroll
    for (int j = 0; j < 4; ++j) {
      const f32x4 y = v[j] * rstd * (sc[j] + 1.f) + sh[j];
      o8[64 * j] = (u32x2){cvtpk(y[0], y[1]), cvtpk(y[2], y[3])};
    }
  }
}

constexpr int PA_V = 0, PA_KF = 32768, PA_KB = 65536, PA_RAWK = 100352, PA_VEC = 135168;
DI void mlstmA_unit(const Ctx& p, int b, int h, int c, LAS unsigned char* lds) {
  const int tid = tid_fresh(), lane = tid & 63, wid = __builtin_amdgcn_readfirstlane(tid >> 6), r32 = lane & 31, hi = lane >> 5;
  unsigned char* ws = p.ws;
  const bf16_t* qkpre = (const bf16_t*)(ws + WS_QKPRE); const bf16_t* vmp = (const bf16_t*)(ws + WS_VM); bf16_t* qkpost = (bf16_t*)(ws + WS_U);
  const float* gates = (const float*)(ws + WS_GATES); float* gvec = (float*)(ws + WS_GVEC); float* nvec = (float*)(ws + WS_NVEC); float* scal = (float*)(ws + WS_SCAL);
  bf16_t* Cbuf = (bf16_t*)p.out;
  LAS float* vec = (LAS float*)(lds + PA_VEC);
  const int bh = b * 4 + h, row0 = b * SEQ + c * 128;
  const int r0 = tid >> 4, c8 = (tid & 15) * 8;
  float ig_pre = 0.f, fg_pre = 0.f;
  if (tid < 256) { const int dir = tid >> 7, t = tid & 127; ig_pre = gates[(size_t)(row0 + t) * 16 + (dir * 2) * 4 + h]; fg_pre = gates[(size_t)(row0 + t) * 16 + (dir * 2 + 1) * 4 + h]; }
  u32x4 rk[5], rq[5], rv[4];
#pragma unroll
  for (int j = 0; j < 5; ++j) {
    const int rr = r0 + 32 * j, sj = c * 128 + rr - 2; const bool ok = rr < 132 && sj >= 0 && sj < SEQ;
    const bf16_t* src = qkpre + (size_t)(b * SEQ + (ok ? sj : 0)) * 1024 + h * 128 + c8;
    rk[j] = ok ? *(const u32x4*)(src + 512) : (u32x4){0u, 0u, 0u, 0u}; rq[j] = ok ? *(const u32x4*)src : (u32x4){0u, 0u, 0u, 0u};
  }
#pragma unroll
  for (int j = 0; j < 4; ++j) rv[j] = *(const u32x4*)(vmp + (size_t)(row0 + r0 + 32 * j) * 512 + h * 128 + c8);
  float gb = 0.f, gcol = 0.f, gcm = 0.f;
  if (tid < 256) {
    const int dir = tid >> 7, t = tid & 127, wv = (tid >> 6) & 1;
    const float ig = ig_pre, fg = fg_pre;
    float x = logsigmoidf_(fg);
    if (dir == 0) {
#pragma unroll
      for (int o = 1; o < 64; o <<= 1) { const float y = __shfl_up(x, o); if (lane >= o) x += y; }
      if (lane == 63) vec[256 + wv] = x;
    } else {
#pragma unroll
      for (int o = 1; o < 64; o <<= 1) { const float y = __shfl_down(x, o); if (lane + o < 64) x += y; }
      if (lane == 0) vec[258 + wv] = x;
    }
    gb = x; gcol = ig;
  }
  __syncthreads();
  if (tid < 256) {
    const int dir = tid >> 7, wv = (tid >> 6) & 1;
    if (dir == 0) { if (wv == 1) gb += vec[256]; } else { if (wv == 0) gb += vec[259]; }
    gcol = gcol - gb;
    float x = gcol;
    if (dir == 0) {
#pragma unroll
      for (int o = 1; o < 64; o <<= 1) { const float y = __shfl_up(x, o); if (lane >= o) x = fmaxf(x, y); }
      if (lane == 63) vec[260 + wv] = x;
    } else {
#pragma unroll
      for (int o = 1; o < 64; o <<= 1) { const float y = __shfl_down(x, o); if (lane + o < 64) x = fmaxf(x, y); }
      if (lane == 0) vec[262 + wv] = x;
    }
    gcm = x;
  }
  __syncthreads();
  if (tid < 256) {
    const int dir = tid >> 7, t = tid & 127, wv = (tid >> 6) & 1;
    if (dir == 0) { if (wv == 1) gcm = fmaxf(gcm, vec[260]); } else { if (wv == 0) gcm = fmaxf(gcm, vec[263]); }
    const float mx = fmaxf(vec[260 + 2 * dir], vec[261 + 2 * dir]);
    const float tot = vec[256 + 2 * dir] + vec[257 + 2 * dir];
    float* gv = gvec + ((size_t)(dir * 8 + bh) * SEQ + c * 128 + t) * 3;
    gv[0] = gb; gv[1] = gcol; gv[2] = gcm;
    vec[dir * 128 + t] = __expf(gcol - mx);
    if (t == 0) { scal[(dir * 8 + bh) * 128 + c] = tot; scal[2048 + (dir * 8 + bh) * 128 + c] = tot + mx; }
  }
  __syncthreads();
#pragma unroll
  for (int j = 0; j < 5; ++j) { const int rr = r0 + 32 * j;
    if (rr < 132) { *(LAS u32x4*)(lds + PA_RAWK + rr * 256 + c8 * 2) = rk[j]; *(LAS u32x4*)(lds + PA_KB + rr * 256 + c8 * 2) = rq[j]; } }
#pragma unroll
  for (int j = 0; j < 4; ++j) { const int r = r0 + 32 * j; *(LAS u32x4*)(lds + PA_V + (r >> 6) * 16384 + v_st(r & 63, c8)) = rv[j]; }
  __syncthreads();
  const float* conv_w = karg<A_CONVW>(); const float* conv_b = karg<A_CONVB>();
  {
    const int ch = h * 128 + c8;
    float w[5][8], bias[8];
#pragma unroll
    for (int j = 0; j < 5; ++j) { const f32x4 a = *(const f32x4*)(conv_w + j * 1024 + ch), bq = *(const f32x4*)(conv_w + j * 1024 + ch + 4);
      w[j][0] = a[0]; w[j][1] = a[1]; w[j][2] = a[2]; w[j][3] = a[3]; w[j][4] = bq[0]; w[j][5] = bq[1]; w[j][6] = bq[2]; w[j][7] = bq[3]; }
    { const f32x4 a = *(const f32x4*)(conv_b + ch), bq = *(const f32x4*)(conv_b + ch + 4); bias[0] = a[0]; bias[1] = a[1]; bias[2] = a[2]; bias[3] = a[3]; bias[4] = bq[0]; bias[5] = bq[1]; bias[6] = bq[2]; bias[7] = bq[3]; }
#pragma unroll
    for (int ps = 0; ps < 4; ++ps) {
      const int r = r0 + 32 * ps;
      float a[8];
#pragma unroll
      for (int e = 0; e < 8; ++e) a[e] = bias[e];
#pragma unroll
      for (int j = 0; j < 5; ++j) { const u32x4 xv = *(const LAS u32x4*)(lds + PA_KB + (r + j) * 256 + c8 * 2);
        a[0] += w[j][0] * bflo(xv[0]); a[1] += w[j][1] * bfhi(xv[0]); a[2] += w[j][2] * bflo(xv[1]); a[3] += w[j][3] * bfhi(xv[1]);
        a[4] += w[j][4] * bflo(xv[2]); a[5] += w[j][5] * bfhi(xv[2]); a[6] += w[j][6] * bflo(xv[3]); a[7] += w[j][7] * bfhi(xv[3]); }
      const float qs = 0.08838834764831845f;
#pragma unroll
      for (int e = 0; e < 8; ++e) a[e] = siluf_(a[e]) * qs;
      *(u32x4*)(qkpost + (size_t)(row0 + r) * 1024 + ch) = (u32x4){cvtpk(a[0], a[1]), cvtpk(a[2], a[3]), cvtpk(a[4], a[5]), cvtpk(a[6], a[7])};
    }
  }
  __syncthreads();
  {
    const int ch = 512 + h * 128 + c8;
    float w[5][8], bias[8];
#pragma unroll
    for (int j = 0; j < 5; ++j) { const f32x4 a = *(const f32x4*)(conv_w + j * 1024 + ch), bq = *(const f32x4*)(conv_w + j * 1024 + ch + 4);
      w[j][0] = a[0]; w[j][1] = a[1]; w[j][2] = a[2]; w[j][3] = a[3]; w[j][4] = bq[0]; w[j][5] = bq[1]; w[j][6] = bq[2]; w[j][7] = bq[3]; }
    { const f32x4 a = *(const f32x4*)(conv_b + ch), bq = *(const f32x4*)(conv_b + ch + 4); bias[0] = a[0]; bias[1] = a[1]; bias[2] = a[2]; bias[3] = a[3]; bias[4] = bq[0]; bias[5] = bq[1]; bias[6] = bq[2]; bias[7] = bq[3]; }
#pragma unroll
    for (int ps = 0; ps < 4; ++ps) {
      const int r = r0 + 32 * ps;
      float a[8];
#pragma unroll
      for (int e = 0; e < 8; ++e) a[e] = bias[e];
#pragma unroll
      for (int j = 0; j < 5; ++j) { const u32x4 xv = *(const LAS u32x4*)(lds + PA_RAWK + (r + j) * 256 + c8 * 2);
        a[0] += w[j][0] * bflo(xv[0]); a[1] += w[j][1] * bfhi(xv[0]); a[2] += w[j][2] * bflo(xv[1]); a[3] += w[j][3] * bfhi(xv[1]);
        a[4] += w[j][4] * bflo(xv[2]); a[5] += w[j][5] * bfhi(xv[2]); a[6] += w[j][6] * bflo(xv[3]); a[7] += w[j][7] * bfhi(xv[3]); }
#pragma unroll
      for (int e = 0; e < 8; ++e) a[e] = siluf_(a[e]);
      *(u32x4*)(qkpost + (size_t)(row0 + r) * 1024 + ch) = (u32x4){cvtpk(a[0], a[1]), cvtpk(a[2], a[3]), cvtpk(a[4], a[5]), cvtpk(a[6], a[7])};
      const float wf = vec[r], wb = vec[128 + r];
      const u32x4 kf = {cvtpk(a[0] * wf, a[1] * wf), cvtpk(a[2] * wf, a[3] * wf), cvtpk(a[4] * wf, a[5] * wf), cvtpk(a[6] * wf, a[7] * wf)};
      const u32x4 kb = {cvtpk(a[0] * wb, a[1] * wb), cvtpk(a[2] * wb, a[3] * wb), cvtpk(a[4] * wb, a[5] * wb), cvtpk(a[6] * wb, a[7] * wb)};
      const int io = (r >> 6) * 16384 + v_st(r & 63, c8);
      *(LAS u32x4*)(lds + PA_KF + io) = kf; *(LAS u32x4*)(lds + PA_KB + io) = kb;
    }
  }
  __syncthreads();
  {
    const int dir = wid >> 2, dkb = wid & 3;
    const int ka = (int)(uintptr_t)(lds + (dir ? PA_KB : PA_KF)) + v_rd_base(lane) + dkb * 512;
    const int va = (int)(uintptr_t)(lds + PA_V) + v_rd_base(lane);
    f32x16 o[4] = {};
#define PA_STEP(TILE, KS) do { s16x4 al, ah, l0, h0, l1, h1, l2, h2, l3, h3;                                                   \
      al = tr_read<v_rd_off(0, KS, 0)>(ka + TILE * 16384); ah = tr_read<v_rd_off(0, KS, 1)>(ka + TILE * 16384);                 \
      l0 = tr_read<v_rd_off(0, KS, 0)>(va + TILE * 16384); h0 = tr_read<v_rd_off(0, KS, 1)>(va + TILE * 16384);                 \
      l1 = tr_read<v_rd_off(1, KS, 0)>(va + TILE * 16384); h1 = tr_read<v_rd_off(1, KS, 1)>(va + TILE * 16384);                 \
      l2 = tr_read<v_rd_off(2, KS, 0)>(va + TILE * 16384); h2 = tr_read<v_rd_off(2, KS, 1)>(va + TILE * 16384);                 \
      l3 = tr_read<v_rd_off(3, KS, 0)>(va + TILE * 16384); h3 = tr_read<v_rd_off(3, KS, 1)>(va + TILE * 16384);                 \
      asm volatile("s_waitcnt lgkmcnt(0)" ::: "memory"); SBAR();                                                                \
      const bf16x8 A = PKLH(al, ah);                                                                                            \
      o[0] = MFMA32(A, PKLH(l0, h0), o[0]); o[1] = MFMA32(A, PKLH(l1, h1), o[1]); o[2] = MFMA32(A, PKLH(l2, h2), o[2]); o[3] = MFMA32(A, PKLH(l3, h3), o[3]); } while (0)
    PA_STEP(0, 0); PA_STEP(0, 1); PA_STEP(0, 2); PA_STEP(0, 3); PA_STEP(1, 0); PA_STEP(1, 1); PA_STEP(1, 2); PA_STEP(1, 3);
#undef PA_STEP
    bf16_t* Cd = Cbuf + ((size_t)(dir * 8 + bh) * 128 + c) * 16384;
#pragma unroll
    for (int r = 0; r < 16; ++r) { const int dk = dkb * 32 + crow(r, hi);
#pragma unroll
      for (int d0 = 0; d0 < 4; ++d0) Cd[dk * 128 + d0 * 32 + r32] = f2bf(o[d0][r]); }
  }
  if (tid < 256) {
    const int dir = tid >> 7, dk = tid & 127; const LAS unsigned char* img = lds + (dir ? PA_KB : PA_KF);
    float n = 0.f;
#pragma unroll 8
    for (int s = 0; s < 128; ++s) n += bf2f(*(const LAS unsigned short*)(img + (s >> 6) * 16384 + v_st(s & 63, dk)));
    nvec[((size_t)(dir * 8 + bh) * 128 + c) * 128 + dk] = n;
  }
  __syncthreads();
}

DI void phase_scan(const Ctx& p, int bid, int G) {
  const int tid = tid_fresh(); unsigned char* ws = p.ws;
  const float* scal = (const float*)(ws + WS_SCAL); float* mprev = (float*)(ws + WS_SCAL) + 4096; float* nvec = (float*)(ws + WS_NVEC); bf16_t* Cbuf = (bf16_t*)p.out;
  for (int gid = bid * NTHREADS + tid, it = 0; gid < 131072; gid += G * NTHREADS, ++it) {
    const int seq = gid >> 13, e2c = gid & 8191, dir = seq >> 3;
    const bool ex = (it == 0) && (gid < 1024);
    const int seqn = (gid & 1023) >> 6, e2 = gid & 63, dirn = seqn >> 3;
    float m = 0.f, a0 = 0.f, a1 = 0.f, mN = 0.f, n0 = 0.f, n1 = 0.f;
    for (int sb = 0; sb < 128; sb += 8) {
      unsigned raw[8]; f32x2 rawn[8];
#pragma unroll
      for (int q = 0; q < 8; ++q) { const int c = dir ? 127 - (sb + q) : sb + q; raw[q] = *(const unsigned*)(Cbuf + ((size_t)seq * 128 + c) * 16384 + e2c * 2); }
      if (ex) {
#pragma unroll
        for (int q = 0; q < 8; ++q) { const int c = dirn ? 127 - (sb + q) : sb + q; rawn[q] = *(const f32x2*)(nvec + ((size_t)seqn * 128 + c) * 128 + e2 * 2); }
      }
#pragma unroll
      for (int q = 0; q < 8; ++q) {
        const int c = dir ? 127 - (sb + q) : sb + q;
        const float be = scal[seq * 128 + c], ml = scal[2048 + seq * 128 + c];
        *(unsigned*)(Cbuf + ((size_t)seq * 128 + c) * 16384 + e2c * 2) = cvtpk(a0, a1);
        if (e2c == 0) mprev[seq * 128 + c] = m;
        const float mn = fmaxf(be + m, ml), al = __expf(be + m - mn), bt = __expf(ml - mn);
        a0 = al * a0 + bt * bflo(raw[q]); a1 = al * a1 + bt * bfhi(raw[q]);
        m = mn;
      }
      if (ex) {
#pragma unroll
        for (int q = 0; q < 8; ++q) {
          const int c = dirn ? 127 - (sb + q) : sb + q;
          const float be = scal[seqn * 128 + c], ml = scal[2048 + seqn * 128 + c];
          *(f32x2*)(nvec + ((size_t)seqn * 128 + c) * 128 + e2 * 2) = (f32x2){n0, n1};
          const float mn = fmaxf(be + mN, ml), al = __expf(be + mN - mn), bt = __expf(ml - mn);
          n0 = al * n0 + bt * rawn[q][0]; n1 = al * n1 + bt * rawn[q][1];
          mN = mn;
        }
      }
    }
  }
}

DI void qkt8(f32x16& p0, f32x16& p1, const LAS unsigned char* Ks, const bf16x8* qr, int r32, int hi) {
  p0 = f32x16{}; p1 = f32x16{};
#pragma unroll
  for (int d0 = 0; d0 < 8; ++d0) { const int cb = (d0 * 16 + hi * 8) * 2;
    const bf16x8 b0 = *(const LAS bf16x8*)(Ks + KSWZ(r32, cb)), b1 = *(const LAS bf16x8*)(Ks + KSWZ(32 + r32, cb));
    p0 = MFMA32(b0, qr[d0], p0); p1 = MFMA32(b1, qr[d0], p1); }
}
DI v8i kfrag8(const LAS unsigned char* K8, int row, int s, int hi) {
  const int c = 4 * s + 2 * hi;
  const u32x4 lo = *(const LAS u32x4*)(K8 + row * 256 + ((c ^ (row & 15)) << 4)), hi4 = *(const LAS u32x4*)(K8 + row * 256 + (((c + 1) ^ (row & 15)) << 4));
  return (v8i){(int)lo[0], (int)lo[1], (int)lo[2], (int)lo[3], (int)hi4[0], (int)hi4[1], (int)hi4[2], (int)hi4[3]};
}
#define MFMA8(a, b, c) __builtin_amdgcn_mfma_scale_f32_32x32x64_f8f6f4((a), (b), (c), 0, 0, 0, 127, 0, 123)
DI void qkt12(f32x16& p0, f32x16& p1, const LAS unsigned char* K8, const v8i* qr, int r32, int hi) {
  p0 = f32x16{}; p1 = f32x16{};
#pragma unroll
  for (int s = 0; s < 3; ++s) {
    const v8i a0 = kfrag8(K8, r32, s, hi), a1 = kfrag8(K8, 32 + r32, s, hi);
    p0 = MFMA8(a0, qr[s], p0); p1 = MFMA8(a1, qr[s], p1);
  }
}

DI void glds16(const void* gsrc, unsigned lds_dst) {
  unsigned keep;
  asm volatile("s_mov_b32 %0, m0\n\ts_mov_b32 m0, %2\n\ts_nop 0\n\tglobal_load_lds_dwordx4 %1, off\n\ts_mov_b32 m0, %0" : "=&s"(keep) : "v"(gsrc), "s"(lds_dst) : "memory");
}
constexpr int AT_KN = 0, AT_V = 49152, AT_WS = 73728;
constexpr float ATT_THR = 3.f;
DI void partialSM(f32x16& p0, f32x16& p1, float& m_reg, float& mn, float& alpha) {
  float pmax = p0[0];
#pragma unroll
  for (int r = 1; r < 16; ++r) pmax = fmaxf(pmax, p0[r]);
#pragma unroll
  for (int r = 0; r < 16; ++r) pmax = fmaxf(pmax, p1[r]);
  pmax = half_swap_max(pmax);
  if (__builtin_expect(__all(pmax - m_reg <= ATT_THR), 1)) { mn = m_reg; alpha = 1.f; }
  else { mn = fmaxf(m_reg, pmax); alpha = __builtin_amdgcn_exp2f(m_reg - mn); m_reg = mn; }
  const float mo = mn - 5.f;
#pragma unroll
  for (int r = 0; r < 16; ++r) { p0[r] = p0[r] - mo; p1[r] = p1[r] - mo; }
#pragma unroll
  for (int r = 0; r < 16; ++r) p0[r] = __builtin_amdgcn_exp2f(p0[r]);
}
DI void finishSM(f32x16& p0, f32x16& p1, v8i& pa) {
#pragma unroll
  for (int r = 0; r < 16; ++r) p1[r] = __builtin_amdgcn_exp2f(p1[r]);
#pragma unroll
  for (int q = 0; q < 4; ++q) {
    int w = __builtin_amdgcn_cvt_pk_fp8_f32(p0[4 * q], p0[4 * q + 1], pa[q], false); pa[q] = __builtin_amdgcn_cvt_pk_fp8_f32(p0[4 * q + 2], p0[4 * q + 3], w, true);
    w = __builtin_amdgcn_cvt_pk_fp8_f32(p1[4 * q], p1[4 * q + 1], pa[4 + q], false); pa[4 + q] = __builtin_amdgcn_cvt_pk_fp8_f32(p1[4 * q + 2], p1[4 * q + 3], w, true);
  }
}
DI void pv8(f32x16* o, f32x16& lsum, const LAS unsigned char* Vt, v8i pa, int r32, int hi) {
  { const v8i ones = {0x38383838, 0x38383838, 0x38383838, 0x38383838, 0x38383838, 0x38383838, 0x38383838, 0x38383838};
    lsum = __builtin_amdgcn_mfma_scale_f32_32x32x64_f8f6f4(pa, ones, lsum, 0, 0, 0, 122, 0, 127); }
#pragma unroll
  for (int d0 = 0; d0 < 4; ++d0) {
    const int n = 32 * d0 + r32, x = (n >> 2) & 3;
    const u32x4 lo = *(const LAS u32x4*)(Vt + n * 64 + (((2 * hi) ^ x) << 4)), h4 = *(const LAS u32x4*)(Vt + n * 64 + (((2 * hi + 1) ^ x) << 4));
    const v8i bv = {(int)lo[0], (int)lo[1], (int)lo[2], (int)lo[3], (int)h4[0], (int)h4[1], (int)h4[2], (int)h4[3]};
    o[d0] = __builtin_amdgcn_mfma_scale_f32_32x32x64_f8f6f4(pa, bv, o[d0], 0, 0, 0, 122, 0, 127);
  }
}
DI void attn_unit(const unsigned char* Qb, const unsigned char* Knh, const unsigned char* Vh, bf16_t* Ob, LAS unsigned char* lds) {
  const int tid = tid_fresh(), wid = __builtin_amdgcn_readfirstlane(tid >> 6), lane = tid & 63, r32 = lane & 31, hi = lane >> 5;
  LAS float* wsf = (LAS float*)(lds + AT_WS) + wid * 64; LAS float* al_l = wsf + 32;
  constexpr int NT = SEQ / 64;
  unsigned offKn, offV;
  { const int row = wid * 4 + (lane >> 4); int lg = (lane & 15) ^ (row & 15); lg = lg < 12 ? lg : 0; offKn = (unsigned)(row * 192 + lg * 16); }
  { const int n = wid * 16 + (lane >> 2), c = (lane & 3) ^ ((n >> 2) & 3); offV = (unsigned)(n * 64 + c * 16); }
  const unsigned ldsw = (unsigned)wid * 1024u, lds0 = (unsigned)(uintptr_t)lds;
#define DMA16(gptr, ldsoff) glds16((gptr), (unsigned)__builtin_amdgcn_readfirstlane((int)(lds0 + (unsigned)(ldsoff))))
#define ISSUE_K(t, ks) do { const int t_ = (t) < NT ? (t) : NT - 1; const char* kn_ = (const char*)Knh + (size_t)t_ * (64 * 192) + offKn; \
    DMA16(kn_, AT_KN + (ks) * 16384 + ldsw); DMA16(kn_ + 32 * 192, AT_KN + (ks) * 16384 + 8192 + ldsw); } while (0)
#define ISSUE_V(t, vs) do { const int t_ = (t) < NT ? (t) : NT - 1; DMA16((const char*)Vh + (size_t)t_ * 8192 + offV, AT_V + (vs) * 8192 + ldsw); } while (0)
#define WAIT_BAR(N) asm volatile("s_waitcnt vmcnt(" #N ") lgkmcnt(0)\n\ts_barrier" ::: "memory")
#define RESC(a) do { if (__any((a) < 1.f)) { if (hi == 0) al_l[r32] = (a); asm volatile("s_waitcnt lgkmcnt(0)" ::: "memory"); \
    _Pragma("unroll") for (int r = 0; r < 16; ++r) { const float a_ = al_l[crow(r, hi)]; lsum[r] *= a_; _Pragma("unroll") for (int d = 0; d < 4; ++d) o[d][r] *= a_; } } } while (0)
  const bool trail = wid >= 4;
  ISSUE_K(0, 0); ISSUE_K(1, 1); ISSUE_V(0, 0);
  float m_reg = -1e30f; f32x16 lsum = {}; f32x16 o[4] = {}; v8i qr[3];
  { const unsigned char* Qw = Qb + (size_t)(wid * 32 + r32) * 192 + hi * 32;
#pragma unroll
    for (int s_ = 0; s_ < 3; ++s_) { const u32x4 lo = *(const u32x4*)(Qw + s_ * 64), h4 = *(const u32x4*)(Qw + s_ * 64 + 16);
      qr[s_] = (v8i){(int)lo[0], (int)lo[1], (int)lo[2], (int)lo[3], (int)h4[0], (int)h4[1], (int)h4[2], (int)h4[3]}; } }
  f32x16 pA0, pA1, pB0, pB1; float mnA, mnB, alA, alB; v8i pa = {};
  asm volatile("s_waitcnt vmcnt(0)" ::: "memory");
  __builtin_amdgcn_s_barrier();
  if (trail) __builtin_amdgcn_s_barrier();
  ISSUE_K(2, 2);
  qkt12(pA0, pA1, lds + AT_KN, qr, r32, hi);
  WAIT_BAR(3);
  ISSUE_V(1, 1);
  partialSM(pA0, pA1, m_reg, mnA, alA);
  WAIT_BAR(3);
  int s1 = 1;
  for (int j = 1; j + 1 < NT; j += 2) {
    const int s0 = s1 == 0 ? 2 : s1 - 1, s2 = s1 == 2 ? 0 : s1 + 1;
    ISSUE_K(j + 2, s0);
    SBAR(); qkt12(pB0, pB1, lds + AT_KN + s1 * 16384, qr, r32, hi);
    finishSM(pA0, pA1, pa); SBAR();
    WAIT_BAR(3);
    ISSUE_V(j + 1, s2);
    pv8(o, lsum, lds + AT_V + s0 * 8192, pa, r32, hi); partialSM(pB0, pB1, m_reg, mnB, alB);
    RESC(alB);
    WAIT_BAR(3);
    ISSUE_K(j + 3, s1);
    SBAR(); qkt12(pA0, pA1, lds + AT_KN + s2 * 16384, qr, r32, hi);
    finishSM(pB0, pB1, pa); SBAR();
    WAIT_BAR(3);
    ISSUE_V(j + 2, s0);
    pv8(o, lsum, lds + AT_V + s1 * 8192, pa, r32, hi); partialSM(pA0, pA1, m_reg, mnA, alA);
    RESC(alA);
    WAIT_BAR(3);
    s1 = s0;
  }
  {
    const int s0 = s1 == 0 ? 2 : s1 - 1, s2 = s1 == 2 ? 0 : s1 + 1;
    ISSUE_K(NT + 1, s0);
    SBAR(); qkt12(pB0, pB1, lds + AT_KN + s1 * 16384, qr, r32, hi);
    finishSM(pA0, pA1, pa); SBAR();
    WAIT_BAR(3);
    ISSUE_V(NT, s2);
    pv8(o, lsum, lds + AT_V + s0 * 8192, pa, r32, hi); partialSM(pB0, pB1, m_reg, mnB, alB);
    RESC(alB);
    WAIT_BAR(3);
    if (!trail) __builtin_amdgcn_s_barrier();
    finishSM(pB0, pB1, pa); SBAR();
    pv8(o, lsum, lds + AT_V + s1 * 8192, pa, r32, hi);
  }
  float rli[16];
#pragma unroll
  for (int r = 0; r < 16; ++r) rli[r] = __builtin_amdgcn_rcpf(lsum[r]);
  bf16_t* Ow = Ob + (size_t)(wid * 32) * 1024;
#pragma unroll
  for (int r = 0; r < 16; ++r) { const int orow = crow(r, hi);
#pragma unroll
    for (int d0 = 0; d0 < 4; ++d0) Ow[(size_t)orow * 1024 + d0 * 32 + r32] = f2bf(o[d0][r] * rli[r]); }
  asm volatile("s_waitcnt vmcnt(0) lgkmcnt(0)\n\ts_barrier" ::: "memory");
#undef DMA16
#undef ISSUE_K
#undef ISSUE_V
#undef WAIT_BAR
#undef RESC
}
DI void phase_attn(const Ctx& p, int bid, int G, LAS unsigned char* lds) {
  unsigned char* ws = p.ws;
  const unsigned char* qatt = ws + WS_QATT; const unsigned char* k8 = ws + WS_KN; const unsigned char* va = ws + WS_VA;
  bf16_t* hcat = (bf16_t*)(ws + WS_H);
  for (int u = bid; u < 512; u += G) {
    const int bh = u & 7, qb = u >> 3, b = bh >> 2, h = bh & 3;
    attn_unit(qatt + ((size_t)bh * SEQ + qb * 256) * 192, k8 + (size_t)bh * SEQ * 192, va + (size_t)bh * SEQ * 128,
              hcat + (size_t)(b * SEQ + qb * 256) * 1024 + 512 + h * 128, lds);
  }
}

constexpr int PC_K = 0, PC_V = 32768, PC_CF = 65536, PC_CB = 98304, PC_VEC = 131072;
template <bool DRY = false> DI void mlstmC_unit(const Ctx& p, int b, int h, int c, LAS unsigned char* lds) {
  const int tid = tid_fresh(), lane = tid & 63, wid = __builtin_amdgcn_readfirstlane(tid >> 6), r32 = lane & 31, hi = lane >> 5;
  unsigned char* ws = p.ws;
  const bf16_t* qkpost = (const bf16_t*)(ws + WS_U); const bf16_t* vmp = (const bf16_t*)(ws + WS_VM); bf16_t* hcat = (bf16_t*)(ws + WS_H);
  const float* gvec = (const float*)(ws + WS_GVEC); const float* nvec = (const float*)(ws + WS_NVEC); const float* mprev = (const float*)(ws + WS_SCAL) + 4096;
  const bf16_t* Cbuf = (const bf16_t*)p.out;
  LAS float* vec = (LAS float*)(lds + PC_VEC);
  const int bh = b * 4 + h, row0 = b * SEQ + c * 128;
  if (tid < 256) {
    const int dir = tid >> 7, t = tid & 127;
    const float* gv = gvec + ((size_t)(dir * 8 + bh) * SEQ + c * 128 + t) * 3;
    const float gb = gv[0], gcol = gv[1], gcm = gv[2], mp = mprev[(dir * 8 + bh) * 128 + c];
    const float M = fmaxf(mp, gcm);
    vec[dir * 128 + t] = gcol * LOG2E; vec[256 + dir * 128 + t] = M * LOG2E; vec[512 + dir * 128 + t] = __expf(mp - M); vec[768 + dir * 128 + t] = __expf(-(gb + M));
    vec[1024 + dir * 128 + t] = nvec[((size_t)(dir * 8 + bh) * 128 + c) * 128 + t];
  }
  {
    const int r0 = tid >> 4, c8 = (tid & 15) * 8;
    const bf16_t* Cf = Cbuf + ((size_t)(0 * 8 + bh) * 128 + c) * 16384; const bf16_t* Cb = Cbuf + ((size_t)(1 * 8 + bh) * 128 + c) * 16384;
#pragma unroll
    for (int ps = 0; ps < 4; ++ps) {
      const int r = r0 + 32 * ps, tile = r >> 6, rr = r & 63;
      *(LAS u32x4*)(lds + PC_K + tile * 16384 + KSWZ(rr, c8 * 2)) = *(const u32x4*)(qkpost + (size_t)(row0 + r) * 1024 + 512 + h * 128 + c8);
      *(LAS u32x4*)(lds + PC_V + tile * 16384 + v_st(rr, c8)) = *(const u32x4*)(vmp + (size_t)(row0 + r) * 512 + h * 128 + c8);
      *(LAS u32x4*)(lds + PC_CF + tile * 16384 + v_st(rr, c8)) = *(const u32x4*)(Cf + r * 128 + c8);
      *(LAS u32x4*)(lds + PC_CB + tile * 16384 + v_st(rr, c8)) = *(const u32x4*)(Cb + r * 128 + c8);
    }
  }
  const int dir = wid >> 2, tb = wid & 3, t = tb * 32 + r32;
  bf16x8 qr[8];
  { const bf16_t* Qw = qkpost + (size_t)(row0 + t) * 1024 + h * 128 + hi * 8;
#pragma unroll
    for (int d0 = 0; d0 < 8; ++d0) qr[d0] = *(const bf16x8*)(Qw + d0 * 16); }
  __syncthreads();
  const LAS float* vcol = vec + dir * 128; const LAS float* va_ = vec + 512 + dir * 128; const LAS float* vn = vec + 1024 + dir * 128;
  float qn = 0.f;
#pragma unroll
  for (int d0 = 0; d0 < 8; ++d0)
#pragma unroll
    for (int j = 0; j < 8; ++j) qn += bf2f((unsigned short)qr[d0][j]) * vn[d0 * 16 + hi * 8 + j];
  qn = half_swap_sum(qn);
  asm volatile("" : "+v"(qn));
  SBAR();
  f32x16 o[4] = {};
  {
    const int vbc = (int)(uintptr_t)(lds + (dir ? PC_CB : PC_CF)) + v_rd_base(lane);
    pv_d0(o, vbc, qr[0], qr[1], qr[2], qr[3]);
    pv_d0(o, vbc + 16384, qr[4], qr[5], qr[6], qr[7]);
  }
#pragma unroll
  for (int d = 0; d < 4; ++d)
#pragma unroll
    for (int r = 0; r < 16; ++r) o[d][r] *= va_[tb * 32 + crow(r, hi)];
  SBAR();
  const float Mt = vec[256 + dir * 128 + t], at = va_[t], flt = vec[768 + dir * 128 + t];
  float rsum = 0.f;
  const int vbv = (int)(uintptr_t)(lds + PC_V) + v_rd_base(lane);
#pragma unroll
  for (int kt = 0; kt < 2; ++kt) {
    const bool need = dir == 0 ? (kt * 64 <= tb * 32 + 31) : (kt * 64 + 63 >= tb * 32);
    if (need) {
      f32x16 p0, p1; qkt8(p0, p1, lds + PC_K + kt * 16384, qr, r32, hi);
#pragma unroll
      for (int r = 0; r < 16; ++r) {
        const int s0 = kt * 64 + crow(r, hi), s1 = s0 + 32;
        const bool ok0 = dir == 0 ? (s0 <= t) : (s0 >= t), ok1 = dir == 0 ? (s1 <= t) : (s1 >= t);
        const float w0 = __builtin_amdgcn_exp2f(vcol[s0] - Mt), w1 = __builtin_amdgcn_exp2f(vcol[s1] - Mt);
        p0[r] = ok0 ? p0[r] * w0 : 0.f; p1[r] = ok1 ? p1[r] * w1 : 0.f;
        rsum += p0[r] + p1[r];
      }
      bf16x8 pa0, pa1, pa2, pa3; pack_p(p0, p1, pa0, pa1, pa2, pa3);
      pv_d0(o, vbv + kt * 16384, pa0, pa1, pa2, pa3);
    }
  }
  rsum = half_swap_sum(rsum);
  {
    const float den = at * qn + rsum, dn = fmaxf(fabsf(den), flt);
    LAS float* rd = vec + 1280 + dir * 128;
    if (hi == 0) rd[t] = 1.f / dn;
    asm volatile("s_waitcnt lgkmcnt(0)" ::: "memory");
#pragma unroll
    for (int d = 0; d < 4; ++d)
#pragma unroll
      for (int r = 0; r < 16; ++r) o[d][r] *= rd[tb * 32 + crow(r, hi)];
  }
  __syncthreads();
  {
    LAS float* hst = (LAS float*)(lds + dir * 65536);
#pragma unroll
    for (int r = 0; r < 16; ++r) { const int tr = tb * 32 + crow(r, hi);
#pragma unroll
      for (int d = 0; d < 4; ++d) hst[tr * 128 + d * 32 + r32] = o[d][r]; }
  }
  __syncthreads();
  {
    const int rg = tid >> 5, cl = tid & 31;
    const f32x4 g = *(const f32x4*)(karg<A_MHG>() + h * 128 + 4 * cl);
    u32x2 sgv[8];
#pragma unroll
    for (int ps = 0; ps < 8; ++ps) sgv[ps] = *(const u32x2*)(hcat + (size_t)(row0 + ps * 16 + rg) * 1024 + h * 128 + 4 * cl);
#pragma unroll
    for (int ps = 0; ps < 8; ++ps) {
      const int tr = ps * 16 + rg;
      const f32x4 xf = *(const LAS f32x4*)(lds + (tr * 128 + 4 * cl) * 4), xb = *(const LAS f32x4*)(lds + 65536 + (tr * 128 + 4 * cl) * 4);
      f32x4 x = xf + xb;
      float s = (x[0] + x[1]) + (x[2] + x[3]);
      s = half_sum32(s);
      const float mu = s * (1.f / 128.f); x = x - mu;
      float q = (x[0] * x[0] + x[1] * x[1]) + (x[2] * x[2] + x[3] * x[3]);
      q = half_sum32(q);
      const float rstd = rsqrtf(q * (1.f / 128.f) + LN_EPS);
      u32x2* dst = (u32x2*)(hcat + (size_t)(row0 + tr) * 1024 + h * 128 + 4 * cl);
      const u32x2 sg = sgv[ps];
      const f32x4 y = x * rstd * g;
      if (DRY) dst = (u32x2*)((bf16_t*)(ws + WS_QKPRE) + (size_t)(row0 + tr) * 1024 + h * 128 + 4 * cl);
      *dst = (u32x2){cvtpk(y[0] * bflo(sg[0]), y[1] * bfhi(sg[0])), cvtpk(y[2] * bflo(sg[1]), y[3] * bfhi(sg[1]))};
    }
  }
  __syncthreads();
}

template <bool DRY = false> DI void phase_hanorm(const Ctx& p, int bid, int G) {
  const int tid = tid_fresh(), lane = tid & 63, wave = tid >> 6; bf16_t* hcat = (bf16_t*)(p.ws + WS_H);
  const f32x4 g0 = *(const f32x4*)(karg<A_ANG>() + 8 * lane), g1 = *(const f32x4*)(karg<A_ANG>() + 8 * lane + 4);
  u32x4 wn = {0u, 0u, 0u, 0u};
  { const int row = bid * 8 + wave; if (row < T) wn = *(const u32x4*)(hcat + (size_t)row * 1024 + 512 + 8 * lane); }
  for (int row = bid * 8 + wave; row < T; row += G * 8) {
    u32x4* ptr = (u32x4*)(hcat + (size_t)row * 1024 + 512 + 8 * lane);
    const u32x4 w = wn;
    if (row + G * 8 < T) wn = *(const u32x4*)(hcat + (size_t)(row + G * 8) * 1024 + 512 + 8 * lane);
    float v[8] = {bflo(w[0]), bfhi(w[0]), bflo(w[1]), bfhi(w[1]), bflo(w[2]), bfhi(w[2]), bflo(w[3]), bfhi(w[3])};
    float s = 0.f;
#pragma unroll
    for (int e = 0; e < 8; ++e) s += v[e] * v[e];
    const float rs = rsqrtf(wave_sum(s) * (1.f / 512.f) + RMS_EPS);
    if (DRY) ptr = (u32x4*)((bf16_t*)(p.ws + WS_QKPRE) + (size_t)row * 1024 + 512 + 8 * lane);
    *ptr = (u32x4){cvtpk(v[0] * rs * g0[0], v[1] * rs * g0[1]), cvtpk(v[2] * rs * g0[2], v[3] * rs * g0[3]), cvtpk(v[4] * rs * g1[0], v[5] * rs * g1[1]), cvtpk(v[6] * rs * g1[2], v[7] * rs * g1[3])};
  }
}

template <bool DRY = false> DI void phase_route(const Ctx& p, int bid, int G, LAS unsigned char* lds) {
  const int tid = tid_fresh(), lane = tid & 63, wave = tid >> 6; unsigned char* ws = p.ws;
  LAS float* wreT = (LAS float*)lds;
  LAS float* wrgT = (LAS float*)(lds + 131072);
  LAS int* rec = (LAS int*)(lds + 147456);
  LAS int* lcnt = (LAS int*)(lds + 147456 + 2048);
  LAS float* bre_l = (LAS float*)(lds + 147456 + 2048 + 256);
  { const f32x4* wrt = (const f32x4*)(ws + WS_WRT);
    for (int i = tid; i < 36 * 256; i += NTHREADS) ((LAS f32x4*)lds)[i] = wrt[i]; }
  if (tid < 32) bre_l[tid] = karg<A_BRE>()[tid];
  const float* ln1_g = karg<A_LN1G>(); const float* ln1_b = karg<A_LN1B>(); const float* b_rg = karg<A_BRG>(); const float* b_re = karg<A_BRE>();
  const float* mod = (const float*)(ws + WS_MOD); bf16_t* U = (bf16_t*)(ws + WS_U);
  int* cnt = (int*)(ws + WS_CNT) + (DRY ? 32 * CNT_STRIDE : 0);
  int* ltok = (int*)(ws + (DRY ? WS_HDN : WS_LTOK)); float* lw = (float*)(ws + (DRY ? WS_HDN + 8 * MiB : WS_LW));
  int* toke = (int*)(ws + WS_TOKE) + (DRY ? 2 * T : 0); int* tokp = (int*)(ws + WS_TOKP) + (DRY ? 2 * T : 0);
  const int nk = T / (G * 8);
  __syncthreads();
  f32x4 wg[4][4];
#pragma unroll
  for (int e = 0; e < 4; ++e)
#pragma unroll
    for (int j = 0; j < 4; ++j) wg[e][j] = *(const LAS f32x4*)(wrgT + e * 1024 + 4 * lane + 256 * j);
  f32x4 l1g[4], l1b[4];
#pragma unroll
  for (int j = 0; j < 4; ++j) { const int col = 4 * lane + 256 * j; l1g[j] = *(const f32x4*)(ln1_g + col); l1b[j] = *(const f32x4*)(ln1_b + col); }
  for (int k0 = 0; k0 < nk; k0 += 16) {
    if (tid < 32) lcnt[tid] = 0;
    __syncthreads();
    u32x2 zn[4];
    { const u32x2* zr = (const u32x2*)((const bf16_t*)p.out + (size_t)(bid * 8 + wave + k0 * G * 8) * 1024) + lane;
#pragma unroll
      for (int j = 0; j < 4; ++j) zn[j] = zr[64 * j]; }
    for (int kk = 0; kk < 16 && k0 + kk < nk; ++kk) {
      const int row = bid * 8 + wave + (k0 + kk) * G * 8, b = row >> 14;
      u32x2* x1r = (u32x2*)((bf16_t*)(ws + (DRY ? 384 * MiB : WS_H)) + (size_t)row * 1024) + lane;
      f32x4 msc[4], msh[4];
#pragma unroll
      for (int j = 0; j < 4; ++j) { const int col = 4 * lane + 256 * j; msc[j] = *(const f32x4*)(mod + b * 6144 + 4096 + col); msh[j] = *(const f32x4*)(mod + b * 6144 + 3072 + col); }
      f32x4 v[4]; float s = 0.f;
#pragma unroll
      for (int j = 0; j < 4; ++j) { const u32x2 raw = zn[j]; v[j] = (f32x4){bflo(raw[0]), bfhi(raw[0]), bflo(raw[1]), bfhi(raw[1])}; s += (v[j][0] + v[j][1]) + (v[j][2] + v[j][3]); }
      if (kk + 1 < 16 && k0 + kk + 1 < nk) { const u32x2* zr = (const u32x2*)((const bf16_t*)p.out + (size_t)(row + G * 8) * 1024) + lane;
#pragma unroll
        for (int j = 0; j < 4; ++j) zn[j] = zr[64 * j]; }
      float mean = wave_sum(s) * (1.f / 1024.f), s2 = 0.f;
#pragma unroll
      for (int j = 0; j < 4; ++j) { v[j] = v[j] - mean; s2 += (v[j][0] * v[j][0] + v[j][1] * v[j][1]) + (v[j][2] * v[j][2] + v[j][3] * v[j][3]); }
      float rstd = rsqrtf(wave_sum(s2) * (1.f / 1024.f) + LN_EPS);
      s = 0.f;
#pragma unroll
      for (int j = 0; j < 4; ++j) { const int col = 4 * lane + 256 * j;
        v[j] = v[j] * rstd * l1g[j] + l1b[j];
        x1r[64 * j] = (u32x2){cvtpk(v[j][0], v[j][1]), cvtpk(v[j][2], v[j][3])};
        s += (v[j][0] + v[j][1]) + (v[j][2] + v[j][3]); }
      mean = wave_sum(s) * (1.f / 1024.f); s2 = 0.f;
#pragma unroll
      for (int j = 0; j < 4; ++j) { v[j] = v[j] - mean; s2 += (v[j][0] * v[j][0] + v[j][1] * v[j][1]) + (v[j][2] * v[j][2] + v[j][3] * v[j][3]); }
      rstd = rsqrtf(wave_sum(s2) * (1.f / 1024.f) + LN_EPS);
      int* o8 = (int*)((unsigned char*)U + (size_t)row * 1024) + lane;
      float gl[4] = {0.f, 0.f, 0.f, 0.f};
#pragma unroll
      for (int j = 0; j < 4; ++j) { const int col = 4 * lane + 256 * j;
        v[j] = v[j] * rstd * (msc[j] + 1.f) + msh[j];
        { int w8 = __builtin_amdgcn_cvt_pk_fp8_f32(v[j][0], v[j][1], 0, false); o8[64 * j] = __builtin_amdgcn_cvt_pk_fp8_f32(v[j][2], v[j][3], w8, true); }
#pragma unroll
        for (int e = 0; e < 4; ++e) { const f32x4 w = wg[e][j]; gl[e] += v[j][0] * w[0] + v[j][1] * w[1] + v[j][2] * w[2] + v[j][3] * w[3]; } }
#pragma unroll
      for (int e = 0; e < 4; ++e) gl[e] = wave_sum(gl[e]) + b_rg[e];
      int gi = 0; float gm = gl[0];
#pragma unroll
      for (int e = 1; e < 4; ++e) if (gl[e] > gm) { gm = gl[e]; gi = e; }
      float gs = 0.f;
#pragma unroll
      for (int e = 0; e < 4; ++e) gs += __expf(gl[e] - gm);
      const float gw = 1.f / gs;
      float el[8] = {0.f, 0.f, 0.f, 0.f, 0.f, 0.f, 0.f, 0.f};
#pragma unroll
      for (int j = 0; j < 4; ++j) { const int col = 4 * lane + 256 * j;
#pragma unroll
        for (int e = 0; e < 8; ++e) { const f32x4 w = *(const LAS f32x4*)(wreT + (gi * 8 + e) * 1024 + col); el[e] += v[j][0] * w[0] + v[j][1] * w[1] + v[j][2] * w[2] + v[j][3] * w[3]; } }
#pragma unroll
      for (int e = 0; e < 8; ++e) el[e] = wave_sum(el[e]) + bre_l[gi * 8 + e];
      int i1 = 0; float v1 = el[0];
#pragma unroll
      for (int e = 1; e < 8; ++e) if (el[e] > v1) { v1 = el[e]; i1 = e; }
      int i2 = (i1 == 0) ? 1 : 0; float v2 = (i1 == 0) ? el[1] : el[0];
#pragma unroll
      for (int e = 0; e < 8; ++e) if (e != i1 && el[e] > v2) { v2 = el[e]; i2 = e; }
      const float p1 = 1.f / (1.f + __expf(v2 - v1)), p2 = 1.f - p1;
      if (lane == 0) {
        const int e1 = gi * 8 + i1, e2 = gi * 8 + i2, li = kk * 8 + wave;
        const int q1 = __hip_atomic_fetch_add(&lcnt[e1], 1, __ATOMIC_RELAXED, __HIP_MEMORY_SCOPE_WORKGROUP), q2 = __hip_atomic_fetch_add(&lcnt[e2], 1, __ATOMIC_RELAXED, __HIP_MEMORY_SCOPE_WORKGROUP);
        rec[li * 4 + 0] = e1 | (e2 << 8); rec[li * 4 + 1] = q1 | (q2 << 16); rec[li * 4 + 2] = __float_as_int(p1 * gw); rec[li * 4 + 3] = __float_as_int(p2 * gw);
      }
    }
    __syncthreads();
    if (tid < 32) { const int n = lcnt[tid]; lcnt[32 + tid] = n ? atomicAdd(&cnt[tid * CNT_STRIDE], n) : 0; }
    __syncthreads();
    if (tid < 128 && k0 + (tid >> 3) < nk) {
      const int li = tid, row = bid * 8 + (li & 7) + (k0 + (li >> 3)) * G * 8;
      const int ee = rec[li * 4], qq = rec[li * 4 + 1], e1 = ee & 255, e2 = ee >> 8, q1 = lcnt[32 + e1] + (qq & 0xffff), q2 = lcnt[32 + e2] + (qq >> 16);
      ltok[(size_t)e1 * T + q1] = row; lw[(size_t)e1 * T + q1] = __int_as_float(rec[li * 4 + 2]);
      ltok[(size_t)e2 * T + q2] = row; lw[(size_t)e2 * T + q2] = __int_as_float(rec[li * 4 + 3]);
      toke[row * 2] = e1; toke[row * 2 + 1] = e2; tokp[row * 2] = q1; tokp[row * 2 + 1] = q2;
    }
    __syncthreads();
  }
}

constexpr int MOE_TS = 131072;
DI void moe_table(const Ctx& p, LAS unsigned char* lds) {
  LAS int* ts = (LAS int*)(lds + MOE_TS); const int* cnt = (const int*)(p.ws + WS_CNT);
  if (threadIdx.x < 64) {
    const int lane = threadIdx.x; const int n = lane < 32 ? (cnt[lane * CNT_STRIDE] + 255) >> 8 : 0; int a = n;
#pragma unroll
    for (int o = 1; o < 32; o <<= 1) { const int t = __shfl_up(a, o); a += lane >= o ? t : 0; }
    if (lane < 32) ts[lane] = a - n;
    if (lane == 31) ts[32] = a;
  }
  __syncthreads();
}

template <bool DRY = false> DI void phase_final(const Ctx& p, int bid, int G, LAS unsigned char* lds) {
  const int tid = tid_fresh(), lane = tid & 63, wave = tid >> 6; unsigned char* ws = p.ws;
  const LAS int* ts = (const LAS int*)(lds + MOE_TS); const float* ln2_g = karg<A_LN2G>(); const float* ln2_b = karg<A_LN2B>();
  const float* mod = (const float*)(ws + WS_MOD); const bf16_t* ybuf = (const bf16_t*)(ws + WS_YBUF); const int* toke = (const int*)(ws + WS_TOKE); const int* tokp = (const int*)(ws + WS_TOKP);
  const int stride = G * 8; int row = bid * 8 + wave;
  int e0n = 0, p0n = 0, e1n = 0, p1n = 0;
  u32x2 an[4], cn[4], xn[4];
  auto rawslots = [&](int r) { e0n = toke[r * 2]; p0n = tokp[r * 2]; e1n = toke[r * 2 + 1]; p1n = tokp[r * 2 + 1]; };
  auto loadrow = [&](int r, size_t a, size_t c) {
    const u32x2* x1r = (const u32x2*)((const bf16_t*)(ws + WS_H) + (size_t)r * 1024) + lane;
    const u32x2* y0 = (const u32x2*)(ybuf + a * 1024) + lane; const u32x2* y1 = (const u32x2*)(ybuf + c * 1024) + lane;
#pragma unroll
    for (int j = 0; j < 4; ++j) { an[j] = y0[64 * j]; cn[j] = y1[64 * j]; xn[j] = x1r[64 * j]; } };
  f32x4 lg[4], lb[4];
#pragma unroll
  for (int j = 0; j < 4; ++j) { const int col = 4 * lane + 256 * j; lg[j] = *(const f32x4*)(ln2_g + col); lb[j] = *(const f32x4*)(ln2_b + col); }
  if (row < T) { rawslots(row); loadrow(row, (size_t)ts[e0n] * 256 + p0n, (size_t)ts[e1n] * 256 + p1n); if (row + stride < T) rawslots(row + stride); }
  for (; row < T; row += stride) {
    const int b = row >> 14;
    f32x4 v[4]; float s = 0.f;
#pragma unroll
    for (int j = 0; j < 4; ++j) { const int col = 4 * lane + 256 * j;
      const u32x2 a = an[j], c = cn[j], xw = xn[j];
      const f32x4 y = {bflo(a[0]) + bflo(c[0]), bfhi(a[0]) + bfhi(c[0]), bflo(a[1]) + bflo(c[1]), bfhi(a[1]) + bfhi(c[1])};
      const f32x4 x1v = {bflo(xw[0]), bfhi(xw[0]), bflo(xw[1]), bfhi(xw[1])};
      v[j] = x1v * ALPHA + (*(const f32x4*)(mod + b * 6144 + 5120 + col) + 1.f) * y;
      s += (v[j][0] + v[j][1]) + (v[j][2] + v[j][3]); }
    if (row + stride < T) { loadrow(row + stride, (size_t)ts[e0n] * 256 + p0n, (size_t)ts[e1n] * 256 + p1n); if (row + 2 * stride < T) rawslots(row + 2 * stride); }
    const float mean = wave_sum(s) * (1.f / 1024.f); float s2 = 0.f;
#pragma unroll
    for (int j = 0; j < 4; ++j) { v[j] = v[j] - mean; s2 += (v[j][0] * v[j][0] + v[j][1] * v[j][1]) + (v[j][2] * v[j][2] + v[j][3] * v[j][3]); }
    const float rstd = rsqrtf(wave_sum(s2) * (1.f / 1024.f) + LN_EPS);
    f32x4* xr = (f32x4*)(p.out + (size_t)row * 1024) + lane;
#pragma unroll
    for (int j = 0; j < 4; ++j) xr[64 * j] = v[j] * rstd * lg[j] + lb[j];
  }
}


#define XB_TMO      128
#define XB_XCNT(j)  (256  + 64 * (j))
#define XB_XSUB(j)  (1280 + 64 * (j))
#define XB_XGEN(j)  (2304 + 64 * (j))
#define XB_TOP      3328
#define XB_TOPGEN   3392
#define XCD_BAR_WORDS 3456
#define XB_SPIN_CAP (1u << 18)
DI unsigned xb_ld(unsigned* p)              { return __hip_atomic_load(p, __ATOMIC_RELAXED, __HIP_MEMORY_SCOPE_AGENT); }
DI unsigned xb_add(unsigned* p, unsigned v) { return __hip_atomic_fetch_add(p, v, __ATOMIC_RELAXED, __HIP_MEMORY_SCOPE_AGENT); }
DI unsigned xb_xcc_id() { return (unsigned)__builtin_amdgcn_s_getreg((3 << 11) | 20) & 0xFu; }
#define XB_SPIN(cond, bar) do { unsigned _sp = 0; while (cond) { __builtin_amdgcn_s_sleep(1); \
    if ((++_sp & 255u) == 0u) { if (xb_ld(&(bar)[XB_TMO])) break; if (_sp > XB_SPIN_CAP) { atomicAdd(&(bar)[XB_TMO], 1u); break; } } } } while (0)
struct XcdBarrier { unsigned* bar; unsigned x; volatile LAS unsigned* st; };
DI XcdBarrier xcd_barrier_post(unsigned* bar, volatile LAS unsigned* st) {
  XcdBarrier b; b.bar = bar; b.x = xb_xcc_id(); b.st = st;
  if (threadIdx.x == 0) (void)xb_add(&bar[XB_XCNT(b.x)], 1u);
  return b;
}
DI void xcd_barrier_complete(unsigned* bar, unsigned x, unsigned& nloc, unsigned& nx) {
  const unsigned G = gridDim.x * gridDim.y * gridDim.z;
  unsigned sum, cnt, mine, sp = 0u;
  for (;;) {
    sum = 0u; cnt = 0u; mine = 0u;
#pragma unroll
    for (unsigned j = 0; j < 16; ++j) { const unsigned c = xb_ld(&bar[XB_XCNT(j)]); sum += c; cnt += (c > 0u) ? 1u : 0u; mine = (j == x) ? c : mine; }
    if (sum == G) break;
    __builtin_amdgcn_s_sleep(1);
    if ((++sp & 255u) == 0u) { if (xb_ld(&bar[XB_TMO])) break; if (sp > XB_SPIN_CAP) { atomicAdd(&bar[XB_TMO], 1u); break; } }
  }
  nloc = mine > 0u ? mine : 1u; nx = cnt > 0u ? cnt : 1u;
}
DI void xcd_barrier(const XcdBarrier& b) {
  asm volatile("s_waitcnt vmcnt(0)" ::: "memory");
  __syncthreads();
  if (threadIdx.x == 0) {
    unsigned* bar = b.bar;
    __builtin_amdgcn_s_waitcnt(0);
    unsigned nloc = b.st[0], nx = b.st[1];
    if (nloc == 0u) { xcd_barrier_complete(bar, b.x, nloc, nx); b.st[0] = nloc; b.st[1] = nx; }
    const unsigned old = xb_add(&bar[XB_XSUB(b.x)], 1u);
    const unsigned gen = old / nloc;
    if (old + 1u == (gen + 1u) * nloc) {
      __builtin_amdgcn_fence(__ATOMIC_RELEASE, "agent");
      asm volatile("s_waitcnt vmcnt(0)" ::: "memory");
      const unsigned og = xb_add(&bar[XB_TOP], 1u);
      const unsigned tg = og / nx;
      if (og + 1u == (tg + 1u) * nx) xb_add(&bar[XB_TOPGEN], 1u);
      else XB_SPIN(xb_ld(&bar[XB_TOPGEN]) == tg, bar);
      __builtin_amdgcn_fence(__ATOMIC_ACQUIRE, "agent");
      xb_add(&bar[XB_XGEN(b.x)], 1u);
      asm volatile("s_waitcnt vmcnt(0)" ::: "memory");
    } else {
      XB_SPIN(xb_ld(&bar[XB_XGEN(b.x)]) == gen, bar);
      __builtin_amdgcn_fence(__ATOMIC_ACQUIRE, "agent");
      asm volatile("s_waitcnt vmcnt(0)" ::: "memory");
    }
  }
  __syncthreads();
}

__device__ unsigned g_bar_counter = 0;
DI void grid_barrier(const unsigned G) {
  asm volatile("s_waitcnt vmcnt(0)" ::: "memory");
  __syncthreads();
  if (threadIdx.x == 0) {
    __builtin_amdgcn_fence(__ATOMIC_RELEASE, "agent");
    asm volatile("s_waitcnt vmcnt(0)" ::: "memory");
    const unsigned old = __hip_atomic_fetch_add(&g_bar_counter, 1u, __ATOMIC_RELAXED, __HIP_MEMORY_SCOPE_AGENT);
    const unsigned target = (old / G + 1u) * G;
    unsigned sp = 0;
    while ((int)(__hip_atomic_load(&g_bar_counter, __ATOMIC_RELAXED, __HIP_MEMORY_SCOPE_AGENT) - target) < 0) { __builtin_amdgcn_s_sleep(1); if (++sp > (1u << 24)) break; }
    __builtin_amdgcn_fence(__ATOMIC_ACQUIRE, "agent");
    asm volatile("s_waitcnt vmcnt(0)" ::: "memory");
  }
  __syncthreads();
}

#define KERNEL_HEAD extern __shared__ __attribute__((aligned(16))) unsigned char lds_raw[]; LAS unsigned char* lds = (LAS unsigned char*)lds_raw; const int bid = blockIdx.x, G = gridDim.x; \
  Ctx p; p.ws = karg<A_WS, unsigned char>(); p.out = karg<A_OUT, float>();
#ifdef MULTI_LAUNCH
__global__ void __launch_bounds__(NTHREADS, 2) k_prep(Params) { KERNEL_HEAD phase_prep(p, bid, G, lds); }
__global__ void __launch_bounds__(NTHREADS, 2) k_lnmod(Params) { KERNEL_HEAD (void)lds; phase_lnmod(p, bid, G); }
__global__ void __launch_bounds__(NTHREADS, 2) k_inproj(Params) { KERNEL_HEAD
  unsigned char* ws = p.ws;
  g8::DenseOrder S; S.init(T, N_INP, 1024, ws + WS_WIN, G, bid);
  EpiIn E{(bf16_t*)(ws + WS_QKPRE), (bf16_t*)(ws + WS_VM), (bf16_t*)(ws + WS_H), (bf16_t*)(ws + WS_CQ), (bf16_t*)(ws + WS_CKV), (unsigned char*)(ws + WS_KN), (float*)(ws + WS_GATES),
          (float*)(ws + WS_SSQQ), (float*)(ws + WS_SSQKV), (const float*)(ws + WS_ROPE), karg<A_GATEB>()};
  g8::gemm_phase(lds, (const char*)(ws + WS_U), 1024, S, E);
}
__global__ void __launch_bounds__(NTHREADS, 2) k_mid1(Params) { KERNEL_HEAD
  unsigned char* ws = p.ws;
  { g8::DenseOrder S; S.init(T, 768, 384, ws + WS_WUQ, G, bid); EpiUQ E{(unsigned char*)(ws + WS_QATT), (const float*)(ws + WS_SSQQ), (const float*)(ws + WS_ROPE)};
    g8::gemm_phase(lds, (const char*)(ws + WS_CQ), 384, S, E); }
}
__global__ void __launch_bounds__(NTHREADS, 2) k_mid2(Params) { KERNEL_HEAD
  unsigned char* ws = p.ws;
  { g8::DenseOrder S; S.init(T, 1024, 256, ws + WS_WUKV, G, bid); EpiUKV E{(unsigned char*)(ws + WS_KN), (unsigned char*)(ws + WS_VA), (const float*)(ws + WS_SSQKV)};
    g8::gemm_phase(lds, (const char*)(ws + WS_CKV), 256, S, E); }
}
__global__ void __launch_bounds__(NTHREADS, 2) k_mid3(Params) { KERNEL_HEAD
  for (int u = bid; u < 1024; u += G) { const int c = u & 127, bh = u >> 7; mlstmA_unit(p, bh >> 2, bh & 3, c, lds); }
}
__global__ void __launch_bounds__(NTHREADS, 2) k_scan_attn(Params) { KERNEL_HEAD phase_scan(p, bid, G); phase_attn(p, bid, G, lds); }
__global__ void __launch_bounds__(NTHREADS, 2) k_mlstm_out(Params) { KERNEL_HEAD
  for (int u = bid; u < 1024; u += G) { const int c = u & 127, bh = u >> 7; mlstmC_unit(p, bh >> 2, bh & 3, c, lds); }
  phase_hanorm(p, bid, G);
}
__global__ void __launch_bounds__(NTHREADS, 2) k_outproj(Params) { KERNEL_HEAD
  unsigned char* ws = p.ws;
  g8::DenseOrder S; S.init(T, 1024, 1024, ws + WS_WOUT, G, bid); EpiOut E{karg<A_X>(), (const float*)(ws + WS_MOD), (bf16_t*)p.out};
  g8::gemm_phase(lds, (const char*)(ws + WS_H), 1024, S, E);
}
__global__ void __launch_bounds__(NTHREADS, 2) k_route(Params) { KERNEL_HEAD phase_route(p, bid, G, lds); }
__global__ void __launch_bounds__(NTHREADS, 2) k_moe_gu(Params) { KERNEL_HEAD
  unsigned char* ws = p.ws; moe_table(p, lds);
  MoeOrderGU S; S.tstart = (const LAS int*)(lds + MOE_TS); S.cnt = (const int*)(ws + WS_CNT); S.G = G; S.c = bid; S.ltok = (const int*)(ws + WS_LTOK); S.Bt = (const char*)(ws + WS_WGU);
  EpiGU E{(unsigned char*)(ws + WS_HDN)};
  g8::gemm_phase(lds, (const char*)(ws + WS_U), 512  , S, E);
}
__global__ void __launch_bounds__(NTHREADS, 2) k_moe_dn(Params) { KERNEL_HEAD
  unsigned char* ws = p.ws; moe_table(p, lds);
  MoeOrderDN S; S.tstart = (const LAS int*)(lds + MOE_TS); S.cnt = (const int*)(ws + WS_CNT); S.G = G; S.c = bid; S.Bt = (const char*)(ws + WS_WDN);
  EpiDN E{(bf16_t*)(ws + WS_YBUF), (const float*)(ws + WS_LW)};
  g8::gemm_phase(lds, (const char*)(ws + WS_HDN), 256  , S, E);
}
__global__ void __launch_bounds__(NTHREADS, 2) k_final(Params) { KERNEL_HEAD moe_table(p, lds); phase_final(p, bid, G, lds); }

#endif

__global__ void __launch_bounds__(NTHREADS, 2) k_mega(Params) { KERNEL_HEAD
  unsigned char* ws = p.ws;
  if (bid == 0) for (int i = threadIdx.x; i < XCD_BAR_WORDS; i += NTHREADS) ((unsigned*)(ws + WS_BAR))[i] = 0u;
  if (threadIdx.x < 64) ((LAS unsigned*)(lds + LDS_BARST))[threadIdx.x] = 0u;
  XcdBarrier xbar; xbar.bar = (unsigned*)(ws + WS_BAR); xbar.x = 0; xbar.st = (volatile LAS unsigned*)(lds + LDS_BARST);
  bool xb_ready = false;
#define PHASE_SEP() do { asm volatile("" ::: "memory"); if (!xb_ready) { grid_barrier((unsigned)G); xbar = xcd_barrier_post((unsigned*)(ws + WS_BAR), (volatile LAS unsigned*)(lds + LDS_BARST)); xb_ready = true; } \
    else xcd_barrier(xbar); asm volatile("" ::: "memory"); } while (0)
#define REP(n) for (int rep_ = 0; rep_ < ((n) == DBL_PHASE ? 2 : 1); ++rep_)
  REP(0) phase_prep(p, bid, G, lds);
  PHASE_SEP();
#if MEGA_STOP == 1
  return;
#endif
  REP(1) phase_lnmod(p, bid, G);
  PHASE_SEP();
#if MEGA_STOP == 2
  return;
#endif
  REP(2) { g8::DenseOrder S; S.init(T, N_INP, 1024, ws + WS_WIN, G, bid);
    EpiIn E{(bf16_t*)(ws + WS_QKPRE), (bf16_t*)(ws + WS_VM), (bf16_t*)(ws + WS_H), (bf16_t*)(ws + WS_CQ), (bf16_t*)(ws + WS_CKV), (unsigned char*)(ws + WS_KN), (float*)(ws + WS_GATES),
            (float*)(ws + WS_SSQQ), (float*)(ws + WS_SSQKV), (const float*)(ws + WS_ROPE), karg<A_GATEB>()};
    g8::gemm_phase(lds, (const char*)(ws + WS_U), 1024, S, E);
    { const int first = S.nwg % G, nb = G - first;
      if (bid >= first) { const int tid = tid_fresh(), lane = tid & 63, wave = __builtin_amdgcn_readfirstlane(tid >> 6);
        prep_items(PREP_ITEMS - PREP_DEFER + (bid - first) * 8 + wave, PREP_ITEMS, nb * 8, lane, ws, (LAS float*)(lds + wave * 16384)); } } }
  PHASE_SEP();
#if MEGA_STOP == 3
  return;
#endif
  const bool mfirst = ((bid >> 3) & 1) != 0;
  if (mfirst) { for (int u = bid; u < 1024; u += G) { const int c = u & 127, bh = u >> 7; mlstmA_unit(p, bh >> 2, bh & 3, c, lds); } __syncthreads(); }
  { g8::DenseOrder S; S.init(T, 768, 384, ws + WS_WUQ, G, bid); EpiUQ E{(unsigned char*)(ws + WS_QATT), (const float*)(ws + WS_SSQQ), (const float*)(ws + WS_ROPE)};
    g8::gemm_phase(lds, (const char*)(ws + WS_CQ), 384, S, E); }
  __syncthreads();
  { g8::DenseOrder S; S.init(T, 1024, 256, ws + WS_WUKV, G, bid); EpiUKV E{(unsigned char*)(ws + WS_KN), (unsigned char*)(ws + WS_VA), (const float*)(ws + WS_SSQKV)};
    g8::gemm_phase(lds, (const char*)(ws + WS_CKV), 256, S, E); }
  __syncthreads();
  if (!mfirst) { for (int u = bid; u < 1024; u += G) { const int c = u & 127, bh = u >> 7; mlstmA_unit(p, bh >> 2, bh & 3, c, lds); } }
  PHASE_SEP();
#if MEGA_STOP == 4
  return;
#endif
  phase_scan(p, bid, G);
  REP(4) phase_attn(p, bid, G, lds);
  PHASE_SEP();
#if MEGA_STOP == 5
  return;
#endif
#if DBL_PHASE == 5
  for (int u = bid; u < 1024; u += G) { const int c = u & 127, bh = u >> 7; mlstmC_unit<true>(p, bh >> 2, bh & 3, c, lds); }
#endif
#if DBL_PHASE == 55
  phase_hanorm<true>(p, bid, G);
#endif
  for (int u = bid; u < 1024; u += G) { const int c = u & 127, bh = u >> 7; mlstmC_unit(p, bh >> 2, bh & 3, c, lds); }
  phase_hanorm(p, bid, G);
  PHASE_SEP();
#if MEGA_STOP == 6
  return;
#endif
  REP(6) { g8::DenseOrder S; S.init(T, 1024, 1024, ws + WS_WOUT, G, bid); EpiOut E{karg<A_X>(), (const float*)(ws + WS_MOD), (bf16_t*)p.out};
    g8::gemm_phase(lds, (const char*)(ws + WS_H), 1024, S, E); }
  PHASE_SEP();
#if MEGA_STOP == 7
  return;
#endif
#if DBL_PHASE == 7
  phase_route<true>(p, bid, G, lds);
#endif
  phase_route(p, bid, G, lds);
  PHASE_SEP();
#if MEGA_STOP == 8
  return;
#endif
  moe_table(p, lds);
  REP(8) { MoeOrderGU S; S.tstart = (const LAS int*)(lds + MOE_TS); S.cnt = (const int*)(ws + WS_CNT); S.G = G; S.c = bid; S.ltok = (const int*)(ws + WS_LTOK); S.Bt = (const char*)(ws + WS_WGU);
    EpiGU E{(unsigned char*)(ws + WS_HDN)};
    g8::gemm_phase(lds, (const char*)(ws + WS_U), 512  , S, E); }
  PHASE_SEP();
#if MEGA_STOP == 9
  return;
#endif
  REP(9) { MoeOrderDN S; S.tstart = (const LAS int*)(lds + MOE_TS); S.cnt = (const int*)(ws + WS_CNT); S.G = G; S.c = bid; S.Bt = (const char*)(ws + WS_WDN);
    EpiDN E{(bf16_t*)(ws + WS_YBUF), (const float*)(ws + WS_LW)};
    g8::gemm_phase(lds, (const char*)(ws + WS_HDN), 256  , S, E); }
  PHASE_SEP();
#if MEGA_STOP == 10
  return;
#endif
#if DBL_PHASE == 10
  phase_final<true>(p, bid, G, lds);
#endif
  phase_final(p, bid, G, lds);
#undef REP
#undef PHASE_SEP
}

#ifdef PROBE_OFF
__global__ void __launch_bounds__(NTHREADS, 2) k_probe(Params p, size_t off, size_t n, int is_f32, int from_out) {
  const unsigned char* base = from_out ? (const unsigned char*)p.out : p.ws + off;
  for (size_t i = (size_t)blockIdx.x * NTHREADS + threadIdx.x; i < (size_t)T * D; i += (size_t)gridDim.x * NTHREADS) {
    const size_t j = i % n; float v = is_f32 ? ((const float*)base)[j] : bf2f(((const unsigned short*)base)[j]);
    if (!(fabsf(v) < 1e30f)) v = 777.f;
    if (from_out) { if (j != i) break; ((float*)p.out)[i] = v; } else p.out[i] = v;
  }
}
#endif
extern "C" void kernel_launch(void* const* d_in, const int* in_sizes, int n_in, void* d_out, int out_size, void* d_ws, size_t ws_size, hipStream_t stream) {
  static int ok = 0, grid = 256;
  typedef void (*kfn)(Params);
#ifndef MULTI_LAUNCH
  const kfn kernels[] = {k_mega};
#else
  const kfn kernels[] = {k_prep, k_lnmod, k_inproj, k_mid1, k_mid2, k_mid3, k_scan_attn, k_mlstm_out, k_outproj, k_route, k_moe_gu, k_moe_dn, k_final};
#endif
  if (ok == 0) {
    if (n_in != 27 || in_sizes[0] != T * D || out_size != T * D || ws_size < WS_END) { fprintf(stderr, "kernel_launch: unexpected shapes (n_in %d, in0 %d, out %d, ws %zu)\n", n_in, n_in > 0 ? in_sizes[0] : -1, out_size, ws_size); ok = -1; return; }
    for (kfn k : kernels) if (hipFuncSetAttribute((const void*)k, hipFuncAttributeMaxDynamicSharedMemorySize, LDS_BYTES) != hipSuccess) { fprintf(stderr, "kernel_launch: hipFuncSetAttribute failed\n"); ok = -1; return; }
    int dev = 0, cus = 0, per_cu = 0;
    if (hipGetDevice(&dev) != hipSuccess || hipDeviceGetAttribute(&cus, hipDeviceAttributeMultiprocessorCount, dev) != hipSuccess) { fprintf(stderr, "kernel_launch: device query failed\n"); ok = -1; return; }
    if (hipOccupancyMaxActiveBlocksPerMultiprocessor(&per_cu, (const void*)kernels[0], NTHREADS, LDS_BYTES) != hipSuccess || per_cu < 1) { fprintf(stderr, "kernel_launch: occupancy query says %d blocks/CU\n", per_cu); (void)hipGetLastError(); per_cu = 1; }
    grid = cus < 256 ? cus : 256;
    fprintf(stderr, "kernel_launch: %d CUs, %d blocks/CU by the occupancy query, grid %d\n", cus, per_cu, grid);
    ok = 1;
  }
  if (ok < 0) return;
  Params p{};
  p.x = (const float*)d_in[0]; p.c = (const float*)d_in[1]; p.pos = (const int*)d_in[2]; p.w_ada = (const float*)d_in[3]; p.b_ada = (const float*)d_in[4]; p.w_in = (const float*)d_in[5];
  p.conv_w = (const float*)d_in[6]; p.conv_b = (const float*)d_in[7]; p.gate_b = (const float*)d_in[8]; p.mh_g = (const float*)d_in[9]; p.qn_g = (const float*)d_in[10]; p.kvn_g = (const float*)d_in[11];
  p.w_uq = (const float*)d_in[12]; p.w_ukv = (const float*)d_in[13]; p.an_g = (const float*)d_in[14]; p.w_out = (const float*)d_in[15]; p.ln1_g = (const float*)d_in[16]; p.ln1_b = (const float*)d_in[17];
  p.w_rg = (const float*)d_in[18]; p.b_rg = (const float*)d_in[19]; p.w_re = (const float*)d_in[20]; p.b_re = (const float*)d_in[21]; p.w_gate = (const float*)d_in[22]; p.w_up = (const float*)d_in[23];
  p.w_down = (const float*)d_in[24]; p.ln2_g = (const float*)d_in[25]; p.ln2_b = (const float*)d_in[26];
  p.out = (float*)d_out; p.ws = (unsigned char*)d_ws;
#ifndef NKERN
#define NKERN 6
#endif
  { int ik = 0; for (kfn k : kernels) { if (ik++ >= NKERN) break; hipLaunchKernelGGL(k, dim3(grid), dim3(NTHREADS), LDS_BYTES, stream, p); } }
#ifdef PROBE_OFF
  hipLaunchKernelGGL(k_probe, dim3(1024), dim3(NTHREADS), 0, stream, p, (size_t)(PROBE_OFF), (size_t)(PROBE_N), PROBE_F32, 0);
#endif
  const hipError_t le = hipPeekAtLastError();
  if (le != hipSuccess) fprintf(stderr, "kernel_launch: launch failed: %s\n", hipGetErrorName(le));
}
```

```cpp
#define NKERN 99
#ifndef MEGA_STOP
#define MEGA_STOP 0
#endif
#ifndef DBL_PHASE
#define DBL_PHASE -1
#endif
#include <hip/hip_runtime.h>
#include <cstdio>
#include <cstdint>
#include <cmath>

#define DI __device__ __forceinline__
#define LAS __attribute__((address_space(3)))
typedef unsigned short bf16_t;
typedef short bf16x8 __attribute__((ext_vector_type(8)));
typedef short s16x4 __attribute__((ext_vector_type(4)));
typedef float f32x4 __attribute__((ext_vector_type(4)));
typedef float f32x2 __attribute__((ext_vector_type(2)));
typedef float f32x16 __attribute__((ext_vector_type(16)));
typedef unsigned u32x4 __attribute__((ext_vector_type(4)));
typedef unsigned u32x2 __attribute__((ext_vector_type(2)));

constexpr int BATCH = 2, SEQ = 16384, T = BATCH * SEQ, D = 1024;
constexpr int NCH = SEQ / 128;
constexpr int N_IN = 2768, N_INP = 2816;
constexpr int NEXP = 32;
constexpr float LN_EPS = 1e-5f, RMS_EPS = 1e-6f;
constexpr float ALPHA = 1.189207115002721f;
constexpr float LOG2E = 1.4426950408889634f;
constexpr float QSCALE = 0.07216878364870323f * LOG2E * 16.f;
constexpr int NTHREADS = 512;
constexpr int LDS_BYTES = 148 * 1024;

constexpr size_t MiB = 1u << 20;
constexpr size_t WS_WIN = 0, WS_WUQ = 6 * MiB, WS_WUKV = 7 * MiB, WS_WOUT = 8 * MiB, WS_WGU = 10 * MiB, WS_WDN = 74 * MiB;
constexpr size_t WS_MOD = 106 * MiB, WS_CNT = 106 * MiB + 65536, WS_ROPE = 107 * MiB, WS_GATES = 115 * MiB, WS_GVEC = 117 * MiB;
constexpr size_t WS_SSQQ = 120 * MiB, WS_SSQKV = 122 * MiB, WS_NVEC = 123 * MiB, WS_SCAL = 124 * MiB, WS_TOKE = 125 * MiB, WS_TOKP = 125 * MiB + 512 * 1024;
constexpr size_t WS_U = 128 * MiB, WS_H = 192 * MiB, WS_QKPRE = 256 * MiB, WS_VM = 320 * MiB, WS_CQ = 352 * MiB, WS_CKV = 376 * MiB;
constexpr size_t WS_KROPE = 392 * MiB, WS_QATT = 396 * MiB, WS_KN = 444 * MiB, WS_VA = 476 * MiB, WS_END = 512 * MiB;
constexpr size_t WS_BAR = 106 * MiB + 131072, CTL_ZERO_OFF = WS_CNT, CTL_ZERO_BYTES = 131072;
constexpr int LDS_BARST = LDS_BYTES - 256;
constexpr size_t WS_LTOK = 256 * MiB, WS_LW = 260 * MiB, WS_HDN = 264 * MiB, WS_YBUF = 336 * MiB;
constexpr int MAXTILES = 288;
constexpr int CNT_STRIDE = 64;
constexpr size_t WS_WRT = 126 * MiB;

struct Params {
  const float* x; const float* c; const int* pos; const float* w_ada; const float* b_ada; const float* w_in; const float* conv_w; const float* conv_b;
  const float* gate_b; const float* mh_g; const float* qn_g; const float* kvn_g; const float* w_uq; const float* w_ukv; const float* an_g; const float* w_out;
  const float* ln1_g; const float* ln1_b; const float* w_rg; const float* b_rg; const float* w_re; const float* b_re; const float* w_gate; const float* w_up;
  const float* w_down; const float* ln2_g; const float* ln2_b;
  float* out; unsigned char* ws;
};

enum { A_X = 0, A_C, A_POS, A_WADA, A_BADA, A_WIN, A_CONVW, A_CONVB, A_GATEB, A_MHG, A_QNG, A_KVNG, A_WUQ, A_WUKV, A_ANG, A_WOUT, A_LN1G, A_LN1B, A_WRG, A_BRG, A_WRE, A_BRE,
       A_WGATE, A_WUP, A_WDOWN, A_LN2G, A_LN2B, A_OUT, A_WS };
template <int IDX, class Tp = const float> __device__ __forceinline__ Tp* karg() {
  const unsigned long long k = (unsigned long long)__builtin_amdgcn_kernarg_segment_ptr();
  unsigned long long v;
  asm volatile("s_load_dwordx2 %0, %1, %2\n\ts_waitcnt lgkmcnt(0)" : "=s"(v) : "s"(k), "i"(IDX * 8) : "memory");
  return (Tp*)v;
}
struct Ctx { unsigned char* ws; float* out; };
template <class Tg> __device__ __forceinline__ Tg* as_global(Tg* q) { return (Tg*)(__attribute__((address_space(1))) Tg*)(unsigned long long)q; }
DI unsigned cvtpk(float lo, float hi) { unsigned r; asm volatile("v_cvt_pk_bf16_f32 %0, %1, %2" : "=v"(r) : "v"(lo), "v"(hi)); return r; }
DI unsigned short f2bf(float f) { unsigned u = __float_as_uint(f); return (unsigned short)((u + 0x7fffu + ((u >> 16) & 1u)) >> 16); }
typedef int v8i __attribute__((ext_vector_type(8)));
typedef int v4i_ __attribute__((ext_vector_type(4)));
DI u32x2 cvt8(f32x4 a, f32x4 b) {
  int w0 = __builtin_amdgcn_cvt_pk_fp8_f32(a[0], a[1], 0, false); w0 = __builtin_amdgcn_cvt_pk_fp8_f32(a[2], a[3], w0, true);
  int w1 = __builtin_amdgcn_cvt_pk_fp8_f32(b[0], b[1], 0, false); w1 = __builtin_amdgcn_cvt_pk_fp8_f32(b[2], b[3], w1, true);
  return (u32x2){(unsigned)w0, (unsigned)w1};
}
DI float bf2f(unsigned short v) { return __uint_as_float(((unsigned)v) << 16); }
DI float bflo(unsigned w) { return __uint_as_float(w << 16); }
DI float bfhi(unsigned w) { return __uint_as_float(w & 0xffff0000u); }
DI int tid_fresh() { int t = threadIdx.x; asm volatile("" : "+v"(t)); return t; }
DI float sigmoidf_(float x) { return 1.f / (1.f + __expf(-x)); }
DI float siluf_(float x) { return x * __builtin_amdgcn_rcpf(1.f + __expf(-x)); }
DI float siluf_rcp(float x) { return x * __builtin_amdgcn_rcpf(1.f + __expf(-x)); }
DI float logsigmoidf_(float x) { return fminf(x, 0.f) - log1pf(__expf(-fabsf(x))); }
DI int crow(int r, int hi) { return (r & 3) + 8 * (r >> 2) + 4 * hi; }
#define SBAR() __builtin_amdgcn_sched_barrier(0)
#define KSWZ(row, colB) ((row) * 256 + ((colB) ^ (((row) & 15) << 4)))
#define KRSWZ(row, colB) ((row) * 128 + ((colB) ^ ((((row) >> 1) & 7) << 4)))
#define MFMA32(a, b, c) __builtin_amdgcn_mfma_f32_32x32x16_bf16((a), (b), (c), 0, 0, 0)

DI int v_st(int k, int c) { const int kk = (k & ~0xC) | ((k & 4) << 1) | ((k & 8) >> 1); return ((kk >> 3) * 4 + (c >> 5)) * 512 + ((kk & 7) * 32 + (c & 31)) * 2; }
DI int v_rd_base(int lane) { return ((lane & 3) << 3) | (((lane >> 2) & 3) << 6) | (((lane >> 4) & 1) << 5) | (((lane >> 5) & 1) << 8); }
constexpr int v_rd_off(int d0, int ks, int half) { return d0 * 512 + ks * 4096 + half * 2048; }
template <int OFF> DI s16x4 tr_read(int vb) {
  s16x4 r; asm volatile("ds_read_b64_tr_b16 %0, %1 offset:%2" : "=&v"(r) : "v"(vb), "i"(OFF) : "memory"); return r;
}
#define PKLH(L, H) (bf16x8){L[0], L[1], L[2], L[3], H[0], H[1], H[2], H[3]}
template <int KS> DI bf16x8 tr_frag_nowait(int vb, s16x4& l, s16x4& h) { l = tr_read<v_rd_off(0, KS, 0)>(vb); h = tr_read<v_rd_off(0, KS, 1)>(vb); return PKLH(l, h); }
template <int D0> DI void pv_one(f32x16& od, int vb, bf16x8 pa0, bf16x8 pa1, bf16x8 pa2, bf16x8 pa3) {
  const s16x4 l0 = tr_read<v_rd_off(D0, 0, 0)>(vb), h0 = tr_read<v_rd_off(D0, 0, 1)>(vb), l1 = tr_read<v_rd_off(D0, 1, 0)>(vb), h1 = tr_read<v_rd_off(D0, 1, 1)>(vb);
  const s16x4 l2 = tr_read<v_rd_off(D0, 2, 0)>(vb), h2 = tr_read<v_rd_off(D0, 2, 1)>(vb), l3 = tr_read<v_rd_off(D0, 3, 0)>(vb), h3 = tr_read<v_rd_off(D0, 3, 1)>(vb);
  asm volatile("s_waitcnt lgkmcnt(0)" ::: "memory"); SBAR();
  od = MFMA32(pa0, PKLH(l0, h0), od); od = MFMA32(pa1, PKLH(l1, h1), od); od = MFMA32(pa2, PKLH(l2, h2), od); od = MFMA32(pa3, PKLH(l3, h3), od);
}
DI void pv_d0(f32x16* o, int vb, bf16x8 pa0, bf16x8 pa1, bf16x8 pa2, bf16x8 pa3) {
  pv_one<0>(o[0], vb, pa0, pa1, pa2, pa3); pv_one<1>(o[1], vb, pa0, pa1, pa2, pa3); pv_one<2>(o[2], vb, pa0, pa1, pa2, pa3); pv_one<3>(o[3], vb, pa0, pa1, pa2, pa3);
}
DI void pack_p(const f32x16& p0, const f32x16& p1, bf16x8& pa0, bf16x8& pa1, bf16x8& pa2, bf16x8& pa3) {
#define PK4(P, BASE, OUT) do { unsigned a0 = cvtpk(P[BASE + 0], P[BASE + 1]), a1 = cvtpk(P[BASE + 2], P[BASE + 3]);   \
    unsigned b0 = cvtpk(P[BASE + 4], P[BASE + 5]), b1 = cvtpk(P[BASE + 6], P[BASE + 7]);                              \
    auto r0 = __builtin_amdgcn_permlane32_swap(a0, b0, false, false); auto r1 = __builtin_amdgcn_permlane32_swap(a1, b1, false, false); \
    u32x4 w = {r0[0], r1[0], r0[1], r1[1]}; OUT = *reinterpret_cast<bf16x8*>(&w); } while (0)
  PK4(p0, 0, pa0); PK4(p0, 8, pa1); PK4(p1, 0, pa2); PK4(p1, 8, pa3);
#undef PK4
}
DI float half_swap_sum(float v) { auto rr = __builtin_amdgcn_permlane32_swap(__float_as_uint(v), __float_as_uint(v), false, false); return __uint_as_float(rr[0]) + __uint_as_float(rr[1]); }
template <int CTRL> DI float dpp_mov(float v) { return __int_as_float(__builtin_amdgcn_update_dpp(0, __float_as_int(v), CTRL, 0xF, 0xF, true)); }
DI float row_sum16(float v) { v += dpp_mov<0xB1>(v); v += dpp_mov<0x4E>(v); v += dpp_mov<0x141>(v); v += dpp_mov<0x140>(v); return v; }
DI float xsum16(float v) { auto rr = __builtin_amdgcn_permlane16_swap(__float_as_uint(v), __float_as_uint(v), false, false); return __uint_as_float(rr[0]) + __uint_as_float(rr[1]); }
DI float half_sum32(float v) { return xsum16(row_sum16(v)); }
DI float wave_sum(float v) { return half_swap_sum(half_sum32(v)); }
DI float half_swap_max(float v) { auto rr = __builtin_amdgcn_permlane32_swap(__float_as_uint(v), __float_as_uint(v), false, false); return fmaxf(__uint_as_float(rr[0]), __uint_as_float(rr[1])); }

namespace g8 {
constexpr int BM = 256, BK = 64, HALF = 128, HTB = HALF * BK * 2, STAGE_BYTES = 8 * HTB;
DI int lds_byte(int r, int c) { const int st = (r >> 4) * 2 + (c >> 5), rr = r & 15, cc = c & 31, ob = rr * 64 + cc * 2; return st * 1024 + (ob ^ (((ob >> 9) & 1) << 5)); }
DI void stage_rc(int b, int& R, int& C) { const int st = b / 1024, sb = b % 1024, swz = sb ^ (((sb >> 9) & 1) << 5); R = (st >> 1) * 16 + swz / 64; C = (st & 1) * 32 + (swz % 64) / 2; }
DI int perm32(int rho) { const int n = rho >> 4, i = rho & 15; return 8 * (i >> 2) + 4 * n + (i & 3); }
struct Unit { int pm, pn, e, j; };

struct NoPre {};
template <class E, class = void> struct PreOf { typedef NoPre type; static constexpr bool has = false; };
template <class E> struct PreOf<E, std::void_t<typename E::Pre>> { typedef typename E::Pre type; static constexpr bool has = true; };
template <class Epi, class Sched>
DI void gemm_phase(LAS unsigned char* lds, const char* Abase, const int Kc, const Sched& S, const Epi& E) {
  constexpr bool GATHER = Sched::GATHER, FP8 = Epi::FP8; constexpr int NBJ = Epi::NBJ;
  int K = Kc; asm volatile("" : "+s"(K));
  const int tid = tid_fresh(), wid = __builtin_amdgcn_readfirstlane(tid >> 6), lane = tid & 63, wr = wid >> 2, wc = wid & 3, fr = lane & 15, fq = lane >> 4;
  const int nt = K / BK;
  unsigned voffA[2], voffB[2];
#pragma unroll
  for (int i = 0; i < 2; ++i) { int R, C; stage_rc(tid * 16 + i * 8192, R, C); const int Rb = Epi::PERM ? ((R & ~31) + perm32(R & 31)) : R; voffA[i] = (unsigned)(R * K + C) * 2u; voffB[i] = (unsigned)(Rb * K + C) * 2u; }
  const size_t kstep = (size_t)(BK * 2);
  const size_t hstepB = (size_t)HALF * K * 2;
  const unsigned ldsw = (unsigned)wid * 1024u;
  const int aoff = lds_byte(wr * 64 + fr, fq * 8), boff = lds_byte(wc * 32 + fr, fq * 8);
#define G8_SA(b, h) (((b) * 2 + (h)) * HTB)
#define G8_SB(b, h) ((4 + (b) * 2 + (h)) * HTB)
#define G8_STAGEB(bufoff, gptr) do { _Pragma("unroll") for (int _i = 0; _i < 2; ++_i) \
    __builtin_amdgcn_global_load_lds((const unsigned*)((const char*)(gptr) + voffB[_i]), (LAS unsigned*)(lds + (bufoff) + ldsw + _i * 8192), 16, 0, 0); } while (0)
#define G8_STAGEA(bufoff, kb, NXT, h) do { _Pragma("unroll") for (int _i = 0; _i < 2; ++_i) { const char* _src; \
    if constexpr (GATHER) _src = Abase + (size_t)(kb) + (size_t)((NXT) ? o2[h][_i] : cuA[h][_i]); else _src = ((NXT) ? a2b : cA) + (size_t)(kb) + (size_t)(h) * hstepB + voffA[_i]; \
    __builtin_amdgcn_global_load_lds((const unsigned*)_src, (LAS unsigned*)(lds + (bufoff) + ldsw + _i * 8192), 16, 0, 0); } } while (0)
#define G8_LD8(ptr) __builtin_shufflevector(*(const LAS v4i_*)(ptr), *(const LAS v4i_*)((ptr) + 1024), 0, 1, 2, 3, 4, 5, 6, 7)
#define G8_LDA(dst, b, h) do { if constexpr (FP8) { _Pragma("unroll") for (int m = 0; m < 4; ++m) dst##8[m] = G8_LD8(lds + G8_SA(b, h) + aoff + m * 2048); } \
    else { _Pragma("unroll") for (int m = 0; m < 4; ++m) _Pragma("unroll") for (int k = 0; k < 2; ++k) dst[m][k] = *(const LAS bf16x8*)(lds + G8_SA(b, h) + aoff + m * 2048 + k * 1024); } } while (0)
#define G8_LDB(dst, b, h) do { if constexpr (FP8) { _Pragma("unroll") for (int n = 0; n < 2; ++n) dst##8[n] = G8_LD8(lds + G8_SB(b, h) + boff + n * 2048); } \
    else { _Pragma("unroll") for (int n = 0; n < 2; ++n) _Pragma("unroll") for (int k = 0; k < 2; ++k) dst[n][k] = *(const LAS bf16x8*)(lds + G8_SB(b, h) + boff + n * 2048 + k * 1024); } } while (0)
#define G8_MMA(ai, bj, At, Bt) do { __builtin_amdgcn_s_setprio(1); \
    if constexpr (FP8) { _Pragma("unroll") for (int m = 0; m < 4; ++m) _Pragma("unroll") for (int n = 0; n < 2; ++n) \
        acc[ai][bj][m][n] = __builtin_amdgcn_mfma_scale_f32_16x16x128_f8f6f4(Bt##8[n], At##8[m], acc[ai][bj][m][n], 0, 0, 0, 122, 0, Epi::ASCALE); } \
    else { _Pragma("unroll") for (int m = 0; m < 4; ++m) _Pragma("unroll") for (int n = 0; n < 2; ++n) _Pragma("unroll") for (int k = 0; k < 2; ++k) \
        acc[ai][bj][m][n] = __builtin_amdgcn_mfma_f32_16x16x32_bf16(Bt[n][k], At[m][k], acc[ai][bj][m][n], 0, 0, 0); } \
    __builtin_amdgcn_s_setprio(0); } while (0)
#define G8_WAIT_V(n) asm volatile("s_waitcnt vmcnt(" #n ")" ::: "memory")
#define G8_WAIT_M do { if constexpr (NBJ == 2) G8_WAIT_V(8); else G8_WAIT_V(6); } while (0)
#define G8_WAIT_L(n) asm volatile("s_waitcnt lgkmcnt(" #n ")" ::: "memory")
#define G8_BAR __builtin_amdgcn_s_barrier()
#define G8_SCHED __builtin_amdgcn_sched_barrier(0)
#define G8_GOFF(dst, u) do { _Pragma("unroll") for (int _i = 0; _i < 2; ++_i) { int _R, _C; stage_rc(tid * 16 + _i * 8192, _R, _C); \
    _Pragma("unroll") for (int _h = 0; _h < 2; ++_h) dst[_h][_i] = S.a_off(u, _R + 128 * _h) + (unsigned)_C * 2u; } } while (0)
  Unit cur, nxt; int ui = 0;
  if (!S.next(0, cur)) return;
  typename PreOf<Epi>::type pre; (void)pre;
  if constexpr (PreOf<Epi>::has) E.pre(cur, wr, fr, pre);
  f32x4 acc[2][NBJ][4][2];
#pragma unroll
  for (int a = 0; a < 2; ++a)
#pragma unroll
    for (int b = 0; b < NBJ; ++b)
#pragma unroll
      for (int m = 0; m < 4; ++m)
#pragma unroll
        for (int n = 0; n < 2; ++n) acc[a][b][m][n] = (f32x4){0.f, 0.f, 0.f, 0.f};
  bf16x8 At[4][2], B0[2][2], B1[2][2]; v8i At8[4], B08[2], B18[2]; (void)At; (void)B0; (void)B1; (void)At8; (void)B08; (void)B18;
  unsigned cuA[2][2], nxA[2][2], o2[2][2];
  const char* cA = Abase; const char* nA = Abase; const char* a2b = Abase;
  if constexpr (GATHER) { G8_GOFF(cuA, cur); } else { cA = Abase + S.a_off(cur, 0); }
  const char* cB = S.b_base(cur);
  (void)voffA; (void)nxA; (void)o2; (void)nA; (void)a2b;
  G8_STAGEB(G8_SB(0, 0), cB); if constexpr (NBJ == 2) G8_STAGEB(G8_SB(0, 1), cB + hstepB); G8_STAGEA(G8_SA(0, 0), 0, false, 0); G8_STAGEA(G8_SA(0, 1), 0, false, 1);
  if (wr == 1) G8_BAR;
  G8_WAIT_V(2); G8_BAR;
  G8_STAGEB(G8_SB(1, 0), cB + kstep); G8_STAGEA(G8_SA(1, 0), kstep, false, 0); if constexpr (NBJ == 2) G8_STAGEB(G8_SB(1, 1), cB + hstepB + kstep);
  if constexpr (NBJ == 2) G8_WAIT_V(6); else G8_WAIT_V(4);
  G8_BAR;
  for (;;) {
    const bool has_next = S.next(ui + 1, nxt);
    const char* nB = cB;
    if (has_next) {
      nB = S.b_base(nxt);
      if constexpr (GATHER) { G8_GOFF(nxA, nxt); } else { nA = Abase + S.a_off(nxt, 0); }
    } else {
      if constexpr (GATHER) {
#pragma unroll
        for (int h = 0; h < 2; ++h)
#pragma unroll
          for (int i = 0; i < 2; ++i) nxA[h][i] = cuA[h][i];
      } else nA = cA;
    }
    for (int t = 0; t < nt; t += 2) {
      const bool last = (t == nt - 2);
      const size_t k1 = (size_t)(t + 1) * kstep;
      const size_t k2 = last ? 0 : (size_t)(t + 2) * kstep, k3 = k2 + kstep;
      if constexpr (GATHER) {
#pragma unroll
        for (int h = 0; h < 2; ++h)
#pragma unroll
          for (int i = 0; i < 2; ++i) o2[h][i] = last ? nxA[h][i] : cuA[h][i];
      } else a2b = last ? nA : cA;
      const char* b2 = last ? nB : cB + (size_t)(t + 2) * kstep; const char* b3 = b2 + kstep;
      G8_LDB(B0, 0, 0); if constexpr (NBJ == 2) G8_LDB(B1, 0, 1); G8_SCHED; G8_LDA(At, 0, 0); G8_STAGEA(G8_SA(1, 1), k1, false, 1);
      G8_WAIT_M; G8_WAIT_L(0); G8_BAR; G8_MMA(0, 0, At, B0); if constexpr (NBJ == 2) G8_MMA(0, 1, At, B1); G8_BAR; G8_SCHED;
      G8_LDA(At, 0, 1); G8_STAGEB(G8_SB(0, 0), b2); if constexpr (NBJ == 2) G8_STAGEB(G8_SB(0, 1), b2 + hstepB); G8_STAGEA(G8_SA(0, 0), k2, true, 0);
      G8_WAIT_M; G8_WAIT_L(0); G8_BAR; G8_MMA(1, 0, At, B0); if constexpr (NBJ == 2) G8_MMA(1, 1, At, B1); G8_BAR; G8_SCHED;
      G8_LDB(B0, 1, 0); if constexpr (NBJ == 2) G8_LDB(B1, 1, 1); G8_SCHED; G8_LDA(At, 1, 0); G8_STAGEA(G8_SA(0, 1), k2, true, 1);
      G8_WAIT_M; G8_WAIT_L(0); G8_BAR; G8_MMA(0, 0, At, B0); if constexpr (NBJ == 2) G8_MMA(0, 1, At, B1); G8_BAR; G8_SCHED;
      G8_LDA(At, 1, 1); G8_STAGEB(G8_SB(1, 0), b3); if constexpr (NBJ == 2) G8_STAGEB(G8_SB(1, 1), b3 + hstepB); G8_STAGEA(G8_SA(1, 0), k3, true, 0);
      G8_WAIT_M; G8_WAIT_L(0); G8_BAR; G8_MMA(1, 0, At, B0); if constexpr (NBJ == 2) G8_MMA(1, 1, At, B1); G8_BAR; G8_SCHED;
    }
    if (wr == 0) G8_BAR;
    G8_SCHED; asm volatile("s_nop 15\n\ts_nop 7" ::: "memory"); G8_SCHED;
    if constexpr (PreOf<Epi>::has) E(acc, cur, wr, wc, fr, fq, pre); else E(acc, cur, wr, wc, fr, fq);
    if (!has_next) break;
#pragma unroll
    for (int a = 0; a < 2; ++a)
#pragma unroll
      for (int b = 0; b < NBJ; ++b)
#pragma unroll
        for (int m = 0; m < 4; ++m)
#pragma unroll
          for (int n = 0; n < 2; ++n) acc[a][b][m][n] = (f32x4){0.f, 0.f, 0.f, 0.f};
    cur = nxt; cB = nB; ++ui;
    if constexpr (PreOf<Epi>::has) E.pre(cur, wr, fr, pre);
    if constexpr (GATHER) {
#pragma unroll
      for (int h = 0; h < 2; ++h)
#pragma unroll
        for (int i = 0; i < 2; ++i) cuA[h][i] = nxA[h][i];
    } else cA = nA;
    if (wr == 1) G8_BAR;
  }
  G8_WAIT_V(0);
  G8_BAR;
#undef G8_SA
#undef G8_SB
#undef G8_STAGEA
#undef G8_STAGEB
#undef G8_LDA
#undef G8_LD8
#undef G8_WAIT_M
#undef G8_LDB
#undef G8_MMA
#undef G8_WAIT_V
#undef G8_WAIT_L
#undef G8_BAR
#undef G8_SCHED
#undef G8_GOFF
}

struct DenseOrder {
  static constexpr bool GATHER = false;
  int nM, nN, nwg, G, c, K; const char* Bt;
  DI void init(int M, int N, int K_, const void* Bt_, int G_, int c_) { nM = M / BM; nN = N / BM; nwg = nM * nN; G = G_; c = c_; K = K_; Bt = (const char*)Bt_; }
  DI bool next(int i, Unit& u) const {
    const long L = (long)i * G + c; if (L >= nwg) return false;
    int wgid = (int)L; { const int q = nwg / 8, r = nwg % 8, xcd = wgid % 8, off = wgid / 8; wgid = (xcd < r ? xcd * (q + 1) : r * (q + 1) + (xcd - r) * q) + off; }
    const int nig = 8 * nN, gid = wgid / nig, fm = gid * 8, gsz = (nM - fm) < 8 ? (nM - fm) : 8;
    u.pm = fm + ((wgid % nig) % gsz); u.pn = (wgid % nig) / gsz; u.e = 0; u.j = 0; return true;
  }
  DI unsigned a_off(const Unit& u, int R) const { return (unsigned)(u.pm * BM + R) * (unsigned)(K * 2); }
  DI const char* b_base(const Unit& u) const { return Bt + (size_t)u.pn * BM * K * 2; }
};

template <class Epi, class Sched>
DI void gemm_phase8(LAS unsigned char* lds, const char* Abase, const int Kc, const Sched& S, const Epi& E) {
  constexpr bool GATHER = Sched::GATHER;
  static_assert(Epi::FP8 && Epi::NBJ == 1, "fp8 256x128 units only");
  int K = Kc; asm volatile("" : "+s"(K));
  const int tid = tid_fresh(), wid = __builtin_amdgcn_readfirstlane(tid >> 6), lane = tid & 63, wr = wid >> 2, wc = wid & 3, fr = lane & 15, fq = lane >> 4;
  const int nt = K / BK;
  unsigned voffA[2], voffB[2];
#pragma unroll
  for (int i = 0; i < 2; ++i) { int R, C; stage_rc(tid * 16 + i * 8192, R, C); const int Rb = (R & ~31) + perm32(R & 31); voffA[i] = (unsigned)(R * K + C) * 2u; voffB[i] = (unsigned)(Rb * K + C) * 2u; }
  const size_t kstep = (size_t)(BK * 2), hstepA = (size_t)HALF * K * 2;
  const unsigned ldsw = (unsigned)wid * 1024u;
  const int aoff = lds_byte(wr * 64 + fr, fq * 8), boff = lds_byte(wc * 32 + fr, fq * 8);
  constexpr int SLOT = 3 * HTB;
#define P8_DMA(src, dstoff) __builtin_amdgcn_global_load_lds((const unsigned*)(src), (LAS unsigned*)(lds + (dstoff)), 16, 0, 0)
#define P8_STAGE(so, bptr, aptr, AO, kb) do { \
    _Pragma("unroll") for (int _i = 0; _i < 2; ++_i) P8_DMA((const char*)(bptr) + (size_t)(kb) + voffB[_i], (so) + 2 * HTB + ldsw + _i * 8192); \
    _Pragma("unroll") for (int _h = 0; _h < 2; ++_h) _Pragma("unroll") for (int _i = 0; _i < 2; ++_i) { const char* _src; \
      if constexpr (GATHER) _src = Abase + (size_t)(kb) + (size_t)AO[_h][_i]; else _src = (aptr) + (size_t)(kb) + (size_t)_h * hstepA + voffA[_i]; \
      P8_DMA(_src, (so) + _h * HTB + ldsw + _i * 8192); } } while (0)
#define P8_LD8(ptr) __builtin_shufflevector(*(const LAS v4i_*)(ptr), *(const LAS v4i_*)((ptr) + 1024), 0, 1, 2, 3, 4, 5, 6, 7)
#define P8_GOFF(dst, u) do { _Pragma("unroll") for (int _i = 0; _i < 2; ++_i) { int _R, _C; stage_rc(tid * 16 + _i * 8192, _R, _C); \
    _Pragma("unroll") for (int _h = 0; _h < 2; ++_h) dst[_h][_i] = S.a_off(u, _R + 128 * _h) + (unsigned)_C * 2u; } } while (0)
#define P8_WAIT_V(n) asm volatile("s_waitcnt vmcnt(" #n ")" ::: "memory")
#define P8_BAR __builtin_amdgcn_s_barrier()
#define P8_SCHED __builtin_amdgcn_sched_barrier(0)
  Unit cur, nxt; int ui = 0;
  if (!S.next(0, cur)) return;
  typename PreOf<Epi>::type pre; (void)pre;
  if constexpr (PreOf<Epi>::has) E.pre(cur, wr, fr, pre);
  f32x4 acc[2][1][4][2];
#pragma unroll
  for (int a = 0; a < 2; ++a)
#pragma unroll
    for (int m = 0; m < 4; ++m)
#pragma unroll
      for (int n = 0; n < 2; ++n) acc[a][0][m][n] = (f32x4){0.f, 0.f, 0.f, 0.f};
  unsigned cuA[2][2], nxA[2][2], o2[2][2];
  const char* cA = Abase; const char* nA = Abase; const char* a2 = Abase;
  if constexpr (GATHER) { P8_GOFF(cuA, cur); } else { cA = Abase + S.a_off(cur, 0); }
  const char* cB = S.b_base(cur);
  (void)voffA; (void)nxA; (void)o2; (void)nA; (void)a2; (void)cuA;
  if constexpr (GATHER) {
#pragma unroll
    for (int h = 0; h < 2; ++h)
#pragma unroll
      for (int i = 0; i < 2; ++i) o2[h][i] = cuA[h][i];
  }
  P8_STAGE(0, cB, cA, o2, 0); P8_STAGE(SLOT, cB, cA, o2, kstep);
  P8_WAIT_V(6); P8_BAR;
  if (wr == 1) P8_BAR;
  int rb = 0;
  for (;;) {
    const bool has_next = S.next(ui + 1, nxt);
    const char* nB = cB;
    if (has_next) {
      nB = S.b_base(nxt);
      if constexpr (GATHER) { P8_GOFF(nxA, nxt); } else { nA = Abase + S.a_off(nxt, 0); }
    } else {
      if constexpr (GATHER) {
#pragma unroll
        for (int h = 0; h < 2; ++h)
#pragma unroll
          for (int i = 0; i < 2; ++i) nxA[h][i] = cuA[h][i];
      } else nA = cA;
    }
    for (int t = 0; t < nt; ++t) {
      const bool nx = t + 2 >= nt;
      const size_t k2 = (size_t)(nx ? t + 2 - nt : t + 2) * kstep;
      if constexpr (GATHER) {
#pragma unroll
        for (int h = 0; h < 2; ++h)
#pragma unroll
          for (int i = 0; i < 2; ++i) o2[h][i] = nx ? nxA[h][i] : cuA[h][i];
      } else a2 = nx ? nA : cA;
      const char* b2 = nx ? nB : cB;
      const int rs2 = rb == 0 ? 2 : rb - 1;
      P8_STAGE(rs2 * SLOT, b2, a2, o2, k2);
      v8i B8[2], A0[4], A1[4];
      const LAS unsigned char* sl = lds + rb * SLOT;
#pragma unroll
      for (int n = 0; n < 2; ++n) B8[n] = P8_LD8(sl + 2 * HTB + boff + n * 2048);
#pragma unroll
      for (int m = 0; m < 4; ++m) { A0[m] = P8_LD8(sl + aoff + m * 2048); A1[m] = P8_LD8(sl + HTB + aoff + m * 2048); }
      P8_WAIT_V(6); asm volatile("s_waitcnt lgkmcnt(0)" ::: "memory"); P8_BAR; P8_SCHED;
      __builtin_amdgcn_s_setprio(1);
#pragma unroll
      for (int m = 0; m < 4; ++m)
#pragma unroll
        for (int n = 0; n < 2; ++n) {
          acc[0][0][m][n] = __builtin_amdgcn_mfma_scale_f32_16x16x128_f8f6f4(B8[n], A0[m], acc[0][0][m][n], 0, 0, 0, 122, 0, Epi::ASCALE);
          acc[1][0][m][n] = __builtin_amdgcn_mfma_scale_f32_16x16x128_f8f6f4(B8[n], A1[m], acc[1][0][m][n], 0, 0, 0, 122, 0, Epi::ASCALE);
        }
      __builtin_amdgcn_s_setprio(0);
      P8_BAR; P8_SCHED;
      rb = rb == 2 ? 0 : rb + 1;
    }
    if (wr == 0) P8_BAR;
    P8_SCHED; asm volatile("s_nop 15\n\ts_nop 7" ::: "memory"); P8_SCHED;
    if constexpr (PreOf<Epi>::has) E(acc, cur, wr, wc, fr, fq, pre); else E(acc, cur, wr, wc, fr, fq);
    if (!has_next) break;
#pragma unroll
    for (int a = 0; a < 2; ++a)
#pragma unroll
      for (int m = 0; m < 4; ++m)
#pragma unroll
        for (int n = 0; n < 2; ++n) acc[a][0][m][n] = (f32x4){0.f, 0.f, 0.f, 0.f};
    cur = nxt; cB = nB; ++ui;
    if constexpr (PreOf<Epi>::has) E.pre(cur, wr, fr, pre);
    if constexpr (GATHER) {
#pragma unroll
      for (int h = 0; h < 2; ++h)
#pragma unroll
        for (int i = 0; i < 2; ++i) cuA[h][i] = nxA[h][i];
    } else cA = nA;
    if (wr == 1) P8_BAR;
  }
  P8_WAIT_V(0);
  P8_BAR;
#undef P8_DMA
#undef P8_STAGE
#undef P8_LD8
#undef P8_GOFF
#undef P8_WAIT_V
#undef P8_BAR
#undef P8_SCHED
}
}
using g8::Unit;

struct EpiIn {
  static constexpr bool PERM = true, FP8 = false; static constexpr int NBJ = 2;
  bf16_t* qkpre; bf16_t* vm; bf16_t* hcat; bf16_t* cq; bf16_t* ckv; unsigned char* krope  ; float* gates; float* ssq_q; float* ssq_kv; const float* rope; const float* gate_b;
  DI void operator()(const f32x4 (&acc)[2][2][4][2], const Unit& u, int wr, int wc, int fr, int fq) const {
#pragma unroll
    for (int bj = 0; bj < 2; ++bj) {
      const int cw = u.pn * 256 + bj * 128 + wc * 32, c0 = cw + 8 * fq;
#pragma unroll
      for (int ai = 0; ai < 2; ++ai)
#pragma unroll
        for (int m = 0; m < 4; ++m) {
          const int row = u.pm * 256 + ai * 128 + wr * 64 + m * 16 + fr;
          const f32x4 v0 = acc[ai][bj][m][0], v1 = acc[ai][bj][m][1];
          if (cw < 1024) { u32x4 w = {cvtpk(v0[0], v0[1]), cvtpk(v0[2], v0[3]), cvtpk(v1[0], v1[1]), cvtpk(v1[2], v1[3])}; *(u32x4*)(qkpre + (size_t)row * 1024 + c0) = w; }
          else if (cw < 1536) { u32x4 w = {cvtpk(v0[0], v0[1]), cvtpk(v0[2], v0[3]), cvtpk(v1[0], v1[1]), cvtpk(v1[2], v1[3])}; *(u32x4*)(vm + (size_t)row * 512 + (c0 - 1024)) = w; }
          else if (cw < 2048) { u32x4 w = {cvtpk(sigmoidf_(v0[0]), sigmoidf_(v0[1])), cvtpk(sigmoidf_(v0[2]), sigmoidf_(v0[3])), cvtpk(sigmoidf_(v1[0]), sigmoidf_(v1[1])), cvtpk(sigmoidf_(v1[2]), sigmoidf_(v1[3]))};
                                *(u32x4*)(hcat + (size_t)row * 1024 + (c0 - 1536)) = w; }
          else if (cw < 2688) {
            u32x4 w = {cvtpk(v0[0], v0[1]), cvtpk(v0[2], v0[3]), cvtpk(v1[0], v1[1]), cvtpk(v1[2], v1[3])};
            float s = v0[0] * v0[0] + v0[1] * v0[1] + v0[2] * v0[2] + v0[3] * v0[3] + v1[0] * v1[0] + v1[1] * v1[1] + v1[2] * v1[2] + v1[3] * v1[3];
            s = half_swap_sum(xsum16(s));
            if (cw < 2432) { *(u32x4*)(cq + (size_t)row * 384 + (c0 - 2048)) = w; if (fq == 0) ssq_q[(size_t)row * 12 + ((cw - 2048) >> 5)] = s; }
            else { *(u32x4*)(ckv + (size_t)row * 256 + (c0 - 2432)) = w; if (fq == 0) ssq_kv[(size_t)row * 8 + ((cw - 2432) >> 5)] = s; }
          }
          else if (cw < 2752) {
            const int i0 = (c0 - 2688) >> 1;
            const f32x4 cs0 = *(const f32x4*)(rope + (size_t)row * 64 + 2 * i0), cs1 = *(const f32x4*)(rope + (size_t)row * 64 + 2 * i0 + 4);
            const float a0 = v0[0] * cs0[0] - v0[1] * cs0[1], b0 = v0[1] * cs0[0] + v0[0] * cs0[1];
            const float a1 = v0[2] * cs0[2] - v0[3] * cs0[3], b1 = v0[3] * cs0[2] + v0[2] * cs0[3];
            const float a2 = v1[0] * cs1[0] - v1[1] * cs1[1], b2 = v1[1] * cs1[0] + v1[0] * cs1[1];
            const float a3 = v1[2] * cs1[2] - v1[3] * cs1[3], b3 = v1[3] * cs1[2] + v1[2] * cs1[3];
            const u32x2 w = cvt8((f32x4){a0, b0, a1, b1}, (f32x4){a2, b2, a3, b3});
            const int b_ = row >> 14, s_ = row & (SEQ - 1);
#pragma unroll
            for (int hh = 0; hh < 4; ++hh) *(u32x2*)(krope + ((size_t)(b_ * 4 + hh) * SEQ + s_) * 192 + 128 + (c0 - 2688)) = w;
          }
          else if (cw == 2752) {
            if (fq < 2) { const f32x4 g0 = *(const f32x4*)(gate_b + 8 * fq), g1 = *(const f32x4*)(gate_b + 8 * fq + 4);
              *(f32x4*)(gates + (size_t)row * 16 + 8 * fq) = v0 + g0; *(f32x4*)(gates + (size_t)row * 16 + 8 * fq + 4) = v1 + g1; }
          }
        }
    }
  }
};
struct EpiUQ {
  static constexpr bool PERM = true, FP8 = false; static constexpr int NBJ = 2;
  unsigned char* qatt; const float* ssq_q; const float* rope;
  DI void operator()(const f32x4 (&acc)[2][2][4][2], const Unit& u, int wr, int wc, int fr, int fq) const {
    float rs[2][4];
#pragma unroll
    for (int ai = 0; ai < 2; ++ai) {
      f32x4 q0[4], q1[4], q2[4];
#pragma unroll
      for (int m = 0; m < 4; ++m) { const int row = u.pm * 256 + ai * 128 + wr * 64 + m * 16 + fr;
        q0[m] = *(const f32x4*)(ssq_q + (size_t)row * 12); q1[m] = *(const f32x4*)(ssq_q + (size_t)row * 12 + 4); q2[m] = *(const f32x4*)(ssq_q + (size_t)row * 12 + 8); }
#pragma unroll
      for (int m = 0; m < 4; ++m) {
        const float ss = (q0[m][0] + q0[m][1] + q0[m][2] + q0[m][3]) + (q1[m][0] + q1[m][1] + q1[m][2] + q1[m][3]) + (q2[m][0] + q2[m][1] + q2[m][2] + q2[m][3]);
        rs[ai][m] = rsqrtf(ss * (1.f / 384.f) + RMS_EPS) * QSCALE; }
      asm volatile("" ::: "memory");
    }
#pragma unroll
    for (int bj = 0; bj < 2; ++bj) {
      const int cw = u.pn * 256 + bj * 128 + wc * 32, h = cw / 192, dw = cw - h * 192, d = dw + 8 * fq;
#pragma unroll
      for (int ai = 0; ai < 2; ++ai)
#pragma unroll
        for (int m = 0; m < 4; ++m) {
          const int row = u.pm * 256 + ai * 128 + wr * 64 + m * 16 + fr, b = row >> 14, s = row & (SEQ - 1);
          const f32x4 v0 = acc[ai][bj][m][0] * rs[ai][m], v1 = acc[ai][bj][m][1] * rs[ai][m];
          u32x2 w;
          if (dw < 128) { w = cvt8(v0, v1); }
          else {
            const int i0 = (d - 128) >> 1;
            const f32x4 cs0 = *(const f32x4*)(rope + (size_t)row * 64 + 2 * i0), cs1 = *(const f32x4*)(rope + (size_t)row * 64 + 2 * i0 + 4);
            const float a0 = v0[0] * cs0[0] - v0[1] * cs0[1], b0 = v0[1] * cs0[0] + v0[0] * cs0[1];
            const float a1 = v0[2] * cs0[2] - v0[3] * cs0[3], b1 = v0[3] * cs0[2] + v0[2] * cs0[3];
            const float a2 = v1[0] * cs1[0] - v1[1] * cs1[1], b2 = v1[1] * cs1[0] + v1[0] * cs1[1];
            const float a3 = v1[2] * cs1[2] - v1[3] * cs1[3], b3 = v1[3] * cs1[2] + v1[2] * cs1[3];
            w = cvt8((f32x4){a0, b0, a1, b1}, (f32x4){a2, b2, a3, b3});
          }
          *(u32x2*)(qatt + ((size_t)(b * 4 + h) * SEQ + s) * 192 + d) = w;
          asm volatile("" ::: "memory");
        }
    }
  }
};
struct EpiUKV {
  static constexpr bool PERM = true, FP8 = false; static constexpr int NBJ = 2;
  unsigned char* kn; unsigned char* vt8; const float* ssq_kv;
  DI void operator()(const f32x4 (&acc)[2][2][4][2], const Unit& u, int wr, int wc, int fr, int fq) const {
    float rsv[2][4];
#pragma unroll
    for (int ai = 0; ai < 2; ++ai) {
      f32x4 q0[4], q1[4];
#pragma unroll
      for (int m = 0; m < 4; ++m) { const int row = u.pm * 256 + ai * 128 + wr * 64 + m * 16 + fr; q0[m] = *(const f32x4*)(ssq_kv + (size_t)row * 8); q1[m] = *(const f32x4*)(ssq_kv + (size_t)row * 8 + 4); }
#pragma unroll
      for (int m = 0; m < 4; ++m) rsv[ai][m] = rsqrtf(((q0[m][0] + q0[m][1] + q0[m][2] + q0[m][3]) + (q1[m][0] + q1[m][1] + q1[m][2] + q1[m][3])) * (1.f / 256.f) + RMS_EPS);
      asm volatile("" ::: "memory");
    }
#pragma unroll
    for (int ai = 0; ai < 2; ++ai)
#pragma unroll
      for (int m = 0; m < 4; ++m) {
        const int row = u.pm * 256 + ai * 128 + wr * 64 + m * 16 + fr, b = row >> 14, s = row & (SEQ - 1);
        const float rs = rsv[ai][m];
        { const f32x4 v0 = acc[ai][0][m][0] * rs, v1 = acc[ai][0][m][1] * rs;
          *(u32x2*)(kn + ((size_t)(b * 4 + u.pn) * SEQ + s) * 192 + wc * 32 + 8 * fq) = cvt8(v0, v1); }
        { const f32x4 v0 = acc[ai][1][m][0] * rs, v1 = acc[ai][1][m][1] * rs;
          const u32x2 w = cvt8(v0, v1);
          const int k = s & 63, kq = k & 31, pos = 32 * ((kq >> 2) & 1) + (kq & 3) + 4 * (kq >> 3) + 16 * (k >> 5);
          unsigned char* dst = vt8 + ((size_t)((b * 4 + u.pn) * 256 + (s >> 6)) * 128 + wc * 32 + 8 * fq) * 64 + pos;
          dst[0] = (unsigned char)w[0]; dst[64] = (unsigned char)(w[0] >> 8); dst[128] = (unsigned char)(w[0] >> 16); dst[192] = (unsigned char)(w[0] >> 24);
          dst[256] = (unsigned char)w[1]; dst[320] = (unsigned char)(w[1] >> 8); dst[384] = (unsigned char)(w[1] >> 16); dst[448] = (unsigned char)(w[1] >> 24); }
        asm volatile("" ::: "memory");
      }
  }
};
struct EpiOut {
  static constexpr bool PERM = true, FP8 = false; static constexpr int NBJ = 2;
  const float* x; const float* mod; bf16_t* z;
  DI void operator()(const f32x4 (&acc)[2][2][4][2], const Unit& u, int wr, int wc, int fr, int fq) const {
#pragma unroll
    for (int ai = 0; ai < 2; ++ai)
#pragma unroll
      for (int m = 0; m < 4; ++m) {
        const int row = u.pm * 256 + ai * 128 + wr * 64 + m * 16 + fr, b = row >> 14;
#pragma unroll
        for (int bj = 0; bj < 2; ++bj) {
          const int c = u.pn * 256 + bj * 128 + wc * 32 + 8 * fq;
          const unsigned off = (unsigned)row * 1024u + (unsigned)c;
          const f32x4 x0 = *(const f32x4*)(x + off), x1 = *(const f32x4*)(x + off + 4), g0 = *(const f32x4*)(mod + b * 6144 + 2048 + c), g1 = *(const f32x4*)(mod + b * 6144 + 2048 + c + 4);
          const f32x4 z0 = x0 * ALPHA + (g0 + 1.f) * acc[ai][bj][m][0], z1 = x1 * ALPHA + (g1 + 1.f) * acc[ai][bj][m][1];
          *(u32x4*)(z + off) = (u32x4){cvtpk(z0[0], z0[1]), cvtpk(z0[2], z0[3]), cvtpk(z1[0], z1[1]), cvtpk(z1[2], z1[3])};
        }
        asm volatile("" ::: "memory");
      }
  }
};
struct EpiGU {
  static constexpr bool PERM = true, FP8 = true; static constexpr int NBJ = 1, ASCALE = 127;
  unsigned char* hdn;
  DI void operator()(const f32x4 (&acc)[2][1][4][2], const Unit& u, int wr, int wc, int fr, int fq) const {
    const unsigned base = ((unsigned)u.pm * 256u + wr * 64 + fr) * 512u + (unsigned)((u.pn * 128 + wc * 32 + 8 * fq) >> 1);
#pragma unroll
    for (int ai = 0; ai < 2; ++ai)
#pragma unroll
      for (int m = 0; m < 4; ++m) {
        const f32x4 g = acc[ai][0][m][0], up = acc[ai][0][m][1] * 8.f;
        int w = __builtin_amdgcn_cvt_pk_fp8_f32(siluf_rcp(g[0]) * up[0], siluf_rcp(g[1]) * up[1], 0, false); w = __builtin_amdgcn_cvt_pk_fp8_f32(siluf_rcp(g[2]) * up[2], siluf_rcp(g[3]) * up[3], w, true);
        *(int*)(hdn + (base + (unsigned)((ai * 128 + m * 16) * 512))) = w;
      }
  }
};
struct EpiDN {
  static constexpr bool PERM = true, FP8 = true; static constexpr int NBJ = 1, ASCALE = 124;
  bf16_t* ybuf; const float* lw;
  struct Pre { float w[2][4]; };
  DI void pre(const Unit& u, int wr, int fr, Pre& P) const {
    const unsigned wbase = ((unsigned)u.e * (unsigned)T + (unsigned)(u.j * 256 + wr * 64 + fr)) * 4u;
#pragma unroll
    for (int ai = 0; ai < 2; ++ai)
#pragma unroll
      for (int m = 0; m < 4; ++m) P.w[ai][m] = *(const float*)((const char*)lw + (wbase + (unsigned)((ai * 128 + m * 16) * 4)));
  }
  DI void operator()(const f32x4 (&acc)[2][1][4][2], const Unit& u, int wr, int wc, int fr, int fq, const Pre& P) const {
    const unsigned base = ((unsigned)u.pm * 256u + wr * 64 + fr) * 2048u + (unsigned)(u.pn * 128 + wc * 32 + 8 * fq) * 2u;
#pragma unroll
    for (int ai = 0; ai < 2; ++ai)
#pragma unroll
      for (int m = 0; m < 4; ++m) {
        const float wgt = P.w[ai][m];
        const f32x4 v0 = acc[ai][0][m][0] * wgt, v1 = acc[ai][0][m][1] * wgt;
        const u32x4 w = {cvtpk(v0[0], v0[1]), cvtpk(v0[2], v0[3]), cvtpk(v1[0], v1[1]), cvtpk(v1[2], v1[3])};
        *(u32x4*)((char*)ybuf + (base + (unsigned)((ai * 128 + m * 16) * 2048))) = w;
        asm volatile("" ::: "memory");
      }
  }
};
struct MoeOrderBase {
  const LAS int* tstart; const int* cnt; int G, c;
  DI bool next(int i, Unit& u) const {
    int L = i * G + c;
    if ((G & 63) == 0) { const int x = c & 7, sl = c >> 3, tpx = G >> 6; L = (((i * 8 + x) * tpx + (sl >> 3)) << 3) + (sl & 7); }
    const int NT = tstart[32]; if (L >= NT * 8) return false;
    const int tile = L >> 3; int e = 0;
    for (int k = 1; k < 32; ++k) e = (tstart[k] <= tile) ? k : e;
    u.pm = tile; u.pn = L & 7; u.e = e; u.j = tile - tstart[e]; return true;
  }
};
struct MoeOrderGU : MoeOrderBase {
  static constexpr bool GATHER = true;
  const int* ltok; const char* Bt;
  DI unsigned a_off(const Unit& u, int R) const { const int n = cnt[u.e * CNT_STRIDE]; int idx = u.j * 256 + R; idx = idx < n ? idx : n - 1; return (unsigned)ltok[(size_t)u.e * T + idx] * 1024u; }
  DI const char* b_base(const Unit& u) const { return Bt + ((size_t)u.e * 1024 + u.pn * 128) * 1024; }
};
struct MoeOrderDN : MoeOrderBase {
  static constexpr bool GATHER = false;
  const char* Bt;
  DI unsigned a_off(const Unit& u, int R) const { return (unsigned)(u.pm * 256 + R) * 512u; }
  DI const char* b_base(const Unit& u) const { return Bt + ((size_t)u.e * 1024 + u.pn * 128) * 512; }
};

struct TDesc { const float* src; const float* kscale; bf16_t* dst; int ld, K, k0, n0, ok, fp8; };
DI TDesc tdesc(int r, int lane, unsigned char* ws) {
  constexpr int I_IN = 16 * 88, I_UQ = 6 * 24, I_UKV = 4 * 32, I_OUT = 16 * 32, I_GU = 32 * 16 * 32;
  TDesc d; d.kscale = nullptr; d.fp8 = 0; int sc, kb, nb; const float* W;
  if (r < I_IN) { kb = r / 88; nb = r % 88; const int n = nb * 32 + (lane & 31);
    sc = n < 2048 ? n : n < 2432 ? 2064 + (n - 2048) : n < 2688 ? 2448 + (n - 2432) : n < 2752 ? 2704 + ((n - 2688) & 1) * 32 + ((n - 2688) >> 1) : n < 2768 ? 2048 + (n - 2752) : -1;
    W = karg<A_WIN>(); d.ld = N_IN; d.K = 1024; d.dst = (bf16_t*)(ws + WS_WIN); }
  else if ((r -= I_IN) < I_UQ) { kb = r / 24; nb = r % 24; const int n = nb * 32 + (lane & 31), h = n / 192, dd = n - h * 192;
    sc = dd < 128 ? n : h * 192 + 128 + ((dd - 128) & 1) * 32 + ((dd - 128) >> 1);
    W = karg<A_WUQ>(); d.ld = 768; d.K = 384; d.dst = (bf16_t*)(ws + WS_WUQ); d.kscale = karg<A_QNG>(); }
  else if ((r -= I_UQ) < I_UKV) { kb = r / 32; nb = r % 32; sc = nb * 32 + (lane & 31); W = karg<A_WUKV>(); d.ld = 1024; d.K = 256; d.dst = (bf16_t*)(ws + WS_WUKV); d.kscale = karg<A_KVNG>(); }
  else if ((r -= I_UKV) < I_OUT) { kb = r / 32; nb = r % 32; sc = nb * 32 + (lane & 31); W = karg<A_WOUT>(); d.ld = 1024; d.K = 1024; d.dst = (bf16_t*)(ws + WS_WOUT); }
  else if ((r -= I_OUT) < I_GU) { const int e = r / 512, q = r % 512; kb = q / 32; nb = q % 32;
    const int lr = nb * 32 + (lane & 31), up = (lr >> 2) & 1; sc = (lr >> 3) * 4 + (lr & 3);
    W = (up ? karg<A_WUP>() : karg<A_WGATE>()) + (size_t)e * 1024 * 512; d.ld = 512; d.K = 1024; d.fp8 = 1; d.dst = (bf16_t*)(ws + WS_WGU + (size_t)e * 1024 * 1024); }
  else { r -= I_GU; const int e = r / 256, q = r % 256; kb = q / 32; nb = q % 32; sc = nb * 32 + (lane & 31);
    W = karg<A_WDOWN>() + (size_t)e * 512 * 1024; d.ld = 1024; d.K = 512; d.fp8 = 1; d.dst = (bf16_t*)(ws + WS_WDN + (size_t)e * 1024 * 512); }
  d.k0 = 64 * kb; d.n0 = 32 * nb; d.ok = sc >= 0;
  d.src = W + (size_t)(d.k0 + (lane >> 5)) * d.ld + (sc >= 0 ? sc : 0);
  return d;
}
DI void tload(const TDesc& d, float (&v)[32]) {
#pragma unroll
  for (int i = 0; i < 32; ++i) v[i] = d.src[(size_t)(2 * i) * d.ld];
}
DI void tstore(const TDesc& d, float (&v)[32], LAS float* scr, int lane) {
  if (d.kscale) {
#pragma unroll
    for (int i = 0; i < 32; ++i) v[i] *= d.kscale[d.k0 + 2 * i + (lane >> 5)];
  }
#pragma unroll
  for (int i = 0; i < 32; ++i) scr[(2 * i + (lane >> 5)) * 33 + (lane & 31)] = d.ok ? v[i] : 0.f;
  asm volatile("s_waitcnt lgkmcnt(0)" ::: "memory");
  const int c = lane & 7;
#pragma unroll
  for (int j = 0; j < 4; ++j) { const int n = (lane >> 3) + 8 * j; const LAS float* s = scr + (8 * c) * 33 + n;
    if (d.fp8) { *(u32x2*)((unsigned char*)d.dst + (size_t)(d.n0 + n) * d.K + d.k0 + 8 * c) =
        cvt8((f32x4){s[0 * 33], s[1 * 33], s[2 * 33], s[3 * 33]} * 32.f, (f32x4){s[4 * 33], s[5 * 33], s[6 * 33], s[7 * 33]} * 32.f); }
    else { u32x4 o; o.x = cvtpk(s[0 * 33], s[1 * 33]); o.y = cvtpk(s[2 * 33], s[3 * 33]); o.z = cvtpk(s[4 * 33], s[5 * 33]); o.w = cvtpk(s[6 * 33], s[7 * 33]);
      *(u32x4*)(d.dst + (size_t)(d.n0 + n) * d.K + d.k0 + 8 * c) = o; } }
  asm volatile("s_waitcnt lgkmcnt(0)" ::: "memory");
}
constexpr int PREP_ITEMS = 16 * 88 + 6 * 24 + 4 * 32 + 16 * 32 + 32 * 16 * 32 + 32 * 8 * 32;
constexpr int PREP_DEFER = 8192;
DI void prep_items(int it, const int end, const int stride, const int lane, unsigned char* ws, LAS float* scr) {
  TDesc dA, dB; float vA[32], vB[32];
  if (it < end) { dA = tdesc(it, lane, ws); tload(dA, vA); }
  while (it < end) {
    if (it + stride < end) { dB = tdesc(it + stride, lane, ws); tload(dB, vB); }
    tstore(dA, vA, scr, lane);
    it += stride; if (it >= end) break;
    if (it + stride < end) { dA = tdesc(it + stride, lane, ws); tload(dA, vA); }
    tstore(dB, vB, scr, lane);
    it += stride;
  }
}
DI void phase_prep(const Ctx& p, int bid, int G, LAS unsigned char* lds) {
  const int tid = tid_fresh(), lane = tid & 63, wave = __builtin_amdgcn_readfirstlane(tid >> 6);
  unsigned char* ws = p.ws;
  LAS float* scr = (LAS float*)(lds + wave * 16384);
  LAS float* cact = (LAS float*)(lds + 131072);
  for (int i = tid; i < 2048; i += NTHREADS) cact[i] = siluf_(karg<A_C>()[i]);
  __syncthreads();
  const int gw = bid * 8 + wave, NGW = G * 8;
  constexpr int I_MOD = 192;
  if (bid < I_MOD) {
    const int kg = lane >> 3, cc = lane & 7, col = bid * 32 + 4 * cc; const float* w_ada = karg<A_WADA>() + col;
    f32x4 a0 = {0.f, 0.f, 0.f, 0.f}, a1 = {0.f, 0.f, 0.f, 0.f};
#pragma unroll
    for (int j = 0; j < 16; ++j) { const int k = wave * 128 + kg + 8 * j; const f32x4 w = *(const f32x4*)(w_ada + (size_t)k * 6144); a0 += w * cact[k]; a1 += w * cact[1024 + k]; }
#pragma unroll
    for (int e = 0; e < 4; ++e) {
#pragma unroll
      for (int o = 8; o < 64; o <<= 1) { a0[e] += __shfl_xor(a0[e], o); a1[e] += __shfl_xor(a1[e], o); } }
    LAS f32x4* part = (LAS f32x4*)(lds + 131072 + 8192);
    if (kg == 0) { part[(wave * 8 + cc) * 2] = a0; part[(wave * 8 + cc) * 2 + 1] = a1; }
    __syncthreads();
    if (wave == 0 && kg == 0) { float* mod = (float*)(ws + WS_MOD); const f32x4 bb = *(const f32x4*)(karg<A_BADA>() + col);
      f32x4 s0 = part[cc * 2], s1 = part[cc * 2 + 1];
#pragma unroll
      for (int w = 1; w < 8; ++w) { s0 += part[(w * 8 + cc) * 2]; s1 += part[(w * 8 + cc) * 2 + 1]; }
      *(f32x4*)(mod + col) = s0 + bb; *(f32x4*)(mod + 6144 + col) = s1 + bb; }
  }
#ifndef DBL_PREP
#define DBL_PREP 0
#endif
  for (int rp_ = 0; rp_ < (DBL_PREP == 1 ? 2 : 1); ++rp_) prep_items(gw, PREP_ITEMS - PREP_DEFER, NGW, lane, ws, scr);
  {
    const float INV[32] = {1.000000000e+00f, 7.498942018e-01f, 5.623413324e-01f, 4.216965139e-01f, 3.162277639e-01f, 2.371373773e-01f, 1.778279394e-01f, 1.333521456e-01f,
                           1.000000015e-01f, 7.498942316e-02f, 5.623413250e-02f, 4.216964915e-02f, 3.162277490e-02f, 2.371373773e-02f, 1.778279431e-02f, 1.333521400e-02f,
                           9.999999776e-03f, 7.498942316e-03f, 5.623413250e-03f, 4.216964822e-03f, 3.162277630e-03f, 2.371373819e-03f, 1.778279431e-03f, 1.333521446e-03f,
                           1.000000047e-03f, 7.498941850e-04f, 5.623413017e-04f, 4.216965172e-04f, 3.162277571e-04f, 2.371373703e-04f, 1.778279402e-04f, 1.333521504e-04f};
    f32x2* rope = (f32x2*)(ws + WS_ROPE); const int* pos = karg<A_POS, const int>();
    { const int base = bid * NTHREADS + tid, stride = G * NTHREADS; const float inv = INV[tid & 31];
      int pv[8];
#pragma unroll
      for (int k = 0; k < 8; ++k) { const int i = base + k * stride; pv[k] = i < T * 32 ? pos[i >> 5] : 0; }
#pragma unroll
      for (int k = 0; k < 8; ++k) { const int i = base + k * stride;
        if (i < T * 32) { float sn, cs; sincosf((float)pv[k] * inv, &sn, &cs); rope[i] = (f32x2){cs, sn}; } }
      for (int i = base + 8 * stride; i < T * 32; i += stride) { float sn, cs; sincosf((float)pos[i >> 5] * inv, &sn, &cs); rope[i] = (f32x2){cs, sn}; } }
  }
  if (bid == 0) for (int i = tid; i < 64 * CNT_STRIDE; i += NTHREADS) ((int*)(ws + WS_CNT))[i] = 0;
  { const float* w_re = karg<A_WRE>(); const float* w_rg = karg<A_WRG>(); float* wrt = (float*)(ws + WS_WRT);
    for (int i = bid * NTHREADS + tid; i < 36 * 1024; i += G * NTHREADS) { const int e = i >> 10, k = i & 1023; wrt[i] = e < 32 ? w_re[k * 32 + e] : w_rg[k * 4 + (e - 32)]; } }
}

DI void phase_lnmod(const Ctx& p, int bid, int G) {
  const int tid = tid_fresh(), lane = tid & 63, wave = tid >> 6;
  const float* mod = (const float*)(p.ws + WS_MOD); bf16_t* U = (bf16_t*)(p.ws + WS_U); const float* xin = karg<A_X>();
  f32x4 vn[4];
  { const int row = bid * 8 + wave; if (row < T) { const f32x4* xr = (const f32x4*)(xin + (size_t)row * 1024) + lane;
#pragma unroll
      for (int j = 0; j < 4; ++j) vn[j] = xr[64 * j]; } }
  for (int row = bid * 8 + wave; row < T; row += G * 8) {
    const int b = row >> 14;
    f32x4 sh[4], sc[4];
#pragma unroll
    for (int j = 0; j < 4; ++j) { const int col = 4 * lane + 256 * j; sh[j] = *(const f32x4*)(mod + b * 6144 + col); sc[j] = *(const f32x4*)(mod + b * 6144 + 1024 + col); }
    f32x4 v[4]; float s = 0.f;
#pragma unroll
    for (int j = 0; j < 4; ++j) { v[j] = vn[j]; s += (v[j][0] + v[j][1]) + (v[j][2] + v[j][3]); }
    if (row + G * 8 < T) { const f32x4* xr = (const f32x4*)(xin + (size_t)(row + G * 8) * 1024) + lane;
#pragma unroll
      for (int j = 0; j < 4; ++j) vn[j] = xr[64 * j]; }
    const float mean = wave_sum(s) * (1.f / 1024.f); float s2 = 0.f;
#pragma unroll
    for (int j = 0; j < 4; ++j) { v[j] = v[j] - mean; s2 += (v[j][0] * v[j][0] + v[j][1] * v[j][1]) + (v[j][2] * v[j][2] + v[j][3] * v[j][3]); }
    const float rstd = rsqrtf(wave_sum(s2) * (1.f / 1024.f) + LN_EPS);
    u32x2* o8 = (u32x2*)(U + (size_t)row * 1024) + lane;
#pragma unroll
    for (int j = 0; j < 4; ++j) {
      const f32x4 y = v[j] * rstd * (sc[j] + 1.f) + sh[j];
      o8[64 * j] = (u32x2){cvtpk(y[0], y[1]), cvtpk(y[2], y[3])};
    }
  }
}

constexpr int PA_V = 0, PA_KF = 32768, PA_KB = 65536, PA_RAWK = 100352, PA_VEC = 135168;
DI void mlstmA_unit(const Ctx& p, int b, int h, int c, LAS unsigned char* lds) {
  const int tid = tid_fresh(), lane = tid & 63, wid = __builtin_amdgcn_readfirstlane(tid >> 6), r32 = lane & 31, hi = lane >> 5;
  unsigned char* ws = as_global(p.ws);
  const bf16_t* qkpre = (const bf16_t*)(ws + WS_QKPRE); const bf16_t* vmp = (const bf16_t*)(ws + WS_VM); bf16_t* qkpost = (bf16_t*)(ws + WS_U);
  const float* gates = (const float*)(ws + WS_GATES); float* gvec = (float*)(ws + WS_GVEC); float* nvec = (float*)(ws + WS_NVEC); float* scal = (float*)(ws + WS_SCAL);
  bf16_t* Cbuf = as_global((bf16_t*)p.out);
  LAS float* vec = (LAS float*)(lds + PA_VEC);
  const int bh = b * 4 + h, row0 = b * SEQ + c * 128;
  const int r0 = tid >> 4, c8 = (tid & 15) * 8;
  float ig_pre = 0.f, fg_pre = 0.f;
  if (tid < 256) { const int dir = tid >> 7, t = tid & 127; ig_pre = gates[(size_t)(row0 + t) * 16 + (dir * 2) * 4 + h]; fg_pre = gates[(size_t)(row0 + t) * 16 + (dir * 2 + 1) * 4 + h]; }
  const float* conv_w = as_global(karg<A_CONVW>()); const float* conv_b = as_global(karg<A_CONVB>());
  float wq[5][8], bqv[8], wk[5][8], bkv[8];
  { const int chq = h * 128 + c8, chk = 512 + h * 128 + c8;
#pragma unroll
    for (int j = 0; j < 5; ++j) { const f32x4 a = *(const f32x4*)(conv_w + j * 1024 + chq), b2 = *(const f32x4*)(conv_w + j * 1024 + chq + 4), c2 = *(const f32x4*)(conv_w + j * 1024 + chk), d2 = *(const f32x4*)(conv_w + j * 1024 + chk + 4);
#pragma unroll
      for (int e = 0; e < 4; ++e) { wq[j][e] = a[e]; wq[j][4 + e] = b2[e]; wk[j][e] = c2[e]; wk[j][4 + e] = d2[e]; } }
    { const f32x4 a = *(const f32x4*)(conv_b + chq), b2 = *(const f32x4*)(conv_b + chq + 4), c2 = *(const f32x4*)(conv_b + chk), d2 = *(const f32x4*)(conv_b + chk + 4);
#pragma unroll
      for (int e = 0; e < 4; ++e) { bqv[e] = a[e]; bqv[4 + e] = b2[e]; bkv[e] = c2[e]; bkv[4 + e] = d2[e]; } } }
  u32x4 rk[5], rq[5], rv[4];
#pragma unroll
  for (int j = 0; j < 5; ++j) {
    const int rr = r0 + 32 * j, sj = c * 128 + rr - 2; const bool ok = rr < 132 && sj >= 0 && sj < SEQ;
    const bf16_t* src = qkpre + (size_t)(b * SEQ + (ok ? sj : 0)) * 1024 + h * 128 + c8;
    rk[j] = ok ? *(const u32x4*)(src + 512) : (u32x4){0u, 0u, 0u, 0u}; rq[j] = ok ? *(const u32x4*)src : (u32x4){0u, 0u, 0u, 0u};
  }
#pragma unroll
  for (int j = 0; j < 4; ++j) rv[j] = *(const u32x4*)(vmp + (size_t)(row0 + r0 + 32 * j) * 512 + h * 128 + c8);
  float gb = 0.f, gcol = 0.f, gcm = 0.f;
  if (tid < 256) {
    const int dir = tid >> 7, t = tid & 127, wv = (tid >> 6) & 1;
    const float ig = ig_pre, fg = fg_pre;
    float x = logsigmoidf_(fg);
    if (dir == 0) {
#pragma unroll
      for (int o = 1; o < 64; o <<= 1) { const float y = __shfl_up(x, o); if (lane >= o) x += y; }
      if (lane == 63) vec[256 + wv] = x;
    } else {
#pragma unroll
      for (int o = 1; o < 64; o <<= 1) { const float y = __shfl_down(x, o); if (lane + o < 64) x += y; }
      if (lane == 0) vec[258 + wv] = x;
    }
    gb = x; gcol = ig;
  }
  __syncthreads();
  if (tid < 256) {
    const int dir = tid >> 7, wv = (tid >> 6) & 1;
    if (dir == 0) { if (wv == 1) gb += vec[256]; } else { if (wv == 0) gb += vec[259]; }
    gcol = gcol - gb;
    float x = gcol;
    if (dir == 0) {
#pragma unroll
      for (int o = 1; o < 64; o <<= 1) { const float y = __shfl_up(x, o); if (lane >= o) x = fmaxf(x, y); }
      if (lane == 63) vec[260 + wv] = x;
    } else {
#pragma unroll
      for (int o = 1; o < 64; o <<= 1) { const float y = __shfl_down(x, o); if (lane + o < 64) x = fmaxf(x, y); }
      if (lane == 0) vec[262 + wv] = x;
    }
    gcm = x;
  }
  __syncthreads();
  if (tid < 256) {
    const int dir = tid >> 7, t = tid & 127, wv = (tid >> 6) & 1;
    if (dir == 0) { if (wv == 1) gcm = fmaxf(gcm, vec[260]); } else { if (wv == 0) gcm = fmaxf(gcm, vec[263]); }
    const float mx = fmaxf(vec[260 + 2 * dir], vec[261 + 2 * dir]);
    const float tot = vec[256 + 2 * dir] + vec[257 + 2 * dir];
    float* gv = gvec + ((size_t)(dir * 8 + bh) * SEQ + c * 128 + t) * 3;
    gv[0] = gb; gv[1] = gcol; gv[2] = gcm;
    vec[dir * 128 + t] = __expf(gcol - mx);
    if (t == 0) { scal[(dir * 8 + bh) * 128 + c] = tot; scal[2048 + (dir * 8 + bh) * 128 + c] = tot + mx; }
  }
  __syncthreads();
#pragma unroll
  for (int j = 0; j < 5; ++j) { const int rr = r0 + 32 * j;
    if (rr < 132) { *(LAS u32x4*)(lds + PA_RAWK + rr * 256 + c8 * 2) = rk[j]; *(LAS u32x4*)(lds + PA_KB + rr * 256 + c8 * 2) = rq[j]; } }
#pragma unroll
  for (int j = 0; j < 4; ++j) { const int r = r0 + 32 * j; *(LAS u32x4*)(lds + PA_V + (r >> 6) * 16384 + v_st(r & 63, c8)) = rv[j]; }
  __syncthreads();
  {
    const int ch = h * 128 + c8;
    const float (&w)[5][8] = wq; const float (&bias)[8] = bqv;
#pragma unroll
    for (int ps = 0; ps < 4; ++ps) {
      const int r = r0 + 32 * ps;
      float a[8];
#pragma unroll
      for (int e = 0; e < 8; ++e) a[e] = bias[e];
#pragma unroll
      for (int j = 0; j < 5; ++j) { const u32x4 xv = *(const LAS u32x4*)(lds + PA_KB + (r + j) * 256 + c8 * 2);
        a[0] += w[j][0] * bflo(xv[0]); a[1] += w[j][1] * bfhi(xv[0]); a[2] += w[j][2] * bflo(xv[1]); a[3] += w[j][3] * bfhi(xv[1]);
        a[4] += w[j][4] * bflo(xv[2]); a[5] += w[j][5] * bfhi(xv[2]); a[6] += w[j][6] * bflo(xv[3]); a[7] += w[j][7] * bfhi(xv[3]); }
      const float qs = 0.08838834764831845f;
#pragma unroll
      for (int e = 0; e < 8; ++e) a[e] = siluf_(a[e]) * qs;
      *(u32x4*)(qkpost + (size_t)(row0 + r) * 1024 + ch) = (u32x4){cvtpk(a[0], a[1]), cvtpk(a[2], a[3]), cvtpk(a[4], a[5]), cvtpk(a[6], a[7])};
    }
  }
  __syncthreads();
  {
    const int ch = 512 + h * 128 + c8;
    const float (&w)[5][8] = wk; const float (&bias)[8] = bkv;
#pragma unroll
    for (int ps = 0; ps < 4; ++ps) {
      const int r = r0 + 32 * ps;
      float a[8];
#pragma unroll
      for (int e = 0; e < 8; ++e) a[e] = bias[e];
#pragma unroll
      for (int j = 0; j < 5; ++j) { const u32x4 xv = *(const LAS u32x4*)(lds + PA_RAWK + (r + j) * 256 + c8 * 2);
        a[0] += w[j][0] * bflo(xv[0]); a[1] += w[j][1] * bfhi(xv[0]); a[2] += w[j][2] * bflo(xv[1]); a[3] += w[j][3] * bfhi(xv[1]);
        a[4] += w[j][4] * bflo(xv[2]); a[5] += w[j][5] * bfhi(xv[2]); a[6] += w[j][6] * bflo(xv[3]); a[7] += w[j][7] * bfhi(xv[3]); }
#pragma unroll
      for (int e = 0; e < 8; ++e) a[e] = siluf_(a[e]);
      *(u32x4*)(qkpost + (size_t)(row0 + r) * 1024 + ch) = (u32x4){cvtpk(a[0], a[1]), cvtpk(a[2], a[3]), cvtpk(a[4], a[5]), cvtpk(a[6], a[7])};
      const float wf = vec[r], wb = vec[128 + r];
      const u32x4 kf = {cvtpk(a[0] * wf, a[1] * wf), cvtpk(a[2] * wf, a[3] * wf), cvtpk(a[4] * wf, a[5] * wf), cvtpk(a[6] * wf, a[7] * wf)};
      const u32x4 kb = {cvtpk(a[0] * wb, a[1] * wb), cvtpk(a[2] * wb, a[3] * wb), cvtpk(a[4] * wb, a[5] * wb), cvtpk(a[6] * wb, a[7] * wb)};
      const int io = (r >> 6) * 16384 + v_st(r & 63, c8);
      *(LAS u32x4*)(lds + PA_KF + io) = kf; *(LAS u32x4*)(lds + PA_KB + io) = kb;
    }
  }
  __syncthreads();
  {
    const int dir = wid >> 2, dkb = wid & 3;
    const int ka = (int)(uintptr_t)(lds + (dir ? PA_KB : PA_KF)) + v_rd_base(lane) + dkb * 512;
    const int va = (int)(uintptr_t)(lds + PA_V) + v_rd_base(lane);
    f32x16 o[4] = {};
#define PA_STEP(TILE, KS) do { s16x4 al, ah, l0, h0, l1, h1, l2, h2, l3, h3;                                                   \
      al = tr_read<v_rd_off(0, KS, 0)>(ka + TILE * 16384); ah = tr_read<v_rd_off(0, KS, 1)>(ka + TILE * 16384);                 \
      l0 = tr_read<v_rd_off(0, KS, 0)>(va + TILE * 16384); h0 = tr_read<v_rd_off(0, KS, 1)>(va + TILE * 16384);                 \
      l1 = tr_read<v_rd_off(1, KS, 0)>(va + TILE * 16384); h1 = tr_read<v_rd_off(1, KS, 1)>(va + TILE * 16384);                 \
      l2 = tr_read<v_rd_off(2, KS, 0)>(va + TILE * 16384); h2 = tr_read<v_rd_off(2, KS, 1)>(va + TILE * 16384);                 \
      l3 = tr_read<v_rd_off(3, KS, 0)>(va + TILE * 16384); h3 = tr_read<v_rd_off(3, KS, 1)>(va + TILE * 16384);                 \
      asm volatile("s_waitcnt lgkmcnt(0)" ::: "memory"); SBAR();                                                                \
      const bf16x8 A = PKLH(al, ah);                                                                                            \
      o[0] = MFMA32(A, PKLH(l0, h0), o[0]); o[1] = MFMA32(A, PKLH(l1, h1), o[1]); o[2] = MFMA32(A, PKLH(l2, h2), o[2]); o[3] = MFMA32(A, PKLH(l3, h3), o[3]); } while (0)
    PA_STEP(0, 0); PA_STEP(0, 1); PA_STEP(0, 2); PA_STEP(0, 3); PA_STEP(1, 0); PA_STEP(1, 1); PA_STEP(1, 2); PA_STEP(1, 3);
#undef PA_STEP
    bf16_t* Cd = Cbuf + ((size_t)(dir * 8 + bh) * 128 + c) * 16384;
#pragma unroll
    for (int r = 0; r < 16; ++r) { const int dk = dkb * 32 + crow(r, hi);
#pragma unroll
      for (int d0 = 0; d0 < 4; ++d0) Cd[dk * 128 + d0 * 32 + r32] = f2bf(o[d0][r]); }
  }
  if (tid < 256) {
    const int dir = tid >> 7, dk = tid & 127; const LAS unsigned char* img = lds + (dir ? PA_KB : PA_KF);
    float n = 0.f;
#pragma unroll 8
    for (int s = 0; s < 128; ++s) n += bf2f(*(const LAS unsigned short*)(img + (s >> 6) * 16384 + v_st(s & 63, dk)));
    nvec[((size_t)(dir * 8 + bh) * 128 + c) * 128 + dk] = n;
  }
  __syncthreads();
}

DI void phase_scan(const Ctx& p, int bid, int G) {
  const int tid = tid_fresh(); unsigned char* ws = p.ws;
  const float* scal = (const float*)(ws + WS_SCAL); float* mprev = (float*)(ws + WS_SCAL) + 4096; float* nvec = (float*)(ws + WS_NVEC); bf16_t* Cbuf = (bf16_t*)p.out;
  for (int gid = bid * NTHREADS + tid, it = 0; gid < 131072; gid += G * NTHREADS, ++it) {
    const int seq = gid >> 13, e2c = gid & 8191, dir = seq >> 3;
    const bool ex = (it == 0) && (gid < 1024);
    const int seqn = (gid & 1023) >> 6, e2 = gid & 63, dirn = seqn >> 3;
    float m = 0.f, a0 = 0.f, a1 = 0.f, mN = 0.f, n0 = 0.f, n1 = 0.f;
    for (int sb = 0; sb < 128; sb += 8) {
      unsigned raw[8]; f32x2 rawn[8]; float bev[8], mlv[8], ben[8], mln[8];
#pragma unroll
      for (int q = 0; q < 8; ++q) { const int c = dir ? 127 - (sb + q) : sb + q; raw[q] = *(const unsigned*)(Cbuf + ((size_t)seq * 128 + c) * 16384 + e2c * 2);
        bev[q] = scal[seq * 128 + c]; mlv[q] = scal[2048 + seq * 128 + c]; }
      if (ex) {
#pragma unroll
        for (int q = 0; q < 8; ++q) { const int c = dirn ? 127 - (sb + q) : sb + q; rawn[q] = *(const f32x2*)(nvec + ((size_t)seqn * 128 + c) * 128 + e2 * 2);
          ben[q] = scal[seqn * 128 + c]; mln[q] = scal[2048 + seqn * 128 + c]; }
      }
#pragma unroll
      for (int q = 0; q < 8; ++q) {
        const int c = dir ? 127 - (sb + q) : sb + q;
        const float be = bev[q], ml = mlv[q];
        *(unsigned*)(Cbuf + ((size_t)seq * 128 + c) * 16384 + e2c * 2) = cvtpk(a0, a1);
        if (e2c == 0) mprev[seq * 128 + c] = m;
        const float mn = fmaxf(be + m, ml), al = __expf(be + m - mn), bt = __expf(ml - mn);
        a0 = al * a0 + bt * bflo(raw[q]); a1 = al * a1 + bt * bfhi(raw[q]);
        m = mn;
      }
      if (ex) {
#pragma unroll
        for (int q = 0; q < 8; ++q) {
          const int c = dirn ? 127 - (sb + q) : sb + q;
          const float be = ben[q], ml = mln[q];
          *(f32x2*)(nvec + ((size_t)seqn * 128 + c) * 128 + e2 * 2) = (f32x2){n0, n1};
          const float mn = fmaxf(be + mN, ml), al = __expf(be + mN - mn), bt = __expf(ml - mn);
          n0 = al * n0 + bt * rawn[q][0]; n1 = al * n1 + bt * rawn[q][1];
          mN = mn;
        }
      }
    }
  }
}

DI void qkt8(f32x16& p0, f32x16& p1, const LAS unsigned char* Ks, const bf16x8* qr, int r32, int hi) {
  p0 = f32x16{}; p1 = f32x16{};
#pragma unroll
  for (int d0 = 0; d0 < 8; ++d0) { const int cb = (d0 * 16 + hi * 8) * 2;
    const bf16x8 b0 = *(const LAS bf16x8*)(Ks + KSWZ(r32, cb)), b1 = *(const LAS bf16x8*)(Ks + KSWZ(32 + r32, cb));
    p0 = MFMA32(b0, qr[d0], p0); p1 = MFMA32(b1, qr[d0], p1); }
}
DI v8i kfrag8(const LAS unsigned char* K8, int row, int s, int hi) {
  const int c = 4 * s + 2 * hi;
  const u32x4 lo = *(const LAS u32x4*)(K8 + row * 256 + ((c ^ (row & 15)) << 4)), hi4 = *(const LAS u32x4*)(K8 + row * 256 + (((c + 1) ^ (row & 15)) << 4));
  return (v8i){(int)lo[0], (int)lo[1], (int)lo[2], (int)lo[3], (int)hi4[0], (int)hi4[1], (int)hi4[2], (int)hi4[3]};
}
#define MFMA8(a, b, c) __builtin_amdgcn_mfma_scale_f32_32x32x64_f8f6f4((a), (b), (c), 0, 0, 0, 127, 0, 123)
DI void qkt12(f32x16& p0, f32x16& p1, const LAS unsigned char* K8, const v8i* qr, int r32, int hi) {
  p0 = f32x16{}; p1 = f32x16{};
#pragma unroll
  for (int s = 0; s < 3; ++s) {
    const v8i a0 = kfrag8(K8, r32, s, hi), a1 = kfrag8(K8, 32 + r32, s, hi);
    p0 = MFMA8(a0, qr[s], p0); p1 = MFMA8(a1, qr[s], p1);
  }
}

DI void glds16(const void* gsrc, unsigned lds_dst) {
  unsigned keep;
  asm volatile("s_mov_b32 %0, m0\n\ts_mov_b32 m0, %2\n\ts_nop 0\n\tglobal_load_lds_dwordx4 %1, off\n\ts_mov_b32 m0, %0" : "=&s"(keep) : "v"(gsrc), "s"(lds_dst) : "memory");
}
constexpr int AT_KN = 0, AT_V = 49152, AT_WS = 73728;
constexpr float ATT_THR = 3.f;
DI void partialSM(f32x16& p0, f32x16& p1, float& m_reg, float& mn, float& alpha) {
  float pmax = p0[0];
#pragma unroll
  for (int r = 1; r < 16; ++r) pmax = fmaxf(pmax, p0[r]);
#pragma unroll
  for (int r = 0; r < 16; ++r) pmax = fmaxf(pmax, p1[r]);
  pmax = half_swap_max(pmax);
  if (__builtin_expect(__all(pmax - m_reg <= ATT_THR), 1)) { mn = m_reg; alpha = 1.f; }
  else { mn = fmaxf(m_reg, pmax); alpha = __builtin_amdgcn_exp2f(m_reg - mn); m_reg = mn; }
  const float mo = mn - 5.f;
#pragma unroll
  for (int r = 0; r < 16; ++r) { p0[r] = p0[r] - mo; p1[r] = p1[r] - mo; }
#pragma unroll
  for (int r = 0; r < 16; ++r) p0[r] = __builtin_amdgcn_exp2f(p0[r]);
}
DI void finishSM(f32x16& p0, f32x16& p1, v8i& pa) {
#pragma unroll
  for (int r = 0; r < 16; ++r) p1[r] = __builtin_amdgcn_exp2f(p1[r]);
#pragma unroll
  for (int q = 0; q < 4; ++q) {
    int w = __builtin_amdgcn_cvt_pk_fp8_f32(p0[4 * q], p0[4 * q + 1], pa[q], false); pa[q] = __builtin_amdgcn_cvt_pk_fp8_f32(p0[4 * q + 2], p0[4 * q + 3], w, true);
    w = __builtin_amdgcn_cvt_pk_fp8_f32(p1[4 * q], p1[4 * q + 1], pa[4 + q], false); pa[4 + q] = __builtin_amdgcn_cvt_pk_fp8_f32(p1[4 * q + 2], p1[4 * q + 3], w, true);
  }
}
DI void pv8(f32x16* o, f32x16& lsum, const LAS unsigned char* Vt, v8i pa, int r32, int hi) {
  { const v8i ones = {0x38383838, 0x38383838, 0x38383838, 0x38383838, 0x38383838, 0x38383838, 0x38383838, 0x38383838};
    lsum = __builtin_amdgcn_mfma_scale_f32_32x32x64_f8f6f4(pa, ones, lsum, 0, 0, 0, 122, 0, 127); }
#pragma unroll
  for (int d0 = 0; d0 < 4; ++d0) {
    const int n = 32 * d0 + r32, x = (n >> 2) & 3;
    const u32x4 lo = *(const LAS u32x4*)(Vt + n * 64 + (((2 * hi) ^ x) << 4)), h4 = *(const LAS u32x4*)(Vt + n * 64 + (((2 * hi + 1) ^ x) << 4));
    const v8i bv = {(int)lo[0], (int)lo[1], (int)lo[2], (int)lo[3], (int)h4[0], (int)h4[1], (int)h4[2], (int)h4[3]};
    o[d0] = __builtin_amdgcn_mfma_scale_f32_32x32x64_f8f6f4(pa, bv, o[d0], 0, 0, 0, 122, 0, 127);
  }
}
DI void attn_unit(const unsigned char* Qb, const unsigned char* Knh, const unsigned char* Vh, bf16_t* Ob, LAS unsigned char* lds) {
  const int tid = tid_fresh(), wid = __builtin_amdgcn_readfirstlane(tid >> 6), lane = tid & 63, r32 = lane & 31, hi = lane >> 5;
  LAS float* wsf = (LAS float*)(lds + AT_WS) + wid * 64; LAS float* al_l = wsf + 32;
  constexpr int NT = SEQ / 64;
  unsigned offKn, offV;
  { const int row = wid * 4 + (lane >> 4); int lg = (lane & 15) ^ (row & 15); lg = lg < 12 ? lg : 0; offKn = (unsigned)(row * 192 + lg * 16); }
  { const int n = wid * 16 + (lane >> 2), c = (lane & 3) ^ ((n >> 2) & 3); offV = (unsigned)(n * 64 + c * 16); }
  const unsigned ldsw = (unsigned)wid * 1024u, lds0 = (unsigned)(uintptr_t)lds;
#define DMA16(gptr, ldsoff) glds16((gptr), (unsigned)__builtin_amdgcn_readfirstlane((int)(lds0 + (unsigned)(ldsoff))))
#define ISSUE_K(t, ks) do { const int t_ = (t) < NT ? (t) : NT - 1; const char* kn_ = (const char*)Knh + (size_t)t_ * (64 * 192) + offKn; \
    DMA16(kn_, AT_KN + (ks) * 16384 + ldsw); DMA16(kn_ + 32 * 192, AT_KN + (ks) * 16384 + 8192 + ldsw); } while (0)
#define ISSUE_V(t, vs) do { const int t_ = (t) < NT ? (t) : NT - 1; DMA16((const char*)Vh + (size_t)t_ * 8192 + offV, AT_V + (vs) * 8192 + ldsw); } while (0)
#define WAIT_BAR(N) asm volatile("s_waitcnt vmcnt(" #N ") lgkmcnt(0)\n\ts_barrier" ::: "memory")
#define RESC(a) do { if (__any((a) < 1.f)) { if (hi == 0) al_l[r32] = (a); asm volatile("s_waitcnt lgkmcnt(0)" ::: "memory"); \
    _Pragma("unroll") for (int r = 0; r < 16; ++r) { const float a_ = al_l[crow(r, hi)]; lsum[r] *= a_; _Pragma("unroll") for (int d = 0; d < 4; ++d) o[d][r] *= a_; } } } while (0)
  const bool trail = wid >= 4;
  ISSUE_K(0, 0); ISSUE_K(1, 1); ISSUE_V(0, 0);
  float m_reg = -1e30f; f32x16 lsum = {}; f32x16 o[4] = {}; v8i qr[3];
  { const unsigned char* Qw = Qb + (size_t)(wid * 32 + r32) * 192 + hi * 32;
#pragma unroll
    for (int s_ = 0; s_ < 3; ++s_) { const u32x4 lo = *(const u32x4*)(Qw + s_ * 64), h4 = *(const u32x4*)(Qw + s_ * 64 + 16);
      qr[s_] = (v8i){(int)lo[0], (int)lo[1], (int)lo[2], (int)lo[3], (int)h4[0], (int)h4[1], (int)h4[2], (int)h4[3]}; } }
  f32x16 pA0, pA1, pB0, pB1; float mnA, mnB, alA, alB; v8i pa = {};
  asm volatile("s_waitcnt vmcnt(0)" ::: "memory");
  __builtin_amdgcn_s_barrier();
  if (trail) __builtin_amdgcn_s_barrier();
  ISSUE_K(2, 2);
  qkt12(pA0, pA1, lds + AT_KN, qr, r32, hi);
  WAIT_BAR(3);
  ISSUE_V(1, 1);
  partialSM(pA0, pA1, m_reg, mnA, alA);
  WAIT_BAR(3);
  int s1 = 1;
  for (int j = 1; j + 1 < NT; j += 2) {
    const int s0 = s1 == 0 ? 2 : s1 - 1, s2 = s1 == 2 ? 0 : s1 + 1;
    ISSUE_K(j + 2, s0);
    SBAR(); qkt12(pB0, pB1, lds + AT_KN + s1 * 16384, qr, r32, hi);
    finishSM(pA0, pA1, pa); SBAR();
    WAIT_BAR(3);
    ISSUE_V(j + 1, s2);
    pv8(o, lsum, lds + AT_V + s0 * 8192, pa, r32, hi); partialSM(pB0, pB1, m_reg, mnB, alB);
    RESC(alB);
    WAIT_BAR(3);
    ISSUE_K(j + 3, s1);
    SBAR(); qkt12(pA0, pA1, lds + AT_KN + s2 * 16384, qr, r32, hi);
    finishSM(pB0, pB1, pa); SBAR();
    WAIT_BAR(3);
    ISSUE_V(j + 2, s0);
    pv8(o, lsum, lds + AT_V + s1 * 8192, pa, r32, hi); partialSM(pA0, pA1, m_reg, mnA, alA);
    RESC(alA);
    WAIT_BAR(3);
    s1 = s0;
  }
  {
    const int s0 = s1 == 0 ? 2 : s1 - 1, s2 = s1 == 2 ? 0 : s1 + 1;
    ISSUE_K(NT + 1, s0);
    SBAR(); qkt12(pB0, pB1, lds + AT_KN + s1 * 16384, qr, r32, hi);
    finishSM(pA0, pA1, pa); SBAR();
    WAIT_BAR(3);
    ISSUE_V(NT, s2);
    pv8(o, lsum, lds + AT_V + s0 * 8192, pa, r32, hi); partialSM(pB0, pB1, m_reg, mnB, alB);
    RESC(alB);
    WAIT_BAR(3);
    if (!trail) __builtin_amdgcn_s_barrier();
    finishSM(pB0, pB1, pa); SBAR();
    pv8(o, lsum, lds + AT_V + s1 * 8192, pa, r32, hi);
  }
  float rli[16];
#pragma unroll
  for (int r = 0; r < 16; ++r) rli[r] = __builtin_amdgcn_rcpf(lsum[r]);
  bf16_t* Ow = Ob + (size_t)(wid * 32) * 1024;
#pragma unroll
  for (int r = 0; r < 16; ++r) { const int orow = crow(r, hi);
#pragma unroll
    for (int d0 = 0; d0 < 4; ++d0) Ow[(size_t)orow * 1024 + d0 * 32 + r32] = f2bf(o[d0][r] * rli[r]); }
  asm volatile("s_waitcnt vmcnt(0) lgkmcnt(0)\n\ts_barrier" ::: "memory");
#undef DMA16
#undef ISSUE_K
#undef ISSUE_V
#undef WAIT_BAR
#undef RESC
}
DI void phase_attn(const Ctx& p, int bid, int G, LAS unsigned char* lds) {
  unsigned char* ws = p.ws;
  const unsigned char* qatt = ws + WS_QATT; const unsigned char* k8 = ws + WS_KN; const unsigned char* va = ws + WS_VA;
  bf16_t* hcat = (bf16_t*)(ws + WS_H);
  for (int u = bid; u < 512; u += G) {
    const int bh = u & 7, qb = u >> 3, b = bh >> 2, h = bh & 3;
    attn_unit(qatt + ((size_t)bh * SEQ + qb * 256) * 192, k8 + (size_t)bh * SEQ * 192, va + (size_t)bh * SEQ * 128,
              hcat + (size_t)(b * SEQ + qb * 256) * 1024 + 512 + h * 128, lds);
  }
}

constexpr int PC_K = 0, PC_V = 32768, PC_CF = 65536, PC_CB = 98304, PC_VEC = 131072;
template <bool DRY = false> DI void mlstmC_unit(const Ctx& p, int b, int h, int c, LAS unsigned char* lds) {
  const int tid = tid_fresh(), lane = tid & 63, wid = __builtin_amdgcn_readfirstlane(tid >> 6), r32 = lane & 31, hi = lane >> 5;
  unsigned char* ws = as_global(p.ws);
  const bf16_t* qkpost = (const bf16_t*)(ws + WS_U); const bf16_t* vmp = (const bf16_t*)(ws + WS_VM); bf16_t* hcat = (bf16_t*)(ws + WS_H);
  const float* gvec = (const float*)(ws + WS_GVEC); const float* nvec = (const float*)(ws + WS_NVEC); const float* mprev = (const float*)(ws + WS_SCAL) + 4096;
  const bf16_t* Cbuf = as_global((const bf16_t*)p.out);
  LAS float* vec = (LAS float*)(lds + PC_VEC);
  const int bh = b * 4 + h, row0 = b * SEQ + c * 128;
  if (tid < 256) {
    const int dir = tid >> 7, t = tid & 127;
    const float* gv = gvec + ((size_t)(dir * 8 + bh) * SEQ + c * 128 + t) * 3;
    const float gb = gv[0], gcol = gv[1], gcm = gv[2], mp = mprev[(dir * 8 + bh) * 128 + c];
    const float M = fmaxf(mp, gcm);
    vec[dir * 128 + t] = gcol * LOG2E; vec[256 + dir * 128 + t] = M * LOG2E; vec[512 + dir * 128 + t] = __expf(mp - M); vec[768 + dir * 128 + t] = __expf(-(gb + M));
    vec[1024 + dir * 128 + t] = nvec[((size_t)(dir * 8 + bh) * 128 + c) * 128 + t];
  }
  {
    const int r0 = tid >> 4, c8 = (tid & 15) * 8;
    const bf16_t* Cf = Cbuf + ((size_t)(0 * 8 + bh) * 128 + c) * 16384; const bf16_t* Cb = Cbuf + ((size_t)(1 * 8 + bh) * 128 + c) * 16384;
#pragma unroll
    for (int ps = 0; ps < 4; ++ps) {
      const int r = r0 + 32 * ps, tile = r >> 6, rr = r & 63;
      *(LAS u32x4*)(lds + PC_K + tile * 16384 + KSWZ(rr, c8 * 2)) = *(const u32x4*)(qkpost + (size_t)(row0 + r) * 1024 + 512 + h * 128 + c8);
      *(LAS u32x4*)(lds + PC_V + tile * 16384 + v_st(rr, c8)) = *(const u32x4*)(vmp + (size_t)(row0 + r) * 512 + h * 128 + c8);
      *(LAS u32x4*)(lds + PC_CF + tile * 16384 + v_st(rr, c8)) = *(const u32x4*)(Cf + r * 128 + c8);
      *(LAS u32x4*)(lds + PC_CB + tile * 16384 + v_st(rr, c8)) = *(const u32x4*)(Cb + r * 128 + c8);
    }
  }
  const int dir = wid >> 2, tb = wid & 3, t = tb * 32 + r32;
  bf16x8 qr[8];
  { const bf16_t* Qw = qkpost + (size_t)(row0 + t) * 1024 + h * 128 + hi * 8;
#pragma unroll
    for (int d0 = 0; d0 < 8; ++d0) qr[d0] = *(const bf16x8*)(Qw + d0 * 16); }
  __syncthreads();
  const LAS float* vcol = vec + dir * 128; const LAS float* va_ = vec + 512 + dir * 128; const LAS float* vn = vec + 1024 + dir * 128;
  float qn = 0.f;
#pragma unroll
  for (int d0 = 0; d0 < 8; ++d0)
#pragma unroll
    for (int j = 0; j < 8; ++j) qn += bf2f((unsigned short)qr[d0][j]) * vn[d0 * 16 + hi * 8 + j];
  qn = half_swap_sum(qn);
  asm volatile("" : "+v"(qn));
  SBAR();
  f32x16 o[4] = {};
  {
    const int vbc = (int)(uintptr_t)(lds + (dir ? PC_CB : PC_CF)) + v_rd_base(lane);
    pv_d0(o, vbc, qr[0], qr[1], qr[2], qr[3]);
    pv_d0(o, vbc + 16384, qr[4], qr[5], qr[6], qr[7]);
  }
#pragma unroll
  for (int d = 0; d < 4; ++d)
#pragma unroll
    for (int r = 0; r < 16; ++r) o[d][r] *= va_[tb * 32 + crow(r, hi)];
  SBAR();
  const float Mt = vec[256 + dir * 128 + t], at = va_[t], flt = vec[768 + dir * 128 + t];
  float rsum = 0.f;
  const int vbv = (int)(uintptr_t)(lds + PC_V) + v_rd_base(lane);
#pragma unroll
  for (int kt = 0; kt < 2; ++kt) {
    const bool need = dir == 0 ? (kt * 64 <= tb * 32 + 31) : (kt * 64 + 63 >= tb * 32);
    if (need) {
      f32x16 p0, p1; qkt8(p0, p1, lds + PC_K + kt * 16384, qr, r32, hi);
#pragma unroll
      for (int r = 0; r < 16; ++r) {
        const int s0 = kt * 64 + crow(r, hi), s1 = s0 + 32;
        const bool ok0 = dir == 0 ? (s0 <= t) : (s0 >= t), ok1 = dir == 0 ? (s1 <= t) : (s1 >= t);
        const float w0 = __builtin_amdgcn_exp2f(vcol[s0] - Mt), w1 = __builtin_amdgcn_exp2f(vcol[s1] - Mt);
        p0[r] = ok0 ? p0[r] * w0 : 0.f; p1[r] = ok1 ? p1[r] * w1 : 0.f;
        rsum += p0[r] + p1[r];
      }
      bf16x8 pa0, pa1, pa2, pa3; pack_p(p0, p1, pa0, pa1, pa2, pa3);
      pv_d0(o, vbv + kt * 16384, pa0, pa1, pa2, pa3);
    }
  }
  rsum = half_swap_sum(rsum);
  {
    const float den = at * qn + rsum, dn = fmaxf(fabsf(den), flt);
    LAS float* rd = vec + 1280 + dir * 128;
    if (hi == 0) rd[t] = 1.f / dn;
    asm volatile("s_waitcnt lgkmcnt(0)" ::: "memory");
#pragma unroll
    for (int d = 0; d < 4; ++d)
#pragma unroll
      for (int r = 0; r < 16; ++r) o[d][r] *= rd[tb * 32 + crow(r, hi)];
  }
  __syncthreads();
  {
    LAS float* hst = (LAS float*)(lds + dir * 65536);
#pragma unroll
    for (int r = 0; r < 16; ++r) { const int tr = tb * 32 + crow(r, hi);
#pragma unroll
      for (int d = 0; d < 4; ++d) hst[tr * 128 + d * 32 + r32] = o[d][r]; }
  }
  __syncthreads();
  {
    const int rg = tid >> 5, cl = tid & 31;
    const f32x4 g = *(const f32x4*)(as_global(karg<A_MHG>()) + h * 128 + 4 * cl);
    u32x2 sgv[8];
#pragma unroll
    for (int ps = 0; ps < 8; ++ps) sgv[ps] = *(const u32x2*)(hcat + (size_t)(row0 + ps * 16 + rg) * 1024 + h * 128 + 4 * cl);
#pragma unroll
    for (int ps = 0; ps < 8; ++ps) {
      const int tr = ps * 16 + rg;
      const f32x4 xf = *(const LAS f32x4*)(lds + (tr * 128 + 4 * cl) * 4), xb = *(const LAS f32x4*)(lds + 65536 + (tr * 128 + 4 * cl) * 4);
      f32x4 x = xf + xb;
      float s = (x[0] + x[1]) + (x[2] + x[3]);
      s = half_sum32(s);
      const float mu = s * (1.f / 128.f); x = x - mu;
      float q = (x[0] * x[0] + x[1] * x[1]) + (x[2] * x[2] + x[3] * x[3]);
      q = half_sum32(q);
      const float rstd = rsqrtf(q * (1.f / 128.f) + LN_EPS);
      u32x2* dst = (u32x2*)(hcat + (size_t)(row0 + tr) * 1024 + h * 128 + 4 * cl);
      const u32x2 sg = sgv[ps];
      const f32x4 y = x * rstd * g;
      if (DRY) dst = (u32x2*)((bf16_t*)(ws + WS_QKPRE) + (size_t)(row0 + tr) * 1024 + h * 128 + 4 * cl);
      *dst = (u32x2){cvtpk(y[0] * bflo(sg[0]), y[1] * bfhi(sg[0])), cvtpk(y[2] * bflo(sg[1]), y[3] * bfhi(sg[1]))};
    }
  }
  __syncthreads();
}

template <bool DRY = false> DI void phase_hanorm(const Ctx& p, int bid, int G) {
  const int tid = tid_fresh(), lane = tid & 63, wave = tid >> 6; bf16_t* hcat = (bf16_t*)(p.ws + WS_H);
  const f32x4 g0 = *(const f32x4*)(karg<A_ANG>() + 8 * lane), g1 = *(const f32x4*)(karg<A_ANG>() + 8 * lane + 4);
  u32x4 wn = {0u, 0u, 0u, 0u};
  { const int row = bid * 8 + wave; if (row < T) wn = *(const u32x4*)(hcat + (size_t)row * 1024 + 512 + 8 * lane); }
  for (int row = bid * 8 + wave; row < T; row += G * 8) {
    u32x4* ptr = (u32x4*)(hcat + (size_t)row * 1024 + 512 + 8 * lane);
    const u32x4 w = wn;
    if (row + G * 8 < T) wn = *(const u32x4*)(hcat + (size_t)(row + G * 8) * 1024 + 512 + 8 * lane);
    float v[8] = {bflo(w[0]), bfhi(w[0]), bflo(w[1]), bfhi(w[1]), bflo(w[2]), bfhi(w[2]), bflo(w[3]), bfhi(w[3])};
    float s = 0.f;
#pragma unroll
    for (int e = 0; e < 8; ++e) s += v[e] * v[e];
    const float rs = rsqrtf(wave_sum(s) * (1.f / 512.f) + RMS_EPS);
    if (DRY) ptr = (u32x4*)((bf16_t*)(p.ws + WS_QKPRE) + (size_t)row * 1024 + 512 + 8 * lane);
    *ptr = (u32x4){cvtpk(v[0] * rs * g0[0], v[1] * rs * g0[1]), cvtpk(v[2] * rs * g0[2], v[3] * rs * g0[3]), cvtpk(v[4] * rs * g1[0], v[5] * rs * g1[1]), cvtpk(v[6] * rs * g1[2], v[7] * rs * g1[3])};
  }
}

template <bool DRY = false> DI void phase_route(const Ctx& p, int bid, int G, LAS unsigned char* lds) {
  const int tid = tid_fresh(), lane = tid & 63, wave = tid >> 6; unsigned char* ws = p.ws;
  LAS float* wreT = (LAS float*)lds;
  LAS float* wrgT = (LAS float*)(lds + 131072);
  LAS int* rec = (LAS int*)(lds + 147456);
  LAS int* lcnt = (LAS int*)(lds + 147456 + 2048);
  LAS float* bre_l = (LAS float*)(lds + 147456 + 2048 + 256);
  { const f32x4* wrt = (const f32x4*)(ws + WS_WRT);
    for (int i = tid; i < 36 * 256; i += NTHREADS) ((LAS f32x4*)lds)[i] = wrt[i]; }
  if (tid < 32) bre_l[tid] = karg<A_BRE>()[tid];
  const float* ln1_g = karg<A_LN1G>(); const float* ln1_b = karg<A_LN1B>(); const float* b_rg = karg<A_BRG>(); const float* b_re = karg<A_BRE>();
  const float* mod = (const float*)(ws + WS_MOD); bf16_t* U = (bf16_t*)(ws + WS_U);
  int* cnt = (int*)(ws + WS_CNT) + (DRY ? 32 * CNT_STRIDE : 0);
  int* ltok = (int*)(ws + (DRY ? WS_HDN : WS_LTOK)); float* lw = (float*)(ws + (DRY ? WS_HDN + 8 * MiB : WS_LW));
  int* toke = (int*)(ws + WS_TOKE) + (DRY ? 2 * T : 0); int* tokp = (int*)(ws + WS_TOKP) + (DRY ? 2 * T : 0);
  const int nk = T / (G * 8);
  __syncthreads();
  f32x4 wg[4][4];
#pragma unroll
  for (int e = 0; e < 4; ++e)
#pragma unroll
    for (int j = 0; j < 4; ++j) wg[e][j] = *(const LAS f32x4*)(wrgT + e * 1024 + 4 * lane + 256 * j);
  f32x4 l1g[4], l1b[4];
#pragma unroll
  for (int j = 0; j < 4; ++j) { const int col = 4 * lane + 256 * j; l1g[j] = *(const f32x4*)(ln1_g + col); l1b[j] = *(const f32x4*)(ln1_b + col); }
  for (int k0 = 0; k0 < nk; k0 += 16) {
    if (tid < 32) lcnt[tid] = 0;
    __syncthreads();
    u32x2 zn[4];
    { const u32x2* zr = (const u32x2*)((const bf16_t*)p.out + (size_t)(bid * 8 + wave + k0 * G * 8) * 1024) + lane;
#pragma unroll
      for (int j = 0; j < 4; ++j) zn[j] = zr[64 * j]; }
    for (int kk = 0; kk < 16 && k0 + kk < nk; ++kk) {
      const int row = bid * 8 + wave + (k0 + kk) * G * 8, b = row >> 14;
      u32x2* x1r = (u32x2*)((bf16_t*)(ws + (DRY ? 384 * MiB : WS_H)) + (size_t)row * 1024) + lane;
      f32x4 msc[4], msh[4];
#pragma unroll
      for (int j = 0; j < 4; ++j) { const int col = 4 * lane + 256 * j; msc[j] = *(const f32x4*)(mod + b * 6144 + 4096 + col); msh[j] = *(const f32x4*)(mod + b * 6144 + 3072 + col); }
      f32x4 v[4]; float s = 0.f;
#pragma unroll
      for (int j = 0; j < 4; ++j) { const u32x2 raw = zn[j]; v[j] = (f32x4){bflo(raw[0]), bfhi(raw[0]), bflo(raw[1]), bfhi(raw[1])}; s += (v[j][0] + v[j][1]) + (v[j][2] + v[j][3]); }
      if (kk + 1 < 16 && k0 + kk + 1 < nk) { const u32x2* zr = (const u32x2*)((const bf16_t*)p.out + (size_t)(row + G * 8) * 1024) + lane;
#pragma unroll
        for (int j = 0; j < 4; ++j) zn[j] = zr[64 * j]; }
      float mean = wave_sum(s) * (1.f / 1024.f), s2 = 0.f;
#pragma unroll
      for (int j = 0; j < 4; ++j) { v[j] = v[j] - mean; s2 += (v[j][0] * v[j][0] + v[j][1] * v[j][1]) + (v[j][2] * v[j][2] + v[j][3] * v[j][3]); }
      float rstd = rsqrtf(wave_sum(s2) * (1.f / 1024.f) + LN_EPS);
      s = 0.f;
#pragma unroll
      for (int j = 0; j < 4; ++j) { const int col = 4 * lane + 256 * j;
        v[j] = v[j] * rstd * l1g[j] + l1b[j];
        x1r[64 * j] = (u32x2){cvtpk(v[j][0], v[j][1]), cvtpk(v[j][2], v[j][3])};
        s += (v[j][0] + v[j][1]) + (v[j][2] + v[j][3]); }
      mean = wave_sum(s) * (1.f / 1024.f); s2 = 0.f;
#pragma unroll
      for (int j = 0; j < 4; ++j) { v[j] = v[j] - mean; s2 += (v[j][0] * v[j][0] + v[j][1] * v[j][1]) + (v[j][2] * v[j][2] + v[j][3] * v[j][3]); }
      rstd = rsqrtf(wave_sum(s2) * (1.f / 1024.f) + LN_EPS);
      int* o8 = (int*)((unsigned char*)U + (size_t)row * 1024) + lane;
      float gl[4] = {0.f, 0.f, 0.f, 0.f};
#pragma unroll
      for (int j = 0; j < 4; ++j) { const int col = 4 * lane + 256 * j;
        v[j] = v[j] * rstd * (msc[j] + 1.f) + msh[j];
        { int w8 = __builtin_amdgcn_cvt_pk_fp8_f32(v[j][0], v[j][1], 0, false); o8[64 * j] = __builtin_amdgcn_cvt_pk_fp8_f32(v[j][2], v[j][3], w8, true); }
#pragma unroll
        for (int e = 0; e < 4; ++e) { const f32x4 w = wg[e][j]; gl[e] += v[j][0] * w[0] + v[j][1] * w[1] + v[j][2] * w[2] + v[j][3] * w[3]; } }
#pragma unroll
      for (int e = 0; e < 4; ++e) gl[e] = wave_sum(gl[e]) + b_rg[e];
      int gi = 0; float gm = gl[0];
#pragma unroll
      for (int e = 1; e < 4; ++e) if (gl[e] > gm) { gm = gl[e]; gi = e; }
      float gs = 0.f;
#pragma unroll
      for (int e = 0; e < 4; ++e) gs += __expf(gl[e] - gm);
      const float gw = 1.f / gs;
      float el[8] = {0.f, 0.f, 0.f, 0.f, 0.f, 0.f, 0.f, 0.f};
#pragma unroll
      for (int j = 0; j < 4; ++j) { const int col = 4 * lane + 256 * j;
#pragma unroll
        for (int e = 0; e < 8; ++e) { const f32x4 w = *(const LAS f32x4*)(wreT + (gi * 8 + e) * 1024 + col); el[e] += v[j][0] * w[0] + v[j][1] * w[1] + v[j][2] * w[2] + v[j][3] * w[3]; } }
#pragma unroll
      for (int e = 0; e < 8; ++e) el[e] = wave_sum(el[e]) + bre_l[gi * 8 + e];
      int i1 = 0; float v1 = el[0];
#pragma unroll
      for (int e = 1; e < 8; ++e) if (el[e] > v1) { v1 = el[e]; i1 = e; }
      int i2 = (i1 == 0) ? 1 : 0; float v2 = (i1 == 0) ? el[1] : el[0];
#pragma unroll
      for (int e = 0; e < 8; ++e) if (e != i1 && el[e] > v2) { v2 = el[e]; i2 = e; }
      const float p1 = 1.f / (1.f + __expf(v2 - v1)), p2 = 1.f - p1;
      if (lane == 0) {
        const int e1 = gi * 8 + i1, e2 = gi * 8 + i2, li = kk * 8 + wave;
        const int q1 = __hip_atomic_fetch_add(&lcnt[e1], 1, __ATOMIC_RELAXED, __HIP_MEMORY_SCOPE_WORKGROUP), q2 = __hip_atomic_fetch_add(&lcnt[e2], 1, __ATOMIC_RELAXED, __HIP_MEMORY_SCOPE_WORKGROUP);
        rec[li * 4 + 0] = e1 | (e2 << 8); rec[li * 4 + 1] = q1 | (q2 << 16); rec[li * 4 + 2] = __float_as_int(p1 * gw); rec[li * 4 + 3] = __float_as_int(p2 * gw);
      }
    }
    __syncthreads();
    if (tid < 32) { const int n = lcnt[tid]; lcnt[32 + tid] = n ? atomicAdd(&cnt[tid * CNT_STRIDE], n) : 0; }
    __syncthreads();
    if (tid < 128 && k0 + (tid >> 3) < nk) {
      const int li = tid, row = bid * 8 + (li & 7) + (k0 + (li >> 3)) * G * 8;
      const int ee = rec[li * 4], qq = rec[li * 4 + 1], e1 = ee & 255, e2 = ee >> 8, q1 = lcnt[32 + e1] + (qq & 0xffff), q2 = lcnt[32 + e2] + (qq >> 16);
      ltok[(size_t)e1 * T + q1] = row; lw[(size_t)e1 * T + q1] = __int_as_float(rec[li * 4 + 2]);
      ltok[(size_t)e2 * T + q2] = row; lw[(size_t)e2 * T + q2] = __int_as_float(rec[li * 4 + 3]);
      toke[row * 2] = e1; toke[row * 2 + 1] = e2; tokp[row * 2] = q1; tokp[row * 2 + 1] = q2;
    }
    __syncthreads();
  }
}

constexpr int MOE_TS = 147456;
DI void moe_table(const Ctx& p, LAS unsigned char* lds) {
  LAS int* ts = (LAS int*)(lds + MOE_TS); const int* cnt = (const int*)(p.ws + WS_CNT);
  if (threadIdx.x < 64) {
    const int lane = threadIdx.x; const int n = lane < 32 ? (cnt[lane * CNT_STRIDE] + 255) >> 8 : 0; int a = n;
#pragma unroll
    for (int o = 1; o < 32; o <<= 1) { const int t = __shfl_up(a, o); a += lane >= o ? t : 0; }
    if (lane < 32) ts[lane] = a - n;
    if (lane == 31) ts[32] = a;
  }
  __syncthreads();
}

template <bool DRY = false> DI void phase_final(const Ctx& p, int bid, int G, LAS unsigned char* lds) {
  const int tid = tid_fresh(), lane = tid & 63, wave = tid >> 6; unsigned char* ws = p.ws;
  const LAS int* ts = (const LAS int*)(lds + MOE_TS); const float* ln2_g = karg<A_LN2G>(); const float* ln2_b = karg<A_LN2B>();
  const float* mod = (const float*)(ws + WS_MOD); const bf16_t* ybuf = (const bf16_t*)(ws + WS_YBUF); const int* toke = (const int*)(ws + WS_TOKE); const int* tokp = (const int*)(ws + WS_TOKP);
  const int stride = G * 8; int row = bid * 8 + wave;
  int e0n = 0, p0n = 0, e1n = 0, p1n = 0;
  u32x2 an[4], cn[4], xn[4];
  auto rawslots = [&](int r) { e0n = toke[r * 2]; p0n = tokp[r * 2]; e1n = toke[r * 2 + 1]; p1n = tokp[r * 2 + 1]; };
  auto loadrow = [&](int r, size_t a, size_t c) {
    const u32x2* x1r = (const u32x2*)((const bf16_t*)(ws + WS_H) + (size_t)r * 1024) + lane;
    const u32x2* y0 = (const u32x2*)(ybuf + a * 1024) + lane; const u32x2* y1 = (const u32x2*)(ybuf + c * 1024) + lane;
#pragma unroll
    for (int j = 0; j < 4; ++j) { an[j] = y0[64 * j]; cn[j] = y1[64 * j]; xn[j] = x1r[64 * j]; } };
  f32x4 lg[4], lb[4];
#pragma unroll
  for (int j = 0; j < 4; ++j) { const int col = 4 * lane + 256 * j; lg[j] = *(const f32x4*)(ln2_g + col); lb[j] = *(const f32x4*)(ln2_b + col); }
  if (row < T) { rawslots(row); loadrow(row, (size_t)ts[e0n] * 256 + p0n, (size_t)ts[e1n] * 256 + p1n); if (row + stride < T) rawslots(row + stride); }
  for (; row < T; row += stride) {
    const int b = row >> 14;
    f32x4 v[4]; float s = 0.f;
#pragma unroll
    for (int j = 0; j < 4; ++j) { const int col = 4 * lane + 256 * j;
      const u32x2 a = an[j], c = cn[j], xw = xn[j];
      const f32x4 y = {bflo(a[0]) + bflo(c[0]), bfhi(a[0]) + bfhi(c[0]), bflo(a[1]) + bflo(c[1]), bfhi(a[1]) + bfhi(c[1])};
      const f32x4 x1v = {bflo(xw[0]), bfhi(xw[0]), bflo(xw[1]), bfhi(xw[1])};
      v[j] = x1v * ALPHA + (*(const f32x4*)(mod + b * 6144 + 5120 + col) + 1.f) * y;
      s += (v[j][0] + v[j][1]) + (v[j][2] + v[j][3]); }
    if (row + stride < T) { loadrow(row + stride, (size_t)ts[e0n] * 256 + p0n, (size_t)ts[e1n] * 256 + p1n); if (row + 2 * stride < T) rawslots(row + 2 * stride); }
    const float mean = wave_sum(s) * (1.f / 1024.f); float s2 = 0.f;
#pragma unroll
    for (int j = 0; j < 4; ++j) { v[j] = v[j] - mean; s2 += (v[j][0] * v[j][0] + v[j][1] * v[j][1]) + (v[j][2] * v[j][2] + v[j][3] * v[j][3]); }
    const float rstd = rsqrtf(wave_sum(s2) * (1.f / 1024.f) + LN_EPS);
    f32x4* xr = (f32x4*)(p.out + (size_t)row * 1024) + lane;
#pragma unroll
    for (int j = 0; j < 4; ++j) xr[64 * j] = v[j] * rstd * lg[j] + lb[j];
  }
}


#define XB_TMO      128
#define XB_XCNT(j)  (256  + 64 * (j))
#define XB_XSUB(j)  (1280 + 64 * (j))
#define XB_XGEN(j)  (2304 + 64 * (j))
#define XB_TOP      3328
#define XB_TOPGEN   3392
#define XCD_BAR_WORDS 3456
#define XB_SPIN_CAP (1u << 18)
DI unsigned xb_ld(unsigned* p)              { return __hip_atomic_load(p, __ATOMIC_RELAXED, __HIP_MEMORY_SCOPE_AGENT); }
DI unsigned xb_add(unsigned* p, unsigned v) { return __hip_atomic_fetch_add(p, v, __ATOMIC_RELAXED, __HIP_MEMORY_SCOPE_AGENT); }
DI unsigned xb_xcc_id() { return (unsigned)__builtin_amdgcn_s_getreg((3 << 11) | 20) & 0xFu; }
#define XB_SPIN(cond, bar) do { unsigned _sp = 0; while (cond) { __builtin_amdgcn_s_sleep(1); \
    if ((++_sp & 255u) == 0u) { if (xb_ld(&(bar)[XB_TMO])) break; if (_sp > XB_SPIN_CAP) { atomicAdd(&(bar)[XB_TMO], 1u); break; } } } } while (0)
struct XcdBarrier { unsigned* bar; unsigned x; volatile LAS unsigned* st; };
DI XcdBarrier xcd_barrier_post(unsigned* bar, volatile LAS unsigned* st) {
  XcdBarrier b; b.bar = bar; b.x = xb_xcc_id(); b.st = st;
  if (threadIdx.x == 0) (void)xb_add(&bar[XB_XCNT(b.x)], 1u);
  return b;
}
DI void xcd_barrier_complete(unsigned* bar, unsigned x, unsigned& nloc, unsigned& nx) {
  const unsigned G = gridDim.x * gridDim.y * gridDim.z;
  unsigned sum, cnt, mine, sp = 0u;
  for (;;) {
    sum = 0u; cnt = 0u; mine = 0u;
#pragma unroll
    for (unsigned j = 0; j < 16; ++j) { const unsigned c = xb_ld(&bar[XB_XCNT(j)]); sum += c; cnt += (c > 0u) ? 1u : 0u; mine = (j == x) ? c : mine; }
    if (sum == G) break;
    __builtin_amdgcn_s_sleep(1);
    if ((++sp & 255u) == 0u) { if (xb_ld(&bar[XB_TMO])) break; if (sp > XB_SPIN_CAP) { atomicAdd(&bar[XB_TMO], 1u); break; } }
  }
  nloc = mine > 0u ? mine : 1u; nx = cnt > 0u ? cnt : 1u;
}
DI void xcd_barrier(const XcdBarrier& b) {
  asm volatile("s_waitcnt vmcnt(0)" ::: "memory");
  __syncthreads();
  if (threadIdx.x == 0) {
    unsigned* bar = b.bar;
    __builtin_amdgcn_s_waitcnt(0);
    unsigned nloc = b.st[0], nx = b.st[1];
    if (nloc == 0u) { xcd_barrier_complete(bar, b.x, nloc, nx); b.st[0] = nloc; b.st[1] = nx; }
    const unsigned old = xb_add(&bar[XB_XSUB(b.x)], 1u);
    const unsigned gen = old / nloc;
    if (old + 1u == (gen + 1u) * nloc) {
      __builtin_amdgcn_fence(__ATOMIC_RELEASE, "agent");
      asm volatile("s_waitcnt vmcnt(0)" ::: "memory");
      const unsigned og = xb_add(&bar[XB_TOP], 1u);
      const unsigned tg = og / nx;
      if (og + 1u == (tg + 1u) * nx) xb_add(&bar[XB_TOPGEN], 1u);
      else XB_SPIN(xb_ld(&bar[XB_TOPGEN]) == tg, bar);
      __builtin_amdgcn_fence(__ATOMIC_ACQUIRE, "agent");
      xb_add(&bar[XB_XGEN(b.x)], 1u);
      asm volatile("s_waitcnt vmcnt(0)" ::: "memory");
    } else {
      XB_SPIN(xb_ld(&bar[XB_XGEN(b.x)]) == gen, bar);
      __builtin_amdgcn_fence(__ATOMIC_ACQUIRE, "agent");
      asm volatile("s_waitcnt vmcnt(0)" ::: "memory");
    }
  }
  __syncthreads();
}

__device__ unsigned g_bar_counter = 0;
DI void grid_barrier(const unsigned G) {
  asm volatile("s_waitcnt vmcnt(0)" ::: "memory");
  __syncthreads();
  if (threadIdx.x == 0) {
    __builtin_amdgcn_fence(__ATOMIC_RELEASE, "agent");
    asm volatile("s_waitcnt vmcnt(0)" ::: "memory");
    const unsigned old = __hip_atomic_fetch_add(&g_bar_counter, 1u, __ATOMIC_RELAXED, __HIP_MEMORY_SCOPE_AGENT);
    const unsigned target = (old / G + 1u) * G;
    unsigned sp = 0;
    while ((int)(__hip_atomic_load(&g_bar_counter, __ATOMIC_RELAXED, __HIP_MEMORY_SCOPE_AGENT) - target) < 0) { __builtin_amdgcn_s_sleep(1); if (++sp > (1u << 24)) break; }
    __builtin_amdgcn_fence(__ATOMIC_ACQUIRE, "agent");
    asm volatile("s_waitcnt vmcnt(0)" ::: "memory");
  }
  __syncthreads();
}

#define KERNEL_HEAD extern __shared__ __attribute__((aligned(16))) unsigned char lds_raw[]; LAS unsigned char* lds = (LAS unsigned char*)lds_raw; const int bid = blockIdx.x, G = gridDim.x; \
  Ctx p; p.ws = karg<A_WS, unsigned char>(); p.out = karg<A_OUT, float>();
#ifdef MULTI_LAUNCH
__global__ void __launch_bounds__(NTHREADS, 2) k_prep(Params) { KERNEL_HEAD phase_prep(p, bid, G, lds); }
__global__ void __launch_bounds__(NTHREADS, 2) k_lnmod(Params) { KERNEL_HEAD (void)lds; phase_lnmod(p, bid, G); }
__global__ void __launch_bounds__(NTHREADS, 2) k_inproj(Params) { KERNEL_HEAD
  unsigned char* ws = p.ws;
  g8::DenseOrder S; S.init(T, N_INP, 1024, ws + WS_WIN, G, bid);
  EpiIn E{(bf16_t*)(ws + WS_QKPRE), (bf16_t*)(ws + WS_VM), (bf16_t*)(ws + WS_H), (bf16_t*)(ws + WS_CQ), (bf16_t*)(ws + WS_CKV), (unsigned char*)(ws + WS_KN), (float*)(ws + WS_GATES),
          (float*)(ws + WS_SSQQ), (float*)(ws + WS_SSQKV), (const float*)(ws + WS_ROPE), karg<A_GATEB>()};
  g8::gemm_phase(lds, (const char*)(ws + WS_U), 1024, S, E);
}
__global__ void __launch_bounds__(NTHREADS, 2) k_mid1(Params) { KERNEL_HEAD
  unsigned char* ws = p.ws;
  { g8::DenseOrder S; S.init(T, 768, 384, ws + WS_WUQ, G, bid); EpiUQ E{(unsigned char*)(ws + WS_QATT), (const float*)(ws + WS_SSQQ), (const float*)(ws + WS_ROPE)};
    g8::gemm_phase(lds, (const char*)(ws + WS_CQ), 384, S, E); }
}
__global__ void __launch_bounds__(NTHREADS, 2) k_mid2(Params) { KERNEL_HEAD
  unsigned char* ws = p.ws;
  { g8::DenseOrder S; S.init(T, 1024, 256, ws + WS_WUKV, G, bid); EpiUKV E{(unsigned char*)(ws + WS_KN), (unsigned char*)(ws + WS_VA), (const float*)(ws + WS_SSQKV)};
    g8::gemm_phase(lds, (const char*)(ws + WS_CKV), 256, S, E); }
}
__global__ void __launch_bounds__(NTHREADS, 2) k_mid3(Params) { KERNEL_HEAD
  for (int u = bid; u < 1024; u += G) { const int c = u & 127, bh = u >> 7; mlstmA_unit(p, bh >> 2, bh & 3, c, lds); }
}
__global__ void __launch_bounds__(NTHREADS, 2) k_scan_attn(Params) { KERNEL_HEAD phase_scan(p, bid, G); phase_attn(p, bid, G, lds); }
__global__ void __launch_bounds__(NTHREADS, 2) k_mlstm_out(Params) { KERNEL_HEAD
  for (int u = bid; u < 1024; u += G) { const int c = u & 127, bh = u >> 7; mlstmC_unit(p, bh >> 2, bh & 3, c, lds); }
  phase_hanorm(p, bid, G);
}
__global__ void __launch_bounds__(NTHREADS, 2) k_outproj(Params) { KERNEL_HEAD
  unsigned char* ws = p.ws;
  g8::DenseOrder S; S.init(T, 1024, 1024, ws + WS_WOUT, G, bid); EpiOut E{karg<A_X>(), (const float*)(ws + WS_MOD), (bf16_t*)p.out};
  g8::gemm_phase(lds, (const char*)(ws + WS_H), 1024, S, E);
}
__global__ void __launch_bounds__(NTHREADS, 2) k_route(Params) { KERNEL_HEAD phase_route(p, bid, G, lds); }
__global__ void __launch_bounds__(NTHREADS, 2) k_moe_gu(Params) { KERNEL_HEAD
  unsigned char* ws = p.ws; moe_table(p, lds);
  MoeOrderGU S; S.tstart = (const LAS int*)(lds + MOE_TS); S.cnt = (const int*)(ws + WS_CNT); S.G = G; S.c = bid; S.ltok = (const int*)(ws + WS_LTOK); S.Bt = (const char*)(ws + WS_WGU);
  EpiGU E{(unsigned char*)(ws + WS_HDN)};
  g8::gemm_phase8(lds, (const char*)(ws + WS_U), 512  , S, E);
}
__global__ void __launch_bounds__(NTHREADS, 2) k_moe_dn(Params) { KERNEL_HEAD
  unsigned char* ws = p.ws; moe_table(p, lds);
  MoeOrderDN S; S.tstart = (const LAS int*)(lds + MOE_TS); S.cnt = (const int*)(ws + WS_CNT); S.G = G; S.c = bid; S.Bt = (const char*)(ws + WS_WDN);
  EpiDN E{(bf16_t*)(ws + WS_YBUF), (const float*)(ws + WS_LW)};
  g8::gemm_phase8(lds, (const char*)(ws + WS_HDN), 256  , S, E);
}
__global__ void __launch_bounds__(NTHREADS, 2) k_final(Params) { KERNEL_HEAD moe_table(p, lds); phase_final(p, bid, G, lds); }

#endif

__global__ void __launch_bounds__(NTHREADS, 2) k_mega(Params) { KERNEL_HEAD
  unsigned char* ws = p.ws;
  if (bid == 0) for (int i = threadIdx.x; i < XCD_BAR_WORDS; i += NTHREADS) ((unsigned*)(ws + WS_BAR))[i] = 0u;
  if (threadIdx.x < 64) ((LAS unsigned*)(lds + LDS_BARST))[threadIdx.x] = 0u;
  XcdBarrier xbar; xbar.bar = (unsigned*)(ws + WS_BAR); xbar.x = 0; xbar.st = (volatile LAS unsigned*)(lds + LDS_BARST);
  bool xb_ready = false;
#define PHASE_SEP() do { asm volatile("" ::: "memory"); if (!xb_ready) { grid_barrier((unsigned)G); xbar = xcd_barrier_post((unsigned*)(ws + WS_BAR), (volatile LAS unsigned*)(lds + LDS_BARST)); xb_ready = true; } \
    else xcd_barrier(xbar); asm volatile("" ::: "memory"); } while (0)
#define REP(n) for (int rep_ = 0; rep_ < ((n) == DBL_PHASE ? 2 : 1); ++rep_)
  REP(0) phase_prep(p, bid, G, lds);
  PHASE_SEP();
#if MEGA_STOP == 1
  return;
#endif
  REP(1) phase_lnmod(p, bid, G);
  PHASE_SEP();
#if MEGA_STOP == 2
  return;
#endif
  REP(2) { g8::DenseOrder S; S.init(T, N_INP, 1024, ws + WS_WIN, G, bid);
    EpiIn E{(bf16_t*)(ws + WS_QKPRE), (bf16_t*)(ws + WS_VM), (bf16_t*)(ws + WS_H), (bf16_t*)(ws + WS_CQ), (bf16_t*)(ws + WS_CKV), (unsigned char*)(ws + WS_KN), (float*)(ws + WS_GATES),
            (float*)(ws + WS_SSQQ), (float*)(ws + WS_SSQKV), (const float*)(ws + WS_ROPE), karg<A_GATEB>()};
    g8::gemm_phase(lds, (const char*)(ws + WS_U), 1024, S, E);
    { const int first = S.nwg % G, nb = G - first;
      if (bid >= first) { const int tid = tid_fresh(), lane = tid & 63, wave = __builtin_amdgcn_readfirstlane(tid >> 6);
        prep_items(PREP_ITEMS - PREP_DEFER + (bid - first) * 8 + wave, PREP_ITEMS, nb * 8, lane, ws, (LAS float*)(lds + wave * 16384)); } } }
  PHASE_SEP();
#if MEGA_STOP == 3
  return;
#endif
  const bool mfirst = ((bid >> 3) & 1) != 0;
  if (mfirst) { for (int u = bid; u < 1024; u += G) { const int c = u & 127, bh = u >> 7; mlstmA_unit(p, bh >> 2, bh & 3, c, lds); } __syncthreads(); }
  { g8::DenseOrder S; S.init(T, 768, 384, ws + WS_WUQ, G, bid); EpiUQ E{(unsigned char*)(ws + WS_QATT), (const float*)(ws + WS_SSQQ), (const float*)(ws + WS_ROPE)};
    g8::gemm_phase(lds, (const char*)(ws + WS_CQ), 384, S, E); }
  __syncthreads();
  { g8::DenseOrder S; S.init(T, 1024, 256, ws + WS_WUKV, G, bid); EpiUKV E{(unsigned char*)(ws + WS_KN), (unsigned char*)(ws + WS_VA), (const float*)(ws + WS_SSQKV)};
    g8::gemm_phase(lds, (const char*)(ws + WS_CKV), 256, S, E); }
  __syncthreads();
  if (!mfirst) { for (int u = bid; u < 1024; u += G) { const int c = u & 127, bh = u >> 7; mlstmA_unit(p, bh >> 2, bh & 3, c, lds); } }
  PHASE_SEP();
#if MEGA_STOP == 4
  return;
#endif
  phase_scan(p, bid, G);
  REP(4) phase_attn(p, bid, G, lds);
  PHASE_SEP();
#if MEGA_STOP == 5
  return;
#endif
#if DBL_PHASE == 5
  for (int u = bid; u < 1024; u += G) { const int c = u & 127, bh = u >> 7; mlstmC_unit<true>(p, bh >> 2, bh & 3, c, lds); }
#endif
#if DBL_PHASE == 55
  phase_hanorm<true>(p, bid, G);
#endif
  for (int u = bid; u < 1024; u += G) { const int c = u & 127, bh = u >> 7; mlstmC_unit(p, bh >> 2, bh & 3, c, lds); }
  phase_hanorm(p, bid, G);
  PHASE_SEP();
#if MEGA_STOP == 6
  return;
#endif
  REP(6) { g8::DenseOrder S; S.init(T, 1024, 1024, ws + WS_WOUT, G, bid); EpiOut E{karg<A_X>(), (const float*)(ws + WS_MOD), (bf16_t*)p.out};
    g8::gemm_phase(lds, (const char*)(ws + WS_H), 1024, S, E); }
  PHASE_SEP();
#if MEGA_STOP == 7
  return;
#endif
#if DBL_PHASE == 7
  phase_route<true>(p, bid, G, lds);
#endif
  phase_route(p, bid, G, lds);
  PHASE_SEP();
#if MEGA_STOP == 8
  return;
#endif
  moe_table(p, lds);
  REP(8) { MoeOrderGU S; S.tstart = (const LAS int*)(lds + MOE_TS); S.cnt = (const int*)(ws + WS_CNT); S.G = G; S.c = bid; S.ltok = (const int*)(ws + WS_LTOK); S.Bt = (const char*)(ws + WS_WGU);
    EpiGU E{(unsigned char*)(ws + WS_HDN)};
    g8::gemm_phase8(lds, (const char*)(ws + WS_U), 512  , S, E); }
  PHASE_SEP();
#if MEGA_STOP == 9
  return;
#endif
  REP(9) { MoeOrderDN S; S.tstart = (const LAS int*)(lds + MOE_TS); S.cnt = (const int*)(ws + WS_CNT); S.G = G; S.c = bid; S.Bt = (const char*)(ws + WS_WDN);
    EpiDN E{(bf16_t*)(ws + WS_YBUF), (const float*)(ws + WS_LW)};
    g8::gemm_phase8(lds, (const char*)(ws + WS_HDN), 256  , S, E); }
  PHASE_SEP();
#if MEGA_STOP == 10
  return;
#endif
#if DBL_PHASE == 10
  phase_final<true>(p, bid, G, lds);
#endif
  phase_final(p, bid, G, lds);
#undef REP
#undef PHASE_SEP
}

#ifdef PROBE_OFF
__global__ void __launch_bounds__(NTHREADS, 2) k_probe(Params p, size_t off, size_t n, int is_f32, int from_out) {
  const unsigned char* base = from_out ? (const unsigned char*)p.out : p.ws + off;
  for (size_t i = (size_t)blockIdx.x * NTHREADS + threadIdx.x; i < (size_t)T * D; i += (size_t)gridDim.x * NTHREADS) {
    const size_t j = i % n; float v = is_f32 ? ((const float*)base)[j] : bf2f(((const unsigned short*)base)[j]);
    if (!(fabsf(v) < 1e30f)) v = 777.f;
    if (from_out) { if (j != i) break; ((float*)p.out)[i] = v; } else p.out[i] = v;
  }
}
#endif
extern "C" void kernel_launch(void* const* d_in, const int* in_sizes, int n_in, void* d_out, int out_size, void* d_ws, size_t ws_size, hipStream_t stream) {
  static int ok = 0, grid = 256;
  typedef void (*kfn)(Params);
#ifndef MULTI_LAUNCH
  const kfn kernels[] = {k_mega};
#else
  const kfn kernels[] = {k_prep, k_lnmod, k_inproj, k_mid1, k_mid2, k_mid3, k_scan_attn, k_mlstm_out, k_outproj, k_route, k_moe_gu, k_moe_dn, k_final};
#endif
  if (ok == 0) {
    if (n_in != 27 || in_sizes[0] != T * D || out_size != T * D || ws_size < WS_END) { fprintf(stderr, "kernel_launch: unexpected shapes (n_in %d, in0 %d, out %d, ws %zu)\n", n_in, n_in > 0 ? in_sizes[0] : -1, out_size, ws_size); ok = -1; return; }
    for (kfn k : kernels) if (hipFuncSetAttribute((const void*)k, hipFuncAttributeMaxDynamicSharedMemorySize, LDS_BYTES) != hipSuccess) { fprintf(stderr, "kernel_launch: hipFuncSetAttribute failed\n"); ok = -1; return; }
    int dev = 0, cus = 0, per_cu = 0;
    if (hipGetDevice(&dev) != hipSuccess || hipDeviceGetAttribute(&cus, hipDeviceAttributeMultiprocessorCount, dev) != hipSuccess) { fprintf(stderr, "kernel_launch: device query failed\n"); ok = -1; return; }
    if (hipOccupancyMaxActiveBlocksPerMultiprocessor(&per_cu, (const void*)kernels[0], NTHREADS, LDS_BYTES) != hipSuccess || per_cu < 1) { fprintf(stderr, "kernel_launch: occupancy query says %d blocks/CU\n", per_cu); (void)hipGetLastError(); per_cu = 1; }
    grid = cus < 256 ? cus : 256;
    fprintf(stderr, "kernel_launch: %d CUs, %d blocks/CU by the occupancy query, grid %d\n", cus, per_cu, grid);
    ok = 1;
  }
  if (ok < 0) return;
  Params p{};
  p.x = (const float*)d_in[0]; p.c = (const float*)d_in[1]; p.pos = (const int*)d_in[2]; p.w_ada = (const float*)d_in[3]; p.b_ada = (const float*)d_in[4]; p.w_in = (const float*)d_in[5];
  p.conv_w = (const float*)d_in[6]; p.conv_b = (const float*)d_in[7]; p.gate_b = (const float*)d_in[8]; p.mh_g = (const float*)d_in[9]; p.qn_g = (const float*)d_in[10]; p.kvn_g = (const float*)d_in[11];
  p.w_uq = (const float*)d_in[12]; p.w_ukv = (const float*)d_in[13]; p.an_g = (const float*)d_in[14]; p.w_out = (const float*)d_in[15]; p.ln1_g = (const float*)d_in[16]; p.ln1_b = (const float*)d_in[17];
  p.w_rg = (const float*)d_in[18]; p.b_rg = (const float*)d_in[19]; p.w_re = (const float*)d_in[20]; p.b_re = (const float*)d_in[21]; p.w_gate = (const float*)d_in[22]; p.w_up = (const float*)d_in[23];
  p.w_down = (const float*)d_in[24]; p.ln2_g = (const float*)d_in[25]; p.ln2_b = (const float*)d_in[26];
  p.out = (float*)d_out; p.ws = (unsigned char*)d_ws;
#ifndef NKERN
#define NKERN 6
#endif
  { int ik = 0; for (kfn k : kernels) { if (ik++ >= NKERN) break; hipLaunchKernelGGL(k, dim3(grid), dim3(NTHREADS), LDS_BYTES, stream, p); } }
#ifdef PROBE_OFF
  hipLaunchKernelGGL(k_probe, dim3(1024), dim3(NTHREADS), 0, stream, p, (size_t)(PROBE_OFF), (size_t)(PROBE_N), PROBE_F32, 0);
#endif
  const hipError_t le = hipPeekAtLastError();
  if (le != hipSuccess) fprintf(stderr, "kernel_launch: launch failed: %s\n", hipGetErrorName(le));
}
```
